# Optimizing an MI355X kernel written in HIP

```python
import jax, jax.numpy as jnp
from jax import lax
import numpy as np

D_MODEL = 1024
BATCH = 2
SEQ = 8192
DEPTH = 4

CHUNK = 64
EPS = 1e-6
ROPE_THETA = 10000.0

A_HEADS = 4
A_DK = 128
A_DV = 128
A_WIDTH = A_HEADS * A_DV
B_GROUPS = 4
B_GROUP_DIM = 128
B_WIDTH = B_GROUPS * B_GROUP_DIM
B_BLOCK = 128
C_HEADS = 4
C_HEAD_DIM = 128
C_WIDTH = C_HEADS * C_HEAD_DIM
IDX_HEADS = 8
IDX_DIM = 64
DSA_TOPK_MAX = 256
Q_BLOCK = 128
N_BRANCH = 3
BRANCH_WIDTH = 512
PEER_HEADS = 8
PEER_N_KEYS = 128
PEER_N_EXPERTS = PEER_N_KEYS * PEER_N_KEYS
PEER_KEY_DIM = 128
PEER_TOPK = 16
PEER_BLOCK = 128

IN_SIZES = (A_HEADS * A_DK, A_HEADS * A_DK, A_WIDTH, A_WIDTH,
            B_WIDTH, B_WIDTH,
            C_WIDTH, C_WIDTH, C_WIDTH,
            IDX_HEADS * IDX_DIM, IDX_DIM, IDX_HEADS,
            N_BRANCH * D_MODEL)
N_IN = sum(IN_SIZES)

kernel_name = "hybrid_hgrn2_gmlp_dsa_peer_trunk"


def rmsnorm(x, gain):
    xf = x.astype(jnp.float32)
    y = xf * lax.rsqrt(jnp.mean(xf * xf, axis=-1, keepdims=True) + EPS)
    return (y * gain.astype(jnp.float32)).astype(x.dtype)


def rope(x, positions):
    half = x.shape[-1] // 2
    inv = ROPE_THETA ** (-jnp.arange(half, dtype=jnp.float32) / half)
    ang = positions.astype(jnp.float32)[..., None] * inv
    cos = jnp.cos(ang)[:, :, None, :]
    sin = jnp.sin(ang)[:, :, None, :]
    x1 = x[..., :half].astype(jnp.float32)
    x2 = x[..., half:].astype(jnp.float32)
    out = jnp.concatenate([x1 * cos - x2 * sin, x2 * cos + x1 * sin], axis=-1)
    return out.astype(x.dtype)


def hgrn2_mixer(q, f_logit, i, g, lb, norm_gain):
    B, S, _ = q.shape
    nc = S // CHUNK
    f32 = jnp.float32
    lbf = lb.astype(f32)
    z = f_logit.astype(f32)
    logf = jnp.logaddexp(jnp.log(lbf), jnp.log1p(-lbf) + jax.nn.log_sigmoid(z))
    key = (1.0 - lbf) * jax.nn.sigmoid(-z)
    qf = jax.nn.silu(q.astype(f32)) * (A_DK ** -0.5)
    vf = i.astype(f32)

    def to_chunks(t, d):
        return t.reshape(B, nc, CHUNK, A_HEADS, d).transpose(1, 0, 3, 2, 4)

    tri = jnp.tril(jnp.ones((CHUNK, CHUNK), dtype=bool))

    def step(state, inp):
        qc, kc, vc, lfc = inp
        b = jnp.cumsum(lfc, axis=2)
        diff = b[:, :, :, None, :] - b[:, :, None, :, :]
        decay = jnp.exp(jnp.where(tri[:, :, None], diff, -jnp.inf))
        attn = jnp.einsum('bhtd,bhtsd,bhsd->bhts', qc, decay, kc)
        o = attn @ vc + jnp.einsum('bhtd,bhde->bhte', qc * jnp.exp(b), state)
        b_last = b[:, :, -1:, :]
        state = (jnp.exp(b_last[:, :, 0, :, None]) * state
                 + jnp.einsum('bhsd,bhse->bhde', kc * jnp.exp(b_last - b), vc))
        return state, o

    state0 = jnp.zeros((B, A_HEADS, A_DK, A_DV), f32)
    _, o = lax.scan(step, state0, (to_chunks(qf, A_DK), to_chunks(key, A_DK),
                                   to_chunks(vf, A_DV), to_chunks(logf, A_DK)))
    o = o.transpose(1, 0, 3, 2, 4).reshape(B, S, A_HEADS, A_DV)
    o = rmsnorm(o, norm_gain)
    gate = jax.nn.silu(g.astype(f32)).reshape(B, S, A_HEADS, A_DV)
    return (o * gate).reshape(B, S, A_WIDTH).astype(g.dtype)


def gmlp_mixer(u, v, norm_gain, w_s, b_s):
    B, S, _ = u.shape
    u = jax.nn.gelu(u)
    v = rmsnorm(jax.nn.gelu(v), norm_gain)
    nb = S // B_BLOCK
    vb = v.reshape(B, nb, B_BLOCK, B_GROUPS, B_GROUP_DIM)
    w = w_s * jnp.tril(jnp.ones((B_BLOCK, B_BLOCK), w_s.dtype))
    mixed = jnp.einsum('gts,bnsgc->bntgc', w, vb) + b_s.T[None, None, :, :, None]
    return u * mixed.reshape(B, S, B_WIDTH)


def dsa_mixer(q, k, v, qi, ki, wi, positions):
    B, S, _ = q.shape
    f32 = jnp.float32
    topk = min(DSA_TOPK_MAX, S // 4)
    q = rope(q.reshape(B, S, C_HEADS, C_HEAD_DIM), positions)
    k = rope(k.reshape(B, S, C_HEADS, C_HEAD_DIM), positions)
    v = v.reshape(B, S, C_HEADS, C_HEAD_DIM)
    qi = rope(qi.reshape(B, S, IDX_HEADS, IDX_DIM), positions)
    ki = rope(ki.reshape(B, S, 1, IDX_DIM), positions)[:, :, 0].astype(f32)
    wi = wi.astype(f32) * (IDX_HEADS ** -0.5)
    nq = S // Q_BLOCK
    key_chunk = jnp.arange(S) // CHUNK
    b_idx = jnp.arange(B)[:, None, None]

    def blocks(t):
        return t.reshape(B, nq, Q_BLOCK, *t.shape[2:]).swapaxes(0, 1)

    def attend(inp):
        q_blk, qi_blk, wi_blk, blk = inp
        q_chunk = (blk * Q_BLOCK + jnp.arange(Q_BLOCK)) // CHUNK
        admissible = key_chunk[None, :] <= q_chunk[:, None]
        logits = jnp.einsum('bthd,bsd->bths', qi_blk.astype(f32), ki) * (IDX_DIM ** -0.5)
        score = jnp.einsum('bth,bths->bts', wi_blk, jax.nn.relu(logits))
        score = jnp.where(admissible[None], score, -jnp.inf)
        _, sel = lax.top_k(score, topk)
        valid = key_chunk[sel] <= q_chunk[None, :, None]
        k_sel = k[b_idx, sel]
        v_sel = v[b_idx, sel]
        s = jnp.einsum('bthd,btkhd->bthk', q_blk.astype(f32), k_sel.astype(f32)) * (C_HEAD_DIM ** -0.5)
        s = jnp.where(valid[:, :, None, :], s, -jnp.inf)
        p = jax.nn.softmax(s, axis=-1)
        return jnp.einsum('bthk,btkhd->bthd', p.astype(v.dtype), v_sel)

    out = lax.map(attend, (blocks(q), blocks(qi), blocks(wi), jnp.arange(nq)))
    return out.swapaxes(0, 1).reshape(B, S, C_WIDTH)


def peer_ffn(h, w_q, sub_keys, u_tab, v_tab):
    B, S, _ = h.shape
    f32 = jnp.float32
    qry = (h @ w_q).reshape(B, S, PEER_HEADS, 2, PEER_KEY_DIM)
    sc = jnp.einsum('bshpd,hpnd->bshpn', qry.astype(f32), sub_keys.astype(f32))
    top_v, top_i = lax.top_k(sc, PEER_TOPK)
    cand = (top_v[..., 0, :, None] + top_v[..., 1, None, :]).reshape(B, S, PEER_HEADS, PEER_TOPK * PEER_TOPK)
    cand_id = (top_i[..., 0, :, None] * PEER_N_KEYS + top_i[..., 1, None, :]).reshape(B, S, PEER_HEADS, PEER_TOPK * PEER_TOPK)
    best_v, best_pos = lax.top_k(cand, PEER_TOPK)
    expert = jnp.take_along_axis(cand_id, best_pos, axis=-1)
    gate = jax.nn.softmax(best_v, axis=-1)
    nb = S // PEER_BLOCK

    def blocks(t):
        return t.reshape(B, nb, PEER_BLOCK, *t.shape[2:]).swapaxes(0, 1)

    def experts(inp):
        h_blk, e_blk, g_blk = inp
        act = jax.nn.gelu(jnp.einsum('btd,bthkd->bthk', h_blk, u_tab[e_blk]))
        return jnp.einsum('bthk,bthkd->btd', (g_blk * act).astype(h.dtype), v_tab[e_blk])

    out = lax.map(experts, (blocks(h), blocks(expert), blocks(gate)))
    return out.swapaxes(0, 1).reshape(B, S, D_MODEL)


def setup_inputs(seed: int = 0) -> dict:
    key = jax.random.key(seed)
    ks = jax.random.split(key, 17)
    f32 = jnp.float32
    nrm = lambda k, shape, s: jax.random.normal(k, shape, f32) * s
    x = jax.random.normal(ks[0], (BATCH, SEQ, D_MODEL), f32)
    offset = jax.random.randint(ks[1], (BATCH, 1), 0, 4096, dtype=jnp.int32)
    positions = (offset + jnp.arange(SEQ, dtype=jnp.int32)[None, :]).astype(jnp.int32)
    return {
        "x": x,
        "positions": positions,
        "norm1_gain": 1.0 + nrm(ks[2], (DEPTH, D_MODEL), 0.05),
        "w_in": nrm(ks[3], (DEPTH, D_MODEL, N_IN), D_MODEL ** -0.5),
        "hgrn_lb_logits": nrm(ks[4], (DEPTH, A_HEADS * A_DK), 0.5),
        "hgrn_norm_gain": 1.0 + nrm(ks[5], (DEPTH, A_DV), 0.05),
        "gmlp_norm_gain": 1.0 + nrm(ks[6], (DEPTH, B_WIDTH), 0.05),
        "gmlp_w_s": nrm(ks[7], (DEPTH, B_GROUPS, B_BLOCK, B_BLOCK), B_BLOCK ** -0.5),
        "gmlp_b_s": nrm(ks[8], (DEPTH, B_GROUPS, B_BLOCK), 0.02),
        "w_branch": nrm(ks[9], (DEPTH, N_BRANCH, BRANCH_WIDTH, D_MODEL), BRANCH_WIDTH ** -0.5),
        "w_out": nrm(ks[10], (DEPTH, D_MODEL, D_MODEL), D_MODEL ** -0.5),
        "norm2_gain": 1.0 + nrm(ks[11], (DEPTH, D_MODEL), 0.05),
        "peer_w_q": nrm(ks[12], (DEPTH, D_MODEL, PEER_HEADS * 2 * PEER_KEY_DIM), D_MODEL ** -0.5),
        "peer_sub_keys": nrm(ks[13], (DEPTH, PEER_HEADS, 2, PEER_N_KEYS, PEER_KEY_DIM), PEER_KEY_DIM ** -0.5),
        "peer_u": nrm(ks[14], (DEPTH, PEER_N_EXPERTS, D_MODEL), D_MODEL ** -0.5),
        "peer_v": nrm(ks[15], (DEPTH, PEER_N_EXPERTS, D_MODEL), (PEER_HEADS * PEER_TOPK) ** -0.5),
        "final_gain": 1.0 + nrm(ks[16], (D_MODEL,), 0.05),
    }


def reference(x, positions, norm1_gain, w_in, hgrn_lb_logits, hgrn_norm_gain,
              gmlp_norm_gain, gmlp_w_s, gmlp_b_s, w_branch, w_out, norm2_gain,
              peer_w_q, peer_sub_keys, peer_u, peer_v, final_gain):
    B, S, _ = x.shape
    split_at = np.cumsum(IN_SIZES)[:-1].tolist()
    p = jax.nn.softmax(hgrn_lb_logits.astype(jnp.float32), axis=0)
    c = jnp.cumsum(p, axis=0)
    lb_all = c - c[0:1]
    for l in range(DEPTH):
        h = rmsnorm(x, norm1_gain[l])
        proj = h @ w_in[l]
        (aq, af, ai, ag, bu, bv, cq, ck, cv, iq, ik, iw, gl) = jnp.split(proj, split_at, axis=-1)
        y_a = hgrn2_mixer(aq, af, ai, ag, lb_all[l], hgrn_norm_gain[l])
        y_b = gmlp_mixer(bu, bv, gmlp_norm_gain[l], gmlp_w_s[l], gmlp_b_s[l])
        y_c = dsa_mixer(cq, ck, cv, iq, ik, iw, positions)
        branches = jnp.stack([y_a, y_b.astype(y_a.dtype), y_c.astype(y_a.dtype)], axis=2)
        branch_proj = jnp.einsum('bsnw,nwd->bsnd', branches, w_branch[l])
        gates = jax.nn.sigmoid(gl.reshape(B, S, N_BRANCH, D_MODEL))
        x = x + jnp.sum(gates * branch_proj, axis=2) @ w_out[l]
        x = x + peer_ffn(rmsnorm(x, norm2_gain[l]), peer_w_q[l], peer_sub_keys[l], peer_u[l], peer_v[l])
    return rmsnorm(x, final_gain)
```

```cpp
#include <hip/hip_runtime.h>
#include <cstdio>
#include <cstdint>

#define LAS __attribute__((address_space(3)))
typedef unsigned short bf16_t;
typedef short bf16x8 __attribute__((ext_vector_type(8)));
typedef float f32x4 __attribute__((ext_vector_type(4)));
typedef unsigned u32x4 __attribute__((ext_vector_type(4)));

constexpr int D = 1024, BATCH = 2, SEQ = 8192, DEPTH = 4, M = BATCH * SEQ;
constexpr int NIN = 8264;
constexpr int NPAD = 8448;
constexpr int C_AQ = 0, C_AF = 512, C_AI = 1024, C_AG = 1536, C_BU = 2048, C_BV = 2560, C_CQ = 3072, C_CK = 3584, C_CV = 4096, C_QI = 4608, C_GL = 5120, C_KI = 8192, C_WI = 8256;
constexpr int NMAIN = 8192;
constexpr int S_GL = 5192;
constexpr int PFW = 768;
constexpr float EPS = 1e-6f;
constexpr int NEXP = 16384;

constexpr size_t MiB = 1u << 20;
constexpr size_t WS_CTL = 0, CTL_BYTES = 1 * MiB;
constexpr size_t WS_WIN = 2 * MiB;
constexpr size_t WIN_L = (size_t)NPAD * D * 2;
constexpr size_t WS_WBR = 68 * MiB;
constexpr size_t WBR_L = (size_t)3072 * 512 * 2;
constexpr size_t WS_WOUT = 80 * MiB;
constexpr size_t WOUT_L = (size_t)1024 * 3072 * 2;
constexpr size_t WS_WPQ = 104 * MiB;
constexpr size_t WPQ_L = (size_t)2048 * 1024 * 2;
constexpr size_t WS_LB = 120 * MiB;
constexpr size_t WS_CS = 121 * MiB;
constexpr size_t WS_H16 = 134 * MiB;
constexpr size_t WS_P16 = 166 * MiB;
constexpr size_t WS_PF = 430 * MiB;
constexpr size_t WS_QR = 478 * MiB, WS_KR = 494 * MiB;
constexpr size_t WS_QI = 510 * MiB;
constexpr size_t WS_KI = 542 * MiB;
constexpr size_t WS_WI = 546 * MiB;
constexpr size_t WS_FF = 548 * MiB, WS_KK = 580 * MiB, WS_QF = 612 * MiB;
constexpr size_t WS_OA = 644 * MiB;
constexpr size_t WS_VN = 676 * MiB;
constexpr size_t WS_YALL = 708 * MiB;
constexpr size_t WS_GB = 756 * MiB;
constexpr size_t WS_EID = 852 * MiB, WS_EG = 860 * MiB;
constexpr size_t WS_DD = 120 * MiB + 256 * 1024;
constexpr size_t WS_WSB = 544 * MiB;
constexpr size_t WS_VT = 644 * MiB;
constexpr size_t WS_MASK = 660 * MiB;
constexpr size_t WS_U16 = 868 * MiB, WS_V16 = 900 * MiB;
constexpr size_t WS_SKB = 932 * MiB;
constexpr size_t WS_END = 934 * MiB;

__device__ const float ROPE_INV64[64] = {
1.000000000e+00f, 8.659643531e-01f, 7.498942614e-01f, 6.493816376e-01f, 5.623413324e-01f, 4.869675338e-01f, 4.216965139e-01f, 3.651741147e-01f, 3.162277639e-01f, 2.738419771e-01f, 2.371373773e-01f, 2.053525001e-01f, 1.778279394e-01f, 1.539926529e-01f, 1.333521307e-01f, 1.154782027e-01f, 1.000000015e-01f, 8.659642935e-02f, 7.498941571e-02f, 6.493816525e-02f, 5.623413250e-02f, 4.869675264e-02f, 4.216965288e-02f, 3.651741147e-02f, 3.162277490e-02f, 2.738419734e-02f, 2.371373773e-02f, 2.053525113e-02f, 1.778279431e-02f, 1.539926510e-02f, 1.333521493e-02f, 1.154782064e-02f, 9.999999776e-03f, 8.659643121e-03f, 7.498941850e-03f, 6.493816152e-03f, 5.623413250e-03f, 4.869675264e-03f, 4.216964822e-03f, 3.651741194e-03f, 3.162277630e-03f, 2.738419687e-03f, 2.371373586e-03f, 2.053524833e-03f, 1.778279431e-03f, 1.539926510e-03f, 1.333521446e-03f, 1.154781901e-03f, 1.000000047e-03f, 8.659643354e-04f, 7.498942432e-04f, 6.493816618e-04f, 5.623413017e-04f, 4.869675322e-04f, 4.216965172e-04f, 3.651741426e-04f, 3.162277571e-04f, 2.738419571e-04f, 2.371373703e-04f, 2.053525095e-04f, 1.778279402e-04f, 1.539926452e-04f, 1.333521504e-04f, 1.154782003e-04f};
__device__ const float ROPE_INV32[32] = {
1.000000000e+00f, 7.498942614e-01f, 5.623413324e-01f, 4.216965139e-01f, 3.162277639e-01f, 2.371373773e-01f, 1.778279394e-01f, 1.333521307e-01f, 1.000000015e-01f, 7.498941571e-02f, 5.623413250e-02f, 4.216965288e-02f, 3.162277490e-02f, 2.371373773e-02f, 1.778279431e-02f, 1.333521493e-02f, 9.999999776e-03f, 7.498941850e-03f, 5.623413250e-03f, 4.216964822e-03f, 3.162277630e-03f, 2.371373586e-03f, 1.778279431e-03f, 1.333521446e-03f, 1.000000047e-03f, 7.498942432e-04f, 5.623413017e-04f, 4.216965172e-04f, 3.162277571e-04f, 2.371373703e-04f, 1.778279402e-04f, 1.333521504e-04f};

__device__ __forceinline__ float bf2f(bf16_t b) { return __uint_as_float(((unsigned)b) << 16); }
__device__ __forceinline__ unsigned f2bf(float f) { unsigned u = __float_as_uint(f); return (u + 0x7fffu + ((u >> 16) & 1u)) >> 16; }
__device__ __forceinline__ unsigned pk2(float lo, float hi) { return f2bf(lo) | (f2bf(hi) << 16); }
__device__ __forceinline__ float lo_bf(unsigned w) { return __uint_as_float(w << 16); }
__device__ __forceinline__ float hi_bf(unsigned w) { return __uint_as_float(w & 0xffff0000u); }
__device__ __forceinline__ float sigm(float x) { return 1.f / (1.f + __expf(-x)); }
__device__ __forceinline__ float silu(float x) { return x * sigm(x); }
__device__ __forceinline__ float gelu_t(float x) { const float u = 0.7978845608028654f * (x + 0.044715f * x * x * x); const float th = 1.f - 2.f / (1.f + __expf(2.f * u)); return 0.5f * x * (1.f + th); }
__device__ __forceinline__ float wave_sum(float v) {
#pragma unroll
    for (int o = 1; o < 64; o <<= 1) v += __shfl_xor(v, o);
    return v;
}
__device__ __forceinline__ float wave_max(float v) {
#pragma unroll
    for (int o = 1; o < 64; o <<= 1) v = fmaxf(v, __shfl_xor(v, o));
    return v;
}
typedef __bf16 bf2_t __attribute__((ext_vector_type(2)));
__device__ __forceinline__ float dot2(unsigned a, unsigned b, float c) { return __builtin_amdgcn_fdot2_f32_bf16(__builtin_bit_cast(bf2_t, a), __builtin_bit_cast(bf2_t, b), c, false); }
__device__ __forceinline__ int otid(int wv) { int t; asm volatile("v_mbcnt_lo_u32_b32 %0, -1, 0\n\tv_mbcnt_hi_u32_b32 %0, -1, %0" : "=v"(t)); return wv * 64 + t; }
__device__ __forceinline__ unsigned char* oport(unsigned char* p) { unsigned long long z; asm volatile("s_mov_b64 %0, 0" : "=s"(z)); return p + z; }
__device__ __forceinline__ unsigned fkey(float f) { const unsigned u = __float_as_uint(f); return u ^ ((u >> 31) ? 0xFFFFFFFFu : 0x80000000u); }

#define XB_TMO      128
#define XB_XCNT(j)  (256  + 64 * (j))
#define XB_XSUB(j)  (1280 + 64 * (j))
#define XB_XGEN(j)  (2304 + 64 * (j))
#define XB_TOP      3328
#define XB_TOPGEN   3392
#define XCD_BAR_WORDS 3456
#define XB_SPIN_CAP (1u << 23)
__device__ __forceinline__ unsigned xb_ld(unsigned* p)              { return __hip_atomic_load(p, __ATOMIC_RELAXED, __HIP_MEMORY_SCOPE_AGENT); }
__device__ __forceinline__ unsigned xb_add(unsigned* p, unsigned v) { return __hip_atomic_fetch_add(p, v, __ATOMIC_RELAXED, __HIP_MEMORY_SCOPE_AGENT); }
__device__ __forceinline__ unsigned xb_xcc_id() { return (unsigned)__builtin_amdgcn_s_getreg((3 << 11) | 20) & 0xFu; }
#define XB_SPIN(cond, bar) do { unsigned _sp = 0; while (cond) { __builtin_amdgcn_s_sleep(1); \
    if ((++_sp & 255u) == 0u) { if (xb_ld(&(bar)[XB_TMO])) break; if (_sp > XB_SPIN_CAP) { atomicAdd(&(bar)[XB_TMO], 1u); break; } } } } while (0)
struct XcdBarrier { unsigned* bar; unsigned x; volatile LAS unsigned* st; };
__device__ __forceinline__ XcdBarrier xcd_barrier_post(unsigned* bar, volatile LAS unsigned* st, int wv) {
    XcdBarrier b; b.bar = bar; b.x = xb_xcc_id(); b.st = st;
    if (otid(wv) == 0) (void)xb_add(&bar[XB_XCNT(b.x)], 1u);
    return b;
}
__device__ __forceinline__ void xcd_barrier_complete(unsigned* bar, unsigned x, unsigned& nloc, unsigned& nx) {
    const unsigned G = gridDim.x * gridDim.y * gridDim.z;
    unsigned sum, cnt, mine, sp = 0u;
    for (;;) {
        sum = 0u; cnt = 0u; mine = 0u;
#pragma unroll
        for (unsigned j = 0; j < 16; ++j) { const unsigned c = xb_ld(&bar[XB_XCNT(j)]); sum += c; cnt += (c > 0u) ? 1u : 0u; mine = (j == x) ? c : mine; }
        if (sum == G) break;
        __builtin_amdgcn_s_sleep(1);
        if ((++sp & 255u) == 0u) { if (xb_ld(&bar[XB_TMO])) break; if (sp > XB_SPIN_CAP) { atomicAdd(&bar[XB_TMO], 1u); break; } }
    }
    nloc = mine > 0u ? mine : 1u; nx = cnt > 0u ? cnt : 1u;
}
__device__ __forceinline__ void xcd_barrier(const XcdBarrier& b, int wv) {
    asm volatile("s_waitcnt vmcnt(0)" ::: "memory");
    __syncthreads();
    if (otid(wv) == 0) {
        unsigned* bar = b.bar;
        __builtin_amdgcn_s_waitcnt(0);
        unsigned nloc = b.st[0], nx = b.st[1];
        if (nloc == 0u) { xcd_barrier_complete(bar, b.x, nloc, nx); b.st[0] = nloc; b.st[1] = nx; }
        const unsigned old = xb_add(&bar[XB_XSUB(b.x)], 1u);
        const unsigned gen = old / nloc;
        if (old + 1u == (gen + 1u) * nloc) {
            __builtin_amdgcn_fence(__ATOMIC_RELEASE, "agent");
            asm volatile("s_waitcnt vmcnt(0)" ::: "memory");
            const unsigned og = xb_add(&bar[XB_TOP], 1u);
            const unsigned tg = og / nx;
            if (og + 1u == (tg + 1u) * nx) xb_add(&bar[XB_TOPGEN], 1u);
            else XB_SPIN(xb_ld(&bar[XB_TOPGEN]) == tg, bar);
            __builtin_amdgcn_fence(__ATOMIC_ACQUIRE, "agent");
            xb_add(&bar[XB_XGEN(b.x)], 1u);
            asm volatile("s_waitcnt vmcnt(0)" ::: "memory");
        } else {
            XB_SPIN(xb_ld(&bar[XB_XGEN(b.x)]) == gen, bar);
            __builtin_amdgcn_fence(__ATOMIC_ACQUIRE, "agent");
            asm volatile("s_waitcnt vmcnt(0)" ::: "memory");
        }
    }
    __syncthreads();
}

namespace pg8 {
constexpr int BM = 256, BK = 64, HALF = 128, HTB = HALF * BK * 2, STAGE_BYTES = 8 * HTB, NXCD = 8, WGM = 8;
__host__ __device__ __forceinline__ int lds_byte(int r, int c) { const int st = (r >> 4) * 2 + (c >> 5), rr = r & 15, cc = c & 31, ob = rr * 64 + cc * 2; return st * 1024 + (ob ^ (((ob >> 9) & 1) << 5)); }
__host__ __device__ __forceinline__ void stage_rc(int b, int& R, int& C) { const int st = b / 1024, sb = b % 1024, swz = sb ^ (((sb >> 9) & 1) << 5); R = (st >> 1) * 16 + swz / 64; C = (st & 1) * 32 + (swz % 64) / 2; }
__host__ __device__ __forceinline__ int perm32(int rho) { const int n = rho >> 4, i = rho & 15; return 8 * (i >> 2) + 4 * n + (i & 3); }
struct Unit { int pm, pn, ka; };
struct Gemm { const bf16_t* A; const bf16_t* Bt; int M, N, K; size_t strideA; int nsplit; };
struct StaticOrder {
    int nM, nN, nwg, G, c, nsplit;
    __device__ __forceinline__ void init(int M_, int N_, int G_, int c_, int nsplit_) { nM = M_ / BM; nN = N_ / BM; nwg = nM * nN; G = G_; c = c_; nsplit = nsplit_; }
    __device__ __forceinline__ bool next(int i, Unit& u) const {
        const long L = (long)i * G + c; if (L >= nwg) return false;
        int wgid = (int)L; { const int q = nwg / NXCD, r = nwg % NXCD, xcd = wgid % NXCD, off = wgid / NXCD; wgid = (xcd < r ? xcd * (q + 1) : r * (q + 1) + (xcd - r) * q) + off; }
        const int nig = WGM * nN, gid = wgid / nig, fm = gid * WGM, gsz = (nM - fm) < WGM ? (nM - fm) : WGM;
        u.pm = fm + ((wgid % nig) % gsz); u.pn = (wgid % nig) / gsz; u.ka = nsplit ? u.pn / nsplit : 0; return true;
    }
};
__device__ __forceinline__ unsigned cvt_pk_bf16(float lo, float hi) { unsigned r; asm volatile("v_cvt_pk_bf16_f32 %0, %1, %2" : "=v"(r) : "v"(lo), "v"(hi)); return r; }

template <class Epi, class Sched>
__device__ __forceinline__ void gemm_phase(LAS unsigned char* lds, const Gemm g, const Sched& S, const Epi& E, int wv) {
    const int tid = otid(wv), wid = __builtin_amdgcn_readfirstlane(tid >> 6), lane = tid & 63, wr = wid >> 2, wc = wid & 3, fr = lane & 15, fq = lane >> 4;
    const int K = g.K, nt = K / BK;
    unsigned voffA[2], voffB[2];
#pragma unroll
    for (int i = 0; i < 2; ++i) { int R, C; stage_rc(tid * 16 + i * 8192, R, C); const int Rb = Epi::PERM ? ((R & ~31) + perm32(R & 31)) : R;
        voffA[i] = (unsigned)(R * K + C) * 2u; voffB[i] = (unsigned)(Rb * K + C) * 2u; }
    const size_t kstep = (size_t)(BK * 2);
    const size_t hstep = (size_t)HALF * K * 2;
    const size_t tstep = 2 * hstep;
    const unsigned ldsw = (unsigned)wid * 1024u;
    const int aoff = lds_byte(wr * 64 + fr, fq * 8), boff = lds_byte(wc * 32 + fr, fq * 8);
#define PG8_SA(b, h) (((b) * 2 + (h)) * HTB)
#define PG8_SB(b, h) ((4 + (b) * 2 + (h)) * HTB)
#define PG8_STAGE(bufoff, gbase, voff) do { _Pragma("unroll") for (int _i = 0; _i < 2; ++_i) \
        __builtin_amdgcn_global_load_lds((const unsigned*)((const char*)(gbase) + (voff)[_i]), (LAS unsigned*)(lds + (bufoff) + ldsw + _i * 8192), 16, 0, 0); } while (0)
#define PG8_LDA(dst, b, h) do { _Pragma("unroll") for (int m = 0; m < 4; ++m) _Pragma("unroll") for (int k = 0; k < 2; ++k) dst[m][k] = *(const LAS bf16x8*)(lds + PG8_SA(b, h) + aoff + m * 2048 + k * 1024); } while (0)
#define PG8_LDB(dst, b, h) do { _Pragma("unroll") for (int n = 0; n < 2; ++n) _Pragma("unroll") for (int k = 0; k < 2; ++k) dst[n][k] = *(const LAS bf16x8*)(lds + PG8_SB(b, h) + boff + n * 2048 + k * 1024); } while (0)
#define PG8_MMA(ai, bj, At, Bt) do { __builtin_amdgcn_s_setprio(1); _Pragma("unroll") for (int m = 0; m < 4; ++m) _Pragma("unroll") for (int n = 0; n < 2; ++n) _Pragma("unroll") for (int k = 0; k < 2; ++k) \
        acc[ai][bj][m][n] = __builtin_amdgcn_mfma_f32_16x16x32_bf16(Bt[n][k], At[m][k], acc[ai][bj][m][n], 0, 0, 0); __builtin_amdgcn_s_setprio(0); } while (0)
#define PG8_WAIT_V(n) asm volatile("s_waitcnt vmcnt(" #n ")" ::: "memory")
#define PG8_WAIT_L(n) asm volatile("s_waitcnt lgkmcnt(" #n ")" ::: "memory")
#define PG8_BAR __builtin_amdgcn_s_barrier()
#define PG8_SCHED __builtin_amdgcn_sched_barrier(0)
    Unit cur, nxt; int ui = 0;
    if (!S.next(0, cur)) return;
    f32x4 acc[2][2][4][2];
#pragma unroll
    for (int a = 0; a < 2; ++a)
#pragma unroll
        for (int b = 0; b < 2; ++b)
#pragma unroll
            for (int m = 0; m < 4; ++m)
#pragma unroll
                for (int n = 0; n < 2; ++n) acc[a][b][m][n] = (f32x4){0.f, 0.f, 0.f, 0.f};
    bf16x8 At[4][2], B0[2][2], B1[2][2];
    const char* cA = (const char*)g.A + (size_t)cur.ka * g.strideA + (size_t)cur.pm * tstep; const char* cB = (const char*)g.Bt + (size_t)cur.pn * tstep;
    PG8_STAGE(PG8_SB(0, 0), cB, voffB); PG8_STAGE(PG8_SA(0, 0), cA, voffA); PG8_STAGE(PG8_SB(0, 1), cB + hstep, voffB); PG8_STAGE(PG8_SA(0, 1), cA + hstep, voffA);
    if (wr == 1) PG8_BAR;
    PG8_WAIT_V(4); PG8_BAR;
    PG8_STAGE(PG8_SB(1, 0), cB + kstep, voffB); PG8_STAGE(PG8_SA(1, 0), cA + kstep, voffA); PG8_STAGE(PG8_SB(1, 1), cB + hstep + kstep, voffB);
    PG8_WAIT_V(6); PG8_BAR;
    for (;;) {
        const bool has_next = S.next(ui + 1, nxt);
        const char* nA = has_next ? (const char*)g.A + (size_t)nxt.ka * g.strideA + (size_t)nxt.pm * tstep : cA; const char* nB = has_next ? (const char*)g.Bt + (size_t)nxt.pn * tstep : cB;
        for (int t = 0; t < nt; t += 2) {
            const bool last = (t == nt - 2);
            const char* a1 = cA + (size_t)(t + 1) * kstep;
            const char* a2 = last ? nA : cA + (size_t)(t + 2) * kstep; const char* b2 = last ? nB : cB + (size_t)(t + 2) * kstep;
            const char* a3 = a2 + kstep; const char* b3 = b2 + kstep;
            PG8_LDB(B0, 0, 0); PG8_SCHED; PG8_LDA(At, 0, 0); PG8_STAGE(PG8_SA(1, 1), a1 + hstep, voffA);
            PG8_WAIT_L(8); PG8_BAR; PG8_WAIT_L(0); PG8_MMA(0, 0, At, B0); PG8_BAR; PG8_SCHED;
            PG8_LDB(B1, 0, 1); PG8_STAGE(PG8_SB(0, 0), b2, voffB);
            PG8_BAR; PG8_WAIT_L(0); PG8_MMA(0, 1, At, B1); PG8_BAR;
            PG8_LDA(At, 0, 1); PG8_STAGE(PG8_SA(0, 0), a2, voffA);
            PG8_BAR; PG8_WAIT_L(0); PG8_MMA(1, 0, At, B0); PG8_BAR; PG8_SCHED;
            PG8_STAGE(PG8_SB(0, 1), b2 + hstep, voffB);
            PG8_WAIT_V(6); PG8_BAR; PG8_MMA(1, 1, At, B1); PG8_BAR;
            PG8_LDB(B0, 1, 0); PG8_SCHED; PG8_LDA(At, 1, 0); PG8_STAGE(PG8_SA(0, 1), a2 + hstep, voffA);
            PG8_WAIT_L(8); PG8_BAR; PG8_WAIT_L(0); PG8_MMA(0, 0, At, B0); PG8_BAR; PG8_SCHED;
            PG8_LDB(B1, 1, 1); PG8_STAGE(PG8_SB(1, 0), b3, voffB);
            PG8_BAR; PG8_WAIT_L(0); PG8_MMA(0, 1, At, B1); PG8_BAR;
            PG8_LDA(At, 1, 1); PG8_STAGE(PG8_SA(1, 0), a3, voffA);
            PG8_BAR; PG8_WAIT_L(0); PG8_MMA(1, 0, At, B0); PG8_BAR; PG8_SCHED;
            PG8_STAGE(PG8_SB(1, 1), b3 + hstep, voffB);
            PG8_WAIT_V(6); PG8_BAR; PG8_MMA(1, 1, At, B1); PG8_BAR;
        }
        E(acc, cur, wr, wc, fr, fq);
        if (!has_next) break;
        if (!E.keep(cur))
#pragma unroll
        for (int a = 0; a < 2; ++a)
#pragma unroll
            for (int b = 0; b < 2; ++b)
#pragma unroll
                for (int m = 0; m < 4; ++m)
#pragma unroll
                    for (int n = 0; n < 2; ++n) acc[a][b][m][n] = (f32x4){0.f, 0.f, 0.f, 0.f};
        cur = nxt; cA = nA; cB = nB; ++ui;
    }
    PG8_WAIT_V(0);
    if (wr == 0) PG8_BAR;
    PG8_BAR;
#undef PG8_SA
#undef PG8_SB
#undef PG8_STAGE
#undef PG8_LDA
#undef PG8_LDB
#undef PG8_MMA
#undef PG8_WAIT_V
#undef PG8_WAIT_L
#undef PG8_BAR
#undef PG8_SCHED
}

struct EpiIn {
    __device__ __forceinline__ bool keep(const Unit&) const { return false; }
    static constexpr bool PERM = true;
    bf16_t* P16; float* PF;
    __device__ __forceinline__ void operator()(f32x4 (&acc)[2][2][4][2], const Unit& u, int wr, int wc, int fr, int fq) const {
        const int row0 = u.pm * BM + wr * 64 + fr, col0 = u.pn * BM + wc * 32 + 8 * fq;
        const bool f32t = (u.pn == 2) || (u.pn == 3);
        const int pfc0 = (u.pn - 2) * 256 + wc * 32 + 8 * fq;
#pragma unroll
        for (int ai = 0; ai < 2; ++ai)
#pragma unroll
            for (int m = 0; m < 4; ++m) { const size_t row = (size_t)(row0 + ai * HALF + m * 16);
#pragma unroll
                for (int bj = 0; bj < 2; ++bj) { const f32x4 v0 = acc[ai][bj][m][0], v1 = acc[ai][bj][m][1];
                    u32x4 w; w.x = cvt_pk_bf16(v0[0], v0[1]); w.y = cvt_pk_bf16(v0[2], v0[3]); w.z = cvt_pk_bf16(v1[0], v1[1]); w.w = cvt_pk_bf16(v1[2], v1[3]);
                    *(u32x4*)(P16 + row * NPAD + col0 + bj * HALF) = w;
                    if (f32t) { float* pf = PF + row * PFW + pfc0 + bj * HALF; *(f32x4*)pf = v0; *(f32x4*)(pf + 4) = v1; } } }
    }
};
struct EpiGate {
    static constexpr bool PERM = true;
    bf16_t* GS; const bf16_t* P16;
    __device__ __forceinline__ bool keep(const Unit& u) const { return (u.pn >> 2) < 2; }
    __device__ __forceinline__ void operator()(f32x4 (&acc)[2][2][4][2], const Unit& u, int wr, int wc, int fr, int fq) const {
        const int n = u.pn >> 2, row0 = u.pm * BM + wr * 64 + fr, col0 = (u.pn & 3) * BM + wc * 32 + 8 * fq;
#pragma unroll
        for (int ai = 0; ai < 2; ++ai)
#pragma unroll
            for (int m = 0; m < 4; ++m) { const size_t row = (size_t)(row0 + ai * HALF + m * 16);
#pragma unroll
                for (int bj = 0; bj < 2; ++bj) { f32x4& v0 = acc[ai][bj][m][0]; f32x4& v1 = acc[ai][bj][m][1];
                    const u32x4 gw = *(const u32x4*)(P16 + row * NPAD + C_GL + n * 1024 + col0 + bj * HALF);
                    const float e[8] = {__expf(-lo_bf(gw.x)), __expf(-hi_bf(gw.x)), __expf(-lo_bf(gw.y)), __expf(-hi_bf(gw.y)), __expf(-lo_bf(gw.z)), __expf(-hi_bf(gw.z)), __expf(-lo_bf(gw.w)), __expf(-hi_bf(gw.w))};
                    if (n < 2) { const u32x4 hw = *(const u32x4*)(P16 + row * NPAD + C_GL + (n + 1) * 1024 + col0 + bj * HALF);
                        const float f[8] = {__expf(-lo_bf(hw.x)), __expf(-hi_bf(hw.x)), __expf(-lo_bf(hw.y)), __expf(-hi_bf(hw.y)), __expf(-lo_bf(hw.z)), __expf(-hi_bf(hw.z)), __expf(-lo_bf(hw.w)), __expf(-hi_bf(hw.w))};
#pragma unroll
                        for (int j = 0; j < 4; ++j) { v0[j] *= (1.f + f[j]) / (1.f + e[j]); v1[j] *= (1.f + f[4 + j]) / (1.f + e[4 + j]); }
                    } else { u32x4 w;
                        w.x = cvt_pk_bf16(v0[0] / (1.f + e[0]), v0[1] / (1.f + e[1])); w.y = cvt_pk_bf16(v0[2] / (1.f + e[2]), v0[3] / (1.f + e[3]));
                        w.z = cvt_pk_bf16(v1[0] / (1.f + e[4]), v1[1] / (1.f + e[5])); w.w = cvt_pk_bf16(v1[2] / (1.f + e[6]), v1[3] / (1.f + e[7]));
                        *(u32x4*)(GS + row * D + col0 + bj * HALF) = w; } } }
    }
};
struct BranchOrder {
    StaticOrder so; int G;
    __device__ __forceinline__ void init(int G_, int c_) { so.init(M, 1024, G_, c_, 0); G = G_; }
    __device__ __forceinline__ bool next(int i, Unit& u) const { Unit t; if (!so.next(i / 3, t)) return false; const int n = i % 3; u.pm = t.pm; u.pn = n * 4 + t.pn; u.ka = n; return true; }
};
struct EpiRes {
    __device__ __forceinline__ bool keep(const Unit&) const { return false; }
    static constexpr bool PERM = false;
    float* X;
    __device__ __forceinline__ void operator()(f32x4 (&acc)[2][2][4][2], const Unit& u, int wr, int wc, int fr, int fq) const {
        const int row0 = u.pm * BM + wr * 64 + fr, col0 = u.pn * BM + wc * 32 + 4 * fq;
#pragma unroll
        for (int ai = 0; ai < 2; ++ai)
#pragma unroll
            for (int m = 0; m < 4; ++m) { float* rowp = X + (size_t)(row0 + ai * HALF + m * 16) * D + col0;
#pragma unroll
                for (int bj = 0; bj < 2; ++bj)
#pragma unroll
                    for (int n = 0; n < 2; ++n) { f32x4* p = (f32x4*)(rowp + bj * HALF + n * 16); *p = *p + acc[ai][bj][m][n]; } }
    }
};
struct EpiB16 {
    __device__ __forceinline__ bool keep(const Unit&) const { return false; }
    static constexpr bool PERM = true;
    bf16_t* O; int ldc;
    __device__ __forceinline__ void operator()(f32x4 (&acc)[2][2][4][2], const Unit& u, int wr, int wc, int fr, int fq) const {
        const int row0 = u.pm * BM + wr * 64 + fr, col0 = u.pn * BM + wc * 32 + 8 * fq;
#pragma unroll
        for (int ai = 0; ai < 2; ++ai)
#pragma unroll
            for (int m = 0; m < 4; ++m) { bf16_t* rowp = O + (size_t)(row0 + ai * HALF + m * 16) * ldc + col0;
#pragma unroll
                for (int bj = 0; bj < 2; ++bj) { const f32x4 v0 = acc[ai][bj][m][0], v1 = acc[ai][bj][m][1];
                    u32x4 w; w.x = cvt_pk_bf16(v0[0], v0[1]); w.y = cvt_pk_bf16(v0[2], v0[3]); w.z = cvt_pk_bf16(v1[0], v1[1]); w.w = cvt_pk_bf16(v1[2], v1[3]);
                    *(u32x4*)(rowp + bj * HALF) = w; } }
    }
};
}

struct Args {
    const float* x; const int* pos; const float* norm1; const float* w_in; const float* lb_logits; const float* hgrn_gain; const float* gmlp_gain; const float* gmlp_ws; const float* gmlp_bs;
    const float* w_branch; const float* w_out; const float* norm2; const float* peer_wq; const float* peer_keys; const float* peer_u; const float* peer_v; const float* final_gain;
    float* out; unsigned char* ws; int ph_lo, ph_hi;
};
constexpr int NTHR = 512, NWAVE = 8;
constexpr int LDS_BYTES = 147456;
constexpr int LDS_CTL_OFF = 143360;

__device__ __forceinline__ void tr_item(const float* src, int ldsrc, int c0, int nvalid, bf16_t* dst, int ldd, int r0, int koff, float* scr, int item, int nblk, int lane) {
    const int kb = item / nblk, nb = item % nblk, k0 = 64 * kb, n0 = 32 * nb;
    const int nn = n0 + (lane & 31);
#pragma unroll 8
    for (int i = 0; i < 32; ++i) { const int kk = 2 * i + (lane >> 5); scr[kk * 33 + (lane & 31)] = (nn < nvalid) ? src[(size_t)(k0 + kk) * ldsrc + c0 + nn] : 0.f; }
    asm volatile("s_waitcnt lgkmcnt(0)" ::: "memory");
    const int c = lane & 7;
#pragma unroll
    for (int j = 0; j < 4; ++j) { const int n = (lane >> 3) + 8 * j; const float* s = scr + (8 * c) * 33 + n;
        u32x4 o; o.x = pk2(s[0 * 33], s[1 * 33]); o.y = pk2(s[2 * 33], s[3 * 33]); o.z = pk2(s[4 * 33], s[5 * 33]); o.w = pk2(s[6 * 33], s[7 * 33]);
        *(u32x4*)(dst + (size_t)(r0 + n0 + n) * ldd + koff + k0 + 8 * c) = o; }
    asm volatile("s_waitcnt lgkmcnt(0)" ::: "memory");
}
__device__ __forceinline__ void rms_row_to_bf16(const float* xrow, const float* gain, bf16_t* orow, int lane) {
    const f32x4* xr = (const f32x4*)xrow + lane; const f32x4* gr = (const f32x4*)gain + lane;
    f32x4 v[4]; float s = 0.f;
#pragma unroll
    for (int j = 0; j < 4; ++j) { v[j] = xr[64 * j]; s += (v[j].x * v[j].x + v[j].y * v[j].y) + (v[j].z * v[j].z + v[j].w * v[j].w); }
    const float r = rsqrtf(wave_sum(s) * (1.f / D) + EPS);
    unsigned long long* o8 = (unsigned long long*)orow + lane;
#pragma unroll
    for (int j = 0; j < 4; ++j) { const f32x4 g = gr[64 * j]; o8[64 * j] = (unsigned long long)pk2(v[j].x * r * g.x, v[j].y * r * g.y) | ((unsigned long long)pk2(v[j].z * r * g.z, v[j].w * r * g.w) << 32); }
}

__device__ __forceinline__ void ph_prologue(const Args& a, unsigned char* lds, int wv) {
    const int tid = otid(wv), lane = tid & 63, wave = tid >> 6;
    const int gw = blockIdx.x * NWAVE + wave, ngw = gridDim.x * NWAVE;
    const size_t gtid = (size_t)blockIdx.x * NTHR + tid, gsz = (size_t)gridDim.x * NTHR;
    unsigned char* ws = oport(a.ws);
    { const f32x4* s = (const f32x4*)a.x; f32x4* d = (f32x4*)a.out; for (size_t i = gtid; i < (size_t)M * D / 4; i += gsz) d[i] = s[i]; }
    float* scr = (float*)(lds + wave * 16384);
    constexpr int I_IN1 = 16 * 160, I_IN2 = 16 * 8, I_IN3 = 16 * 96, I_IN = I_IN1 + I_IN2 + I_IN3;
    constexpr int I_BR = 3 * 8 * 32, I_OUT = 16 * 32, I_PQ = 16 * 64, I_L = I_IN + I_BR + I_OUT + I_PQ;
    for (int it = gw; it < DEPTH * I_L; it += ngw) {
        const int l = it / I_L; int r = it % I_L;
        bf16_t* win = (bf16_t*)(ws + WS_WIN + (size_t)l * WIN_L); const float* src_in = a.w_in + (size_t)l * D * NIN;
        if (r < I_IN1) { tr_item(src_in, NIN, 0, 5120, win, D, 0, 0, scr, r, 160, lane); continue; } r -= I_IN1;
        if (r < I_IN2) { tr_item(src_in, NIN, 5120, 72, win, D, C_KI, 0, scr, r, 8, lane); continue; } r -= I_IN2;
        if (r < I_IN3) { tr_item(src_in, NIN, S_GL, 3072, win, D, C_GL, 0, scr, r, 96, lane); continue; } r -= I_IN3;
        if (r < I_BR) { const int n = r / 256; tr_item(a.w_branch + ((size_t)l * 3 + n) * 512 * D, D, 0, 1024, (bf16_t*)(ws + WS_WBR + (size_t)l * WBR_L), 512, n * 1024, 0, scr, r % 256, 32, lane); continue; } r -= I_BR;
        if (r < I_OUT) { tr_item(a.w_out + (size_t)l * D * D, D, 0, 1024, (bf16_t*)(ws + WS_WOUT + (size_t)l * WOUT_L), D, 0, 0, scr, r, 32, lane); continue; } r -= I_OUT;
        tr_item(a.peer_wq + (size_t)l * D * 2048, 2048, 0, 2048, (bf16_t*)(ws + WS_WPQ + (size_t)l * WPQ_L), D, 0, 0, scr, r, 64, lane);
    }
    if (gtid < 512) { float v[DEPTH], mx = -1e30f; for (int l = 0; l < DEPTH; ++l) { v[l] = a.lb_logits[l * 512 + gtid]; mx = fmaxf(mx, v[l]); }
        float s = 0.f; for (int l = 0; l < DEPTH; ++l) { v[l] = __expf(v[l] - mx); s += v[l]; }
        float c = 0.f; float* lb = (float*)(ws + WS_LB); for (int l = 0; l < DEPTH; ++l) { if (l > 0) c += v[l] / s; lb[l * 512 + gtid] = c; } }
    { u32x4* SKB = (u32x4*)(ws + WS_SKB); const f32x4* sk = (const f32x4*)a.peer_keys; for (size_t i = gtid; i < (size_t)DEPTH * 16 * 128 * 128 / 8; i += gsz) { const f32x4 k0 = sk[2 * i], k1 = sk[2 * i + 1]; SKB[i] = (u32x4){pk2(k0.x, k0.y), pk2(k0.z, k0.w), pk2(k1.x, k1.y), pk2(k1.z, k1.w)}; } }
    { bf16_t* WSB = (bf16_t*)(ws + WS_WSB); for (size_t i = gtid; i < (size_t)DEPTH * 4 * 128 * 128; i += gsz) { const int t = (int)((i >> 7) & 127), sx = (int)(i & 127); WSB[i] = (bf16_t)f2bf(sx <= t ? a.gmlp_ws[i] : 0.f); } }
    { float2* cs = (float2*)(ws + WS_CS);
      for (size_t i = gtid; i < (size_t)M * 96; i += gsz) { const int m = (int)(i / 96), j = (int)(i % 96);
          const float inv = j < 64 ? ROPE_INV64[j] : ROPE_INV32[j - 64]; const float angf = (float)a.pos[m] * inv;
          const double ang = (double)angf; const double k = rint(ang * 0.15915494309189535); const float r = (float)(ang - k * 6.283185307179586);
          cs[i] = make_float2(__cosf(r), __sinf(r)); } }
    for (int m = gw; m < M; m += ngw) rms_row_to_bf16(a.x + (size_t)m * D, a.norm1, (bf16_t*)(ws + WS_H16) + (size_t)m * D, lane);
}

__device__ __forceinline__ void ph_kiwi(const Args& a, int l, int wv) {
    unsigned char* ws = oport(a.ws); const int tid = otid(wv), lane = tid & 63, gw = blockIdx.x * NWAVE + (tid >> 6), ngw = gridDim.x * NWAVE, fr = lane & 15, fq = lane >> 4;
    const bf16_t* H16 = (const bf16_t*)(ws + WS_H16); const bf16_t* W = (const bf16_t*)(ws + WS_WIN + (size_t)l * WIN_L) + (size_t)C_KI * D; float* PF = (float*)(ws + WS_PF);
    for (int tg = gw; tg < M / 16; tg += ngw) { f32x4 acc[5];
#pragma unroll
        for (int nt = 0; nt < 5; ++nt) acc[nt] = (f32x4){0.f, 0.f, 0.f, 0.f};
#pragma unroll 4
        for (int ks = 0; ks < 32; ++ks) { const bf16x8 y = ((const bf16x8*)(H16 + (size_t)tg * 16 * D + 32 * ks))[fr * (D / 8) + fq];
#pragma unroll
            for (int nt = 0; nt < 5; ++nt) { const bf16x8 x = ((const bf16x8*)(W + (size_t)nt * 16 * D + 32 * ks))[fr * (D / 8) + fq]; acc[nt] = __builtin_amdgcn_mfma_f32_16x16x32_bf16(x, y, acc[nt], 0, 0, 0); } }
#pragma unroll
        for (int nt = 0; nt < 5; ++nt) *(f32x4*)(PF + ((size_t)tg * 16 + fr) * PFW + 512 + 16 * nt + 4 * fq) = acc[nt]; }
}

__device__ __forceinline__ void ph_post(const Args& a, int l, unsigned char* lds, int wv) {
    const int tid = otid(wv), lane = tid & 63, wave = tid >> 6;
    const int gw = blockIdx.x * NWAVE + wave, ngw = gridDim.x * NWAVE;
    const size_t gtid = (size_t)blockIdx.x * NTHR + tid, gsz = (size_t)gridDim.x * NTHR;
    unsigned char* ws = oport(a.ws);
    const bf16_t* P16 = (const bf16_t*)(ws + WS_P16); const float* PF = (const float*)(ws + WS_PF); const float2* cs = (const float2*)(ws + WS_CS);
    { bf16_t* QR = (bf16_t*)(ws + WS_QR); bf16_t* KR = (bf16_t*)(ws + WS_KR);
      for (size_t i = gtid; i < (size_t)M * 256; i += gsz) { const int m = (int)(i >> 8), h = (int)((i >> 6) & 3), j = (int)(i & 63);
          const float2 c = cs[(size_t)m * 96 + j]; const size_t pb = (size_t)m * NPAD + h * 128 + j, ob = (size_t)m * 512 + h * 128 + j;
          const float q1 = bf2f(P16[pb + C_CQ]), q2 = bf2f(P16[pb + C_CQ + 64]), k1 = bf2f(P16[pb + C_CK]), k2 = bf2f(P16[pb + C_CK + 64]);
          const float sc = 0.08838834764831845f * 1.4426950408889634f;
          QR[ob] = (bf16_t)f2bf((q1 * c.x - q2 * c.y) * sc); QR[ob + 64] = (bf16_t)f2bf((q2 * c.x + q1 * c.y) * sc);
          KR[ob] = (bf16_t)f2bf(k1 * c.x - k2 * c.y); KR[ob + 64] = (bf16_t)f2bf(k2 * c.x + k1 * c.y); } }
    { bf16_t* QS = (bf16_t*)(ws + WS_QI); bf16_t* KIb = (bf16_t*)(ws + WS_KI); float* WP = (float*)(ws + WS_WI);
      for (int m = gw; m < M; m += ngw) { const int h = lane >> 3, jj = lane & 7;
          const unsigned long long w1 = *(const unsigned long long*)(P16 + (size_t)m * NPAD + C_QI + h * 64 + 4 * jj), w2 = *(const unsigned long long*)(P16 + (size_t)m * NPAD + C_QI + h * 64 + 32 + 4 * jj);
          const float q1[4] = {lo_bf((unsigned)w1), hi_bf((unsigned)w1), lo_bf((unsigned)(w1 >> 32)), hi_bf((unsigned)(w1 >> 32))}, q2[4] = {lo_bf((unsigned)w2), hi_bf((unsigned)w2), lo_bf((unsigned)(w2 >> 32)), hi_bf((unsigned)(w2 >> 32))};
          const float2* c = cs + (size_t)m * 96 + 64 + 4 * jj; const float w = PF[(size_t)m * PFW + 576 + h] * 0.02209708691207961f;
          float r1[4], r2[4], l1[4], l2[4];
#pragma unroll
          for (int i = 0; i < 4; ++i) { const float2 cc = c[i]; r1[i] = q1[i] * cc.x - q2[i] * cc.y; r2[i] = q2[i] * cc.x + q1[i] * cc.y; l1[i] = w * r1[i]; l2[i] = w * r2[i]; }
          *(unsigned long long*)(QS + (size_t)m * 576 + h * 64 + 4 * jj) = (unsigned long long)pk2(r1[0], r1[1]) | ((unsigned long long)pk2(r1[2], r1[3]) << 32);
          *(unsigned long long*)(QS + (size_t)m * 576 + h * 64 + 32 + 4 * jj) = (unsigned long long)pk2(r2[0], r2[1]) | ((unsigned long long)pk2(r2[2], r2[3]) << 32);
#pragma unroll
          for (int i = 0; i < 4; ++i) { l1[i] += __shfl_xor(l1[i], 8); l1[i] += __shfl_xor(l1[i], 16); l1[i] += __shfl_xor(l1[i], 32); l2[i] += __shfl_xor(l2[i], 8); l2[i] += __shfl_xor(l2[i], 16); l2[i] += __shfl_xor(l2[i], 32); }
          if (h == 0) { *(unsigned long long*)(QS + (size_t)m * 576 + 512 + 4 * jj) = (unsigned long long)pk2(l1[0], l1[1]) | ((unsigned long long)pk2(l1[2], l1[3]) << 32);
                        *(unsigned long long*)(QS + (size_t)m * 576 + 512 + 32 + 4 * jj) = (unsigned long long)pk2(l2[0], l2[1]) | ((unsigned long long)pk2(l2[2], l2[3]) << 32);
                        const f32x4 k1 = *(const f32x4*)(PF + (size_t)m * PFW + 512 + 4 * jj), k2 = *(const f32x4*)(PF + (size_t)m * PFW + 512 + 32 + 4 * jj);
                        const float kk1[4] = {k1.x, k1.y, k1.z, k1.w}, kk2[4] = {k2.x, k2.y, k2.z, k2.w}; float o1[4], o2[4];
#pragma unroll
                        for (int i = 0; i < 4; ++i) { const float2 cc = c[i]; o1[i] = kk1[i] * cc.x - kk2[i] * cc.y; o2[i] = kk2[i] * cc.x + kk1[i] * cc.y; }
                        *(unsigned long long*)(KIb + (size_t)m * 64 + 4 * jj) = (unsigned long long)pk2(o1[0], o1[1]) | ((unsigned long long)pk2(o1[2], o1[3]) << 32);
                        *(unsigned long long*)(KIb + (size_t)m * 64 + 32 + 4 * jj) = (unsigned long long)pk2(o2[0], o2[1]) | ((unsigned long long)pk2(o2[2], o2[3]) << 32); }
          if (jj == 0) WP[(size_t)m * 8 + h] = w; } }
    { bf16_t* VT = (bf16_t*)(ws + WS_VT); bf16_t* sT = (bf16_t*)lds;
      for (int tile = blockIdx.x; tile < (M / 64) * 8; tile += gridDim.x) { const int tb = tile >> 3, cb = tile & 7;
          { const int row = tid >> 3, seg = tid & 7; const u32x4 w = *(const u32x4*)(P16 + (size_t)(tb * 64 + row) * NPAD + C_CV + cb * 64 + seg * 8);
            unsigned* d = (unsigned*)(sT + row * 66 + seg * 8); d[0] = w.x; d[1] = w.y; d[2] = w.z; d[3] = w.w; }
          __syncthreads();
          { const int ch = tid >> 3, tg = tid & 7; unsigned short v[8];
#pragma unroll
            for (int i = 0; i < 8; ++i) v[i] = sT[(tg * 8 + i) * 66 + ch];
            const u32x4 o = {(unsigned)v[0] | ((unsigned)v[1] << 16), (unsigned)v[2] | ((unsigned)v[3] << 16), (unsigned)v[4] | ((unsigned)v[5] << 16), (unsigned)v[6] | ((unsigned)v[7] << 16)};
            *(u32x4*)(VT + ((size_t)((tb >> 7) * 512 + cb * 64 + ch)) * SEQ + (tb & 127) * 64 + tg * 8) = o; }
          __syncthreads(); } }
    { bf16_t* VN = (bf16_t*)(ws + WS_VN); const float* gain = a.gmlp_gain + l * 512;
      for (int m = gw; m < M; m += ngw) { const u32x4 w = *(const u32x4*)(P16 + (size_t)m * NPAD + C_BV + lane * 8);
          float v[8] = {gelu_t(lo_bf(w.x)), gelu_t(hi_bf(w.x)), gelu_t(lo_bf(w.y)), gelu_t(hi_bf(w.y)), gelu_t(lo_bf(w.z)), gelu_t(hi_bf(w.z)), gelu_t(lo_bf(w.w)), gelu_t(hi_bf(w.w))};
          float sm = 0.f;
#pragma unroll
          for (int j = 0; j < 8; ++j) sm += v[j] * v[j];
          const float r = rsqrtf(wave_sum(sm) * (1.f / 512.f) + EPS);
          const f32x4 g0 = *(const f32x4*)(gain + lane * 8), g1 = *(const f32x4*)(gain + lane * 8 + 4);
          *(u32x4*)(VN + (size_t)m * 512 + lane * 8) = (u32x4){pk2(v[0] * r * g0.x, v[1] * r * g0.y), pk2(v[2] * r * g0.z, v[3] * r * g0.w), pk2(v[4] * r * g1.x, v[5] * r * g1.y), pk2(v[6] * r * g1.z, v[7] * r * g1.w)}; } }
}

constexpr int NHU = BATCH * 128 * 4;
__device__ __forceinline__ void ph_h1(const Args& a, int l, unsigned char* lds, int wv) {
    unsigned char* ws = oport(a.ws);
    const int tid = otid(wv), lane = tid & 63, wave = __builtin_amdgcn_readfirstlane(tid >> 6), j = wave >> 1, d = tid & 127, fr = lane & 15, fq = lane >> 4;
    bf16_t* KT = (bf16_t*)lds;
    bf16_t* VT = KT + 128 * 72;
    float* sT = (float*)(VT + 128 * 72);
    const float* PF = (const float*)(ws + WS_PF); const bf16_t* P16 = (const bf16_t*)(ws + WS_P16); const float* LB = (const float*)(ws + WS_LB) + l * 512;
    float* LL = (float*)(ws + WS_FF); float* DD = (float*)(ws + WS_DD);
    for (int u = blockIdx.x; u < NHU; u += gridDim.x) {
        const int h = u & 3, c = (u >> 2) & 127, b = u >> 9; const size_t m0 = (size_t)b * SEQ + c * 64 + j * 16;
        const float lbv = LB[h * 128 + d];
        float cs[16], ky[16]; unsigned vv[16]; float run = 0.f;
#pragma unroll
        for (int i = 0; i < 16; ++i) { const float z = PF[(m0 + i) * PFW + h * 128 + d]; const float sg = sigm(z); run += __logf(lbv + (1.f - lbv) * sg); cs[i] = run; ky[i] = (1.f - lbv) * (1.f - sg);
            vv[i] = P16[(m0 + i) * NPAD + C_AI + h * 128 + d]; }
        sT[j * 128 + d] = run;
        __syncthreads();
        float tail = 0.f;
#pragma unroll
        for (int jj = 1; jj < 4; ++jj) if (jj > j) tail += sT[jj * 128 + d];
        { unsigned w[8], x[8];
#pragma unroll
          for (int i = 0; i < 8; ++i) { w[i] = pk2(ky[2 * i] * __expf(tail + (run - cs[2 * i])), ky[2 * i + 1] * __expf(tail + (run - cs[2 * i + 1]))); x[i] = vv[2 * i] | (vv[2 * i + 1] << 16); }
          u32x4* kp = (u32x4*)(KT + d * 72 + j * 16); kp[0] = (u32x4){w[0], w[1], w[2], w[3]}; kp[1] = (u32x4){w[4], w[5], w[6], w[7]};
          u32x4* vp = (u32x4*)(VT + d * 72 + j * 16); vp[0] = (u32x4){x[0], x[1], x[2], x[3]}; vp[1] = (u32x4){x[4], x[5], x[6], x[7]}; }
        if (j == 0) DD[(size_t)u * 128 + d] = __expf(run + tail);
        __syncthreads();
        { bf16x8 xk[2];
#pragma unroll
          for (int ks = 0; ks < 2; ++ks) xk[ks] = *(const bf16x8*)(KT + (16 * wave + fr) * 72 + ks * 32 + fq * 8);
#pragma unroll
          for (int nt = 0; nt < 8; ++nt) { f32x4 acc = {0.f, 0.f, 0.f, 0.f};
#pragma unroll
              for (int ks = 0; ks < 2; ++ks) { const bf16x8 y = *(const bf16x8*)(VT + (16 * nt + fr) * 72 + ks * 32 + fq * 8); acc = __builtin_amdgcn_mfma_f32_16x16x32_bf16(xk[ks], y, acc, 0, 0, 0); }
              *(f32x4*)(LL + ((size_t)u * 128 + 16 * nt + fr) * 128 + 16 * wave + 4 * fq) = acc; } }
        __syncthreads();
    }
}
__device__ __forceinline__ void ph_h2(const Args& a, int wv) {
    unsigned char* ws = oport(a.ws);
    const float* LL = (const float*)(ws + WS_FF); const float* DD = (const float*)(ws + WS_DD); bf16_t* SB = (bf16_t*)(ws + WS_QF);
    for (int e = blockIdx.x * NTHR + otid(wv); e < 8 * 16384; e += gridDim.x * NTHR) { const int bh = e >> 14, b = bh >> 2, h = bh & 3, dvdk = e & 16383, dk = e & 127; float S = 0.f;
#pragma unroll 8
        for (int c = 0; c < 128; ++c) { const size_t u = (size_t)(((b * 128 + c) << 2) + h); SB[u * 16384 + dvdk] = (bf16_t)f2bf(S); S = DD[u * 128 + dk] * S + LL[u * 16384 + dvdk]; } }
}
__device__ __forceinline__ void ph_h3(const Args& a, int l, unsigned char* lds, int wv) {
    unsigned char* ws = oport(a.ws);
    const int tid = otid(wv), lane = tid & 63, wave = __builtin_amdgcn_readfirstlane(tid >> 6), j = wave >> 1, d = tid & 127, fr = lane & 15, fq = lane >> 4;
    bf16_t* QT = (bf16_t*)lds;
    bf16_t* QH = QT + 64 * 136;
    bf16_t* KI = QH + 64 * 136;
    bf16_t* VT = KI + 160 * 136;
    bf16_t* AT = VT + 128 * 72;
    float* sT = (float*)(AT + 64 * 72);
    float* sSS = sT + 512;
    const float* PF = (const float*)(ws + WS_PF); const bf16_t* P16 = (const bf16_t*)(ws + WS_P16); const float* LB = (const float*)(ws + WS_LB) + l * 512;
    const bf16_t* SB = (const bf16_t*)(ws + WS_QF); bf16_t* YA = (bf16_t*)(ws + WS_YALL); const float* gain = a.hgrn_gain + l * 128;
    for (int u = blockIdx.x; u < NHU; u += gridDim.x) {
        const int h = u & 3, c = (u >> 2) & 127, b = u >> 9; const size_t mc = (size_t)b * SEQ + c * 64, m0 = mc + j * 16;
        for (int i = tid; i < 64 * 72 * 2 / 16; i += NTHR) ((u32x4*)AT)[i] = (u32x4){0u, 0u, 0u, 0u};
        const float lbv = LB[h * 128 + d];
        float cs[16], ky[16], qf[16]; unsigned vv[16]; float run = 0.f;
#pragma unroll
        for (int i = 0; i < 16; ++i) { const size_t pr = (m0 + i) * NPAD + h * 128 + d; const float z = PF[(m0 + i) * PFW + h * 128 + d]; const float sg = sigm(z); run += __logf(lbv + (1.f - lbv) * sg); cs[i] = run; ky[i] = (1.f - lbv) * (1.f - sg);
            qf[i] = silu(bf2f(P16[pr + C_AQ])) * 0.08838834764831845f; vv[i] = P16[pr + C_AI]; }
        sT[j * 128 + d] = run;
        __syncthreads();
        const float T0 = sT[d], T1 = sT[128 + d], T2 = sT[256 + d];
        const float Bj = (j > 0 ? T0 : 0.f) + (j > 1 ? T1 : 0.f) + (j > 2 ? T2 : 0.f); const float eBj = __expf(Bj);
        float pre[4]; pre[0] = 0.f; pre[1] = (j < 1 ? T0 : 0.f); pre[2] = (j < 1 ? T0 : 0.f) + (j < 2 ? T1 : 0.f); pre[3] = (j < 1 ? T0 : 0.f) + (j < 2 ? T1 : 0.f) + (j < 3 ? T2 : 0.f);
#pragma unroll
        for (int i = 0; i < 16; ++i) { const int t = 16 * j + i; const float ec = __expf(cs[i]);
            QT[t * 136 + d] = (bf16_t)f2bf(qf[i] * ec); QH[t * 136 + d] = (bf16_t)f2bf(qf[i] * ec * eBj);
#pragma unroll
            for (int I = 0; I < 4; ++I) if (I >= j) KI[(8 * I * (I + 1) + t) * 136 + d] = (bf16_t)f2bf(ky[i] * __expf(fminf(pre[I] - cs[i], 80.f))); }
        { unsigned x[8];
#pragma unroll
          for (int i = 0; i < 8; ++i) x[i] = vv[2 * i] | (vv[2 * i + 1] << 16);
          u32x4* vp = (u32x4*)(VT + d * 72 + j * 16); vp[0] = (u32x4){x[0], x[1], x[2], x[3]}; vp[1] = (u32x4){x[4], x[5], x[6], x[7]}; }
        __syncthreads();
        for (int tl = wave; tl < 10; tl += 8) { const int I = tl < 1 ? 0 : tl < 3 ? 1 : tl < 6 ? 2 : 3, J = tl - (I * (I + 1)) / 2; f32x4 acc = {0.f, 0.f, 0.f, 0.f};
#pragma unroll
            for (int ks = 0; ks < 4; ++ks) { const bf16x8 x = *(const bf16x8*)(QT + (16 * I + fr) * 136 + ks * 32 + fq * 8); const bf16x8 y = *(const bf16x8*)(KI + (8 * I * (I + 1) + 16 * J + fr) * 136 + ks * 32 + fq * 8);
                acc = __builtin_amdgcn_mfma_f32_16x16x32_bf16(x, y, acc, 0, 0, 0); }
#pragma unroll
            for (int r = 0; r < 4; ++r) { float v = acc[r]; if (J == I && fr > 4 * fq + r) v = 0.f; AT[(16 * I + 4 * fq + r) * 72 + 16 * J + fr] = (bf16_t)f2bf(v); } }
        __syncthreads();
        const int I = wave & 3, nt0 = 4 * (wave >> 2); f32x4 o[4];
#pragma unroll
        for (int q4 = 0; q4 < 4; ++q4) { const int nt = nt0 + q4; f32x4 acc = {0.f, 0.f, 0.f, 0.f};
            for (int ks = 0; ks <= (I >> 1); ++ks) { const bf16x8 x = *(const bf16x8*)(AT + (16 * I + fr) * 72 + ks * 32 + fq * 8); const bf16x8 y = *(const bf16x8*)(VT + (16 * nt + fr) * 72 + ks * 32 + fq * 8);
                acc = __builtin_amdgcn_mfma_f32_16x16x32_bf16(x, y, acc, 0, 0, 0); }
#pragma unroll
            for (int ks = 0; ks < 4; ++ks) { const bf16x8 x = *(const bf16x8*)(QH + (16 * I + fr) * 136 + ks * 32 + fq * 8); const bf16x8 y = *(const bf16x8*)(SB + ((size_t)u * 128 + 16 * nt + fr) * 128 + ks * 32 + fq * 8);
                acc = __builtin_amdgcn_mfma_f32_16x16x32_bf16(x, y, acc, 0, 0, 0); }
            o[q4] = acc; }
        { float ssq[4];
#pragma unroll
          for (int r = 0; r < 4; ++r) { float s = o[0][r] * o[0][r] + o[1][r] * o[1][r] + o[2][r] * o[2][r] + o[3][r] * o[3][r]; s += __shfl_xor(s, 1); s += __shfl_xor(s, 2); s += __shfl_xor(s, 4); s += __shfl_xor(s, 8); ssq[r] = s; }
          if (fr == 0) {
#pragma unroll
              for (int r = 0; r < 4; ++r) sSS[(16 * I + 4 * fq + r) * 2 + (wave >> 2)] = ssq[r]; } }
        __syncthreads();
#pragma unroll
        for (int r = 0; r < 4; ++r) { const int tt = 16 * I + 4 * fq + r; const float rinv = rsqrtf((sSS[tt * 2] + sSS[tt * 2 + 1]) * (1.f / 128.f) + EPS); const size_t m = mc + tt;
#pragma unroll
            for (int q4 = 0; q4 < 4; ++q4) { const int dv = 16 * (nt0 + q4) + fr; const float g = bf2f(P16[m * NPAD + C_AG + h * 128 + dv]);
                YA[m * 512 + h * 128 + dv] = (bf16_t)f2bf(o[q4][r] * rinv * gain[dv] * silu(g)); } }
        __syncthreads();
    }
}
__device__ __forceinline__ void ph_gmlp(const Args& a, int l, unsigned char* lds, int wv) {
    unsigned char* ws = oport(a.ws);
    const int tid = otid(wv), lane = tid & 63, wave = __builtin_amdgcn_readfirstlane(tid >> 6), fr = lane & 15, fq = lane >> 4;
    const bf16_t* P16 = (const bf16_t*)(ws + WS_P16); const bf16_t* VN = (const bf16_t*)(ws + WS_VN); bf16_t* YB = (bf16_t*)(ws + WS_YALL) + (size_t)M * 512;
    const bf16_t* WSB = (const bf16_t*)(ws + WS_WSB) + (size_t)l * 4 * 128 * 128; const float* bs = a.gmlp_bs + (size_t)l * 4 * 128;
    bf16_t* VNt = (bf16_t*)lds;
    for (int u = blockIdx.x; u < (M / 128) * 4; u += gridDim.x) { const int g = u & 3, nb = u >> 2; const size_t mb = (size_t)nb * 128;
        __syncthreads();
#pragma unroll
        for (int n = 0; n < 4; ++n) { const int idx = tid + NTHR * n, row = idx >> 4, seg = idx & 15; const u32x4 w = *(const u32x4*)(VN + (mb + row) * 512 + g * 128 + seg * 8);
            bf16_t* d = VNt + (seg * 8) * 136 + row;
            d[0 * 136] = (bf16_t)(w.x & 0xffffu); d[1 * 136] = (bf16_t)(w.x >> 16); d[2 * 136] = (bf16_t)(w.y & 0xffffu); d[3 * 136] = (bf16_t)(w.y >> 16);
            d[4 * 136] = (bf16_t)(w.z & 0xffffu); d[5 * 136] = (bf16_t)(w.z >> 16); d[6 * 136] = (bf16_t)(w.w & 0xffffu); d[7 * 136] = (bf16_t)(w.w >> 16); }
        bf16x8 wf[4];
#pragma unroll
        for (int ks = 0; ks < 4; ++ks) wf[ks] = *(const bf16x8*)(WSB + ((size_t)g * 128 + 16 * wave + fr) * 128 + 32 * ks + 8 * fq);
        __syncthreads();
        const int t = 16 * wave + fr; const float bias = bs[g * 128 + t]; const int nks = (wave >> 1) + 1;
#pragma unroll
        for (int ct = 0; ct < 8; ++ct) { f32x4 acc = {0.f, 0.f, 0.f, 0.f};
#pragma unroll
            for (int ks = 0; ks < 4; ++ks) if (ks < nks) { const bf16x8 x = *(const bf16x8*)(VNt + (16 * ct + fr) * 136 + 32 * ks + 8 * fq); acc = __builtin_amdgcn_mfma_f32_16x16x32_bf16(x, wf[ks], acc, 0, 0, 0); }
            const size_t m = mb + t; const int c = g * 128 + 16 * ct + 4 * fq; const unsigned long long uw = *(const unsigned long long*)(P16 + m * NPAD + C_BU + c);
            const float o0 = gelu_t(lo_bf((unsigned)uw)) * (acc[0] + bias), o1 = gelu_t(hi_bf((unsigned)uw)) * (acc[1] + bias), o2 = gelu_t(lo_bf((unsigned)(uw >> 32))) * (acc[2] + bias), o3 = gelu_t(hi_bf((unsigned)(uw >> 32))) * (acc[3] + bias);
            *(unsigned long long*)(YB + m * 512 + c) = (unsigned long long)pk2(o0, o1) | ((unsigned long long)pk2(o2, o3) << 32); }
    }
}
constexpr int SEL_CAP = 128;
__device__ __forceinline__ int sel_bin(float s, float lo, float sc) { return (int)__builtin_amdgcn_fmed3f((s - lo) * sc, 0.f, 511.f); }
struct SelQ { float lo1, sc1, lo2, sc2, tau; int b1, b2, ref, tidx; };
__device__ __forceinline__ void sel_pass(const int mode, const bf16x8 (&qf)[9][2], const float (&wp)[8], const SelQ& sq, const bf16_t* kib, int c, int kp, int qloc, int fr, int fq,
                                         unsigned* sHist, unsigned* sCand, unsigned* sCnt, unsigned* maskrow) {
    bf16x8 af[4][2];
    { const int T0 = kp <= c ? kp : c;
#pragma unroll
      for (int rg = 0; rg < 4; ++rg)
#pragma unroll
          for (int ks = 0; ks < 2; ++ks) af[rg][ks] = ((const bf16x8*)(kib + (size_t)(64 * T0 + 16 * rg) * 64 + 32 * ks))[fr * 8 + fq]; }
#pragma unroll 1
    for (int T = kp; T <= c; T += 4) {
        const int Tn = (T + 4 <= c) ? T + 4 : T;
        unsigned mlo = 0u, mhi = 0u;
#pragma unroll
        for (int rg = 0; rg < 4; ++rg) {
            f32x4 sc = __builtin_amdgcn_mfma_f32_16x16x32_bf16(af[rg][0], qf[8][0], (f32x4){0.f, 0.f, 0.f, 0.f}, 0, 0, 0);
            sc = __builtin_amdgcn_mfma_f32_16x16x32_bf16(af[rg][1], qf[8][1], sc, 0, 0, 0);
#pragma unroll
            for (int h = 0; h < 8; ++h) { f32x4 ah = __builtin_amdgcn_mfma_f32_16x16x32_bf16(af[rg][0], qf[h][0], (f32x4){0.f, 0.f, 0.f, 0.f}, 0, 0, 0);
                ah = __builtin_amdgcn_mfma_f32_16x16x32_bf16(af[rg][1], qf[h][1], ah, 0, 0, 0);
#pragma unroll
                for (int r = 0; r < 4; ++r) sc[r] += wp[h] * __builtin_fabsf(ah[r]); }
#pragma unroll
            for (int ks = 0; ks < 2; ++ks) af[rg][ks] = ((const bf16x8*)(kib + (size_t)(64 * Tn + 16 * rg) * 64 + 32 * ks))[fr * 8 + fq];
            if (mode == 0) {
#pragma unroll
                for (int r = 0; r < 4; ++r) __hip_atomic_fetch_add(sHist + qloc * 512 + sel_bin(sc[r], sq.lo1, sq.sc1), 1u, __ATOMIC_RELAXED, __HIP_MEMORY_SCOPE_WORKGROUP);
            } else if (mode == 1) {
                if (sq.ref) {
#pragma unroll
                    for (int r = 0; r < 4; ++r) if (sel_bin(sc[r], sq.lo1, sq.sc1) == sq.b1) __hip_atomic_fetch_add(sHist + qloc * 512 + sel_bin(sc[r], sq.lo2, sq.sc2), 1u, __ATOMIC_RELAXED, __HIP_MEMORY_SCOPE_WORKGROUP); }
            } else {
                int b[4]; unsigned bits = 0u; bool anyc = false;
#pragma unroll
                for (int r = 0; r < 4; ++r) { b[r] = sel_bin(sc[r], sq.lo1, sq.sc1); bits |= (b[r] > sq.b1) ? (1u << r) : 0u; anyc |= (b[r] == sq.b1); }
                if (anyc) {
#pragma unroll
                    for (int r = 0; r < 4; ++r) if (b[r] == sq.b1) { bool cand = true;
                        if (sq.ref) { const int b2 = sel_bin(sc[r], sq.lo2, sq.sc2); if (b2 > sq.b2) bits |= 1u << r; cand = b2 == sq.b2; }
                        if (cand) { const unsigned slot = __hip_atomic_fetch_add(sCnt + qloc, 1u, __ATOMIC_RELAXED, __HIP_MEMORY_SCOPE_WORKGROUP);
                            if (slot < (unsigned)SEL_CAP) { sCand[(qloc * SEL_CAP + slot) * 2] = __float_as_uint(sc[r]); sCand[(qloc * SEL_CAP + slot) * 2 + 1] = (unsigned)(64 * T + 16 * rg + 4 * fq + r); } } } }
                bits <<= (16 * (rg & 1)) + 4 * fq; if (rg < 2) mlo |= bits; else mhi |= bits;
            }
            __builtin_amdgcn_sched_barrier(0);
        }
        if (mode == 2) { mlo |= __shfl_xor(mlo, 16); mlo |= __shfl_xor(mlo, 32); mhi |= __shfl_xor(mhi, 16); mhi |= __shfl_xor(mhi, 32);
            if (fq == 0) *(uint2*)(maskrow + 2 * T) = make_uint2(mlo, mhi); }
    }
}
__device__ __forceinline__ void sel_scan(const unsigned* hist, unsigned need, int lane, int& bsel, unsigned& nneed, unsigned& cnt) {
    unsigned c8[8]; unsigned tot = 0u;
    { const u32x4 w0 = *(const u32x4*)(hist + 512 - 8 * (lane + 1)), w1 = *(const u32x4*)(hist + 512 - 8 * (lane + 1) + 4);
      c8[0] = w0.x; c8[1] = w0.y; c8[2] = w0.z; c8[3] = w0.w; c8[4] = w1.x; c8[5] = w1.y; c8[6] = w1.z; c8[7] = w1.w; }
#pragma unroll
    for (int i = 0; i < 8; ++i) tot += c8[i];
    unsigned inc = tot;
#pragma unroll
    for (int o = 1; o < 64; o <<= 1) { const unsigned t2 = __shfl_up(inc, o); if (lane >= o) inc += t2; }
    const unsigned long long bal = __ballot(inc >= need);
    const int L = bal ? (__ffsll((long long)bal) - 1) : 63;
    unsigned above = __shfl(inc - tot, L); int bs = 0; unsigned nn = 1u, cc = 0u; bool found = false;
#pragma unroll
    for (int j = 0; j < 8; ++j) { const unsigned hcnt = __shfl(c8[7 - j], L); if (!found) { if (above + hcnt >= need) { found = true; bs = 512 - 8 * L - 1 - j; nn = need - above; cc = hcnt; } else above += hcnt; } }
    bsel = bs; nneed = nn; cnt = cc;
}
__device__ __forceinline__ void ph_sel(const Args& a, unsigned char* lds, int wv) {
    unsigned char* ws = oport(a.ws);
    const int tid = otid(wv), lane = tid & 63, wave = __builtin_amdgcn_readfirstlane(tid >> 6), gq = wave & 1, kp = wave >> 1, fr = lane & 15, fq = lane >> 4, qloc = 16 * gq + fr;
    unsigned* sHist = (unsigned*)lds;
    unsigned* sCand = (unsigned*)(lds + 65536);
    float* sLo1 = (float*)(lds + 98304); float* sSc1 = sLo1 + 32; float* sLo2 = sSc1 + 32; float* sSc2 = sLo2 + 32; float* sTau = sSc2 + 32;
    int* sB1 = (int*)(sTau + 32); int* sB2 = sB1 + 32; int* sRef = sB2 + 32; int* sTidx = sRef + 32; unsigned* sNeed = (unsigned*)(sTidx + 32); unsigned* sCnt = sNeed + 32; int* sAny = (int*)(sCnt + 32);
    const bf16_t* QS = (const bf16_t*)(ws + WS_QI); const bf16_t* KIb = (const bf16_t*)(ws + WS_KI); const float* WP = (const float*)(ws + WS_WI); unsigned* MASKB = (unsigned*)(ws + WS_MASK);
    for (int pi = blockIdx.x; pi < 256; pi += gridDim.x) {
#pragma unroll 1
      for (int which = 0; which < 2; ++which) {
        const int b = pi & 1, half = (pi >> 1) & 1, cc = pi >> 2, c = which ? cc : 127 - cc;
        const size_t mq = (size_t)b * SEQ + 64 * c + 32 * half;
        const bf16_t* kib = KIb + (size_t)b * SEQ * 64;
        __syncthreads();
        if (tid < 32) { const float* w = WP + (mq + tid) * 8; float s1 = 0.f, s2 = 0.f;
#pragma unroll
            for (int h = 0; h < 8; ++h) { s1 += w[h]; s2 += w[h] * w[h]; }
            const float sd = 9.34f * sqrtf(fmaxf(s2, 1e-30f)); sLo1[tid] = 6.38f * s1 - 8.f * sd; sSc1[tid] = 512.f / (16.f * sd);
            sLo2[tid] = 0.f; sSc2[tid] = 1.f; sB1[tid] = 0; sB2[tid] = 0; sRef[tid] = 0; sNeed[tid] = 256u; sCnt[tid] = 0u; sTau[tid] = -INFINITY; sTidx[tid] = 0x7fffffff; }
        if (tid == 0) sAny[0] = 0;
        for (int i = tid; i < 32 * 512 / 4; i += NTHR) ((u32x4*)sHist)[i] = (u32x4){0u, 0u, 0u, 0u};
        bf16x8 qf[9][2]; float wp[8];
        { const bf16_t* qrow = QS + (mq + qloc) * 576;
#pragma unroll
          for (int h = 0; h < 9; ++h)
#pragma unroll
              for (int ks = 0; ks < 2; ++ks) qf[h][ks] = *(const bf16x8*)(qrow + h * 64 + 32 * ks + 8 * fq);
#pragma unroll
          for (int h = 0; h < 8; ++h) wp[h] = WP[(mq + qloc) * 8 + h]; }
        __syncthreads();
        unsigned* maskrow = MASKB + (mq + qloc) * 256;
        if (c < 4) {
            if (tid < 32) for (int T = 0; T <= c; ++T) *(uint2*)(MASKB + (mq + tid) * 256 + 2 * T) = make_uint2(0xFFFFFFFFu, 0xFFFFFFFFu);
        } else {
#pragma unroll 1
            for (int pass = 0; pass < 3; ++pass) {
                if (pass == 1) { if (!sAny[0]) continue; __syncthreads(); for (int i = tid; i < 32 * 512 / 4; i += NTHR) ((u32x4*)sHist)[i] = (u32x4){0u, 0u, 0u, 0u}; __syncthreads(); }
                SelQ sq; sq.lo1 = sLo1[qloc]; sq.sc1 = sSc1[qloc]; sq.lo2 = sLo2[qloc]; sq.sc2 = sSc2[qloc]; sq.b1 = sB1[qloc]; sq.b2 = sB2[qloc]; sq.ref = sRef[qloc]; sq.tau = 0.f; sq.tidx = 0;
                sel_pass(pass, qf, wp, sq, kib, c, kp, qloc, fr, fq, sHist, sCand, sCnt, maskrow);
                asm volatile("s_waitcnt vmcnt(0)" ::: "memory");
                __syncthreads();
                if (pass < 2) {
                    for (int qq = wave * 4; qq < wave * 4 + 4; ++qq) if (pass == 0 || sRef[qq]) { int bs; unsigned nn, cn; sel_scan(sHist + qq * 512, sNeed[qq], lane, bs, nn, cn);
                        if (lane == 0) { sNeed[qq] = nn; if (pass == 0) { sB1[qq] = bs; if (cn > (unsigned)SEL_CAP) { sRef[qq] = 1; sLo2[qq] = sLo1[qq] + (float)bs / sSc1[qq]; sSc2[qq] = sSc1[qq] * 512.f; sAny[0] = 1; } } else sB2[qq] = bs; } }
                    __syncthreads(); }
            }
            { const int qq = tid >> 4, t16 = tid & 15; const unsigned n = sCnt[qq] < (unsigned)SEL_CAP ? sCnt[qq] : (unsigned)SEL_CAP; const unsigned want = sNeed[qq] - 1u;
              for (unsigned i = t16; i < n; i += 16) { const float si = __uint_as_float(sCand[(qq * SEL_CAP + i) * 2]); const unsigned ki = sCand[(qq * SEL_CAP + i) * 2 + 1]; unsigned rank = 0u;
                  for (unsigned j = 0; j < n; ++j) { const float sj = __uint_as_float(sCand[(qq * SEL_CAP + j) * 2]); const unsigned kj = sCand[(qq * SEL_CAP + j) * 2 + 1]; rank += (sj > si || (sj == si && kj < ki)) ? 1u : 0u; }
                  if (rank <= want) atomicOr(MASKB + (mq + qq) * 256 + (ki >> 5), 1u << (ki & 31u)); } }
        }
      }
    }
}

__device__ __forceinline__ void ph_attn(const Args& a, unsigned char* lds, int wv) {
    unsigned char* ws = oport(a.ws);
    const int tid = otid(wv), lane = tid & 63, wave = __builtin_amdgcn_readfirstlane(tid >> 6), g4 = wave & 3, par = wave >> 2, fr = lane & 15, fq = lane >> 4;
    const bf16_t* QR = (const bf16_t*)(ws + WS_QR); const bf16_t* KR = (const bf16_t*)(ws + WS_KR); const bf16_t* VT = (const bf16_t*)(ws + WS_VT); const unsigned* MASKB = (const unsigned*)(ws + WS_MASK);
    bf16_t* YC = (bf16_t*)(ws + WS_YALL) + (size_t)2 * M * 512;
    bf16_t* Kt = (bf16_t*)lds;
    bf16_t* Vt = Kt + 2 * 64 * 136;
    float* sMrg = (float*)lds;
    for (int pi = blockIdx.x; pi < 256; pi += gridDim.x) {
#pragma unroll 1
      for (int which = 0; which < 2; ++which) {
        const int bh = pi & 7, b = bh >> 2, h = bh & 3, cc = pi >> 3, qb = which ? cc : 63 - cc;
        const size_t m0 = (size_t)b * SEQ + 128 * qb + 32 * g4;
        const int mych = 2 * qb + (g4 >> 1);
        bf16x8 qf[2][4];
#pragma unroll
        for (int cg = 0; cg < 2; ++cg)
#pragma unroll
            for (int ks = 0; ks < 4; ++ks) qf[cg][ks] = *(const bf16x8*)(QR + (m0 + 16 * cg + fr) * 512 + h * 128 + 32 * ks + 8 * fq);
        f32x4 O[2][8]; float mrun[2], lrun[2];
#pragma unroll
        for (int cg = 0; cg < 2; ++cg) { mrun[cg] = -1e30f; lrun[cg] = 0.f;
#pragma unroll
            for (int vt = 0; vt < 8; ++vt) O[cg][vt] = (f32x4){0.f, 0.f, 0.f, 0.f}; }
        const bf16_t* kbase = KR + (size_t)b * SEQ * 512 + h * 128; const bf16_t* vbase = VT + (size_t)(b * 512 + h * 128) * SEQ;
#define ATT_DMA(jj, buf) do { const bf16_t* kb_ = kbase + (size_t)(jj) * 128 * 512; const bf16_t* vb_ = vbase + (size_t)(jj) * 128; \
            _Pragma("unroll 1") for (int i_ = wave; i_ < 70; i_ += NWAVE) { const int slot = 64 * i_ + lane; const bf16_t* src; \
                if (slot < 2176) { const int tl = slot >= 1088 ? 1 : 0, rs = slot - 1088 * tl, row = rs / 17, seg = rs - 17 * row; src = kb_ + (size_t)((64 * tl + row) * 512 + (seg & 15) * 8); } \
                else { const int s2 = slot - 2176, tl = s2 >= 1152 ? 1 : 0, rs = s2 - 1152 * tl, row = rs / 9, seg = rs - 9 * row; src = vb_ + (size_t)(row * SEQ + 64 * tl + (seg & 7) * 8); } \
                __builtin_amdgcn_global_load_lds((const unsigned*)src, (LAS unsigned*)(LAS unsigned char*)(lds + (buf) * 71680 + i_ * 1024), 16, 0, 0); } } while (0)
        __syncthreads();
        ATT_DMA(0, 0);
        asm volatile("s_waitcnt vmcnt(0)" ::: "memory");
        __syncthreads();
        for (int j = 0; j <= qb; ++j) {
            if (j < qb) ATT_DMA(j + 1, (j + 1) & 1);
            const bf16_t* Ktb = Kt + (j & 1) * 35840; const bf16_t* Vtb = Vt + (j & 1) * 35840;
            const int T = 2 * j + par;
            if (T <= mych) {
                const bf16_t* kt = Ktb + par * 64 * 136; const bf16_t* vtl = Vtb + par * 128 * 72;
                uint2 mw[2];
#pragma unroll
                for (int cg = 0; cg < 2; ++cg) mw[cg] = *(const uint2*)(MASKB + (m0 + 16 * cg + fr) * 256 + 2 * T);
                f32x4 S[2][4];
#pragma unroll
                for (int rg = 0; rg < 4; ++rg) { S[0][rg] = (f32x4){0.f, 0.f, 0.f, 0.f}; S[1][rg] = (f32x4){0.f, 0.f, 0.f, 0.f};
                    const int krow = 32 * (rg >> 1) + 8 * (fr >> 2) + 4 * (rg & 1) + (fr & 3);
#pragma unroll
                    for (int ks = 0; ks < 4; ++ks) { const bf16x8 kf = *(const bf16x8*)(kt + krow * 136 + 32 * ks + 8 * fq);
                        S[0][rg] = __builtin_amdgcn_mfma_f32_16x16x32_bf16(kf, qf[0][ks], S[0][rg], 0, 0, 0); S[1][rg] = __builtin_amdgcn_mfma_f32_16x16x32_bf16(kf, qf[1][ks], S[1][rg], 0, 0, 0); } }
                bf16x8 pf[2][2];
#pragma unroll
                for (int cg = 0; cg < 2; ++cg) {
                    float mx = fmaxf(fmaxf(fmaxf(S[cg][0][0], S[cg][0][1]), fmaxf(S[cg][0][2], S[cg][0][3])), fmaxf(fmaxf(S[cg][1][0], S[cg][1][1]), fmaxf(S[cg][1][2], S[cg][1][3])));
                    mx = fmaxf(mx, fmaxf(fmaxf(fmaxf(S[cg][2][0], S[cg][2][1]), fmaxf(S[cg][2][2], S[cg][2][3])), fmaxf(fmaxf(S[cg][3][0], S[cg][3][1]), fmaxf(S[cg][3][2], S[cg][3][3]))));
                    mx = fmaxf(mx, __shfl_xor(mx, 16)); mx = fmaxf(mx, __shfl_xor(mx, 32));
                    const float mnew = fmaxf(mrun[cg], mx), alpha = __builtin_amdgcn_exp2f(mrun[cg] - mnew); mrun[cg] = mnew; float ls = 0.f;
                    const int m16 = (int)(((mw[cg].x >> (8 * fq)) & 0xFFu) | (((mw[cg].y >> (8 * fq)) & 0xFFu) << 8));
#pragma unroll
                    for (int rg = 0; rg < 4; ++rg)
#pragma unroll
                        for (int r = 0; r < 4; ++r) { const int keep = __builtin_amdgcn_sbfe(m16, 4 * rg + r, 1);
                            const float p = __int_as_float(__float_as_int(__builtin_amdgcn_exp2f(S[cg][rg][r] - mnew)) & keep); S[cg][rg][r] = p; ls += p; }
                    lrun[cg] = lrun[cg] * alpha + ls;
                    if (__builtin_amdgcn_ballot_w64(alpha != 1.0f) != 0ull) {
#pragma unroll
                        for (int vt = 0; vt < 8; ++vt) O[cg][vt] = O[cg][vt] * alpha; }
#pragma unroll
                    for (int k2 = 0; k2 < 2; ++k2) { const u32x4 w = {pg8::cvt_pk_bf16(S[cg][2 * k2][0], S[cg][2 * k2][1]), pg8::cvt_pk_bf16(S[cg][2 * k2][2], S[cg][2 * k2][3]), pg8::cvt_pk_bf16(S[cg][2 * k2 + 1][0], S[cg][2 * k2 + 1][1]), pg8::cvt_pk_bf16(S[cg][2 * k2 + 1][2], S[cg][2 * k2 + 1][3])};
                        pf[cg][k2] = __builtin_bit_cast(bf16x8, w); }
                }
#pragma unroll
                for (int vt = 0; vt < 8; ++vt)
#pragma unroll
                    for (int k2 = 0; k2 < 2; ++k2) { const bf16x8 vf = *(const bf16x8*)(vtl + (16 * vt + fr) * 72 + 32 * k2 + 8 * fq);
                        O[0][vt] = __builtin_amdgcn_mfma_f32_16x16x32_bf16(vf, pf[0][k2], O[0][vt], 0, 0, 0); O[1][vt] = __builtin_amdgcn_mfma_f32_16x16x32_bf16(vf, pf[1][k2], O[1][vt], 0, 0, 0); }
            }
            asm volatile("s_waitcnt vmcnt(0)" ::: "memory");
            __syncthreads();
        }
#undef ATT_DMA
        float* mb = sMrg + (size_t)g4 * 68 * 64 + lane;
        if (par == 1) {
#pragma unroll
            for (int cg = 0; cg < 2; ++cg) { mb[(cg * 2 + 0) * 64] = mrun[cg]; mb[(cg * 2 + 1) * 64] = lrun[cg];
#pragma unroll
                for (int vt = 0; vt < 8; ++vt)
#pragma unroll
                    for (int r = 0; r < 4; ++r) mb[(4 + (cg * 8 + vt) * 4 + r) * 64] = O[cg][vt][r]; } }
        __syncthreads();
        if (par == 0) {
#pragma unroll
            for (int cg = 0; cg < 2; ++cg) { const float m1 = mb[(cg * 2 + 0) * 64], l1 = mb[(cg * 2 + 1) * 64]; const float mm = fmaxf(mrun[cg], m1), a0 = __builtin_amdgcn_exp2f(mrun[cg] - mm), a1 = __builtin_amdgcn_exp2f(m1 - mm);
                float lt = lrun[cg] * a0 + l1 * a1; lt += __shfl_xor(lt, 16); lt += __shfl_xor(lt, 32); const float inv = 1.f / lt;
#pragma unroll
                for (int vt = 0; vt < 8; ++vt) { float o[4];
#pragma unroll
                    for (int r = 0; r < 4; ++r) o[r] = (O[cg][vt][r] * a0 + mb[(4 + (cg * 8 + vt) * 4 + r) * 64] * a1) * inv;
                    *(unsigned long long*)(YC + (m0 + 16 * cg + fr) * 512 + h * 128 + 16 * vt + 4 * fq) = (unsigned long long)pk2(o[0], o[1]) | ((unsigned long long)pk2(o[2], o[3]) << 32); } } }
      }
    }
}
__device__ __forceinline__ void ph_norm2(const Args& a, int l, int wv) {
    const int tid = otid(wv), lane = tid & 63, gw = blockIdx.x * NWAVE + (tid >> 6), ngw = gridDim.x * NWAVE;
    unsigned char* ws = oport(a.ws);
    for (int m = gw; m < M; m += ngw) rms_row_to_bf16(a.out + (size_t)m * D, a.norm2 + l * D, (bf16_t*)(ws + WS_H16) + (size_t)m * D, lane);
    { const f32x4* U = (const f32x4*)(a.peer_u + (size_t)l * NEXP * D); const f32x4* V = (const f32x4*)(a.peer_v + (size_t)l * NEXP * D); u32x4* U8 = (u32x4*)(ws + WS_U16); u32x4* V8 = (u32x4*)(ws + WS_V16);
      for (size_t i = (size_t)blockIdx.x * NTHR + tid; i < (size_t)NEXP * D / 16; i += (size_t)gridDim.x * NTHR) { u32x4 ou, ov; unsigned* pu = (unsigned*)&ou; unsigned* pv = (unsigned*)&ov;
#pragma unroll
          for (int q = 0; q < 4; ++q) { const f32x4 u = U[4 * i + q] * 256.f, v = V[4 * i + q] * 64.f; int wu = 0, wvv = 0;
              wu = __builtin_amdgcn_cvt_pk_fp8_f32(u.x, u.y, wu, false); wu = __builtin_amdgcn_cvt_pk_fp8_f32(u.z, u.w, wu, true); wvv = __builtin_amdgcn_cvt_pk_fp8_f32(v.x, v.y, wvv, false); wvv = __builtin_amdgcn_cvt_pk_fp8_f32(v.z, v.w, wvv, true);
              pu[q] = (unsigned)wu; pv[q] = (unsigned)wvv; }
          U8[i] = ou; V8[i] = ov; } }
}
__device__ __forceinline__ float pkf(float v, unsigned tag) { return __uint_as_float((__float_as_uint(v) & 0xFFFFFF00u) | tag); }
__device__ __forceinline__ void ph_peer_select(const Args& a, int l, unsigned char* lds, int wv, int nunits, int pm0, int pn0, int pm1, int pn1) {
    unsigned char* ws = oport(a.ws); const int tid = otid(wv), lane = tid & 63, wave = __builtin_amdgcn_readfirstlane(tid >> 6), fr = lane & 15, fq = lane >> 4;
    int* sI = (int*)(lds + wave * 2048);
    const bf16_t* QRY = (const bf16_t*)(ws + WS_GB); const bf16_t* SKB = (const bf16_t*)(ws + WS_SKB) + (size_t)l * 16 * 128 * 128; int* EID = (int*)(ws + WS_EID); float* EG = (float*)(ws + WS_EG);
    for (int it = wave; it < 16 * nunits; it += NWAVE) { const int uu = it >> 4, h = uu == 0 ? pn0 : pn1, tg = (uu == 0 ? pm0 : pm1) * 16 + (it & 15); const size_t m = (size_t)tg * 16 + fr;
        float va[16], vb[16];
#pragma unroll
        for (int p = 0; p < 2; ++p) {
            bf16x8 qf[4];
#pragma unroll
            for (int ks = 0; ks < 4; ++ks) qf[ks] = *(const bf16x8*)(QRY + m * 2048 + h * 256 + p * 128 + 32 * ks + 8 * fq);
            const bf16_t* kb = SKB + ((size_t)(h * 2 + p) * 128) * 128; float sc[32];
#pragma unroll
            for (int nt = 0; nt < 8; ++nt) { f32x4 acc = {0.f, 0.f, 0.f, 0.f};
#pragma unroll
                for (int ks = 0; ks < 4; ++ks) { const bf16x8 x = *(const bf16x8*)(kb + (size_t)(16 * nt + fr) * 128 + 32 * ks + 8 * fq); acc = __builtin_amdgcn_mfma_f32_16x16x32_bf16(x, qf[ks], acc, 0, 0, 0); }
#pragma unroll
                for (int r = 0; r < 4; ++r) sc[nt * 4 + r] = __uint_as_float((__float_as_uint(acc[r]) & 0xFFFFFF80u) | (unsigned)(127 - (16 * nt + 4 * fq + r))); }
#pragma unroll
            for (int rd = 0; rd < 16; ++rd) { float mx = sc[0];
#pragma unroll
                for (int j = 1; j < 32; ++j) mx = fmaxf(mx, sc[j]);
                mx = fmaxf(mx, __shfl_xor(mx, 16)); mx = fmaxf(mx, __shfl_xor(mx, 32));
#pragma unroll
                for (int j = 0; j < 32; ++j) sc[j] = (sc[j] == mx) ? -INFINITY : sc[j];
                if (p == 0) va[rd] = mx; else vb[rd] = mx; }
            __builtin_amdgcn_sched_barrier(0);
        }
        if (fq == 0) {
#pragma unroll
            for (int r = 0; r < 16; ++r) { sI[fr * 32 + r] = 127 - (int)(__float_as_uint(va[r]) & 127u); sI[fr * 32 + 16 + r] = 127 - (int)(__float_as_uint(vb[r]) & 127u); } }
#pragma unroll
        for (int r = 0; r < 16; ++r) { va[r] = __uint_as_float(__float_as_uint(va[r]) & 0xFFFFFF80u); vb[r] = __uint_as_float(__float_as_uint(vb[r]) & 0xFFFFFF80u); }
        float cs[13];
        {
            cs[0] = fq == 0 ? pkf(va[0] + vb[0], 255u) : fq == 1 ? pkf(va[0] + vb[1], 254u) : fq == 2 ? pkf(va[0] + vb[2], 253u) : pkf(va[0] + vb[3], 252u);
            cs[1] = fq == 0 ? pkf(va[0] + vb[4], 251u) : fq == 1 ? pkf(va[0] + vb[5], 250u) : fq == 2 ? pkf(va[0] + vb[6], 249u) : pkf(va[0] + vb[7], 248u);
            cs[2] = fq == 0 ? pkf(va[0] + vb[8], 247u) : fq == 1 ? pkf(va[0] + vb[9], 246u) : fq == 2 ? pkf(va[0] + vb[10], 245u) : pkf(va[0] + vb[11], 244u);
            cs[3] = fq == 0 ? pkf(va[0] + vb[12], 243u) : fq == 1 ? pkf(va[0] + vb[13], 242u) : fq == 2 ? pkf(va[0] + vb[14], 241u) : pkf(va[0] + vb[15], 240u);
            cs[4] = fq == 0 ? pkf(va[1] + vb[0], 239u) : fq == 1 ? pkf(va[1] + vb[1], 238u) : fq == 2 ? pkf(va[1] + vb[2], 237u) : pkf(va[1] + vb[3], 236u);
            cs[5] = fq == 0 ? pkf(va[1] + vb[4], 235u) : fq == 1 ? pkf(va[1] + vb[5], 234u) : fq == 2 ? pkf(va[1] + vb[6], 233u) : pkf(va[1] + vb[7], 232u);
            cs[6] = fq == 0 ? pkf(va[2] + vb[0], 223u) : fq == 1 ? pkf(va[2] + vb[1], 222u) : fq == 2 ? pkf(va[2] + vb[2], 221u) : pkf(va[2] + vb[3], 220u);
            cs[7] = fq == 0 ? pkf(va[2] + vb[4], 219u) : fq == 1 ? pkf(va[3] + vb[0], 207u) : fq == 2 ? pkf(va[3] + vb[1], 206u) : pkf(va[3] + vb[2], 205u);
            cs[8] = fq == 0 ? pkf(va[3] + vb[3], 204u) : fq == 1 ? pkf(va[4] + vb[0], 191u) : fq == 2 ? pkf(va[4] + vb[1], 190u) : pkf(va[4] + vb[2], 189u);
            cs[9] = fq == 0 ? pkf(va[5] + vb[0], 175u) : fq == 1 ? pkf(va[5] + vb[1], 174u) : fq == 2 ? pkf(va[6] + vb[0], 159u) : pkf(va[6] + vb[1], 158u);
            cs[10] = fq == 0 ? pkf(va[7] + vb[0], 143u) : fq == 1 ? pkf(va[7] + vb[1], 142u) : fq == 2 ? pkf(va[8] + vb[0], 127u) : pkf(va[9] + vb[0], 111u);
            cs[11] = fq == 0 ? pkf(va[10] + vb[0], 95u) : fq == 1 ? pkf(va[11] + vb[0], 79u) : fq == 2 ? pkf(va[12] + vb[0], 63u) : pkf(va[13] + vb[0], 47u);
            cs[12] = fq == 0 ? pkf(va[14] + vb[0], 31u) : fq == 1 ? pkf(va[15] + vb[0], 15u) : fq == 2 ? -INFINITY : -INFINITY;
        }
        __builtin_amdgcn_sched_barrier(0);
        float bv[16];
#pragma unroll
        for (int rd = 0; rd < 16; ++rd) { float mx = cs[0];
#pragma unroll
            for (int j = 1; j < 13; ++j) mx = fmaxf(mx, cs[j]);
            mx = fmaxf(mx, __shfl_xor(mx, 16)); mx = fmaxf(mx, __shfl_xor(mx, 32));
#pragma unroll
            for (int j = 0; j < 13; ++j) cs[j] = (cs[j] == mx) ? -INFINITY : cs[j];
            bv[rd] = mx; }
        asm volatile("s_waitcnt lgkmcnt(0)" ::: "memory"); __builtin_amdgcn_sched_barrier(0);
        if (fq == 0) { int eid[16]; float ex[16]; float sm = 0.f; const float b0 = __uint_as_float(__float_as_uint(bv[0]) & 0xFFFFFF00u);
#pragma unroll
            for (int r = 0; r < 16; ++r) { const unsigned bits = __float_as_uint(bv[r]); const int f = 255 - (int)(bits & 255u); eid[r] = sI[fr * 32 + (f >> 4)] * 128 + sI[fr * 32 + 16 + (f & 15)];
                ex[r] = __expf(__uint_as_float(bits & 0xFFFFFF00u) - b0); sm += ex[r]; }
            const float inv = 1.f / sm; int* ep = EID + m * 128 + h * 16; float* gp = EG + m * 128 + h * 16;
#pragma unroll
            for (int r = 0; r < 16; r += 4) { *(int4*)(ep + r) = make_int4(eid[r], eid[r + 1], eid[r + 2], eid[r + 3]); *(f32x4*)(gp + r) = (f32x4){ex[r] * inv, ex[r + 1] * inv, ex[r + 2] * inv, ex[r + 3] * inv}; } }
        asm volatile("s_waitcnt lgkmcnt(0)" ::: "memory");
    }
}
typedef float f32x2_t __attribute__((ext_vector_type(2)));
__device__ __forceinline__ void dec8(const u32x4 w, float (&f)[16]) {
    const unsigned ww[4] = {w.x, w.y, w.z, w.w};
#pragma unroll
    for (int q = 0; q < 4; ++q) { const f32x2_t lo = __builtin_amdgcn_cvt_pk_f32_fp8((int)ww[q], false), hi = __builtin_amdgcn_cvt_pk_f32_fp8((int)ww[q], true); f[4 * q] = lo.x; f[4 * q + 1] = lo.y; f[4 * q + 2] = hi.x; f[4 * q + 3] = hi.y; }
}
__device__ __forceinline__ void ph_peer_experts(const Args& a, int l, unsigned char* lds, int wv) {
    unsigned char* ws = oport(a.ws); const int tid = otid(wv), lane = tid & 63, wave = __builtin_amdgcn_readfirstlane(tid >> 6), gw = blockIdx.x * NWAVE + wave, ngw = gridDim.x * NWAVE;
    const bf16_t* H16 = (const bf16_t*)(ws + WS_H16); const int* EID = (const int*)(ws + WS_EID); const float* EG = (const float*)(ws + WS_EG);
    const unsigned char* U8 = (const unsigned char*)(ws + WS_U16); const unsigned char* V8 = (const unsigned char*)(ws + WS_V16);
    float* sP = (float*)(lds + wave * 4096) + lane;
    for (int m = gw; m < M; m += ngw) {
        float hv[16];
        { const u32x4 h0 = *(const u32x4*)(H16 + (size_t)m * D + lane * 16), h1 = *(const u32x4*)(H16 + (size_t)m * D + lane * 16 + 8);
          hv[0] = lo_bf(h0.x); hv[1] = hi_bf(h0.x); hv[2] = lo_bf(h0.y); hv[3] = hi_bf(h0.y); hv[4] = lo_bf(h0.z); hv[5] = hi_bf(h0.z); hv[6] = lo_bf(h0.w); hv[7] = hi_bf(h0.w);
          hv[8] = lo_bf(h1.x); hv[9] = hi_bf(h1.x); hv[10] = lo_bf(h1.y); hv[11] = hi_bf(h1.y); hv[12] = lo_bf(h1.z); hv[13] = hi_bf(h1.z); hv[14] = lo_bf(h1.w); hv[15] = hi_bf(h1.w); }
        float acc[16];
#pragma unroll
        for (int j = 0; j < 16; ++j) acc[j] = 0.f;
#pragma unroll 1
        for (int half = 0; half < 2; ++half) {
            const int ev = EID[(size_t)m * 128 + half * 64 + lane]; const float gv = EG[(size_t)m * 128 + half * 64 + lane];
            u32x4 cur[4], nxt[4];
#define ROWLD(dst, T, e_) dst = ((const u32x4*)(T + (size_t)(e_) * D))[lane]
#define BF2(a_, b_, o) (((lane & (o)) ? (b_) : (a_)) + __shfl_xor((lane & (o)) ? (a_) : (b_), (o)))
            ROWLD(cur[0], U8, __builtin_amdgcn_readlane(ev, 0)); ROWLD(cur[1], U8, __builtin_amdgcn_readlane(ev, 32)); ROWLD(cur[2], U8, __builtin_amdgcn_readlane(ev, 16)); ROWLD(cur[3], U8, __builtin_amdgcn_readlane(ev, 48));
#pragma unroll 1
            for (int g = 0; g < 16; ++g) { const int gn = g < 15 ? g + 1 : 15;
                ROWLD(nxt[0], U8, __builtin_amdgcn_readlane(ev, gn)); ROWLD(nxt[1], U8, __builtin_amdgcn_readlane(ev, gn + 32)); ROWLD(nxt[2], U8, __builtin_amdgcn_readlane(ev, gn + 16)); ROWLD(nxt[3], U8, __builtin_amdgcn_readlane(ev, gn + 48));
                float d4[4];
#pragma unroll
                for (int i = 0; i < 4; ++i) { float f[16]; dec8(cur[i], f); float d = 0.f;
#pragma unroll
                    for (int j = 0; j < 16; ++j) d += hv[j] * f[j];
                    d4[i] = d; }
                const float q0 = BF2(d4[0], d4[1], 32), q1 = BF2(d4[2], d4[3], 32); sP[g * 64] = BF2(q0, q1, 16);
#pragma unroll
                for (int i = 0; i < 4; ++i) cur[i] = nxt[i]; }
            float p[16];
#pragma unroll
            for (int i = 0; i < 16; ++i) p[i] = sP[i * 64];
#define BFLY(o, n) do { const bool up_ = (lane & (o)) != 0; _Pragma("unroll") for (int i_ = 0; i_ < (n); ++i_) { const float a_ = p[i_], b_ = p[i_ + (n)]; const float sd_ = up_ ? a_ : b_, kp_ = up_ ? b_ : a_; p[i_] = kp_ + __shfl_xor(sd_, (o)); } } while (0)
            BFLY(8, 8); BFLY(4, 4); BFLY(2, 2); BFLY(1, 1);
            const int svb = __builtin_bit_cast(int, gv * gelu_t(p[0] * (1.f / 256.f)) * (1.f / 64.f));
            ROWLD(cur[0], V8, __builtin_amdgcn_readlane(ev, 0)); ROWLD(cur[1], V8, __builtin_amdgcn_readlane(ev, 1)); ROWLD(cur[2], V8, __builtin_amdgcn_readlane(ev, 2)); ROWLD(cur[3], V8, __builtin_amdgcn_readlane(ev, 3));
#pragma unroll 1
            for (int g = 0; g < 16; ++g) { const int gn = g < 15 ? g + 1 : 15;
#pragma unroll
                for (int i = 0; i < 4; ++i) ROWLD(nxt[i], V8, __builtin_amdgcn_readlane(ev, 4 * gn + i));
#pragma unroll
                for (int i = 0; i < 4; ++i) { const float sk = __builtin_bit_cast(float, __builtin_amdgcn_readlane(svb, 4 * g + i)); float f[16]; dec8(cur[i], f);
#pragma unroll
                    for (int j = 0; j < 16; ++j) acc[j] += sk * f[j]; }
#pragma unroll
                for (int i = 0; i < 4; ++i) cur[i] = nxt[i]; }
#undef ROWLD
#undef BF2
#undef BFLY
        }
        float* xr = a.out + (size_t)m * D + lane * 16; float xn[16]; float ss = 0.f;
#pragma unroll
        for (int j = 0; j < 4; ++j) { const f32x4 xv = *(const f32x4*)(xr + 4 * j); xn[4 * j] = xv.x + acc[4 * j]; xn[4 * j + 1] = xv.y + acc[4 * j + 1]; xn[4 * j + 2] = xv.z + acc[4 * j + 2]; xn[4 * j + 3] = xv.w + acc[4 * j + 3]; }
#pragma unroll
        for (int j = 0; j < 16; ++j) ss += xn[j] * xn[j];
        const float r = rsqrtf(wave_sum(ss) * (1.f / D) + EPS);
        if (l + 1 < DEPTH) { const float* gn = a.norm1 + (size_t)(l + 1) * D + lane * 16;
#pragma unroll
            for (int j = 0; j < 4; ++j) *(f32x4*)(xr + 4 * j) = (f32x4){xn[4 * j], xn[4 * j + 1], xn[4 * j + 2], xn[4 * j + 3]};
            u32x4 w0, w1;
            w0.x = pk2(xn[0] * r * gn[0], xn[1] * r * gn[1]); w0.y = pk2(xn[2] * r * gn[2], xn[3] * r * gn[3]); w0.z = pk2(xn[4] * r * gn[4], xn[5] * r * gn[5]); w0.w = pk2(xn[6] * r * gn[6], xn[7] * r * gn[7]);
            w1.x = pk2(xn[8] * r * gn[8], xn[9] * r * gn[9]); w1.y = pk2(xn[10] * r * gn[10], xn[11] * r * gn[11]); w1.z = pk2(xn[12] * r * gn[12], xn[13] * r * gn[13]); w1.w = pk2(xn[14] * r * gn[14], xn[15] * r * gn[15]);
            *(u32x4*)((bf16_t*)(ws + WS_H16) + (size_t)m * D + lane * 16) = w0; *(u32x4*)((bf16_t*)(ws + WS_H16) + (size_t)m * D + lane * 16 + 8) = w1;
        } else { const float* gn = a.final_gain + lane * 16;
#pragma unroll
            for (int j = 0; j < 4; ++j) *(f32x4*)(xr + 4 * j) = (f32x4){xn[4 * j] * r * gn[4 * j], xn[4 * j + 1] * r * gn[4 * j + 1], xn[4 * j + 2] * r * gn[4 * j + 2], xn[4 * j + 3] * r * gn[4 * j + 3]}; }
    }
}

constexpr int PH_PER_LAYER = 9, N_PHASES = 1 + DEPTH * PH_PER_LAYER;
__global__ void __launch_bounds__(NTHR, 2) fwd_kernel(Args a) {
    extern __shared__ __attribute__((aligned(16))) unsigned char lds[];
    const int wv = __builtin_amdgcn_readfirstlane((int)threadIdx.x >> 6);
    const int tid = threadIdx.x;
    for (int u = tid; u < (LDS_BYTES - LDS_CTL_OFF) / 4; u += NTHR) ((unsigned*)(lds + LDS_CTL_OFF))[u] = 0u;
    __syncthreads();
    unsigned* ctl = (unsigned*)(a.ws + WS_CTL);
    XcdBarrier bar = xcd_barrier_post(ctl + 4096, (volatile LAS unsigned*)(LAS unsigned char*)(lds + LDS_CTL_OFF), wv);
    const int lo = a.ph_lo, hi = a.ph_hi;
#define IN(k) (lo <= (k) && (k) < hi)
#define SEAM(k) do { if (IN(k) && IN((k) + 1)) xcd_barrier(bar, wv); } while (0)
    unsigned char* ws = oport(a.ws);
    if (IN(0)) { ph_prologue(a, lds, wv); } SEAM(0);
    for (int l = 0; l < DEPTH; ++l) {
        const int pb = 1 + l * PH_PER_LAYER;
        if (IN(pb + 0)) {
            ph_kiwi(a, l, wv);
            pg8::Gemm g{(const bf16_t*)(ws + WS_H16), (const bf16_t*)(ws + WS_WIN + (size_t)l * WIN_L), M, NMAIN, D, 0, 0};
            pg8::StaticOrder S; S.init(M, NMAIN, gridDim.x, blockIdx.x, 0);
            pg8::EpiIn E{(bf16_t*)(ws + WS_P16), (float*)(ws + WS_PF)};
            pg8::gemm_phase(((LAS unsigned char*)lds), g, S, E, wv);
        } SEAM(pb + 0);
        if (IN(pb + 1)) { ph_post(a, l, lds, wv); ph_h1(a, l, lds, wv); } SEAM(pb + 1);
        if (IN(pb + 2)) { ph_h2(a, wv); ph_gmlp(a, l, lds, wv); ph_sel(a, lds, wv); } SEAM(pb + 2);
        if (IN(pb + 3)) { ph_attn(a, lds, wv); ph_h3(a, l, lds, wv); } SEAM(pb + 3);
        if (IN(pb + 4)) {
            pg8::Gemm g{(const bf16_t*)(ws + WS_YALL), (const bf16_t*)(ws + WS_WBR + (size_t)l * WBR_L), M, 3072, 512, (size_t)M * 512 * 2, 4};
            pg8::BranchOrder S; S.init(gridDim.x, blockIdx.x);
            pg8::EpiGate E{(bf16_t*)(ws + WS_GB), (const bf16_t*)(ws + WS_P16)};
            pg8::gemm_phase(((LAS unsigned char*)lds), g, S, E, wv);
        } SEAM(pb + 4);
        if (IN(pb + 5)) {
            pg8::Gemm g{(const bf16_t*)(ws + WS_GB), (const bf16_t*)(ws + WS_WOUT + (size_t)l * WOUT_L), M, D, D, 0, 0};
            pg8::StaticOrder S; S.init(M, D, gridDim.x, blockIdx.x, 0);
            pg8::EpiRes E{a.out};
            pg8::gemm_phase(((LAS unsigned char*)lds), g, S, E, wv);
        } SEAM(pb + 5);
        if (IN(pb + 6)) { ph_norm2(a, l, wv); } SEAM(pb + 6);
        if (IN(pb + 7)) {
            pg8::Gemm g{(const bf16_t*)(ws + WS_H16), (const bf16_t*)(ws + WS_WPQ + (size_t)l * WPQ_L), M, 2048, D, 0, 0};
            pg8::StaticOrder S; S.init(M, 2048, gridDim.x, blockIdx.x, 0);
            pg8::EpiB16 E{(bf16_t*)(ws + WS_GB), 2048};
            pg8::gemm_phase(((LAS unsigned char*)lds), g, S, E, wv);
            asm volatile("s_waitcnt vmcnt(0)" ::: "memory"); __syncthreads();
            for (int i0_ = 0;; i0_ += 2) { pg8::Unit u0, u1; if (!S.next(i0_, u0)) break; const bool two = S.next(i0_ + 1, u1);
                ph_peer_select(a, l, lds, wv, two ? 2 : 1, u0.pm, u0.pn, two ? u1.pm : 0, two ? u1.pn : 0); }
        } SEAM(pb + 7);
        if (IN(pb + 8)) { ph_peer_experts(a, l, lds, wv); } SEAM(pb + 8);
    }
#undef IN
#undef SEAM
}

#ifndef MK_N_LAUNCHES
#define MK_N_LAUNCHES 1
#endif
extern "C" void kernel_launch(void* const* d_in, const int* in_sizes, int n_in, void* d_out, int out_size, void* d_ws, size_t ws_size, hipStream_t stream) {
    static int grid = 0;
    if (grid == 0) {
        if (n_in != 17 || out_size != M * D || ws_size < WS_END) { fprintf(stderr, "kernel_launch: unexpected shapes (n_in %d, out %d, ws %zu)\n", n_in, out_size, ws_size); grid = -1; return; }
        int dev = 0, cus = 0, per_cu = 0;
        if (hipGetDevice(&dev) != hipSuccess || hipDeviceGetAttribute(&cus, hipDeviceAttributeMultiprocessorCount, dev) != hipSuccess) { grid = -1; return; }
        if (hipFuncSetAttribute((const void*)fwd_kernel, hipFuncAttributeMaxDynamicSharedMemorySize, LDS_BYTES) != hipSuccess) { fprintf(stderr, "kernel_launch: hipFuncSetAttribute failed\n"); grid = -1; return; }
        if (hipOccupancyMaxActiveBlocksPerMultiprocessor(&per_cu, (const void*)fwd_kernel, NTHR, LDS_BYTES) != hipSuccess || per_cu < 1) { fprintf(stderr, "kernel_launch: occupancy query says %d\n", per_cu); (void)hipGetLastError(); grid = -1; return; }
        grid = cus;
    }
    if (grid < 0) return;
    (void)hipMemsetAsync((char*)d_ws + WS_CTL, 0, CTL_BYTES, stream);
    Args a{};
    a.x = (const float*)d_in[0]; a.pos = (const int*)d_in[1]; a.norm1 = (const float*)d_in[2]; a.w_in = (const float*)d_in[3]; a.lb_logits = (const float*)d_in[4]; a.hgrn_gain = (const float*)d_in[5];
    a.gmlp_gain = (const float*)d_in[6]; a.gmlp_ws = (const float*)d_in[7]; a.gmlp_bs = (const float*)d_in[8]; a.w_branch = (const float*)d_in[9]; a.w_out = (const float*)d_in[10]; a.norm2 = (const float*)d_in[11];
    a.peer_wq = (const float*)d_in[12]; a.peer_keys = (const float*)d_in[13]; a.peer_u = (const float*)d_in[14]; a.peer_v = (const float*)d_in[15]; a.final_gain = (const float*)d_in[16];
    a.out = (float*)d_out; a.ws = (unsigned char*)d_ws;
    if (MK_N_LAUNCHES == 1) { a.ph_lo = 0; a.ph_hi = N_PHASES; hipLaunchKernelGGL(fwd_kernel, dim3(grid), dim3(NTHR), LDS_BYTES, stream, a); }
    else for (int p = 0; p < N_PHASES; ++p) { a.ph_lo = p; a.ph_hi = p + 1; hipLaunchKernelGGL(fwd_kernel, dim3(grid), dim3(NTHR), LDS_BYTES, stream, a); }
}
```

```cpp
#include <hip/hip_runtime.h>
#include <cstdio>
#include <cstdint>

#define LAS __attribute__((address_space(3)))
typedef unsigned short bf16_t;
typedef short bf16x8 __attribute__((ext_vector_type(8)));
typedef float f32x4 __attribute__((ext_vector_type(4)));
typedef unsigned u32x4 __attribute__((ext_vector_type(4)));

constexpr int D = 1024, BATCH = 2, SEQ = 8192, DEPTH = 4, M = BATCH * SEQ;
constexpr int NIN = 8264;
constexpr int NPAD = 8448;
constexpr int C_AQ = 0, C_AF = 512, C_AI = 1024, C_AG = 1536, C_BU = 2048, C_BV = 2560, C_CQ = 3072, C_CK = 3584, C_CV = 4096, C_QI = 4608, C_GL = 5120, C_KI = 8192, C_WI = 8256;
constexpr int NMAIN = 8192;
constexpr int S_GL = 5192;
constexpr int PFW = 768;
constexpr float EPS = 1e-6f;
constexpr int NEXP = 16384;

constexpr size_t MiB = 1u << 20;
constexpr size_t WS_CTL = 0, CTL_BYTES = 1 * MiB;
constexpr size_t WS_WIN = 2 * MiB;
constexpr size_t WIN_L = (size_t)NPAD * D * 2;
constexpr size_t WS_WBR = 68 * MiB;
constexpr size_t WBR_L = (size_t)3072 * 512 * 2;
constexpr size_t WS_WOUT = 80 * MiB;
constexpr size_t WOUT_L = (size_t)1024 * 3072 * 2;
constexpr size_t WS_WPQ = 104 * MiB;
constexpr size_t WPQ_L = (size_t)2048 * 1024 * 2;
constexpr size_t WS_LB = 120 * MiB;
constexpr size_t WS_CS = 121 * MiB;
constexpr size_t WS_H16 = 134 * MiB;
constexpr size_t WS_P16 = 166 * MiB;
constexpr size_t WS_PF = 430 * MiB;
constexpr size_t WS_QR = 478 * MiB, WS_KR = 494 * MiB;
constexpr size_t WS_QI = 510 * MiB;
constexpr size_t WS_KI = 542 * MiB;
constexpr size_t WS_WI = 546 * MiB;
constexpr size_t WS_FF = 548 * MiB, WS_KK = 580 * MiB, WS_QF = 612 * MiB;
constexpr size_t WS_OA = 644 * MiB;
constexpr size_t WS_VN = 676 * MiB;
constexpr size_t WS_YALL = 708 * MiB;
constexpr size_t WS_GB = 756 * MiB;
constexpr size_t WS_EID = 852 * MiB, WS_EG = 860 * MiB;
constexpr size_t WS_DD = 120 * MiB + 256 * 1024;
constexpr size_t WS_WSB = 544 * MiB;
constexpr size_t WS_VT = 644 * MiB;
constexpr size_t WS_MASK = 660 * MiB;
constexpr size_t WS_U16 = 868 * MiB, WS_V16 = 900 * MiB;
constexpr size_t WS_SKB = 932 * MiB;
constexpr size_t WS_END = 934 * MiB;

__device__ const float ROPE_INV64[64] = {
1.000000000e+00f, 8.659643531e-01f, 7.498942614e-01f, 6.493816376e-01f, 5.623413324e-01f, 4.869675338e-01f, 4.216965139e-01f, 3.651741147e-01f, 3.162277639e-01f, 2.738419771e-01f, 2.371373773e-01f, 2.053525001e-01f, 1.778279394e-01f, 1.539926529e-01f, 1.333521307e-01f, 1.154782027e-01f, 1.000000015e-01f, 8.659642935e-02f, 7.498941571e-02f, 6.493816525e-02f, 5.623413250e-02f, 4.869675264e-02f, 4.216965288e-02f, 3.651741147e-02f, 3.162277490e-02f, 2.738419734e-02f, 2.371373773e-02f, 2.053525113e-02f, 1.778279431e-02f, 1.539926510e-02f, 1.333521493e-02f, 1.154782064e-02f, 9.999999776e-03f, 8.659643121e-03f, 7.498941850e-03f, 6.493816152e-03f, 5.623413250e-03f, 4.869675264e-03f, 4.216964822e-03f, 3.651741194e-03f, 3.162277630e-03f, 2.738419687e-03f, 2.371373586e-03f, 2.053524833e-03f, 1.778279431e-03f, 1.539926510e-03f, 1.333521446e-03f, 1.154781901e-03f, 1.000000047e-03f, 8.659643354e-04f, 7.498942432e-04f, 6.493816618e-04f, 5.623413017e-04f, 4.869675322e-04f, 4.216965172e-04f, 3.651741426e-04f, 3.162277571e-04f, 2.738419571e-04f, 2.371373703e-04f, 2.053525095e-04f, 1.778279402e-04f, 1.539926452e-04f, 1.333521504e-04f, 1.154782003e-04f};
__device__ const float ROPE_INV32[32] = {
1.000000000e+00f, 7.498942614e-01f, 5.623413324e-01f, 4.216965139e-01f, 3.162277639e-01f, 2.371373773e-01f, 1.778279394e-01f, 1.333521307e-01f, 1.000000015e-01f, 7.498941571e-02f, 5.623413250e-02f, 4.216965288e-02f, 3.162277490e-02f, 2.371373773e-02f, 1.778279431e-02f, 1.333521493e-02f, 9.999999776e-03f, 7.498941850e-03f, 5.623413250e-03f, 4.216964822e-03f, 3.162277630e-03f, 2.371373586e-03f, 1.778279431e-03f, 1.333521446e-03f, 1.000000047e-03f, 7.498942432e-04f, 5.623413017e-04f, 4.216965172e-04f, 3.162277571e-04f, 2.371373703e-04f, 1.778279402e-04f, 1.333521504e-04f};

__device__ __forceinline__ float bf2f(bf16_t b) { return __uint_as_float(((unsigned)b) << 16); }
__device__ __forceinline__ unsigned f2bf(float f) { unsigned u = __float_as_uint(f); return (u + 0x7fffu + ((u >> 16) & 1u)) >> 16; }
__device__ __forceinline__ unsigned pk2(float lo, float hi) { return f2bf(lo) | (f2bf(hi) << 16); }
__device__ __forceinline__ float lo_bf(unsigned w) { return __uint_as_float(w << 16); }
__device__ __forceinline__ float hi_bf(unsigned w) { return __uint_as_float(w & 0xffff0000u); }
__device__ __forceinline__ float sigm(float x) { return 1.f / (1.f + __expf(-x)); }
__device__ __forceinline__ float silu(float x) { return x * sigm(x); }
__device__ __forceinline__ float gelu_t(float x) { const float u = 0.7978845608028654f * (x + 0.044715f * x * x * x); const float th = 1.f - 2.f / (1.f + __expf(2.f * u)); return 0.5f * x * (1.f + th); }
__device__ __forceinline__ float wave_sum(float v) {
#pragma unroll
    for (int o = 1; o < 64; o <<= 1) v += __shfl_xor(v, o);
    return v;
}
__device__ __forceinline__ float wave_max(float v) {
#pragma unroll
    for (int o = 1; o < 64; o <<= 1) v = fmaxf(v, __shfl_xor(v, o));
    return v;
}
typedef __bf16 bf2_t __attribute__((ext_vector_type(2)));
__device__ __forceinline__ float dot2(unsigned a, unsigned b, float c) { return __builtin_amdgcn_fdot2_f32_bf16(__builtin_bit_cast(bf2_t, a), __builtin_bit_cast(bf2_t, b), c, false); }
__device__ __forceinline__ int otid(int wv) { int t; asm volatile("v_mbcnt_lo_u32_b32 %0, -1, 0\n\tv_mbcnt_hi_u32_b32 %0, -1, %0" : "=v"(t)); return wv * 64 + t; }
__device__ __forceinline__ unsigned char* oport(unsigned char* p) { unsigned long long z; asm volatile("s_mov_b64 %0, 0" : "=s"(z)); return p + z; }
__device__ __forceinline__ unsigned fkey(float f) { const unsigned u = __float_as_uint(f); return u ^ ((u >> 31) ? 0xFFFFFFFFu : 0x80000000u); }

#define XB_TMO      128
#define XB_XCNT(j)  (256  + 64 * (j))
#define XB_XSUB(j)  (1280 + 64 * (j))
#define XB_XGEN(j)  (2304 + 64 * (j))
#define XB_TOP      3328
#define XB_TOPGEN   3392
#define XCD_BAR_WORDS 3456
#define XB_SPIN_CAP (1u << 23)
__device__ __forceinline__ unsigned xb_ld(unsigned* p)              { return __hip_atomic_load(p, __ATOMIC_RELAXED, __HIP_MEMORY_SCOPE_AGENT); }
__device__ __forceinline__ unsigned xb_add(unsigned* p, unsigned v) { return __hip_atomic_fetch_add(p, v, __ATOMIC_RELAXED, __HIP_MEMORY_SCOPE_AGENT); }
__device__ __forceinline__ unsigned xb_xcc_id() { return (unsigned)__builtin_amdgcn_s_getreg((3 << 11) | 20) & 0xFu; }
#define XB_SPIN(cond, bar) do { unsigned _sp = 0; while (cond) { __builtin_amdgcn_s_sleep(1); \
    if ((++_sp & 255u) == 0u) { if (xb_ld(&(bar)[XB_TMO])) break; if (_sp > XB_SPIN_CAP) { atomicAdd(&(bar)[XB_TMO], 1u); break; } } } } while (0)
struct XcdBarrier { unsigned* bar; unsigned x; volatile LAS unsigned* st; };
__device__ __forceinline__ XcdBarrier xcd_barrier_post(unsigned* bar, volatile LAS unsigned* st, int wv) {
    XcdBarrier b; b.bar = bar; b.x = xb_xcc_id(); b.st = st;
    if (otid(wv) == 0) (void)xb_add(&bar[XB_XCNT(b.x)], 1u);
    return b;
}
__device__ __forceinline__ void xcd_barrier_complete(unsigned* bar, unsigned x, unsigned& nloc, unsigned& nx) {
    const unsigned G = gridDim.x * gridDim.y * gridDim.z;
    unsigned sum, cnt, mine, sp = 0u;
    for (;;) {
        sum = 0u; cnt = 0u; mine = 0u;
#pragma unroll
        for (unsigned j = 0; j < 16; ++j) { const unsigned c = xb_ld(&bar[XB_XCNT(j)]); sum += c; cnt += (c > 0u) ? 1u : 0u; mine = (j == x) ? c : mine; }
        if (sum == G) break;
        __builtin_amdgcn_s_sleep(1);
        if ((++sp & 255u) == 0u) { if (xb_ld(&bar[XB_TMO])) break; if (sp > XB_SPIN_CAP) { atomicAdd(&bar[XB_TMO], 1u); break; } }
    }
    nloc = mine > 0u ? mine : 1u; nx = cnt > 0u ? cnt : 1u;
}
__device__ __forceinline__ void xcd_barrier(const XcdBarrier& b, int wv) {
    asm volatile("s_waitcnt vmcnt(0)" ::: "memory");
    __syncthreads();
    if (otid(wv) == 0) {
        unsigned* bar = b.bar;
        __builtin_amdgcn_s_waitcnt(0);
        unsigned nloc = b.st[0], nx = b.st[1];
        if (nloc == 0u) { xcd_barrier_complete(bar, b.x, nloc, nx); b.st[0] = nloc; b.st[1] = nx; }
        const unsigned old = xb_add(&bar[XB_XSUB(b.x)], 1u);
        const unsigned gen = old / nloc;
        if (old + 1u == (gen + 1u) * nloc) {
            __builtin_amdgcn_fence(__ATOMIC_RELEASE, "agent");
            asm volatile("s_waitcnt vmcnt(0)" ::: "memory");
            const unsigned og = xb_add(&bar[XB_TOP], 1u);
            const unsigned tg = og / nx;
            if (og + 1u == (tg + 1u) * nx) xb_add(&bar[XB_TOPGEN], 1u);
            else XB_SPIN(xb_ld(&bar[XB_TOPGEN]) == tg, bar);
            __builtin_amdgcn_fence(__ATOMIC_ACQUIRE, "agent");
            xb_add(&bar[XB_XGEN(b.x)], 1u);
            asm volatile("s_waitcnt vmcnt(0)" ::: "memory");
        } else {
            XB_SPIN(xb_ld(&bar[XB_XGEN(b.x)]) == gen, bar);
            __builtin_amdgcn_fence(__ATOMIC_ACQUIRE, "agent");
            asm volatile("s_waitcnt vmcnt(0)" ::: "memory");
        }
    }
    __syncthreads();
}

namespace pg8 {
constexpr int BM = 256, BK = 64, HALF = 128, HTB = HALF * BK * 2, STAGE_BYTES = 8 * HTB, NXCD = 8, WGM = 8;
__host__ __device__ __forceinline__ int lds_byte(int r, int c) { const int st = (r >> 4) * 2 + (c >> 5), rr = r & 15, cc = c & 31, ob = rr * 64 + cc * 2; return st * 1024 + (ob ^ (((ob >> 9) & 1) << 5)); }
__host__ __device__ __forceinline__ void stage_rc(int b, int& R, int& C) { const int st = b / 1024, sb = b % 1024, swz = sb ^ (((sb >> 9) & 1) << 5); R = (st >> 1) * 16 + swz / 64; C = (st & 1) * 32 + (swz % 64) / 2; }
__host__ __device__ __forceinline__ int perm32(int rho) { const int n = rho >> 4, i = rho & 15; return 8 * (i >> 2) + 4 * n + (i & 3); }
struct Unit { int pm, pn, ka; };
struct Gemm { const bf16_t* A; const bf16_t* Bt; int M, N, K; size_t strideA; int nsplit; };
struct StaticOrder {
    int nM, nN, nwg, G, c, nsplit;
    __device__ __forceinline__ void init(int M_, int N_, int G_, int c_, int nsplit_) { nM = M_ / BM; nN = N_ / BM; nwg = nM * nN; G = G_; c = c_; nsplit = nsplit_; }
    __device__ __forceinline__ bool next(int i, Unit& u) const {
        const long L = (long)i * G + c; if (L >= nwg) return false;
        int wgid = (int)L; { const int q = nwg / NXCD, r = nwg % NXCD, xcd = wgid % NXCD, off = wgid / NXCD; wgid = (xcd < r ? xcd * (q + 1) : r * (q + 1) + (xcd - r) * q) + off; }
        const int nig = WGM * nN, gid = wgid / nig, fm = gid * WGM, gsz = (nM - fm) < WGM ? (nM - fm) : WGM;
        u.pm = fm + ((wgid % nig) % gsz); u.pn = (wgid % nig) / gsz; u.ka = nsplit ? u.pn / nsplit : 0; return true;
    }
};
__device__ __forceinline__ unsigned cvt_pk_bf16(float lo, float hi) { unsigned r; asm volatile("v_cvt_pk_bf16_f32 %0, %1, %2" : "=v"(r) : "v"(lo), "v"(hi)); return r; }

template <class Epi, class Sched>
__device__ __forceinline__ void gemm_phase(LAS unsigned char* lds, const Gemm g, const Sched& S, const Epi& E, int wv) {
    const int tid = otid(wv), wid = __builtin_amdgcn_readfirstlane(tid >> 6), lane = tid & 63, wr = wid >> 2, wc = wid & 3, fr = lane & 15, fq = lane >> 4;
    const int K = g.K, nt = K / BK;
    unsigned voffA[2], voffB[2];
#pragma unroll
    for (int i = 0; i < 2; ++i) { int R, C; stage_rc(tid * 16 + i * 8192, R, C); const int Rb = Epi::PERM ? ((R & ~31) + perm32(R & 31)) : R;
        voffA[i] = (unsigned)(R * K + C) * 2u; voffB[i] = (unsigned)(Rb * K + C) * 2u; }
    const size_t kstep = (size_t)(BK * 2);
    const size_t hstep = (size_t)HALF * K * 2;
    const size_t tstep = 2 * hstep;
    const unsigned ldsw = (unsigned)wid * 1024u;
    const int aoff = lds_byte(wr * 64 + fr, fq * 8), boff = lds_byte(wc * 32 + fr, fq * 8);
#define PG8_SA(b, h) (((b) * 2 + (h)) * HTB)
#define PG8_SB(b, h) ((4 + (b) * 2 + (h)) * HTB)
#define PG8_STAGE(bufoff, gbase, voff) do { _Pragma("unroll") for (int _i = 0; _i < 2; ++_i) \
        __builtin_amdgcn_global_load_lds((const unsigned*)((const char*)(gbase) + (voff)[_i]), (LAS unsigned*)(lds + (bufoff) + ldsw + _i * 8192), 16, 0, 0); } while (0)
#define PG8_LDA(dst, b, h) do { _Pragma("unroll") for (int m = 0; m < 4; ++m) _Pragma("unroll") for (int k = 0; k < 2; ++k) dst[m][k] = *(const LAS bf16x8*)(lds + PG8_SA(b, h) + aoff + m * 2048 + k * 1024); } while (0)
#define PG8_LDB(dst, b, h) do { _Pragma("unroll") for (int n = 0; n < 2; ++n) _Pragma("unroll") for (int k = 0; k < 2; ++k) dst[n][k] = *(const LAS bf16x8*)(lds + PG8_SB(b, h) + boff + n * 2048 + k * 1024); } while (0)
#define PG8_MMA(ai, bj, At, Bt) do { __builtin_amdgcn_s_setprio(1); _Pragma("unroll") for (int m = 0; m < 4; ++m) _Pragma("unroll") for (int n = 0; n < 2; ++n) _Pragma("unroll") for (int k = 0; k < 2; ++k) \
        acc[ai][bj][m][n] = __builtin_amdgcn_mfma_f32_16x16x32_bf16(Bt[n][k], At[m][k], acc[ai][bj][m][n], 0, 0, 0); __builtin_amdgcn_s_setprio(0); } while (0)
#define PG8_WAIT_V(n) asm volatile("s_waitcnt vmcnt(" #n ")" ::: "memory")
#define PG8_WAIT_L(n) asm volatile("s_waitcnt lgkmcnt(" #n ")" ::: "memory")
#define PG8_BAR __builtin_amdgcn_s_barrier()
#define PG8_SCHED __builtin_amdgcn_sched_barrier(0)
    Unit cur, nxt; int ui = 0;
    if (!S.next(0, cur)) return;
    f32x4 acc[2][2][4][2];
#pragma unroll
    for (int a = 0; a < 2; ++a)
#pragma unroll
        for (int b = 0; b < 2; ++b)
#pragma unroll
            for (int m = 0; m < 4; ++m)
#pragma unroll
                for (int n = 0; n < 2; ++n) acc[a][b][m][n] = (f32x4){0.f, 0.f, 0.f, 0.f};
    bf16x8 At[4][2], B0[2][2], B1[2][2];
    const char* cA = (const char*)g.A + (size_t)cur.ka * g.strideA + (size_t)cur.pm * tstep; const char* cB = (const char*)g.Bt + (size_t)cur.pn * tstep;
    PG8_STAGE(PG8_SB(0, 0), cB, voffB); PG8_STAGE(PG8_SA(0, 0), cA, voffA); PG8_STAGE(PG8_SB(0, 1), cB + hstep, voffB); PG8_STAGE(PG8_SA(0, 1), cA + hstep, voffA);
    if (wr == 1) PG8_BAR;
    PG8_WAIT_V(4); PG8_BAR;
    PG8_STAGE(PG8_SB(1, 0), cB + kstep, voffB); PG8_STAGE(PG8_SA(1, 0), cA + kstep, voffA); PG8_STAGE(PG8_SB(1, 1), cB + hstep + kstep, voffB);
    PG8_WAIT_V(6); PG8_BAR;
    for (;;) {
        const bool has_next = S.next(ui + 1, nxt);
        const char* nA = has_next ? (const char*)g.A + (size_t)nxt.ka * g.strideA + (size_t)nxt.pm * tstep : cA; const char* nB = has_next ? (const char*)g.Bt + (size_t)nxt.pn * tstep : cB;
        for (int t = 0; t < nt; t += 2) {
            const bool last = (t == nt - 2);
            const char* a1 = cA + (size_t)(t + 1) * kstep;
            const char* a2 = last ? nA : cA + (size_t)(t + 2) * kstep; const char* b2 = last ? nB : cB + (size_t)(t + 2) * kstep;
            const char* a3 = a2 + kstep; const char* b3 = b2 + kstep;
            PG8_LDB(B0, 0, 0); PG8_SCHED; PG8_LDA(At, 0, 0); PG8_STAGE(PG8_SA(1, 1), a1 + hstep, voffA);
            PG8_WAIT_L(8); PG8_BAR; PG8_WAIT_L(0); PG8_MMA(0, 0, At, B0); PG8_BAR; PG8_SCHED;
            PG8_LDB(B1, 0, 1); PG8_STAGE(PG8_SB(0, 0), b2, voffB);
            PG8_BAR; PG8_WAIT_L(0); PG8_MMA(0, 1, At, B1); PG8_BAR;
            PG8_LDA(At, 0, 1); PG8_STAGE(PG8_SA(0, 0), a2, voffA);
            PG8_BAR; PG8_WAIT_L(0); PG8_MMA(1, 0, At, B0); PG8_BAR; PG8_SCHED;
            PG8_STAGE(PG8_SB(0, 1), b2 + hstep, voffB);
            PG8_WAIT_V(6); PG8_BAR; PG8_MMA(1, 1, At, B1); PG8_BAR;
            PG8_LDB(B0, 1, 0); PG8_SCHED; PG8_LDA(At, 1, 0); PG8_STAGE(PG8_SA(0, 1), a2 + hstep, voffA);
            PG8_WAIT_L(8); PG8_BAR; PG8_WAIT_L(0); PG8_MMA(0, 0, At, B0); PG8_BAR; PG8_SCHED;
            PG8_LDB(B1, 1, 1); PG8_STAGE(PG8_SB(1, 0), b3, voffB);
            PG8_BAR; PG8_WAIT_L(0); PG8_MMA(0, 1, At, B1); PG8_BAR;
            PG8_LDA(At, 1, 1); PG8_STAGE(PG8_SA(1, 0), a3, voffA);
            PG8_BAR; PG8_WAIT_L(0); PG8_MMA(1, 0, At, B0); PG8_BAR; PG8_SCHED;
            PG8_STAGE(PG8_SB(1, 1), b3 + hstep, voffB);
            PG8_WAIT_V(6); PG8_BAR; PG8_MMA(1, 1, At, B1); PG8_BAR;
        }
        E(acc, cur, wr, wc, fr, fq);
        if (!has_next) break;
        if (!E.keep(cur))
#pragma unroll
        for (int a = 0; a < 2; ++a)
#pragma unroll
            for (int b = 0; b < 2; ++b)
#pragma unroll
                for (int m = 0; m < 4; ++m)
#pragma unroll
                    for (int n = 0; n < 2; ++n) acc[a][b][m][n] = (f32x4){0.f, 0.f, 0.f, 0.f};
        cur = nxt; cA = nA; cB = nB; ++ui;
    }
    PG8_WAIT_V(0);
    if (wr == 0) PG8_BAR;
    PG8_BAR;
#undef PG8_SA
#undef PG8_SB
#undef PG8_STAGE
#undef PG8_LDA
#undef PG8_LDB
#undef PG8_MMA
#undef PG8_WAIT_V
#undef PG8_WAIT_L
#undef PG8_BAR
#undef PG8_SCHED
}

struct EpiIn {
    __device__ __forceinline__ bool keep(const Unit&) const { return false; }
    static constexpr bool PERM = true;
    bf16_t* P16; float* PF;
    __device__ __forceinline__ void operator()(f32x4 (&acc)[2][2][4][2], const Unit& u, int wr, int wc, int fr, int fq) const {
        const int row0 = u.pm * BM + wr * 64 + fr, col0 = u.pn * BM + wc * 32 + 8 * fq;
        const bool f32t = (u.pn == 2) || (u.pn == 3);
        const int pfc0 = (u.pn - 2) * 256 + wc * 32 + 8 * fq;
#pragma unroll
        for (int ai = 0; ai < 2; ++ai)
#pragma unroll
            for (int m = 0; m < 4; ++m) { const size_t row = (size_t)(row0 + ai * HALF + m * 16);
#pragma unroll
                for (int bj = 0; bj < 2; ++bj) { const f32x4 v0 = acc[ai][bj][m][0], v1 = acc[ai][bj][m][1];
                    u32x4 w; w.x = cvt_pk_bf16(v0[0], v0[1]); w.y = cvt_pk_bf16(v0[2], v0[3]); w.z = cvt_pk_bf16(v1[0], v1[1]); w.w = cvt_pk_bf16(v1[2], v1[3]);
                    *(u32x4*)(P16 + row * NPAD + col0 + bj * HALF) = w;
                    if (f32t) { float* pf = PF + row * PFW + pfc0 + bj * HALF; *(f32x4*)pf = v0; *(f32x4*)(pf + 4) = v1; } } }
    }
};
struct EpiGate {
    static constexpr bool PERM = true;
    bf16_t* GS; const bf16_t* P16;
    __device__ __forceinline__ bool keep(const Unit& u) const { return (u.pn >> 2) < 2; }
    __device__ __forceinline__ void operator()(f32x4 (&acc)[2][2][4][2], const Unit& u, int wr, int wc, int fr, int fq) const {
        const int n = u.pn >> 2, row0 = u.pm * BM + wr * 64 + fr, col0 = (u.pn & 3) * BM + wc * 32 + 8 * fq;
#pragma unroll
        for (int ai = 0; ai < 2; ++ai)
#pragma unroll
            for (int m = 0; m < 4; ++m) { const size_t row = (size_t)(row0 + ai * HALF + m * 16);
#pragma unroll
                for (int bj = 0; bj < 2; ++bj) { f32x4& v0 = acc[ai][bj][m][0]; f32x4& v1 = acc[ai][bj][m][1];
                    const u32x4 gw = *(const u32x4*)(P16 + row * NPAD + C_GL + n * 1024 + col0 + bj * HALF);
                    const float e[8] = {__expf(-lo_bf(gw.x)), __expf(-hi_bf(gw.x)), __expf(-lo_bf(gw.y)), __expf(-hi_bf(gw.y)), __expf(-lo_bf(gw.z)), __expf(-hi_bf(gw.z)), __expf(-lo_bf(gw.w)), __expf(-hi_bf(gw.w))};
                    if (n < 2) { const u32x4 hw = *(const u32x4*)(P16 + row * NPAD + C_GL + (n + 1) * 1024 + col0 + bj * HALF);
                        const float f[8] = {__expf(-lo_bf(hw.x)), __expf(-hi_bf(hw.x)), __expf(-lo_bf(hw.y)), __expf(-hi_bf(hw.y)), __expf(-lo_bf(hw.z)), __expf(-hi_bf(hw.z)), __expf(-lo_bf(hw.w)), __expf(-hi_bf(hw.w))};
#pragma unroll
                        for (int j = 0; j < 4; ++j) { v0[j] *= (1.f + f[j]) / (1.f + e[j]); v1[j] *= (1.f + f[4 + j]) / (1.f + e[4 + j]); }
                    } else { u32x4 w;
                        w.x = cvt_pk_bf16(v0[0] / (1.f + e[0]), v0[1] / (1.f + e[1])); w.y = cvt_pk_bf16(v0[2] / (1.f + e[2]), v0[3] / (1.f + e[3]));
                        w.z = cvt_pk_bf16(v1[0] / (1.f + e[4]), v1[1] / (1.f + e[5])); w.w = cvt_pk_bf16(v1[2] / (1.f + e[6]), v1[3] / (1.f + e[7]));
                        *(u32x4*)(GS + row * D + col0 + bj * HALF) = w; } } }
    }
};
struct BranchOrder {
    StaticOrder so; int G;
    __device__ __forceinline__ void init(int G_, int c_) { so.init(M, 1024, G_, c_, 0); G = G_; }
    __device__ __forceinline__ bool next(int i, Unit& u) const { Unit t; if (!so.next(i / 3, t)) return false; const int n = i % 3; u.pm = t.pm; u.pn = n * 4 + t.pn; u.ka = n; return true; }
};
struct EpiRes {
    __device__ __forceinline__ bool keep(const Unit&) const { return false; }
    static constexpr bool PERM = false;
    float* X;
    __device__ __forceinline__ void operator()(f32x4 (&acc)[2][2][4][2], const Unit& u, int wr, int wc, int fr, int fq) const {
        const int row0 = u.pm * BM + wr * 64 + fr, col0 = u.pn * BM + wc * 32 + 4 * fq;
#pragma unroll
        for (int ai = 0; ai < 2; ++ai)
#pragma unroll
            for (int m = 0; m < 4; ++m) { float* rowp = X + (size_t)(row0 + ai * HALF + m * 16) * D + col0;
#pragma unroll
                for (int bj = 0; bj < 2; ++bj)
#pragma unroll
                    for (int n = 0; n < 2; ++n) { f32x4* p = (f32x4*)(rowp + bj * HALF + n * 16); *p = *p + acc[ai][bj][m][n]; } }
    }
};
struct EpiB16 {
    __device__ __forceinline__ bool keep(const Unit&) const { return false; }
    static constexpr bool PERM = true;
    bf16_t* O; int ldc;
    __device__ __forceinline__ void operator()(f32x4 (&acc)[2][2][4][2], const Unit& u, int wr, int wc, int fr, int fq) const {
        const int row0 = u.pm * BM + wr * 64 + fr, col0 = u.pn * BM + wc * 32 + 8 * fq;
#pragma unroll
        for (int ai = 0; ai < 2; ++ai)
#pragma unroll
            for (int m = 0; m < 4; ++m) { bf16_t* rowp = O + (size_t)(row0 + ai * HALF + m * 16) * ldc + col0;
#pragma unroll
                for (int bj = 0; bj < 2; ++bj) { const f32x4 v0 = acc[ai][bj][m][0], v1 = acc[ai][bj][m][1];
                    u32x4 w; w.x = cvt_pk_bf16(v0[0], v0[1]); w.y = cvt_pk_bf16(v0[2], v0[3]); w.z = cvt_pk_bf16(v1[0], v1[1]); w.w = cvt_pk_bf16(v1[2], v1[3]);
                    *(u32x4*)(rowp + bj * HALF) = w; } }
    }
};
}

struct Args {
    const float* x; const int* pos; const float* norm1; const float* w_in; const float* lb_logits; const float* hgrn_gain; const float* gmlp_gain; const float* gmlp_ws; const float* gmlp_bs;
    const float* w_branch; const float* w_out; const float* norm2; const float* peer_wq; const float* peer_keys; const float* peer_u; const float* peer_v; const float* final_gain;
    float* out; unsigned char* ws; int ph_lo, ph_hi;
};
constexpr int NTHR = 512, NWAVE = 8;
constexpr int LDS_BYTES = 147456;
constexpr int LDS_CTL_OFF = 143360;

__device__ __forceinline__ void tr_item(const float* src, int ldsrc, int c0, int nvalid, bf16_t* dst, int ldd, int r0, int koff, float* scr, int item, int nblk, int lane) {
    const int kb = item / nblk, nb = item % nblk, k0 = 64 * kb, n0 = 32 * nb;
    const int nn = n0 + (lane & 31);
#pragma unroll 8
    for (int i = 0; i < 32; ++i) { const int kk = 2 * i + (lane >> 5); scr[kk * 33 + (lane & 31)] = (nn < nvalid) ? src[(size_t)(k0 + kk) * ldsrc + c0 + nn] : 0.f; }
    asm volatile("s_waitcnt lgkmcnt(0)" ::: "memory");
    const int c = lane & 7;
#pragma unroll
    for (int j = 0; j < 4; ++j) { const int n = (lane >> 3) + 8 * j; const float* s = scr + (8 * c) * 33 + n;
        u32x4 o; o.x = pk2(s[0 * 33], s[1 * 33]); o.y = pk2(s[2 * 33], s[3 * 33]); o.z = pk2(s[4 * 33], s[5 * 33]); o.w = pk2(s[6 * 33], s[7 * 33]);
        *(u32x4*)(dst + (size_t)(r0 + n0 + n) * ldd + koff + k0 + 8 * c) = o; }
    asm volatile("s_waitcnt lgkmcnt(0)" ::: "memory");
}
__device__ __forceinline__ void rms_row_to_bf16(const float* xrow, const float* gain, bf16_t* orow, int lane) {
    const f32x4* xr = (const f32x4*)xrow + lane; const f32x4* gr = (const f32x4*)gain + lane;
    f32x4 v[4]; float s = 0.f;
#pragma unroll
    for (int j = 0; j < 4; ++j) { v[j] = xr[64 * j]; s += (v[j].x * v[j].x + v[j].y * v[j].y) + (v[j].z * v[j].z + v[j].w * v[j].w); }
    const float r = rsqrtf(wave_sum(s) * (1.f / D) + EPS);
    unsigned long long* o8 = (unsigned long long*)orow + lane;
#pragma unroll
    for (int j = 0; j < 4; ++j) { const f32x4 g = gr[64 * j]; o8[64 * j] = (unsigned long long)pk2(v[j].x * r * g.x, v[j].y * r * g.y) | ((unsigned long long)pk2(v[j].z * r * g.z, v[j].w * r * g.w) << 32); }
}

__device__ __forceinline__ void ph_prologue(const Args& a, unsigned char* lds, int wv) {
    const int tid = otid(wv), lane = tid & 63, wave = tid >> 6;
    const int gw = blockIdx.x * NWAVE + wave, ngw = gridDim.x * NWAVE;
    const size_t gtid = (size_t)blockIdx.x * NTHR + tid, gsz = (size_t)gridDim.x * NTHR;
    unsigned char* ws = oport(a.ws);
    { const f32x4* s = (const f32x4*)a.x; f32x4* d = (f32x4*)a.out; for (size_t i = gtid; i < (size_t)M * D / 4; i += gsz) d[i] = s[i]; }
    float* scr = (float*)(lds + wave * 16384);
    constexpr int I_IN1 = 16 * 160, I_IN2 = 16 * 8, I_IN3 = 16 * 96, I_IN = I_IN1 + I_IN2 + I_IN3;
    constexpr int I_BR = 3 * 8 * 32, I_OUT = 16 * 32, I_PQ = 16 * 64, I_L = I_IN + I_BR + I_OUT + I_PQ;
    for (int it = gw; it < DEPTH * I_L; it += ngw) {
        const int l = it / I_L; int r = it % I_L;
        bf16_t* win = (bf16_t*)(ws + WS_WIN + (size_t)l * WIN_L); const float* src_in = a.w_in + (size_t)l * D * NIN;
        if (r < I_IN1) { tr_item(src_in, NIN, 0, 5120, win, D, 0, 0, scr, r, 160, lane); continue; } r -= I_IN1;
        if (r < I_IN2) { tr_item(src_in, NIN, 5120, 72, win, D, C_KI, 0, scr, r, 8, lane); continue; } r -= I_IN2;
        if (r < I_IN3) { tr_item(src_in, NIN, S_GL, 3072, win, D, C_GL, 0, scr, r, 96, lane); continue; } r -= I_IN3;
        if (r < I_BR) { const int n = r / 256; tr_item(a.w_branch + ((size_t)l * 3 + n) * 512 * D, D, 0, 1024, (bf16_t*)(ws + WS_WBR + (size_t)l * WBR_L), 512, n * 1024, 0, scr, r % 256, 32, lane); continue; } r -= I_BR;
        if (r < I_OUT) { tr_item(a.w_out + (size_t)l * D * D, D, 0, 1024, (bf16_t*)(ws + WS_WOUT + (size_t)l * WOUT_L), D, 0, 0, scr, r, 32, lane); continue; } r -= I_OUT;
        tr_item(a.peer_wq + (size_t)l * D * 2048, 2048, 0, 2048, (bf16_t*)(ws + WS_WPQ + (size_t)l * WPQ_L), D, 0, 0, scr, r, 64, lane);
    }
    if (gtid < 512) { float v[DEPTH], mx = -1e30f; for (int l = 0; l < DEPTH; ++l) { v[l] = a.lb_logits[l * 512 + gtid]; mx = fmaxf(mx, v[l]); }
        float s = 0.f; for (int l = 0; l < DEPTH; ++l) { v[l] = __expf(v[l] - mx); s += v[l]; }
        float c = 0.f; float* lb = (float*)(ws + WS_LB); for (int l = 0; l < DEPTH; ++l) { if (l > 0) c += v[l] / s; lb[l * 512 + gtid] = c; } }
    { u32x4* SKB = (u32x4*)(ws + WS_SKB); const f32x4* sk = (const f32x4*)a.peer_keys; for (size_t i = gtid; i < (size_t)DEPTH * 16 * 128 * 128 / 8; i += gsz) { const f32x4 k0 = sk[2 * i], k1 = sk[2 * i + 1]; SKB[i] = (u32x4){pk2(k0.x, k0.y), pk2(k0.z, k0.w), pk2(k1.x, k1.y), pk2(k1.z, k1.w)}; } }
    { bf16_t* WSB = (bf16_t*)(ws + WS_WSB); for (size_t i = gtid; i < (size_t)DEPTH * 4 * 128 * 128; i += gsz) { const int t = (int)((i >> 7) & 127), sx = (int)(i & 127); WSB[i] = (bf16_t)f2bf(sx <= t ? a.gmlp_ws[i] : 0.f); } }
    { float2* cs = (float2*)(ws + WS_CS);
      for (size_t i = gtid; i < (size_t)M * 96; i += gsz) { const int m = (int)(i / 96), j = (int)(i % 96);
          const float inv = j < 64 ? ROPE_INV64[j] : ROPE_INV32[j - 64]; const float angf = (float)a.pos[m] * inv;
          const double ang = (double)angf; const double k = rint(ang * 0.15915494309189535); const float r = (float)(ang - k * 6.283185307179586);
          cs[i] = make_float2(__cosf(r), __sinf(r)); } }
    for (int m = gw; m < M; m += ngw) rms_row_to_bf16(a.x + (size_t)m * D, a.norm1, (bf16_t*)(ws + WS_H16) + (size_t)m * D, lane);
}

__device__ __forceinline__ void ph_kiwi(const Args& a, int l, int wv) {
    unsigned char* ws = oport(a.ws); const int tid = otid(wv), lane = tid & 63, gw = blockIdx.x * NWAVE + (tid >> 6), ngw = gridDim.x * NWAVE, fr = lane & 15, fq = lane >> 4;
    const bf16_t* H16 = (const bf16_t*)(ws + WS_H16); const bf16_t* W = (const bf16_t*)(ws + WS_WIN + (size_t)l * WIN_L) + (size_t)C_KI * D; float* PF = (float*)(ws + WS_PF);
    for (int tg = gw; tg < M / 16; tg += ngw) { f32x4 acc[5];
#pragma unroll
        for (int nt = 0; nt < 5; ++nt) acc[nt] = (f32x4){0.f, 0.f, 0.f, 0.f};
#pragma unroll 4
        for (int ks = 0; ks < 32; ++ks) { const bf16x8 y = ((const bf16x8*)(H16 + (size_t)tg * 16 * D + 32 * ks))[fr * (D / 8) + fq];
#pragma unroll
            for (int nt = 0; nt < 5; ++nt) { const bf16x8 x = ((const bf16x8*)(W + (size_t)nt * 16 * D + 32 * ks))[fr * (D / 8) + fq]; acc[nt] = __builtin_amdgcn_mfma_f32_16x16x32_bf16(x, y, acc[nt], 0, 0, 0); } }
#pragma unroll
        for (int nt = 0; nt < 5; ++nt) *(f32x4*)(PF + ((size_t)tg * 16 + fr) * PFW + 512 + 16 * nt + 4 * fq) = acc[nt]; }
}

__device__ __forceinline__ void ph_post(const Args& a, int l, unsigned char* lds, int wv) {
    const int tid = otid(wv), lane = tid & 63, wave = tid >> 6;
    const int gw = blockIdx.x * NWAVE + wave, ngw = gridDim.x * NWAVE;
    const size_t gtid = (size_t)blockIdx.x * NTHR + tid, gsz = (size_t)gridDim.x * NTHR;
    unsigned char* ws = oport(a.ws);
    const bf16_t* P16 = (const bf16_t*)(ws + WS_P16); const float* PF = (const float*)(ws + WS_PF); const float2* cs = (const float2*)(ws + WS_CS);
    { bf16_t* QR = (bf16_t*)(ws + WS_QR); bf16_t* KR = (bf16_t*)(ws + WS_KR);
      for (size_t i = gtid; i < (size_t)M * 256; i += gsz) { const int m = (int)(i >> 8), h = (int)((i >> 6) & 3), j = (int)(i & 63);
          const float2 c = cs[(size_t)m * 96 + j]; const size_t pb = (size_t)m * NPAD + h * 128 + j, ob = (size_t)m * 512 + h * 128 + j;
          const float q1 = bf2f(P16[pb + C_CQ]), q2 = bf2f(P16[pb + C_CQ + 64]), k1 = bf2f(P16[pb + C_CK]), k2 = bf2f(P16[pb + C_CK + 64]);
          const float sc = 0.08838834764831845f * 1.4426950408889634f;
          QR[ob] = (bf16_t)f2bf((q1 * c.x - q2 * c.y) * sc); QR[ob + 64] = (bf16_t)f2bf((q2 * c.x + q1 * c.y) * sc);
          KR[ob] = (bf16_t)f2bf(k1 * c.x - k2 * c.y); KR[ob + 64] = (bf16_t)f2bf(k2 * c.x + k1 * c.y); } }
    { bf16_t* QS = (bf16_t*)(ws + WS_QI); bf16_t* KIb = (bf16_t*)(ws + WS_KI); float* WP = (float*)(ws + WS_WI);
      for (int m = gw; m < M; m += ngw) { const int h = lane >> 3, jj = lane & 7;
          const unsigned long long w1 = *(const unsigned long long*)(P16 + (size_t)m * NPAD + C_QI + h * 64 + 4 * jj), w2 = *(const unsigned long long*)(P16 + (size_t)m * NPAD + C_QI + h * 64 + 32 + 4 * jj);
          const float q1[4] = {lo_bf((unsigned)w1), hi_bf((unsigned)w1), lo_bf((unsigned)(w1 >> 32)), hi_bf((unsigned)(w1 >> 32))}, q2[4] = {lo_bf((unsigned)w2), hi_bf((unsigned)w2), lo_bf((unsigned)(w2 >> 32)), hi_bf((unsigned)(w2 >> 32))};
          const float2* c = cs + (size_t)m * 96 + 64 + 4 * jj; const float w = PF[(size_t)m * PFW + 576 + h] * 0.02209708691207961f;
          float r1[4], r2[4], l1[4], l2[4];
#pragma unroll
          for (int i = 0; i < 4; ++i) { const float2 cc = c[i]; r1[i] = q1[i] * cc.x - q2[i] * cc.y; r2[i] = q2[i] * cc.x + q1[i] * cc.y; l1[i] = w * r1[i]; l2[i] = w * r2[i]; }
          *(unsigned long long*)(QS + (size_t)m * 576 + h * 64 + 4 * jj) = (unsigned long long)pk2(r1[0], r1[1]) | ((unsigned long long)pk2(r1[2], r1[3]) << 32);
          *(unsigned long long*)(QS + (size_t)m * 576 + h * 64 + 32 + 4 * jj) = (unsigned long long)pk2(r2[0], r2[1]) | ((unsigned long long)pk2(r2[2], r2[3]) << 32);
#pragma unroll
          for (int i = 0; i < 4; ++i) { l1[i] += __shfl_xor(l1[i], 8); l1[i] += __shfl_xor(l1[i], 16); l1[i] += __shfl_xor(l1[i], 32); l2[i] += __shfl_xor(l2[i], 8); l2[i] += __shfl_xor(l2[i], 16); l2[i] += __shfl_xor(l2[i], 32); }
          if (h == 0) { *(unsigned long long*)(QS + (size_t)m * 576 + 512 + 4 * jj) = (unsigned long long)pk2(l1[0], l1[1]) | ((unsigned long long)pk2(l1[2], l1[3]) << 32);
                        *(unsigned long long*)(QS + (size_t)m * 576 + 512 + 32 + 4 * jj) = (unsigned long long)pk2(l2[0], l2[1]) | ((unsigned long long)pk2(l2[2], l2[3]) << 32);
                        const f32x4 k1 = *(const f32x4*)(PF + (size_t)m * PFW + 512 + 4 * jj), k2 = *(const f32x4*)(PF + (size_t)m * PFW + 512 + 32 + 4 * jj);
                        const float kk1[4] = {k1.x, k1.y, k1.z, k1.w}, kk2[4] = {k2.x, k2.y, k2.z, k2.w}; float o1[4], o2[4];
#pragma unroll
                        for (int i = 0; i < 4; ++i) { const float2 cc = c[i]; o1[i] = kk1[i] * cc.x - kk2[i] * cc.y; o2[i] = kk2[i] * cc.x + kk1[i] * cc.y; }
                        *(unsigned long long*)(KIb + (size_t)m * 64 + 4 * jj) = (unsigned long long)pk2(o1[0], o1[1]) | ((unsigned long long)pk2(o1[2], o1[3]) << 32);
                        *(unsigned long long*)(KIb + (size_t)m * 64 + 32 + 4 * jj) = (unsigned long long)pk2(o2[0], o2[1]) | ((unsigned long long)pk2(o2[2], o2[3]) << 32); }
          if (jj == 0) WP[(size_t)m * 8 + h] = w; } }
    { bf16_t* VT = (bf16_t*)(ws + WS_VT); bf16_t* sT = (bf16_t*)lds;
      for (int tile = blockIdx.x; tile < (M / 64) * 8; tile += gridDim.x) { const int tb = tile >> 3, cb = tile & 7;
          { const int row = tid >> 3, seg = tid & 7; const u32x4 w = *(const u32x4*)(P16 + (size_t)(tb * 64 + row) * NPAD + C_CV + cb * 64 + seg * 8);
            unsigned* d = (unsigned*)(sT + row * 66 + seg * 8); d[0] = w.x; d[1] = w.y; d[2] = w.z; d[3] = w.w; }
          __syncthreads();
          { const int ch = tid >> 3, tg = tid & 7; unsigned short v[8];
#pragma unroll
            for (int i = 0; i < 8; ++i) v[i] = sT[(tg * 8 + i) * 66 + ch];
            const u32x4 o = {(unsigned)v[0] | ((unsigned)v[1] << 16), (unsigned)v[2] | ((unsigned)v[3] << 16), (unsigned)v[4] | ((unsigned)v[5] << 16), (unsigned)v[6] | ((unsigned)v[7] << 16)};
            *(u32x4*)(VT + ((size_t)((tb >> 7) * 512 + cb * 64 + ch)) * SEQ + (tb & 127) * 64 + tg * 8) = o; }
          __syncthreads(); } }
    { bf16_t* VN = (bf16_t*)(ws + WS_VN); const float* gain = a.gmlp_gain + l * 512;
      for (int m = gw; m < M; m += ngw) { const u32x4 w = *(const u32x4*)(P16 + (size_t)m * NPAD + C_BV + lane * 8);
          float v[8] = {gelu_t(lo_bf(w.x)), gelu_t(hi_bf(w.x)), gelu_t(lo_bf(w.y)), gelu_t(hi_bf(w.y)), gelu_t(lo_bf(w.z)), gelu_t(hi_bf(w.z)), gelu_t(lo_bf(w.w)), gelu_t(hi_bf(w.w))};
          float sm = 0.f;
#pragma unroll
          for (int j = 0; j < 8; ++j) sm += v[j] * v[j];
          const float r = rsqrtf(wave_sum(sm) * (1.f / 512.f) + EPS);
          const f32x4 g0 = *(const f32x4*)(gain + lane * 8), g1 = *(const f32x4*)(gain + lane * 8 + 4);
          *(u32x4*)(VN + (size_t)m * 512 + lane * 8) = (u32x4){pk2(v[0] * r * g0.x, v[1] * r * g0.y), pk2(v[2] * r * g0.z, v[3] * r * g0.w), pk2(v[4] * r * g1.x, v[5] * r * g1.y), pk2(v[6] * r * g1.z, v[7] * r * g1.w)}; } }
}

constexpr int NHU = BATCH * 128 * 4;
__device__ __forceinline__ void ph_h1(const Args& a, int l, unsigned char* lds, int wv) {
    unsigned char* ws = oport(a.ws);
    const int tid = otid(wv), lane = tid & 63, wave = __builtin_amdgcn_readfirstlane(tid >> 6), j = wave >> 1, d = tid & 127, fr = lane & 15, fq = lane >> 4;
    bf16_t* KT = (bf16_t*)lds;
    bf16_t* VT = KT + 128 * 72;
    float* sT = (float*)(VT + 128 * 72);
    const float* PF = (const float*)(ws + WS_PF); const bf16_t* P16 = (const bf16_t*)(ws + WS_P16); const float* LB = (const float*)(ws + WS_LB) + l * 512;
    float* LL = (float*)(ws + WS_FF); float* DD = (float*)(ws + WS_DD);
    for (int u = blockIdx.x; u < NHU; u += gridDim.x) {
        const int h = u & 3, c = (u >> 2) & 127, b = u >> 9; const size_t m0 = (size_t)b * SEQ + c * 64 + j * 16;
        const float lbv = LB[h * 128 + d];
        float cs[16], ky[16]; unsigned vv[16]; float run = 0.f;
#pragma unroll
        for (int i = 0; i < 16; ++i) { const float z = PF[(m0 + i) * PFW + h * 128 + d]; const float sg = sigm(z); run += __logf(lbv + (1.f - lbv) * sg); cs[i] = run; ky[i] = (1.f - lbv) * (1.f - sg);
            vv[i] = P16[(m0 + i) * NPAD + C_AI + h * 128 + d]; }
        sT[j * 128 + d] = run;
        __syncthreads();
        float tail = 0.f;
#pragma unroll
        for (int jj = 1; jj < 4; ++jj) if (jj > j) tail += sT[jj * 128 + d];
        { unsigned w[8], x[8];
#pragma unroll
          for (int i = 0; i < 8; ++i) { w[i] = pk2(ky[2 * i] * __expf(tail + (run - cs[2 * i])), ky[2 * i + 1] * __expf(tail + (run - cs[2 * i + 1]))); x[i] = vv[2 * i] | (vv[2 * i + 1] << 16); }
          u32x4* kp = (u32x4*)(KT + d * 72 + j * 16); kp[0] = (u32x4){w[0], w[1], w[2], w[3]}; kp[1] = (u32x4){w[4], w[5], w[6], w[7]};
          u32x4* vp = (u32x4*)(VT + d * 72 + j * 16); vp[0] = (u32x4){x[0], x[1], x[2], x[3]}; vp[1] = (u32x4){x[4], x[5], x[6], x[7]}; }
        if (j == 0) DD[(size_t)u * 128 + d] = __expf(run + tail);
        __syncthreads();
        { bf16x8 xk[2];
#pragma unroll
          for (int ks = 0; ks < 2; ++ks) xk[ks] = *(const bf16x8*)(KT + (16 * wave + fr) * 72 + ks * 32 + fq * 8);
#pragma unroll
          for (int nt = 0; nt < 8; ++nt) { f32x4 acc = {0.f, 0.f, 0.f, 0.f};
#pragma unroll
              for (int ks = 0; ks < 2; ++ks) { const bf16x8 y = *(const bf16x8*)(VT + (16 * nt + fr) * 72 + ks * 32 + fq * 8); acc = __builtin_amdgcn_mfma_f32_16x16x32_bf16(xk[ks], y, acc, 0, 0, 0); }
              *(f32x4*)(LL + ((size_t)u * 128 + 16 * nt + fr) * 128 + 16 * wave + 4 * fq) = acc; } }
        __syncthreads();
    }
}
__device__ __forceinline__ void ph_h2(const Args& a, int wv) {
    unsigned char* ws = oport(a.ws);
    const float* LL = (const float*)(ws + WS_FF); const float* DD = (const float*)(ws + WS_DD); bf16_t* SB = (bf16_t*)(ws + WS_QF);
    for (int e = blockIdx.x * NTHR + otid(wv); e < 8 * 16384; e += gridDim.x * NTHR) { const int bh = e >> 14, b = bh >> 2, h = bh & 3, dvdk = e & 16383, dk = e & 127; float S = 0.f;
#pragma unroll 8
        for (int c = 0; c < 128; ++c) { const size_t u = (size_t)(((b * 128 + c) << 2) + h); SB[u * 16384 + dvdk] = (bf16_t)f2bf(S); S = DD[u * 128 + dk] * S + LL[u * 16384 + dvdk]; } }
}
__device__ __forceinline__ void ph_h3(const Args& a, int l, unsigned char* lds, int wv) {
    unsigned char* ws = oport(a.ws);
    const int tid = otid(wv), lane = tid & 63, wave = __builtin_amdgcn_readfirstlane(tid >> 6), j = wave >> 1, d = tid & 127, fr = lane & 15, fq = lane >> 4;
    bf16_t* QT = (bf16_t*)lds;
    bf16_t* QH = QT + 64 * 136;
    bf16_t* KI = QH + 64 * 136;
    bf16_t* VT = KI + 160 * 136;
    bf16_t* AT = VT + 128 * 72;
    float* sT = (float*)(AT + 64 * 72);
    float* sSS = sT + 512;
    const float* PF = (const float*)(ws + WS_PF); const bf16_t* P16 = (const bf16_t*)(ws + WS_P16); const float* LB = (const float*)(ws + WS_LB) + l * 512;
    const bf16_t* SB = (const bf16_t*)(ws + WS_QF); bf16_t* YA = (bf16_t*)(ws + WS_YALL); const float* gain = a.hgrn_gain + l * 128;
    for (int u = blockIdx.x; u < NHU; u += gridDim.x) {
        const int h = u & 3, c = (u >> 2) & 127, b = u >> 9; const size_t mc = (size_t)b * SEQ + c * 64, m0 = mc + j * 16;
        for (int i = tid; i < 64 * 72 * 2 / 16; i += NTHR) ((u32x4*)AT)[i] = (u32x4){0u, 0u, 0u, 0u};
        const float lbv = LB[h * 128 + d];
        float cs[16], ky[16], qf[16]; unsigned vv[16]; float run = 0.f;
#pragma unroll
        for (int i = 0; i < 16; ++i) { const size_t pr = (m0 + i) * NPAD + h * 128 + d; const float z = PF[(m0 + i) * PFW + h * 128 + d]; const float sg = sigm(z); run += __logf(lbv + (1.f - lbv) * sg); cs[i] = run; ky[i] = (1.f - lbv) * (1.f - sg);
            qf[i] = silu(bf2f(P16[pr + C_AQ])) * 0.08838834764831845f; vv[i] = P16[pr + C_AI]; }
        sT[j * 128 + d] = run;
        __syncthreads();
        const float T0 = sT[d], T1 = sT[128 + d], T2 = sT[256 + d];
        const float Bj = (j > 0 ? T0 : 0.f) + (j > 1 ? T1 : 0.f) + (j > 2 ? T2 : 0.f); const float eBj = __expf(Bj);
        float pre[4]; pre[0] = 0.f; pre[1] = (j < 1 ? T0 : 0.f); pre[2] = (j < 1 ? T0 : 0.f) + (j < 2 ? T1 : 0.f); pre[3] = (j < 1 ? T0 : 0.f) + (j < 2 ? T1 : 0.f) + (j < 3 ? T2 : 0.f);
#pragma unroll
        for (int i = 0; i < 16; ++i) { const int t = 16 * j + i; const float ec = __expf(cs[i]);
            QT[t * 136 + d] = (bf16_t)f2bf(qf[i] * ec); QH[t * 136 + d] = (bf16_t)f2bf(qf[i] * ec * eBj);
#pragma unroll
            for (int I = 0; I < 4; ++I) if (I >= j) KI[(8 * I * (I + 1) + t) * 136 + d] = (bf16_t)f2bf(ky[i] * __expf(fminf(pre[I] - cs[i], 80.f))); }
        { unsigned x[8];
#pragma unroll
          for (int i = 0; i < 8; ++i) x[i] = vv[2 * i] | (vv[2 * i + 1] << 16);
          u32x4* vp = (u32x4*)(VT + d * 72 + j * 16); vp[0] = (u32x4){x[0], x[1], x[2], x[3]}; vp[1] = (u32x4){x[4], x[5], x[6], x[7]}; }
        __syncthreads();
        for (int tl = wave; tl < 10; tl += 8) { const int I = tl < 1 ? 0 : tl < 3 ? 1 : tl < 6 ? 2 : 3, J = tl - (I * (I + 1)) / 2; f32x4 acc = {0.f, 0.f, 0.f, 0.f};
#pragma unroll
            for (int ks = 0; ks < 4; ++ks) { const bf16x8 x = *(const bf16x8*)(QT + (16 * I + fr) * 136 + ks * 32 + fq * 8); const bf16x8 y = *(const bf16x8*)(KI + (8 * I * (I + 1) + 16 * J + fr) * 136 + ks * 32 + fq * 8);
                acc = __builtin_amdgcn_mfma_f32_16x16x32_bf16(x, y, acc, 0, 0, 0); }
#pragma unroll
            for (int r = 0; r < 4; ++r) { float v = acc[r]; if (J == I && fr > 4 * fq + r) v = 0.f; AT[(16 * I + 4 * fq + r) * 72 + 16 * J + fr] = (bf16_t)f2bf(v); } }
        __syncthreads();
        const int I = wave & 3, nt0 = 4 * (wave >> 2); f32x4 o[4];
#pragma unroll
        for (int q4 = 0; q4 < 4; ++q4) { const int nt = nt0 + q4; f32x4 acc = {0.f, 0.f, 0.f, 0.f};
            for (int ks = 0; ks <= (I >> 1); ++ks) { const bf16x8 x = *(const bf16x8*)(AT + (16 * I + fr) * 72 + ks * 32 + fq * 8); const bf16x8 y = *(const bf16x8*)(VT + (16 * nt + fr) * 72 + ks * 32 + fq * 8);
                acc = __builtin_amdgcn_mfma_f32_16x16x32_bf16(x, y, acc, 0, 0, 0); }
#pragma unroll
            for (int ks = 0; ks < 4; ++ks) { const bf16x8 x = *(const bf16x8*)(QH + (16 * I + fr) * 136 + ks * 32 + fq * 8); const bf16x8 y = *(const bf16x8*)(SB + ((size_t)u * 128 + 16 * nt + fr) * 128 + ks * 32 + fq * 8);
                acc = __builtin_amdgcn_mfma_f32_16x16x32_bf16(x, y, acc, 0, 0, 0); }
            o[q4] = acc; }
        { float ssq[4];
#pragma unroll
          for (int r = 0; r < 4; ++r) { float s = o[0][r] * o[0][r] + o[1][r] * o[1][r] + o[2][r] * o[2][r] + o[3][r] * o[3][r]; s += __shfl_xor(s, 1); s += __shfl_xor(s, 2); s += __shfl_xor(s, 4); s += __shfl_xor(s, 8); ssq[r] = s; }
          if (fr == 0) {
#pragma unroll
              for (int r = 0; r < 4; ++r) sSS[(16 * I + 4 * fq + r) * 2 + (wave >> 2)] = ssq[r]; } }
        __syncthreads();
#pragma unroll
        for (int r = 0; r < 4; ++r) { const int tt = 16 * I + 4 * fq + r; const float rinv = rsqrtf((sSS[tt * 2] + sSS[tt * 2 + 1]) * (1.f / 128.f) + EPS); const size_t m = mc + tt;
#pragma unroll
            for (int q4 = 0; q4 < 4; ++q4) { const int dv = 16 * (nt0 + q4) + fr; const float g = bf2f(P16[m * NPAD + C_AG + h * 128 + dv]);
                YA[m * 512 + h * 128 + dv] = (bf16_t)f2bf(o[q4][r] * rinv * gain[dv] * silu(g)); } }
        __syncthreads();
    }
}
__device__ __forceinline__ void ph_gmlp(const Args& a, int l, unsigned char* lds, int wv) {
    unsigned char* ws = oport(a.ws);
    const int tid = otid(wv), lane = tid & 63, wave = __builtin_amdgcn_readfirstlane(tid >> 6), fr = lane & 15, fq = lane >> 4;
    const bf16_t* P16 = (const bf16_t*)(ws + WS_P16); const bf16_t* VN = (const bf16_t*)(ws + WS_VN); bf16_t* YB = (bf16_t*)(ws + WS_YALL) + (size_t)M * 512;
    const bf16_t* WSB = (const bf16_t*)(ws + WS_WSB) + (size_t)l * 4 * 128 * 128; const float* bs = a.gmlp_bs + (size_t)l * 4 * 128;
    bf16_t* VNt = (bf16_t*)lds;
    for (int u = blockIdx.x; u < (M / 128) * 4; u += gridDim.x) { const int g = u & 3, nb = u >> 2; const size_t mb = (size_t)nb * 128;
        __syncthreads();
#pragma unroll
        for (int n = 0; n < 4; ++n) { const int idx = tid + NTHR * n, row = idx >> 4, seg = idx & 15; const u32x4 w = *(const u32x4*)(VN + (mb + row) * 512 + g * 128 + seg * 8);
            bf16_t* d = VNt + (seg * 8) * 136 + row;
            d[0 * 136] = (bf16_t)(w.x & 0xffffu); d[1 * 136] = (bf16_t)(w.x >> 16); d[2 * 136] = (bf16_t)(w.y & 0xffffu); d[3 * 136] = (bf16_t)(w.y >> 16);
            d[4 * 136] = (bf16_t)(w.z & 0xffffu); d[5 * 136] = (bf16_t)(w.z >> 16); d[6 * 136] = (bf16_t)(w.w & 0xffffu); d[7 * 136] = (bf16_t)(w.w >> 16); }
        bf16x8 wf[4];
#pragma unroll
        for (int ks = 0; ks < 4; ++ks) wf[ks] = *(const bf16x8*)(WSB + ((size_t)g * 128 + 16 * wave + fr) * 128 + 32 * ks + 8 * fq);
        __syncthreads();
        const int t = 16 * wave + fr; const float bias = bs[g * 128 + t]; const int nks = (wave >> 1) + 1;
#pragma unroll
        for (int ct = 0; ct < 8; ++ct) { f32x4 acc = {0.f, 0.f, 0.f, 0.f};
#pragma unroll
            for (int ks = 0; ks < 4; ++ks) if (ks < nks) { const bf16x8 x = *(const bf16x8*)(VNt + (16 * ct + fr) * 136 + 32 * ks + 8 * fq); acc = __builtin_amdgcn_mfma_f32_16x16x32_bf16(x, wf[ks], acc, 0, 0, 0); }
            const size_t m = mb + t; const int c = g * 128 + 16 * ct + 4 * fq; const unsigned long long uw = *(const unsigned long long*)(P16 + m * NPAD + C_BU + c);
            const float o0 = gelu_t(lo_bf((unsigned)uw)) * (acc[0] + bias), o1 = gelu_t(hi_bf((unsigned)uw)) * (acc[1] + bias), o2 = gelu_t(lo_bf((unsigned)(uw >> 32))) * (acc[2] + bias), o3 = gelu_t(hi_bf((unsigned)(uw >> 32))) * (acc[3] + bias);
            *(unsigned long long*)(YB + m * 512 + c) = (unsigned long long)pk2(o0, o1) | ((unsigned long long)pk2(o2, o3) << 32); }
    }
}
constexpr int SEL_CAP = 128;
__device__ __forceinline__ int sel_bin(float s, float lo, float sc) { return (int)__builtin_amdgcn_fmed3f((s - lo) * sc, 0.f, 511.f); }
struct SelQ { float lo1, sc1, lo2, sc2, tau; int b1, b2, ref, tidx; };
__device__ __forceinline__ void sel_pass(const int mode, const bf16x8 (&qf)[9][2], const float (&wp)[8], const SelQ& sq, const bf16_t* kib, int c, int kp, int qloc, int fr, int fq,
                                         unsigned* sHist, unsigned* sCand, unsigned* sCnt, unsigned* maskrow) {
    bf16x8 af[4][2];
    { const int T0 = kp <= c ? kp : c;
#pragma unroll
      for (int rg = 0; rg < 4; ++rg)
#pragma unroll
          for (int ks = 0; ks < 2; ++ks) af[rg][ks] = ((const bf16x8*)(kib + (size_t)(64 * T0 + 16 * rg) * 64 + 32 * ks))[fr * 8 + fq]; }
#pragma unroll 1
    for (int T = kp; T <= c; T += 4) {
        const int Tn = (T + 4 <= c) ? T + 4 : T;
        unsigned mlo = 0u, mhi = 0u;
#pragma unroll
        for (int rg = 0; rg < 4; ++rg) {
            f32x4 sc = __builtin_amdgcn_mfma_f32_16x16x32_bf16(af[rg][0], qf[8][0], (f32x4){0.f, 0.f, 0.f, 0.f}, 0, 0, 0);
            sc = __builtin_amdgcn_mfma_f32_16x16x32_bf16(af[rg][1], qf[8][1], sc, 0, 0, 0);
#pragma unroll
            for (int h = 0; h < 8; ++h) { f32x4 ah = __builtin_amdgcn_mfma_f32_16x16x32_bf16(af[rg][0], qf[h][0], (f32x4){0.f, 0.f, 0.f, 0.f}, 0, 0, 0);
                ah = __builtin_amdgcn_mfma_f32_16x16x32_bf16(af[rg][1], qf[h][1], ah, 0, 0, 0);
#pragma unroll
                for (int r = 0; r < 4; ++r) sc[r] += wp[h] * __builtin_fabsf(ah[r]); }
#pragma unroll
            for (int ks = 0; ks < 2; ++ks) af[rg][ks] = ((const bf16x8*)(kib + (size_t)(64 * Tn + 16 * rg) * 64 + 32 * ks))[fr * 8 + fq];
            if (mode == 0) {
#pragma unroll
                for (int r = 0; r < 4; ++r) __hip_atomic_fetch_add(sHist + qloc * 512 + sel_bin(sc[r], sq.lo1, sq.sc1), 1u, __ATOMIC_RELAXED, __HIP_MEMORY_SCOPE_WORKGROUP);
            } else if (mode == 1) {
                if (sq.ref) {
#pragma unroll
                    for (int r = 0; r < 4; ++r) if (sel_bin(sc[r], sq.lo1, sq.sc1) == sq.b1) __hip_atomic_fetch_add(sHist + qloc * 512 + sel_bin(sc[r], sq.lo2, sq.sc2), 1u, __ATOMIC_RELAXED, __HIP_MEMORY_SCOPE_WORKGROUP); }
            } else {
                int b[4]; unsigned bits = 0u; bool anyc = false;
#pragma unroll
                for (int r = 0; r < 4; ++r) { b[r] = sel_bin(sc[r], sq.lo1, sq.sc1); bits |= (b[r] > sq.b1) ? (1u << r) : 0u; anyc |= (b[r] == sq.b1); }
                if (anyc) {
#pragma unroll
                    for (int r = 0; r < 4; ++r) if (b[r] == sq.b1) { bool cand = true;
                        if (sq.ref) { const int b2 = sel_bin(sc[r], sq.lo2, sq.sc2); if (b2 > sq.b2) bits |= 1u << r; cand = b2 == sq.b2; }
                        if (cand) { const unsigned slot = __hip_atomic_fetch_add(sCnt + qloc, 1u, __ATOMIC_RELAXED, __HIP_MEMORY_SCOPE_WORKGROUP);
                            if (slot < (unsigned)SEL_CAP) { sCand[(qloc * SEL_CAP + slot) * 2] = __float_as_uint(sc[r]); sCand[(qloc * SEL_CAP + slot) * 2 + 1] = (unsigned)(64 * T + 16 * rg + 4 * fq + r); } } } }
                bits <<= (16 * (rg & 1)) + 4 * fq; if (rg < 2) mlo |= bits; else mhi |= bits;
            }
            __builtin_amdgcn_sched_barrier(0);
        }
        if (mode == 2) { mlo |= __shfl_xor(mlo, 16); mlo |= __shfl_xor(mlo, 32); mhi |= __shfl_xor(mhi, 16); mhi |= __shfl_xor(mhi, 32);
            if (fq == 0) *(uint2*)(maskrow + 2 * T) = make_uint2(mlo, mhi); }
    }
}
__device__ __forceinline__ void sel_scan(const unsigned* hist, unsigned need, int lane, int& bsel, unsigned& nneed, unsigned& cnt) {
    unsigned c8[8]; unsigned tot = 0u;
    { const u32x4 w0 = *(const u32x4*)(hist + 512 - 8 * (lane + 1)), w1 = *(const u32x4*)(hist + 512 - 8 * (lane + 1) + 4);
      c8[0] = w0.x; c8[1] = w0.y; c8[2] = w0.z; c8[3] = w0.w; c8[4] = w1.x; c8[5] = w1.y; c8[6] = w1.z; c8[7] = w1.w; }
#pragma unroll
    for (int i = 0; i < 8; ++i) tot += c8[i];
    unsigned inc = tot;
#pragma unroll
    for (int o = 1; o < 64; o <<= 1) { const unsigned t2 = __shfl_up(inc, o); if (lane >= o) inc += t2; }
    const unsigned long long bal = __ballot(inc >= need);
    const int L = bal ? (__ffsll((long long)bal) - 1) : 63;
    unsigned above = __shfl(inc - tot, L); int bs = 0; unsigned nn = 1u, cc = 0u; bool found = false;
#pragma unroll
    for (int j = 0; j < 8; ++j) { const unsigned hcnt = __shfl(c8[7 - j], L); if (!found) { if (above + hcnt >= need) { found = true; bs = 512 - 8 * L - 1 - j; nn = need - above; cc = hcnt; } else above += hcnt; } }
    bsel = bs; nneed = nn; cnt = cc;
}
__device__ __forceinline__ void ph_sel(const Args& a, unsigned char* lds, int wv) {
    unsigned char* ws = oport(a.ws);
    const int tid = otid(wv), lane = tid & 63, wave = __builtin_amdgcn_readfirstlane(tid >> 6), gq = wave & 1, kp = wave >> 1, fr = lane & 15, fq = lane >> 4, qloc = 16 * gq + fr;
    unsigned* sHist = (unsigned*)lds;
    unsigned* sCand = (unsigned*)(lds + 65536);
    float* sLo1 = (float*)(lds + 98304); float* sSc1 = sLo1 + 32; float* sLo2 = sSc1 + 32; float* sSc2 = sLo2 + 32; float* sTau = sSc2 + 32;
    int* sB1 = (int*)(sTau + 32); int* sB2 = sB1 + 32; int* sRef = sB2 + 32; int* sTidx = sRef + 32; unsigned* sNeed = (unsigned*)(sTidx + 32); unsigned* sCnt = sNeed + 32; int* sAny = (int*)(sCnt + 32);
    const bf16_t* QS = (const bf16_t*)(ws + WS_QI); const bf16_t* KIb = (const bf16_t*)(ws + WS_KI); const float* WP = (const float*)(ws + WS_WI); unsigned* MASKB = (unsigned*)(ws + WS_MASK);
    for (int pi = blockIdx.x; pi < 256; pi += gridDim.x) {
#pragma unroll 1
      for (int which = 0; which < 2; ++which) {
        const int b = pi & 1, half = (pi >> 1) & 1, cc = pi >> 2, c = which ? cc : 127 - cc;
        const size_t mq = (size_t)b * SEQ + 64 * c + 32 * half;
        const bf16_t* kib = KIb + (size_t)b * SEQ * 64;
        __syncthreads();
        if (tid < 32) { const float* w = WP + (mq + tid) * 8; float s1 = 0.f, s2 = 0.f;
#pragma unroll
            for (int h = 0; h < 8; ++h) { s1 += w[h]; s2 += w[h] * w[h]; }
            const float sd = 9.34f * sqrtf(fmaxf(s2, 1e-30f)); sLo1[tid] = 6.38f * s1 - 8.f * sd; sSc1[tid] = 512.f / (16.f * sd);
            sLo2[tid] = 0.f; sSc2[tid] = 1.f; sB1[tid] = 0; sB2[tid] = 0; sRef[tid] = 0; sNeed[tid] = 256u; sCnt[tid] = 0u; sTau[tid] = -INFINITY; sTidx[tid] = 0x7fffffff; }
        if (tid == 0) sAny[0] = 0;
        for (int i = tid; i < 32 * 512 / 4; i += NTHR) ((u32x4*)sHist)[i] = (u32x4){0u, 0u, 0u, 0u};
        bf16x8 qf[9][2]; float wp[8];
        { const bf16_t* qrow = QS + (mq + qloc) * 576;
#pragma unroll
          for (int h = 0; h < 9; ++h)
#pragma unroll
              for (int ks = 0; ks < 2; ++ks) qf[h][ks] = *(const bf16x8*)(qrow + h * 64 + 32 * ks + 8 * fq);
#pragma unroll
          for (int h = 0; h < 8; ++h) wp[h] = WP[(mq + qloc) * 8 + h]; }
        __syncthreads();
        unsigned* maskrow = MASKB + (mq + qloc) * 256;
        if (c < 4) {
            if (tid < 32) for (int T = 0; T <= c; ++T) *(uint2*)(MASKB + (mq + tid) * 256 + 2 * T) = make_uint2(0xFFFFFFFFu, 0xFFFFFFFFu);
        } else {
#pragma unroll 1
            for (int pass = 0; pass < 3; ++pass) {
                if (pass == 1) { if (!sAny[0]) continue; __syncthreads(); for (int i = tid; i < 32 * 512 / 4; i += NTHR) ((u32x4*)sHist)[i] = (u32x4){0u, 0u, 0u, 0u}; __syncthreads(); }
                SelQ sq; sq.lo1 = sLo1[qloc]; sq.sc1 = sSc1[qloc]; sq.lo2 = sLo2[qloc]; sq.sc2 = sSc2[qloc]; sq.b1 = sB1[qloc]; sq.b2 = sB2[qloc]; sq.ref = sRef[qloc]; sq.tau = 0.f; sq.tidx = 0;
                sel_pass(pass, qf, wp, sq, kib, c, kp, qloc, fr, fq, sHist, sCand, sCnt, maskrow);
                asm volatile("s_waitcnt vmcnt(0)" ::: "memory");
                __syncthreads();
                if (pass < 2) {
                    for (int qq = wave * 4; qq < wave * 4 + 4; ++qq) if (pass == 0 || sRef[qq]) { int bs; unsigned nn, cn; sel_scan(sHist + qq * 512, sNeed[qq], lane, bs, nn, cn);
                        if (lane == 0) { sNeed[qq] = nn; if (pass == 0) { sB1[qq] = bs; if (cn > (unsigned)SEL_CAP) { sRef[qq] = 1; sLo2[qq] = sLo1[qq] + (float)bs / sSc1[qq]; sSc2[qq] = sSc1[qq] * 512.f; sAny[0] = 1; } } else sB2[qq] = bs; } }
                    __syncthreads(); }
            }
            { const int qq = tid >> 4, t16 = tid & 15; const unsigned n = sCnt[qq] < (unsigned)SEL_CAP ? sCnt[qq] : (unsigned)SEL_CAP; const unsigned want = sNeed[qq] - 1u;
              for (unsigned i = t16; i < n; i += 16) { const float si = __uint_as_float(sCand[(qq * SEL_CAP + i) * 2]); const unsigned ki = sCand[(qq * SEL_CAP + i) * 2 + 1]; unsigned rank = 0u;
                  for (unsigned j = 0; j < n; ++j) { const float sj = __uint_as_float(sCand[(qq * SEL_CAP + j) * 2]); const unsigned kj = sCand[(qq * SEL_CAP + j) * 2 + 1]; rank += (sj > si || (sj == si && kj < ki)) ? 1u : 0u; }
                  if (rank <= want) atomicOr(MASKB + (mq + qq) * 256 + (ki >> 5), 1u << (ki & 31u)); } }
        }
      }
    }
}

__device__ __forceinline__ void ph_attn(const Args& a, unsigned char* lds, int wv) {
    unsigned char* ws = oport(a.ws);
    const int tid = otid(wv), lane = tid & 63, wave = __builtin_amdgcn_readfirstlane(tid >> 6), g4 = wave & 3, par = wave >> 2, fr = lane & 15, fq = lane >> 4;
    const bf16_t* QR = (const bf16_t*)(ws + WS_QR); const bf16_t* KR = (const bf16_t*)(ws + WS_KR); const bf16_t* VT = (const bf16_t*)(ws + WS_VT); const unsigned* MASKB = (const unsigned*)(ws + WS_MASK);
    bf16_t* YC = (bf16_t*)(ws + WS_YALL) + (size_t)2 * M * 512;
    bf16_t* Kt = (bf16_t*)lds;
    bf16_t* Vt = Kt + 2 * 64 * 136;
    float* sMrg = (float*)lds;
    for (int pi = blockIdx.x; pi < 256; pi += gridDim.x) {
#pragma unroll 1
      for (int which = 0; which < 2; ++which) {
        const int bh = pi & 7, b = bh >> 2, h = bh & 3, cc = pi >> 3, qb = which ? cc : 63 - cc;
        const size_t m0 = (size_t)b * SEQ + 128 * qb + 32 * g4;
        const int mych = 2 * qb + (g4 >> 1);
        bf16x8 qf[2][4];
#pragma unroll
        for (int cg = 0; cg < 2; ++cg)
#pragma unroll
            for (int ks = 0; ks < 4; ++ks) qf[cg][ks] = *(const bf16x8*)(QR + (m0 + 16 * cg + fr) * 512 + h * 128 + 32 * ks + 8 * fq);
        f32x4 O[2][8]; float mrun[2], lrun[2];
#pragma unroll
        for (int cg = 0; cg < 2; ++cg) { mrun[cg] = -1e30f; lrun[cg] = 0.f;
#pragma unroll
            for (int vt = 0; vt < 8; ++vt) O[cg][vt] = (f32x4){0.f, 0.f, 0.f, 0.f}; }
        const bf16_t* kbase = KR + (size_t)b * SEQ * 512 + h * 128; const bf16_t* vbase = VT + (size_t)(b * 512 + h * 128) * SEQ;
#define ATT_DMA(jj, buf) do { const bf16_t* kb_ = kbase + (size_t)(jj) * 128 * 512; const bf16_t* vb_ = vbase + (size_t)(jj) * 128; \
            _Pragma("unroll 1") for (int i_ = wave; i_ < 70; i_ += NWAVE) { const int slot = 64 * i_ + lane; const bf16_t* src; \
                if (slot < 2176) { const int tl = slot >= 1088 ? 1 : 0, rs = slot - 1088 * tl, row = rs / 17, seg = rs - 17 * row; src = kb_ + (size_t)((64 * tl + row) * 512 + (seg & 15) * 8); } \
                else { const int s2 = slot - 2176, tl = s2 >= 1152 ? 1 : 0, rs = s2 - 1152 * tl, row = rs / 9, seg = rs - 9 * row; src = vb_ + (size_t)(row * SEQ + 64 * tl + (seg & 7) * 8); } \
                __builtin_amdgcn_global_load_lds((const unsigned*)src, (LAS unsigned*)(LAS unsigned char*)(lds + (buf) * 71680 + i_ * 1024), 16, 0, 0); } } while (0)
        __syncthreads();
        ATT_DMA(0, 0);
        asm volatile("s_waitcnt vmcnt(0)" ::: "memory");
        __syncthreads();
        for (int j = 0; j <= qb; ++j) {
            if (j < qb) ATT_DMA(j + 1, (j + 1) & 1);
            const bf16_t* Ktb = Kt + (j & 1) * 35840; const bf16_t* Vtb = Vt + (j & 1) * 35840;
            const int T = 2 * j + par;
            if (T <= mych) {
                const bf16_t* kt = Ktb + par * 64 * 136; const bf16_t* vtl = Vtb + par * 128 * 72;
                uint2 mw[2];
#pragma unroll
                for (int cg = 0; cg < 2; ++cg) mw[cg] = *(const uint2*)(MASKB + (m0 + 16 * cg + fr) * 256 + 2 * T);
                f32x4 S[2][4];
#pragma unroll
                for (int rg = 0; rg < 4; ++rg) { S[0][rg] = (f32x4){0.f, 0.f, 0.f, 0.f}; S[1][rg] = (f32x4){0.f, 0.f, 0.f, 0.f};
                    const int krow = 32 * (rg >> 1) + 8 * (fr >> 2) + 4 * (rg & 1) + (fr & 3);
#pragma unroll
                    for (int ks = 0; ks < 4; ++ks) { const bf16x8 kf = *(const bf16x8*)(kt + krow * 136 + 32 * ks + 8 * fq);
                        S[0][rg] = __builtin_amdgcn_mfma_f32_16x16x32_bf16(kf, qf[0][ks], S[0][rg], 0, 0, 0); S[1][rg] = __builtin_amdgcn_mfma_f32_16x16x32_bf16(kf, qf[1][ks], S[1][rg], 0, 0, 0); } }
                bf16x8 pf[2][2];
#pragma unroll
                for (int cg = 0; cg < 2; ++cg) {
                    float mx = fmaxf(fmaxf(fmaxf(S[cg][0][0], S[cg][0][1]), fmaxf(S[cg][0][2], S[cg][0][3])), fmaxf(fmaxf(S[cg][1][0], S[cg][1][1]), fmaxf(S[cg][1][2], S[cg][1][3])));
                    mx = fmaxf(mx, fmaxf(fmaxf(fmaxf(S[cg][2][0], S[cg][2][1]), fmaxf(S[cg][2][2], S[cg][2][3])), fmaxf(fmaxf(S[cg][3][0], S[cg][3][1]), fmaxf(S[cg][3][2], S[cg][3][3]))));
                    mx = fmaxf(mx, __shfl_xor(mx, 16)); mx = fmaxf(mx, __shfl_xor(mx, 32));
                    const float mnew = fmaxf(mrun[cg], mx), alpha = __builtin_amdgcn_exp2f(mrun[cg] - mnew); mrun[cg] = mnew; float ls = 0.f;
                    const int m16 = (int)(((mw[cg].x >> (8 * fq)) & 0xFFu) | (((mw[cg].y >> (8 * fq)) & 0xFFu) << 8));
#pragma unroll
                    for (int rg = 0; rg < 4; ++rg)
#pragma unroll
                        for (int r = 0; r < 4; ++r) { const int keep = __builtin_amdgcn_sbfe(m16, 4 * rg + r, 1);
                            const float p = __int_as_float(__float_as_int(__builtin_amdgcn_exp2f(S[cg][rg][r] - mnew)) & keep); S[cg][rg][r] = p; ls += p; }
                    lrun[cg] = lrun[cg] * alpha + ls;
                    if (__builtin_amdgcn_ballot_w64(alpha != 1.0f) != 0ull) {
#pragma unroll
                        for (int vt = 0; vt < 8; ++vt) O[cg][vt] = O[cg][vt] * alpha; }
#pragma unroll
                    for (int k2 = 0; k2 < 2; ++k2) { const u32x4 w = {pg8::cvt_pk_bf16(S[cg][2 * k2][0], S[cg][2 * k2][1]), pg8::cvt_pk_bf16(S[cg][2 * k2][2], S[cg][2 * k2][3]), pg8::cvt_pk_bf16(S[cg][2 * k2 + 1][0], S[cg][2 * k2 + 1][1]), pg8::cvt_pk_bf16(S[cg][2 * k2 + 1][2], S[cg][2 * k2 + 1][3])};
                        pf[cg][k2] = __builtin_bit_cast(bf16x8, w); }
                }
#pragma unroll
                for (int vt = 0; vt < 8; ++vt)
#pragma unroll
                    for (int k2 = 0; k2 < 2; ++k2) { const bf16x8 vf = *(const bf16x8*)(vtl + (16 * vt + fr) * 72 + 32 * k2 + 8 * fq);
                        O[0][vt] = __builtin_amdgcn_mfma_f32_16x16x32_bf16(vf, pf[0][k2], O[0][vt], 0, 0, 0); O[1][vt] = __builtin_amdgcn_mfma_f32_16x16x32_bf16(vf, pf[1][k2], O[1][vt], 0, 0, 0); }
            }
            asm volatile("s_waitcnt vmcnt(0)" ::: "memory");
            __syncthreads();
        }
#undef ATT_DMA
        float* mb = sMrg + (size_t)g4 * 68 * 64 + lane;
        if (par == 1) {
#pragma unroll
            for (int cg = 0; cg < 2; ++cg) { mb[(cg * 2 + 0) * 64] = mrun[cg]; mb[(cg * 2 + 1) * 64] = lrun[cg];
#pragma unroll
                for (int vt = 0; vt < 8; ++vt)
#pragma unroll
                    for (int r = 0; r < 4; ++r) mb[(4 + (cg * 8 + vt) * 4 + r) * 64] = O[cg][vt][r]; } }
        __syncthreads();
        if (par == 0) {
#pragma unroll
            for (int cg = 0; cg < 2; ++cg) { const float m1 = mb[(cg * 2 + 0) * 64], l1 = mb[(cg * 2 + 1) * 64]; const float mm = fmaxf(mrun[cg], m1), a0 = __builtin_amdgcn_exp2f(mrun[cg] - mm), a1 = __builtin_amdgcn_exp2f(m1 - mm);
                float lt = lrun[cg] * a0 + l1 * a1; lt += __shfl_xor(lt, 16); lt += __shfl_xor(lt, 32); const float inv = 1.f / lt;
#pragma unroll
                for (int vt = 0; vt < 8; ++vt) { float o[4];
#pragma unroll
                    for (int r = 0; r < 4; ++r) o[r] = (O[cg][vt][r] * a0 + mb[(4 + (cg * 8 + vt) * 4 + r) * 64] * a1) * inv;
                    *(unsigned long long*)(YC + (m0 + 16 * cg + fr) * 512 + h * 128 + 16 * vt + 4 * fq) = (unsigned long long)pk2(o[0], o[1]) | ((unsigned long long)pk2(o[2], o[3]) << 32); } } }
      }
    }
}
__device__ __forceinline__ void ph_norm2(const Args& a, int l, int wv) {
    const int tid = otid(wv), lane = tid & 63, gw = blockIdx.x * NWAVE + (tid >> 6), ngw = gridDim.x * NWAVE;
    unsigned char* ws = oport(a.ws);
    for (int m = gw; m < M; m += ngw) rms_row_to_bf16(a.out + (size_t)m * D, a.norm2 + l * D, (bf16_t*)(ws + WS_H16) + (size_t)m * D, lane);
    { const f32x4* U = (const f32x4*)(a.peer_u + (size_t)l * NEXP * D); const f32x4* V = (const f32x4*)(a.peer_v + (size_t)l * NEXP * D); u32x4* U8 = (u32x4*)(ws + WS_U16); u32x4* V8 = (u32x4*)(ws + WS_V16);
      for (size_t i = (size_t)blockIdx.x * NTHR + tid; i < (size_t)NEXP * D / 16; i += (size_t)gridDim.x * NTHR) { u32x4 ou, ov; unsigned* pu = (unsigned*)&ou; unsigned* pv = (unsigned*)&ov;
#pragma unroll
          for (int q = 0; q < 4; ++q) { const f32x4 u = U[4 * i + q] * 256.f, v = V[4 * i + q] * 64.f; int wu = 0, wvv = 0;
              wu = __builtin_amdgcn_cvt_pk_fp8_f32(u.x, u.y, wu, false); wu = __builtin_amdgcn_cvt_pk_fp8_f32(u.z, u.w, wu, true); wvv = __builtin_amdgcn_cvt_pk_fp8_f32(v.x, v.y, wvv, false); wvv = __builtin_amdgcn_cvt_pk_fp8_f32(v.z, v.w, wvv, true);
              pu[q] = (unsigned)wu; pv[q] = (unsigned)wvv; }
          U8[i] = ou; V8[i] = ov; } }
}
__device__ __forceinline__ float pkf(float v, unsigned tag) { return __uint_as_float((__float_as_uint(v) & 0xFFFFFF00u) | tag); }
__device__ __forceinline__ void ph_peer_select(const Args& a, int l, unsigned char* lds, int wv, int nunits, int pm0, int pn0, int pm1, int pn1) {
    unsigned char* ws = oport(a.ws); const int tid = otid(wv), lane = tid & 63, wave = __builtin_amdgcn_readfirstlane(tid >> 6), fr = lane & 15, fq = lane >> 4;
    int* sI = (int*)(lds + wave * 2048);
    const bf16_t* QRY = (const bf16_t*)(ws + WS_GB); const bf16_t* SKB = (const bf16_t*)(ws + WS_SKB) + (size_t)l * 16 * 128 * 128; int* EID = (int*)(ws + WS_EID); float* EG = (float*)(ws + WS_EG);
    for (int it = wave; it < 16 * nunits; it += NWAVE) { const int uu = it >> 4, h = uu == 0 ? pn0 : pn1, tg = (uu == 0 ? pm0 : pm1) * 16 + (it & 15); const size_t m = (size_t)tg * 16 + fr;
        float va[16], vb[16];
#pragma unroll
        for (int p = 0; p < 2; ++p) {
            bf16x8 qf[4];
#pragma unroll
            for (int ks = 0; ks < 4; ++ks) qf[ks] = *(const bf16x8*)(QRY + m * 2048 + h * 256 + p * 128 + 32 * ks + 8 * fq);
            const bf16_t* kb = SKB + ((size_t)(h * 2 + p) * 128) * 128; float sc[32];
#pragma unroll
            for (int nt = 0; nt < 8; ++nt) { f32x4 acc = {0.f, 0.f, 0.f, 0.f};
#pragma unroll
                for (int ks = 0; ks < 4; ++ks) { const bf16x8 x = *(const bf16x8*)(kb + (size_t)(16 * nt + fr) * 128 + 32 * ks + 8 * fq); acc = __builtin_amdgcn_mfma_f32_16x16x32_bf16(x, qf[ks], acc, 0, 0, 0); }
#pragma unroll
                for (int r = 0; r < 4; ++r) sc[nt * 4 + r] = __uint_as_float((__float_as_uint(acc[r]) & 0xFFFFFF80u) | (unsigned)(127 - (16 * nt + 4 * fq + r))); }
#pragma unroll
            for (int rd = 0; rd < 16; ++rd) { float mx = sc[0];
#pragma unroll
                for (int j = 1; j < 32; ++j) mx = fmaxf(mx, sc[j]);
                mx = fmaxf(mx, __shfl_xor(mx, 16)); mx = fmaxf(mx, __shfl_xor(mx, 32));
#pragma unroll
                for (int j = 0; j < 32; ++j) sc[j] = (sc[j] == mx) ? -INFINITY : sc[j];
                if (p == 0) va[rd] = mx; else vb[rd] = mx; }
            __builtin_amdgcn_sched_barrier(0);
        }
        if (fq == 0) {
#pragma unroll
            for (int r = 0; r < 16; ++r) { sI[fr * 32 + r] = 127 - (int)(__float_as_uint(va[r]) & 127u); sI[fr * 32 + 16 + r] = 127 - (int)(__float_as_uint(vb[r]) & 127u); } }
#pragma unroll
        for (int r = 0; r < 16; ++r) { va[r] = __uint_as_float(__float_as_uint(va[r]) & 0xFFFFFF80u); vb[r] = __uint_as_float(__float_as_uint(vb[r]) & 0xFFFFFF80u); }
        float cs[13];
        {
            cs[0] = fq == 0 ? pkf(va[0] + vb[0], 255u) : fq == 1 ? pkf(va[0] + vb[1], 254u) : fq == 2 ? pkf(va[0] + vb[2], 253u) : pkf(va[0] + vb[3], 252u);
            cs[1] = fq == 0 ? pkf(va[0] + vb[4], 251u) : fq == 1 ? pkf(va[0] + vb[5], 250u) : fq == 2 ? pkf(va[0] + vb[6], 249u) : pkf(va[0] + vb[7], 248u);
            cs[2] = fq == 0 ? pkf(va[0] + vb[8], 247u) : fq == 1 ? pkf(va[0] + vb[9], 246u) : fq == 2 ? pkf(va[0] + vb[10], 245u) : pkf(va[0] + vb[11], 244u);
            cs[3] = fq == 0 ? pkf(va[0] + vb[12], 243u) : fq == 1 ? pkf(va[0] + vb[13], 242u) : fq == 2 ? pkf(va[0] + vb[14], 241u) : pkf(va[0] + vb[15], 240u);
            cs[4] = fq == 0 ? pkf(va[1] + vb[0], 239u) : fq == 1 ? pkf(va[1] + vb[1], 238u) : fq == 2 ? pkf(va[1] + vb[2], 237u) : pkf(va[1] + vb[3], 236u);
            cs[5] = fq == 0 ? pkf(va[1] + vb[4], 235u) : fq == 1 ? pkf(va[1] + vb[5], 234u) : fq == 2 ? pkf(va[1] + vb[6], 233u) : pkf(va[1] + vb[7], 232u);
            cs[6] = fq == 0 ? pkf(va[2] + vb[0], 223u) : fq == 1 ? pkf(va[2] + vb[1], 222u) : fq == 2 ? pkf(va[2] + vb[2], 221u) : pkf(va[2] + vb[3], 220u);
            cs[7] = fq == 0 ? pkf(va[2] + vb[4], 219u) : fq == 1 ? pkf(va[3] + vb[0], 207u) : fq == 2 ? pkf(va[3] + vb[1], 206u) : pkf(va[3] + vb[2], 205u);
            cs[8] = fq == 0 ? pkf(va[3] + vb[3], 204u) : fq == 1 ? pkf(va[4] + vb[0], 191u) : fq == 2 ? pkf(va[4] + vb[1], 190u) : pkf(va[4] + vb[2], 189u);
            cs[9] = fq == 0 ? pkf(va[5] + vb[0], 175u) : fq == 1 ? pkf(va[5] + vb[1], 174u) : fq == 2 ? pkf(va[6] + vb[0], 159u) : pkf(va[6] + vb[1], 158u);
            cs[10] = fq == 0 ? pkf(va[7] + vb[0], 143u) : fq == 1 ? pkf(va[7] + vb[1], 142u) : fq == 2 ? pkf(va[8] + vb[0], 127u) : pkf(va[9] + vb[0], 111u);
            cs[11] = fq == 0 ? pkf(va[10] + vb[0], 95u) : fq == 1 ? pkf(va[11] + vb[0], 79u) : fq == 2 ? pkf(va[12] + vb[0], 63u) : pkf(va[13] + vb[0], 47u);
            cs[12] = fq == 0 ? pkf(va[14] + vb[0], 31u) : fq == 1 ? pkf(va[15] + vb[0], 15u) : fq == 2 ? -INFINITY : -INFINITY;
        }
        __builtin_amdgcn_sched_barrier(0);
        float bv[16];
#pragma unroll
        for (int rd = 0; rd < 16; ++rd) { float mx = cs[0];
#pragma unroll
            for (int j = 1; j < 13; ++j) mx = fmaxf(mx, cs[j]);
            mx = fmaxf(mx, __shfl_xor(mx, 16)); mx = fmaxf(mx, __shfl_xor(mx, 32));
#pragma unroll
            for (int j = 0; j < 13; ++j) cs[j] = (cs[j] == mx) ? -INFINITY : cs[j];
            bv[rd] = mx; }
        asm volatile("s_waitcnt lgkmcnt(0)" ::: "memory"); __builtin_amdgcn_sched_barrier(0);
        if (fq == 0) { int eid[16]; float ex[16]; float sm = 0.f; const float b0 = __uint_as_float(__float_as_uint(bv[0]) & 0xFFFFFF00u);
#pragma unroll
            for (int r = 0; r < 16; ++r) { const unsigned bits = __float_as_uint(bv[r]); const int f = 255 - (int)(bits & 255u); eid[r] = sI[fr * 32 + (f >> 4)] * 128 + sI[fr * 32 + 16 + (f & 15)];
                ex[r] = __expf(__uint_as_float(bits & 0xFFFFFF00u) - b0); sm += ex[r]; }
            const float inv = 1.f / sm; int* ep = EID + m * 128 + h * 16; float* gp = EG + m * 128 + h * 16;
#pragma unroll
            for (int r = 0; r < 16; r += 4) { *(int4*)(ep + r) = make_int4(eid[r], eid[r + 1], eid[r + 2], eid[r + 3]); *(f32x4*)(gp + r) = (f32x4){ex[r] * inv, ex[r + 1] * inv, ex[r + 2] * inv, ex[r + 3] * inv}; } }
        asm volatile("s_waitcnt lgkmcnt(0)" ::: "memory");
    }
}
typedef float f32x2_t __attribute__((ext_vector_type(2)));
__device__ __forceinline__ void dec8(const u32x4 w, f32x2_t (&f)[8]) {
    const unsigned ww[4] = {w.x, w.y, w.z, w.w};
#pragma unroll
    for (int q = 0; q < 4; ++q) { f[2 * q] = __builtin_amdgcn_cvt_pk_f32_fp8((int)ww[q], false); f[2 * q + 1] = __builtin_amdgcn_cvt_pk_f32_fp8((int)ww[q], true); }
}
__device__ __forceinline__ void ph_peer_experts(const Args& a, int l, unsigned char* lds, int wv) {
    unsigned char* ws = oport(a.ws); const int tid = otid(wv), lane = tid & 63, wave = __builtin_amdgcn_readfirstlane(tid >> 6), gw = blockIdx.x * NWAVE + wave, ngw = gridDim.x * NWAVE;
    const bf16_t* H16 = (const bf16_t*)(ws + WS_H16); const int* EID = (const int*)(ws + WS_EID); const float* EG = (const float*)(ws + WS_EG);
    const unsigned char* U8 = (const unsigned char*)(ws + WS_U16); const unsigned char* V8 = (const unsigned char*)(ws + WS_V16);
    float* sP = (float*)(lds + wave * 4096) + lane;
    for (int m = gw; m < M; m += ngw) {
        f32x2_t hp[8];
        { float hv[16]; const u32x4 h0 = *(const u32x4*)(H16 + (size_t)m * D + lane * 16), h1 = *(const u32x4*)(H16 + (size_t)m * D + lane * 16 + 8);
          hv[0] = lo_bf(h0.x); hv[1] = hi_bf(h0.x); hv[2] = lo_bf(h0.y); hv[3] = hi_bf(h0.y); hv[4] = lo_bf(h0.z); hv[5] = hi_bf(h0.z); hv[6] = lo_bf(h0.w); hv[7] = hi_bf(h0.w);
          hv[8] = lo_bf(h1.x); hv[9] = hi_bf(h1.x); hv[10] = lo_bf(h1.y); hv[11] = hi_bf(h1.y); hv[12] = lo_bf(h1.z); hv[13] = hi_bf(h1.z); hv[14] = lo_bf(h1.w); hv[15] = hi_bf(h1.w);
#pragma unroll
          for (int j = 0; j < 8; ++j) hp[j] = (f32x2_t){hv[2 * j], hv[2 * j + 1]}; }
        f32x2_t acc2[8];
#pragma unroll
        for (int j = 0; j < 8; ++j) acc2[j] = (f32x2_t){0.f, 0.f};
#pragma unroll 1
        for (int half = 0; half < 2; ++half) {
            const int ev = EID[(size_t)m * 128 + half * 64 + lane]; const float gv = EG[(size_t)m * 128 + half * 64 + lane];
            u32x4 cur[4], nxt[4];
#define ROWLD(dst, T, e_) dst = ((const u32x4*)(T + (size_t)(e_) * D))[lane]
#define BF2(a_, b_, o) (((lane & (o)) ? (b_) : (a_)) + __shfl_xor((lane & (o)) ? (a_) : (b_), (o)))
            ROWLD(cur[0], U8, __builtin_amdgcn_readlane(ev, 0)); ROWLD(cur[1], U8, __builtin_amdgcn_readlane(ev, 32)); ROWLD(cur[2], U8, __builtin_amdgcn_readlane(ev, 16)); ROWLD(cur[3], U8, __builtin_amdgcn_readlane(ev, 48));
#pragma unroll 1
            for (int g = 0; g < 16; ++g) { const int gn = g < 15 ? g + 1 : 15;
                ROWLD(nxt[0], U8, __builtin_amdgcn_readlane(ev, gn)); ROWLD(nxt[1], U8, __builtin_amdgcn_readlane(ev, gn + 32)); ROWLD(nxt[2], U8, __builtin_amdgcn_readlane(ev, gn + 16)); ROWLD(nxt[3], U8, __builtin_amdgcn_readlane(ev, gn + 48));
                float d4[4];
#pragma unroll
                for (int i = 0; i < 4; ++i) { f32x2_t f[8]; dec8(cur[i], f); f32x2_t d2 = f[0] * hp[0];
#pragma unroll
                    for (int j = 1; j < 8; ++j) d2 = __builtin_elementwise_fma(f[j], hp[j], d2);
                    d4[i] = d2.x + d2.y; }
                const float q0 = BF2(d4[0], d4[1], 32), q1 = BF2(d4[2], d4[3], 32); sP[g * 64] = BF2(q0, q1, 16);
#pragma unroll
                for (int i = 0; i < 4; ++i) cur[i] = nxt[i]; }
            float p[16];
#pragma unroll
            for (int i = 0; i < 16; ++i) p[i] = sP[i * 64];
#define BFLY(o, n) do { const bool up_ = (lane & (o)) != 0; _Pragma("unroll") for (int i_ = 0; i_ < (n); ++i_) { const float a_ = p[i_], b_ = p[i_ + (n)]; const float sd_ = up_ ? a_ : b_, kp_ = up_ ? b_ : a_; p[i_] = kp_ + __shfl_xor(sd_, (o)); } } while (0)
            BFLY(8, 8); BFLY(4, 4); BFLY(2, 2); BFLY(1, 1);
            const int svb = __builtin_bit_cast(int, gv * gelu_t(p[0] * (1.f / 256.f)) * (1.f / 64.f));
            ROWLD(cur[0], V8, __builtin_amdgcn_readlane(ev, 0)); ROWLD(cur[1], V8, __builtin_amdgcn_readlane(ev, 1)); ROWLD(cur[2], V8, __builtin_amdgcn_readlane(ev, 2)); ROWLD(cur[3], V8, __builtin_amdgcn_readlane(ev, 3));
#pragma unroll 1
            for (int g = 0; g < 16; ++g) { const int gn = g < 15 ? g + 1 : 15;
#pragma unroll
                for (int i = 0; i < 4; ++i) ROWLD(nxt[i], V8, __builtin_amdgcn_readlane(ev, 4 * gn + i));
#pragma unroll
                for (int i = 0; i < 4; ++i) { const float sk = __builtin_bit_cast(float, __builtin_amdgcn_readlane(svb, 4 * g + i)); const f32x2_t s2 = {sk, sk}; f32x2_t f[8]; dec8(cur[i], f);
#pragma unroll
                    for (int j = 0; j < 8; ++j) acc2[j] = __builtin_elementwise_fma(f[j], s2, acc2[j]); }
#pragma unroll
                for (int i = 0; i < 4; ++i) cur[i] = nxt[i]; }
#undef ROWLD
#undef BF2
#undef BFLY
        }
        float acc[16];
#pragma unroll
        for (int j = 0; j < 8; ++j) { acc[2 * j] = acc2[j].x; acc[2 * j + 1] = acc2[j].y; }
        float* xr = a.out + (size_t)m * D + lane * 16; float xn[16]; float ss = 0.f;
#pragma unroll
        for (int j = 0; j < 4; ++j) { const f32x4 xv = *(const f32x4*)(xr + 4 * j); xn[4 * j] = xv.x + acc[4 * j]; xn[4 * j + 1] = xv.y + acc[4 * j + 1]; xn[4 * j + 2] = xv.z + acc[4 * j + 2]; xn[4 * j + 3] = xv.w + acc[4 * j + 3]; }
#pragma unroll
        for (int j = 0; j < 16; ++j) ss += xn[j] * xn[j];
        const float r = rsqrtf(wave_sum(ss) * (1.f / D) + EPS);
        if (l + 1 < DEPTH) { const float* gn = a.norm1 + (size_t)(l + 1) * D + lane * 16;
#pragma unroll
            for (int j = 0; j < 4; ++j) *(f32x4*)(xr + 4 * j) = (f32x4){xn[4 * j], xn[4 * j + 1], xn[4 * j + 2], xn[4 * j + 3]};
            u32x4 w0, w1;
            w0.x = pk2(xn[0] * r * gn[0], xn[1] * r * gn[1]); w0.y = pk2(xn[2] * r * gn[2], xn[3] * r * gn[3]); w0.z = pk2(xn[4] * r * gn[4], xn[5] * r * gn[5]); w0.w = pk2(xn[6] * r * gn[6], xn[7] * r * gn[7]);
            w1.x = pk2(xn[8] * r * gn[8], xn[9] * r * gn[9]); w1.y = pk2(xn[10] * r * gn[10], xn[11] * r * gn[11]); w1.z = pk2(xn[12] * r * gn[12], xn[13] * r * gn[13]); w1.w = pk2(xn[14] * r * gn[14], xn[15] * r * gn[15]);
            *(u32x4*)((bf16_t*)(ws + WS_H16) + (size_t)m * D + lane * 16) = w0; *(u32x4*)((bf16_t*)(ws + WS_H16) + (size_t)m * D + lane * 16 + 8) = w1;
        } else { const float* gn = a.final_gain + lane * 16;
#pragma unroll
            for (int j = 0; j < 4; ++j) *(f32x4*)(xr + 4 * j) = (f32x4){xn[4 * j] * r * gn[4 * j], xn[4 * j + 1] * r * gn[4 * j + 1], xn[4 * j + 2] * r * gn[4 * j + 2], xn[4 * j + 3] * r * gn[4 * j + 3]}; }
    }
}

constexpr int PH_PER_LAYER = 9, N_PHASES = 1 + DEPTH * PH_PER_LAYER;
__global__ void __launch_bounds__(NTHR, 2) fwd_kernel(Args a) {
    extern __shared__ __attribute__((aligned(16))) unsigned char lds[];
    const int wv = __builtin_amdgcn_readfirstlane((int)threadIdx.x >> 6);
    const int tid = threadIdx.x;
    for (int u = tid; u < (LDS_BYTES - LDS_CTL_OFF) / 4; u += NTHR) ((unsigned*)(lds + LDS_CTL_OFF))[u] = 0u;
    __syncthreads();
    unsigned* ctl = (unsigned*)(a.ws + WS_CTL);
    XcdBarrier bar = xcd_barrier_post(ctl + 4096, (volatile LAS unsigned*)(LAS unsigned char*)(lds + LDS_CTL_OFF), wv);
    const int lo = a.ph_lo, hi = a.ph_hi;
#define IN(k) (lo <= (k) && (k) < hi)
#define SEAM(k) do { if (IN(k) && IN((k) + 1)) xcd_barrier(bar, wv); } while (0)
    unsigned char* ws = oport(a.ws);
    if (IN(0)) { ph_prologue(a, lds, wv); } SEAM(0);
    for (int l = 0; l < DEPTH; ++l) {
        const int pb = 1 + l * PH_PER_LAYER;
        if (IN(pb + 0)) {
            ph_kiwi(a, l, wv);
            pg8::Gemm g{(const bf16_t*)(ws + WS_H16), (const bf16_t*)(ws + WS_WIN + (size_t)l * WIN_L), M, NMAIN, D, 0, 0};
            pg8::StaticOrder S; S.init(M, NMAIN, gridDim.x, blockIdx.x, 0);
            pg8::EpiIn E{(bf16_t*)(ws + WS_P16), (float*)(ws + WS_PF)};
            pg8::gemm_phase(((LAS unsigned char*)lds), g, S, E, wv);
        } SEAM(pb + 0);
        if (IN(pb + 1)) { ph_post(a, l, lds, wv); ph_h1(a, l, lds, wv); } SEAM(pb + 1);
        if (IN(pb + 2)) { ph_h2(a, wv); ph_gmlp(a, l, lds, wv); ph_sel(a, lds, wv); } SEAM(pb + 2);
        if (IN(pb + 3)) { ph_attn(a, lds, wv); ph_h3(a, l, lds, wv); } SEAM(pb + 3);
        if (IN(pb + 4)) {
            pg8::Gemm g{(const bf16_t*)(ws + WS_YALL), (const bf16_t*)(ws + WS_WBR + (size_t)l * WBR_L), M, 3072, 512, (size_t)M * 512 * 2, 4};
            pg8::BranchOrder S; S.init(gridDim.x, blockIdx.x);
            pg8::EpiGate E{(bf16_t*)(ws + WS_GB), (const bf16_t*)(ws + WS_P16)};
            pg8::gemm_phase(((LAS unsigned char*)lds), g, S, E, wv);
        } SEAM(pb + 4);
        if (IN(pb + 5)) {
            pg8::Gemm g{(const bf16_t*)(ws + WS_GB), (const bf16_t*)(ws + WS_WOUT + (size_t)l * WOUT_L), M, D, D, 0, 0};
            pg8::StaticOrder S; S.init(M, D, gridDim.x, blockIdx.x, 0);
            pg8::EpiRes E{a.out};
            pg8::gemm_phase(((LAS unsigned char*)lds), g, S, E, wv);
        } SEAM(pb + 5);
        if (IN(pb + 6)) { ph_norm2(a, l, wv); } SEAM(pb + 6);
        if (IN(pb + 7)) {
            pg8::Gemm g{(const bf16_t*)(ws + WS_H16), (const bf16_t*)(ws + WS_WPQ + (size_t)l * WPQ_L), M, 2048, D, 0, 0};
            pg8::StaticOrder S; S.init(M, 2048, gridDim.x, blockIdx.x, 0);
            pg8::EpiB16 E{(bf16_t*)(ws + WS_GB), 2048};
            pg8::gemm_phase(((LAS unsigned char*)lds), g, S, E, wv);
            asm volatile("s_waitcnt vmcnt(0)" ::: "memory"); __syncthreads();
            for (int i0_ = 0;; i0_ += 2) { pg8::Unit u0, u1; if (!S.next(i0_, u0)) break; const bool two = S.next(i0_ + 1, u1);
                ph_peer_select(a, l, lds, wv, two ? 2 : 1, u0.pm, u0.pn, two ? u1.pm : 0, two ? u1.pn : 0); }
        } SEAM(pb + 7);
        if (IN(pb + 8)) { ph_peer_experts(a, l, lds, wv); } SEAM(pb + 8);
    }
#undef IN
#undef SEAM
}

#ifndef MK_N_LAUNCHES
#define MK_N_LAUNCHES 1
#endif
extern "C" void kernel_launch(void* const* d_in, const int* in_sizes, int n_in, void* d_out, int out_size, void* d_ws, size_t ws_size, hipStream_t stream) {
    static int grid = 0;
    if (grid == 0) {
        if (n_in != 17 || out_size != M * D || ws_size < WS_END) { fprintf(stderr, "kernel_launch: unexpected shapes (n_in %d, out %d, ws %zu)\n", n_in, out_size, ws_size); grid = -1; return; }
        int dev = 0, cus = 0, per_cu = 0;
        if (hipGetDevice(&dev) != hipSuccess || hipDeviceGetAttribute(&cus, hipDeviceAttributeMultiprocessorCount, dev) != hipSuccess) { grid = -1; return; }
        if (hipFuncSetAttribute((const void*)fwd_kernel, hipFuncAttributeMaxDynamicSharedMemorySize, LDS_BYTES) != hipSuccess) { fprintf(stderr, "kernel_launch: hipFuncSetAttribute failed\n"); grid = -1; return; }
        if (hipOccupancyMaxActiveBlocksPerMultiprocessor(&per_cu, (const void*)fwd_kernel, NTHR, LDS_BYTES) != hipSuccess || per_cu < 1) { fprintf(stderr, "kernel_launch: occupancy query says %d\n", per_cu); (void)hipGetLastError(); grid = -1; return; }
        grid = cus;
    }
    if (grid < 0) return;
    (void)hipMemsetAsync((char*)d_ws + WS_CTL, 0, CTL_BYTES, stream);
    Args a{};
    a.x = (const float*)d_in[0]; a.pos = (const int*)d_in[1]; a.norm1 = (const float*)d_in[2]; a.w_in = (const float*)d_in[3]; a.lb_logits = (const float*)d_in[4]; a.hgrn_gain = (const float*)d_in[5];
    a.gmlp_gain = (const float*)d_in[6]; a.gmlp_ws = (const float*)d_in[7]; a.gmlp_bs = (const float*)d_in[8]; a.w_branch = (const float*)d_in[9]; a.w_out = (const float*)d_in[10]; a.norm2 = (const float*)d_in[11];
    a.peer_wq = (const float*)d_in[12]; a.peer_keys = (const float*)d_in[13]; a.peer_u = (const float*)d_in[14]; a.peer_v = (const float*)d_in[15]; a.final_gain = (const float*)d_in[16];
    a.out = (float*)d_out; a.ws = (unsigned char*)d_ws;
    if (MK_N_LAUNCHES == 1) { a.ph_lo = 0; a.ph_hi = N_PHASES; hipLaunchKernelGGL(fwd_kernel, dim3(grid), dim3(NTHR), LDS_BYTES, stream, a); }
    else for (int p = 0; p < N_PHASES; ++p) { a.ph_lo = p; a.ph_hi = p + 1; hipLaunchKernelGGL(fwd_kernel, dim3(grid), dim3(NTHR), LDS_BYTES, stream, a); }
}
```

```cpp
#include <hip/hip_runtime.h>
#include <cstdio>
#include <cstdint>

#define LAS __attribute__((address_space(3)))
typedef unsigned short bf16_t;
typedef short bf16x8 __attribute__((ext_vector_type(8)));
typedef float f32x4 __attribute__((ext_vector_type(4)));
typedef unsigned u32x4 __attribute__((ext_vector_type(4)));

constexpr int D = 1024, BATCH = 2, SEQ = 8192, DEPTH = 4, M = BATCH * SEQ;
constexpr int NIN = 8264;
constexpr int NPAD = 8448;
constexpr int C_AQ = 0, C_AF = 512, C_AI = 1024, C_AG = 1536, C_BU = 2048, C_BV = 2560, C_CQ = 3072, C_CK = 3584, C_CV = 4096, C_QI = 4608, C_GL = 5120, C_KI = 8192, C_WI = 8256;
constexpr int NMAIN = 8192;
constexpr int S_GL = 5192;
constexpr int PFW = 768;
constexpr float EPS = 1e-6f;
constexpr int NEXP = 16384;

constexpr size_t MiB = 1u << 20;
constexpr size_t WS_CTL = 0, CTL_BYTES = 1 * MiB;
constexpr size_t WS_WIN = 2 * MiB;
constexpr size_t WIN_L = (size_t)NPAD * D * 2;
constexpr size_t WS_WBR = 68 * MiB;
constexpr size_t WBR_L = (size_t)3072 * 512 * 2;
constexpr size_t WS_WOUT = 80 * MiB;
constexpr size_t WOUT_L = (size_t)1024 * 3072 * 2;
constexpr size_t WS_WPQ = 104 * MiB;
constexpr size_t WPQ_L = (size_t)2048 * 1024 * 2;
constexpr size_t WS_LB = 120 * MiB;
constexpr size_t WS_CS = 121 * MiB;
constexpr size_t WS_H16 = 134 * MiB;
constexpr size_t WS_P16 = 166 * MiB;
constexpr size_t WS_PF = 430 * MiB;
constexpr size_t WS_QR = 478 * MiB, WS_KR = 494 * MiB;
constexpr size_t WS_QI = 510 * MiB;
constexpr size_t WS_KI = 542 * MiB;
constexpr size_t WS_WI = 546 * MiB;
constexpr size_t WS_FF = 548 * MiB, WS_KK = 580 * MiB, WS_QF = 612 * MiB;
constexpr size_t WS_OA = 644 * MiB;
constexpr size_t WS_VN = 676 * MiB;
constexpr size_t WS_YALL = 708 * MiB;
constexpr size_t WS_GB = 756 * MiB;
constexpr size_t WS_EID = 852 * MiB, WS_EG = 860 * MiB;
constexpr size_t WS_DD = 120 * MiB + 256 * 1024;
constexpr size_t WS_WSB = 544 * MiB;
constexpr size_t WS_VT = 644 * MiB;
constexpr size_t WS_MASK = 660 * MiB;
constexpr size_t WS_U16 = 868 * MiB, WS_V16 = 900 * MiB;
constexpr size_t WS_SKB = 932 * MiB;
constexpr size_t WS_END = 934 * MiB;

__device__ const float ROPE_INV64[64] = {
1.000000000e+00f, 8.659643531e-01f, 7.498942614e-01f, 6.493816376e-01f, 5.623413324e-01f, 4.869675338e-01f, 4.216965139e-01f, 3.651741147e-01f, 3.162277639e-01f, 2.738419771e-01f, 2.371373773e-01f, 2.053525001e-01f, 1.778279394e-01f, 1.539926529e-01f, 1.333521307e-01f, 1.154782027e-01f, 1.000000015e-01f, 8.659642935e-02f, 7.498941571e-02f, 6.493816525e-02f, 5.623413250e-02f, 4.869675264e-02f, 4.216965288e-02f, 3.651741147e-02f, 3.162277490e-02f, 2.738419734e-02f, 2.371373773e-02f, 2.053525113e-02f, 1.778279431e-02f, 1.539926510e-02f, 1.333521493e-02f, 1.154782064e-02f, 9.999999776e-03f, 8.659643121e-03f, 7.498941850e-03f, 6.493816152e-03f, 5.623413250e-03f, 4.869675264e-03f, 4.216964822e-03f, 3.651741194e-03f, 3.162277630e-03f, 2.738419687e-03f, 2.371373586e-03f, 2.053524833e-03f, 1.778279431e-03f, 1.539926510e-03f, 1.333521446e-03f, 1.154781901e-03f, 1.000000047e-03f, 8.659643354e-04f, 7.498942432e-04f, 6.493816618e-04f, 5.623413017e-04f, 4.869675322e-04f, 4.216965172e-04f, 3.651741426e-04f, 3.162277571e-04f, 2.738419571e-04f, 2.371373703e-04f, 2.053525095e-04f, 1.778279402e-04f, 1.539926452e-04f, 1.333521504e-04f, 1.154782003e-04f};
__device__ const float ROPE_INV32[32] = {
1.000000000e+00f, 7.498942614e-01f, 5.623413324e-01f, 4.216965139e-01f, 3.162277639e-01f, 2.371373773e-01f, 1.778279394e-01f, 1.333521307e-01f, 1.000000015e-01f, 7.498941571e-02f, 5.623413250e-02f, 4.216965288e-02f, 3.162277490e-02f, 2.371373773e-02f, 1.778279431e-02f, 1.333521493e-02f, 9.999999776e-03f, 7.498941850e-03f, 5.623413250e-03f, 4.216964822e-03f, 3.162277630e-03f, 2.371373586e-03f, 1.778279431e-03f, 1.333521446e-03f, 1.000000047e-03f, 7.498942432e-04f, 5.623413017e-04f, 4.216965172e-04f, 3.162277571e-04f, 2.371373703e-04f, 1.778279402e-04f, 1.333521504e-04f};

__device__ __forceinline__ float bf2f(bf16_t b) { return __uint_as_float(((unsigned)b) << 16); }
__device__ __forceinline__ unsigned f2bf(float f) { unsigned u = __float_as_uint(f); return (u + 0x7fffu + ((u >> 16) & 1u)) >> 16; }
__device__ __forceinline__ unsigned pk2(float lo, float hi) { return f2bf(lo) | (f2bf(hi) << 16); }
__device__ __forceinline__ float lo_bf(unsigned w) { return __uint_as_float(w << 16); }
__device__ __forceinline__ float hi_bf(unsigned w) { return __uint_as_float(w & 0xffff0000u); }
__device__ __forceinline__ float sigm(float x) { return 1.f / (1.f + __expf(-x)); }
__device__ __forceinline__ float silu(float x) { return x * sigm(x); }
__device__ __forceinline__ float gelu_t(float x) { const float u = 0.7978845608028654f * (x + 0.044715f * x * x * x); const float th = 1.f - 2.f / (1.f + __expf(2.f * u)); return 0.5f * x * (1.f + th); }
__device__ __forceinline__ float wave_sum(float v) {
#pragma unroll
    for (int o = 1; o < 64; o <<= 1) v += __shfl_xor(v, o);
    return v;
}
__device__ __forceinline__ float wave_max(float v) {
#pragma unroll
    for (int o = 1; o < 64; o <<= 1) v = fmaxf(v, __shfl_xor(v, o));
    return v;
}
typedef __bf16 bf2_t __attribute__((ext_vector_type(2)));
__device__ __forceinline__ float dot2(unsigned a, unsigned b, float c) { return __builtin_amdgcn_fdot2_f32_bf16(__builtin_bit_cast(bf2_t, a), __builtin_bit_cast(bf2_t, b), c, false); }
__device__ __forceinline__ int otid(int wv) { int t; asm volatile("v_mbcnt_lo_u32_b32 %0, -1, 0\n\tv_mbcnt_hi_u32_b32 %0, -1, %0" : "=v"(t)); return wv * 64 + t; }
__device__ __forceinline__ unsigned char* oport(unsigned char* p) { unsigned long long z; asm volatile("s_mov_b64 %0, 0" : "=s"(z)); return p + z; }
__device__ __forceinline__ unsigned fkey(float f) { const unsigned u = __float_as_uint(f); return u ^ ((u >> 31) ? 0xFFFFFFFFu : 0x80000000u); }

#define XB_TMO      128
#define XB_XCNT(j)  (256  + 64 * (j))
#define XB_XSUB(j)  (1280 + 64 * (j))
#define XB_XGEN(j)  (2304 + 64 * (j))
#define XB_TOP      3328
#define XB_TOPGEN   3392
#define XCD_BAR_WORDS 3456
#define XB_SPIN_CAP (1u << 23)
__device__ __forceinline__ unsigned xb_ld(unsigned* p)              { return __hip_atomic_load(p, __ATOMIC_RELAXED, __HIP_MEMORY_SCOPE_AGENT); }
__device__ __forceinline__ unsigned xb_add(unsigned* p, unsigned v) { return __hip_atomic_fetch_add(p, v, __ATOMIC_RELAXED, __HIP_MEMORY_SCOPE_AGENT); }
__device__ __forceinline__ unsigned xb_xcc_id() { return (unsigned)__builtin_amdgcn_s_getreg((3 << 11) | 20) & 0xFu; }
#define XB_SPIN(cond, bar) do { unsigned _sp = 0; while (cond) { __builtin_amdgcn_s_sleep(1); \
    if ((++_sp & 255u) == 0u) { if (xb_ld(&(bar)[XB_TMO])) break; if (_sp > XB_SPIN_CAP) { atomicAdd(&(bar)[XB_TMO], 1u); break; } } } } while (0)
struct XcdBarrier { unsigned* bar; unsigned x; volatile LAS unsigned* st; };
__device__ __forceinline__ XcdBarrier xcd_barrier_post(unsigned* bar, volatile LAS unsigned* st, int wv) {
    XcdBarrier b; b.bar = bar; b.x = xb_xcc_id(); b.st = st;
    if (otid(wv) == 0) (void)xb_add(&bar[XB_XCNT(b.x)], 1u);
    return b;
}
__device__ __forceinline__ void xcd_barrier_complete(unsigned* bar, unsigned x, unsigned& nloc, unsigned& nx) {
    const unsigned G = gridDim.x * gridDim.y * gridDim.z;
    unsigned sum, cnt, mine, sp = 0u;
    for (;;) {
        sum = 0u; cnt = 0u; mine = 0u;
#pragma unroll
        for (unsigned j = 0; j < 16; ++j) { const unsigned c = xb_ld(&bar[XB_XCNT(j)]); sum += c; cnt += (c > 0u) ? 1u : 0u; mine = (j == x) ? c : mine; }
        if (sum == G) break;
        __builtin_amdgcn_s_sleep(1);
        if ((++sp & 255u) == 0u) { if (xb_ld(&bar[XB_TMO])) break; if (sp > XB_SPIN_CAP) { atomicAdd(&bar[XB_TMO], 1u); break; } }
    }
    nloc = mine > 0u ? mine : 1u; nx = cnt > 0u ? cnt : 1u;
}
__device__ __forceinline__ void xcd_barrier(const XcdBarrier& b, int wv) {
    asm volatile("s_waitcnt vmcnt(0)" ::: "memory");
    __syncthreads();
    if (otid(wv) == 0) {
        unsigned* bar = b.bar;
        __builtin_amdgcn_s_waitcnt(0);
        unsigned nloc = b.st[0], nx = b.st[1];
        if (nloc == 0u) { xcd_barrier_complete(bar, b.x, nloc, nx); b.st[0] = nloc; b.st[1] = nx; }
        const unsigned old = xb_add(&bar[XB_XSUB(b.x)], 1u);
        const unsigned gen = old / nloc;
        if (old + 1u == (gen + 1u) * nloc) {
            __builtin_amdgcn_fence(__ATOMIC_RELEASE, "agent");
            asm volatile("s_waitcnt vmcnt(0)" ::: "memory");
            const unsigned og = xb_add(&bar[XB_TOP], 1u);
            const unsigned tg = og / nx;
            if (og + 1u == (tg + 1u) * nx) xb_add(&bar[XB_TOPGEN], 1u);
            else XB_SPIN(xb_ld(&bar[XB_TOPGEN]) == tg, bar);
            __builtin_amdgcn_fence(__ATOMIC_ACQUIRE, "agent");
            xb_add(&bar[XB_XGEN(b.x)], 1u);
            asm volatile("s_waitcnt vmcnt(0)" ::: "memory");
        } else {
            XB_SPIN(xb_ld(&bar[XB_XGEN(b.x)]) == gen, bar);
            __builtin_amdgcn_fence(__ATOMIC_ACQUIRE, "agent");
            asm volatile("s_waitcnt vmcnt(0)" ::: "memory");
        }
    }
    __syncthreads();
}

namespace pg8 {
constexpr int BM = 256, BK = 64, HALF = 128, HTB = HALF * BK * 2, STAGE_BYTES = 8 * HTB, NXCD = 8, WGM = 8;
__host__ __device__ __forceinline__ int lds_byte(int r, int c) { const int st = (r >> 4) * 2 + (c >> 5), rr = r & 15, cc = c & 31, ob = rr * 64 + cc * 2; return st * 1024 + (ob ^ (((ob >> 9) & 1) << 5)); }
__host__ __device__ __forceinline__ void stage_rc(int b, int& R, int& C) { const int st = b / 1024, sb = b % 1024, swz = sb ^ (((sb >> 9) & 1) << 5); R = (st >> 1) * 16 + swz / 64; C = (st & 1) * 32 + (swz % 64) / 2; }
__host__ __device__ __forceinline__ int perm32(int rho) { const int n = rho >> 4, i = rho & 15; return 8 * (i >> 2) + 4 * n + (i & 3); }
struct Unit { int pm, pn, ka; };
struct Gemm { const bf16_t* A; const bf16_t* Bt; int M, N, K; size_t strideA; int nsplit; };
struct StaticOrder {
    int nM, nN, nwg, G, c, nsplit;
    __device__ __forceinline__ void init(int M_, int N_, int G_, int c_, int nsplit_) { nM = M_ / BM; nN = N_ / BM; nwg = nM * nN; G = G_; c = c_; nsplit = nsplit_; }
    __device__ __forceinline__ bool next(int i, Unit& u) const {
        const long L = (long)i * G + c; if (L >= nwg) return false;
        int wgid = (int)L; { const int q = nwg / NXCD, r = nwg % NXCD, xcd = wgid % NXCD, off = wgid / NXCD; wgid = (xcd < r ? xcd * (q + 1) : r * (q + 1) + (xcd - r) * q) + off; }
        const int nig = WGM * nN, gid = wgid / nig, fm = gid * WGM, gsz = (nM - fm) < WGM ? (nM - fm) : WGM;
        u.pm = fm + ((wgid % nig) % gsz); u.pn = (wgid % nig) / gsz; u.ka = nsplit ? u.pn / nsplit : 0; return true;
    }
};
__device__ __forceinline__ unsigned cvt_pk_bf16(float lo, float hi) { unsigned r; asm volatile("v_cvt_pk_bf16_f32 %0, %1, %2" : "=v"(r) : "v"(lo), "v"(hi)); return r; }

template <class Epi, class Sched>
__device__ __forceinline__ void gemm_phase(LAS unsigned char* lds, const Gemm g, const Sched& S, const Epi& E, int wv) {
    const int tid = otid(wv), wid = __builtin_amdgcn_readfirstlane(tid >> 6), lane = tid & 63, wr = wid >> 2, wc = wid & 3, fr = lane & 15, fq = lane >> 4;
    const int K = g.K, nt = K / BK;
    unsigned voffA[2], voffB[2];
#pragma unroll
    for (int i = 0; i < 2; ++i) { int R, C; stage_rc(tid * 16 + i * 8192, R, C); const int Rb = Epi::PERM ? ((R & ~31) + perm32(R & 31)) : R;
        voffA[i] = (unsigned)(R * K + C) * 2u; voffB[i] = (unsigned)(Rb * K + C) * 2u; }
    const size_t kstep = (size_t)(BK * 2);
    const size_t hstep = (size_t)HALF * K * 2;
    const size_t tstep = 2 * hstep;
    const unsigned ldsw = (unsigned)wid * 1024u;
    const int aoff = lds_byte(wr * 64 + fr, fq * 8), boff = lds_byte(wc * 32 + fr, fq * 8);
#define PG8_SA(b, h) (((b) * 2 + (h)) * HTB)
#define PG8_SB(b, h) ((4 + (b) * 2 + (h)) * HTB)
#define PG8_STAGE(bufoff, gbase, voff) do { _Pragma("unroll") for (int _i = 0; _i < 2; ++_i) \
        __builtin_amdgcn_global_load_lds((const unsigned*)((const char*)(gbase) + (voff)[_i]), (LAS unsigned*)(lds + (bufoff) + ldsw + _i * 8192), 16, 0, 0); } while (0)
#define PG8_LDA(dst, b, h) do { _Pragma("unroll") for (int m = 0; m < 4; ++m) _Pragma("unroll") for (int k = 0; k < 2; ++k) dst[m][k] = *(const LAS bf16x8*)(lds + PG8_SA(b, h) + aoff + m * 2048 + k * 1024); } while (0)
#define PG8_LDB(dst, b, h) do { _Pragma("unroll") for (int n = 0; n < 2; ++n) _Pragma("unroll") for (int k = 0; k < 2; ++k) dst[n][k] = *(const LAS bf16x8*)(lds + PG8_SB(b, h) + boff + n * 2048 + k * 1024); } while (0)
#define PG8_MMA(ai, bj, At, Bt) do { __builtin_amdgcn_s_setprio(1); _Pragma("unroll") for (int m = 0; m < 4; ++m) _Pragma("unroll") for (int n = 0; n < 2; ++n) _Pragma("unroll") for (int k = 0; k < 2; ++k) \
        acc[ai][bj][m][n] = __builtin_amdgcn_mfma_f32_16x16x32_bf16(Bt[n][k], At[m][k], acc[ai][bj][m][n], 0, 0, 0); __builtin_amdgcn_s_setprio(0); } while (0)
#define PG8_WAIT_V(n) asm volatile("s_waitcnt vmcnt(" #n ")" ::: "memory")
#define PG8_WAIT_L(n) asm volatile("s_waitcnt lgkmcnt(" #n ")" ::: "memory")
#define PG8_BAR __builtin_amdgcn_s_barrier()
#define PG8_SCHED __builtin_amdgcn_sched_barrier(0)
    Unit cur, nxt; int ui = 0;
    if (!S.next(0, cur)) return;
    f32x4 acc[2][2][4][2];
#pragma unroll
    for (int a = 0; a < 2; ++a)
#pragma unroll
        for (int b = 0; b < 2; ++b)
#pragma unroll
            for (int m = 0; m < 4; ++m)
#pragma unroll
                for (int n = 0; n < 2; ++n) acc[a][b][m][n] = (f32x4){0.f, 0.f, 0.f, 0.f};
    bf16x8 At[4][2], B0[2][2], B1[2][2];
    const char* cA = (const char*)g.A + (size_t)cur.ka * g.strideA + (size_t)cur.pm * tstep; const char* cB = (const char*)g.Bt + (size_t)cur.pn * tstep;
    PG8_STAGE(PG8_SB(0, 0), cB, voffB); PG8_STAGE(PG8_SA(0, 0), cA, voffA); PG8_STAGE(PG8_SB(0, 1), cB + hstep, voffB); PG8_STAGE(PG8_SA(0, 1), cA + hstep, voffA);
    if (wr == 1) PG8_BAR;
    PG8_WAIT_V(4); PG8_BAR;
    PG8_STAGE(PG8_SB(1, 0), cB + kstep, voffB); PG8_STAGE(PG8_SA(1, 0), cA + kstep, voffA); PG8_STAGE(PG8_SB(1, 1), cB + hstep + kstep, voffB);
    PG8_WAIT_V(6); PG8_BAR;
    for (;;) {
        const bool has_next = S.next(ui + 1, nxt);
        const char* nA = has_next ? (const char*)g.A + (size_t)nxt.ka * g.strideA + (size_t)nxt.pm * tstep : cA; const char* nB = has_next ? (const char*)g.Bt + (size_t)nxt.pn * tstep : cB;
        for (int t = 0; t < nt; t += 2) {
            const bool last = (t == nt - 2);
            const char* a1 = cA + (size_t)(t + 1) * kstep;
            const char* a2 = last ? nA : cA + (size_t)(t + 2) * kstep; const char* b2 = last ? nB : cB + (size_t)(t + 2) * kstep;
            const char* a3 = a2 + kstep; const char* b3 = b2 + kstep;
            PG8_LDB(B0, 0, 0); PG8_SCHED; PG8_LDA(At, 0, 0); PG8_STAGE(PG8_SA(1, 1), a1 + hstep, voffA);
            PG8_WAIT_L(8); PG8_BAR; PG8_WAIT_L(0); PG8_MMA(0, 0, At, B0); PG8_BAR; PG8_SCHED;
            PG8_LDB(B1, 0, 1); PG8_STAGE(PG8_SB(0, 0), b2, voffB);
            PG8_BAR; PG8_WAIT_L(0); PG8_MMA(0, 1, At, B1); PG8_BAR;
            PG8_LDA(At, 0, 1); PG8_STAGE(PG8_SA(0, 0), a2, voffA);
            PG8_BAR; PG8_WAIT_L(0); PG8_MMA(1, 0, At, B0); PG8_BAR; PG8_SCHED;
            PG8_STAGE(PG8_SB(0, 1), b2 + hstep, voffB);
            PG8_WAIT_V(6); PG8_BAR; PG8_MMA(1, 1, At, B1); PG8_BAR;
            PG8_LDB(B0, 1, 0); PG8_SCHED; PG8_LDA(At, 1, 0); PG8_STAGE(PG8_SA(0, 1), a2 + hstep, voffA);
            PG8_WAIT_L(8); PG8_BAR; PG8_WAIT_L(0); PG8_MMA(0, 0, At, B0); PG8_BAR; PG8_SCHED;
            PG8_LDB(B1, 1, 1); PG8_STAGE(PG8_SB(1, 0), b3, voffB);
            PG8_BAR; PG8_WAIT_L(0); PG8_MMA(0, 1, At, B1); PG8_BAR;
            PG8_LDA(At, 1, 1); PG8_STAGE(PG8_SA(1, 0), a3, voffA);
            PG8_BAR; PG8_WAIT_L(0); PG8_MMA(1, 0, At, B0); PG8_BAR; PG8_SCHED;
            PG8_STAGE(PG8_SB(1, 1), b3 + hstep, voffB);
            PG8_WAIT_V(6); PG8_BAR; PG8_MMA(1, 1, At, B1); PG8_BAR;
        }
        E(acc, cur, wr, wc, fr, fq);
        if (!has_next) break;
        if (!E.keep(cur))
#pragma unroll
        for (int a = 0; a < 2; ++a)
#pragma unroll
            for (int b = 0; b < 2; ++b)
#pragma unroll
                for (int m = 0; m < 4; ++m)
#pragma unroll
                    for (int n = 0; n < 2; ++n) acc[a][b][m][n] = (f32x4){0.f, 0.f, 0.f, 0.f};
        cur = nxt; cA = nA; cB = nB; ++ui;
    }
    PG8_WAIT_V(0);
    if (wr == 0) PG8_BAR;
    PG8_BAR;
#undef PG8_SA
#undef PG8_SB
#undef PG8_STAGE
#undef PG8_LDA
#undef PG8_LDB
#undef PG8_MMA
#undef PG8_WAIT_V
#undef PG8_WAIT_L
#undef PG8_BAR
#undef PG8_SCHED
}

struct EpiIn {
    __device__ __forceinline__ bool keep(const Unit&) const { return false; }
    static constexpr bool PERM = true;
    bf16_t* P16; float* PF;
    __device__ __forceinline__ void operator()(f32x4 (&acc)[2][2][4][2], const Unit& u, int wr, int wc, int fr, int fq) const {
        const int row0 = u.pm * BM + wr * 64 + fr, col0 = u.pn * BM + wc * 32 + 8 * fq;
        const bool f32t = (u.pn == 2) || (u.pn == 3), gate = u.pn >= C_GL / 256;
        const int pfc0 = (u.pn - 2) * 256 + wc * 32 + 8 * fq;
#pragma unroll
        for (int ai = 0; ai < 2; ++ai)
#pragma unroll
            for (int m = 0; m < 4; ++m) { const size_t row = (size_t)(row0 + ai * HALF + m * 16);
#pragma unroll
                for (int bj = 0; bj < 2; ++bj) { f32x4 v0 = acc[ai][bj][m][0], v1 = acc[ai][bj][m][1];
                    if (gate) {
#pragma unroll
                        for (int j = 0; j < 4; ++j) { v0[j] = sigm(v0[j]); v1[j] = sigm(v1[j]); } }
                    u32x4 w; w.x = cvt_pk_bf16(v0[0], v0[1]); w.y = cvt_pk_bf16(v0[2], v0[3]); w.z = cvt_pk_bf16(v1[0], v1[1]); w.w = cvt_pk_bf16(v1[2], v1[3]);
                    *(u32x4*)(P16 + row * NPAD + col0 + bj * HALF) = w;
                    if (f32t) { float* pf = PF + row * PFW + pfc0 + bj * HALF; *(f32x4*)pf = v0; *(f32x4*)(pf + 4) = v1; } } }
    }
};
struct EpiGate {
    static constexpr bool PERM = true;
    bf16_t* GS; const bf16_t* P16;
    __device__ __forceinline__ bool keep(const Unit& u) const { return (u.pn >> 2) < 2; }
    __device__ __forceinline__ void operator()(f32x4 (&acc)[2][2][4][2], const Unit& u, int wr, int wc, int fr, int fq) const {
        const int n = u.pn >> 2, row0 = u.pm * BM + wr * 64 + fr, col0 = (u.pn & 3) * BM + wc * 32 + 8 * fq;
#pragma unroll
        for (int ai = 0; ai < 2; ++ai)
#pragma unroll
            for (int m = 0; m < 4; ++m) { const size_t row = (size_t)(row0 + ai * HALF + m * 16);
#pragma unroll
                for (int bj = 0; bj < 2; ++bj) { f32x4& v0 = acc[ai][bj][m][0]; f32x4& v1 = acc[ai][bj][m][1];
                    const u32x4 gw = *(const u32x4*)(P16 + row * NPAD + C_GL + n * 1024 + col0 + bj * HALF);
                    const float g[8] = {lo_bf(gw.x), hi_bf(gw.x), lo_bf(gw.y), hi_bf(gw.y), lo_bf(gw.z), hi_bf(gw.z), lo_bf(gw.w), hi_bf(gw.w)};
                    if (n < 2) { const u32x4 hw = *(const u32x4*)(P16 + row * NPAD + C_GL + (n + 1) * 1024 + col0 + bj * HALF);
                        const float h[8] = {lo_bf(hw.x), hi_bf(hw.x), lo_bf(hw.y), hi_bf(hw.y), lo_bf(hw.z), hi_bf(hw.z), lo_bf(hw.w), hi_bf(hw.w)};
#pragma unroll
                        for (int j = 0; j < 4; ++j) { v0[j] *= g[j] * __builtin_amdgcn_rcpf(h[j]); v1[j] *= g[4 + j] * __builtin_amdgcn_rcpf(h[4 + j]); }
                    } else { u32x4 w;
                        w.x = cvt_pk_bf16(v0[0] * g[0], v0[1] * g[1]); w.y = cvt_pk_bf16(v0[2] * g[2], v0[3] * g[3]);
                        w.z = cvt_pk_bf16(v1[0] * g[4], v1[1] * g[5]); w.w = cvt_pk_bf16(v1[2] * g[6], v1[3] * g[7]);
                        *(u32x4*)(GS + row * D + col0 + bj * HALF) = w; } } }
    }
};
struct BranchOrder {
    StaticOrder so; int G;
    __device__ __forceinline__ void init(int G_, int c_) { so.init(M, 1024, G_, c_, 0); G = G_; }
    __device__ __forceinline__ bool next(int i, Unit& u) const { Unit t; if (!so.next(i / 3, t)) return false; const int n = i % 3; u.pm = t.pm; u.pn = n * 4 + t.pn; u.ka = n; return true; }
};
struct EpiRes {
    __device__ __forceinline__ bool keep(const Unit&) const { return false; }
    static constexpr bool PERM = false;
    float* X;
    __device__ __forceinline__ void operator()(f32x4 (&acc)[2][2][4][2], const Unit& u, int wr, int wc, int fr, int fq) const {
        const int row0 = u.pm * BM + wr * 64 + fr, col0 = u.pn * BM + wc * 32 + 4 * fq;
#pragma unroll
        for (int ai = 0; ai < 2; ++ai)
#pragma unroll
            for (int m = 0; m < 4; ++m) { float* rowp = X + (size_t)(row0 + ai * HALF + m * 16) * D + col0;
#pragma unroll
                for (int bj = 0; bj < 2; ++bj)
#pragma unroll
                    for (int n = 0; n < 2; ++n) { f32x4* p = (f32x4*)(rowp + bj * HALF + n * 16); *p = *p + acc[ai][bj][m][n]; } }
    }
};
struct EpiB16 {
    __device__ __forceinline__ bool keep(const Unit&) const { return false; }
    static constexpr bool PERM = true;
    bf16_t* O; int ldc;
    __device__ __forceinline__ void operator()(f32x4 (&acc)[2][2][4][2], const Unit& u, int wr, int wc, int fr, int fq) const {
        const int row0 = u.pm * BM + wr * 64 + fr, col0 = u.pn * BM + wc * 32 + 8 * fq;
#pragma unroll
        for (int ai = 0; ai < 2; ++ai)
#pragma unroll
            for (int m = 0; m < 4; ++m) { bf16_t* rowp = O + (size_t)(row0 + ai * HALF + m * 16) * ldc + col0;
#pragma unroll
                for (int bj = 0; bj < 2; ++bj) { const f32x4 v0 = acc[ai][bj][m][0], v1 = acc[ai][bj][m][1];
                    u32x4 w; w.x = cvt_pk_bf16(v0[0], v0[1]); w.y = cvt_pk_bf16(v0[2], v0[3]); w.z = cvt_pk_bf16(v1[0], v1[1]); w.w = cvt_pk_bf16(v1[2], v1[3]);
                    *(u32x4*)(rowp + bj * HALF) = w; } }
    }
};
}

struct Args {
    const float* x; const int* pos; const float* norm1; const float* w_in; const float* lb_logits; const float* hgrn_gain; const float* gmlp_gain; const float* gmlp_ws; const float* gmlp_bs;
    const float* w_branch; const float* w_out; const float* norm2; const float* peer_wq; const float* peer_keys; const float* peer_u; const float* peer_v; const float* final_gain;
    float* out; unsigned char* ws; int ph_lo, ph_hi;
};
constexpr int NTHR = 512, NWAVE = 8;
constexpr int LDS_BYTES = 147456;
constexpr int LDS_CTL_OFF = 143360;

__device__ __forceinline__ void tr_item(const float* src, int ldsrc, int c0, int nvalid, bf16_t* dst, int ldd, int r0, int koff, float* scr, int item, int nblk, int lane) {
    const int kb = item / nblk, nb = item % nblk, k0 = 64 * kb, n0 = 32 * nb;
    const int nn = n0 + (lane & 31);
#pragma unroll 8
    for (int i = 0; i < 32; ++i) { const int kk = 2 * i + (lane >> 5); scr[kk * 33 + (lane & 31)] = (nn < nvalid) ? src[(size_t)(k0 + kk) * ldsrc + c0 + nn] : 0.f; }
    asm volatile("s_waitcnt lgkmcnt(0)" ::: "memory");
    const int c = lane & 7;
#pragma unroll
    for (int j = 0; j < 4; ++j) { const int n = (lane >> 3) + 8 * j; const float* s = scr + (8 * c) * 33 + n;
        u32x4 o; o.x = pk2(s[0 * 33], s[1 * 33]); o.y = pk2(s[2 * 33], s[3 * 33]); o.z = pk2(s[4 * 33], s[5 * 33]); o.w = pk2(s[6 * 33], s[7 * 33]);
        *(u32x4*)(dst + (size_t)(r0 + n0 + n) * ldd + koff + k0 + 8 * c) = o; }
    asm volatile("s_waitcnt lgkmcnt(0)" ::: "memory");
}
__device__ __forceinline__ void rms_row_to_bf16(const float* xrow, const float* gain, bf16_t* orow, int lane) {
    const f32x4* xr = (const f32x4*)xrow + lane; const f32x4* gr = (const f32x4*)gain + lane;
    f32x4 v[4]; float s = 0.f;
#pragma unroll
    for (int j = 0; j < 4; ++j) { v[j] = xr[64 * j]; s += (v[j].x * v[j].x + v[j].y * v[j].y) + (v[j].z * v[j].z + v[j].w * v[j].w); }
    const float r = rsqrtf(wave_sum(s) * (1.f / D) + EPS);
    unsigned long long* o8 = (unsigned long long*)orow + lane;
#pragma unroll
    for (int j = 0; j < 4; ++j) { const f32x4 g = gr[64 * j]; o8[64 * j] = (unsigned long long)pk2(v[j].x * r * g.x, v[j].y * r * g.y) | ((unsigned long long)pk2(v[j].z * r * g.z, v[j].w * r * g.w) << 32); }
}

__device__ __forceinline__ void ph_prologue(const Args& a, unsigned char* lds, int wv) {
    const int tid = otid(wv), lane = tid & 63, wave = tid >> 6;
    const int gw = blockIdx.x * NWAVE + wave, ngw = gridDim.x * NWAVE;
    const size_t gtid = (size_t)blockIdx.x * NTHR + tid, gsz = (size_t)gridDim.x * NTHR;
    unsigned char* ws = oport(a.ws);
    { const f32x4* s = (const f32x4*)a.x; f32x4* d = (f32x4*)a.out; for (size_t i = gtid; i < (size_t)M * D / 4; i += gsz) d[i] = s[i]; }
    float* scr = (float*)(lds + wave * 16384);
    constexpr int I_IN1 = 16 * 160, I_IN2 = 16 * 8, I_IN3 = 16 * 96, I_IN = I_IN1 + I_IN2 + I_IN3;
    constexpr int I_BR = 3 * 8 * 32, I_OUT = 16 * 32, I_PQ = 16 * 64, I_L = I_IN + I_BR + I_OUT + I_PQ;
    for (int it = gw; it < DEPTH * I_L; it += ngw) {
        const int l = it / I_L; int r = it % I_L;
        bf16_t* win = (bf16_t*)(ws + WS_WIN + (size_t)l * WIN_L); const float* src_in = a.w_in + (size_t)l * D * NIN;
        if (r < I_IN1) { tr_item(src_in, NIN, 0, 5120, win, D, 0, 0, scr, r, 160, lane); continue; } r -= I_IN1;
        if (r < I_IN2) { tr_item(src_in, NIN, 5120, 72, win, D, C_KI, 0, scr, r, 8, lane); continue; } r -= I_IN2;
        if (r < I_IN3) { tr_item(src_in, NIN, S_GL, 3072, win, D, C_GL, 0, scr, r, 96, lane); continue; } r -= I_IN3;
        if (r < I_BR) { const int n = r / 256; tr_item(a.w_branch + ((size_t)l * 3 + n) * 512 * D, D, 0, 1024, (bf16_t*)(ws + WS_WBR + (size_t)l * WBR_L), 512, n * 1024, 0, scr, r % 256, 32, lane); continue; } r -= I_BR;
        if (r < I_OUT) { tr_item(a.w_out + (size_t)l * D * D, D, 0, 1024, (bf16_t*)(ws + WS_WOUT + (size_t)l * WOUT_L), D, 0, 0, scr, r, 32, lane); continue; } r -= I_OUT;
        tr_item(a.peer_wq + (size_t)l * D * 2048, 2048, 0, 2048, (bf16_t*)(ws + WS_WPQ + (size_t)l * WPQ_L), D, 0, 0, scr, r, 64, lane);
    }
    if (gtid < 512) { float v[DEPTH], mx = -1e30f; for (int l = 0; l < DEPTH; ++l) { v[l] = a.lb_logits[l * 512 + gtid]; mx = fmaxf(mx, v[l]); }
        float s = 0.f; for (int l = 0; l < DEPTH; ++l) { v[l] = __expf(v[l] - mx); s += v[l]; }
        float c = 0.f; float* lb = (float*)(ws + WS_LB); for (int l = 0; l < DEPTH; ++l) { if (l > 0) c += v[l] / s; lb[l * 512 + gtid] = c; } }
    { u32x4* SKB = (u32x4*)(ws + WS_SKB); const f32x4* sk = (const f32x4*)a.peer_keys; for (size_t i = gtid; i < (size_t)DEPTH * 16 * 128 * 128 / 8; i += gsz) { const f32x4 k0 = sk[2 * i], k1 = sk[2 * i + 1]; SKB[i] = (u32x4){pk2(k0.x, k0.y), pk2(k0.z, k0.w), pk2(k1.x, k1.y), pk2(k1.z, k1.w)}; } }
    { bf16_t* WSB = (bf16_t*)(ws + WS_WSB); for (size_t i = gtid; i < (size_t)DEPTH * 4 * 128 * 128; i += gsz) { const int t = (int)((i >> 7) & 127), sx = (int)(i & 127); WSB[i] = (bf16_t)f2bf(sx <= t ? a.gmlp_ws[i] : 0.f); } }
    { float2* cs = (float2*)(ws + WS_CS);
      for (size_t i = gtid; i < (size_t)M * 96; i += gsz) { const int m = (int)(i / 96), j = (int)(i % 96);
          const float inv = j < 64 ? ROPE_INV64[j] : ROPE_INV32[j - 64]; const float angf = (float)a.pos[m] * inv;
          const double ang = (double)angf; const double k = rint(ang * 0.15915494309189535); const float r = (float)(ang - k * 6.283185307179586);
          cs[i] = make_float2(__cosf(r), __sinf(r)); } }
    for (int m = gw; m < M; m += ngw) rms_row_to_bf16(a.x + (size_t)m * D, a.norm1, (bf16_t*)(ws + WS_H16) + (size_t)m * D, lane);
}

__device__ __forceinline__ void ph_kiwi(const Args& a, int l, unsigned char* lds, int wv) {
    unsigned char* ws = oport(a.ws); const int tid = otid(wv), lane = tid & 63, wave = __builtin_amdgcn_readfirstlane(tid >> 6), g4 = wave & 3, kh = wave >> 2, fr = lane & 15, fq = lane >> 4;
    const bf16_t* H16 = (const bf16_t*)(ws + WS_H16); const bf16_t* W = (const bf16_t*)(ws + WS_WIN + (size_t)l * WIN_L) + (size_t)C_KI * D; float* PF = (float*)(ws + WS_PF);
    f32x4* sK = (f32x4*)lds + (g4 * 5) * 64 + lane;
    for (int base = blockIdx.x; base * 4 < M / 16; base += gridDim.x) { const int tg = base * 4 + g4; f32x4 acc[5];
#pragma unroll
        for (int nt = 0; nt < 5; ++nt) acc[nt] = (f32x4){0.f, 0.f, 0.f, 0.f};
#pragma unroll 8
        for (int ks = 16 * kh; ks < 16 * kh + 16; ++ks) { const bf16x8 y = ((const bf16x8*)(H16 + (size_t)tg * 16 * D + 32 * ks))[fr * (D / 8) + fq];
#pragma unroll
            for (int nt = 0; nt < 5; ++nt) { const bf16x8 x = ((const bf16x8*)(W + (size_t)nt * 16 * D + 32 * ks))[fr * (D / 8) + fq]; acc[nt] = __builtin_amdgcn_mfma_f32_16x16x32_bf16(x, y, acc[nt], 0, 0, 0); } }
        __syncthreads();
        if (kh == 1) {
#pragma unroll
            for (int nt = 0; nt < 5; ++nt) sK[nt * 64] = acc[nt]; }
        __syncthreads();
        if (kh == 0) {
#pragma unroll
            for (int nt = 0; nt < 5; ++nt) *(f32x4*)(PF + ((size_t)tg * 16 + fr) * PFW + 512 + 16 * nt + 4 * fq) = acc[nt] + sK[nt * 64]; }
    }
    __syncthreads();
}

__device__ __forceinline__ void ph_post(const Args& a, int l, unsigned char* lds, int wv) {
    const int tid = otid(wv), lane = tid & 63, wave = tid >> 6;
    const int gw = blockIdx.x * NWAVE + wave, ngw = gridDim.x * NWAVE;
    const size_t gtid = (size_t)blockIdx.x * NTHR + tid, gsz = (size_t)gridDim.x * NTHR;
    unsigned char* ws = oport(a.ws);
    const bf16_t* P16 = (const bf16_t*)(ws + WS_P16); const float* PF = (const float*)(ws + WS_PF); const float2* cs = (const float2*)(ws + WS_CS);
    { bf16_t* QR = (bf16_t*)(ws + WS_QR); bf16_t* KR = (bf16_t*)(ws + WS_KR);
#pragma unroll 4
      for (size_t i = gtid; i < (size_t)M * 256; i += gsz) { const int m = (int)(i >> 8), h = (int)((i >> 6) & 3), j = (int)(i & 63);
          const float2 c = cs[(size_t)m * 96 + j]; const size_t pb = (size_t)m * NPAD + h * 128 + j, ob = (size_t)m * 512 + h * 128 + j;
          const float q1 = bf2f(P16[pb + C_CQ]), q2 = bf2f(P16[pb + C_CQ + 64]), k1 = bf2f(P16[pb + C_CK]), k2 = bf2f(P16[pb + C_CK + 64]);
          const float sc = 0.08838834764831845f * 1.4426950408889634f;
          QR[ob] = (bf16_t)f2bf((q1 * c.x - q2 * c.y) * sc); QR[ob + 64] = (bf16_t)f2bf((q2 * c.x + q1 * c.y) * sc);
          KR[ob] = (bf16_t)f2bf(k1 * c.x - k2 * c.y); KR[ob + 64] = (bf16_t)f2bf(k2 * c.x + k1 * c.y); } }
    { bf16_t* QS = (bf16_t*)(ws + WS_QI); bf16_t* KIb = (bf16_t*)(ws + WS_KI); float* WP = (float*)(ws + WS_WI);
#pragma unroll 2
      for (int m = gw; m < M; m += ngw) { const int h = lane >> 3, jj = lane & 7;
          const unsigned long long w1 = *(const unsigned long long*)(P16 + (size_t)m * NPAD + C_QI + h * 64 + 4 * jj), w2 = *(const unsigned long long*)(P16 + (size_t)m * NPAD + C_QI + h * 64 + 32 + 4 * jj);
          const float q1[4] = {lo_bf((unsigned)w1), hi_bf((unsigned)w1), lo_bf((unsigned)(w1 >> 32)), hi_bf((unsigned)(w1 >> 32))}, q2[4] = {lo_bf((unsigned)w2), hi_bf((unsigned)w2), lo_bf((unsigned)(w2 >> 32)), hi_bf((unsigned)(w2 >> 32))};
          const float2* c = cs + (size_t)m * 96 + 64 + 4 * jj; const float w = PF[(size_t)m * PFW + 576 + h] * 0.02209708691207961f;
          float r1[4], r2[4], l1[4], l2[4];
#pragma unroll
          for (int i = 0; i < 4; ++i) { const float2 cc = c[i]; r1[i] = q1[i] * cc.x - q2[i] * cc.y; r2[i] = q2[i] * cc.x + q1[i] * cc.y; l1[i] = w * r1[i]; l2[i] = w * r2[i]; }
          *(unsigned long long*)(QS + (size_t)m * 576 + h * 64 + 4 * jj) = (unsigned long long)pk2(r1[0], r1[1]) | ((unsigned long long)pk2(r1[2], r1[3]) << 32);
          *(unsigned long long*)(QS + (size_t)m * 576 + h * 64 + 32 + 4 * jj) = (unsigned long long)pk2(r2[0], r2[1]) | ((unsigned long long)pk2(r2[2], r2[3]) << 32);
#pragma unroll
          for (int i = 0; i < 4; ++i) { l1[i] += __shfl_xor(l1[i], 8); l1[i] += __shfl_xor(l1[i], 16); l1[i] += __shfl_xor(l1[i], 32); l2[i] += __shfl_xor(l2[i], 8); l2[i] += __shfl_xor(l2[i], 16); l2[i] += __shfl_xor(l2[i], 32); }
          if (h == 0) { *(unsigned long long*)(QS + (size_t)m * 576 + 512 + 4 * jj) = (unsigned long long)pk2(l1[0], l1[1]) | ((unsigned long long)pk2(l1[2], l1[3]) << 32);
                        *(unsigned long long*)(QS + (size_t)m * 576 + 512 + 32 + 4 * jj) = (unsigned long long)pk2(l2[0], l2[1]) | ((unsigned long long)pk2(l2[2], l2[3]) << 32);
                        const f32x4 k1 = *(const f32x4*)(PF + (size_t)m * PFW + 512 + 4 * jj), k2 = *(const f32x4*)(PF + (size_t)m * PFW + 512 + 32 + 4 * jj);
                        const float kk1[4] = {k1.x, k1.y, k1.z, k1.w}, kk2[4] = {k2.x, k2.y, k2.z, k2.w}; float o1[4], o2[4];
#pragma unroll
                        for (int i = 0; i < 4; ++i) { const float2 cc = c[i]; o1[i] = kk1[i] * cc.x - kk2[i] * cc.y; o2[i] = kk2[i] * cc.x + kk1[i] * cc.y; }
                        *(unsigned long long*)(KIb + (size_t)m * 64 + 4 * jj) = (unsigned long long)pk2(o1[0], o1[1]) | ((unsigned long long)pk2(o1[2], o1[3]) << 32);
                        *(unsigned long long*)(KIb + (size_t)m * 64 + 32 + 4 * jj) = (unsigned long long)pk2(o2[0], o2[1]) | ((unsigned long long)pk2(o2[2], o2[3]) << 32); }
          if (jj == 0) WP[(size_t)m * 8 + h] = w; } }
    { bf16_t* VT = (bf16_t*)(ws + WS_VT); bf16_t* sT = (bf16_t*)lds;
      for (int tile = blockIdx.x; tile < (M / 64) * 8; tile += gridDim.x) { const int tb = tile >> 3, cb = tile & 7;
          { const int row = tid >> 3, seg = tid & 7; const u32x4 w = *(const u32x4*)(P16 + (size_t)(tb * 64 + row) * NPAD + C_CV + cb * 64 + seg * 8);
            unsigned* d = (unsigned*)(sT + row * 66 + seg * 8); d[0] = w.x; d[1] = w.y; d[2] = w.z; d[3] = w.w; }
          __syncthreads();
          { const int ch = tid >> 3, tg = tid & 7; unsigned short v[8];
#pragma unroll
            for (int i = 0; i < 8; ++i) v[i] = sT[(tg * 8 + i) * 66 + ch];
            const u32x4 o = {(unsigned)v[0] | ((unsigned)v[1] << 16), (unsigned)v[2] | ((unsigned)v[3] << 16), (unsigned)v[4] | ((unsigned)v[5] << 16), (unsigned)v[6] | ((unsigned)v[7] << 16)};
            *(u32x4*)(VT + ((size_t)((tb >> 7) * 512 + cb * 64 + ch)) * SEQ + (tb & 127) * 64 + tg * 8) = o; }
          __syncthreads(); } }
    { bf16_t* VN = (bf16_t*)(ws + WS_VN); const float* gain = a.gmlp_gain + l * 512;
#pragma unroll 4
      for (int m = gw; m < M; m += ngw) { const u32x4 w = *(const u32x4*)(P16 + (size_t)m * NPAD + C_BV + lane * 8);
          float v[8] = {gelu_t(lo_bf(w.x)), gelu_t(hi_bf(w.x)), gelu_t(lo_bf(w.y)), gelu_t(hi_bf(w.y)), gelu_t(lo_bf(w.z)), gelu_t(hi_bf(w.z)), gelu_t(lo_bf(w.w)), gelu_t(hi_bf(w.w))};
          float sm = 0.f;
#pragma unroll
          for (int j = 0; j < 8; ++j) sm += v[j] * v[j];
          const float r = rsqrtf(wave_sum(sm) * (1.f / 512.f) + EPS);
          const f32x4 g0 = *(const f32x4*)(gain + lane * 8), g1 = *(const f32x4*)(gain + lane * 8 + 4);
          *(u32x4*)(VN + (size_t)m * 512 + lane * 8) = (u32x4){pk2(v[0] * r * g0.x, v[1] * r * g0.y), pk2(v[2] * r * g0.z, v[3] * r * g0.w), pk2(v[4] * r * g1.x, v[5] * r * g1.y), pk2(v[6] * r * g1.z, v[7] * r * g1.w)}; } }
}

constexpr int NHU = BATCH * 128 * 4;
__device__ __forceinline__ void ph_h1(const Args& a, int l, unsigned char* lds, int wv) {
    unsigned char* ws = oport(a.ws);
    const int tid = otid(wv), lane = tid & 63, wave = __builtin_amdgcn_readfirstlane(tid >> 6), j = wave >> 1, d = tid & 127, fr = lane & 15, fq = lane >> 4;
    bf16_t* KT = (bf16_t*)lds;
    bf16_t* VT = KT + 128 * 72;
    float* sT = (float*)(VT + 128 * 72);
    const float* PF = (const float*)(ws + WS_PF); const bf16_t* P16 = (const bf16_t*)(ws + WS_P16); const float* LB = (const float*)(ws + WS_LB) + l * 512;
    float* LL = (float*)(ws + WS_FF); float* DD = (float*)(ws + WS_DD);
    for (int u = blockIdx.x; u < NHU; u += gridDim.x) {
        const int h = u & 3, c = (u >> 2) & 127, b = u >> 9; const size_t m0 = (size_t)b * SEQ + c * 64 + j * 16;
        const float lbv = LB[h * 128 + d];
        float cs[16], ky[16]; unsigned vv[16]; float run = 0.f;
#pragma unroll
        for (int i = 0; i < 16; ++i) { const float z = PF[(m0 + i) * PFW + h * 128 + d]; const float sg = sigm(z); run += __logf(lbv + (1.f - lbv) * sg); cs[i] = run; ky[i] = (1.f - lbv) * (1.f - sg);
            vv[i] = P16[(m0 + i) * NPAD + C_AI + h * 128 + d]; }
        sT[j * 128 + d] = run;
        __syncthreads();
        float tail = 0.f;
#pragma unroll
        for (int jj = 1; jj < 4; ++jj) if (jj > j) tail += sT[jj * 128 + d];
        { unsigned w[8], x[8];
#pragma unroll
          for (int i = 0; i < 8; ++i) { w[i] = pk2(ky[2 * i] * __expf(tail + (run - cs[2 * i])), ky[2 * i + 1] * __expf(tail + (run - cs[2 * i + 1]))); x[i] = vv[2 * i] | (vv[2 * i + 1] << 16); }
          u32x4* kp = (u32x4*)(KT + d * 72 + j * 16); kp[0] = (u32x4){w[0], w[1], w[2], w[3]}; kp[1] = (u32x4){w[4], w[5], w[6], w[7]};
          u32x4* vp = (u32x4*)(VT + d * 72 + j * 16); vp[0] = (u32x4){x[0], x[1], x[2], x[3]}; vp[1] = (u32x4){x[4], x[5], x[6], x[7]}; }
        if (j == 0) DD[(size_t)u * 128 + d] = __expf(run + tail);
        __syncthreads();
        { bf16x8 xk[2];
#pragma unroll
          for (int ks = 0; ks < 2; ++ks) xk[ks] = *(const bf16x8*)(KT + (16 * wave + fr) * 72 + ks * 32 + fq * 8);
#pragma unroll
          for (int nt = 0; nt < 8; ++nt) { f32x4 acc = {0.f, 0.f, 0.f, 0.f};
#pragma unroll
              for (int ks = 0; ks < 2; ++ks) { const bf16x8 y = *(const bf16x8*)(VT + (16 * nt + fr) * 72 + ks * 32 + fq * 8); acc = __builtin_amdgcn_mfma_f32_16x16x32_bf16(xk[ks], y, acc, 0, 0, 0); }
              *(f32x4*)(LL + ((size_t)u * 128 + 16 * nt + fr) * 128 + 16 * wave + 4 * fq) = acc; } }
        __syncthreads();
    }
}
__device__ __forceinline__ void ph_h2(const Args& a, int wv) {
    unsigned char* ws = oport(a.ws);
    const float* LL = (const float*)(ws + WS_FF); const float* DD = (const float*)(ws + WS_DD); bf16_t* SB = (bf16_t*)(ws + WS_QF);
    for (int e = blockIdx.x * NTHR + otid(wv); e < 8 * 16384; e += gridDim.x * NTHR) { const int bh = e >> 14, b = bh >> 2, h = bh & 3, dvdk = e & 16383, dk = e & 127; float S = 0.f;
#pragma unroll 16
        for (int c = 0; c < 128; ++c) { const size_t u = (size_t)(((b * 128 + c) << 2) + h); SB[u * 16384 + dvdk] = (bf16_t)f2bf(S); S = DD[u * 128 + dk] * S + LL[u * 16384 + dvdk]; } }
}
__device__ __forceinline__ void ph_h3(const Args& a, int l, unsigned char* lds, int wv) {
    unsigned char* ws = oport(a.ws);
    const int tid = otid(wv), lane = tid & 63, wave = __builtin_amdgcn_readfirstlane(tid >> 6), j = wave >> 1, d = tid & 127, fr = lane & 15, fq = lane >> 4;
    bf16_t* QT = (bf16_t*)lds;
    bf16_t* QH = QT + 64 * 136;
    bf16_t* KI = QH + 64 * 136;
    bf16_t* VT = KI + 160 * 136;
    bf16_t* AT = VT + 128 * 72;
    float* sT = (float*)(AT + 64 * 72);
    float* sSS = sT + 512;
    const float* PF = (const float*)(ws + WS_PF); const bf16_t* P16 = (const bf16_t*)(ws + WS_P16); const float* LB = (const float*)(ws + WS_LB) + l * 512;
    const bf16_t* SB = (const bf16_t*)(ws + WS_QF); bf16_t* YA = (bf16_t*)(ws + WS_YALL); const float* gain = a.hgrn_gain + l * 128;
    for (int u = blockIdx.x; u < NHU; u += gridDim.x) {
        const int h = u & 3, c = (u >> 2) & 127, b = u >> 9; const size_t mc = (size_t)b * SEQ + c * 64, m0 = mc + j * 16;
        for (int i = tid; i < 64 * 72 * 2 / 16; i += NTHR) ((u32x4*)AT)[i] = (u32x4){0u, 0u, 0u, 0u};
        bf16x8 sbf[4][4];
#pragma unroll
        for (int q4 = 0; q4 < 4; ++q4)
#pragma unroll
            for (int ks = 0; ks < 4; ++ks) sbf[q4][ks] = ((const bf16x8*)(SB + ((size_t)u * 128 + 16 * (4 * (wave >> 2) + q4)) * 128 + 32 * ks))[fr * 16 + fq];
        const float lbv = LB[h * 128 + d];
        float cs[16], ky[16], qf[16]; unsigned vv[16]; float run = 0.f;
#pragma unroll
        for (int i = 0; i < 16; ++i) { const size_t pr = (m0 + i) * NPAD + h * 128 + d; const float z = PF[(m0 + i) * PFW + h * 128 + d]; const float sg = sigm(z); run += __logf(lbv + (1.f - lbv) * sg); cs[i] = run; ky[i] = (1.f - lbv) * (1.f - sg);
            qf[i] = silu(bf2f(P16[pr + C_AQ])) * 0.08838834764831845f; vv[i] = P16[pr + C_AI]; }
        sT[j * 128 + d] = run;
        __syncthreads();
        const float T0 = sT[d], T1 = sT[128 + d], T2 = sT[256 + d];
        const float Bj = (j > 0 ? T0 : 0.f) + (j > 1 ? T1 : 0.f) + (j > 2 ? T2 : 0.f); const float eBj = __expf(Bj);
        float pre[4]; pre[0] = 0.f; pre[1] = (j < 1 ? T0 : 0.f); pre[2] = (j < 1 ? T0 : 0.f) + (j < 2 ? T1 : 0.f); pre[3] = (j < 1 ? T0 : 0.f) + (j < 2 ? T1 : 0.f) + (j < 3 ? T2 : 0.f);
#pragma unroll
        for (int i = 0; i < 16; ++i) { const int t = 16 * j + i; const float ec = __expf(cs[i]);
            QT[t * 136 + d] = (bf16_t)f2bf(qf[i] * ec); QH[t * 136 + d] = (bf16_t)f2bf(qf[i] * ec * eBj);
#pragma unroll
            for (int I = 0; I < 4; ++I) if (I >= j) KI[(8 * I * (I + 1) + t) * 136 + d] = (bf16_t)f2bf(ky[i] * __expf(fminf(pre[I] - cs[i], 80.f))); }
        { unsigned x[8];
#pragma unroll
          for (int i = 0; i < 8; ++i) x[i] = vv[2 * i] | (vv[2 * i + 1] << 16);
          u32x4* vp = (u32x4*)(VT + d * 72 + j * 16); vp[0] = (u32x4){x[0], x[1], x[2], x[3]}; vp[1] = (u32x4){x[4], x[5], x[6], x[7]}; }
        __syncthreads();
        for (int tl = wave; tl < 10; tl += 8) { const int I = tl < 1 ? 0 : tl < 3 ? 1 : tl < 6 ? 2 : 3, J = tl - (I * (I + 1)) / 2; f32x4 acc = {0.f, 0.f, 0.f, 0.f};
#pragma unroll
            for (int ks = 0; ks < 4; ++ks) { const bf16x8 x = *(const bf16x8*)(QT + (16 * I + fr) * 136 + ks * 32 + fq * 8); const bf16x8 y = *(const bf16x8*)(KI + (8 * I * (I + 1) + 16 * J + fr) * 136 + ks * 32 + fq * 8);
                acc = __builtin_amdgcn_mfma_f32_16x16x32_bf16(x, y, acc, 0, 0, 0); }
#pragma unroll
            for (int r = 0; r < 4; ++r) { float v = acc[r]; if (J == I && fr > 4 * fq + r) v = 0.f; AT[(16 * I + 4 * fq + r) * 72 + 16 * J + fr] = (bf16_t)f2bf(v); } }
        __syncthreads();
        const int I = wave & 3, nt0 = 4 * (wave >> 2); f32x4 o[4];
#pragma unroll
        for (int q4 = 0; q4 < 4; ++q4) { const int nt = nt0 + q4; f32x4 acc = {0.f, 0.f, 0.f, 0.f};
            for (int ks = 0; ks <= (I >> 1); ++ks) { const bf16x8 x = *(const bf16x8*)(AT + (16 * I + fr) * 72 + ks * 32 + fq * 8); const bf16x8 y = *(const bf16x8*)(VT + (16 * nt + fr) * 72 + ks * 32 + fq * 8);
                acc = __builtin_amdgcn_mfma_f32_16x16x32_bf16(x, y, acc, 0, 0, 0); }
#pragma unroll
            for (int ks = 0; ks < 4; ++ks) { const bf16x8 x = *(const bf16x8*)(QH + (16 * I + fr) * 136 + ks * 32 + fq * 8); acc = __builtin_amdgcn_mfma_f32_16x16x32_bf16(x, sbf[q4][ks], acc, 0, 0, 0); }
            o[q4] = acc; }
        { float ssq[4];
#pragma unroll
          for (int r = 0; r < 4; ++r) { float s = o[0][r] * o[0][r] + o[1][r] * o[1][r] + o[2][r] * o[2][r] + o[3][r] * o[3][r]; s += __shfl_xor(s, 1); s += __shfl_xor(s, 2); s += __shfl_xor(s, 4); s += __shfl_xor(s, 8); ssq[r] = s; }
          if (fr == 0) {
#pragma unroll
              for (int r = 0; r < 4; ++r) sSS[(16 * I + 4 * fq + r) * 2 + (wave >> 2)] = ssq[r]; } }
        __syncthreads();
#pragma unroll
        for (int r = 0; r < 4; ++r) { const int tt = 16 * I + 4 * fq + r; const float rinv = rsqrtf((sSS[tt * 2] + sSS[tt * 2 + 1]) * (1.f / 128.f) + EPS); const size_t m = mc + tt;
#pragma unroll
            for (int q4 = 0; q4 < 4; ++q4) { const int dv = 16 * (nt0 + q4) + fr; const float g = bf2f(P16[m * NPAD + C_AG + h * 128 + dv]);
                YA[m * 512 + h * 128 + dv] = (bf16_t)f2bf(o[q4][r] * rinv * gain[dv] * silu(g)); } }
        __syncthreads();
    }
}
__device__ __forceinline__ void ph_gmlp(const Args& a, int l, unsigned char* lds, int wv) {
    unsigned char* ws = oport(a.ws);
    const int tid = otid(wv), lane = tid & 63, wave = __builtin_amdgcn_readfirstlane(tid >> 6), fr = lane & 15, fq = lane >> 4;
    const bf16_t* P16 = (const bf16_t*)(ws + WS_P16); const bf16_t* VN = (const bf16_t*)(ws + WS_VN); bf16_t* YB = (bf16_t*)(ws + WS_YALL) + (size_t)M * 512;
    const bf16_t* WSB = (const bf16_t*)(ws + WS_WSB) + (size_t)l * 4 * 128 * 128; const float* bs = a.gmlp_bs + (size_t)l * 4 * 128;
    bf16_t* VNt = (bf16_t*)lds;
    for (int u = blockIdx.x; u < (M / 128) * 4; u += gridDim.x) { const int g = u & 3, nb = u >> 2; const size_t mb = (size_t)nb * 128;
        __syncthreads();
#pragma unroll
        for (int n = 0; n < 4; ++n) { const int idx = tid + NTHR * n, row = idx >> 4, seg = idx & 15; const u32x4 w = *(const u32x4*)(VN + (mb + row) * 512 + g * 128 + seg * 8);
            bf16_t* d = VNt + (seg * 8) * 136 + row;
            d[0 * 136] = (bf16_t)(w.x & 0xffffu); d[1 * 136] = (bf16_t)(w.x >> 16); d[2 * 136] = (bf16_t)(w.y & 0xffffu); d[3 * 136] = (bf16_t)(w.y >> 16);
            d[4 * 136] = (bf16_t)(w.z & 0xffffu); d[5 * 136] = (bf16_t)(w.z >> 16); d[6 * 136] = (bf16_t)(w.w & 0xffffu); d[7 * 136] = (bf16_t)(w.w >> 16); }
        bf16x8 wf[4];
#pragma unroll
        for (int ks = 0; ks < 4; ++ks) wf[ks] = *(const bf16x8*)(WSB + ((size_t)g * 128 + 16 * wave + fr) * 128 + 32 * ks + 8 * fq);
        __syncthreads();
        const int t = 16 * wave + fr; const float bias = bs[g * 128 + t]; const int nks = (wave >> 1) + 1;
#pragma unroll
        for (int ct = 0; ct < 8; ++ct) { f32x4 acc = {0.f, 0.f, 0.f, 0.f};
#pragma unroll
            for (int ks = 0; ks < 4; ++ks) if (ks < nks) { const bf16x8 x = *(const bf16x8*)(VNt + (16 * ct + fr) * 136 + 32 * ks + 8 * fq); acc = __builtin_amdgcn_mfma_f32_16x16x32_bf16(x, wf[ks], acc, 0, 0, 0); }
            const size_t m = mb + t; const int c = g * 128 + 16 * ct + 4 * fq; const unsigned long long uw = *(const unsigned long long*)(P16 + m * NPAD + C_BU + c);
            const float o0 = gelu_t(lo_bf((unsigned)uw)) * (acc[0] + bias), o1 = gelu_t(hi_bf((unsigned)uw)) * (acc[1] + bias), o2 = gelu_t(lo_bf((unsigned)(uw >> 32))) * (acc[2] + bias), o3 = gelu_t(hi_bf((unsigned)(uw >> 32))) * (acc[3] + bias);
            *(unsigned long long*)(YB + m * 512 + c) = (unsigned long long)pk2(o0, o1) | ((unsigned long long)pk2(o2, o3) << 32); }
    }
}
constexpr int SEL_CAP = 128;
__device__ __forceinline__ int sel_bin(float s, float lo, float sc) { return (int)__builtin_amdgcn_fmed3f((s - lo) * sc, 0.f, 511.f); }
struct SelQ { float lo1, sc1, lo2, sc2, tau; int b1, b2, ref, tidx; };
__device__ __forceinline__ void sel_pass(const int mode, const bf16x8 (&qf)[9][2], const float (&wp)[8], const SelQ& sq, const bf16_t* kib, int c, int kp, int qloc, int fr, int fq,
                                         unsigned* sHist, unsigned* sCand, unsigned* sCnt, unsigned* maskrow) {
    bf16x8 af[4][2];
    { const int T0 = kp <= c ? kp : c;
#pragma unroll
      for (int rg = 0; rg < 4; ++rg)
#pragma unroll
          for (int ks = 0; ks < 2; ++ks) af[rg][ks] = ((const bf16x8*)(kib + (size_t)(64 * T0 + 16 * rg) * 64 + 32 * ks))[fr * 8 + fq]; }
#pragma unroll 1
    for (int T = kp; T <= c; T += 4) {
        const int Tn = (T + 4 <= c) ? T + 4 : T;
        unsigned mlo = 0u, mhi = 0u;
#pragma unroll
        for (int rg = 0; rg < 4; ++rg) {
            f32x4 sc = __builtin_amdgcn_mfma_f32_16x16x32_bf16(af[rg][0], qf[8][0], (f32x4){0.f, 0.f, 0.f, 0.f}, 0, 0, 0);
            sc = __builtin_amdgcn_mfma_f32_16x16x32_bf16(af[rg][1], qf[8][1], sc, 0, 0, 0);
#pragma unroll
            for (int h = 0; h < 8; ++h) { f32x4 ah = __builtin_amdgcn_mfma_f32_16x16x32_bf16(af[rg][0], qf[h][0], (f32x4){0.f, 0.f, 0.f, 0.f}, 0, 0, 0);
                ah = __builtin_amdgcn_mfma_f32_16x16x32_bf16(af[rg][1], qf[h][1], ah, 0, 0, 0);
#pragma unroll
                for (int r = 0; r < 4; ++r) sc[r] += wp[h] * __builtin_fabsf(ah[r]); }
#pragma unroll
            for (int ks = 0; ks < 2; ++ks) af[rg][ks] = ((const bf16x8*)(kib + (size_t)(64 * Tn + 16 * rg) * 64 + 32 * ks))[fr * 8 + fq];
            if (mode == 0) {
#pragma unroll
                for (int r = 0; r < 4; ++r) __hip_atomic_fetch_add(sHist + qloc * 512 + sel_bin(sc[r], sq.lo1, sq.sc1), 1u, __ATOMIC_RELAXED, __HIP_MEMORY_SCOPE_WORKGROUP);
            } else if (mode == 1) {
                if (sq.ref) {
#pragma unroll
                    for (int r = 0; r < 4; ++r) if (sel_bin(sc[r], sq.lo1, sq.sc1) == sq.b1) __hip_atomic_fetch_add(sHist + qloc * 512 + sel_bin(sc[r], sq.lo2, sq.sc2), 1u, __ATOMIC_RELAXED, __HIP_MEMORY_SCOPE_WORKGROUP); }
            } else {
                int b[4]; unsigned bits = 0u; bool anyc = false;
#pragma unroll
                for (int r = 0; r < 4; ++r) { b[r] = sel_bin(sc[r], sq.lo1, sq.sc1); bits |= (b[r] > sq.b1) ? (1u << r) : 0u; anyc |= (b[r] == sq.b1); }
                if (anyc) {
#pragma unroll
                    for (int r = 0; r < 4; ++r) if (b[r] == sq.b1) { bool cand = true;
                        if (sq.ref) { const int b2 = sel_bin(sc[r], sq.lo2, sq.sc2); if (b2 > sq.b2) bits |= 1u << r; cand = b2 == sq.b2; }
                        if (cand) { const unsigned slot = __hip_atomic_fetch_add(sCnt + qloc, 1u, __ATOMIC_RELAXED, __HIP_MEMORY_SCOPE_WORKGROUP);
                            if (slot < (unsigned)SEL_CAP) { sCand[(qloc * SEL_CAP + slot) * 2] = __float_as_uint(sc[r]); sCand[(qloc * SEL_CAP + slot) * 2 + 1] = (unsigned)(64 * T + 16 * rg + 4 * fq + r); } } } }
                bits <<= (16 * (rg & 1)) + 4 * fq; if (rg < 2) mlo |= bits; else mhi |= bits;
            }
            __builtin_amdgcn_sched_barrier(0);
        }
        if (mode == 2) { mlo |= __shfl_xor(mlo, 16); mlo |= __shfl_xor(mlo, 32); mhi |= __shfl_xor(mhi, 16); mhi |= __shfl_xor(mhi, 32);
            if (fq == 0) *(uint2*)(maskrow + 2 * T) = make_uint2(mlo, mhi); }
    }
}
__device__ __forceinline__ void sel_scan(const unsigned* hist, unsigned need, int lane, int& bsel, unsigned& nneed, unsigned& cnt) {
    unsigned c8[8]; unsigned tot = 0u;
    { const u32x4 w0 = *(const u32x4*)(hist + 512 - 8 * (lane + 1)), w1 = *(const u32x4*)(hist + 512 - 8 * (lane + 1) + 4);
      c8[0] = w0.x; c8[1] = w0.y; c8[2] = w0.z; c8[3] = w0.w; c8[4] = w1.x; c8[5] = w1.y; c8[6] = w1.z; c8[7] = w1.w; }
#pragma unroll
    for (int i = 0; i < 8; ++i) tot += c8[i];
    unsigned inc = tot;
#pragma unroll
    for (int o = 1; o < 64; o <<= 1) { const unsigned t2 = __shfl_up(inc, o); if (lane >= o) inc += t2; }
    const unsigned long long bal = __ballot(inc >= need);
    const int L = bal ? (__ffsll((long long)bal) - 1) : 63;
    unsigned above = __shfl(inc - tot, L); int bs = 0; unsigned nn = 1u, cc = 0u; bool found = false;
#pragma unroll
    for (int j = 0; j < 8; ++j) { const unsigned hcnt = __shfl(c8[7 - j], L); if (!found) { if (above + hcnt >= need) { found = true; bs = 512 - 8 * L - 1 - j; nn = need - above; cc = hcnt; } else above += hcnt; } }
    bsel = bs; nneed = nn; cnt = cc;
}
__device__ __forceinline__ void ph_sel(const Args& a, unsigned char* lds, int wv) {
    unsigned char* ws = oport(a.ws);
    const int tid = otid(wv), lane = tid & 63, wave = __builtin_amdgcn_readfirstlane(tid >> 6), gq = wave & 1, kp = wave >> 1, fr = lane & 15, fq = lane >> 4, qloc = 16 * gq + fr;
    unsigned* sHist = (unsigned*)lds;
    unsigned* sCand = (unsigned*)(lds + 65536);
    float* sLo1 = (float*)(lds + 98304); float* sSc1 = sLo1 + 32; float* sLo2 = sSc1 + 32; float* sSc2 = sLo2 + 32; float* sTau = sSc2 + 32;
    int* sB1 = (int*)(sTau + 32); int* sB2 = sB1 + 32; int* sRef = sB2 + 32; int* sTidx = sRef + 32; unsigned* sNeed = (unsigned*)(sTidx + 32); unsigned* sCnt = sNeed + 32; int* sAny = (int*)(sCnt + 32);
    const bf16_t* QS = (const bf16_t*)(ws + WS_QI); const bf16_t* KIb = (const bf16_t*)(ws + WS_KI); const float* WP = (const float*)(ws + WS_WI); unsigned* MASKB = (unsigned*)(ws + WS_MASK);
    for (int pi = blockIdx.x; pi < 256; pi += gridDim.x) {
#pragma unroll 1
      for (int which = 0; which < 2; ++which) {
        const int b = pi & 1, half = (pi >> 1) & 1, cc = pi >> 2, c = which ? cc : 127 - cc;
        const size_t mq = (size_t)b * SEQ + 64 * c + 32 * half;
        const bf16_t* kib = KIb + (size_t)b * SEQ * 64;
        __syncthreads();
        if (tid < 32) { const float* w = WP + (mq + tid) * 8; float s1 = 0.f, s2 = 0.f;
#pragma unroll
            for (int h = 0; h < 8; ++h) { s1 += w[h]; s2 += w[h] * w[h]; }
            const float sd = 9.34f * sqrtf(fmaxf(s2, 1e-30f)); sLo1[tid] = 6.38f * s1 - 8.f * sd; sSc1[tid] = 512.f / (16.f * sd);
            sLo2[tid] = 0.f; sSc2[tid] = 1.f; sB1[tid] = 0; sB2[tid] = 0; sRef[tid] = 0; sNeed[tid] = 256u; sCnt[tid] = 0u; sTau[tid] = -INFINITY; sTidx[tid] = 0x7fffffff; }
        if (tid == 0) sAny[0] = 0;
        for (int i = tid; i < 32 * 512 / 4; i += NTHR) ((u32x4*)sHist)[i] = (u32x4){0u, 0u, 0u, 0u};
        bf16x8 qf[9][2]; float wp[8];
        { const bf16_t* qrow = QS + (mq + qloc) * 576;
#pragma unroll
          for (int h = 0; h < 9; ++h)
#pragma unroll
              for (int ks = 0; ks < 2; ++ks) qf[h][ks] = *(const bf16x8*)(qrow + h * 64 + 32 * ks + 8 * fq);
#pragma unroll
          for (int h = 0; h < 8; ++h) wp[h] = WP[(mq + qloc) * 8 + h]; }
        __syncthreads();
        unsigned* maskrow = MASKB + (mq + qloc) * 256;
        if (c < 4) {
            if (tid < 32) for (int T = 0; T <= c; ++T) *(uint2*)(MASKB + (mq + tid) * 256 + 2 * T) = make_uint2(0xFFFFFFFFu, 0xFFFFFFFFu);
        } else {
#pragma unroll 1
            for (int pass = 0; pass < 3; ++pass) {
                if (pass == 1) { if (!sAny[0]) continue; __syncthreads(); for (int i = tid; i < 32 * 512 / 4; i += NTHR) ((u32x4*)sHist)[i] = (u32x4){0u, 0u, 0u, 0u}; __syncthreads(); }
                SelQ sq; sq.lo1 = sLo1[qloc]; sq.sc1 = sSc1[qloc]; sq.lo2 = sLo2[qloc]; sq.sc2 = sSc2[qloc]; sq.b1 = sB1[qloc]; sq.b2 = sB2[qloc]; sq.ref = sRef[qloc]; sq.tau = 0.f; sq.tidx = 0;
                sel_pass(pass, qf, wp, sq, kib, c, kp, qloc, fr, fq, sHist, sCand, sCnt, maskrow);
                asm volatile("s_waitcnt vmcnt(0)" ::: "memory");
                __syncthreads();
                if (pass < 2) {
                    for (int qq = wave * 4; qq < wave * 4 + 4; ++qq) if (pass == 0 || sRef[qq]) { int bs; unsigned nn, cn; sel_scan(sHist + qq * 512, sNeed[qq], lane, bs, nn, cn);
                        if (lane == 0) { sNeed[qq] = nn; if (pass == 0) { sB1[qq] = bs; if (cn > (unsigned)SEL_CAP) { sRef[qq] = 1; sLo2[qq] = sLo1[qq] + (float)bs / sSc1[qq]; sSc2[qq] = sSc1[qq] * 512.f; sAny[0] = 1; } } else sB2[qq] = bs; } }
                    __syncthreads(); }
            }
            { const int qq = tid >> 4, t16 = tid & 15; const unsigned n = sCnt[qq] < (unsigned)SEL_CAP ? sCnt[qq] : (unsigned)SEL_CAP; const unsigned want = sNeed[qq] - 1u;
              for (unsigned i = t16; i < n; i += 16) { const float si = __uint_as_float(sCand[(qq * SEL_CAP + i) * 2]); const unsigned ki = sCand[(qq * SEL_CAP + i) * 2 + 1]; unsigned rank = 0u;
                  for (unsigned j = 0; j < n; ++j) { const float sj = __uint_as_float(sCand[(qq * SEL_CAP + j) * 2]); const unsigned kj = sCand[(qq * SEL_CAP + j) * 2 + 1]; rank += (sj > si || (sj == si && kj < ki)) ? 1u : 0u; }
                  if (rank <= want) atomicOr(MASKB + (mq + qq) * 256 + (ki >> 5), 1u << (ki & 31u)); } }
        }
      }
    }
}

__device__ __forceinline__ void ph_attn(const Args& a, unsigned char* lds, int wv) {
    unsigned char* ws = oport(a.ws);
    const int tid = otid(wv), lane = tid & 63, wave = __builtin_amdgcn_readfirstlane(tid >> 6), g4 = wave & 3, par = wave >> 2, fr = lane & 15, fq = lane >> 4;
    const bf16_t* QR = (const bf16_t*)(ws + WS_QR); const bf16_t* KR = (const bf16_t*)(ws + WS_KR); const bf16_t* VT = (const bf16_t*)(ws + WS_VT); const unsigned* MASKB = (const unsigned*)(ws + WS_MASK);
    bf16_t* YC = (bf16_t*)(ws + WS_YALL) + (size_t)2 * M * 512;
    bf16_t* Kt = (bf16_t*)lds;
    bf16_t* Vt = Kt + 2 * 64 * 136;
    float* sMrg = (float*)lds;
    for (int pi = blockIdx.x; pi < 256; pi += gridDim.x) {
#pragma unroll 1
      for (int which = 0; which < 2; ++which) {
        const int bh = pi & 7, b = bh >> 2, h = bh & 3, cc = pi >> 3, qb = which ? cc : 63 - cc;
        const size_t m0 = (size_t)b * SEQ + 128 * qb + 32 * g4;
        const int mych = 2 * qb + (g4 >> 1);
        bf16x8 qf[2][4];
#pragma unroll
        for (int cg = 0; cg < 2; ++cg)
#pragma unroll
            for (int ks = 0; ks < 4; ++ks) qf[cg][ks] = *(const bf16x8*)(QR + (m0 + 16 * cg + fr) * 512 + h * 128 + 32 * ks + 8 * fq);
        f32x4 O[2][8]; float mrun[2], lrun[2];
#pragma unroll
        for (int cg = 0; cg < 2; ++cg) { mrun[cg] = -1e30f; lrun[cg] = 0.f;
#pragma unroll
            for (int vt = 0; vt < 8; ++vt) O[cg][vt] = (f32x4){0.f, 0.f, 0.f, 0.f}; }
        const bf16_t* kbase = KR + (size_t)b * SEQ * 512 + h * 128; const bf16_t* vbase = VT + (size_t)(b * 512 + h * 128) * SEQ;
        unsigned doff[9];
#pragma unroll
        for (int k = 0; k < 9; ++k) { const int i_ = wave + NWAVE * k, slot = 64 * i_ + lane;
            if (slot < 2176) { const int tl = slot >= 1088 ? 1 : 0, rs = slot - 1088 * tl, row = rs / 17, seg = rs - 17 * row; doff[k] = (unsigned)((64 * tl + row) * 512 + (seg & 15) * 8); }
            else { const int s2 = slot - 2176, tl = s2 >= 1152 ? 1 : 0, rs = s2 - 1152 * tl, row = rs / 9, seg = rs - 9 * row; doff[k] = (unsigned)(row * SEQ + 64 * tl + (seg & 7) * 8); } }
#define ATT_DMA(jj, buf) do { const bf16_t* kb_ = kbase + (size_t)(jj) * 128 * 512; const bf16_t* vb_ = vbase + (size_t)(jj) * 128; \
            _Pragma("unroll") for (int k = 0; k < 9; ++k) { const int i_ = wave + NWAVE * k; if (i_ < 70) { const bf16_t* src = (i_ < 34 ? kb_ : vb_) + doff[k]; \
                __builtin_amdgcn_global_load_lds((const unsigned*)src, (LAS unsigned*)(LAS unsigned char*)(lds + (buf) * 71680 + i_ * 1024), 16, 0, 0); } } } while (0)
        __syncthreads();
        ATT_DMA(0, 0);
        asm volatile("s_waitcnt vmcnt(0)" ::: "memory");
        __syncthreads();
        for (int j = 0; j <= qb; ++j) {
            if (j < qb) ATT_DMA(j + 1, (j + 1) & 1);
            const bf16_t* Ktb = Kt + (j & 1) * 35840; const bf16_t* Vtb = Vt + (j & 1) * 35840;
            const int T = 2 * j + par;
            if (T <= mych) {
                const bf16_t* kt = Ktb + par * 64 * 136; const bf16_t* vtl = Vtb + par * 128 * 72;
                uint2 mw[2];
#pragma unroll
                for (int cg = 0; cg < 2; ++cg) mw[cg] = *(const uint2*)(MASKB + (m0 + 16 * cg + fr) * 256 + 2 * T);
                f32x4 S[2][4];
#pragma unroll
                for (int rg = 0; rg < 4; ++rg) { S[0][rg] = (f32x4){0.f, 0.f, 0.f, 0.f}; S[1][rg] = (f32x4){0.f, 0.f, 0.f, 0.f};
                    const int krow = 32 * (rg >> 1) + 8 * (fr >> 2) + 4 * (rg & 1) + (fr & 3);
#pragma unroll
                    for (int ks = 0; ks < 4; ++ks) { const bf16x8 kf = *(const bf16x8*)(kt + krow * 136 + 32 * ks + 8 * fq);
                        S[0][rg] = __builtin_amdgcn_mfma_f32_16x16x32_bf16(kf, qf[0][ks], S[0][rg], 0, 0, 0); S[1][rg] = __builtin_amdgcn_mfma_f32_16x16x32_bf16(kf, qf[1][ks], S[1][rg], 0, 0, 0); } }
                bf16x8 pf[2][2];
#pragma unroll
                for (int cg = 0; cg < 2; ++cg) {
                    float mx = fmaxf(fmaxf(fmaxf(S[cg][0][0], S[cg][0][1]), fmaxf(S[cg][0][2], S[cg][0][3])), fmaxf(fmaxf(S[cg][1][0], S[cg][1][1]), fmaxf(S[cg][1][2], S[cg][1][3])));
                    mx = fmaxf(mx, fmaxf(fmaxf(fmaxf(S[cg][2][0], S[cg][2][1]), fmaxf(S[cg][2][2], S[cg][2][3])), fmaxf(fmaxf(S[cg][3][0], S[cg][3][1]), fmaxf(S[cg][3][2], S[cg][3][3]))));
                    mx = fmaxf(mx, __shfl_xor(mx, 16)); mx = fmaxf(mx, __shfl_xor(mx, 32));
                    const float mnew = fmaxf(mrun[cg], mx), alpha = __builtin_amdgcn_exp2f(mrun[cg] - mnew); mrun[cg] = mnew; float ls = 0.f;
                    const int m16 = (int)(((mw[cg].x >> (8 * fq)) & 0xFFu) | (((mw[cg].y >> (8 * fq)) & 0xFFu) << 8));
#pragma unroll
                    for (int rg = 0; rg < 4; ++rg)
#pragma unroll
                        for (int r = 0; r < 4; ++r) { const int keep = __builtin_amdgcn_sbfe(m16, 4 * rg + r, 1);
                            const float p = __int_as_float(__float_as_int(__builtin_amdgcn_exp2f(S[cg][rg][r] - mnew)) & keep); S[cg][rg][r] = p; ls += p; }
                    lrun[cg] = lrun[cg] * alpha + ls;
                    if (__builtin_amdgcn_ballot_w64(alpha != 1.0f) != 0ull) {
#pragma unroll
                        for (int vt = 0; vt < 8; ++vt) O[cg][vt] = O[cg][vt] * alpha; }
#pragma unroll
                    for (int k2 = 0; k2 < 2; ++k2) { const u32x4 w = {pg8::cvt_pk_bf16(S[cg][2 * k2][0], S[cg][2 * k2][1]), pg8::cvt_pk_bf16(S[cg][2 * k2][2], S[cg][2 * k2][3]), pg8::cvt_pk_bf16(S[cg][2 * k2 + 1][0], S[cg][2 * k2 + 1][1]), pg8::cvt_pk_bf16(S[cg][2 * k2 + 1][2], S[cg][2 * k2 + 1][3])};
                        pf[cg][k2] = __builtin_bit_cast(bf16x8, w); }
                }
#pragma unroll
                for (int vt = 0; vt < 8; ++vt)
#pragma unroll
                    for (int k2 = 0; k2 < 2; ++k2) { const bf16x8 vf = *(const bf16x8*)(vtl + (16 * vt + fr) * 72 + 32 * k2 + 8 * fq);
                        O[0][vt] = __builtin_amdgcn_mfma_f32_16x16x32_bf16(vf, pf[0][k2], O[0][vt], 0, 0, 0); O[1][vt] = __builtin_amdgcn_mfma_f32_16x16x32_bf16(vf, pf[1][k2], O[1][vt], 0, 0, 0); }
            }
            asm volatile("s_waitcnt vmcnt(0)" ::: "memory");
            __syncthreads();
        }
#undef ATT_DMA
        float* mb = sMrg + (size_t)g4 * 68 * 64 + lane;
        if (par == 1) {
#pragma unroll
            for (int cg = 0; cg < 2; ++cg) { mb[(cg * 2 + 0) * 64] = mrun[cg]; mb[(cg * 2 + 1) * 64] = lrun[cg];
#pragma unroll
                for (int vt = 0; vt < 8; ++vt)
#pragma unroll
                    for (int r = 0; r < 4; ++r) mb[(4 + (cg * 8 + vt) * 4 + r) * 64] = O[cg][vt][r]; } }
        __syncthreads();
        if (par == 0) {
#pragma unroll
            for (int cg = 0; cg < 2; ++cg) { const float m1 = mb[(cg * 2 + 0) * 64], l1 = mb[(cg * 2 + 1) * 64]; const float mm = fmaxf(mrun[cg], m1), a0 = __builtin_amdgcn_exp2f(mrun[cg] - mm), a1 = __builtin_amdgcn_exp2f(m1 - mm);
                float lt = lrun[cg] * a0 + l1 * a1; lt += __shfl_xor(lt, 16); lt += __shfl_xor(lt, 32); const float inv = 1.f / lt;
#pragma unroll
                for (int vt = 0; vt < 8; ++vt) { float o[4];
#pragma unroll
                    for (int r = 0; r < 4; ++r) o[r] = (O[cg][vt][r] * a0 + mb[(4 + (cg * 8 + vt) * 4 + r) * 64] * a1) * inv;
                    *(unsigned long long*)(YC + (m0 + 16 * cg + fr) * 512 + h * 128 + 16 * vt + 4 * fq) = (unsigned long long)pk2(o[0], o[1]) | ((unsigned long long)pk2(o[2], o[3]) << 32); } } }
      }
    }
}
__device__ __forceinline__ void ph_norm2(const Args& a, int l, int wv) {
    const int tid = otid(wv), lane = tid & 63, gw = blockIdx.x * NWAVE + (tid >> 6), ngw = gridDim.x * NWAVE;
    unsigned char* ws = oport(a.ws);
#pragma unroll 2
    for (int m = gw; m < M; m += ngw) rms_row_to_bf16(a.out + (size_t)m * D, a.norm2 + l * D, (bf16_t*)(ws + WS_H16) + (size_t)m * D, lane);
    { const f32x4* U = (const f32x4*)(a.peer_u + (size_t)l * NEXP * D); const f32x4* V = (const f32x4*)(a.peer_v + (size_t)l * NEXP * D); u32x4* U8 = (u32x4*)(ws + WS_U16); u32x4* V8 = (u32x4*)(ws + WS_V16);
#pragma unroll 2
      for (size_t i = (size_t)blockIdx.x * NTHR + tid; i < (size_t)NEXP * D / 16; i += (size_t)gridDim.x * NTHR) { u32x4 ou, ov; unsigned* pu = (unsigned*)&ou; unsigned* pv = (unsigned*)&ov;
#pragma unroll
          for (int q = 0; q < 4; ++q) { const f32x4 u = U[4 * i + q] * 256.f, v = V[4 * i + q] * 64.f; int wu = 0, wvv = 0;
              wu = __builtin_amdgcn_cvt_pk_fp8_f32(u.x, u.y, wu, false); wu = __builtin_amdgcn_cvt_pk_fp8_f32(u.z, u.w, wu, true); wvv = __builtin_amdgcn_cvt_pk_fp8_f32(v.x, v.y, wvv, false); wvv = __builtin_amdgcn_cvt_pk_fp8_f32(v.z, v.w, wvv, true);
              pu[q] = (unsigned)wu; pv[q] = (unsigned)wvv; }
          U8[i] = ou; V8[i] = ov; } }
}
#define CE_(a_, b_) do { const float hi_ = fmaxf(a_, b_), lo_ = fminf(a_, b_); a_ = hi_; b_ = lo_; } while (0)
#define SORT16D(x) do { CE_(x[0], x[1]); CE_(x[3], x[2]); CE_(x[4], x[5]); CE_(x[7], x[6]); CE_(x[8], x[9]); CE_(x[11], x[10]); CE_(x[12], x[13]); CE_(x[15], x[14]); CE_(x[0], x[2]); CE_(x[1], x[3]); CE_(x[6], x[4]); CE_(x[7], x[5]); CE_(x[8], x[10]); CE_(x[9], x[11]); CE_(x[14], x[12]); CE_(x[15], x[13]); CE_(x[0], x[1]); CE_(x[2], x[3]); CE_(x[5], x[4]); CE_(x[7], x[6]); CE_(x[8], x[9]); CE_(x[10], x[11]); CE_(x[13], x[12]); CE_(x[15], x[14]); CE_(x[0], x[4]); CE_(x[1], x[5]); CE_(x[2], x[6]); CE_(x[3], x[7]); CE_(x[12], x[8]); CE_(x[13], x[9]); CE_(x[14], x[10]); CE_(x[15], x[11]); CE_(x[0], x[2]); CE_(x[1], x[3]); CE_(x[4], x[6]); CE_(x[5], x[7]); CE_(x[10], x[8]); CE_(x[11], x[9]); CE_(x[14], x[12]); CE_(x[15], x[13]); CE_(x[0], x[1]); CE_(x[2], x[3]); CE_(x[4], x[5]); CE_(x[6], x[7]); CE_(x[9], x[8]); CE_(x[11], x[10]); CE_(x[13], x[12]); CE_(x[15], x[14]); CE_(x[0], x[8]); CE_(x[1], x[9]); CE_(x[2], x[10]); CE_(x[3], x[11]); CE_(x[4], x[12]); CE_(x[5], x[13]); CE_(x[6], x[14]); CE_(x[7], x[15]); CE_(x[0], x[4]); CE_(x[1], x[5]); CE_(x[2], x[6]); CE_(x[3], x[7]); CE_(x[8], x[12]); CE_(x[9], x[13]); CE_(x[10], x[14]); CE_(x[11], x[15]); CE_(x[0], x[2]); CE_(x[1], x[3]); CE_(x[4], x[6]); CE_(x[5], x[7]); CE_(x[8], x[10]); CE_(x[9], x[11]); CE_(x[12], x[14]); CE_(x[13], x[15]); CE_(x[0], x[1]); CE_(x[2], x[3]); CE_(x[4], x[5]); CE_(x[6], x[7]); CE_(x[8], x[9]); CE_(x[10], x[11]); CE_(x[12], x[13]); CE_(x[14], x[15]); } while (0)
#define MERGE16D(x) do { CE_(x[0], x[8]); CE_(x[1], x[9]); CE_(x[2], x[10]); CE_(x[3], x[11]); CE_(x[4], x[12]); CE_(x[5], x[13]); CE_(x[6], x[14]); CE_(x[7], x[15]); CE_(x[0], x[4]); CE_(x[1], x[5]); CE_(x[2], x[6]); CE_(x[3], x[7]); CE_(x[8], x[12]); CE_(x[9], x[13]); CE_(x[10], x[14]); CE_(x[11], x[15]); CE_(x[0], x[2]); CE_(x[1], x[3]); CE_(x[4], x[6]); CE_(x[5], x[7]); CE_(x[8], x[10]); CE_(x[9], x[11]); CE_(x[12], x[14]); CE_(x[13], x[15]); CE_(x[0], x[1]); CE_(x[2], x[3]); CE_(x[4], x[5]); CE_(x[6], x[7]); CE_(x[8], x[9]); CE_(x[10], x[11]); CE_(x[12], x[13]); CE_(x[14], x[15]); } while (0)
__device__ __forceinline__ float pkf(float v, unsigned tag) { return __uint_as_float((__float_as_uint(v) & 0xFFFFFF00u) | tag); }
__device__ __forceinline__ void ph_peer_select(const Args& a, int l, unsigned char* lds, int wv, int nunits, int pm0, int pn0, int pm1, int pn1) {
    unsigned char* ws = oport(a.ws); const int tid = otid(wv), lane = tid & 63, wave = __builtin_amdgcn_readfirstlane(tid >> 6), fr = lane & 15, fq = lane >> 4;
    bf16_t* sK = (bf16_t*)lds;
    int* sI = (int*)(lds + 69632 + wave * 2048);
    const bf16_t* QRY = (const bf16_t*)(ws + WS_GB); const bf16_t* SKB = (const bf16_t*)(ws + WS_SKB) + (size_t)l * 16 * 128 * 128; int* EID = (int*)(ws + WS_EID); float* EG = (float*)(ws + WS_EG);
  for (int uu = 0; uu < nunits; ++uu) { const int h = uu == 0 ? pn0 : pn1, pmu = uu == 0 ? pm0 : pm1;
    __syncthreads();
    { const u32x4* src = (const u32x4*)(SKB + (size_t)h * 2 * 128 * 128);
#pragma unroll
      for (int n = 0; n < 8; ++n) { const int idx = tid + NTHR * n, row = idx >> 4, seg = idx & 15; *(u32x4*)(sK + row * 136 + seg * 8) = src[idx]; } }
    __syncthreads();
    for (int it = wave; it < 16; it += NWAVE) { const int tg = pmu * 16 + it; const size_t m = (size_t)tg * 16 + fr;
        float va[16], vb[16];
#pragma unroll
        for (int p = 0; p < 2; ++p) {
            bf16x8 qf[4];
#pragma unroll
            for (int ks = 0; ks < 4; ++ks) qf[ks] = *(const bf16x8*)(QRY + m * 2048 + h * 256 + p * 128 + 32 * ks + 8 * fq);
            const bf16_t* kb = sK + (size_t)p * 128 * 136; float s0[16], s1[16];
#pragma unroll
            for (int nt = 0; nt < 8; ++nt) { f32x4 acc = {0.f, 0.f, 0.f, 0.f};
#pragma unroll
                for (int ks = 0; ks < 4; ++ks) { const bf16x8 x = *(const bf16x8*)(kb + (16 * nt + fr) * 136 + 32 * ks + 8 * fq); acc = __builtin_amdgcn_mfma_f32_16x16x32_bf16(x, qf[ks], acc, 0, 0, 0); }
#pragma unroll
                for (int r = 0; r < 4; ++r) { const float tv = __uint_as_float((__float_as_uint(acc[r]) & 0xFFFFFF80u) | (unsigned)(127 - (16 * nt + 4 * fq + r))); if (nt < 4) s0[nt * 4 + r] = tv; else s1[(nt - 4) * 4 + r] = tv; } }
            SORT16D(s0); SORT16D(s1);
            float t[16];
#pragma unroll
            for (int i = 0; i < 16; ++i) t[i] = fmaxf(s0[i], s1[15 - i]);
            MERGE16D(t);
#pragma unroll
            for (int off = 16; off <= 32; off <<= 1) { float o[16];
#pragma unroll
                for (int i = 0; i < 16; ++i) o[i] = __shfl_xor(t[15 - i], off);
#pragma unroll
                for (int i = 0; i < 16; ++i) t[i] = fmaxf(t[i], o[i]);
                MERGE16D(t); }
#pragma unroll
            for (int i = 0; i < 16; ++i) { if (p == 0) va[i] = t[i]; else vb[i] = t[i]; }
            __builtin_amdgcn_sched_barrier(0);
        }
        if (fq == 0) {
#pragma unroll
            for (int r = 0; r < 16; ++r) { sI[fr * 32 + r] = 127 - (int)(__float_as_uint(va[r]) & 127u); sI[fr * 32 + 16 + r] = 127 - (int)(__float_as_uint(vb[r]) & 127u); } }
#pragma unroll
        for (int r = 0; r < 16; ++r) { va[r] = __uint_as_float(__float_as_uint(va[r]) & 0xFFFFFF80u); vb[r] = __uint_as_float(__float_as_uint(vb[r]) & 0xFFFFFF80u); }
        float cs[16];
        {
            cs[0] = fq == 0 ? pkf(va[0] + vb[0], 255u) : fq == 1 ? pkf(va[0] + vb[1], 254u) : fq == 2 ? pkf(va[0] + vb[2], 253u) : pkf(va[0] + vb[3], 252u);
            cs[1] = fq == 0 ? pkf(va[0] + vb[4], 251u) : fq == 1 ? pkf(va[0] + vb[5], 250u) : fq == 2 ? pkf(va[0] + vb[6], 249u) : pkf(va[0] + vb[7], 248u);
            cs[2] = fq == 0 ? pkf(va[0] + vb[8], 247u) : fq == 1 ? pkf(va[0] + vb[9], 246u) : fq == 2 ? pkf(va[0] + vb[10], 245u) : pkf(va[0] + vb[11], 244u);
            cs[3] = fq == 0 ? pkf(va[0] + vb[12], 243u) : fq == 1 ? pkf(va[0] + vb[13], 242u) : fq == 2 ? pkf(va[0] + vb[14], 241u) : pkf(va[0] + vb[15], 240u);
            cs[4] = fq == 0 ? pkf(va[1] + vb[0], 239u) : fq == 1 ? pkf(va[1] + vb[1], 238u) : fq == 2 ? pkf(va[1] + vb[2], 237u) : pkf(va[1] + vb[3], 236u);
            cs[5] = fq == 0 ? pkf(va[1] + vb[4], 235u) : fq == 1 ? pkf(va[1] + vb[5], 234u) : fq == 2 ? pkf(va[1] + vb[6], 233u) : pkf(va[1] + vb[7], 232u);
            cs[6] = fq == 0 ? pkf(va[2] + vb[0], 223u) : fq == 1 ? pkf(va[2] + vb[1], 222u) : fq == 2 ? pkf(va[2] + vb[2], 221u) : pkf(va[2] + vb[3], 220u);
            cs[7] = fq == 0 ? pkf(va[2] + vb[4], 219u) : fq == 1 ? pkf(va[3] + vb[0], 207u) : fq == 2 ? pkf(va[3] + vb[1], 206u) : pkf(va[3] + vb[2], 205u);
            cs[8] = fq == 0 ? pkf(va[3] + vb[3], 204u) : fq == 1 ? pkf(va[4] + vb[0], 191u) : fq == 2 ? pkf(va[4] + vb[1], 190u) : pkf(va[4] + vb[2], 189u);
            cs[9] = fq == 0 ? pkf(va[5] + vb[0], 175u) : fq == 1 ? pkf(va[5] + vb[1], 174u) : fq == 2 ? pkf(va[6] + vb[0], 159u) : pkf(va[6] + vb[1], 158u);
            cs[10] = fq == 0 ? pkf(va[7] + vb[0], 143u) : fq == 1 ? pkf(va[7] + vb[1], 142u) : fq == 2 ? pkf(va[8] + vb[0], 127u) : pkf(va[9] + vb[0], 111u);
            cs[11] = fq == 0 ? pkf(va[10] + vb[0], 95u) : fq == 1 ? pkf(va[11] + vb[0], 79u) : fq == 2 ? pkf(va[12] + vb[0], 63u) : pkf(va[13] + vb[0], 47u);
            cs[12] = fq == 0 ? pkf(va[14] + vb[0], 31u) : fq == 1 ? pkf(va[15] + vb[0], 15u) : fq == 2 ? -INFINITY : -INFINITY;
            cs[13] = -INFINITY; cs[14] = -INFINITY; cs[15] = -INFINITY;
        }
        __builtin_amdgcn_sched_barrier(0);
        SORT16D(cs);
#pragma unroll
        for (int off = 16; off <= 32; off <<= 1) { float o[16];
#pragma unroll
            for (int i = 0; i < 16; ++i) o[i] = __shfl_xor(cs[15 - i], off);
#pragma unroll
            for (int i = 0; i < 16; ++i) cs[i] = fmaxf(cs[i], o[i]);
            MERGE16D(cs); }
        float bv[16];
#pragma unroll
        for (int i = 0; i < 16; ++i) bv[i] = cs[i];
        asm volatile("s_waitcnt lgkmcnt(0)" ::: "memory"); __builtin_amdgcn_sched_barrier(0);
        if (fq == 0) { int eid[16]; float ex[16]; float sm = 0.f; const float b0 = __uint_as_float(__float_as_uint(bv[0]) & 0xFFFFFF00u);
#pragma unroll
            for (int r = 0; r < 16; ++r) { const unsigned bits = __float_as_uint(bv[r]); const int f = 255 - (int)(bits & 255u); eid[r] = sI[fr * 32 + (f >> 4)] * 128 + sI[fr * 32 + 16 + (f & 15)];
                ex[r] = __expf(__uint_as_float(bits & 0xFFFFFF00u) - b0); sm += ex[r]; }
            const float inv = 1.f / sm; int* ep = EID + m * 128 + h * 16; float* gp = EG + m * 128 + h * 16;
#pragma unroll
            for (int r = 0; r < 16; r += 4) { *(int4*)(ep + r) = make_int4(eid[r], eid[r + 1], eid[r + 2], eid[r + 3]); *(f32x4*)(gp + r) = (f32x4){ex[r] * inv, ex[r + 1] * inv, ex[r + 2] * inv, ex[r + 3] * inv}; } }
        asm volatile("s_waitcnt lgkmcnt(0)" ::: "memory");
    }
  }
}
typedef float f32x2_t __attribute__((ext_vector_type(2)));
__device__ __forceinline__ void dec8(const u32x4 w, f32x2_t (&f)[8]) {
    const unsigned ww[4] = {w.x, w.y, w.z, w.w};
#pragma unroll
    for (int q = 0; q < 4; ++q) { f[2 * q] = __builtin_amdgcn_cvt_pk_f32_fp8((int)ww[q], false); f[2 * q + 1] = __builtin_amdgcn_cvt_pk_f32_fp8((int)ww[q], true); }
}
__device__ __forceinline__ void ph_peer_experts(const Args& a, int l, unsigned char* lds, int wv) {
    unsigned char* ws = oport(a.ws); const int tid = otid(wv), lane = tid & 63, wave = __builtin_amdgcn_readfirstlane(tid >> 6), gw = blockIdx.x * NWAVE + wave, ngw = gridDim.x * NWAVE;
    const bf16_t* H16 = (const bf16_t*)(ws + WS_H16); const int* EID = (const int*)(ws + WS_EID); const float* EG = (const float*)(ws + WS_EG);
    const unsigned char* U8 = (const unsigned char*)(ws + WS_U16); const unsigned char* V8 = (const unsigned char*)(ws + WS_V16);
    float* sP = (float*)(lds + wave * 4096) + lane;
    int* sE = (int*)(lds + 32768 + wave * 1024); float* sG = (float*)(sE + 128);
    for (int it = 0, nit = (M + ngw - 1) / ngw; it < nit; ++it) { const int m = gw + it * ngw;
        __syncthreads();
        if (m >= M) continue;
        f32x2_t hp[8];
        { float hv[16]; const u32x4 h0 = *(const u32x4*)(H16 + (size_t)m * D + lane * 16), h1 = *(const u32x4*)(H16 + (size_t)m * D + lane * 16 + 8);
          hv[0] = lo_bf(h0.x); hv[1] = hi_bf(h0.x); hv[2] = lo_bf(h0.y); hv[3] = hi_bf(h0.y); hv[4] = lo_bf(h0.z); hv[5] = hi_bf(h0.z); hv[6] = lo_bf(h0.w); hv[7] = hi_bf(h0.w);
          hv[8] = lo_bf(h1.x); hv[9] = hi_bf(h1.x); hv[10] = lo_bf(h1.y); hv[11] = hi_bf(h1.y); hv[12] = lo_bf(h1.z); hv[13] = hi_bf(h1.z); hv[14] = lo_bf(h1.w); hv[15] = hi_bf(h1.w);
#pragma unroll
          for (int j = 0; j < 8; ++j) hp[j] = (f32x2_t){hv[2 * j], hv[2 * j + 1]}; }
        f32x2_t acc2[8];
#pragma unroll
        for (int j = 0; j < 8; ++j) acc2[j] = (f32x2_t){0.f, 0.f};
        { int key[2] = {EID[(size_t)m * 128 + 2 * lane], EID[(size_t)m * 128 + 2 * lane + 1]}; float pay[2] = {EG[(size_t)m * 128 + 2 * lane], EG[(size_t)m * 128 + 2 * lane + 1]};
#pragma unroll
          for (int k = 2; k <= 128; k <<= 1)
#pragma unroll
              for (int j = k >> 1; j >= 1; j >>= 1) {
                  if (j == 1) { const bool asc = ((2 * lane) & k) == 0; if ((key[0] > key[1]) == asc) { const int tk = key[0]; key[0] = key[1]; key[1] = tk; const float tp = pay[0]; pay[0] = pay[1]; pay[1] = tp; } }
                  else { const int lj = j >> 1; const bool keep_min = (((2 * lane) & k) == 0) == ((lane & lj) == 0);
#pragma unroll
                      for (int r = 0; r < 2; ++r) { const int pk = __shfl_xor(key[r], lj); const float pp = __shfl_xor(pay[r], lj); const bool take = keep_min ? (pk < key[r]) : (pk > key[r]); if (take) { key[r] = pk; pay[r] = pp; } } } }
          *(int2*)(sE + 2 * lane) = make_int2(key[0], key[1]); *(float2*)(sG + 2 * lane) = make_float2(pay[0], pay[1]); }
        asm volatile("s_waitcnt lgkmcnt(0)" ::: "memory");
#pragma unroll 1
        for (int half = 0; half < 2; ++half) {
            const int pos = half * 64 + 4 * (lane & 15) + (((lane >> 4) == 1) ? 2 : ((lane >> 4) == 2) ? 1 : (lane >> 4));
            const int ev = sE[pos]; const float gv = sG[pos];
            u32x4 cur[4], nxt[4];
#define ROWLD(dst, T, e_) dst = ((const u32x4*)(T + (size_t)(e_) * D))[lane]
#define BF2(a_, b_, o) (((lane & (o)) ? (b_) : (a_)) + __shfl_xor((lane & (o)) ? (a_) : (b_), (o)))
            ROWLD(cur[0], U8, __builtin_amdgcn_readlane(ev, 0)); ROWLD(cur[1], U8, __builtin_amdgcn_readlane(ev, 32)); ROWLD(cur[2], U8, __builtin_amdgcn_readlane(ev, 16)); ROWLD(cur[3], U8, __builtin_amdgcn_readlane(ev, 48));
#pragma unroll 1
            for (int g = 0; g < 16; ++g) { const int gn = g < 15 ? g + 1 : 15;
                ROWLD(nxt[0], U8, __builtin_amdgcn_readlane(ev, gn)); ROWLD(nxt[1], U8, __builtin_amdgcn_readlane(ev, gn + 32)); ROWLD(nxt[2], U8, __builtin_amdgcn_readlane(ev, gn + 16)); ROWLD(nxt[3], U8, __builtin_amdgcn_readlane(ev, gn + 48));
                float d4[4];
#pragma unroll
                for (int i = 0; i < 4; ++i) { f32x2_t f[8]; dec8(cur[i], f); f32x2_t d2 = f[0] * hp[0];
#pragma unroll
                    for (int j = 1; j < 8; ++j) d2 = __builtin_elementwise_fma(f[j], hp[j], d2);
                    d4[i] = d2.x + d2.y; }
                const float q0 = BF2(d4[0], d4[1], 32), q1 = BF2(d4[2], d4[3], 32); sP[g * 64] = BF2(q0, q1, 16);
#pragma unroll
                for (int i = 0; i < 4; ++i) cur[i] = nxt[i]; }
            float p[16];
#pragma unroll
            for (int i = 0; i < 16; ++i) p[i] = sP[i * 64];
#define BFLY(o, n) do { const bool up_ = (lane & (o)) != 0; _Pragma("unroll") for (int i_ = 0; i_ < (n); ++i_) { const float a_ = p[i_], b_ = p[i_ + (n)]; const float sd_ = up_ ? a_ : b_, kp_ = up_ ? b_ : a_; p[i_] = kp_ + __shfl_xor(sd_, (o)); } } while (0)
            BFLY(8, 8); BFLY(4, 4); BFLY(2, 2); BFLY(1, 1);
            const int svb = __builtin_bit_cast(int, gv * gelu_t(p[0] * (1.f / 256.f)) * (1.f / 64.f));
#define KIDX(g, c) ((g) + ((c) == 1 ? 32 : (c) == 2 ? 16 : (c) == 3 ? 48 : 0))
            ROWLD(cur[0], V8, __builtin_amdgcn_readlane(ev, KIDX(0, 0))); ROWLD(cur[1], V8, __builtin_amdgcn_readlane(ev, KIDX(0, 1))); ROWLD(cur[2], V8, __builtin_amdgcn_readlane(ev, KIDX(0, 2))); ROWLD(cur[3], V8, __builtin_amdgcn_readlane(ev, KIDX(0, 3)));
#pragma unroll 1
            for (int g = 0; g < 16; ++g) { const int gn = g < 15 ? g + 1 : 15;
#pragma unroll
                for (int i = 0; i < 4; ++i) ROWLD(nxt[i], V8, __builtin_amdgcn_readlane(ev, KIDX(gn, i)));
#pragma unroll
                for (int i = 0; i < 4; ++i) { const float sk = __builtin_bit_cast(float, __builtin_amdgcn_readlane(svb, KIDX(g, i))); const f32x2_t s2 = {sk, sk}; f32x2_t f[8]; dec8(cur[i], f);
#pragma unroll
                    for (int j = 0; j < 8; ++j) acc2[j] = __builtin_elementwise_fma(f[j], s2, acc2[j]); }
#pragma unroll
                for (int i = 0; i < 4; ++i) cur[i] = nxt[i]; }
#undef KIDX
#undef ROWLD
#undef BF2
#undef BFLY
        }
        float acc[16];
#pragma unroll
        for (int j = 0; j < 8; ++j) { acc[2 * j] = acc2[j].x; acc[2 * j + 1] = acc2[j].y; }
        float* xr = a.out + (size_t)m * D + lane * 16; float xn[16]; float ss = 0.f;
#pragma unroll
        for (int j = 0; j < 4; ++j) { const f32x4 xv = *(const f32x4*)(xr + 4 * j); xn[4 * j] = xv.x + acc[4 * j]; xn[4 * j + 1] = xv.y + acc[4 * j + 1]; xn[4 * j + 2] = xv.z + acc[4 * j + 2]; xn[4 * j + 3] = xv.w + acc[4 * j + 3]; }
#pragma unroll
        for (int j = 0; j < 16; ++j) ss += xn[j] * xn[j];
        const float r = rsqrtf(wave_sum(ss) * (1.f / D) + EPS);
        if (l + 1 < DEPTH) { const float* gn = a.norm1 + (size_t)(l + 1) * D + lane * 16;
#pragma unroll
            for (int j = 0; j < 4; ++j) *(f32x4*)(xr + 4 * j) = (f32x4){xn[4 * j], xn[4 * j + 1], xn[4 * j + 2], xn[4 * j + 3]};
            u32x4 w0, w1;
            w0.x = pk2(xn[0] * r * gn[0], xn[1] * r * gn[1]); w0.y = pk2(xn[2] * r * gn[2], xn[3] * r * gn[3]); w0.z = pk2(xn[4] * r * gn[4], xn[5] * r * gn[5]); w0.w = pk2(xn[6] * r * gn[6], xn[7] * r * gn[7]);
            w1.x = pk2(xn[8] * r * gn[8], xn[9] * r * gn[9]); w1.y = pk2(xn[10] * r * gn[10], xn[11] * r * gn[11]); w1.z = pk2(xn[12] * r * gn[12], xn[13] * r * gn[13]); w1.w = pk2(xn[14] * r * gn[14], xn[15] * r * gn[15]);
            *(u32x4*)((bf16_t*)(ws + WS_H16) + (size_t)m * D + lane * 16) = w0; *(u32x4*)((bf16_t*)(ws + WS_H16) + (size_t)m * D + lane * 16 + 8) = w1;
        } else { const float* gn = a.final_gain + lane * 16;
#pragma unroll
            for (int j = 0; j < 4; ++j) *(f32x4*)(xr + 4 * j) = (f32x4){xn[4 * j] * r * gn[4 * j], xn[4 * j + 1] * r * gn[4 * j + 1], xn[4 * j + 2] * r * gn[4 * j + 2], xn[4 * j + 3] * r * gn[4 * j + 3]}; }
    }
}

constexpr int PH_PER_LAYER = 9, N_PHASES = 1 + DEPTH * PH_PER_LAYER;
__global__ void __launch_bounds__(NTHR, 2) fwd_kernel(Args a) {
    extern __shared__ __attribute__((aligned(16))) unsigned char lds[];
    const int wv = __builtin_amdgcn_readfirstlane((int)threadIdx.x >> 6);
    const int tid = threadIdx.x;
    for (int u = tid; u < (LDS_BYTES - LDS_CTL_OFF) / 4; u += NTHR) ((unsigned*)(lds + LDS_CTL_OFF))[u] = 0u;
    __syncthreads();
    unsigned* ctl = (unsigned*)(a.ws + WS_CTL);
    XcdBarrier bar = xcd_barrier_post(ctl + 4096, (volatile LAS unsigned*)(LAS unsigned char*)(lds + LDS_CTL_OFF), wv);
    const int lo = a.ph_lo, hi = a.ph_hi;
#define IN(k) (lo <= (k) && (k) < hi)
#define SEAM(k) do { if (IN(k) && IN((k) + 1)) xcd_barrier(bar, wv); } while (0)
    unsigned char* ws = oport(a.ws);
    if (IN(0)) { ph_prologue(a, lds, wv); } SEAM(0);
    for (int l = 0; l < DEPTH; ++l) {
        const int pb = 1 + l * PH_PER_LAYER;
        if (IN(pb + 0)) {
            ph_kiwi(a, l, lds, wv);
            pg8::Gemm g{(const bf16_t*)(ws + WS_H16), (const bf16_t*)(ws + WS_WIN + (size_t)l * WIN_L), M, NMAIN, D, 0, 0};
            pg8::StaticOrder S; S.init(M, NMAIN, gridDim.x, blockIdx.x, 0);
            pg8::EpiIn E{(bf16_t*)(ws + WS_P16), (float*)(ws + WS_PF)};
            pg8::gemm_phase(((LAS unsigned char*)lds), g, S, E, wv);
        } SEAM(pb + 0);
        if (IN(pb + 1)) { ph_post(a, l, lds, wv); ph_h1(a, l, lds, wv); } SEAM(pb + 1);
        if (IN(pb + 2)) { ph_h2(a, wv); ph_gmlp(a, l, lds, wv); ph_sel(a, lds, wv); } SEAM(pb + 2);
        if (IN(pb + 3)) { ph_attn(a, lds, wv); ph_h3(a, l, lds, wv); } SEAM(pb + 3);
        if (IN(pb + 4)) {
            pg8::Gemm g{(const bf16_t*)(ws + WS_YALL), (const bf16_t*)(ws + WS_WBR + (size_t)l * WBR_L), M, 3072, 512, (size_t)M * 512 * 2, 4};
            pg8::BranchOrder S; S.init(gridDim.x, blockIdx.x);
            pg8::EpiGate E{(bf16_t*)(ws + WS_GB), (const bf16_t*)(ws + WS_P16)};
            pg8::gemm_phase(((LAS unsigned char*)lds), g, S, E, wv);
        } SEAM(pb + 4);
        if (IN(pb + 5)) {
            pg8::Gemm g{(const bf16_t*)(ws + WS_GB), (const bf16_t*)(ws + WS_WOUT + (size_t)l * WOUT_L), M, D, D, 0, 0};
            pg8::StaticOrder S; S.init(M, D, gridDim.x, blockIdx.x, 0);
            pg8::EpiRes E{a.out};
            pg8::gemm_phase(((LAS unsigned char*)lds), g, S, E, wv);
        } SEAM(pb + 5);
        if (IN(pb + 6)) { ph_norm2(a, l, wv); } SEAM(pb + 6);
        if (IN(pb + 7)) {
            pg8::Gemm g{(const bf16_t*)(ws + WS_H16), (const bf16_t*)(ws + WS_WPQ + (size_t)l * WPQ_L), M, 2048, D, 0, 0};
            pg8::StaticOrder S; S.init(M, 2048, gridDim.x, blockIdx.x, 0);
            pg8::EpiB16 E{(bf16_t*)(ws + WS_GB), 2048};
            pg8::gemm_phase(((LAS unsigned char*)lds), g, S, E, wv);
            asm volatile("s_waitcnt vmcnt(0)" ::: "memory"); __syncthreads();
            for (int i0_ = 0;; i0_ += 2) { pg8::Unit u0, u1; if (!S.next(i0_, u0)) break; const bool two = S.next(i0_ + 1, u1);
                ph_peer_select(a, l, lds, wv, two ? 2 : 1, u0.pm, u0.pn, two ? u1.pm : 0, two ? u1.pn : 0); }
        } SEAM(pb + 7);
        if (IN(pb + 8)) { ph_peer_experts(a, l, lds, wv); } SEAM(pb + 8);
    }
#undef IN
#undef SEAM
}

#ifndef MK_N_LAUNCHES
#define MK_N_LAUNCHES 1
#endif
extern "C" void kernel_launch(void* const* d_in, const int* in_sizes, int n_in, void* d_out, int out_size, void* d_ws, size_t ws_size, hipStream_t stream) {
    static int grid = 0;
    if (grid == 0) {
        if (n_in != 17 || out_size != M * D || ws_size < WS_END) { fprintf(stderr, "kernel_launch: unexpected shapes (n_in %d, out %d, ws %zu)\n", n_in, out_size, ws_size); grid = -1; return; }
        int dev = 0, cus = 0, per_cu = 0;
        if (hipGetDevice(&dev) != hipSuccess || hipDeviceGetAttribute(&cus, hipDeviceAttributeMultiprocessorCount, dev) != hipSuccess) { grid = -1; return; }
        if (hipFuncSetAttribute((const void*)fwd_kernel, hipFuncAttributeMaxDynamicSharedMemorySize, LDS_BYTES) != hipSuccess) { fprintf(stderr, "kernel_launch: hipFuncSetAttribute failed\n"); grid = -1; return; }
        if (hipOccupancyMaxActiveBlocksPerMultiprocessor(&per_cu, (const void*)fwd_kernel, NTHR, LDS_BYTES) != hipSuccess || per_cu < 1) { fprintf(stderr, "kernel_launch: occupancy query says %d\n", per_cu); (void)hipGetLastError(); grid = -1; return; }
        grid = cus;
    }
    if (grid < 0) return;
    (void)hipMemsetAsync((char*)d_ws + WS_CTL, 0, CTL_BYTES, stream);
    Args a{};
    a.x = (const float*)d_in[0]; a.pos = (const int*)d_in[1]; a.norm1 = (const float*)d_in[2]; a.w_in = (const float*)d_in[3]; a.lb_logits = (const float*)d_in[4]; a.hgrn_gain = (const float*)d_in[5];
    a.gmlp_gain = (const float*)d_in[6]; a.gmlp_ws = (const float*)d_in[7]; a.gmlp_bs = (const float*)d_in[8]; a.w_branch = (const float*)d_in[9]; a.w_out = (const float*)d_in[10]; a.norm2 = (const float*)d_in[11];
    a.peer_wq = (const float*)d_in[12]; a.peer_keys = (const float*)d_in[13]; a.peer_u = (const float*)d_in[14]; a.peer_v = (const float*)d_in[15]; a.final_gain = (const float*)d_in[16];
    a.out = (float*)d_out; a.ws = (unsigned char*)d_ws;
    if (MK_N_LAUNCHES == 1) { a.ph_lo = 0; a.ph_hi = N_PHASES; hipLaunchKernelGGL(fwd_kernel, dim3(grid), dim3(NTHR), LDS_BYTES, stream, a); }
    else for (int p = 0; p < N_PHASES; ++p) { a.ph_lo = p; a.ph_hi = p + 1; hipLaunchKernelGGL(fwd_kernel, dim3(grid), dim3(NTHR), LDS_BYTES, stream, a); }
}
```

```cpp
#include <hip/hip_runtime.h>
#include <cstdio>
#include <cstdint>

#define LAS __attribute__((address_space(3)))
typedef unsigned short bf16_t;
typedef short bf16x8 __attribute__((ext_vector_type(8)));
typedef float f32x4 __attribute__((ext_vector_type(4)));
typedef unsigned u32x4 __attribute__((ext_vector_type(4)));

constexpr int D = 1024, BATCH = 2, SEQ = 8192, DEPTH = 4, M = BATCH * SEQ;
constexpr int NIN = 8264;
constexpr int NPAD = 8448;
constexpr int C_AQ = 0, C_AF = 512, C_AI = 1024, C_AG = 1536, C_BU = 2048, C_BV = 2560, C_CQ = 3072, C_CK = 3584, C_CV = 4096, C_QI = 4608, C_GL = 5120, C_KI = 8192, C_WI = 8256;
constexpr int NMAIN = 8192;
constexpr int S_GL = 5192;
constexpr int PFW = 768;
constexpr float EPS = 1e-6f;
constexpr int NEXP = 16384;

constexpr size_t MiB = 1u << 20;
constexpr size_t WS_CTL = 0, CTL_BYTES = 1 * MiB;
constexpr size_t WS_WIN = 2 * MiB;
constexpr size_t WIN_L = (size_t)NPAD * D * 2;
constexpr size_t WS_WBR = 68 * MiB;
constexpr size_t WBR_L = (size_t)3072 * 512 * 2;
constexpr size_t WS_WOUT = 80 * MiB;
constexpr size_t WOUT_L = (size_t)1024 * 3072 * 2;
constexpr size_t WS_WPQ = 104 * MiB;
constexpr size_t WPQ_L = (size_t)2048 * 1024 * 2;
constexpr size_t WS_LB = 120 * MiB;
constexpr size_t WS_CS = 121 * MiB;
constexpr size_t WS_H16 = 134 * MiB;
constexpr size_t WS_P16 = 166 * MiB;
constexpr size_t WS_PF = 430 * MiB;
constexpr size_t WS_QR = 478 * MiB, WS_KR = 494 * MiB;
constexpr size_t WS_QI = 510 * MiB;
constexpr size_t WS_KI = 542 * MiB;
constexpr size_t WS_WI = 546 * MiB;
constexpr size_t WS_FF = 548 * MiB, WS_KK = 580 * MiB, WS_QF = 612 * MiB;
constexpr size_t WS_OA = 644 * MiB;
constexpr size_t WS_VN = 676 * MiB;
constexpr size_t WS_YALL = 708 * MiB;
constexpr size_t WS_GB = 756 * MiB;
constexpr size_t WS_EID = 852 * MiB, WS_EG = 860 * MiB;
constexpr size_t WS_DD = 120 * MiB + 256 * 1024;
constexpr size_t WS_WSB = 544 * MiB;
constexpr size_t WS_VT = 644 * MiB;
constexpr size_t WS_MASK = 660 * MiB;
constexpr size_t WS_U16 = 868 * MiB, WS_V16 = 900 * MiB;
constexpr size_t WS_SKB = 932 * MiB;
constexpr size_t WS_END = 934 * MiB;

__device__ const float ROPE_INV64[64] = {
1.000000000e+00f, 8.659643531e-01f, 7.498942614e-01f, 6.493816376e-01f, 5.623413324e-01f, 4.869675338e-01f, 4.216965139e-01f, 3.651741147e-01f, 3.162277639e-01f, 2.738419771e-01f, 2.371373773e-01f, 2.053525001e-01f, 1.778279394e-01f, 1.539926529e-01f, 1.333521307e-01f, 1.154782027e-01f, 1.000000015e-01f, 8.659642935e-02f, 7.498941571e-02f, 6.493816525e-02f, 5.623413250e-02f, 4.869675264e-02f, 4.216965288e-02f, 3.651741147e-02f, 3.162277490e-02f, 2.738419734e-02f, 2.371373773e-02f, 2.053525113e-02f, 1.778279431e-02f, 1.539926510e-02f, 1.333521493e-02f, 1.154782064e-02f, 9.999999776e-03f, 8.659643121e-03f, 7.498941850e-03f, 6.493816152e-03f, 5.623413250e-03f, 4.869675264e-03f, 4.216964822e-03f, 3.651741194e-03f, 3.162277630e-03f, 2.738419687e-03f, 2.371373586e-03f, 2.053524833e-03f, 1.778279431e-03f, 1.539926510e-03f, 1.333521446e-03f, 1.154781901e-03f, 1.000000047e-03f, 8.659643354e-04f, 7.498942432e-04f, 6.493816618e-04f, 5.623413017e-04f, 4.869675322e-04f, 4.216965172e-04f, 3.651741426e-04f, 3.162277571e-04f, 2.738419571e-04f, 2.371373703e-04f, 2.053525095e-04f, 1.778279402e-04f, 1.539926452e-04f, 1.333521504e-04f, 1.154782003e-04f};
__device__ const float ROPE_INV32[32] = {
1.000000000e+00f, 7.498942614e-01f, 5.623413324e-01f, 4.216965139e-01f, 3.162277639e-01f, 2.371373773e-01f, 1.778279394e-01f, 1.333521307e-01f, 1.000000015e-01f, 7.498941571e-02f, 5.623413250e-02f, 4.216965288e-02f, 3.162277490e-02f, 2.371373773e-02f, 1.778279431e-02f, 1.333521493e-02f, 9.999999776e-03f, 7.498941850e-03f, 5.623413250e-03f, 4.216964822e-03f, 3.162277630e-03f, 2.371373586e-03f, 1.778279431e-03f, 1.333521446e-03f, 1.000000047e-03f, 7.498942432e-04f, 5.623413017e-04f, 4.216965172e-04f, 3.162277571e-04f, 2.371373703e-04f, 1.778279402e-04f, 1.333521504e-04f};

__device__ __forceinline__ float bf2f(bf16_t b) { return __uint_as_float(((unsigned)b) << 16); }
__device__ __forceinline__ unsigned f2bf(float f) { unsigned u = __float_as_uint(f); return (u + 0x7fffu + ((u >> 16) & 1u)) >> 16; }
__device__ __forceinline__ unsigned pk2(float lo, float hi) { return f2bf(lo) | (f2bf(hi) << 16); }
__device__ __forceinline__ float lo_bf(unsigned w) { return __uint_as_float(w << 16); }
__device__ __forceinline__ float hi_bf(unsigned w) { return __uint_as_float(w & 0xffff0000u); }
__device__ __forceinline__ float sigm(float x) { return 1.f / (1.f + __expf(-x)); }
__device__ __forceinline__ float silu(float x) { return x * sigm(x); }
__device__ __forceinline__ float gelu_t(float x) { const float u = 0.7978845608028654f * (x + 0.044715f * x * x * x); const float th = 1.f - 2.f / (1.f + __expf(2.f * u)); return 0.5f * x * (1.f + th); }
__device__ __forceinline__ float wave_sum(float v) {
#pragma unroll
    for (int o = 1; o < 64; o <<= 1) v += __shfl_xor(v, o);
    return v;
}
__device__ __forceinline__ float wave_max(float v) {
#pragma unroll
    for (int o = 1; o < 64; o <<= 1) v = fmaxf(v, __shfl_xor(v, o));
    return v;
}
typedef __bf16 bf2_t __attribute__((ext_vector_type(2)));
__device__ __forceinline__ float dot2(unsigned a, unsigned b, float c) { return __builtin_amdgcn_fdot2_f32_bf16(__builtin_bit_cast(bf2_t, a), __builtin_bit_cast(bf2_t, b), c, false); }
__device__ __forceinline__ int otid(int wv) { int t; asm volatile("v_mbcnt_lo_u32_b32 %0, -1, 0\n\tv_mbcnt_hi_u32_b32 %0, -1, %0" : "=v"(t)); return wv * 64 + t; }
__device__ __forceinline__ unsigned char* oport(unsigned char* p) { unsigned long long z; asm volatile("s_mov_b64 %0, 0" : "=s"(z)); return p + z; }
__device__ __forceinline__ unsigned fkey(float f) { const unsigned u = __float_as_uint(f); return u ^ ((u >> 31) ? 0xFFFFFFFFu : 0x80000000u); }

#define XB_TMO      128
#define XB_XCNT(j)  (256  + 64 * (j))
#define XB_XSUB(j)  (1280 + 64 * (j))
#define XB_XGEN(j)  (2304 + 64 * (j))
#define XB_TOP      3328
#define XB_TOPGEN   3392
#define XCD_BAR_WORDS 3456
#define XB_SPIN_CAP (1u << 23)
__device__ __forceinline__ unsigned xb_ld(unsigned* p)              { return __hip_atomic_load(p, __ATOMIC_RELAXED, __HIP_MEMORY_SCOPE_AGENT); }
__device__ __forceinline__ unsigned xb_add(unsigned* p, unsigned v) { return __hip_atomic_fetch_add(p, v, __ATOMIC_RELAXED, __HIP_MEMORY_SCOPE_AGENT); }
__device__ __forceinline__ unsigned xb_xcc_id() { return (unsigned)__builtin_amdgcn_s_getreg((3 << 11) | 20) & 0xFu; }
#define XB_SPIN(cond, bar) do { unsigned _sp = 0; while (cond) { __builtin_amdgcn_s_sleep(1); \
    if ((++_sp & 255u) == 0u) { if (xb_ld(&(bar)[XB_TMO])) break; if (_sp > XB_SPIN_CAP) { atomicAdd(&(bar)[XB_TMO], 1u); break; } } } } while (0)
struct XcdBarrier { unsigned* bar; unsigned x; volatile LAS unsigned* st; };
__device__ __forceinline__ XcdBarrier xcd_barrier_post(unsigned* bar, volatile LAS unsigned* st, int wv) {
    XcdBarrier b; b.bar = bar; b.x = xb_xcc_id(); b.st = st;
    if (otid(wv) == 0) (void)xb_add(&bar[XB_XCNT(b.x)], 1u);
    return b;
}
__device__ __forceinline__ void xcd_barrier_complete(unsigned* bar, unsigned x, unsigned& nloc, unsigned& nx) {
    const unsigned G = gridDim.x * gridDim.y * gridDim.z;
    unsigned sum, cnt, mine, sp = 0u;
    for (;;) {
        sum = 0u; cnt = 0u; mine = 0u;
#pragma unroll
        for (unsigned j = 0; j < 16; ++j) { const unsigned c = xb_ld(&bar[XB_XCNT(j)]); sum += c; cnt += (c > 0u) ? 1u : 0u; mine = (j == x) ? c : mine; }
        if (sum == G) break;
        __builtin_amdgcn_s_sleep(1);
        if ((++sp & 255u) == 0u) { if (xb_ld(&bar[XB_TMO])) break; if (sp > XB_SPIN_CAP) { atomicAdd(&bar[XB_TMO], 1u); break; } }
    }
    nloc = mine > 0u ? mine : 1u; nx = cnt > 0u ? cnt : 1u;
}
__device__ __forceinline__ void xcd_barrier(const XcdBarrier& b, int wv) {
    asm volatile("s_waitcnt vmcnt(0)" ::: "memory");
    __syncthreads();
    if (otid(wv) == 0) {
        unsigned* bar = b.bar;
        __builtin_amdgcn_s_waitcnt(0);
        unsigned nloc = b.st[0], nx = b.st[1];
        if (nloc == 0u) { xcd_barrier_complete(bar, b.x, nloc, nx); b.st[0] = nloc; b.st[1] = nx; }
        const unsigned old = xb_add(&bar[XB_XSUB(b.x)], 1u);
        const unsigned gen = old / nloc;
        if (old + 1u == (gen + 1u) * nloc) {
            __builtin_amdgcn_fence(__ATOMIC_RELEASE, "agent");
            asm volatile("s_waitcnt vmcnt(0)" ::: "memory");
            const unsigned og = xb_add(&bar[XB_TOP], 1u);
            const unsigned tg = og / nx;
            if (og + 1u == (tg + 1u) * nx) xb_add(&bar[XB_TOPGEN], 1u);
            else XB_SPIN(xb_ld(&bar[XB_TOPGEN]) == tg, bar);
            __builtin_amdgcn_fence(__ATOMIC_ACQUIRE, "agent");
            xb_add(&bar[XB_XGEN(b.x)], 1u);
            asm volatile("s_waitcnt vmcnt(0)" ::: "memory");
        } else {
            XB_SPIN(xb_ld(&bar[XB_XGEN(b.x)]) == gen, bar);
            __builtin_amdgcn_fence(__ATOMIC_ACQUIRE, "agent");
            asm volatile("s_waitcnt vmcnt(0)" ::: "memory");
        }
    }
    __syncthreads();
}

namespace pg8 {
constexpr int BM = 256, BK = 64, HALF = 128, HTB = HALF * BK * 2, STAGE_BYTES = 8 * HTB, NXCD = 8, WGM = 8;
__host__ __device__ __forceinline__ int lds_byte(int r, int c) { const int st = (r >> 4) * 2 + (c >> 5), rr = r & 15, cc = c & 31, ob = rr * 64 + cc * 2; return st * 1024 + (ob ^ (((ob >> 9) & 1) << 5)); }
__host__ __device__ __forceinline__ void stage_rc(int b, int& R, int& C) { const int st = b / 1024, sb = b % 1024, swz = sb ^ (((sb >> 9) & 1) << 5); R = (st >> 1) * 16 + swz / 64; C = (st & 1) * 32 + (swz % 64) / 2; }
__host__ __device__ __forceinline__ int perm32(int rho) { const int n = rho >> 4, i = rho & 15; return 8 * (i >> 2) + 4 * n + (i & 3); }
struct Unit { int pm, pn, ka; };
struct Gemm { const bf16_t* A; const bf16_t* Bt; int M, N, K; size_t strideA; int nsplit; };
struct StaticOrder {
    int nM, nN, nwg, G, c, nsplit;
    __device__ __forceinline__ void init(int M_, int N_, int G_, int c_, int nsplit_) { nM = M_ / BM; nN = N_ / BM; nwg = nM * nN; G = G_; c = c_; nsplit = nsplit_; }
    __device__ __forceinline__ bool next(int i, Unit& u) const {
        const long L = (long)i * G + c; if (L >= nwg) return false;
        int wgid = (int)L; { const int q = nwg / NXCD, r = nwg % NXCD, xcd = wgid % NXCD, off = wgid / NXCD; wgid = (xcd < r ? xcd * (q + 1) : r * (q + 1) + (xcd - r) * q) + off; }
        const int nig = WGM * nN, gid = wgid / nig, fm = gid * WGM, gsz = (nM - fm) < WGM ? (nM - fm) : WGM;
        u.pm = fm + ((wgid % nig) % gsz); u.pn = (wgid % nig) / gsz; u.ka = nsplit ? u.pn / nsplit : 0; return true;
    }
};
__device__ __forceinline__ unsigned cvt_pk_bf16(float lo, float hi) { unsigned r; asm volatile("v_cvt_pk_bf16_f32 %0, %1, %2" : "=v"(r) : "v"(lo), "v"(hi)); return r; }

template <class Epi, class Sched>
__device__ __forceinline__ void gemm_phase(LAS unsigned char* lds, const Gemm g, const Sched& S, const Epi& E, int wv) {
    const int tid = otid(wv), wid = __builtin_amdgcn_readfirstlane(tid >> 6), lane = tid & 63, wr = wid >> 2, wc = wid & 3, fr = lane & 15, fq = lane >> 4;
    const int K = g.K, nt = K / BK;
    unsigned voffA[2], voffB[2];
#pragma unroll
    for (int i = 0; i < 2; ++i) { int R, C; stage_rc(tid * 16 + i * 8192, R, C); const int Rb = Epi::PERM ? ((R & ~31) + perm32(R & 31)) : R;
        voffA[i] = (unsigned)(R * K + C) * 2u; voffB[i] = (unsigned)(Rb * K + C) * 2u; }
    const size_t kstep = (size_t)(BK * 2);
    const size_t hstep = (size_t)HALF * K * 2;
    const size_t tstep = 2 * hstep;
    const unsigned ldsw = (unsigned)wid * 1024u;
    const int aoff = lds_byte(wr * 64 + fr, fq * 8), boff = lds_byte(wc * 32 + fr, fq * 8);
#define PG8_SA(b, h) (((b) * 2 + (h)) * HTB)
#define PG8_SB(b, h) ((4 + (b) * 2 + (h)) * HTB)
#define PG8_STAGE(bufoff, gbase, voff) do { _Pragma("unroll") for (int _i = 0; _i < 2; ++_i) \
        __builtin_amdgcn_global_load_lds((const unsigned*)((const char*)(gbase) + (voff)[_i]), (LAS unsigned*)(lds + (bufoff) + ldsw + _i * 8192), 16, 0, 0); } while (0)
#define PG8_LDA(dst, b, h) do { _Pragma("unroll") for (int m = 0; m < 4; ++m) _Pragma("unroll") for (int k = 0; k < 2; ++k) dst[m][k] = *(const LAS bf16x8*)(lds + PG8_SA(b, h) + aoff + m * 2048 + k * 1024); } while (0)
#define PG8_LDB(dst, b, h) do { _Pragma("unroll") for (int n = 0; n < 2; ++n) _Pragma("unroll") for (int k = 0; k < 2; ++k) dst[n][k] = *(const LAS bf16x8*)(lds + PG8_SB(b, h) + boff + n * 2048 + k * 1024); } while (0)
#define PG8_MMA(ai, bj, At, Bt) do { __builtin_amdgcn_s_setprio(1); _Pragma("unroll") for (int m = 0; m < 4; ++m) _Pragma("unroll") for (int n = 0; n < 2; ++n) _Pragma("unroll") for (int k = 0; k < 2; ++k) \
        acc[ai][bj][m][n] = __builtin_amdgcn_mfma_f32_16x16x32_bf16(Bt[n][k], At[m][k], acc[ai][bj][m][n], 0, 0, 0); __builtin_amdgcn_s_setprio(0); } while (0)
#define PG8_WAIT_V(n) asm volatile("s_waitcnt vmcnt(" #n ")" ::: "memory")
#define PG8_WAIT_L(n) asm volatile("s_waitcnt lgkmcnt(" #n ")" ::: "memory")
#define PG8_BAR __builtin_amdgcn_s_barrier()
#define PG8_SCHED __builtin_amdgcn_sched_barrier(0)
    Unit cur, nxt; int ui = 0;
    if (!S.next(0, cur)) return;
    f32x4 acc[2][2][4][2];
#pragma unroll
    for (int a = 0; a < 2; ++a)
#pragma unroll
        for (int b = 0; b < 2; ++b)
#pragma unroll
            for (int m = 0; m < 4; ++m)
#pragma unroll
                for (int n = 0; n < 2; ++n) acc[a][b][m][n] = (f32x4){0.f, 0.f, 0.f, 0.f};
    bf16x8 At[4][2], B0[2][2], B1[2][2];
    const char* cA = (const char*)g.A + (size_t)cur.ka * g.strideA + (size_t)cur.pm * tstep; const char* cB = (const char*)g.Bt + (size_t)cur.pn * tstep;
    PG8_STAGE(PG8_SB(0, 0), cB, voffB); PG8_STAGE(PG8_SA(0, 0), cA, voffA); PG8_STAGE(PG8_SB(0, 1), cB + hstep, voffB); PG8_STAGE(PG8_SA(0, 1), cA + hstep, voffA);
    if (wr == 1) PG8_BAR;
    PG8_WAIT_V(4); PG8_BAR;
    PG8_STAGE(PG8_SB(1, 0), cB + kstep, voffB); PG8_STAGE(PG8_SA(1, 0), cA + kstep, voffA); PG8_STAGE(PG8_SB(1, 1), cB + hstep + kstep, voffB);
    PG8_WAIT_V(6); PG8_BAR;
    for (;;) {
        const bool has_next = S.next(ui + 1, nxt);
        const char* nA = has_next ? (const char*)g.A + (size_t)nxt.ka * g.strideA + (size_t)nxt.pm * tstep : cA; const char* nB = has_next ? (const char*)g.Bt + (size_t)nxt.pn * tstep : cB;
        for (int t = 0; t < nt; t += 2) {
            const bool last = (t == nt - 2);
            const char* a1 = cA + (size_t)(t + 1) * kstep;
            const char* a2 = last ? nA : cA + (size_t)(t + 2) * kstep; const char* b2 = last ? nB : cB + (size_t)(t + 2) * kstep;
            const char* a3 = a2 + kstep; const char* b3 = b2 + kstep;
            PG8_LDB(B0, 0, 0); PG8_SCHED; PG8_LDA(At, 0, 0); PG8_STAGE(PG8_SA(1, 1), a1 + hstep, voffA);
            PG8_WAIT_L(8); PG8_BAR; PG8_WAIT_L(0); PG8_MMA(0, 0, At, B0); PG8_BAR; PG8_SCHED;
            PG8_LDB(B1, 0, 1); PG8_STAGE(PG8_SB(0, 0), b2, voffB);
            PG8_BAR; PG8_WAIT_L(0); PG8_MMA(0, 1, At, B1); PG8_BAR;
            PG8_LDA(At, 0, 1); PG8_STAGE(PG8_SA(0, 0), a2, voffA);
            PG8_BAR; PG8_WAIT_L(0); PG8_MMA(1, 0, At, B0); PG8_BAR; PG8_SCHED;
            PG8_STAGE(PG8_SB(0, 1), b2 + hstep, voffB);
            PG8_WAIT_V(6); PG8_BAR; PG8_MMA(1, 1, At, B1); PG8_BAR;
            PG8_LDB(B0, 1, 0); PG8_SCHED; PG8_LDA(At, 1, 0); PG8_STAGE(PG8_SA(0, 1), a2 + hstep, voffA);
            PG8_WAIT_L(8); PG8_BAR; PG8_WAIT_L(0); PG8_MMA(0, 0, At, B0); PG8_BAR; PG8_SCHED;
            PG8_LDB(B1, 1, 1); PG8_STAGE(PG8_SB(1, 0), b3, voffB);
            PG8_BAR; PG8_WAIT_L(0); PG8_MMA(0, 1, At, B1); PG8_BAR;
            PG8_LDA(At, 1, 1); PG8_STAGE(PG8_SA(1, 0), a3, voffA);
            PG8_BAR; PG8_WAIT_L(0); PG8_MMA(1, 0, At, B0); PG8_BAR; PG8_SCHED;
            PG8_STAGE(PG8_SB(1, 1), b3 + hstep, voffB);
            PG8_WAIT_V(6); PG8_BAR; PG8_MMA(1, 1, At, B1); PG8_BAR;
        }
        E(acc, cur, wr, wc, fr, fq);
        if (!has_next) break;
        if (!E.keep(cur))
#pragma unroll
        for (int a = 0; a < 2; ++a)
#pragma unroll
            for (int b = 0; b < 2; ++b)
#pragma unroll
                for (int m = 0; m < 4; ++m)
#pragma unroll
                    for (int n = 0; n < 2; ++n) acc[a][b][m][n] = (f32x4){0.f, 0.f, 0.f, 0.f};
        cur = nxt; cA = nA; cB = nB; ++ui;
    }
    PG8_WAIT_V(0);
    if (wr == 0) PG8_BAR;
    PG8_BAR;
#undef PG8_SA
#undef PG8_SB
#undef PG8_STAGE
#undef PG8_LDA
#undef PG8_LDB
#undef PG8_MMA
#undef PG8_WAIT_V
#undef PG8_WAIT_L
#undef PG8_BAR
#undef PG8_SCHED
}

struct EpiIn {
    __device__ __forceinline__ bool keep(const Unit&) const { return false; }
    static constexpr bool PERM = true;
    bf16_t* P16; float* PF;
    __device__ __forceinline__ void operator()(f32x4 (&acc)[2][2][4][2], const Unit& u, int wr, int wc, int fr, int fq) const {
        const int row0 = u.pm * BM + wr * 64 + fr, col0 = u.pn * BM + wc * 32 + 8 * fq;
        const bool f32t = (u.pn == 2) || (u.pn == 3), gate = u.pn >= C_GL / 256;
        const int pfc0 = (u.pn - 2) * 256 + wc * 32 + 8 * fq;
#pragma unroll
        for (int ai = 0; ai < 2; ++ai)
#pragma unroll
            for (int m = 0; m < 4; ++m) { const size_t row = (size_t)(row0 + ai * HALF + m * 16);
#pragma unroll
                for (int bj = 0; bj < 2; ++bj) { f32x4 v0 = acc[ai][bj][m][0], v1 = acc[ai][bj][m][1];
                    if (gate) {
#pragma unroll
                        for (int j = 0; j < 4; ++j) { v0[j] = sigm(v0[j]); v1[j] = sigm(v1[j]); } }
                    u32x4 w; w.x = cvt_pk_bf16(v0[0], v0[1]); w.y = cvt_pk_bf16(v0[2], v0[3]); w.z = cvt_pk_bf16(v1[0], v1[1]); w.w = cvt_pk_bf16(v1[2], v1[3]);
                    *(u32x4*)(P16 + row * NPAD + col0 + bj * HALF) = w;
                    if (f32t) { float* pf = PF + row * PFW + pfc0 + bj * HALF; *(f32x4*)pf = v0; *(f32x4*)(pf + 4) = v1; } } }
    }
};
struct EpiGate {
    static constexpr bool PERM = true;
    bf16_t* GS; const bf16_t* P16;
    __device__ __forceinline__ bool keep(const Unit& u) const { return (u.pn >> 2) < 2; }
    __device__ __forceinline__ void operator()(f32x4 (&acc)[2][2][4][2], const Unit& u, int wr, int wc, int fr, int fq) const {
        const int n = u.pn >> 2, row0 = u.pm * BM + wr * 64 + fr, col0 = (u.pn & 3) * BM + wc * 32 + 8 * fq;
#pragma unroll
        for (int ai = 0; ai < 2; ++ai)
#pragma unroll
            for (int m = 0; m < 4; ++m) { const size_t row = (size_t)(row0 + ai * HALF + m * 16);
#pragma unroll
                for (int bj = 0; bj < 2; ++bj) { f32x4& v0 = acc[ai][bj][m][0]; f32x4& v1 = acc[ai][bj][m][1];
                    const u32x4 gw = *(const u32x4*)(P16 + row * NPAD + C_GL + n * 1024 + col0 + bj * HALF);
                    const float g[8] = {lo_bf(gw.x), hi_bf(gw.x), lo_bf(gw.y), hi_bf(gw.y), lo_bf(gw.z), hi_bf(gw.z), lo_bf(gw.w), hi_bf(gw.w)};
                    if (n < 2) { const u32x4 hw = *(const u32x4*)(P16 + row * NPAD + C_GL + (n + 1) * 1024 + col0 + bj * HALF);
                        const float h[8] = {lo_bf(hw.x), hi_bf(hw.x), lo_bf(hw.y), hi_bf(hw.y), lo_bf(hw.z), hi_bf(hw.z), lo_bf(hw.w), hi_bf(hw.w)};
#pragma unroll
                        for (int j = 0; j < 4; ++j) { v0[j] *= g[j] * __builtin_amdgcn_rcpf(h[j]); v1[j] *= g[4 + j] * __builtin_amdgcn_rcpf(h[4 + j]); }
                    } else { u32x4 w;
                        w.x = cvt_pk_bf16(v0[0] * g[0], v0[1] * g[1]); w.y = cvt_pk_bf16(v0[2] * g[2], v0[3] * g[3]);
                        w.z = cvt_pk_bf16(v1[0] * g[4], v1[1] * g[5]); w.w = cvt_pk_bf16(v1[2] * g[6], v1[3] * g[7]);
                        *(u32x4*)(GS + row * D + col0 + bj * HALF) = w; } } }
    }
};
struct BranchOrder {
    StaticOrder so; int G;
    __device__ __forceinline__ void init(int G_, int c_) { so.init(M, 1024, G_, c_, 0); G = G_; }
    __device__ __forceinline__ bool next(int i, Unit& u) const { Unit t; if (!so.next(i / 3, t)) return false; const int n = i % 3; u.pm = t.pm; u.pn = n * 4 + t.pn; u.ka = n; return true; }
};
struct EpiRes {
    __device__ __forceinline__ bool keep(const Unit&) const { return false; }
    static constexpr bool PERM = false;
    float* X;
    __device__ __forceinline__ void operator()(f32x4 (&acc)[2][2][4][2], const Unit& u, int wr, int wc, int fr, int fq) const {
        const int row0 = u.pm * BM + wr * 64 + fr, col0 = u.pn * BM + wc * 32 + 4 * fq;
#pragma unroll
        for (int ai = 0; ai < 2; ++ai)
#pragma unroll
            for (int m = 0; m < 4; ++m) { float* rowp = X + (size_t)(row0 + ai * HALF + m * 16) * D + col0;
#pragma unroll
                for (int bj = 0; bj < 2; ++bj)
#pragma unroll
                    for (int n = 0; n < 2; ++n) { f32x4* p = (f32x4*)(rowp + bj * HALF + n * 16); *p = *p + acc[ai][bj][m][n]; } }
    }
};
struct EpiB16 {
    __device__ __forceinline__ bool keep(const Unit&) const { return false; }
    static constexpr bool PERM = true;
    bf16_t* O; int ldc;
    __device__ __forceinline__ void operator()(f32x4 (&acc)[2][2][4][2], const Unit& u, int wr, int wc, int fr, int fq) const {
        const int row0 = u.pm * BM + wr * 64 + fr, col0 = u.pn * BM + wc * 32 + 8 * fq;
#pragma unroll
        for (int ai = 0; ai < 2; ++ai)
#pragma unroll
            for (int m = 0; m < 4; ++m) { bf16_t* rowp = O + (size_t)(row0 + ai * HALF + m * 16) * ldc + col0;
#pragma unroll
                for (int bj = 0; bj < 2; ++bj) { const f32x4 v0 = acc[ai][bj][m][0], v1 = acc[ai][bj][m][1];
                    u32x4 w; w.x = cvt_pk_bf16(v0[0], v0[1]); w.y = cvt_pk_bf16(v0[2], v0[3]); w.z = cvt_pk_bf16(v1[0], v1[1]); w.w = cvt_pk_bf16(v1[2], v1[3]);
                    *(u32x4*)(rowp + bj * HALF) = w; } }
    }
};
}

struct Args {
    const float* x; const int* pos; const float* norm1; const float* w_in; const float* lb_logits; const float* hgrn_gain; const float* gmlp_gain; const float* gmlp_ws; const float* gmlp_bs;
    const float* w_branch; const float* w_out; const float* norm2; const float* peer_wq; const float* peer_keys; const float* peer_u; const float* peer_v; const float* final_gain;
    float* out; unsigned char* ws; int ph_lo, ph_hi;
};
constexpr int NTHR = 512, NWAVE = 8;
constexpr int LDS_BYTES = 147456;
constexpr int LDS_CTL_OFF = 143360;

__device__ __forceinline__ void tr_item(const float* src, int ldsrc, int c0, int nvalid, bf16_t* dst, int ldd, int r0, int koff, float* scr, int item, int nblk, int lane) {
    const int kb = item / nblk, nb = item % nblk, k0 = 64 * kb, n0 = 32 * nb;
    const int nn = n0 + (lane & 31);
#pragma unroll 8
    for (int i = 0; i < 32; ++i) { const int kk = 2 * i + (lane >> 5); scr[kk * 33 + (lane & 31)] = (nn < nvalid) ? src[(size_t)(k0 + kk) * ldsrc + c0 + nn] : 0.f; }
    asm volatile("s_waitcnt lgkmcnt(0)" ::: "memory");
    const int c = lane & 7;
#pragma unroll
    for (int j = 0; j < 4; ++j) { const int n = (lane >> 3) + 8 * j; const float* s = scr + (8 * c) * 33 + n;
        u32x4 o; o.x = pk2(s[0 * 33], s[1 * 33]); o.y = pk2(s[2 * 33], s[3 * 33]); o.z = pk2(s[4 * 33], s[5 * 33]); o.w = pk2(s[6 * 33], s[7 * 33]);
        *(u32x4*)(dst + (size_t)(r0 + n0 + n) * ldd + koff + k0 + 8 * c) = o; }
    asm volatile("s_waitcnt lgkmcnt(0)" ::: "memory");
}
__device__ __forceinline__ void rms_row_to_bf16(const float* xrow, const float* gain, bf16_t* orow, int lane) {
    const f32x4* xr = (const f32x4*)xrow + lane; const f32x4* gr = (const f32x4*)gain + lane;
    f32x4 v[4]; float s = 0.f;
#pragma unroll
    for (int j = 0; j < 4; ++j) { v[j] = xr[64 * j]; s += (v[j].x * v[j].x + v[j].y * v[j].y) + (v[j].z * v[j].z + v[j].w * v[j].w); }
    const float r = rsqrtf(wave_sum(s) * (1.f / D) + EPS);
    unsigned long long* o8 = (unsigned long long*)orow + lane;
#pragma unroll
    for (int j = 0; j < 4; ++j) { const f32x4 g = gr[64 * j]; o8[64 * j] = (unsigned long long)pk2(v[j].x * r * g.x, v[j].y * r * g.y) | ((unsigned long long)pk2(v[j].z * r * g.z, v[j].w * r * g.w) << 32); }
}

__device__ __forceinline__ void ph_prologue(const Args& a, unsigned char* lds, int wv) {
    const int tid = otid(wv), lane = tid & 63, wave = tid >> 6;
    const int gw = blockIdx.x * NWAVE + wave, ngw = gridDim.x * NWAVE;
    const size_t gtid = (size_t)blockIdx.x * NTHR + tid, gsz = (size_t)gridDim.x * NTHR;
    unsigned char* ws = oport(a.ws);
    { const f32x4* s = (const f32x4*)a.x; f32x4* d = (f32x4*)a.out; for (size_t i = gtid; i < (size_t)M * D / 4; i += gsz) d[i] = s[i]; }
    float* scr = (float*)(lds + wave * 16384);
    constexpr int I_IN1 = 16 * 160, I_IN2 = 16 * 8, I_IN3 = 16 * 96, I_IN = I_IN1 + I_IN2 + I_IN3;
    constexpr int I_BR = 3 * 8 * 32, I_OUT = 16 * 32, I_PQ = 16 * 64, I_L = I_IN + I_BR + I_OUT + I_PQ;
    for (int it = gw; it < DEPTH * I_L; it += ngw) {
        const int l = it / I_L; int r = it % I_L;
        bf16_t* win = (bf16_t*)(ws + WS_WIN + (size_t)l * WIN_L); const float* src_in = a.w_in + (size_t)l * D * NIN;
        if (r < I_IN1) { tr_item(src_in, NIN, 0, 5120, win, D, 0, 0, scr, r, 160, lane); continue; } r -= I_IN1;
        if (r < I_IN2) { tr_item(src_in, NIN, 5120, 72, win, D, C_KI, 0, scr, r, 8, lane); continue; } r -= I_IN2;
        if (r < I_IN3) { tr_item(src_in, NIN, S_GL, 3072, win, D, C_GL, 0, scr, r, 96, lane); continue; } r -= I_IN3;
        if (r < I_BR) { const int n = r / 256; tr_item(a.w_branch + ((size_t)l * 3 + n) * 512 * D, D, 0, 1024, (bf16_t*)(ws + WS_WBR + (size_t)l * WBR_L), 512, n * 1024, 0, scr, r % 256, 32, lane); continue; } r -= I_BR;
        if (r < I_OUT) { tr_item(a.w_out + (size_t)l * D * D, D, 0, 1024, (bf16_t*)(ws + WS_WOUT + (size_t)l * WOUT_L), D, 0, 0, scr, r, 32, lane); continue; } r -= I_OUT;
        tr_item(a.peer_wq + (size_t)l * D * 2048, 2048, 0, 2048, (bf16_t*)(ws + WS_WPQ + (size_t)l * WPQ_L), D, 0, 0, scr, r, 64, lane);
    }
    if (gtid < 512) { float v[DEPTH], mx = -1e30f; for (int l = 0; l < DEPTH; ++l) { v[l] = a.lb_logits[l * 512 + gtid]; mx = fmaxf(mx, v[l]); }
        float s = 0.f; for (int l = 0; l < DEPTH; ++l) { v[l] = __expf(v[l] - mx); s += v[l]; }
        float c = 0.f; float* lb = (float*)(ws + WS_LB); for (int l = 0; l < DEPTH; ++l) { if (l > 0) c += v[l] / s; lb[l * 512 + gtid] = c; } }
    { u32x4* SKB = (u32x4*)(ws + WS_SKB); const f32x4* sk = (const f32x4*)a.peer_keys; for (size_t i = gtid; i < (size_t)DEPTH * 16 * 128 * 128 / 8; i += gsz) { const f32x4 k0 = sk[2 * i], k1 = sk[2 * i + 1]; SKB[i] = (u32x4){pk2(k0.x, k0.y), pk2(k0.z, k0.w), pk2(k1.x, k1.y), pk2(k1.z, k1.w)}; } }
    { bf16_t* WSB = (bf16_t*)(ws + WS_WSB); for (size_t i = gtid; i < (size_t)DEPTH * 4 * 128 * 128; i += gsz) { const int t = (int)((i >> 7) & 127), sx = (int)(i & 127); WSB[i] = (bf16_t)f2bf(sx <= t ? a.gmlp_ws[i] : 0.f); } }
    { float2* cs = (float2*)(ws + WS_CS);
      for (size_t i = gtid; i < (size_t)M * 96; i += gsz) { const int m = (int)(i / 96), j = (int)(i % 96);
          const float inv = j < 64 ? ROPE_INV64[j] : ROPE_INV32[j - 64]; const float angf = (float)a.pos[m] * inv;
          const double ang = (double)angf; const double k = rint(ang * 0.15915494309189535); const float r = (float)(ang - k * 6.283185307179586);
          cs[i] = make_float2(__cosf(r), __sinf(r)); } }
    for (int m = gw; m < M; m += ngw) rms_row_to_bf16(a.x + (size_t)m * D, a.norm1, (bf16_t*)(ws + WS_H16) + (size_t)m * D, lane);
}

__device__ __forceinline__ void ph_kiwi(const Args& a, int l, unsigned char* lds, int wv) {
    unsigned char* ws = oport(a.ws); const int tid = otid(wv), lane = tid & 63, wave = __builtin_amdgcn_readfirstlane(tid >> 6), g4 = wave & 3, kh = wave >> 2, fr = lane & 15, fq = lane >> 4;
    const bf16_t* H16 = (const bf16_t*)(ws + WS_H16); const bf16_t* W = (const bf16_t*)(ws + WS_WIN + (size_t)l * WIN_L) + (size_t)C_KI * D; float* PF = (float*)(ws + WS_PF);
    f32x4* sK = (f32x4*)lds + (g4 * 5) * 64 + lane;
    for (int base = blockIdx.x; base * 4 < M / 16; base += gridDim.x) { const int tg = base * 4 + g4; f32x4 acc[5];
#pragma unroll
        for (int nt = 0; nt < 5; ++nt) acc[nt] = (f32x4){0.f, 0.f, 0.f, 0.f};
#pragma unroll 8
        for (int ks = 16 * kh; ks < 16 * kh + 16; ++ks) { const bf16x8 y = ((const bf16x8*)(H16 + (size_t)tg * 16 * D + 32 * ks))[fr * (D / 8) + fq];
#pragma unroll
            for (int nt = 0; nt < 5; ++nt) { const bf16x8 x = ((const bf16x8*)(W + (size_t)nt * 16 * D + 32 * ks))[fr * (D / 8) + fq]; acc[nt] = __builtin_amdgcn_mfma_f32_16x16x32_bf16(x, y, acc[nt], 0, 0, 0); } }
        __syncthreads();
        if (kh == 1) {
#pragma unroll
            for (int nt = 0; nt < 5; ++nt) sK[nt * 64] = acc[nt]; }
        __syncthreads();
        if (kh == 0) {
#pragma unroll
            for (int nt = 0; nt < 5; ++nt) *(f32x4*)(PF + ((size_t)tg * 16 + fr) * PFW + 512 + 16 * nt + 4 * fq) = acc[nt] + sK[nt * 64]; }
    }
    __syncthreads();
}

__device__ __forceinline__ void ph_post(const Args& a, int l, unsigned char* lds, int wv) {
    const int tid = otid(wv), lane = tid & 63, wave = tid >> 6;
    const int gw = blockIdx.x * NWAVE + wave, ngw = gridDim.x * NWAVE;
    const size_t gtid = (size_t)blockIdx.x * NTHR + tid, gsz = (size_t)gridDim.x * NTHR;
    unsigned char* ws = oport(a.ws);
    const bf16_t* P16 = (const bf16_t*)(ws + WS_P16); const float* PF = (const float*)(ws + WS_PF); const float2* cs = (const float2*)(ws + WS_CS);
    { bf16_t* QR = (bf16_t*)(ws + WS_QR); bf16_t* KR = (bf16_t*)(ws + WS_KR);
#pragma unroll 4
      for (size_t i = gtid; i < (size_t)M * 256; i += gsz) { const int m = (int)(i >> 8), h = (int)((i >> 6) & 3), j = (int)(i & 63);
          const float2 c = cs[(size_t)m * 96 + j]; const size_t pb = (size_t)m * NPAD + h * 128 + j, ob = (size_t)m * 512 + h * 128 + j;
          const float q1 = bf2f(P16[pb + C_CQ]), q2 = bf2f(P16[pb + C_CQ + 64]), k1 = bf2f(P16[pb + C_CK]), k2 = bf2f(P16[pb + C_CK + 64]);
          const float sc = 0.08838834764831845f * 1.4426950408889634f;
          QR[ob] = (bf16_t)f2bf((q1 * c.x - q2 * c.y) * sc); QR[ob + 64] = (bf16_t)f2bf((q2 * c.x + q1 * c.y) * sc);
          KR[ob] = (bf16_t)f2bf(k1 * c.x - k2 * c.y); KR[ob + 64] = (bf16_t)f2bf(k2 * c.x + k1 * c.y); } }
    { bf16_t* QS = (bf16_t*)(ws + WS_QI); bf16_t* KIb = (bf16_t*)(ws + WS_KI); float* WP = (float*)(ws + WS_WI);
#pragma unroll 2
      for (int m = gw; m < M; m += ngw) { const int h = lane >> 3, jj = lane & 7;
          const unsigned long long w1 = *(const unsigned long long*)(P16 + (size_t)m * NPAD + C_QI + h * 64 + 4 * jj), w2 = *(const unsigned long long*)(P16 + (size_t)m * NPAD + C_QI + h * 64 + 32 + 4 * jj);
          const float q1[4] = {lo_bf((unsigned)w1), hi_bf((unsigned)w1), lo_bf((unsigned)(w1 >> 32)), hi_bf((unsigned)(w1 >> 32))}, q2[4] = {lo_bf((unsigned)w2), hi_bf((unsigned)w2), lo_bf((unsigned)(w2 >> 32)), hi_bf((unsigned)(w2 >> 32))};
          const float2* c = cs + (size_t)m * 96 + 64 + 4 * jj; const float w = PF[(size_t)m * PFW + 576 + h] * 0.02209708691207961f;
          float r1[4], r2[4], l1[4], l2[4];
#pragma unroll
          for (int i = 0; i < 4; ++i) { const float2 cc = c[i]; r1[i] = q1[i] * cc.x - q2[i] * cc.y; r2[i] = q2[i] * cc.x + q1[i] * cc.y; l1[i] = w * r1[i]; l2[i] = w * r2[i]; }
          *(unsigned long long*)(QS + (size_t)m * 576 + h * 64 + 4 * jj) = (unsigned long long)pk2(r1[0], r1[1]) | ((unsigned long long)pk2(r1[2], r1[3]) << 32);
          *(unsigned long long*)(QS + (size_t)m * 576 + h * 64 + 32 + 4 * jj) = (unsigned long long)pk2(r2[0], r2[1]) | ((unsigned long long)pk2(r2[2], r2[3]) << 32);
#pragma unroll
          for (int i = 0; i < 4; ++i) { l1[i] += __shfl_xor(l1[i], 8); l1[i] += __shfl_xor(l1[i], 16); l1[i] += __shfl_xor(l1[i], 32); l2[i] += __shfl_xor(l2[i], 8); l2[i] += __shfl_xor(l2[i], 16); l2[i] += __shfl_xor(l2[i], 32); }
          if (h == 0) { *(unsigned long long*)(QS + (size_t)m * 576 + 512 + 4 * jj) = (unsigned long long)pk2(l1[0], l1[1]) | ((unsigned long long)pk2(l1[2], l1[3]) << 32);
                        *(unsigned long long*)(QS + (size_t)m * 576 + 512 + 32 + 4 * jj) = (unsigned long long)pk2(l2[0], l2[1]) | ((unsigned long long)pk2(l2[2], l2[3]) << 32);
                        const f32x4 k1 = *(const f32x4*)(PF + (size_t)m * PFW + 512 + 4 * jj), k2 = *(const f32x4*)(PF + (size_t)m * PFW + 512 + 32 + 4 * jj);
                        const float kk1[4] = {k1.x, k1.y, k1.z, k1.w}, kk2[4] = {k2.x, k2.y, k2.z, k2.w}; float o1[4], o2[4];
#pragma unroll
                        for (int i = 0; i < 4; ++i) { const float2 cc = c[i]; o1[i] = kk1[i] * cc.x - kk2[i] * cc.y; o2[i] = kk2[i] * cc.x + kk1[i] * cc.y; }
                        *(unsigned long long*)(KIb + (size_t)m * 64 + 4 * jj) = (unsigned long long)pk2(o1[0], o1[1]) | ((unsigned long long)pk2(o1[2], o1[3]) << 32);
                        *(unsigned long long*)(KIb + (size_t)m * 64 + 32 + 4 * jj) = (unsigned long long)pk2(o2[0], o2[1]) | ((unsigned long long)pk2(o2[2], o2[3]) << 32); }
          if (jj == 0) WP[(size_t)m * 8 + h] = w; } }
    { bf16_t* VT = (bf16_t*)(ws + WS_VT); bf16_t* sT = (bf16_t*)lds;
      for (int t0 = blockIdx.x * 8; t0 < (M / 64) * 8; t0 += gridDim.x * 8) {
          u32x4 w[8]; const int row = tid >> 3, seg = tid & 7;
#pragma unroll
          for (int q = 0; q < 8; ++q) { const int tile = t0 + q, tb = tile >> 3, cb = tile & 7; w[q] = *(const u32x4*)(P16 + (size_t)(tb * 64 + row) * NPAD + C_CV + cb * 64 + seg * 8); }
          __syncthreads();
#pragma unroll
          for (int q = 0; q < 8; ++q) { unsigned* d = (unsigned*)(sT + q * 64 * 66 + row * 66 + seg * 8); d[0] = w[q].x; d[1] = w[q].y; d[2] = w[q].z; d[3] = w[q].w; }
          __syncthreads();
          const int ch = tid >> 3, tg = tid & 7;
#pragma unroll
          for (int q = 0; q < 8; ++q) { const int tile = t0 + q, tb = tile >> 3, cb = tile & 7; unsigned short v[8];
#pragma unroll
              for (int i = 0; i < 8; ++i) v[i] = sT[q * 64 * 66 + (tg * 8 + i) * 66 + ch];
              const u32x4 o = {(unsigned)v[0] | ((unsigned)v[1] << 16), (unsigned)v[2] | ((unsigned)v[3] << 16), (unsigned)v[4] | ((unsigned)v[5] << 16), (unsigned)v[6] | ((unsigned)v[7] << 16)};
              *(u32x4*)(VT + ((size_t)((tb >> 7) * 512 + cb * 64 + ch)) * SEQ + (tb & 127) * 64 + tg * 8) = o; } }
      __syncthreads(); }
    { bf16_t* VN = (bf16_t*)(ws + WS_VN); const float* gain = a.gmlp_gain + l * 512;
#pragma unroll 4
      for (int m = gw; m < M; m += ngw) { const u32x4 w = *(const u32x4*)(P16 + (size_t)m * NPAD + C_BV + lane * 8);
          float v[8] = {gelu_t(lo_bf(w.x)), gelu_t(hi_bf(w.x)), gelu_t(lo_bf(w.y)), gelu_t(hi_bf(w.y)), gelu_t(lo_bf(w.z)), gelu_t(hi_bf(w.z)), gelu_t(lo_bf(w.w)), gelu_t(hi_bf(w.w))};
          float sm = 0.f;
#pragma unroll
          for (int j = 0; j < 8; ++j) sm += v[j] * v[j];
          const float r = rsqrtf(wave_sum(sm) * (1.f / 512.f) + EPS);
          const f32x4 g0 = *(const f32x4*)(gain + lane * 8), g1 = *(const f32x4*)(gain + lane * 8 + 4);
          *(u32x4*)(VN + (size_t)m * 512 + lane * 8) = (u32x4){pk2(v[0] * r * g0.x, v[1] * r * g0.y), pk2(v[2] * r * g0.z, v[3] * r * g0.w), pk2(v[4] * r * g1.x, v[5] * r * g1.y), pk2(v[6] * r * g1.z, v[7] * r * g1.w)}; } }
}

constexpr int NHU = BATCH * 128 * 4;
__device__ __forceinline__ void ph_h1(const Args& a, int l, unsigned char* lds, int wv) {
    unsigned char* ws = oport(a.ws);
    const int tid = otid(wv), lane = tid & 63, wave = __builtin_amdgcn_readfirstlane(tid >> 6), j = wave >> 1, d = tid & 127, fr = lane & 15, fq = lane >> 4;
    bf16_t* KT = (bf16_t*)lds;
    bf16_t* VT = KT + 128 * 72;
    float* sT = (float*)(VT + 128 * 72);
    const float* PF = (const float*)(ws + WS_PF); const bf16_t* P16 = (const bf16_t*)(ws + WS_P16); const float* LB = (const float*)(ws + WS_LB) + l * 512;
    float* LL = (float*)(ws + WS_FF); float* DD = (float*)(ws + WS_DD);
    for (int u = blockIdx.x; u < NHU; u += gridDim.x) {
        const int h = u & 3, c = (u >> 2) & 127, b = u >> 9; const size_t m0 = (size_t)b * SEQ + c * 64 + j * 16;
        const float lbv = LB[h * 128 + d];
        float cs[16], ky[16]; unsigned vv[16]; float run = 0.f;
#pragma unroll
        for (int i = 0; i < 16; ++i) { const float z = PF[(m0 + i) * PFW + h * 128 + d]; const float sg = sigm(z); run += __logf(lbv + (1.f - lbv) * sg); cs[i] = run; ky[i] = (1.f - lbv) * (1.f - sg);
            vv[i] = P16[(m0 + i) * NPAD + C_AI + h * 128 + d]; }
        sT[j * 128 + d] = run;
        __syncthreads();
        float tail = 0.f;
#pragma unroll
        for (int jj = 1; jj < 4; ++jj) if (jj > j) tail += sT[jj * 128 + d];
        { unsigned w[8], x[8];
#pragma unroll
          for (int i = 0; i < 8; ++i) { w[i] = pk2(ky[2 * i] * __expf(tail + (run - cs[2 * i])), ky[2 * i + 1] * __expf(tail + (run - cs[2 * i + 1]))); x[i] = vv[2 * i] | (vv[2 * i + 1] << 16); }
          u32x4* kp = (u32x4*)(KT + d * 72 + j * 16); kp[0] = (u32x4){w[0], w[1], w[2], w[3]}; kp[1] = (u32x4){w[4], w[5], w[6], w[7]};
          u32x4* vp = (u32x4*)(VT + d * 72 + j * 16); vp[0] = (u32x4){x[0], x[1], x[2], x[3]}; vp[1] = (u32x4){x[4], x[5], x[6], x[7]}; }
        if (j == 0) DD[(size_t)u * 128 + d] = __expf(run + tail);
        __syncthreads();
        { bf16x8 xk[2];
#pragma unroll
          for (int ks = 0; ks < 2; ++ks) xk[ks] = *(const bf16x8*)(KT + (16 * wave + fr) * 72 + ks * 32 + fq * 8);
#pragma unroll
          for (int nt = 0; nt < 8; ++nt) { f32x4 acc = {0.f, 0.f, 0.f, 0.f};
#pragma unroll
              for (int ks = 0; ks < 2; ++ks) { const bf16x8 y = *(const bf16x8*)(VT + (16 * nt + fr) * 72 + ks * 32 + fq * 8); acc = __builtin_amdgcn_mfma_f32_16x16x32_bf16(xk[ks], y, acc, 0, 0, 0); }
              *(f32x4*)(LL + ((size_t)u * 128 + 16 * nt + fr) * 128 + 16 * wave + 4 * fq) = acc; } }
        __syncthreads();
    }
}
__device__ __forceinline__ void ph_h2(const Args& a, int wv) {
    unsigned char* ws = oport(a.ws);
    const float* LL = (const float*)(ws + WS_FF); const float* DD = (const float*)(ws + WS_DD); bf16_t* SB = (bf16_t*)(ws + WS_QF);
    for (int e = blockIdx.x * NTHR + otid(wv); e < 8 * 16384; e += gridDim.x * NTHR) { const int bh = e >> 14, b = bh >> 2, h = bh & 3, dvdk = e & 16383, dk = e & 127; float S = 0.f;
#pragma unroll 16
        for (int c = 0; c < 128; ++c) { const size_t u = (size_t)(((b * 128 + c) << 2) + h); SB[u * 16384 + dvdk] = (bf16_t)f2bf(S); S = DD[u * 128 + dk] * S + LL[u * 16384 + dvdk]; } }
}
__device__ __forceinline__ void ph_h3(const Args& a, int l, unsigned char* lds, int wv) {
    unsigned char* ws = oport(a.ws);
    const int tid = otid(wv), lane = tid & 63, wave = __builtin_amdgcn_readfirstlane(tid >> 6), j = wave >> 1, d = tid & 127, fr = lane & 15, fq = lane >> 4;
    bf16_t* QT = (bf16_t*)lds;
    bf16_t* QH = QT + 64 * 136;
    bf16_t* KI = QH + 64 * 136;
    bf16_t* VT = KI + 160 * 136;
    bf16_t* AT = VT + 128 * 72;
    float* sT = (float*)(AT + 64 * 72);
    float* sSS = sT + 512;
    const float* PF = (const float*)(ws + WS_PF); const bf16_t* P16 = (const bf16_t*)(ws + WS_P16); const float* LB = (const float*)(ws + WS_LB) + l * 512;
    const bf16_t* SB = (const bf16_t*)(ws + WS_QF); bf16_t* YA = (bf16_t*)(ws + WS_YALL); const float* gain = a.hgrn_gain + l * 128;
    for (int u = blockIdx.x; u < NHU; u += gridDim.x) {
        const int h = u & 3, c = (u >> 2) & 127, b = u >> 9; const size_t mc = (size_t)b * SEQ + c * 64, m0 = mc + j * 16;
        for (int i = tid; i < 64 * 72 * 2 / 16; i += NTHR) ((u32x4*)AT)[i] = (u32x4){0u, 0u, 0u, 0u};
        bf16x8 sbf[4][4];
#pragma unroll
        for (int q4 = 0; q4 < 4; ++q4)
#pragma unroll
            for (int ks = 0; ks < 4; ++ks) sbf[q4][ks] = ((const bf16x8*)(SB + ((size_t)u * 128 + 16 * (4 * (wave >> 2) + q4)) * 128 + 32 * ks))[fr * 16 + fq];
        const float lbv = LB[h * 128 + d];
        float cs[16], ky[16], qf[16]; unsigned vv[16]; float run = 0.f;
#pragma unroll
        for (int i = 0; i < 16; ++i) { const size_t pr = (m0 + i) * NPAD + h * 128 + d; const float z = PF[(m0 + i) * PFW + h * 128 + d]; const float sg = sigm(z); run += __logf(lbv + (1.f - lbv) * sg); cs[i] = run; ky[i] = (1.f - lbv) * (1.f - sg);
            qf[i] = silu(bf2f(P16[pr + C_AQ])) * 0.08838834764831845f; vv[i] = P16[pr + C_AI]; }
        sT[j * 128 + d] = run;
        __syncthreads();
        const float T0 = sT[d], T1 = sT[128 + d], T2 = sT[256 + d];
        const float Bj = (j > 0 ? T0 : 0.f) + (j > 1 ? T1 : 0.f) + (j > 2 ? T2 : 0.f); const float eBj = __expf(Bj);
        float pre[4]; pre[0] = 0.f; pre[1] = (j < 1 ? T0 : 0.f); pre[2] = (j < 1 ? T0 : 0.f) + (j < 2 ? T1 : 0.f); pre[3] = (j < 1 ? T0 : 0.f) + (j < 2 ? T1 : 0.f) + (j < 3 ? T2 : 0.f);
#pragma unroll
        for (int i = 0; i < 16; ++i) { const int t = 16 * j + i; const float ec = __expf(cs[i]);
            QT[t * 136 + d] = (bf16_t)f2bf(qf[i] * ec); QH[t * 136 + d] = (bf16_t)f2bf(qf[i] * ec * eBj);
#pragma unroll
            for (int I = 0; I < 4; ++I) if (I >= j) KI[(8 * I * (I + 1) + t) * 136 + d] = (bf16_t)f2bf(ky[i] * __expf(fminf(pre[I] - cs[i], 80.f))); }
        { unsigned x[8];
#pragma unroll
          for (int i = 0; i < 8; ++i) x[i] = vv[2 * i] | (vv[2 * i + 1] << 16);
          u32x4* vp = (u32x4*)(VT + d * 72 + j * 16); vp[0] = (u32x4){x[0], x[1], x[2], x[3]}; vp[1] = (u32x4){x[4], x[5], x[6], x[7]}; }
        __syncthreads();
        for (int tl = wave; tl < 10; tl += 8) { const int I = tl < 1 ? 0 : tl < 3 ? 1 : tl < 6 ? 2 : 3, J = tl - (I * (I + 1)) / 2; f32x4 acc = {0.f, 0.f, 0.f, 0.f};
#pragma unroll
            for (int ks = 0; ks < 4; ++ks) { const bf16x8 x = *(const bf16x8*)(QT + (16 * I + fr) * 136 + ks * 32 + fq * 8); const bf16x8 y = *(const bf16x8*)(KI + (8 * I * (I + 1) + 16 * J + fr) * 136 + ks * 32 + fq * 8);
                acc = __builtin_amdgcn_mfma_f32_16x16x32_bf16(x, y, acc, 0, 0, 0); }
#pragma unroll
            for (int r = 0; r < 4; ++r) { float v = acc[r]; if (J == I && fr > 4 * fq + r) v = 0.f; AT[(16 * I + 4 * fq + r) * 72 + 16 * J + fr] = (bf16_t)f2bf(v); } }
        __syncthreads();
        const int I = wave & 3, nt0 = 4 * (wave >> 2); f32x4 o[4];
#pragma unroll
        for (int q4 = 0; q4 < 4; ++q4) { const int nt = nt0 + q4; f32x4 acc = {0.f, 0.f, 0.f, 0.f};
            for (int ks = 0; ks <= (I >> 1); ++ks) { const bf16x8 x = *(const bf16x8*)(AT + (16 * I + fr) * 72 + ks * 32 + fq * 8); const bf16x8 y = *(const bf16x8*)(VT + (16 * nt + fr) * 72 + ks * 32 + fq * 8);
                acc = __builtin_amdgcn_mfma_f32_16x16x32_bf16(x, y, acc, 0, 0, 0); }
#pragma unroll
            for (int ks = 0; ks < 4; ++ks) { const bf16x8 x = *(const bf16x8*)(QH + (16 * I + fr) * 136 + ks * 32 + fq * 8); acc = __builtin_amdgcn_mfma_f32_16x16x32_bf16(x, sbf[q4][ks], acc, 0, 0, 0); }
            o[q4] = acc; }
        { float ssq[4];
#pragma unroll
          for (int r = 0; r < 4; ++r) { float s = o[0][r] * o[0][r] + o[1][r] * o[1][r] + o[2][r] * o[2][r] + o[3][r] * o[3][r]; s += __shfl_xor(s, 1); s += __shfl_xor(s, 2); s += __shfl_xor(s, 4); s += __shfl_xor(s, 8); ssq[r] = s; }
          if (fr == 0) {
#pragma unroll
              for (int r = 0; r < 4; ++r) sSS[(16 * I + 4 * fq + r) * 2 + (wave >> 2)] = ssq[r]; } }
        __syncthreads();
#pragma unroll
        for (int r = 0; r < 4; ++r) { const int tt = 16 * I + 4 * fq + r; const float rinv = rsqrtf((sSS[tt * 2] + sSS[tt * 2 + 1]) * (1.f / 128.f) + EPS); const size_t m = mc + tt;
#pragma unroll
            for (int q4 = 0; q4 < 4; ++q4) { const int dv = 16 * (nt0 + q4) + fr; const float g = bf2f(P16[m * NPAD + C_AG + h * 128 + dv]);
                YA[m * 512 + h * 128 + dv] = (bf16_t)f2bf(o[q4][r] * rinv * gain[dv] * silu(g)); } }
        __syncthreads();
    }
}
__device__ __forceinline__ void ph_gmlp(const Args& a, int l, unsigned char* lds, int wv) {
    unsigned char* ws = oport(a.ws);
    const int tid = otid(wv), lane = tid & 63, wave = __builtin_amdgcn_readfirstlane(tid >> 6), fr = lane & 15, fq = lane >> 4;
    const bf16_t* P16 = (const bf16_t*)(ws + WS_P16); const bf16_t* VN = (const bf16_t*)(ws + WS_VN); bf16_t* YB = (bf16_t*)(ws + WS_YALL) + (size_t)M * 512;
    const bf16_t* WSB = (const bf16_t*)(ws + WS_WSB) + (size_t)l * 4 * 128 * 128; const float* bs = a.gmlp_bs + (size_t)l * 4 * 128;
    bf16_t* VNt = (bf16_t*)lds;
    for (int u = blockIdx.x; u < (M / 128) * 4; u += gridDim.x) { const int g = u & 3, nb = u >> 2; const size_t mb = (size_t)nb * 128;
        __syncthreads();
#pragma unroll
        for (int n = 0; n < 4; ++n) { const int idx = tid + NTHR * n, row = idx >> 4, seg = idx & 15; const u32x4 w = *(const u32x4*)(VN + (mb + row) * 512 + g * 128 + seg * 8);
            bf16_t* d = VNt + (seg * 8) * 136 + row;
            d[0 * 136] = (bf16_t)(w.x & 0xffffu); d[1 * 136] = (bf16_t)(w.x >> 16); d[2 * 136] = (bf16_t)(w.y & 0xffffu); d[3 * 136] = (bf16_t)(w.y >> 16);
            d[4 * 136] = (bf16_t)(w.z & 0xffffu); d[5 * 136] = (bf16_t)(w.z >> 16); d[6 * 136] = (bf16_t)(w.w & 0xffffu); d[7 * 136] = (bf16_t)(w.w >> 16); }
        bf16x8 wf[4];
#pragma unroll
        for (int ks = 0; ks < 4; ++ks) wf[ks] = *(const bf16x8*)(WSB + ((size_t)g * 128 + 16 * wave + fr) * 128 + 32 * ks + 8 * fq);
        __syncthreads();
        const int t = 16 * wave + fr; const float bias = bs[g * 128 + t]; const int nks = (wave >> 1) + 1;
#pragma unroll
        for (int ct = 0; ct < 8; ++ct) { f32x4 acc = {0.f, 0.f, 0.f, 0.f};
#pragma unroll
            for (int ks = 0; ks < 4; ++ks) if (ks < nks) { const bf16x8 x = *(const bf16x8*)(VNt + (16 * ct + fr) * 136 + 32 * ks + 8 * fq); acc = __builtin_amdgcn_mfma_f32_16x16x32_bf16(x, wf[ks], acc, 0, 0, 0); }
            const size_t m = mb + t; const int c = g * 128 + 16 * ct + 4 * fq; const unsigned long long uw = *(const unsigned long long*)(P16 + m * NPAD + C_BU + c);
            const float o0 = gelu_t(lo_bf((unsigned)uw)) * (acc[0] + bias), o1 = gelu_t(hi_bf((unsigned)uw)) * (acc[1] + bias), o2 = gelu_t(lo_bf((unsigned)(uw >> 32))) * (acc[2] + bias), o3 = gelu_t(hi_bf((unsigned)(uw >> 32))) * (acc[3] + bias);
            *(unsigned long long*)(YB + m * 512 + c) = (unsigned long long)pk2(o0, o1) | ((unsigned long long)pk2(o2, o3) << 32); }
    }
}
constexpr int SEL_CAP = 256;
__device__ __forceinline__ int sel_bin(float s, float lo, float sc) { return (int)__builtin_amdgcn_fmed3f((s - lo) * sc, 0.f, 1023.f); }
struct SelQ { float lo1, sc1, lo2, sc2, tau; int b1, b2, ref, tidx; };
__device__ __forceinline__ void sel_pass(const int mode, const bf16x8 (&qf)[9][2], const float (&wp)[8], const SelQ& sq, const bf16_t* kib, int c, int kp, int qloc, int fr, int fq,
                                         unsigned* sHist, unsigned* sCand, unsigned* sCnt, unsigned* maskrow) {
    bf16x8 af[4][2];
    { const int T0 = kp <= c ? kp : c;
#pragma unroll
      for (int rg = 0; rg < 4; ++rg)
#pragma unroll
          for (int ks = 0; ks < 2; ++ks) af[rg][ks] = ((const bf16x8*)(kib + (size_t)(64 * T0 + 16 * rg) * 64 + 32 * ks))[fr * 8 + fq]; }
#pragma unroll 1
    for (int T = kp; T <= c; T += 4) {
        const int Tn = (T + 4 <= c) ? T + 4 : T;
        unsigned mlo = 0u, mhi = 0u;
#pragma unroll
        for (int rg = 0; rg < 4; ++rg) {
            f32x4 sc = __builtin_amdgcn_mfma_f32_16x16x32_bf16(af[rg][0], qf[8][0], (f32x4){0.f, 0.f, 0.f, 0.f}, 0, 0, 0);
            sc = __builtin_amdgcn_mfma_f32_16x16x32_bf16(af[rg][1], qf[8][1], sc, 0, 0, 0);
#pragma unroll
            for (int h = 0; h < 8; ++h) { f32x4 ah = __builtin_amdgcn_mfma_f32_16x16x32_bf16(af[rg][0], qf[h][0], (f32x4){0.f, 0.f, 0.f, 0.f}, 0, 0, 0);
                ah = __builtin_amdgcn_mfma_f32_16x16x32_bf16(af[rg][1], qf[h][1], ah, 0, 0, 0);
#pragma unroll
                for (int r = 0; r < 4; ++r) sc[r] += wp[h] * __builtin_fabsf(ah[r]); }
#pragma unroll
            for (int ks = 0; ks < 2; ++ks) af[rg][ks] = ((const bf16x8*)(kib + (size_t)(64 * Tn + 16 * rg) * 64 + 32 * ks))[fr * 8 + fq];
            if (mode == 0) {
#pragma unroll
                for (int r = 0; r < 4; ++r) { const int b = sel_bin(sc[r], sq.lo1, sq.sc1); __hip_atomic_fetch_add(sHist + qloc * 512 + (b >> 1), 1u << ((b & 1) * 16), __ATOMIC_RELAXED, __HIP_MEMORY_SCOPE_WORKGROUP); }
            } else if (mode == 1) {
                if (sq.ref) {
#pragma unroll
                    for (int r = 0; r < 4; ++r) if (sel_bin(sc[r], sq.lo1, sq.sc1) == sq.b1) { const int b = sel_bin(sc[r], sq.lo2, sq.sc2); __hip_atomic_fetch_add(sHist + qloc * 512 + (b >> 1), 1u << ((b & 1) * 16), __ATOMIC_RELAXED, __HIP_MEMORY_SCOPE_WORKGROUP); } }
            } else {
                int b[4]; unsigned bits = 0u; bool anyc = false;
#pragma unroll
                for (int r = 0; r < 4; ++r) { b[r] = sel_bin(sc[r], sq.lo1, sq.sc1); bits |= (b[r] > sq.b1) ? (1u << r) : 0u; anyc |= (b[r] == sq.b1); }
                if (anyc) {
#pragma unroll
                    for (int r = 0; r < 4; ++r) if (b[r] == sq.b1) { bool cand = true;
                        if (sq.ref) { const int b2 = sel_bin(sc[r], sq.lo2, sq.sc2); if (b2 > sq.b2) bits |= 1u << r; cand = b2 == sq.b2; }
                        if (cand) { const unsigned slot = __hip_atomic_fetch_add(sCnt + qloc, 1u, __ATOMIC_RELAXED, __HIP_MEMORY_SCOPE_WORKGROUP);
                            if (slot < (unsigned)SEL_CAP) { sCand[(qloc * SEL_CAP + slot) * 2] = __float_as_uint(sc[r]); sCand[(qloc * SEL_CAP + slot) * 2 + 1] = (unsigned)(64 * T + 16 * rg + 4 * fq + r); } } } }
                bits <<= (16 * (rg & 1)) + 4 * fq; if (rg < 2) mlo |= bits; else mhi |= bits;
            }
            __builtin_amdgcn_sched_barrier(0);
        }
        if (mode == 2) { mlo |= __shfl_xor(mlo, 16); mlo |= __shfl_xor(mlo, 32); mhi |= __shfl_xor(mhi, 16); mhi |= __shfl_xor(mhi, 32);
            if (fq == 0) *(uint2*)(maskrow + 2 * T) = make_uint2(mlo, mhi); }
    }
}
__device__ __forceinline__ void sel_scan(const unsigned* hist, unsigned need, int lane, int& bsel, unsigned& nneed, unsigned& cnt) {
    unsigned c16[16]; unsigned tot = 0u;
#pragma unroll
    for (int i = 0; i < 8; ++i) { const unsigned w = hist[512 - 8 * (lane + 1) + i]; c16[2 * i] = w & 0xffffu; c16[2 * i + 1] = w >> 16; tot += (w & 0xffffu) + (w >> 16); }
    unsigned inc = tot;
#pragma unroll
    for (int o = 1; o < 64; o <<= 1) { const unsigned t2 = __shfl_up(inc, o); if (lane >= o) inc += t2; }
    const unsigned long long bal = __ballot(inc >= need);
    const int L = bal ? (__ffsll((long long)bal) - 1) : 63;
    unsigned above = __shfl(inc - tot, L); int bs = 0; unsigned nn = 1u, cc = 0u; bool found = false;
#pragma unroll
    for (int j = 0; j < 16; ++j) { const unsigned hcnt = __shfl(c16[15 - j], L); if (!found) { if (above + hcnt >= need) { found = true; bs = 1024 - 16 * L - 1 - j; nn = need - above; cc = hcnt; } else above += hcnt; } }
    bsel = bs; nneed = nn; cnt = cc;
}
__device__ __forceinline__ void ph_sel(const Args& a, unsigned char* lds, int wv) {
    unsigned char* ws = oport(a.ws);
    const int tid = otid(wv), lane = tid & 63, wave = __builtin_amdgcn_readfirstlane(tid >> 6), gq = wave & 1, kp = wave >> 1, fr = lane & 15, fq = lane >> 4, qloc = 16 * gq + fr;
    unsigned* sHist = (unsigned*)lds;
    unsigned* sCand = (unsigned*)(lds + 65536);
    float* sLo1 = (float*)(lds + 131072); float* sSc1 = sLo1 + 32; float* sLo2 = sSc1 + 32; float* sSc2 = sLo2 + 32; float* sTau = sSc2 + 32;
    int* sB1 = (int*)(sTau + 32); int* sB2 = sB1 + 32; int* sRef = sB2 + 32; int* sTidx = sRef + 32; unsigned* sNeed = (unsigned*)(sTidx + 32); unsigned* sCnt = sNeed + 32; int* sAny = (int*)(sCnt + 32);
    const bf16_t* QS = (const bf16_t*)(ws + WS_QI); const bf16_t* KIb = (const bf16_t*)(ws + WS_KI); const float* WP = (const float*)(ws + WS_WI); unsigned* MASKB = (unsigned*)(ws + WS_MASK);
    for (int pi = blockIdx.x; pi < 256; pi += gridDim.x) {
#pragma unroll 1
      for (int which = 0; which < 2; ++which) {
        const int b = pi & 1, half = (pi >> 1) & 1, cc = pi >> 2, c = which ? cc : 127 - cc;
        const size_t mq = (size_t)b * SEQ + 64 * c + 32 * half;
        const bf16_t* kib = KIb + (size_t)b * SEQ * 64;
        __syncthreads();
        if (tid < 32) { const float* w = WP + (mq + tid) * 8; float s1 = 0.f, s2 = 0.f;
#pragma unroll
            for (int h = 0; h < 8; ++h) { s1 += w[h]; s2 += w[h] * w[h]; }
            const float sd = 9.34f * sqrtf(fmaxf(s2, 1e-30f)); sLo1[tid] = 6.38f * s1 - 8.f * sd; sSc1[tid] = 1024.f / (16.f * sd);
            sLo2[tid] = 0.f; sSc2[tid] = 1.f; sB1[tid] = 0; sB2[tid] = 0; sRef[tid] = 0; sNeed[tid] = 256u; sCnt[tid] = 0u; sTau[tid] = -INFINITY; sTidx[tid] = 0x7fffffff; }
        if (tid == 0) sAny[0] = 0;
        for (int i = tid; i < 32 * 512 / 4; i += NTHR) ((u32x4*)sHist)[i] = (u32x4){0u, 0u, 0u, 0u};
        bf16x8 qf[9][2]; float wp[8];
        { const bf16_t* qrow = QS + (mq + qloc) * 576;
#pragma unroll
          for (int h = 0; h < 9; ++h)
#pragma unroll
              for (int ks = 0; ks < 2; ++ks) qf[h][ks] = *(const bf16x8*)(qrow + h * 64 + 32 * ks + 8 * fq);
#pragma unroll
          for (int h = 0; h < 8; ++h) wp[h] = WP[(mq + qloc) * 8 + h]; }
        __syncthreads();
        unsigned* maskrow = MASKB + (mq + qloc) * 256;
        if (c < 4) {
            if (tid < 32) for (int T = 0; T <= c; ++T) *(uint2*)(MASKB + (mq + tid) * 256 + 2 * T) = make_uint2(0xFFFFFFFFu, 0xFFFFFFFFu);
        } else {
#pragma unroll 1
            for (int pass = 0; pass < 3; ++pass) {
                if (pass == 1) { if (!sAny[0]) continue; __syncthreads(); for (int i = tid; i < 32 * 512 / 4; i += NTHR) ((u32x4*)sHist)[i] = (u32x4){0u, 0u, 0u, 0u}; __syncthreads(); }
                SelQ sq; sq.lo1 = sLo1[qloc]; sq.sc1 = sSc1[qloc]; sq.lo2 = sLo2[qloc]; sq.sc2 = sSc2[qloc]; sq.b1 = sB1[qloc]; sq.b2 = sB2[qloc]; sq.ref = sRef[qloc]; sq.tau = 0.f; sq.tidx = 0;
                sel_pass(pass, qf, wp, sq, kib, c, kp, qloc, fr, fq, sHist, sCand, sCnt, maskrow);
                asm volatile("s_waitcnt vmcnt(0)" ::: "memory");
                __syncthreads();
                if (pass < 2) {
                    for (int qq = wave * 4; qq < wave * 4 + 4; ++qq) if (pass == 0 || sRef[qq]) { int bs; unsigned nn, cn; sel_scan(sHist + qq * 512, sNeed[qq], lane, bs, nn, cn);
                        if (lane == 0) { sNeed[qq] = nn; if (pass == 0) { sB1[qq] = bs; if (cn > (unsigned)SEL_CAP) { sRef[qq] = 1; sLo2[qq] = sLo1[qq] + (float)bs / sSc1[qq]; sSc2[qq] = sSc1[qq] * 1024.f; sAny[0] = 1; } } else sB2[qq] = bs; } }
                    __syncthreads(); }
            }
            unsigned* sOff = (unsigned*)sAny + 4;
            if (tid < 64) { unsigned n = 0u; if (tid < 32) n = sCnt[tid] < (unsigned)SEL_CAP ? sCnt[tid] : (unsigned)SEL_CAP; unsigned inc = n;
#pragma unroll
                for (int o = 1; o < 32; o <<= 1) { const unsigned t2 = __shfl_up(inc, o); if (lane >= o) inc += t2; }
                if (tid < 32) { sOff[tid] = inc - n; if (tid == 31) sOff[32] = inc; } }
            __syncthreads();
            { const unsigned total = sOff[32];
              for (unsigned p = tid; p < total; p += NTHR) { int qq = 0;
#pragma unroll
                  for (int st = 16; st >= 1; st >>= 1) if (sOff[qq + st] <= p) qq += st;
                  const unsigned i = p - sOff[qq], n = sOff[qq + 1] - sOff[qq], want = sNeed[qq] - 1u;
                  const float si = __uint_as_float(sCand[(qq * SEL_CAP + i) * 2]); const unsigned ki = sCand[(qq * SEL_CAP + i) * 2 + 1]; unsigned rank = 0u;
                  for (unsigned j = 0; j < n; ++j) { const float sj = __uint_as_float(sCand[(qq * SEL_CAP + j) * 2]); const unsigned kj = sCand[(qq * SEL_CAP + j) * 2 + 1]; rank += (sj > si || (sj == si && kj < ki)) ? 1u : 0u; }
                  if (rank <= want) atomicOr(MASKB + (mq + qq) * 256 + (ki >> 5), 1u << (ki & 31u)); } }
        }
      }
    }
}

__device__ __forceinline__ void ph_attn(const Args& a, unsigned char* lds, int wv) {
    unsigned char* ws = oport(a.ws);
    const int tid = otid(wv), lane = tid & 63, wave = __builtin_amdgcn_readfirstlane(tid >> 6), g4 = wave & 3, par = wave >> 2, fr = lane & 15, fq = lane >> 4;
    const bf16_t* QR = (const bf16_t*)(ws + WS_QR); const bf16_t* KR = (const bf16_t*)(ws + WS_KR); const bf16_t* VT = (const bf16_t*)(ws + WS_VT); const unsigned* MASKB = (const unsigned*)(ws + WS_MASK);
    bf16_t* YC = (bf16_t*)(ws + WS_YALL) + (size_t)2 * M * 512;
    bf16_t* Kt = (bf16_t*)lds;
    bf16_t* Vt = Kt + 2 * 64 * 136;
    float* sMrg = (float*)lds;
    for (int pi = blockIdx.x; pi < 256; pi += gridDim.x) {
#pragma unroll 1
      for (int which = 0; which < 2; ++which) {
        const int bh = pi & 7, b = bh >> 2, h = bh & 3, cc = pi >> 3, qb = which ? cc : 63 - cc;
        const size_t m0 = (size_t)b * SEQ + 128 * qb + 32 * g4;
        const int mych = 2 * qb + (g4 >> 1);
        bf16x8 qf[2][4];
#pragma unroll
        for (int cg = 0; cg < 2; ++cg)
#pragma unroll
            for (int ks = 0; ks < 4; ++ks) qf[cg][ks] = *(const bf16x8*)(QR + (m0 + 16 * cg + fr) * 512 + h * 128 + 32 * ks + 8 * fq);
        f32x4 O[2][8]; float mrun[2], lrun[2];
#pragma unroll
        for (int cg = 0; cg < 2; ++cg) { mrun[cg] = -1e30f; lrun[cg] = 0.f;
#pragma unroll
            for (int vt = 0; vt < 8; ++vt) O[cg][vt] = (f32x4){0.f, 0.f, 0.f, 0.f}; }
        const bf16_t* kbase = KR + (size_t)b * SEQ * 512 + h * 128; const bf16_t* vbase = VT + (size_t)(b * 512 + h * 128) * SEQ;
        unsigned doff[9];
#pragma unroll
        for (int k = 0; k < 9; ++k) { const int i_ = wave + NWAVE * k, slot = 64 * i_ + lane;
            if (slot < 2176) { const int tl = slot >= 1088 ? 1 : 0, rs = slot - 1088 * tl, row = rs / 17, seg = rs - 17 * row; doff[k] = (unsigned)((64 * tl + row) * 512 + (seg & 15) * 8); }
            else { const int s2 = slot - 2176, tl = s2 >= 1152 ? 1 : 0, rs = s2 - 1152 * tl, row = rs / 9, seg = rs - 9 * row; doff[k] = (unsigned)(row * SEQ + 64 * tl + (seg & 7) * 8); } }
#define ATT_DMA(jj, buf) do { const bf16_t* kb_ = kbase + (size_t)(jj) * 128 * 512; const bf16_t* vb_ = vbase + (size_t)(jj) * 128; \
            _Pragma("unroll") for (int k = 0; k < 9; ++k) { const int i_ = wave + NWAVE * k; if (i_ < 70) { const bf16_t* src = (i_ < 34 ? kb_ : vb_) + doff[k]; \
                __builtin_amdgcn_global_load_lds((const unsigned*)src, (LAS unsigned*)(LAS unsigned char*)(lds + (buf) * 71680 + i_ * 1024), 16, 0, 0); } } } while (0)
        __syncthreads();
        ATT_DMA(0, 0);
        asm volatile("s_waitcnt vmcnt(0)" ::: "memory");
        __syncthreads();
        for (int j = 0; j <= qb; ++j) {
            if (j < qb) ATT_DMA(j + 1, (j + 1) & 1);
            const bf16_t* Ktb = Kt + (j & 1) * 35840; const bf16_t* Vtb = Vt + (j & 1) * 35840;
            const int T = 2 * j + par;
            if (T <= mych) {
                const bf16_t* kt = Ktb + par * 64 * 136; const bf16_t* vtl = Vtb + par * 128 * 72;
                uint2 mw[2];
#pragma unroll
                for (int cg = 0; cg < 2; ++cg) mw[cg] = *(const uint2*)(MASKB + (m0 + 16 * cg + fr) * 256 + 2 * T);
                f32x4 S[2][4];
#pragma unroll
                for (int rg = 0; rg < 4; ++rg) { S[0][rg] = (f32x4){0.f, 0.f, 0.f, 0.f}; S[1][rg] = (f32x4){0.f, 0.f, 0.f, 0.f};
                    const int krow = 32 * (rg >> 1) + 8 * (fr >> 2) + 4 * (rg & 1) + (fr & 3);
#pragma unroll
                    for (int ks = 0; ks < 4; ++ks) { const bf16x8 kf = *(const bf16x8*)(kt + krow * 136 + 32 * ks + 8 * fq);
                        S[0][rg] = __builtin_amdgcn_mfma_f32_16x16x32_bf16(kf, qf[0][ks], S[0][rg], 0, 0, 0); S[1][rg] = __builtin_amdgcn_mfma_f32_16x16x32_bf16(kf, qf[1][ks], S[1][rg], 0, 0, 0); } }
                bf16x8 pf[2][2];
#pragma unroll
                for (int cg = 0; cg < 2; ++cg) {
                    float mx = fmaxf(fmaxf(fmaxf(S[cg][0][0], S[cg][0][1]), fmaxf(S[cg][0][2], S[cg][0][3])), fmaxf(fmaxf(S[cg][1][0], S[cg][1][1]), fmaxf(S[cg][1][2], S[cg][1][3])));
                    mx = fmaxf(mx, fmaxf(fmaxf(fmaxf(S[cg][2][0], S[cg][2][1]), fmaxf(S[cg][2][2], S[cg][2][3])), fmaxf(fmaxf(S[cg][3][0], S[cg][3][1]), fmaxf(S[cg][3][2], S[cg][3][3]))));
                    mx = fmaxf(mx, __shfl_xor(mx, 16)); mx = fmaxf(mx, __shfl_xor(mx, 32));
                    const float mnew = fmaxf(mrun[cg], mx), alpha = __builtin_amdgcn_exp2f(mrun[cg] - mnew); mrun[cg] = mnew; float ls = 0.f;
                    const int m16 = (int)(((mw[cg].x >> (8 * fq)) & 0xFFu) | (((mw[cg].y >> (8 * fq)) & 0xFFu) << 8));
#pragma unroll
                    for (int rg = 0; rg < 4; ++rg)
#pragma unroll
                        for (int r = 0; r < 4; ++r) { const int keep = __builtin_amdgcn_sbfe(m16, 4 * rg + r, 1);
                            const float p = __int_as_float(__float_as_int(__builtin_amdgcn_exp2f(S[cg][rg][r] - mnew)) & keep); S[cg][rg][r] = p; ls += p; }
                    lrun[cg] = lrun[cg] * alpha + ls;
                    if (__builtin_amdgcn_ballot_w64(alpha != 1.0f) != 0ull) {
#pragma unroll
                        for (int vt = 0; vt < 8; ++vt) O[cg][vt] = O[cg][vt] * alpha; }
#pragma unroll
                    for (int k2 = 0; k2 < 2; ++k2) { const u32x4 w = {pg8::cvt_pk_bf16(S[cg][2 * k2][0], S[cg][2 * k2][1]), pg8::cvt_pk_bf16(S[cg][2 * k2][2], S[cg][2 * k2][3]), pg8::cvt_pk_bf16(S[cg][2 * k2 + 1][0], S[cg][2 * k2 + 1][1]), pg8::cvt_pk_bf16(S[cg][2 * k2 + 1][2], S[cg][2 * k2 + 1][3])};
                        pf[cg][k2] = __builtin_bit_cast(bf16x8, w); }
                }
#pragma unroll
                for (int vt = 0; vt < 8; ++vt)
#pragma unroll
                    for (int k2 = 0; k2 < 2; ++k2) { const bf16x8 vf = *(const bf16x8*)(vtl + (16 * vt + fr) * 72 + 32 * k2 + 8 * fq);
                        O[0][vt] = __builtin_amdgcn_mfma_f32_16x16x32_bf16(vf, pf[0][k2], O[0][vt], 0, 0, 0); O[1][vt] = __builtin_amdgcn_mfma_f32_16x16x32_bf16(vf, pf[1][k2], O[1][vt], 0, 0, 0); }
            }
            asm volatile("s_waitcnt vmcnt(0)" ::: "memory");
            __syncthreads();
        }
#undef ATT_DMA
        float* mb = sMrg + (size_t)g4 * 68 * 64 + lane;
        if (par == 1) {
#pragma unroll
            for (int cg = 0; cg < 2; ++cg) { mb[(cg * 2 + 0) * 64] = mrun[cg]; mb[(cg * 2 + 1) * 64] = lrun[cg];
#pragma unroll
                for (int vt = 0; vt < 8; ++vt)
#pragma unroll
                    for (int r = 0; r < 4; ++r) mb[(4 + (cg * 8 + vt) * 4 + r) * 64] = O[cg][vt][r]; } }
        __syncthreads();
        if (par == 0) {
#pragma unroll
            for (int cg = 0; cg < 2; ++cg) { const float m1 = mb[(cg * 2 + 0) * 64], l1 = mb[(cg * 2 + 1) * 64]; const float mm = fmaxf(mrun[cg], m1), a0 = __builtin_amdgcn_exp2f(mrun[cg] - mm), a1 = __builtin_amdgcn_exp2f(m1 - mm);
                float lt = lrun[cg] * a0 + l1 * a1; lt += __shfl_xor(lt, 16); lt += __shfl_xor(lt, 32); const float inv = 1.f / lt;
#pragma unroll
                for (int vt = 0; vt < 8; ++vt) { float o[4];
#pragma unroll
                    for (int r = 0; r < 4; ++r) o[r] = (O[cg][vt][r] * a0 + mb[(4 + (cg * 8 + vt) * 4 + r) * 64] * a1) * inv;
                    *(unsigned long long*)(YC + (m0 + 16 * cg + fr) * 512 + h * 128 + 16 * vt + 4 * fq) = (unsigned long long)pk2(o[0], o[1]) | ((unsigned long long)pk2(o[2], o[3]) << 32); } } }
      }
    }
}
__device__ __forceinline__ void ph_norm2(const Args& a, int l, int wv) {
    const int tid = otid(wv), lane = tid & 63, gw = blockIdx.x * NWAVE + (tid >> 6), ngw = gridDim.x * NWAVE;
    unsigned char* ws = oport(a.ws);
#pragma unroll 2
    for (int m = gw; m < M; m += ngw) rms_row_to_bf16(a.out + (size_t)m * D, a.norm2 + l * D, (bf16_t*)(ws + WS_H16) + (size_t)m * D, lane);
    { const f32x4* U = (const f32x4*)(a.peer_u + (size_t)l * NEXP * D); const f32x4* V = (const f32x4*)(a.peer_v + (size_t)l * NEXP * D); u32x4* U8 = (u32x4*)(ws + WS_U16); u32x4* V8 = (u32x4*)(ws + WS_V16);
#pragma unroll 2
      for (size_t i = (size_t)blockIdx.x * NTHR + tid; i < (size_t)NEXP * D / 16; i += (size_t)gridDim.x * NTHR) { u32x4 ou, ov; unsigned* pu = (unsigned*)&ou; unsigned* pv = (unsigned*)&ov;
#pragma unroll
          for (int q = 0; q < 4; ++q) { const f32x4 u = U[4 * i + q] * 256.f, v = V[4 * i + q] * 64.f; int wu = 0, wvv = 0;
              wu = __builtin_amdgcn_cvt_pk_fp8_f32(u.x, u.y, wu, false); wu = __builtin_amdgcn_cvt_pk_fp8_f32(u.z, u.w, wu, true); wvv = __builtin_amdgcn_cvt_pk_fp8_f32(v.x, v.y, wvv, false); wvv = __builtin_amdgcn_cvt_pk_fp8_f32(v.z, v.w, wvv, true);
              pu[q] = (unsigned)wu; pv[q] = (unsigned)wvv; }
          U8[i] = ou; V8[i] = ov; } }
}
#define CE_(a_, b_) do { const float hi_ = fmaxf(a_, b_), lo_ = fminf(a_, b_); a_ = hi_; b_ = lo_; } while (0)
#define SORT16D(x) do { CE_(x[0], x[1]); CE_(x[3], x[2]); CE_(x[4], x[5]); CE_(x[7], x[6]); CE_(x[8], x[9]); CE_(x[11], x[10]); CE_(x[12], x[13]); CE_(x[15], x[14]); CE_(x[0], x[2]); CE_(x[1], x[3]); CE_(x[6], x[4]); CE_(x[7], x[5]); CE_(x[8], x[10]); CE_(x[9], x[11]); CE_(x[14], x[12]); CE_(x[15], x[13]); CE_(x[0], x[1]); CE_(x[2], x[3]); CE_(x[5], x[4]); CE_(x[7], x[6]); CE_(x[8], x[9]); CE_(x[10], x[11]); CE_(x[13], x[12]); CE_(x[15], x[14]); CE_(x[0], x[4]); CE_(x[1], x[5]); CE_(x[2], x[6]); CE_(x[3], x[7]); CE_(x[12], x[8]); CE_(x[13], x[9]); CE_(x[14], x[10]); CE_(x[15], x[11]); CE_(x[0], x[2]); CE_(x[1], x[3]); CE_(x[4], x[6]); CE_(x[5], x[7]); CE_(x[10], x[8]); CE_(x[11], x[9]); CE_(x[14], x[12]); CE_(x[15], x[13]); CE_(x[0], x[1]); CE_(x[2], x[3]); CE_(x[4], x[5]); CE_(x[6], x[7]); CE_(x[9], x[8]); CE_(x[11], x[10]); CE_(x[13], x[12]); CE_(x[15], x[14]); CE_(x[0], x[8]); CE_(x[1], x[9]); CE_(x[2], x[10]); CE_(x[3], x[11]); CE_(x[4], x[12]); CE_(x[5], x[13]); CE_(x[6], x[14]); CE_(x[7], x[15]); CE_(x[0], x[4]); CE_(x[1], x[5]); CE_(x[2], x[6]); CE_(x[3], x[7]); CE_(x[8], x[12]); CE_(x[9], x[13]); CE_(x[10], x[14]); CE_(x[11], x[15]); CE_(x[0], x[2]); CE_(x[1], x[3]); CE_(x[4], x[6]); CE_(x[5], x[7]); CE_(x[8], x[10]); CE_(x[9], x[11]); CE_(x[12], x[14]); CE_(x[13], x[15]); CE_(x[0], x[1]); CE_(x[2], x[3]); CE_(x[4], x[5]); CE_(x[6], x[7]); CE_(x[8], x[9]); CE_(x[10], x[11]); CE_(x[12], x[13]); CE_(x[14], x[15]); } while (0)
#define MERGE16D(x) do { CE_(x[0], x[8]); CE_(x[1], x[9]); CE_(x[2], x[10]); CE_(x[3], x[11]); CE_(x[4], x[12]); CE_(x[5], x[13]); CE_(x[6], x[14]); CE_(x[7], x[15]); CE_(x[0], x[4]); CE_(x[1], x[5]); CE_(x[2], x[6]); CE_(x[3], x[7]); CE_(x[8], x[12]); CE_(x[9], x[13]); CE_(x[10], x[14]); CE_(x[11], x[15]); CE_(x[0], x[2]); CE_(x[1], x[3]); CE_(x[4], x[6]); CE_(x[5], x[7]); CE_(x[8], x[10]); CE_(x[9], x[11]); CE_(x[12], x[14]); CE_(x[13], x[15]); CE_(x[0], x[1]); CE_(x[2], x[3]); CE_(x[4], x[5]); CE_(x[6], x[7]); CE_(x[8], x[9]); CE_(x[10], x[11]); CE_(x[12], x[13]); CE_(x[14], x[15]); } while (0)
__device__ __forceinline__ float pkf(float v, unsigned tag) { return __uint_as_float((__float_as_uint(v) & 0xFFFFFF00u) | tag); }
__device__ __forceinline__ void ph_peer_select(const Args& a, int l, unsigned char* lds, int wv, int nunits, int pm0, int pn0, int pm1, int pn1) {
    unsigned char* ws = oport(a.ws); const int tid = otid(wv), lane = tid & 63, wave = __builtin_amdgcn_readfirstlane(tid >> 6), fr = lane & 15, fq = lane >> 4;
    bf16_t* sK = (bf16_t*)lds;
    int* sI = (int*)(lds + 69632 + wave * 2048);
    const bf16_t* QRY = (const bf16_t*)(ws + WS_GB); const bf16_t* SKB = (const bf16_t*)(ws + WS_SKB) + (size_t)l * 16 * 128 * 128; int* EID = (int*)(ws + WS_EID); float* EG = (float*)(ws + WS_EG);
  for (int uu = 0; uu < nunits; ++uu) { const int h = uu == 0 ? pn0 : pn1, pmu = uu == 0 ? pm0 : pm1;
    __syncthreads();
    { const u32x4* src = (const u32x4*)(SKB + (size_t)h * 2 * 128 * 128);
#pragma unroll
      for (int n = 0; n < 8; ++n) { const int idx = tid + NTHR * n, row = idx >> 4, seg = idx & 15; *(u32x4*)(sK + row * 136 + seg * 8) = src[idx]; } }
    __syncthreads();
    for (int it = wave; it < 16; it += NWAVE) { const int tg = pmu * 16 + it; const size_t m = (size_t)tg * 16 + fr;
        float va[16], vb[16];
#pragma unroll
        for (int p = 0; p < 2; ++p) {
            bf16x8 qf[4];
#pragma unroll
            for (int ks = 0; ks < 4; ++ks) qf[ks] = *(const bf16x8*)(QRY + m * 2048 + h * 256 + p * 128 + 32 * ks + 8 * fq);
            const bf16_t* kb = sK + (size_t)p * 128 * 136; float s0[16], s1[16];
#pragma unroll
            for (int nt = 0; nt < 8; ++nt) { f32x4 acc = {0.f, 0.f, 0.f, 0.f};
#pragma unroll
                for (int ks = 0; ks < 4; ++ks) { const bf16x8 x = *(const bf16x8*)(kb + (16 * nt + fr) * 136 + 32 * ks + 8 * fq); acc = __builtin_amdgcn_mfma_f32_16x16x32_bf16(x, qf[ks], acc, 0, 0, 0); }
#pragma unroll
                for (int r = 0; r < 4; ++r) { const float tv = __uint_as_float((__float_as_uint(acc[r]) & 0xFFFFFF80u) | (unsigned)(127 - (16 * nt + 4 * fq + r))); if (nt < 4) s0[nt * 4 + r] = tv; else s1[(nt - 4) * 4 + r] = tv; } }
            SORT16D(s0); SORT16D(s1);
            float t[16];
#pragma unroll
            for (int i = 0; i < 16; ++i) t[i] = fmaxf(s0[i], s1[15 - i]);
            MERGE16D(t);
#pragma unroll
            for (int off = 16; off <= 32; off <<= 1) { float o[16];
#pragma unroll
                for (int i = 0; i < 16; ++i) o[i] = __shfl_xor(t[15 - i], off);
#pragma unroll
                for (int i = 0; i < 16; ++i) t[i] = fmaxf(t[i], o[i]);
                MERGE16D(t); }
#pragma unroll
            for (int i = 0; i < 16; ++i) { if (p == 0) va[i] = t[i]; else vb[i] = t[i]; }
            __builtin_amdgcn_sched_barrier(0);
        }
        if (fq == 0) {
#pragma unroll
            for (int r = 0; r < 16; ++r) { sI[fr * 32 + r] = 127 - (int)(__float_as_uint(va[r]) & 127u); sI[fr * 32 + 16 + r] = 127 - (int)(__float_as_uint(vb[r]) & 127u); } }
#pragma unroll
        for (int r = 0; r < 16; ++r) { va[r] = __uint_as_float(__float_as_uint(va[r]) & 0xFFFFFF80u); vb[r] = __uint_as_float(__float_as_uint(vb[r]) & 0xFFFFFF80u); }
        float cs[16];
        {
            cs[0] = fq == 0 ? pkf(va[0] + vb[0], 255u) : fq == 1 ? pkf(va[0] + vb[1], 254u) : fq == 2 ? pkf(va[0] + vb[2], 253u) : pkf(va[0] + vb[3], 252u);
            cs[1] = fq == 0 ? pkf(va[0] + vb[4], 251u) : fq == 1 ? pkf(va[0] + vb[5], 250u) : fq == 2 ? pkf(va[0] + vb[6], 249u) : pkf(va[0] + vb[7], 248u);
            cs[2] = fq == 0 ? pkf(va[0] + vb[8], 247u) : fq == 1 ? pkf(va[0] + vb[9], 246u) : fq == 2 ? pkf(va[0] + vb[10], 245u) : pkf(va[0] + vb[11], 244u);
            cs[3] = fq == 0 ? pkf(va[0] + vb[12], 243u) : fq == 1 ? pkf(va[0] + vb[13], 242u) : fq == 2 ? pkf(va[0] + vb[14], 241u) : pkf(va[0] + vb[15], 240u);
            cs[4] = fq == 0 ? pkf(va[1] + vb[0], 239u) : fq == 1 ? pkf(va[1] + vb[1], 238u) : fq == 2 ? pkf(va[1] + vb[2], 237u) : pkf(va[1] + vb[3], 236u);
            cs[5] = fq == 0 ? pkf(va[1] + vb[4], 235u) : fq == 1 ? pkf(va[1] + vb[5], 234u) : fq == 2 ? pkf(va[1] + vb[6], 233u) : pkf(va[1] + vb[7], 232u);
            cs[6] = fq == 0 ? pkf(va[2] + vb[0], 223u) : fq == 1 ? pkf(va[2] + vb[1], 222u) : fq == 2 ? pkf(va[2] + vb[2], 221u) : pkf(va[2] + vb[3], 220u);
            cs[7] = fq == 0 ? pkf(va[2] + vb[4], 219u) : fq == 1 ? pkf(va[3] + vb[0], 207u) : fq == 2 ? pkf(va[3] + vb[1], 206u) : pkf(va[3] + vb[2], 205u);
            cs[8] = fq == 0 ? pkf(va[3] + vb[3], 204u) : fq == 1 ? pkf(va[4] + vb[0], 191u) : fq == 2 ? pkf(va[4] + vb[1], 190u) : pkf(va[4] + vb[2], 189u);
            cs[9] = fq == 0 ? pkf(va[5] + vb[0], 175u) : fq == 1 ? pkf(va[5] + vb[1], 174u) : fq == 2 ? pkf(va[6] + vb[0], 159u) : pkf(va[6] + vb[1], 158u);
            cs[10] = fq == 0 ? pkf(va[7] + vb[0], 143u) : fq == 1 ? pkf(va[7] + vb[1], 142u) : fq == 2 ? pkf(va[8] + vb[0], 127u) : pkf(va[9] + vb[0], 111u);
            cs[11] = fq == 0 ? pkf(va[10] + vb[0], 95u) : fq == 1 ? pkf(va[11] + vb[0], 79u) : fq == 2 ? pkf(va[12] + vb[0], 63u) : pkf(va[13] + vb[0], 47u);
            cs[12] = fq == 0 ? pkf(va[14] + vb[0], 31u) : fq == 1 ? pkf(va[15] + vb[0], 15u) : fq == 2 ? -INFINITY : -INFINITY;
            cs[13] = -INFINITY; cs[14] = -INFINITY; cs[15] = -INFINITY;
        }
        __builtin_amdgcn_sched_barrier(0);
        SORT16D(cs);
#pragma unroll
        for (int off = 16; off <= 32; off <<= 1) { float o[16];
#pragma unroll
            for (int i = 0; i < 16; ++i) o[i] = __shfl_xor(cs[15 - i], off);
#pragma unroll
            for (int i = 0; i < 16; ++i) cs[i] = fmaxf(cs[i], o[i]);
            MERGE16D(cs); }
        float bv[16];
#pragma unroll
        for (int i = 0; i < 16; ++i) bv[i] = cs[i];
        asm volatile("s_waitcnt lgkmcnt(0)" ::: "memory"); __builtin_amdgcn_sched_barrier(0);
        if (fq == 0) { int eid[16]; float ex[16]; float sm = 0.f; const float b0 = __uint_as_float(__float_as_uint(bv[0]) & 0xFFFFFF00u);
#pragma unroll
            for (int r = 0; r < 16; ++r) { const unsigned bits = __float_as_uint(bv[r]); const int f = 255 - (int)(bits & 255u); eid[r] = sI[fr * 32 + (f >> 4)] * 128 + sI[fr * 32 + 16 + (f & 15)];
                ex[r] = __expf(__uint_as_float(bits & 0xFFFFFF00u) - b0); sm += ex[r]; }
            const float inv = 1.f / sm; int* ep = EID + m * 128 + h * 16; float* gp = EG + m * 128 + h * 16;
#pragma unroll
            for (int r = 0; r < 16; r += 4) { *(int4*)(ep + r) = make_int4(eid[r], eid[r + 1], eid[r + 2], eid[r + 3]); *(f32x4*)(gp + r) = (f32x4){ex[r] * inv, ex[r + 1] * inv, ex[r + 2] * inv, ex[r + 3] * inv}; } }
        asm volatile("s_waitcnt lgkmcnt(0)" ::: "memory");
    }
  }
}
typedef float f32x2_t __attribute__((ext_vector_type(2)));
__device__ __forceinline__ void dec8(const u32x4 w, f32x2_t (&f)[8]) {
    const unsigned ww[4] = {w.x, w.y, w.z, w.w};
#pragma unroll
    for (int q = 0; q < 4; ++q) { f[2 * q] = __builtin_amdgcn_cvt_pk_f32_fp8((int)ww[q], false); f[2 * q + 1] = __builtin_amdgcn_cvt_pk_f32_fp8((int)ww[q], true); }
}
__device__ __forceinline__ void ph_peer_experts(const Args& a, int l, unsigned char* lds, int wv) {
    unsigned char* ws = oport(a.ws); const int tid = otid(wv), lane = tid & 63, wave = __builtin_amdgcn_readfirstlane(tid >> 6), gw = blockIdx.x * NWAVE + wave, ngw = gridDim.x * NWAVE;
    const bf16_t* H16 = (const bf16_t*)(ws + WS_H16); const int* EID = (const int*)(ws + WS_EID); const float* EG = (const float*)(ws + WS_EG);
    const unsigned char* U8 = (const unsigned char*)(ws + WS_U16); const unsigned char* V8 = (const unsigned char*)(ws + WS_V16);
    float* sPA = (float*)(lds + wave * 8192) + lane; float* sPB = sPA + 1024;
    int* sEA = (int*)(lds + 65536 + wave * 2048); float* sGA = (float*)(sEA + 128); int* sEB = sEA + 256; float* sGB = (float*)(sEB + 128);
    for (int it = 0, nit = ((M + ngw - 1) / ngw + 1) / 2; it < nit; ++it) { const int mA = gw + (2 * it) * ngw, mB = mA + ngw; const bool vA = mA < M, vB = mB < M;
        __syncthreads();
        if (!vA) continue;
        const int mBs = vB ? mB : mA;
        f32x2_t hpA[8], hpB[8], accA[8], accB[8];
#define LOADH(hp, m_) do { float hv_[16]; const u32x4 h0_ = *(const u32x4*)(H16 + (size_t)(m_) * D + lane * 16), h1_ = *(const u32x4*)(H16 + (size_t)(m_) * D + lane * 16 + 8); \
          hv_[0] = lo_bf(h0_.x); hv_[1] = hi_bf(h0_.x); hv_[2] = lo_bf(h0_.y); hv_[3] = hi_bf(h0_.y); hv_[4] = lo_bf(h0_.z); hv_[5] = hi_bf(h0_.z); hv_[6] = lo_bf(h0_.w); hv_[7] = hi_bf(h0_.w); \
          hv_[8] = lo_bf(h1_.x); hv_[9] = hi_bf(h1_.x); hv_[10] = lo_bf(h1_.y); hv_[11] = hi_bf(h1_.y); hv_[12] = lo_bf(h1_.z); hv_[13] = hi_bf(h1_.z); hv_[14] = lo_bf(h1_.w); hv_[15] = hi_bf(h1_.w); \
          _Pragma("unroll") for (int j_ = 0; j_ < 8; ++j_) hp[j_] = (f32x2_t){hv_[2 * j_], hv_[2 * j_ + 1]}; } while (0)
        LOADH(hpA, mA); LOADH(hpB, mBs);
#pragma unroll
        for (int j = 0; j < 8; ++j) { accA[j] = (f32x2_t){0.f, 0.f}; accB[j] = (f32x2_t){0.f, 0.f}; }
#define SORTTOK(m_, sE_, sG_) do { int key[2] = {EID[(size_t)(m_) * 128 + 2 * lane], EID[(size_t)(m_) * 128 + 2 * lane + 1]}; float pay[2] = {EG[(size_t)(m_) * 128 + 2 * lane], EG[(size_t)(m_) * 128 + 2 * lane + 1]}; \
          _Pragma("unroll") for (int k = 2; k <= 128; k <<= 1) _Pragma("unroll") for (int j = k >> 1; j >= 1; j >>= 1) { \
              if (j == 1) { const bool asc = ((2 * lane) & k) == 0; if ((key[0] > key[1]) == asc) { const int tk = key[0]; key[0] = key[1]; key[1] = tk; const float tp = pay[0]; pay[0] = pay[1]; pay[1] = tp; } } \
              else { const int lj = j >> 1; const bool keep_min = (((2 * lane) & k) == 0) == ((lane & lj) == 0); \
                  _Pragma("unroll") for (int r = 0; r < 2; ++r) { const int pk = __shfl_xor(key[r], lj); const float pp = __shfl_xor(pay[r], lj); const bool take = keep_min ? (pk < key[r]) : (pk > key[r]); if (take) { key[r] = pk; pay[r] = pp; } } } } \
          *(int2*)(sE_ + 2 * lane) = make_int2(key[0], key[1]); *(float2*)(sG_ + 2 * lane) = make_float2(pay[0], pay[1]); } while (0)
        SORTTOK(mA, sEA, sGA); SORTTOK(mBs, sEB, sGB);
        asm volatile("s_waitcnt lgkmcnt(0)" ::: "memory");
#pragma unroll 1
        for (int half = 0; half < 2; ++half) {
            const int pos = half * 64 + 4 * (lane & 15) + (((lane >> 4) == 1) ? 2 : ((lane >> 4) == 2) ? 1 : (lane >> 4));
            const int evA = sEA[pos], evB = sEB[pos]; const float gvA = sGA[pos], gvB = sGB[pos];
            u32x4 bufA[4], bufB[4];
#define ROWLD(dst, T, e_) dst = ((const u32x4*)(T + (size_t)(e_) * D))[lane]
#define KIDX(g, c) ((g) + ((c) == 1 ? 32 : (c) == 2 ? 16 : (c) == 3 ? 48 : 0))
#define LOADG(buf, T, ev_, g) do { _Pragma("unroll") for (int i_ = 0; i_ < 4; ++i_) ROWLD(buf[i_], T, __builtin_amdgcn_readlane(ev_, KIDX(g, i_))); } while (0)
#define BF2(a_, b_, o) (((lane & (o)) ? (b_) : (a_)) + __shfl_xor((lane & (o)) ? (a_) : (b_), (o)))
#define DOTG(buf, hp, sP_, g) do { float d4_[4]; _Pragma("unroll") for (int i_ = 0; i_ < 4; ++i_) { f32x2_t f_[8]; dec8(buf[i_], f_); f32x2_t d2_ = f_[0] * hp[0]; \
              _Pragma("unroll") for (int j_ = 1; j_ < 8; ++j_) d2_ = __builtin_elementwise_fma(f_[j_], hp[j_], d2_); d4_[i_] = d2_.x + d2_.y; } \
              const float q0_ = BF2(d4_[0], d4_[1], 32), q1_ = BF2(d4_[2], d4_[3], 32); sP_[(g) * 64] = BF2(q0_, q1_, 16); } while (0)
            LOADG(bufA, U8, evA, 0);
#pragma unroll 1
            for (int g = 0; g < 16; ++g) { const int gn = g < 15 ? g + 1 : 15;
                LOADG(bufB, U8, evB, g); DOTG(bufA, hpA, sPA, g);
                LOADG(bufA, U8, evA, gn); DOTG(bufB, hpB, sPB, g); }
            int svbA, svbB;
#define BFLY(o, n) do { const bool up_ = (lane & (o)) != 0; _Pragma("unroll") for (int i_ = 0; i_ < (n); ++i_) { const float a_ = p[i_], b_ = p[i_ + (n)]; const float sd_ = up_ ? a_ : b_, kp_ = up_ ? b_ : a_; p[i_] = kp_ + __shfl_xor(sd_, (o)); } } while (0)
#define FINISH(sP_, gv_, svb_) do { float p[16]; _Pragma("unroll") for (int i_ = 0; i_ < 16; ++i_) p[i_] = sP_[i_ * 64]; BFLY(8, 8); BFLY(4, 4); BFLY(2, 2); BFLY(1, 1); \
              svb_ = __builtin_bit_cast(int, gv_ * gelu_t(p[0] * (1.f / 256.f)) * (1.f / 64.f)); } while (0)
            FINISH(sPA, gvA, svbA); FINISH(sPB, gvB, svbB);
#define ACCG(buf, acc, svb_, g) do { _Pragma("unroll") for (int i_ = 0; i_ < 4; ++i_) { const float sk_ = __builtin_bit_cast(float, __builtin_amdgcn_readlane(svb_, KIDX(g, i_))); const f32x2_t s2_ = {sk_, sk_}; f32x2_t f_[8]; dec8(buf[i_], f_); \
              _Pragma("unroll") for (int j_ = 0; j_ < 8; ++j_) acc[j_] = __builtin_elementwise_fma(f_[j_], s2_, acc[j_]); } } while (0)
            LOADG(bufA, V8, evA, 0);
#pragma unroll 1
            for (int g = 0; g < 16; ++g) { const int gn = g < 15 ? g + 1 : 15;
                LOADG(bufB, V8, evB, g); ACCG(bufA, accA, svbA, g);
                LOADG(bufA, V8, evA, gn); ACCG(bufB, accB, svbB, g); }
#undef ROWLD
#undef KIDX
#undef LOADG
#undef BF2
#undef DOTG
#undef BFLY
#undef FINISH
#undef ACCG
        }
#define EPILOG(m_, acc2) do { float acc[16]; _Pragma("unroll") for (int j = 0; j < 8; ++j) { acc[2 * j] = acc2[j].x; acc[2 * j + 1] = acc2[j].y; } \
        float* xr = a.out + (size_t)(m_) * D + lane * 16; float xn[16]; float ss = 0.f; \
        _Pragma("unroll") for (int j = 0; j < 4; ++j) { const f32x4 xv = *(const f32x4*)(xr + 4 * j); xn[4 * j] = xv.x + acc[4 * j]; xn[4 * j + 1] = xv.y + acc[4 * j + 1]; xn[4 * j + 2] = xv.z + acc[4 * j + 2]; xn[4 * j + 3] = xv.w + acc[4 * j + 3]; } \
        _Pragma("unroll") for (int j = 0; j < 16; ++j) ss += xn[j] * xn[j]; \
        const float r = rsqrtf(wave_sum(ss) * (1.f / D) + EPS); \
        if (l + 1 < DEPTH) { const float* gn = a.norm1 + (size_t)(l + 1) * D + lane * 16; \
            _Pragma("unroll") for (int j = 0; j < 4; ++j) *(f32x4*)(xr + 4 * j) = (f32x4){xn[4 * j], xn[4 * j + 1], xn[4 * j + 2], xn[4 * j + 3]}; \
            u32x4 w0, w1; \
            w0.x = pk2(xn[0] * r * gn[0], xn[1] * r * gn[1]); w0.y = pk2(xn[2] * r * gn[2], xn[3] * r * gn[3]); w0.z = pk2(xn[4] * r * gn[4], xn[5] * r * gn[5]); w0.w = pk2(xn[6] * r * gn[6], xn[7] * r * gn[7]); \
            w1.x = pk2(xn[8] * r * gn[8], xn[9] * r * gn[9]); w1.y = pk2(xn[10] * r * gn[10], xn[11] * r * gn[11]); w1.z = pk2(xn[12] * r * gn[12], xn[13] * r * gn[13]); w1.w = pk2(xn[14] * r * gn[14], xn[15] * r * gn[15]); \
            *(u32x4*)((bf16_t*)(ws + WS_H16) + (size_t)(m_) * D + lane * 16) = w0; *(u32x4*)((bf16_t*)(ws + WS_H16) + (size_t)(m_) * D + lane * 16 + 8) = w1; \
        } else { const float* gn = a.final_gain + lane * 16; \
            _Pragma("unroll") for (int j = 0; j < 4; ++j) *(f32x4*)(xr + 4 * j) = (f32x4){xn[4 * j] * r * gn[4 * j], xn[4 * j + 1] * r * gn[4 * j + 1], xn[4 * j + 2] * r * gn[4 * j + 2], xn[4 * j + 3] * r * gn[4 * j + 3]}; } } while (0)
        EPILOG(mA, accA);
        if (vB) EPILOG(mB, accB);
#undef EPILOG
#undef LOADH
#undef SORTTOK
    }
}

constexpr int PH_PER_LAYER = 9, N_PHASES = 1 + DEPTH * PH_PER_LAYER;
__global__ void __launch_bounds__(NTHR, 2) fwd_kernel(Args a) {
    extern __shared__ __attribute__((aligned(16))) unsigned char lds[];
    const int wv = __builtin_amdgcn_readfirstlane((int)threadIdx.x >> 6);
    const int tid = threadIdx.x;
    for (int u = tid; u < (LDS_BYTES - LDS_CTL_OFF) / 4; u += NTHR) ((unsigned*)(lds + LDS_CTL_OFF))[u] = 0u;
    __syncthreads();
    unsigned* ctl = (unsigned*)(a.ws + WS_CTL);
    XcdBarrier bar = xcd_barrier_post(ctl + 4096, (volatile LAS unsigned*)(LAS unsigned char*)(lds + LDS_CTL_OFF), wv);
    const int lo = a.ph_lo, hi = a.ph_hi;
#define IN(k) (lo <= (k) && (k) < hi)
#define SEAM(k) do { if (IN(k) && IN((k) + 1)) xcd_barrier(bar, wv); } while (0)
    unsigned char* ws = oport(a.ws);
    if (IN(0)) { ph_prologue(a, lds, wv); } SEAM(0);
    for (int l = 0; l < DEPTH; ++l) {
        const int pb = 1 + l * PH_PER_LAYER;
        unsigned char* ws = oport(a.ws);
        if (IN(pb + 0)) {
            ph_kiwi(a, l, lds, wv);
            pg8::Gemm g{(const bf16_t*)(ws + WS_H16), (const bf16_t*)(ws + WS_WIN + (size_t)l * WIN_L), M, NMAIN, D, 0, 0};
            pg8::StaticOrder S; S.init(M, NMAIN, gridDim.x, blockIdx.x, 0);
            pg8::EpiIn E{(bf16_t*)(ws + WS_P16), (float*)(ws + WS_PF)};
            pg8::gemm_phase(((LAS unsigned char*)lds), g, S, E, wv);
        } SEAM(pb + 0);
        if (IN(pb + 1)) { ph_post(a, l, lds, wv); ph_h1(a, l, lds, wv); } SEAM(pb + 1);
        if (IN(pb + 2)) { ph_h2(a, wv); ph_gmlp(a, l, lds, wv); ph_sel(a, lds, wv); } SEAM(pb + 2);
        if (IN(pb + 3)) { ph_attn(a, lds, wv); ph_h3(a, l, lds, wv); } SEAM(pb + 3);
        if (IN(pb + 4)) {
            pg8::Gemm g{(const bf16_t*)(ws + WS_YALL), (const bf16_t*)(ws + WS_WBR + (size_t)l * WBR_L), M, 3072, 512, (size_t)M * 512 * 2, 4};
            pg8::BranchOrder S; S.init(gridDim.x, blockIdx.x);
            pg8::EpiGate E{(bf16_t*)(ws + WS_GB), (const bf16_t*)(ws + WS_P16)};
            pg8::gemm_phase(((LAS unsigned char*)lds), g, S, E, wv);
        } SEAM(pb + 4);
        if (IN(pb + 5)) {
            pg8::Gemm g{(const bf16_t*)(ws + WS_GB), (const bf16_t*)(ws + WS_WOUT + (size_t)l * WOUT_L), M, D, D, 0, 0};
            pg8::StaticOrder S; S.init(M, D, gridDim.x, blockIdx.x, 0);
            pg8::EpiRes E{a.out};
            pg8::gemm_phase(((LAS unsigned char*)lds), g, S, E, wv);
        } SEAM(pb + 5);
        if (IN(pb + 6)) { ph_norm2(a, l, wv); } SEAM(pb + 6);
        if (IN(pb + 7)) {
            pg8::Gemm g{(const bf16_t*)(ws + WS_H16), (const bf16_t*)(ws + WS_WPQ + (size_t)l * WPQ_L), M, 2048, D, 0, 0};
            pg8::StaticOrder S; S.init(M, 2048, gridDim.x, blockIdx.x, 0);
            pg8::EpiB16 E{(bf16_t*)(ws + WS_GB), 2048};
            pg8::gemm_phase(((LAS unsigned char*)lds), g, S, E, wv);
            asm volatile("s_waitcnt vmcnt(0)" ::: "memory"); __syncthreads();
            for (int i0_ = 0;; i0_ += 2) { pg8::Unit u0, u1; if (!S.next(i0_, u0)) break; const bool two = S.next(i0_ + 1, u1);
                ph_peer_select(a, l, lds, wv, two ? 2 : 1, u0.pm, u0.pn, two ? u1.pm : 0, two ? u1.pn : 0); }
        } SEAM(pb + 7);
        if (IN(pb + 8)) { ph_peer_experts(a, l, lds, wv); } SEAM(pb + 8);
    }
#undef IN
#undef SEAM
}

#ifndef MK_N_LAUNCHES
#define MK_N_LAUNCHES 1
#endif
extern "C" void kernel_launch(void* const* d_in, const int* in_sizes, int n_in, void* d_out, int out_size, void* d_ws, size_t ws_size, hipStream_t stream) {
    static int grid = 0;
    if (grid == 0) {
        if (n_in != 17 || out_size != M * D || ws_size < WS_END) { fprintf(stderr, "kernel_launch: unexpected shapes (n_in %d, out %d, ws %zu)\n", n_in, out_size, ws_size); grid = -1; return; }
        int dev = 0, cus = 0, per_cu = 0;
        if (hipGetDevice(&dev) != hipSuccess || hipDeviceGetAttribute(&cus, hipDeviceAttributeMultiprocessorCount, dev) != hipSuccess) { grid = -1; return; }
        if (hipFuncSetAttribute((const void*)fwd_kernel, hipFuncAttributeMaxDynamicSharedMemorySize, LDS_BYTES) != hipSuccess) { fprintf(stderr, "kernel_launch: hipFuncSetAttribute failed\n"); grid = -1; return; }
        if (hipOccupancyMaxActiveBlocksPerMultiprocessor(&per_cu, (const void*)fwd_kernel, NTHR, LDS_BYTES) != hipSuccess || per_cu < 1) { fprintf(stderr, "kernel_launch: occupancy query says %d\n", per_cu); (void)hipGetLastError(); grid = -1; return; }
        grid = cus;
    }
    if (grid < 0) return;
    (void)hipMemsetAsync((char*)d_ws + WS_CTL, 0, CTL_BYTES, stream);
    Args a{};
    a.x = (const float*)d_in[0]; a.pos = (const int*)d_in[1]; a.norm1 = (const float*)d_in[2]; a.w_in = (const float*)d_in[3]; a.lb_logits = (const float*)d_in[4]; a.hgrn_gain = (const float*)d_in[5];
    a.gmlp_gain = (const float*)d_in[6]; a.gmlp_ws = (const float*)d_in[7]; a.gmlp_bs = (const float*)d_in[8]; a.w_branch = (const float*)d_in[9]; a.w_out = (const float*)d_in[10]; a.norm2 = (const float*)d_in[11];
    a.peer_wq = (const float*)d_in[12]; a.peer_keys = (const float*)d_in[13]; a.peer_u = (const float*)d_in[14]; a.peer_v = (const float*)d_in[15]; a.final_gain = (const float*)d_in[16];
    a.out = (float*)d_out; a.ws = (unsigned char*)d_ws;
    if (MK_N_LAUNCHES == 1) { a.ph_lo = 0; a.ph_hi = N_PHASES; hipLaunchKernelGGL(fwd_kernel, dim3(grid), dim3(NTHR), LDS_BYTES, stream, a); }
    else for (int p = 0; p < N_PHASES; ++p) { a.ph_lo = p; a.ph_hi = p + 1; hipLaunchKernelGGL(fwd_kernel, dim3(grid), dim3(NTHR), LDS_BYTES, stream, a); }
}
```

```cpp
#include <hip/hip_runtime.h>
#include <cstdio>
#include <cstdint>

#define LAS __attribute__((address_space(3)))
typedef unsigned short bf16_t;
typedef short bf16x8 __attribute__((ext_vector_type(8)));
typedef float f32x4 __attribute__((ext_vector_type(4)));
typedef unsigned u32x4 __attribute__((ext_vector_type(4)));

constexpr int D = 1024, BATCH = 2, SEQ = 8192, DEPTH = 4, M = BATCH * SEQ;
constexpr int NIN = 8264;
constexpr int NPAD = 8448;
constexpr int C_AQ = 0, C_AF = 512, C_AI = 1024, C_AG = 1536, C_BU = 2048, C_BV = 2560, C_CQ = 3072, C_CK = 3584, C_CV = 4096, C_QI = 4608, C_GL = 5120, C_KI = 8192, C_WI = 8256;
constexpr int NMAIN = 8192;
constexpr int S_GL = 5192;
constexpr int PFW = 768;
constexpr float EPS = 1e-6f;
constexpr int NEXP = 16384;

constexpr size_t MiB = 1u << 20;
constexpr size_t WS_CTL = 0, CTL_BYTES = 1 * MiB;
constexpr size_t WS_WIN = 2 * MiB;
constexpr size_t WIN_L = (size_t)NPAD * D * 2;
constexpr size_t WS_WBR = 68 * MiB;
constexpr size_t WBR_L = (size_t)3072 * 512 * 2;
constexpr size_t WS_WOUT = 80 * MiB;
constexpr size_t WOUT_L = (size_t)1024 * 3072 * 2;
constexpr size_t WS_WPQ = 104 * MiB;
constexpr size_t WPQ_L = (size_t)2048 * 1024 * 2;
constexpr size_t WS_LB = 120 * MiB;
constexpr size_t WS_CS = 121 * MiB;
constexpr size_t WS_H16 = 134 * MiB;
constexpr size_t WS_P16 = 166 * MiB;
constexpr size_t WS_PF = 430 * MiB;
constexpr size_t WS_QR = 478 * MiB, WS_KR = 494 * MiB;
constexpr size_t WS_QI = 510 * MiB;
constexpr size_t WS_KI = 542 * MiB;
constexpr size_t WS_WI = 546 * MiB;
constexpr size_t WS_FF = 548 * MiB, WS_KK = 580 * MiB, WS_QF = 612 * MiB;
constexpr size_t WS_OA = 644 * MiB;
constexpr size_t WS_VN = 676 * MiB;
constexpr size_t WS_YALL = 708 * MiB;
constexpr size_t WS_GB = 756 * MiB;
constexpr size_t WS_EID = 852 * MiB, WS_EG = 860 * MiB;
constexpr size_t WS_DD = 120 * MiB + 256 * 1024;
constexpr size_t WS_WSB = 544 * MiB;
constexpr size_t WS_VT = 644 * MiB;
constexpr size_t WS_MASK = 660 * MiB;
constexpr size_t WS_U16 = 868 * MiB, WS_V16 = 900 * MiB;
constexpr size_t WS_SKB = 932 * MiB;
constexpr size_t WS_END = 934 * MiB;

__device__ const float ROPE_INV64[64] = {
1.000000000e+00f, 8.659643531e-01f, 7.498942614e-01f, 6.493816376e-01f, 5.623413324e-01f, 4.869675338e-01f, 4.216965139e-01f, 3.651741147e-01f, 3.162277639e-01f, 2.738419771e-01f, 2.371373773e-01f, 2.053525001e-01f, 1.778279394e-01f, 1.539926529e-01f, 1.333521307e-01f, 1.154782027e-01f, 1.000000015e-01f, 8.659642935e-02f, 7.498941571e-02f, 6.493816525e-02f, 5.623413250e-02f, 4.869675264e-02f, 4.216965288e-02f, 3.651741147e-02f, 3.162277490e-02f, 2.738419734e-02f, 2.371373773e-02f, 2.053525113e-02f, 1.778279431e-02f, 1.539926510e-02f, 1.333521493e-02f, 1.154782064e-02f, 9.999999776e-03f, 8.659643121e-03f, 7.498941850e-03f, 6.493816152e-03f, 5.623413250e-03f, 4.869675264e-03f, 4.216964822e-03f, 3.651741194e-03f, 3.162277630e-03f, 2.738419687e-03f, 2.371373586e-03f, 2.053524833e-03f, 1.778279431e-03f, 1.539926510e-03f, 1.333521446e-03f, 1.154781901e-03f, 1.000000047e-03f, 8.659643354e-04f, 7.498942432e-04f, 6.493816618e-04f, 5.623413017e-04f, 4.869675322e-04f, 4.216965172e-04f, 3.651741426e-04f, 3.162277571e-04f, 2.738419571e-04f, 2.371373703e-04f, 2.053525095e-04f, 1.778279402e-04f, 1.539926452e-04f, 1.333521504e-04f, 1.154782003e-04f};
__device__ const float ROPE_INV32[32] = {
1.000000000e+00f, 7.498942614e-01f, 5.623413324e-01f, 4.216965139e-01f, 3.162277639e-01f, 2.371373773e-01f, 1.778279394e-01f, 1.333521307e-01f, 1.000000015e-01f, 7.498941571e-02f, 5.623413250e-02f, 4.216965288e-02f, 3.162277490e-02f, 2.371373773e-02f, 1.778279431e-02f, 1.333521493e-02f, 9.999999776e-03f, 7.498941850e-03f, 5.623413250e-03f, 4.216964822e-03f, 3.162277630e-03f, 2.371373586e-03f, 1.778279431e-03f, 1.333521446e-03f, 1.000000047e-03f, 7.498942432e-04f, 5.623413017e-04f, 4.216965172e-04f, 3.162277571e-04f, 2.371373703e-04f, 1.778279402e-04f, 1.333521504e-04f};

__device__ __forceinline__ float bf2f(bf16_t b) { return __uint_as_float(((unsigned)b) << 16); }
__device__ __forceinline__ unsigned f2bf(float f) { unsigned u = __float_as_uint(f); return (u + 0x7fffu + ((u >> 16) & 1u)) >> 16; }
__device__ __forceinline__ unsigned pk2(float lo, float hi) { return f2bf(lo) | (f2bf(hi) << 16); }
__device__ __forceinline__ float lo_bf(unsigned w) { return __uint_as_float(w << 16); }
__device__ __forceinline__ float hi_bf(unsigned w) { return __uint_as_float(w & 0xffff0000u); }
__device__ __forceinline__ float sigm(float x) { return 1.f / (1.f + __expf(-x)); }
__device__ __forceinline__ float silu(float x) { return x * sigm(x); }
__device__ __forceinline__ float gelu_t(float x) { const float u = 0.7978845608028654f * (x + 0.044715f * x * x * x); const float th = 1.f - 2.f / (1.f + __expf(2.f * u)); return 0.5f * x * (1.f + th); }
__device__ __forceinline__ float wave_sum(float v) {
#pragma unroll
    for (int o = 1; o < 64; o <<= 1) v += __shfl_xor(v, o);
    return v;
}
__device__ __forceinline__ float wave_max(float v) {
#pragma unroll
    for (int o = 1; o < 64; o <<= 1) v = fmaxf(v, __shfl_xor(v, o));
    return v;
}
typedef __bf16 bf2_t __attribute__((ext_vector_type(2)));
__device__ __forceinline__ float dot2(unsigned a, unsigned b, float c) { return __builtin_amdgcn_fdot2_f32_bf16(__builtin_bit_cast(bf2_t, a), __builtin_bit_cast(bf2_t, b), c, false); }
__device__ __forceinline__ int otid(int wv) { int t; asm volatile("v_mbcnt_lo_u32_b32 %0, -1, 0\n\tv_mbcnt_hi_u32_b32 %0, -1, %0" : "=v"(t)); return wv * 64 + t; }
__device__ __forceinline__ unsigned char* oport(unsigned char* p) { unsigned long long z; asm volatile("s_mov_b64 %0, 0" : "=s"(z)); return p + z; }
__device__ __forceinline__ unsigned fkey(float f) { const unsigned u = __float_as_uint(f); return u ^ ((u >> 31) ? 0xFFFFFFFFu : 0x80000000u); }

#define XB_TMO      128
#define XB_XCNT(j)  (256  + 64 * (j))
#define XB_XSUB(j)  (1280 + 64 * (j))
#define XB_XGEN(j)  (2304 + 64 * (j))
#define XB_TOP      3328
#define XB_TOPGEN   3392
#define XCD_BAR_WORDS 3456
#define XB_SPIN_CAP (1u << 23)
__device__ __forceinline__ unsigned xb_ld(unsigned* p)              { return __hip_atomic_load(p, __ATOMIC_RELAXED, __HIP_MEMORY_SCOPE_AGENT); }
__device__ __forceinline__ unsigned xb_add(unsigned* p, unsigned v) { return __hip_atomic_fetch_add(p, v, __ATOMIC_RELAXED, __HIP_MEMORY_SCOPE_AGENT); }
__device__ __forceinline__ unsigned xb_xcc_id() { return (unsigned)__builtin_amdgcn_s_getreg((3 << 11) | 20) & 0xFu; }
#define XB_SPIN(cond, bar) do { unsigned _sp = 0; while (cond) { __builtin_amdgcn_s_sleep(1); \
    if ((++_sp & 255u) == 0u) { if (xb_ld(&(bar)[XB_TMO])) break; if (_sp > XB_SPIN_CAP) { atomicAdd(&(bar)[XB_TMO], 1u); break; } } } } while (0)
struct XcdBarrier { unsigned* bar; unsigned x; volatile LAS unsigned* st; };
__device__ __forceinline__ XcdBarrier xcd_barrier_post(unsigned* bar, volatile LAS unsigned* st, int wv) {
    XcdBarrier b; b.bar = bar; b.x = xb_xcc_id(); b.st = st;
    if (wv == 0) if ((otid(0) & 63) == 0) (void)xb_add(&bar[XB_XCNT(b.x)], 1u);
    return b;
}
__device__ __forceinline__ void xcd_barrier_complete(unsigned* bar, unsigned x, unsigned& nloc, unsigned& nx) {
    const unsigned G = gridDim.x * gridDim.y * gridDim.z;
    unsigned sum, cnt, mine, sp = 0u;
    for (;;) {
        sum = 0u; cnt = 0u; mine = 0u;
#pragma unroll
        for (unsigned j = 0; j < 16; ++j) { const unsigned c = xb_ld(&bar[XB_XCNT(j)]); sum += c; cnt += (c > 0u) ? 1u : 0u; mine = (j == x) ? c : mine; }
        if (sum == G) break;
        __builtin_amdgcn_s_sleep(1);
        if ((++sp & 255u) == 0u) { if (xb_ld(&bar[XB_TMO])) break; if (sp > XB_SPIN_CAP) { atomicAdd(&bar[XB_TMO], 1u); break; } }
    }
    nloc = mine > 0u ? mine : 1u; nx = cnt > 0u ? cnt : 1u;
}
__device__ __forceinline__ void xcd_barrier(const XcdBarrier& b, int wv) {
    asm volatile("s_waitcnt vmcnt(0)" ::: "memory");
    __syncthreads();
    if (wv == 0) if ((otid(0) & 63) == 0) {
        unsigned* bar = b.bar;
        __builtin_amdgcn_s_waitcnt(0);
        unsigned nloc = b.st[0], nx = b.st[1];
        if (nloc == 0u) { xcd_barrier_complete(bar, b.x, nloc, nx); b.st[0] = nloc; b.st[1] = nx; }
        const unsigned old = xb_add(&bar[XB_XSUB(b.x)], 1u);
        const unsigned gen = old / nloc;
        if (old + 1u == (gen + 1u) * nloc) {
            __builtin_amdgcn_fence(__ATOMIC_RELEASE, "agent");
            asm volatile("s_waitcnt vmcnt(0)" ::: "memory");
            const unsigned og = xb_add(&bar[XB_TOP], 1u);
            const unsigned tg = og / nx;
            if (og + 1u == (tg + 1u) * nx) xb_add(&bar[XB_TOPGEN], 1u);
            else XB_SPIN(xb_ld(&bar[XB_TOPGEN]) == tg, bar);
            __builtin_amdgcn_fence(__ATOMIC_ACQUIRE, "agent");
            xb_add(&bar[XB_XGEN(b.x)], 1u);
            asm volatile("s_waitcnt vmcnt(0)" ::: "memory");
        } else {
            XB_SPIN(xb_ld(&bar[XB_XGEN(b.x)]) == gen, bar);
            __builtin_amdgcn_fence(__ATOMIC_ACQUIRE, "agent");
            asm volatile("s_waitcnt vmcnt(0)" ::: "memory");
        }
    }
    __syncthreads();
}

namespace pg8 {
constexpr int BM = 256, BK = 64, HALF = 128, HTB = HALF * BK * 2, STAGE_BYTES = 8 * HTB, NXCD = 8, WGM = 8;
__host__ __device__ __forceinline__ int lds_byte(int r, int c) { const int st = (r >> 4) * 2 + (c >> 5), rr = r & 15, cc = c & 31, ob = rr * 64 + cc * 2; return st * 1024 + (ob ^ (((ob >> 9) & 1) << 5)); }
__host__ __device__ __forceinline__ void stage_rc(int b, int& R, int& C) { const int st = b / 1024, sb = b % 1024, swz = sb ^ (((sb >> 9) & 1) << 5); R = (st >> 1) * 16 + swz / 64; C = (st & 1) * 32 + (swz % 64) / 2; }
__host__ __device__ __forceinline__ int perm32(int rho) { const int n = rho >> 4, i = rho & 15; return 8 * (i >> 2) + 4 * n + (i & 3); }
struct Unit { int pm, pn, ka; };
struct Gemm { const bf16_t* A; const bf16_t* Bt; int M, N, K; size_t strideA; int nsplit; };
struct StaticOrder {
    int nM, nN, nwg, G, c, nsplit;
    __device__ __forceinline__ void init(int M_, int N_, int G_, int c_, int nsplit_) { nM = M_ / BM; nN = N_ / BM; nwg = nM * nN; G = G_; c = c_; nsplit = nsplit_; }
    __device__ __forceinline__ bool next(int i, Unit& u) const {
        const long L = (long)i * G + c; if (L >= nwg) return false;
        int wgid = (int)L; { const int q = nwg / NXCD, r = nwg % NXCD, xcd = wgid % NXCD, off = wgid / NXCD; wgid = (xcd < r ? xcd * (q + 1) : r * (q + 1) + (xcd - r) * q) + off; }
        const int nig = WGM * nN, gid = wgid / nig, fm = gid * WGM, gsz = (nM - fm) < WGM ? (nM - fm) : WGM;
        u.pm = fm + ((wgid % nig) % gsz); u.pn = (wgid % nig) / gsz; u.ka = nsplit ? u.pn / nsplit : 0; return true;
    }
};
__device__ __forceinline__ unsigned cvt_pk_bf16(float lo, float hi) { unsigned r; asm volatile("v_cvt_pk_bf16_f32 %0, %1, %2" : "=v"(r) : "v"(lo), "v"(hi)); return r; }

template <class Epi, class Sched>
__device__ __forceinline__ void gemm_phase(LAS unsigned char* lds, const Gemm g, const Sched& S, const Epi& E, int wv) {
    const int tid = otid(wv), wid = __builtin_amdgcn_readfirstlane(tid >> 6), lane = tid & 63, wr = wid >> 2, wc = wid & 3, fr = lane & 15, fq = lane >> 4;
    const int K = g.K, nt = K / BK;
    unsigned voffA[2], voffB[2];
#pragma unroll
    for (int i = 0; i < 2; ++i) { int R, C; stage_rc(tid * 16 + i * 8192, R, C); const int Rb = Epi::PERM ? ((R & ~31) + perm32(R & 31)) : R;
        voffA[i] = (unsigned)(R * K + C) * 2u; voffB[i] = (unsigned)(Rb * K + C) * 2u; }
    const size_t kstep = (size_t)(BK * 2);
    const size_t hstep = (size_t)HALF * K * 2;
    const size_t tstep = 2 * hstep;
    const unsigned ldsw = (unsigned)wid * 1024u;
    const int aoff = lds_byte(wr * 64 + fr, fq * 8), boff = lds_byte(wc * 32 + fr, fq * 8);
#define PG8_SA(b, h) (((b) * 2 + (h)) * HTB)
#define PG8_SB(b, h) ((4 + (b) * 2 + (h)) * HTB)
#define PG8_STAGE(bufoff, gbase, voff) do { _Pragma("unroll") for (int _i = 0; _i < 2; ++_i) \
        __builtin_amdgcn_global_load_lds((const unsigned*)((const char*)(gbase) + (voff)[_i]), (LAS unsigned*)(lds + (bufoff) + ldsw + _i * 8192), 16, 0, 0); } while (0)
#define PG8_LDA(dst, b, h) do { _Pragma("unroll") for (int m = 0; m < 4; ++m) _Pragma("unroll") for (int k = 0; k < 2; ++k) dst[m][k] = *(const LAS bf16x8*)(lds + PG8_SA(b, h) + aoff + m * 2048 + k * 1024); } while (0)
#define PG8_LDB(dst, b, h) do { _Pragma("unroll") for (int n = 0; n < 2; ++n) _Pragma("unroll") for (int k = 0; k < 2; ++k) dst[n][k] = *(const LAS bf16x8*)(lds + PG8_SB(b, h) + boff + n * 2048 + k * 1024); } while (0)
#define PG8_MMA(ai, bj, At, Bt) do { __builtin_amdgcn_s_setprio(1); _Pragma("unroll") for (int m = 0; m < 4; ++m) _Pragma("unroll") for (int n = 0; n < 2; ++n) _Pragma("unroll") for (int k = 0; k < 2; ++k) \
        acc[ai][bj][m][n] = __builtin_amdgcn_mfma_f32_16x16x32_bf16(Bt[n][k], At[m][k], acc[ai][bj][m][n], 0, 0, 0); __builtin_amdgcn_s_setprio(0); } while (0)
#define PG8_WAIT_V(n) asm volatile("s_waitcnt vmcnt(" #n ")" ::: "memory")
#define PG8_WAIT_L(n) asm volatile("s_waitcnt lgkmcnt(" #n ")" ::: "memory")
#define PG8_BAR __builtin_amdgcn_s_barrier()
#define PG8_SCHED __builtin_amdgcn_sched_barrier(0)
    Unit cur, nxt; int ui = 0;
    if (!S.next(0, cur)) return;
    f32x4 acc[2][2][4][2];
#pragma unroll
    for (int a = 0; a < 2; ++a)
#pragma unroll
        for (int b = 0; b < 2; ++b)
#pragma unroll
            for (int m = 0; m < 4; ++m)
#pragma unroll
                for (int n = 0; n < 2; ++n) acc[a][b][m][n] = (f32x4){0.f, 0.f, 0.f, 0.f};
    bf16x8 At[4][2], B0[2][2], B1[2][2];
    const char* cA = (const char*)g.A + (size_t)cur.ka * g.strideA + (size_t)cur.pm * tstep; const char* cB = (const char*)g.Bt + (size_t)cur.pn * tstep;
    PG8_STAGE(PG8_SB(0, 0), cB, voffB); PG8_STAGE(PG8_SA(0, 0), cA, voffA); PG8_STAGE(PG8_SB(0, 1), cB + hstep, voffB); PG8_STAGE(PG8_SA(0, 1), cA + hstep, voffA);
    if (wr == 1) PG8_BAR;
    PG8_WAIT_V(4); PG8_BAR;
    PG8_STAGE(PG8_SB(1, 0), cB + kstep, voffB); PG8_STAGE(PG8_SA(1, 0), cA + kstep, voffA); PG8_STAGE(PG8_SB(1, 1), cB + hstep + kstep, voffB);
    PG8_WAIT_V(6); PG8_BAR;
    for (;;) {
        const bool has_next = S.next(ui + 1, nxt);
        const char* nA = has_next ? (const char*)g.A + (size_t)nxt.ka * g.strideA + (size_t)nxt.pm * tstep : cA; const char* nB = has_next ? (const char*)g.Bt + (size_t)nxt.pn * tstep : cB;
        for (int t = 0; t < nt; t += 2) {
            const bool last = (t == nt - 2);
            const char* a1 = cA + (size_t)(t + 1) * kstep;
            const char* a2 = last ? nA : cA + (size_t)(t + 2) * kstep; const char* b2 = last ? nB : cB + (size_t)(t + 2) * kstep;
            const char* a3 = a2 + kstep; const char* b3 = b2 + kstep;
            PG8_LDB(B0, 0, 0); PG8_SCHED; PG8_LDA(At, 0, 0); PG8_STAGE(PG8_SA(1, 1), a1 + hstep, voffA);
            PG8_WAIT_L(8); PG8_BAR; PG8_WAIT_L(0); PG8_MMA(0, 0, At, B0); PG8_BAR; PG8_SCHED;
            PG8_LDB(B1, 0, 1); PG8_STAGE(PG8_SB(0, 0), b2, voffB);
            PG8_BAR; PG8_WAIT_L(0); PG8_MMA(0, 1, At, B1); PG8_BAR;
            PG8_LDA(At, 0, 1); PG8_STAGE(PG8_SA(0, 0), a2, voffA);
            PG8_BAR; PG8_WAIT_L(0); PG8_MMA(1, 0, At, B0); PG8_BAR; PG8_SCHED;
            PG8_STAGE(PG8_SB(0, 1), b2 + hstep, voffB);
            PG8_WAIT_V(6); PG8_BAR; PG8_MMA(1, 1, At, B1); PG8_BAR;
            PG8_LDB(B0, 1, 0); PG8_SCHED; PG8_LDA(At, 1, 0); PG8_STAGE(PG8_SA(0, 1), a2 + hstep, voffA);
            PG8_WAIT_L(8); PG8_BAR; PG8_WAIT_L(0); PG8_MMA(0, 0, At, B0); PG8_BAR; PG8_SCHED;
            PG8_LDB(B1, 1, 1); PG8_STAGE(PG8_SB(1, 0), b3, voffB);
            PG8_BAR; PG8_WAIT_L(0); PG8_MMA(0, 1, At, B1); PG8_BAR;
            PG8_LDA(At, 1, 1); PG8_STAGE(PG8_SA(1, 0), a3, voffA);
            PG8_BAR; PG8_WAIT_L(0); PG8_MMA(1, 0, At, B0); PG8_BAR; PG8_SCHED;
            PG8_STAGE(PG8_SB(1, 1), b3 + hstep, voffB);
            PG8_WAIT_V(6); PG8_BAR; PG8_MMA(1, 1, At, B1); PG8_BAR;
        }
        E(acc, cur, wr, wc, fr, fq);
        if (!has_next) break;
        if (!E.keep(cur))
#pragma unroll
        for (int a = 0; a < 2; ++a)
#pragma unroll
            for (int b = 0; b < 2; ++b)
#pragma unroll
                for (int m = 0; m < 4; ++m)
#pragma unroll
                    for (int n = 0; n < 2; ++n) acc[a][b][m][n] = (f32x4){0.f, 0.f, 0.f, 0.f};
        cur = nxt; cA = nA; cB = nB; ++ui;
    }
    PG8_WAIT_V(0);
    if (wr == 0) PG8_BAR;
    PG8_BAR;
#undef PG8_SA
#undef PG8_SB
#undef PG8_STAGE
#undef PG8_LDA
#undef PG8_LDB
#undef PG8_MMA
#undef PG8_WAIT_V
#undef PG8_WAIT_L
#undef PG8_BAR
#undef PG8_SCHED
}

struct EpiIn {
    __device__ __forceinline__ bool keep(const Unit&) const { return false; }
    static constexpr bool PERM = true;
    bf16_t* P16; float* PF;
    __device__ __forceinline__ void operator()(f32x4 (&acc)[2][2][4][2], const Unit& u, int wr, int wc, int fr, int fq) const {
        const int row0 = u.pm * BM + wr * 64 + fr, col0 = u.pn * BM + wc * 32 + 8 * fq;
        const bool f32t = (u.pn == 2) || (u.pn == 3), gate = u.pn >= C_GL / 256;
        const int pfc0 = (u.pn - 2) * 256 + wc * 32 + 8 * fq;
#pragma unroll
        for (int ai = 0; ai < 2; ++ai)
#pragma unroll
            for (int m = 0; m < 4; ++m) { const size_t row = (size_t)(row0 + ai * HALF + m * 16);
#pragma unroll
                for (int bj = 0; bj < 2; ++bj) { f32x4 v0 = acc[ai][bj][m][0], v1 = acc[ai][bj][m][1];
                    if (gate) {
#pragma unroll
                        for (int j = 0; j < 4; ++j) { v0[j] = sigm(v0[j]); v1[j] = sigm(v1[j]); } }
                    u32x4 w; w.x = cvt_pk_bf16(v0[0], v0[1]); w.y = cvt_pk_bf16(v0[2], v0[3]); w.z = cvt_pk_bf16(v1[0], v1[1]); w.w = cvt_pk_bf16(v1[2], v1[3]);
                    *(u32x4*)(P16 + row * NPAD + col0 + bj * HALF) = w;
                    if (f32t) { float* pf = PF + row * PFW + pfc0 + bj * HALF; *(f32x4*)pf = v0; *(f32x4*)(pf + 4) = v1; } } }
    }
};
struct EpiGate {
    static constexpr bool PERM = true;
    bf16_t* GS; const bf16_t* P16;
    __device__ __forceinline__ bool keep(const Unit& u) const { return (u.pn >> 2) < 2; }
    __device__ __forceinline__ void operator()(f32x4 (&acc)[2][2][4][2], const Unit& u, int wr, int wc, int fr, int fq) const {
        const int n = u.pn >> 2, row0 = u.pm * BM + wr * 64 + fr, col0 = (u.pn & 3) * BM + wc * 32 + 8 * fq;
#pragma unroll
        for (int ai = 0; ai < 2; ++ai) {
            u32x4 gwv[4][2], hwv[4][2];
#pragma unroll
            for (int m = 0; m < 4; ++m)
#pragma unroll
                for (int bj = 0; bj < 2; ++bj) { const size_t row = (size_t)(row0 + ai * HALF + m * 16);
                    gwv[m][bj] = *(const u32x4*)(P16 + row * NPAD + C_GL + n * 1024 + col0 + bj * HALF);
                    if (n < 2) hwv[m][bj] = *(const u32x4*)(P16 + row * NPAD + C_GL + (n + 1) * 1024 + col0 + bj * HALF); else hwv[m][bj] = gwv[m][bj]; }
#pragma unroll
            for (int m = 0; m < 4; ++m)
#pragma unroll
                for (int bj = 0; bj < 2; ++bj) { const size_t row = (size_t)(row0 + ai * HALF + m * 16); f32x4& v0 = acc[ai][bj][m][0]; f32x4& v1 = acc[ai][bj][m][1];
                    const u32x4 gw = gwv[m][bj], hw = hwv[m][bj];
                    const float g[8] = {lo_bf(gw.x), hi_bf(gw.x), lo_bf(gw.y), hi_bf(gw.y), lo_bf(gw.z), hi_bf(gw.z), lo_bf(gw.w), hi_bf(gw.w)};
                    if (n < 2) { const float h[8] = {lo_bf(hw.x), hi_bf(hw.x), lo_bf(hw.y), hi_bf(hw.y), lo_bf(hw.z), hi_bf(hw.z), lo_bf(hw.w), hi_bf(hw.w)};
#pragma unroll
                        for (int j = 0; j < 4; ++j) { v0[j] *= g[j] * __builtin_amdgcn_rcpf(h[j]); v1[j] *= g[4 + j] * __builtin_amdgcn_rcpf(h[4 + j]); }
                    } else { u32x4 w;
                        w.x = cvt_pk_bf16(v0[0] * g[0], v0[1] * g[1]); w.y = cvt_pk_bf16(v0[2] * g[2], v0[3] * g[3]);
                        w.z = cvt_pk_bf16(v1[0] * g[4], v1[1] * g[5]); w.w = cvt_pk_bf16(v1[2] * g[6], v1[3] * g[7]);
                        *(u32x4*)(GS + row * D + col0 + bj * HALF) = w; } }
        }
    }
};
struct BranchOrder {
    StaticOrder so; int G;
    __device__ __forceinline__ void init(int G_, int c_) { so.init(M, 1024, G_, c_, 0); G = G_; }
    __device__ __forceinline__ bool next(int i, Unit& u) const { Unit t; if (!so.next(i / 3, t)) return false; const int n = i % 3; u.pm = t.pm; u.pn = n * 4 + t.pn; u.ka = n; return true; }
};
struct EpiRes {
    __device__ __forceinline__ bool keep(const Unit&) const { return false; }
    static constexpr bool PERM = false;
    float* X;
    __device__ __forceinline__ void operator()(f32x4 (&acc)[2][2][4][2], const Unit& u, int wr, int wc, int fr, int fq) const {
        const int row0 = u.pm * BM + wr * 64 + fr, col0 = u.pn * BM + wc * 32 + 4 * fq;
#pragma unroll
        for (int ai = 0; ai < 2; ++ai)
#pragma unroll
            for (int m = 0; m < 4; ++m) { float* rowp = X + (size_t)(row0 + ai * HALF + m * 16) * D + col0;
#pragma unroll
                for (int bj = 0; bj < 2; ++bj)
#pragma unroll
                    for (int n = 0; n < 2; ++n) { f32x4* p = (f32x4*)(rowp + bj * HALF + n * 16); *p = *p + acc[ai][bj][m][n]; } }
    }
};
struct EpiB16 {
    __device__ __forceinline__ bool keep(const Unit&) const { return false; }
    static constexpr bool PERM = true;
    bf16_t* O; int ldc;
    __device__ __forceinline__ void operator()(f32x4 (&acc)[2][2][4][2], const Unit& u, int wr, int wc, int fr, int fq) const {
        const int row0 = u.pm * BM + wr * 64 + fr, col0 = u.pn * BM + wc * 32 + 8 * fq;
#pragma unroll
        for (int ai = 0; ai < 2; ++ai)
#pragma unroll
            for (int m = 0; m < 4; ++m) { bf16_t* rowp = O + (size_t)(row0 + ai * HALF + m * 16) * ldc + col0;
#pragma unroll
                for (int bj = 0; bj < 2; ++bj) { const f32x4 v0 = acc[ai][bj][m][0], v1 = acc[ai][bj][m][1];
                    u32x4 w; w.x = cvt_pk_bf16(v0[0], v0[1]); w.y = cvt_pk_bf16(v0[2], v0[3]); w.z = cvt_pk_bf16(v1[0], v1[1]); w.w = cvt_pk_bf16(v1[2], v1[3]);
                    *(u32x4*)(rowp + bj * HALF) = w; } }
    }
};
}

struct Args {
    const float* x; const int* pos; const float* norm1; const float* w_in; const float* lb_logits; const float* hgrn_gain; const float* gmlp_gain; const float* gmlp_ws; const float* gmlp_bs;
    const float* w_branch; const float* w_out; const float* norm2; const float* peer_wq; const float* peer_keys; const float* peer_u; const float* peer_v; const float* final_gain;
    float* out; unsigned char* ws; int ph_lo, ph_hi;
};
constexpr int NTHR = 512, NWAVE = 8;
constexpr int LDS_BYTES = 147456;
constexpr int LDS_CTL_OFF = 143360;

__device__ __forceinline__ void tr_item(const float* src, int ldsrc, int c0, int nvalid, bf16_t* dst, int ldd, int r0, int koff, float* scr, int item, int nblk, int lane) {
    const int kb = item / nblk, nb = item % nblk, k0 = 64 * kb, n0 = 32 * nb;
    const int nn = n0 + (lane & 31);
    float tv[32];
#pragma unroll
    for (int i = 0; i < 32; ++i) { const int kk = 2 * i + (lane >> 5); tv[i] = (nn < nvalid) ? src[(size_t)(k0 + kk) * ldsrc + c0 + nn] : 0.f; }
#pragma unroll
    for (int i = 0; i < 32; ++i) { const int kk = 2 * i + (lane >> 5); scr[kk * 33 + (lane & 31)] = tv[i]; }
    asm volatile("s_waitcnt lgkmcnt(0)" ::: "memory");
    const int c = lane & 7;
#pragma unroll
    for (int j = 0; j < 4; ++j) { const int n = (lane >> 3) + 8 * j; const float* s = scr + (8 * c) * 33 + n;
        u32x4 o; o.x = pk2(s[0 * 33], s[1 * 33]); o.y = pk2(s[2 * 33], s[3 * 33]); o.z = pk2(s[4 * 33], s[5 * 33]); o.w = pk2(s[6 * 33], s[7 * 33]);
        *(u32x4*)(dst + (size_t)(r0 + n0 + n) * ldd + koff + k0 + 8 * c) = o; }
    asm volatile("s_waitcnt lgkmcnt(0)" ::: "memory");
}
__device__ __forceinline__ void rms_row_to_bf16(const float* xrow, const float* gain, bf16_t* orow, int lane) {
    const f32x4* xr = (const f32x4*)xrow + lane; const f32x4* gr = (const f32x4*)gain + lane;
    f32x4 v[4]; float s = 0.f;
#pragma unroll
    for (int j = 0; j < 4; ++j) { v[j] = xr[64 * j]; s += (v[j].x * v[j].x + v[j].y * v[j].y) + (v[j].z * v[j].z + v[j].w * v[j].w); }
    const float r = rsqrtf(wave_sum(s) * (1.f / D) + EPS);
    unsigned long long* o8 = (unsigned long long*)orow + lane;
#pragma unroll
    for (int j = 0; j < 4; ++j) { const f32x4 g = gr[64 * j]; o8[64 * j] = (unsigned long long)pk2(v[j].x * r * g.x, v[j].y * r * g.y) | ((unsigned long long)pk2(v[j].z * r * g.z, v[j].w * r * g.w) << 32); }
}

__device__ __forceinline__ void ph_prologue(const Args& a, unsigned char* lds, int wv) {
    const int tid = otid(wv), lane = tid & 63, wave = tid >> 6;
    const int gw = blockIdx.x * NWAVE + wave, ngw = gridDim.x * NWAVE;
    const size_t gtid = (size_t)blockIdx.x * NTHR + tid, gsz = (size_t)gridDim.x * NTHR;
    unsigned char* ws = oport(a.ws);
    { const f32x4* s = (const f32x4*)a.x; f32x4* d = (f32x4*)a.out; for (size_t i = gtid; i < (size_t)M * D / 4; i += gsz) d[i] = s[i]; }
    float* scr = (float*)(lds + wave * 16384);
    constexpr int I_IN1 = 16 * 160, I_IN2 = 16 * 8, I_IN3 = 16 * 96, I_IN = I_IN1 + I_IN2 + I_IN3;
    constexpr int I_BR = 3 * 8 * 32, I_OUT = 16 * 32, I_PQ = 16 * 64, I_L = I_IN + I_BR + I_OUT + I_PQ;
    for (int it = gw; it < DEPTH * I_L; it += ngw) {
        const int l = it / I_L; int r = it % I_L;
        bf16_t* win = (bf16_t*)(ws + WS_WIN + (size_t)l * WIN_L); const float* src_in = a.w_in + (size_t)l * D * NIN;
        if (r < I_IN1) { tr_item(src_in, NIN, 0, 5120, win, D, 0, 0, scr, r, 160, lane); continue; } r -= I_IN1;
        if (r < I_IN2) { tr_item(src_in, NIN, 5120, 72, win, D, C_KI, 0, scr, r, 8, lane); continue; } r -= I_IN2;
        if (r < I_IN3) { tr_item(src_in, NIN, S_GL, 3072, win, D, C_GL, 0, scr, r, 96, lane); continue; } r -= I_IN3;
        if (r < I_BR) { const int n = r / 256; tr_item(a.w_branch + ((size_t)l * 3 + n) * 512 * D, D, 0, 1024, (bf16_t*)(ws + WS_WBR + (size_t)l * WBR_L), 512, n * 1024, 0, scr, r % 256, 32, lane); continue; } r -= I_BR;
        if (r < I_OUT) { tr_item(a.w_out + (size_t)l * D * D, D, 0, 1024, (bf16_t*)(ws + WS_WOUT + (size_t)l * WOUT_L), D, 0, 0, scr, r, 32, lane); continue; } r -= I_OUT;
        tr_item(a.peer_wq + (size_t)l * D * 2048, 2048, 0, 2048, (bf16_t*)(ws + WS_WPQ + (size_t)l * WPQ_L), D, 0, 0, scr, r, 64, lane);
    }
    if (gtid < 512) { float v[DEPTH], mx = -1e30f; for (int l = 0; l < DEPTH; ++l) { v[l] = a.lb_logits[l * 512 + gtid]; mx = fmaxf(mx, v[l]); }
        float s = 0.f; for (int l = 0; l < DEPTH; ++l) { v[l] = __expf(v[l] - mx); s += v[l]; }
        float c = 0.f; float* lb = (float*)(ws + WS_LB); for (int l = 0; l < DEPTH; ++l) { if (l > 0) c += v[l] / s; lb[l * 512 + gtid] = c; } }
    { u32x4* SKB = (u32x4*)(ws + WS_SKB); const f32x4* sk = (const f32x4*)a.peer_keys; for (size_t i = gtid; i < (size_t)DEPTH * 16 * 128 * 128 / 8; i += gsz) { const f32x4 k0 = sk[2 * i], k1 = sk[2 * i + 1]; SKB[i] = (u32x4){pk2(k0.x, k0.y), pk2(k0.z, k0.w), pk2(k1.x, k1.y), pk2(k1.z, k1.w)}; } }
    { bf16_t* WSB = (bf16_t*)(ws + WS_WSB); for (size_t i = gtid; i < (size_t)DEPTH * 4 * 128 * 128; i += gsz) { const int t = (int)((i >> 7) & 127), sx = (int)(i & 127); WSB[i] = (bf16_t)f2bf(sx <= t ? a.gmlp_ws[i] : 0.f); } }
    { float2* cs = (float2*)(ws + WS_CS);
      for (size_t i = gtid; i < (size_t)M * 96; i += gsz) { const int m = (int)(i / 96), j = (int)(i % 96);
          const float inv = j < 64 ? ROPE_INV64[j] : ROPE_INV32[j - 64]; const float angf = (float)a.pos[m] * inv;
          const double ang = (double)angf; const double k = rint(ang * 0.15915494309189535); const float r = (float)(ang - k * 6.283185307179586);
          cs[i] = make_float2(__cosf(r), __sinf(r)); } }
    for (int m = gw; m < M; m += ngw) rms_row_to_bf16(a.x + (size_t)m * D, a.norm1, (bf16_t*)(ws + WS_H16) + (size_t)m * D, lane);
}

__device__ __forceinline__ void ph_kiwi(const Args& a, int l, unsigned char* lds, int wv) {
    unsigned char* ws = oport(a.ws); const int tid = otid(wv), lane = tid & 63, wave = __builtin_amdgcn_readfirstlane(tid >> 6), g4 = wave & 3, kh = wave >> 2, fr = lane & 15, fq = lane >> 4;
    const bf16_t* H16 = (const bf16_t*)(ws + WS_H16); const bf16_t* W = (const bf16_t*)(ws + WS_WIN + (size_t)l * WIN_L) + (size_t)C_KI * D; float* PF = (float*)(ws + WS_PF);
    f32x4* sK = (f32x4*)lds + (g4 * 5) * 64 + lane;
    for (int base = blockIdx.x; base * 4 < M / 16; base += gridDim.x) { const int tg = base * 4 + g4; f32x4 acc[5];
#pragma unroll
        for (int nt = 0; nt < 5; ++nt) acc[nt] = (f32x4){0.f, 0.f, 0.f, 0.f};
#pragma unroll 8
        for (int ks = 16 * kh; ks < 16 * kh + 16; ++ks) { const bf16x8 y = ((const bf16x8*)(H16 + (size_t)tg * 16 * D + 32 * ks))[fr * (D / 8) + fq];
#pragma unroll
            for (int nt = 0; nt < 5; ++nt) { const bf16x8 x = ((const bf16x8*)(W + (size_t)nt * 16 * D + 32 * ks))[fr * (D / 8) + fq]; acc[nt] = __builtin_amdgcn_mfma_f32_16x16x32_bf16(x, y, acc[nt], 0, 0, 0); } }
        __syncthreads();
        if (kh == 1) {
#pragma unroll
            for (int nt = 0; nt < 5; ++nt) sK[nt * 64] = acc[nt]; }
        __syncthreads();
        if (kh == 0) {
#pragma unroll
            for (int nt = 0; nt < 5; ++nt) *(f32x4*)(PF + ((size_t)tg * 16 + fr) * PFW + 512 + 16 * nt + 4 * fq) = acc[nt] + sK[nt * 64]; }
    }
    __syncthreads();
}

__device__ __forceinline__ void ph_post(const Args& a, int l, unsigned char* lds, int wv) {
    const int tid = otid(wv), lane = tid & 63, wave = tid >> 6;
    const int gw = blockIdx.x * NWAVE + wave, ngw = gridDim.x * NWAVE;
    const size_t gtid = (size_t)blockIdx.x * NTHR + tid, gsz = (size_t)gridDim.x * NTHR;
    unsigned char* ws = oport(a.ws);
    const bf16_t* P16 = (const bf16_t*)(ws + WS_P16); const float* PF = (const float*)(ws + WS_PF); const float2* cs = (const float2*)(ws + WS_CS);
    { bf16_t* QR = (bf16_t*)(ws + WS_QR); bf16_t* KR = (bf16_t*)(ws + WS_KR);
#pragma unroll 4
      for (size_t i = gtid; i < (size_t)M * 256; i += gsz) { const int m = (int)(i >> 8), h = (int)((i >> 6) & 3), j = (int)(i & 63);
          const float2 c = cs[(size_t)m * 96 + j]; const size_t pb = (size_t)m * NPAD + h * 128 + j, ob = (size_t)m * 512 + h * 128 + j;
          const float q1 = bf2f(P16[pb + C_CQ]), q2 = bf2f(P16[pb + C_CQ + 64]), k1 = bf2f(P16[pb + C_CK]), k2 = bf2f(P16[pb + C_CK + 64]);
          const float sc = 0.08838834764831845f * 1.4426950408889634f;
          QR[ob] = (bf16_t)f2bf((q1 * c.x - q2 * c.y) * sc); QR[ob + 64] = (bf16_t)f2bf((q2 * c.x + q1 * c.y) * sc);
          KR[ob] = (bf16_t)f2bf(k1 * c.x - k2 * c.y); KR[ob + 64] = (bf16_t)f2bf(k2 * c.x + k1 * c.y); } }
    { bf16_t* QS = (bf16_t*)(ws + WS_QI); bf16_t* KIb = (bf16_t*)(ws + WS_KI); float* WP = (float*)(ws + WS_WI);
#pragma unroll 2
      for (int m = gw; m < M; m += ngw) { const int h = lane >> 3, jj = lane & 7;
          const unsigned long long w1 = *(const unsigned long long*)(P16 + (size_t)m * NPAD + C_QI + h * 64 + 4 * jj), w2 = *(const unsigned long long*)(P16 + (size_t)m * NPAD + C_QI + h * 64 + 32 + 4 * jj);
          const float q1[4] = {lo_bf((unsigned)w1), hi_bf((unsigned)w1), lo_bf((unsigned)(w1 >> 32)), hi_bf((unsigned)(w1 >> 32))}, q2[4] = {lo_bf((unsigned)w2), hi_bf((unsigned)w2), lo_bf((unsigned)(w2 >> 32)), hi_bf((unsigned)(w2 >> 32))};
          const float2* c = cs + (size_t)m * 96 + 64 + 4 * jj; const float w = PF[(size_t)m * PFW + 576 + h] * 0.02209708691207961f;
          float r1[4], r2[4], l1[4], l2[4];
#pragma unroll
          for (int i = 0; i < 4; ++i) { const float2 cc = c[i]; r1[i] = q1[i] * cc.x - q2[i] * cc.y; r2[i] = q2[i] * cc.x + q1[i] * cc.y; l1[i] = w * r1[i]; l2[i] = w * r2[i]; }
          *(unsigned long long*)(QS + (size_t)m * 576 + h * 64 + 4 * jj) = (unsigned long long)pk2(r1[0], r1[1]) | ((unsigned long long)pk2(r1[2], r1[3]) << 32);
          *(unsigned long long*)(QS + (size_t)m * 576 + h * 64 + 32 + 4 * jj) = (unsigned long long)pk2(r2[0], r2[1]) | ((unsigned long long)pk2(r2[2], r2[3]) << 32);
#pragma unroll
          for (int i = 0; i < 4; ++i) { l1[i] += __shfl_xor(l1[i], 8); l1[i] += __shfl_xor(l1[i], 16); l1[i] += __shfl_xor(l1[i], 32); l2[i] += __shfl_xor(l2[i], 8); l2[i] += __shfl_xor(l2[i], 16); l2[i] += __shfl_xor(l2[i], 32); }
          if (h == 0) { *(unsigned long long*)(QS + (size_t)m * 576 + 512 + 4 * jj) = (unsigned long long)pk2(l1[0], l1[1]) | ((unsigned long long)pk2(l1[2], l1[3]) << 32);
                        *(unsigned long long*)(QS + (size_t)m * 576 + 512 + 32 + 4 * jj) = (unsigned long long)pk2(l2[0], l2[1]) | ((unsigned long long)pk2(l2[2], l2[3]) << 32);
                        const f32x4 k1 = *(const f32x4*)(PF + (size_t)m * PFW + 512 + 4 * jj), k2 = *(const f32x4*)(PF + (size_t)m * PFW + 512 + 32 + 4 * jj);
                        const float kk1[4] = {k1.x, k1.y, k1.z, k1.w}, kk2[4] = {k2.x, k2.y, k2.z, k2.w}; float o1[4], o2[4];
#pragma unroll
                        for (int i = 0; i < 4; ++i) { const float2 cc = c[i]; o1[i] = kk1[i] * cc.x - kk2[i] * cc.y; o2[i] = kk2[i] * cc.x + kk1[i] * cc.y; }
                        *(unsigned long long*)(KIb + (size_t)m * 64 + 4 * jj) = (unsigned long long)pk2(o1[0], o1[1]) | ((unsigned long long)pk2(o1[2], o1[3]) << 32);
                        *(unsigned long long*)(KIb + (size_t)m * 64 + 32 + 4 * jj) = (unsigned long long)pk2(o2[0], o2[1]) | ((unsigned long long)pk2(o2[2], o2[3]) << 32); }
          if (jj == 0) WP[(size_t)m * 8 + h] = w; } }
    { bf16_t* VT = (bf16_t*)(ws + WS_VT); bf16_t* sT = (bf16_t*)lds;
      for (int t0 = blockIdx.x * 8; t0 < (M / 64) * 8; t0 += gridDim.x * 8) {
          u32x4 w[8]; const int row = tid >> 3, seg = tid & 7;
#pragma unroll
          for (int q = 0; q < 8; ++q) { const int tile = t0 + q, tb = tile >> 3, cb = tile & 7; w[q] = *(const u32x4*)(P16 + (size_t)(tb * 64 + row) * NPAD + C_CV + cb * 64 + seg * 8); }
          __syncthreads();
#pragma unroll
          for (int q = 0; q < 8; ++q) { unsigned* d = (unsigned*)(sT + q * 64 * 66 + row * 66 + seg * 8); d[0] = w[q].x; d[1] = w[q].y; d[2] = w[q].z; d[3] = w[q].w; }
          __syncthreads();
          const int ch = tid >> 3, tg = tid & 7;
#pragma unroll
          for (int q = 0; q < 8; ++q) { const int tile = t0 + q, tb = tile >> 3, cb = tile & 7; unsigned short v[8];
#pragma unroll
              for (int i = 0; i < 8; ++i) v[i] = sT[q * 64 * 66 + (tg * 8 + i) * 66 + ch];
              const u32x4 o = {(unsigned)v[0] | ((unsigned)v[1] << 16), (unsigned)v[2] | ((unsigned)v[3] << 16), (unsigned)v[4] | ((unsigned)v[5] << 16), (unsigned)v[6] | ((unsigned)v[7] << 16)};
              *(u32x4*)(VT + ((size_t)((tb >> 7) * 512 + cb * 64 + ch)) * SEQ + (tb & 127) * 64 + tg * 8) = o; } }
      __syncthreads(); }
    { bf16_t* VN = (bf16_t*)(ws + WS_VN); const float* gain = a.gmlp_gain + l * 512;
#pragma unroll 4
      for (int m = gw; m < M; m += ngw) { const u32x4 w = *(const u32x4*)(P16 + (size_t)m * NPAD + C_BV + lane * 8);
          float v[8] = {gelu_t(lo_bf(w.x)), gelu_t(hi_bf(w.x)), gelu_t(lo_bf(w.y)), gelu_t(hi_bf(w.y)), gelu_t(lo_bf(w.z)), gelu_t(hi_bf(w.z)), gelu_t(lo_bf(w.w)), gelu_t(hi_bf(w.w))};
          float sm = 0.f;
#pragma unroll
          for (int j = 0; j < 8; ++j) sm += v[j] * v[j];
          const float r = rsqrtf(wave_sum(sm) * (1.f / 512.f) + EPS);
          const f32x4 g0 = *(const f32x4*)(gain + lane * 8), g1 = *(const f32x4*)(gain + lane * 8 + 4);
          *(u32x4*)(VN + (size_t)m * 512 + lane * 8) = (u32x4){pk2(v[0] * r * g0.x, v[1] * r * g0.y), pk2(v[2] * r * g0.z, v[3] * r * g0.w), pk2(v[4] * r * g1.x, v[5] * r * g1.y), pk2(v[6] * r * g1.z, v[7] * r * g1.w)}; } }
}

constexpr int NHU = BATCH * 128 * 4;
__device__ __forceinline__ void ph_h1(const Args& a, int l, unsigned char* lds, int wv) {
    unsigned char* ws = oport(a.ws);
    const int tid = otid(wv), lane = tid & 63, wave = __builtin_amdgcn_readfirstlane(tid >> 6), j = wave >> 1, d = tid & 127, fr = lane & 15, fq = lane >> 4;
    bf16_t* KT = (bf16_t*)lds;
    bf16_t* VT = KT + 128 * 72;
    float* sT = (float*)(VT + 128 * 72);
    const float* PF = (const float*)(ws + WS_PF); const bf16_t* P16 = (const bf16_t*)(ws + WS_P16); const float* LB = (const float*)(ws + WS_LB) + l * 512;
    float* LL = (float*)(ws + WS_FF); float* DD = (float*)(ws + WS_DD);
    for (int u = blockIdx.x; u < NHU; u += gridDim.x) {
        const int h = u & 3, c = (u >> 2) & 127, b = u >> 9; const size_t m0 = (size_t)b * SEQ + c * 64 + j * 16;
        const float lbv = LB[h * 128 + d];
        float cs[16], ky[16]; unsigned vv[16]; float run = 0.f;
#pragma unroll
        for (int i = 0; i < 16; ++i) { const float z = PF[(m0 + i) * PFW + h * 128 + d]; const float sg = sigm(z); run += __logf(lbv + (1.f - lbv) * sg); cs[i] = run; ky[i] = (1.f - lbv) * (1.f - sg);
            vv[i] = P16[(m0 + i) * NPAD + C_AI + h * 128 + d]; }
        sT[j * 128 + d] = run;
        __syncthreads();
        float tail = 0.f;
#pragma unroll
        for (int jj = 1; jj < 4; ++jj) if (jj > j) tail += sT[jj * 128 + d];
        { unsigned w[8], x[8];
#pragma unroll
          for (int i = 0; i < 8; ++i) { w[i] = pk2(ky[2 * i] * __expf(tail + (run - cs[2 * i])), ky[2 * i + 1] * __expf(tail + (run - cs[2 * i + 1]))); x[i] = vv[2 * i] | (vv[2 * i + 1] << 16); }
          u32x4* kp = (u32x4*)(KT + d * 72 + j * 16); kp[0] = (u32x4){w[0], w[1], w[2], w[3]}; kp[1] = (u32x4){w[4], w[5], w[6], w[7]};
          u32x4* vp = (u32x4*)(VT + d * 72 + j * 16); vp[0] = (u32x4){x[0], x[1], x[2], x[3]}; vp[1] = (u32x4){x[4], x[5], x[6], x[7]}; }
        if (j == 0) DD[(size_t)u * 128 + d] = __expf(run + tail);
        __syncthreads();
        { bf16x8 xk[2];
#pragma unroll
          for (int ks = 0; ks < 2; ++ks) xk[ks] = *(const bf16x8*)(KT + (16 * wave + fr) * 72 + ks * 32 + fq * 8);
#pragma unroll
          for (int nt = 0; nt < 8; ++nt) { f32x4 acc = {0.f, 0.f, 0.f, 0.f};
#pragma unroll
              for (int ks = 0; ks < 2; ++ks) { const bf16x8 y = *(const bf16x8*)(VT + (16 * nt + fr) * 72 + ks * 32 + fq * 8); acc = __builtin_amdgcn_mfma_f32_16x16x32_bf16(xk[ks], y, acc, 0, 0, 0); }
              *(f32x4*)(LL + ((size_t)u * 128 + 16 * nt + fr) * 128 + 16 * wave + 4 * fq) = acc; } }
        __syncthreads();
    }
}
__device__ __forceinline__ void ph_h2(const Args& a, int wv) {
    unsigned char* ws = oport(a.ws);
    const float* LL = (const float*)(ws + WS_FF); const float* DD = (const float*)(ws + WS_DD); bf16_t* SB = (bf16_t*)(ws + WS_QF);
    for (int e = blockIdx.x * NTHR + otid(wv); e < 8 * 16384; e += gridDim.x * NTHR) { const int bh = e >> 14, b = bh >> 2, h = bh & 3, dvdk = e & 16383, dk = e & 127; float S = 0.f;
#pragma unroll 16
        for (int c = 0; c < 128; ++c) { const size_t u = (size_t)(((b * 128 + c) << 2) + h); SB[u * 16384 + dvdk] = (bf16_t)f2bf(S); S = DD[u * 128 + dk] * S + LL[u * 16384 + dvdk]; } }
}
__device__ __forceinline__ void ph_h3(const Args& a, int l, unsigned char* lds, int wv) {
    unsigned char* ws = oport(a.ws);
    const int tid = otid(wv), lane = tid & 63, wave = __builtin_amdgcn_readfirstlane(tid >> 6), j = wave >> 1, d = tid & 127, fr = lane & 15, fq = lane >> 4;
    bf16_t* QT = (bf16_t*)lds;
    bf16_t* QH = QT + 64 * 136;
    bf16_t* KI = QH + 64 * 136;
    bf16_t* VT = KI + 160 * 136;
    bf16_t* AT = VT + 128 * 72;
    float* sT = (float*)(AT + 64 * 72);
    float* sSS = sT + 512;
    const float* PF = (const float*)(ws + WS_PF); const bf16_t* P16 = (const bf16_t*)(ws + WS_P16); const float* LB = (const float*)(ws + WS_LB) + l * 512;
    const bf16_t* SB = (const bf16_t*)(ws + WS_QF); bf16_t* YA = (bf16_t*)(ws + WS_YALL); const float* gain = a.hgrn_gain + l * 128;
    for (int u = blockIdx.x; u < NHU; u += gridDim.x) {
        const int h = u & 3, c = (u >> 2) & 127, b = u >> 9; const size_t mc = (size_t)b * SEQ + c * 64, m0 = mc + j * 16;
        for (int i = tid; i < 64 * 72 * 2 / 16; i += NTHR) ((u32x4*)AT)[i] = (u32x4){0u, 0u, 0u, 0u};
        bf16x8 sbf[4][4];
#pragma unroll
        for (int q4 = 0; q4 < 4; ++q4)
#pragma unroll
            for (int ks = 0; ks < 4; ++ks) sbf[q4][ks] = ((const bf16x8*)(SB + ((size_t)u * 128 + 16 * (4 * (wave >> 2) + q4)) * 128 + 32 * ks))[fr * 16 + fq];
        const float lbv = LB[h * 128 + d];
        float cs[16], ky[16], qf[16]; unsigned vv[16]; float run = 0.f;
#pragma unroll
        for (int i = 0; i < 16; ++i) { const size_t pr = (m0 + i) * NPAD + h * 128 + d; const float z = PF[(m0 + i) * PFW + h * 128 + d]; const float sg = sigm(z); run += __logf(lbv + (1.f - lbv) * sg); cs[i] = run; ky[i] = (1.f - lbv) * (1.f - sg);
            qf[i] = silu(bf2f(P16[pr + C_AQ])) * 0.08838834764831845f; vv[i] = P16[pr + C_AI]; }
        sT[j * 128 + d] = run;
        __syncthreads();
        const float T0 = sT[d], T1 = sT[128 + d], T2 = sT[256 + d];
        const float Bj = (j > 0 ? T0 : 0.f) + (j > 1 ? T1 : 0.f) + (j > 2 ? T2 : 0.f); const float eBj = __expf(Bj);
        float pre[4]; pre[0] = 0.f; pre[1] = (j < 1 ? T0 : 0.f); pre[2] = (j < 1 ? T0 : 0.f) + (j < 2 ? T1 : 0.f); pre[3] = (j < 1 ? T0 : 0.f) + (j < 2 ? T1 : 0.f) + (j < 3 ? T2 : 0.f);
#pragma unroll
        for (int i = 0; i < 16; ++i) { const int t = 16 * j + i; const float ec = __expf(cs[i]);
            QT[t * 136 + d] = (bf16_t)f2bf(qf[i] * ec); QH[t * 136 + d] = (bf16_t)f2bf(qf[i] * ec * eBj);
#pragma unroll
            for (int I = 0; I < 4; ++I) if (I >= j) KI[(8 * I * (I + 1) + t) * 136 + d] = (bf16_t)f2bf(ky[i] * __expf(fminf(pre[I] - cs[i], 80.f))); }
        { unsigned x[8];
#pragma unroll
          for (int i = 0; i < 8; ++i) x[i] = vv[2 * i] | (vv[2 * i + 1] << 16);
          u32x4* vp = (u32x4*)(VT + d * 72 + j * 16); vp[0] = (u32x4){x[0], x[1], x[2], x[3]}; vp[1] = (u32x4){x[4], x[5], x[6], x[7]}; }
        __syncthreads();
        for (int tl = wave; tl < 10; tl += 8) { const int I = tl < 1 ? 0 : tl < 3 ? 1 : tl < 6 ? 2 : 3, J = tl - (I * (I + 1)) / 2; f32x4 acc = {0.f, 0.f, 0.f, 0.f};
#pragma unroll
            for (int ks = 0; ks < 4; ++ks) { const bf16x8 x = *(const bf16x8*)(QT + (16 * I + fr) * 136 + ks * 32 + fq * 8); const bf16x8 y = *(const bf16x8*)(KI + (8 * I * (I + 1) + 16 * J + fr) * 136 + ks * 32 + fq * 8);
                acc = __builtin_amdgcn_mfma_f32_16x16x32_bf16(x, y, acc, 0, 0, 0); }
#pragma unroll
            for (int r = 0; r < 4; ++r) { float v = acc[r]; if (J == I && fr > 4 * fq + r) v = 0.f; AT[(16 * I + 4 * fq + r) * 72 + 16 * J + fr] = (bf16_t)f2bf(v); } }
        __syncthreads();
        const int I = wave & 3, nt0 = 4 * (wave >> 2); f32x4 o[4];
#pragma unroll
        for (int q4 = 0; q4 < 4; ++q4) { const int nt = nt0 + q4; f32x4 acc = {0.f, 0.f, 0.f, 0.f};
            for (int ks = 0; ks <= (I >> 1); ++ks) { const bf16x8 x = *(const bf16x8*)(AT + (16 * I + fr) * 72 + ks * 32 + fq * 8); const bf16x8 y = *(const bf16x8*)(VT + (16 * nt + fr) * 72 + ks * 32 + fq * 8);
                acc = __builtin_amdgcn_mfma_f32_16x16x32_bf16(x, y, acc, 0, 0, 0); }
#pragma unroll
            for (int ks = 0; ks < 4; ++ks) { const bf16x8 x = *(const bf16x8*)(QH + (16 * I + fr) * 136 + ks * 32 + fq * 8); acc = __builtin_amdgcn_mfma_f32_16x16x32_bf16(x, sbf[q4][ks], acc, 0, 0, 0); }
            o[q4] = acc; }
        { float ssq[4];
#pragma unroll
          for (int r = 0; r < 4; ++r) { float s = o[0][r] * o[0][r] + o[1][r] * o[1][r] + o[2][r] * o[2][r] + o[3][r] * o[3][r]; s += __shfl_xor(s, 1); s += __shfl_xor(s, 2); s += __shfl_xor(s, 4); s += __shfl_xor(s, 8); ssq[r] = s; }
          if (fr == 0) {
#pragma unroll
              for (int r = 0; r < 4; ++r) sSS[(16 * I + 4 * fq + r) * 2 + (wave >> 2)] = ssq[r]; } }
        __syncthreads();
#pragma unroll
        for (int r = 0; r < 4; ++r) { const int tt = 16 * I + 4 * fq + r; const float rinv = rsqrtf((sSS[tt * 2] + sSS[tt * 2 + 1]) * (1.f / 128.f) + EPS); const size_t m = mc + tt;
#pragma unroll
            for (int q4 = 0; q4 < 4; ++q4) { const int dv = 16 * (nt0 + q4) + fr; const float g = bf2f(P16[m * NPAD + C_AG + h * 128 + dv]);
                YA[m * 512 + h * 128 + dv] = (bf16_t)f2bf(o[q4][r] * rinv * gain[dv] * silu(g)); } }
        __syncthreads();
    }
}
__device__ __forceinline__ void ph_gmlp(const Args& a, int l, unsigned char* lds, int wv) {
    unsigned char* ws = oport(a.ws);
    const int tid = otid(wv), lane = tid & 63, wave = __builtin_amdgcn_readfirstlane(tid >> 6), fr = lane & 15, fq = lane >> 4;
    const bf16_t* P16 = (const bf16_t*)(ws + WS_P16); const bf16_t* VN = (const bf16_t*)(ws + WS_VN); bf16_t* YB = (bf16_t*)(ws + WS_YALL) + (size_t)M * 512;
    const bf16_t* WSB = (const bf16_t*)(ws + WS_WSB) + (size_t)l * 4 * 128 * 128; const float* bs = a.gmlp_bs + (size_t)l * 4 * 128;
    bf16_t* VNt = (bf16_t*)lds;
    for (int u = blockIdx.x; u < (M / 128) * 4; u += gridDim.x) { const int g = u & 3, nb = u >> 2; const size_t mb = (size_t)nb * 128;
        __syncthreads();
#pragma unroll
        for (int n = 0; n < 4; ++n) { const int idx = tid + NTHR * n, row = idx >> 4, seg = idx & 15; const u32x4 w = *(const u32x4*)(VN + (mb + row) * 512 + g * 128 + seg * 8);
            bf16_t* d = VNt + (seg * 8) * 136 + row;
            d[0 * 136] = (bf16_t)(w.x & 0xffffu); d[1 * 136] = (bf16_t)(w.x >> 16); d[2 * 136] = (bf16_t)(w.y & 0xffffu); d[3 * 136] = (bf16_t)(w.y >> 16);
            d[4 * 136] = (bf16_t)(w.z & 0xffffu); d[5 * 136] = (bf16_t)(w.z >> 16); d[6 * 136] = (bf16_t)(w.w & 0xffffu); d[7 * 136] = (bf16_t)(w.w >> 16); }
        bf16x8 wf[4];
#pragma unroll
        for (int ks = 0; ks < 4; ++ks) wf[ks] = *(const bf16x8*)(WSB + ((size_t)g * 128 + 16 * wave + fr) * 128 + 32 * ks + 8 * fq);
        __syncthreads();
        const int t = 16 * wave + fr; const float bias = bs[g * 128 + t]; const int nks = (wave >> 1) + 1;
        unsigned long long uwv[8];
#pragma unroll
        for (int ct = 0; ct < 8; ++ct) uwv[ct] = *(const unsigned long long*)(P16 + (mb + t) * NPAD + C_BU + g * 128 + 16 * ct + 4 * fq);
#pragma unroll
        for (int ct = 0; ct < 8; ++ct) { f32x4 acc = {0.f, 0.f, 0.f, 0.f};
#pragma unroll
            for (int ks = 0; ks < 4; ++ks) if (ks < nks) { const bf16x8 x = *(const bf16x8*)(VNt + (16 * ct + fr) * 136 + 32 * ks + 8 * fq); acc = __builtin_amdgcn_mfma_f32_16x16x32_bf16(x, wf[ks], acc, 0, 0, 0); }
            const size_t m = mb + t; const int c = g * 128 + 16 * ct + 4 * fq; const unsigned long long uw = uwv[ct];
            const float o0 = gelu_t(lo_bf((unsigned)uw)) * (acc[0] + bias), o1 = gelu_t(hi_bf((unsigned)uw)) * (acc[1] + bias), o2 = gelu_t(lo_bf((unsigned)(uw >> 32))) * (acc[2] + bias), o3 = gelu_t(hi_bf((unsigned)(uw >> 32))) * (acc[3] + bias);
            *(unsigned long long*)(YB + m * 512 + c) = (unsigned long long)pk2(o0, o1) | ((unsigned long long)pk2(o2, o3) << 32); }
    }
}
constexpr int SEL_CAP = 256;
__device__ __forceinline__ int sel_bin(float s, float lo, float sc) { return (int)__builtin_amdgcn_fmed3f((s - lo) * sc, 0.f, 1023.f); }
struct SelQ { float lo1, sc1, lo2, sc2, tau; int b1, b2, ref, tidx; };
__device__ __forceinline__ void sel_pass(const int mode, const bf16x8 (&qf)[9][2], const float (&wp)[8], const SelQ& sq, const bf16_t* kib, int c, int kp, int qloc, int fr, int fq,
                                         unsigned* sHist, unsigned* sCand, unsigned* sCnt, unsigned* maskrow) {
    bf16x8 af[4][2];
    { const int T0 = kp <= c ? kp : c;
#pragma unroll
      for (int rg = 0; rg < 4; ++rg)
#pragma unroll
          for (int ks = 0; ks < 2; ++ks) af[rg][ks] = ((const bf16x8*)(kib + (size_t)(64 * T0 + 16 * rg) * 64 + 32 * ks))[fr * 8 + fq]; }
#pragma unroll 1
    for (int T = kp; T <= c; T += 4) {
        const int Tn = (T + 4 <= c) ? T + 4 : T;
        unsigned mlo = 0u, mhi = 0u;
#pragma unroll
        for (int rg = 0; rg < 4; ++rg) {
            f32x4 sc = __builtin_amdgcn_mfma_f32_16x16x32_bf16(af[rg][0], qf[8][0], (f32x4){0.f, 0.f, 0.f, 0.f}, 0, 0, 0);
            sc = __builtin_amdgcn_mfma_f32_16x16x32_bf16(af[rg][1], qf[8][1], sc, 0, 0, 0);
#pragma unroll
            for (int h = 0; h < 8; ++h) { f32x4 ah = __builtin_amdgcn_mfma_f32_16x16x32_bf16(af[rg][0], qf[h][0], (f32x4){0.f, 0.f, 0.f, 0.f}, 0, 0, 0);
                ah = __builtin_amdgcn_mfma_f32_16x16x32_bf16(af[rg][1], qf[h][1], ah, 0, 0, 0);
#pragma unroll
                for (int r = 0; r < 4; ++r) sc[r] += wp[h] * __builtin_fabsf(ah[r]); }
#pragma unroll
            for (int ks = 0; ks < 2; ++ks) af[rg][ks] = ((const bf16x8*)(kib + (size_t)(64 * Tn + 16 * rg) * 64 + 32 * ks))[fr * 8 + fq];
            if (mode == 0) {
#pragma unroll
                for (int r = 0; r < 4; ++r) { const int b = sel_bin(sc[r], sq.lo1, sq.sc1); __hip_atomic_fetch_add(sHist + qloc * 512 + (b >> 1), 1u << ((b & 1) * 16), __ATOMIC_RELAXED, __HIP_MEMORY_SCOPE_WORKGROUP); }
            } else if (mode == 1) {
                if (sq.ref) {
#pragma unroll
                    for (int r = 0; r < 4; ++r) if (sel_bin(sc[r], sq.lo1, sq.sc1) == sq.b1) { const int b = sel_bin(sc[r], sq.lo2, sq.sc2); __hip_atomic_fetch_add(sHist + qloc * 512 + (b >> 1), 1u << ((b & 1) * 16), __ATOMIC_RELAXED, __HIP_MEMORY_SCOPE_WORKGROUP); } }
            } else {
                int b[4]; unsigned bits = 0u; bool anyc = false;
#pragma unroll
                for (int r = 0; r < 4; ++r) { b[r] = sel_bin(sc[r], sq.lo1, sq.sc1); bits |= (b[r] > sq.b1) ? (1u << r) : 0u; anyc |= (b[r] == sq.b1); }
                if (anyc) {
#pragma unroll
                    for (int r = 0; r < 4; ++r) if (b[r] == sq.b1) { bool cand = true;
                        if (sq.ref) { const int b2 = sel_bin(sc[r], sq.lo2, sq.sc2); if (b2 > sq.b2) bits |= 1u << r; cand = b2 == sq.b2; }
                        if (cand) { const unsigned slot = __hip_atomic_fetch_add(sCnt + qloc, 1u, __ATOMIC_RELAXED, __HIP_MEMORY_SCOPE_WORKGROUP);
                            if (slot < (unsigned)SEL_CAP) { sCand[(qloc * SEL_CAP + slot) * 2] = __float_as_uint(sc[r]); sCand[(qloc * SEL_CAP + slot) * 2 + 1] = (unsigned)(64 * T + 16 * rg + 4 * fq + r); } } } }
                bits <<= (16 * (rg & 1)) + 4 * fq; if (rg < 2) mlo |= bits; else mhi |= bits;
            }
            __builtin_amdgcn_sched_barrier(0);
        }
        if (mode == 2) { mlo |= __shfl_xor(mlo, 16); mlo |= __shfl_xor(mlo, 32); mhi |= __shfl_xor(mhi, 16); mhi |= __shfl_xor(mhi, 32);
            if (fq == 0) *(uint2*)(maskrow + 2 * T) = make_uint2(mlo, mhi); }
    }
}
__device__ __forceinline__ void sel_scan(const unsigned* hist, unsigned need, int lane, int& bsel, unsigned& nneed, unsigned& cnt) {
    unsigned c16[16]; unsigned tot = 0u;
#pragma unroll
    for (int i = 0; i < 8; ++i) { const unsigned w = hist[512 - 8 * (lane + 1) + i]; c16[2 * i] = w & 0xffffu; c16[2 * i + 1] = w >> 16; tot += (w & 0xffffu) + (w >> 16); }
    unsigned inc = tot;
#pragma unroll
    for (int o = 1; o < 64; o <<= 1) { const unsigned t2 = __shfl_up(inc, o); if (lane >= o) inc += t2; }
    const unsigned long long bal = __ballot(inc >= need);
    const int L = bal ? (__ffsll((long long)bal) - 1) : 63;
    unsigned above = __shfl(inc - tot, L); int bs = 0; unsigned nn = 1u, cc = 0u; bool found = false;
#pragma unroll
    for (int j = 0; j < 16; ++j) { const unsigned hcnt = __shfl(c16[15 - j], L); if (!found) { if (above + hcnt >= need) { found = true; bs = 1024 - 16 * L - 1 - j; nn = need - above; cc = hcnt; } else above += hcnt; } }
    bsel = bs; nneed = nn; cnt = cc;
}
__device__ __forceinline__ void ph_sel(const Args& a, unsigned char* lds, int wv) {
    unsigned char* ws = oport(a.ws);
    const int tid = otid(wv), lane = tid & 63, wave = __builtin_amdgcn_readfirstlane(tid >> 6), gq = wave & 1, kp = wave >> 1, fr = lane & 15, fq = lane >> 4, qloc = 16 * gq + fr;
    unsigned* sHist = (unsigned*)lds;
    unsigned* sCand = (unsigned*)(lds + 65536);
    float* sLo1 = (float*)(lds + 131072); float* sSc1 = sLo1 + 32; float* sLo2 = sSc1 + 32; float* sSc2 = sLo2 + 32; float* sTau = sSc2 + 32;
    int* sB1 = (int*)(sTau + 32); int* sB2 = sB1 + 32; int* sRef = sB2 + 32; int* sTidx = sRef + 32; unsigned* sNeed = (unsigned*)(sTidx + 32); unsigned* sCnt = sNeed + 32; int* sAny = (int*)(sCnt + 32);
    const bf16_t* QS = (const bf16_t*)(ws + WS_QI); const bf16_t* KIb = (const bf16_t*)(ws + WS_KI); const float* WP = (const float*)(ws + WS_WI); unsigned* MASKB = (unsigned*)(ws + WS_MASK);
    for (int pi = blockIdx.x; pi < 256; pi += gridDim.x) {
#pragma unroll 1
      for (int which = 0; which < 2; ++which) {
        const int b = pi & 1, half = (pi >> 1) & 1, cc = pi >> 2, c = which ? cc : 127 - cc;
        const size_t mq = (size_t)b * SEQ + 64 * c + 32 * half;
        const bf16_t* kib = KIb + (size_t)b * SEQ * 64;
        __syncthreads();
        if (tid < 32) { const float* w = WP + (mq + tid) * 8; float s1 = 0.f, s2 = 0.f;
#pragma unroll
            for (int h = 0; h < 8; ++h) { s1 += w[h]; s2 += w[h] * w[h]; }
            const float sd = 9.34f * sqrtf(fmaxf(s2, 1e-30f)); sLo1[tid] = 6.38f * s1 - 8.f * sd; sSc1[tid] = 1024.f / (16.f * sd);
            sLo2[tid] = 0.f; sSc2[tid] = 1.f; sB1[tid] = 0; sB2[tid] = 0; sRef[tid] = 0; sNeed[tid] = 256u; sCnt[tid] = 0u; sTau[tid] = -INFINITY; sTidx[tid] = 0x7fffffff; }
        if (tid == 0) sAny[0] = 0;
        for (int i = tid; i < 32 * 512 / 4; i += NTHR) ((u32x4*)sHist)[i] = (u32x4){0u, 0u, 0u, 0u};
        bf16x8 qf[9][2]; float wp[8];
        { const bf16_t* qrow = QS + (mq + qloc) * 576;
#pragma unroll
          for (int h = 0; h < 9; ++h)
#pragma unroll
              for (int ks = 0; ks < 2; ++ks) qf[h][ks] = *(const bf16x8*)(qrow + h * 64 + 32 * ks + 8 * fq);
#pragma unroll
          for (int h = 0; h < 8; ++h) wp[h] = WP[(mq + qloc) * 8 + h]; }
        __syncthreads();
        unsigned* maskrow = MASKB + (mq + qloc) * 256;
        if (c < 4) {
            if (tid < 32) for (int T = 0; T <= c; ++T) *(uint2*)(MASKB + (mq + tid) * 256 + 2 * T) = make_uint2(0xFFFFFFFFu, 0xFFFFFFFFu);
        } else {
#pragma unroll 1
            for (int pass = 0; pass < 3; ++pass) {
                if (pass == 1) { if (!sAny[0]) continue; __syncthreads(); for (int i = tid; i < 32 * 512 / 4; i += NTHR) ((u32x4*)sHist)[i] = (u32x4){0u, 0u, 0u, 0u}; __syncthreads(); }
                SelQ sq; sq.lo1 = sLo1[qloc]; sq.sc1 = sSc1[qloc]; sq.lo2 = sLo2[qloc]; sq.sc2 = sSc2[qloc]; sq.b1 = sB1[qloc]; sq.b2 = sB2[qloc]; sq.ref = sRef[qloc]; sq.tau = 0.f; sq.tidx = 0;
                sel_pass(pass, qf, wp, sq, kib, c, kp, qloc, fr, fq, sHist, sCand, sCnt, maskrow);
                asm volatile("s_waitcnt vmcnt(0)" ::: "memory");
                __syncthreads();
                if (pass < 2) {
                    for (int qq = wave * 4; qq < wave * 4 + 4; ++qq) if (pass == 0 || sRef[qq]) { int bs; unsigned nn, cn; sel_scan(sHist + qq * 512, sNeed[qq], lane, bs, nn, cn);
                        if (lane == 0) { sNeed[qq] = nn; if (pass == 0) { sB1[qq] = bs; if (cn > (unsigned)SEL_CAP) { sRef[qq] = 1; sLo2[qq] = sLo1[qq] + (float)bs / sSc1[qq]; sSc2[qq] = sSc1[qq] * 1024.f; sAny[0] = 1; } } else sB2[qq] = bs; } }
                    __syncthreads(); }
            }
            unsigned* sOff = (unsigned*)sAny + 4;
            if (tid < 64) { unsigned n = 0u; if (tid < 32) n = sCnt[tid] < (unsigned)SEL_CAP ? sCnt[tid] : (unsigned)SEL_CAP; unsigned inc = n;
#pragma unroll
                for (int o = 1; o < 32; o <<= 1) { const unsigned t2 = __shfl_up(inc, o); if (lane >= o) inc += t2; }
                if (tid < 32) { sOff[tid] = inc - n; if (tid == 31) sOff[32] = inc; } }
            __syncthreads();
            { const unsigned total = sOff[32];
              for (unsigned p = tid; p < total; p += NTHR) { int qq = 0;
#pragma unroll
                  for (int st = 16; st >= 1; st >>= 1) if (sOff[qq + st] <= p) qq += st;
                  const unsigned i = p - sOff[qq], n = sOff[qq + 1] - sOff[qq], want = sNeed[qq] - 1u;
                  const float si = __uint_as_float(sCand[(qq * SEL_CAP + i) * 2]); const unsigned ki = sCand[(qq * SEL_CAP + i) * 2 + 1]; unsigned rank = 0u;
                  for (unsigned j = 0; j < n; ++j) { const float sj = __uint_as_float(sCand[(qq * SEL_CAP + j) * 2]); const unsigned kj = sCand[(qq * SEL_CAP + j) * 2 + 1]; rank += (sj > si || (sj == si && kj < ki)) ? 1u : 0u; }
                  if (rank <= want) atomicOr(MASKB + (mq + qq) * 256 + (ki >> 5), 1u << (ki & 31u)); } }
        }
      }
    }
}

__device__ __forceinline__ void ph_attn(const Args& a, unsigned char* lds, int wv) {
    unsigned char* ws = oport(a.ws);
    const int tid = otid(wv), lane = tid & 63, wave = __builtin_amdgcn_readfirstlane(tid >> 6), g4 = wave & 3, par = wave >> 2, fr = lane & 15, fq = lane >> 4;
    const bf16_t* QR = (const bf16_t*)(ws + WS_QR); const bf16_t* KR = (const bf16_t*)(ws + WS_KR); const bf16_t* VT = (const bf16_t*)(ws + WS_VT); const unsigned* MASKB = (const unsigned*)(ws + WS_MASK);
    bf16_t* YC = (bf16_t*)(ws + WS_YALL) + (size_t)2 * M * 512;
    bf16_t* Kt = (bf16_t*)lds;
    bf16_t* Vt = Kt + 2 * 64 * 136;
    float* sMrg = (float*)lds;
    for (int pi = blockIdx.x; pi < 256; pi += gridDim.x) {
#pragma unroll 1
      for (int which = 0; which < 2; ++which) {
        const int bh = pi & 7, b = bh >> 2, h = bh & 3, cc = pi >> 3, qb = which ? cc : 63 - cc;
        const size_t m0 = (size_t)b * SEQ + 128 * qb + 32 * g4;
        const int mych = 2 * qb + (g4 >> 1);
        bf16x8 qf[2][4];
#pragma unroll
        for (int cg = 0; cg < 2; ++cg)
#pragma unroll
            for (int ks = 0; ks < 4; ++ks) qf[cg][ks] = *(const bf16x8*)(QR + (m0 + 16 * cg + fr) * 512 + h * 128 + 32 * ks + 8 * fq);
        f32x4 O[2][8], Lacc[2]; float mrun[2];
        const bf16x8 xones = (fr == 0) ? (bf16x8){0x3f80, 0x3f80, 0x3f80, 0x3f80, 0x3f80, 0x3f80, 0x3f80, 0x3f80} : (bf16x8){0, 0, 0, 0, 0, 0, 0, 0};
#pragma unroll
        for (int cg = 0; cg < 2; ++cg) { mrun[cg] = 0.f; Lacc[cg] = (f32x4){0.f, 0.f, 0.f, 0.f};
#pragma unroll
            for (int vt = 0; vt < 8; ++vt) O[cg][vt] = (f32x4){0.f, 0.f, 0.f, 0.f}; }
        const bf16_t* kbase = KR + (size_t)b * SEQ * 512 + h * 128; const bf16_t* vbase = VT + (size_t)(b * 512 + h * 128) * SEQ;
        unsigned doff[9];
#pragma unroll
        for (int k = 0; k < 9; ++k) { const int i_ = wave + NWAVE * k, slot = 64 * i_ + lane;
            if (slot < 2176) { const int tl = slot >= 1088 ? 1 : 0, rs = slot - 1088 * tl, row = rs / 17, seg = rs - 17 * row; doff[k] = (unsigned)((64 * tl + row) * 512 + ((seg < 16) ? (seg ^ ((row & 16) >> 2)) : 0) * 8); }
            else { const int s2 = slot - 2176, tl = s2 >= 1152 ? 1 : 0, rs = s2 - 1152 * tl, row = rs / 9, seg = rs - 9 * row; doff[k] = (unsigned)(row * SEQ + 64 * tl + (seg & 7) * 8); } }
#define ATT_DMA(jj, buf) do { const bf16_t* kb_ = kbase + (size_t)(jj) * 128 * 512; const bf16_t* vb_ = vbase + (size_t)(jj) * 128; \
            _Pragma("unroll") for (int k = 0; k < 9; ++k) { const int i_ = wave + NWAVE * k; if (i_ < 70) { const bf16_t* src = (i_ < 34 ? kb_ : vb_) + doff[k]; \
                __builtin_amdgcn_global_load_lds((const unsigned*)src, (LAS unsigned*)(LAS unsigned char*)(lds + (buf) * 71680 + i_ * 1024), 16, 0, 0); } } } while (0)
        __syncthreads();
        ATT_DMA(0, 0);
        asm volatile("s_waitcnt vmcnt(0)" ::: "memory");
        __syncthreads();
        for (int j = 0; j <= qb; ++j) {
            if (j < qb) ATT_DMA(j + 1, (j + 1) & 1);
            const bf16_t* Ktb = Kt + (j & 1) * 35840; const bf16_t* Vtb = Vt + (j & 1) * 35840;
            const int T = 2 * j + par;
            if (T <= mych) {
                const bf16_t* kt = Ktb + par * 64 * 136; const bf16_t* vtl = Vtb + par * 128 * 72;
                uint2 mw[2];
#pragma unroll
                for (int cg = 0; cg < 2; ++cg) mw[cg] = *(const uint2*)(MASKB + (m0 + 16 * cg + fr) * 256 + 2 * T);
                f32x4 S[2][4];
#pragma unroll
                for (int rg = 0; rg < 4; ++rg) { S[0][rg] = (f32x4){-mrun[0], -mrun[0], -mrun[0], -mrun[0]}; S[1][rg] = (f32x4){-mrun[1], -mrun[1], -mrun[1], -mrun[1]};
                    const int krow = 32 * (rg >> 1) + 8 * (fr >> 2) + 4 * (rg & 1) + (fr & 3);
#pragma unroll
                    for (int ks = 0; ks < 4; ++ks) { const bf16x8 kf = *(const bf16x8*)(kt + krow * 136 + ((4 * ks + fq) ^ ((krow & 16) >> 2)) * 8);
                        S[0][rg] = __builtin_amdgcn_mfma_f32_16x16x32_bf16(kf, qf[0][ks], S[0][rg], 0, 0, 0); S[1][rg] = __builtin_amdgcn_mfma_f32_16x16x32_bf16(kf, qf[1][ks], S[1][rg], 0, 0, 0); } }
                bf16x8 pf[2][2];
#pragma unroll
                for (int cg = 0; cg < 2; ++cg) {
                    float mx = fmaxf(fmaxf(fmaxf(S[cg][0][0], S[cg][0][1]), fmaxf(S[cg][0][2], S[cg][0][3])), fmaxf(fmaxf(S[cg][1][0], S[cg][1][1]), fmaxf(S[cg][1][2], S[cg][1][3])));
                    mx = fmaxf(mx, fmaxf(fmaxf(fmaxf(S[cg][2][0], S[cg][2][1]), fmaxf(S[cg][2][2], S[cg][2][3])), fmaxf(fmaxf(S[cg][3][0], S[cg][3][1]), fmaxf(S[cg][3][2], S[cg][3][3]))));
                    mx = fmaxf(mx, __shfl_xor(mx, 16)); mx = fmaxf(mx, __shfl_xor(mx, 32));
                    const float dlt = fmaxf(mx, 0.f);
                    const int m16 = (int)(((mw[cg].x >> (8 * fq)) & 0xFFu) | (((mw[cg].y >> (8 * fq)) & 0xFFu) << 8));
                    if (__builtin_amdgcn_ballot_w64(dlt != 0.f) != 0ull) {
                        mrun[cg] += dlt; const float alpha = __builtin_amdgcn_exp2f(-dlt);
#pragma unroll
                        for (int rg = 0; rg < 4; ++rg)
#pragma unroll
                            for (int r = 0; r < 4; ++r) S[cg][rg][r] -= dlt;
#pragma unroll
                        for (int vt = 0; vt < 8; ++vt) O[cg][vt] = O[cg][vt] * alpha;
                        Lacc[cg] = Lacc[cg] * alpha; }
#pragma unroll
                    for (int rg = 0; rg < 4; ++rg)
#pragma unroll
                        for (int r = 0; r < 4; ++r) S[cg][rg][r] = __int_as_float(__float_as_int(__builtin_amdgcn_exp2f(S[cg][rg][r])) & __builtin_amdgcn_sbfe(m16, 4 * rg + r, 1));
#pragma unroll
                    for (int k2 = 0; k2 < 2; ++k2) { const u32x4 w = {pg8::cvt_pk_bf16(S[cg][2 * k2][0], S[cg][2 * k2][1]), pg8::cvt_pk_bf16(S[cg][2 * k2][2], S[cg][2 * k2][3]), pg8::cvt_pk_bf16(S[cg][2 * k2 + 1][0], S[cg][2 * k2 + 1][1]), pg8::cvt_pk_bf16(S[cg][2 * k2 + 1][2], S[cg][2 * k2 + 1][3])};
                        pf[cg][k2] = __builtin_bit_cast(bf16x8, w); }
                    Lacc[cg] = __builtin_amdgcn_mfma_f32_16x16x32_bf16(xones, pf[cg][0], Lacc[cg], 0, 0, 0); Lacc[cg] = __builtin_amdgcn_mfma_f32_16x16x32_bf16(xones, pf[cg][1], Lacc[cg], 0, 0, 0);
                }
#pragma unroll
                for (int vt = 0; vt < 8; ++vt)
#pragma unroll
                    for (int k2 = 0; k2 < 2; ++k2) { const bf16x8 vf = *(const bf16x8*)(vtl + (16 * vt + fr) * 72 + 32 * k2 + 8 * fq);
                        O[0][vt] = __builtin_amdgcn_mfma_f32_16x16x32_bf16(vf, pf[0][k2], O[0][vt], 0, 0, 0); O[1][vt] = __builtin_amdgcn_mfma_f32_16x16x32_bf16(vf, pf[1][k2], O[1][vt], 0, 0, 0); }
            }
            asm volatile("s_waitcnt vmcnt(0)" ::: "memory");
            __syncthreads();
        }
#undef ATT_DMA
        const float lrun[2] = {Lacc[0][0], Lacc[1][0]};
        float* mb = sMrg + (size_t)g4 * 68 * 64 + lane;
        if (par == 1) {
#pragma unroll
            for (int cg = 0; cg < 2; ++cg) { mb[(cg * 2 + 0) * 64] = mrun[cg]; mb[(cg * 2 + 1) * 64] = lrun[cg];
#pragma unroll
                for (int vt = 0; vt < 8; ++vt)
#pragma unroll
                    for (int r = 0; r < 4; ++r) mb[(4 + (cg * 8 + vt) * 4 + r) * 64] = O[cg][vt][r]; } }
        __syncthreads();
        if (par == 0) {
#pragma unroll
            for (int cg = 0; cg < 2; ++cg) { const float m1 = mb[(cg * 2 + 0) * 64], l1 = mb[(cg * 2 + 1) * 64]; const float mm = fmaxf(mrun[cg], m1), a0 = __builtin_amdgcn_exp2f(mrun[cg] - mm), a1 = __builtin_amdgcn_exp2f(m1 - mm);
                float lt = lrun[cg] * a0 + l1 * a1; lt += __shfl_xor(lt, 16); lt += __shfl_xor(lt, 32); const float inv = 1.f / lt;
#pragma unroll
                for (int vt = 0; vt < 8; ++vt) { float o[4];
#pragma unroll
                    for (int r = 0; r < 4; ++r) o[r] = (O[cg][vt][r] * a0 + mb[(4 + (cg * 8 + vt) * 4 + r) * 64] * a1) * inv;
                    *(unsigned long long*)(YC + (m0 + 16 * cg + fr) * 512 + h * 128 + 16 * vt + 4 * fq) = (unsigned long long)pk2(o[0], o[1]) | ((unsigned long long)pk2(o[2], o[3]) << 32); } } }
      }
    }
}
__device__ __forceinline__ void ph_norm2(const Args& a, int l, int wv) {
    const int tid = otid(wv), lane = tid & 63, gw = blockIdx.x * NWAVE + (tid >> 6), ngw = gridDim.x * NWAVE;
    unsigned char* ws = oport(a.ws);
#pragma unroll 2
    for (int m = gw; m < M; m += ngw) rms_row_to_bf16(a.out + (size_t)m * D, a.norm2 + l * D, (bf16_t*)(ws + WS_H16) + (size_t)m * D, lane);
    { const f32x4* U = (const f32x4*)(a.peer_u + (size_t)l * NEXP * D); const f32x4* V = (const f32x4*)(a.peer_v + (size_t)l * NEXP * D); u32x4* U8 = (u32x4*)(ws + WS_U16); u32x4* V8 = (u32x4*)(ws + WS_V16);
#pragma unroll 2
      for (size_t i = (size_t)blockIdx.x * NTHR + tid; i < (size_t)NEXP * D / 16; i += (size_t)gridDim.x * NTHR) { u32x4 ou, ov; unsigned* pu = (unsigned*)&ou; unsigned* pv = (unsigned*)&ov;
#pragma unroll
          for (int q = 0; q < 4; ++q) { const f32x4 u = U[4 * i + q] * 256.f, v = V[4 * i + q] * 64.f; int wu = 0, wvv = 0;
              wu = __builtin_amdgcn_cvt_pk_fp8_f32(u.x, u.y, wu, false); wu = __builtin_amdgcn_cvt_pk_fp8_f32(u.z, u.w, wu, true); wvv = __builtin_amdgcn_cvt_pk_fp8_f32(v.x, v.y, wvv, false); wvv = __builtin_amdgcn_cvt_pk_fp8_f32(v.z, v.w, wvv, true);
              pu[q] = (unsigned)wu; pv[q] = (unsigned)wvv; }
          U8[i] = ou; V8[i] = ov; } }
}
#define CE_(a_, b_) do { const float hi_ = fmaxf(a_, b_), lo_ = fminf(a_, b_); a_ = hi_; b_ = lo_; } while (0)
#define SORT16D(x) do { CE_(x[0], x[1]); CE_(x[3], x[2]); CE_(x[4], x[5]); CE_(x[7], x[6]); CE_(x[8], x[9]); CE_(x[11], x[10]); CE_(x[12], x[13]); CE_(x[15], x[14]); CE_(x[0], x[2]); CE_(x[1], x[3]); CE_(x[6], x[4]); CE_(x[7], x[5]); CE_(x[8], x[10]); CE_(x[9], x[11]); CE_(x[14], x[12]); CE_(x[15], x[13]); CE_(x[0], x[1]); CE_(x[2], x[3]); CE_(x[5], x[4]); CE_(x[7], x[6]); CE_(x[8], x[9]); CE_(x[10], x[11]); CE_(x[13], x[12]); CE_(x[15], x[14]); CE_(x[0], x[4]); CE_(x[1], x[5]); CE_(x[2], x[6]); CE_(x[3], x[7]); CE_(x[12], x[8]); CE_(x[13], x[9]); CE_(x[14], x[10]); CE_(x[15], x[11]); CE_(x[0], x[2]); CE_(x[1], x[3]); CE_(x[4], x[6]); CE_(x[5], x[7]); CE_(x[10], x[8]); CE_(x[11], x[9]); CE_(x[14], x[12]); CE_(x[15], x[13]); CE_(x[0], x[1]); CE_(x[2], x[3]); CE_(x[4], x[5]); CE_(x[6], x[7]); CE_(x[9], x[8]); CE_(x[11], x[10]); CE_(x[13], x[12]); CE_(x[15], x[14]); CE_(x[0], x[8]); CE_(x[1], x[9]); CE_(x[2], x[10]); CE_(x[3], x[11]); CE_(x[4], x[12]); CE_(x[5], x[13]); CE_(x[6], x[14]); CE_(x[7], x[15]); CE_(x[0], x[4]); CE_(x[1], x[5]); CE_(x[2], x[6]); CE_(x[3], x[7]); CE_(x[8], x[12]); CE_(x[9], x[13]); CE_(x[10], x[14]); CE_(x[11], x[15]); CE_(x[0], x[2]); CE_(x[1], x[3]); CE_(x[4], x[6]); CE_(x[5], x[7]); CE_(x[8], x[10]); CE_(x[9], x[11]); CE_(x[12], x[14]); CE_(x[13], x[15]); CE_(x[0], x[1]); CE_(x[2], x[3]); CE_(x[4], x[5]); CE_(x[6], x[7]); CE_(x[8], x[9]); CE_(x[10], x[11]); CE_(x[12], x[13]); CE_(x[14], x[15]); } while (0)
#define MERGE16D(x) do { CE_(x[0], x[8]); CE_(x[1], x[9]); CE_(x[2], x[10]); CE_(x[3], x[11]); CE_(x[4], x[12]); CE_(x[5], x[13]); CE_(x[6], x[14]); CE_(x[7], x[15]); CE_(x[0], x[4]); CE_(x[1], x[5]); CE_(x[2], x[6]); CE_(x[3], x[7]); CE_(x[8], x[12]); CE_(x[9], x[13]); CE_(x[10], x[14]); CE_(x[11], x[15]); CE_(x[0], x[2]); CE_(x[1], x[3]); CE_(x[4], x[6]); CE_(x[5], x[7]); CE_(x[8], x[10]); CE_(x[9], x[11]); CE_(x[12], x[14]); CE_(x[13], x[15]); CE_(x[0], x[1]); CE_(x[2], x[3]); CE_(x[4], x[5]); CE_(x[6], x[7]); CE_(x[8], x[9]); CE_(x[10], x[11]); CE_(x[12], x[13]); CE_(x[14], x[15]); } while (0)
__device__ __forceinline__ float pkf(float v, unsigned tag) { return __uint_as_float((__float_as_uint(v) & 0xFFFFFF00u) | tag); }
__device__ __forceinline__ void ph_peer_select(const Args& a, int l, unsigned char* lds, int wv, int nunits, int pm0, int pn0, int pm1, int pn1) {
    unsigned char* ws = oport(a.ws); const int tid = otid(wv), lane = tid & 63, wave = __builtin_amdgcn_readfirstlane(tid >> 6), fr = lane & 15, fq = lane >> 4;
    bf16_t* sK = (bf16_t*)lds;
    int* sI = (int*)(lds + 69632 + wave * 2048);
    const bf16_t* QRY = (const bf16_t*)(ws + WS_GB); const bf16_t* SKB = (const bf16_t*)(ws + WS_SKB) + (size_t)l * 16 * 128 * 128; int* EID = (int*)(ws + WS_EID); float* EG = (float*)(ws + WS_EG);
  for (int uu = 0; uu < nunits; ++uu) { const int h = uu == 0 ? pn0 : pn1, pmu = uu == 0 ? pm0 : pm1;
    __syncthreads();
    { const u32x4* src = (const u32x4*)(SKB + (size_t)h * 2 * 128 * 128);
#pragma unroll
      for (int n = 0; n < 8; ++n) { const int idx = tid + NTHR * n, row = idx >> 4, seg = idx & 15; *(u32x4*)(sK + row * 136 + seg * 8) = src[idx]; } }
    __syncthreads();
    for (int it = wave; it < 16; it += NWAVE) { const int tg = pmu * 16 + it; const size_t m = (size_t)tg * 16 + fr;
        float va[16], vb[16];
#pragma unroll
        for (int p = 0; p < 2; ++p) {
            bf16x8 qf[4];
#pragma unroll
            for (int ks = 0; ks < 4; ++ks) qf[ks] = *(const bf16x8*)(QRY + m * 2048 + h * 256 + p * 128 + 32 * ks + 8 * fq);
            const bf16_t* kb = sK + (size_t)p * 128 * 136; float s0[16], s1[16];
#pragma unroll
            for (int nt = 0; nt < 8; ++nt) { f32x4 acc = {0.f, 0.f, 0.f, 0.f};
#pragma unroll
                for (int ks = 0; ks < 4; ++ks) { const bf16x8 x = *(const bf16x8*)(kb + (16 * nt + fr) * 136 + 32 * ks + 8 * fq); acc = __builtin_amdgcn_mfma_f32_16x16x32_bf16(x, qf[ks], acc, 0, 0, 0); }
#pragma unroll
                for (int r = 0; r < 4; ++r) { const float tv = __uint_as_float((__float_as_uint(acc[r]) & 0xFFFFFF80u) | (unsigned)(127 - (16 * nt + 4 * fq + r))); if (nt < 4) s0[nt * 4 + r] = tv; else s1[(nt - 4) * 4 + r] = tv; } }
            SORT16D(s0); SORT16D(s1);
            float t[16];
#pragma unroll
            for (int i = 0; i < 16; ++i) t[i] = fmaxf(s0[i], s1[15 - i]);
            MERGE16D(t);
#pragma unroll
            for (int off = 16; off <= 32; off <<= 1) { float o[16];
#pragma unroll
                for (int i = 0; i < 16; ++i) o[i] = __shfl_xor(t[15 - i], off);
#pragma unroll
                for (int i = 0; i < 16; ++i) t[i] = fmaxf(t[i], o[i]);
                MERGE16D(t); }
#pragma unroll
            for (int i = 0; i < 16; ++i) { if (p == 0) va[i] = t[i]; else vb[i] = t[i]; }
            __builtin_amdgcn_sched_barrier(0);
        }
        if (fq == 0) {
#pragma unroll
            for (int r = 0; r < 16; ++r) { sI[fr * 32 + r] = 127 - (int)(__float_as_uint(va[r]) & 127u); sI[fr * 32 + 16 + r] = 127 - (int)(__float_as_uint(vb[r]) & 127u); } }
#pragma unroll
        for (int r = 0; r < 16; ++r) { va[r] = __uint_as_float(__float_as_uint(va[r]) & 0xFFFFFF80u); vb[r] = __uint_as_float(__float_as_uint(vb[r]) & 0xFFFFFF80u); }
        float cs[16];
        {
            cs[0] = fq == 0 ? pkf(va[0] + vb[0], 255u) : fq == 1 ? pkf(va[0] + vb[1], 254u) : fq == 2 ? pkf(va[0] + vb[2], 253u) : pkf(va[0] + vb[3], 252u);
            cs[1] = fq == 0 ? pkf(va[0] + vb[4], 251u) : fq == 1 ? pkf(va[0] + vb[5], 250u) : fq == 2 ? pkf(va[0] + vb[6], 249u) : pkf(va[0] + vb[7], 248u);
            cs[2] = fq == 0 ? pkf(va[0] + vb[8], 247u) : fq == 1 ? pkf(va[0] + vb[9], 246u) : fq == 2 ? pkf(va[0] + vb[10], 245u) : pkf(va[0] + vb[11], 244u);
            cs[3] = fq == 0 ? pkf(va[0] + vb[12], 243u) : fq == 1 ? pkf(va[0] + vb[13], 242u) : fq == 2 ? pkf(va[0] + vb[14], 241u) : pkf(va[0] + vb[15], 240u);
            cs[4] = fq == 0 ? pkf(va[1] + vb[0], 239u) : fq == 1 ? pkf(va[1] + vb[1], 238u) : fq == 2 ? pkf(va[1] + vb[2], 237u) : pkf(va[1] + vb[3], 236u);
            cs[5] = fq == 0 ? pkf(va[1] + vb[4], 235u) : fq == 1 ? pkf(va[1] + vb[5], 234u) : fq == 2 ? pkf(va[1] + vb[6], 233u) : pkf(va[1] + vb[7], 232u);
            cs[6] = fq == 0 ? pkf(va[2] + vb[0], 223u) : fq == 1 ? pkf(va[2] + vb[1], 222u) : fq == 2 ? pkf(va[2] + vb[2], 221u) : pkf(va[2] + vb[3], 220u);
            cs[7] = fq == 0 ? pkf(va[2] + vb[4], 219u) : fq == 1 ? pkf(va[3] + vb[0], 207u) : fq == 2 ? pkf(va[3] + vb[1], 206u) : pkf(va[3] + vb[2], 205u);
            cs[8] = fq == 0 ? pkf(va[3] + vb[3], 204u) : fq == 1 ? pkf(va[4] + vb[0], 191u) : fq == 2 ? pkf(va[4] + vb[1], 190u) : pkf(va[4] + vb[2], 189u);
            cs[9] = fq == 0 ? pkf(va[5] + vb[0], 175u) : fq == 1 ? pkf(va[5] + vb[1], 174u) : fq == 2 ? pkf(va[6] + vb[0], 159u) : pkf(va[6] + vb[1], 158u);
            cs[10] = fq == 0 ? pkf(va[7] + vb[0], 143u) : fq == 1 ? pkf(va[7] + vb[1], 142u) : fq == 2 ? pkf(va[8] + vb[0], 127u) : pkf(va[9] + vb[0], 111u);
            cs[11] = fq == 0 ? pkf(va[10] + vb[0], 95u) : fq == 1 ? pkf(va[11] + vb[0], 79u) : fq == 2 ? pkf(va[12] + vb[0], 63u) : pkf(va[13] + vb[0], 47u);
            cs[12] = fq == 0 ? pkf(va[14] + vb[0], 31u) : fq == 1 ? pkf(va[15] + vb[0], 15u) : fq == 2 ? -INFINITY : -INFINITY;
            cs[13] = -INFINITY; cs[14] = -INFINITY; cs[15] = -INFINITY;
        }
        __builtin_amdgcn_sched_barrier(0);
        SORT16D(cs);
#pragma unroll
        for (int off = 16; off <= 32; off <<= 1) { float o[16];
#pragma unroll
            for (int i = 0; i < 16; ++i) o[i] = __shfl_xor(cs[15 - i], off);
#pragma unroll
            for (int i = 0; i < 16; ++i) cs[i] = fmaxf(cs[i], o[i]);
            MERGE16D(cs); }
        float bv[16];
#pragma unroll
        for (int i = 0; i < 16; ++i) bv[i] = cs[i];
        asm volatile("s_waitcnt lgkmcnt(0)" ::: "memory"); __builtin_amdgcn_sched_barrier(0);
        if (fq == 0) { int eid[16]; float ex[16]; float sm = 0.f; const float b0 = __uint_as_float(__float_as_uint(bv[0]) & 0xFFFFFF00u);
#pragma unroll
            for (int r = 0; r < 16; ++r) { const unsigned bits = __float_as_uint(bv[r]); const int f = 255 - (int)(bits & 255u); eid[r] = sI[fr * 32 + (f >> 4)] * 128 + sI[fr * 32 + 16 + (f & 15)];
                ex[r] = __expf(__uint_as_float(bits & 0xFFFFFF00u) - b0); sm += ex[r]; }
            const float inv = 1.f / sm; int* ep = EID + m * 128 + h * 16; float* gp = EG + m * 128 + h * 16;
#pragma unroll
            for (int r = 0; r < 16; r += 4) { *(int4*)(ep + r) = make_int4(eid[r], eid[r + 1], eid[r + 2], eid[r + 3]); *(f32x4*)(gp + r) = (f32x4){ex[r] * inv, ex[r + 1] * inv, ex[r + 2] * inv, ex[r + 3] * inv}; } }
        asm volatile("s_waitcnt lgkmcnt(0)" ::: "memory");
    }
  }
}
typedef float f32x2_t __attribute__((ext_vector_type(2)));
__device__ __forceinline__ void dec8(const u32x4 w, f32x2_t (&f)[8]) {
    const unsigned ww[4] = {w.x, w.y, w.z, w.w};
#pragma unroll
    for (int q = 0; q < 4; ++q) { f[2 * q] = __builtin_amdgcn_cvt_pk_f32_fp8((int)ww[q], false); f[2 * q + 1] = __builtin_amdgcn_cvt_pk_f32_fp8((int)ww[q], true); }
}
__device__ __forceinline__ void ph_peer_experts(const Args& a, int l, unsigned char* lds, int wv) {
    unsigned char* ws = oport(a.ws); const int tid = otid(wv), lane = tid & 63, wave = __builtin_amdgcn_readfirstlane(tid >> 6), gw = blockIdx.x * NWAVE + wave, ngw = gridDim.x * NWAVE;
    const bf16_t* H16 = (const bf16_t*)(ws + WS_H16); const int* EID = (const int*)(ws + WS_EID); const float* EG = (const float*)(ws + WS_EG);
    const unsigned char* U8 = (const unsigned char*)(ws + WS_U16); const unsigned char* V8 = (const unsigned char*)(ws + WS_V16);
    float* sPA = (float*)(lds + wave * 8192) + lane; float* sPB = sPA + 1024;
    int* sEA = (int*)(lds + 65536 + wave * 2048); float* sGA = (float*)(sEA + 128); int* sEB = sEA + 256; float* sGB = (float*)(sEB + 128);
    for (int it = 0, nit = ((M + ngw - 1) / ngw + 1) / 2; it < nit; ++it) { const int mA = gw + (2 * it) * ngw, mB = mA + ngw; const bool vA = mA < M, vB = mB < M;
        __syncthreads();
        if (!vA) continue;
        const int mBs = vB ? mB : mA;
        f32x2_t hpA[8], hpB[8], accA[8], accB[8];
#define LOADH(hp, m_) do { float hv_[16]; const u32x4 h0_ = *(const u32x4*)(H16 + (size_t)(m_) * D + lane * 16), h1_ = *(const u32x4*)(H16 + (size_t)(m_) * D + lane * 16 + 8); \
          hv_[0] = lo_bf(h0_.x); hv_[1] = hi_bf(h0_.x); hv_[2] = lo_bf(h0_.y); hv_[3] = hi_bf(h0_.y); hv_[4] = lo_bf(h0_.z); hv_[5] = hi_bf(h0_.z); hv_[6] = lo_bf(h0_.w); hv_[7] = hi_bf(h0_.w); \
          hv_[8] = lo_bf(h1_.x); hv_[9] = hi_bf(h1_.x); hv_[10] = lo_bf(h1_.y); hv_[11] = hi_bf(h1_.y); hv_[12] = lo_bf(h1_.z); hv_[13] = hi_bf(h1_.z); hv_[14] = lo_bf(h1_.w); hv_[15] = hi_bf(h1_.w); \
          _Pragma("unroll") for (int j_ = 0; j_ < 8; ++j_) hp[j_] = (f32x2_t){hv_[2 * j_], hv_[2 * j_ + 1]}; } while (0)
        LOADH(hpA, mA); LOADH(hpB, mBs);
#pragma unroll
        for (int j = 0; j < 8; ++j) { accA[j] = (f32x2_t){0.f, 0.f}; accB[j] = (f32x2_t){0.f, 0.f}; }
#define SORTTOK(m_, sE_, sG_) do { int key[2] = {EID[(size_t)(m_) * 128 + 2 * lane], EID[(size_t)(m_) * 128 + 2 * lane + 1]}; float pay[2] = {EG[(size_t)(m_) * 128 + 2 * lane], EG[(size_t)(m_) * 128 + 2 * lane + 1]}; \
          _Pragma("unroll") for (int k = 2; k <= 128; k <<= 1) _Pragma("unroll") for (int j = k >> 1; j >= 1; j >>= 1) { \
              if (j == 1) { const bool asc = ((2 * lane) & k) == 0; if ((key[0] > key[1]) == asc) { const int tk = key[0]; key[0] = key[1]; key[1] = tk; const float tp = pay[0]; pay[0] = pay[1]; pay[1] = tp; } } \
              else { const int lj = j >> 1; const bool keep_min = (((2 * lane) & k) == 0) == ((lane & lj) == 0); \
                  _Pragma("unroll") for (int r = 0; r < 2; ++r) { const int pk = __shfl_xor(key[r], lj); const float pp = __shfl_xor(pay[r], lj); const bool take = keep_min ? (pk < key[r]) : (pk > key[r]); if (take) { key[r] = pk; pay[r] = pp; } } } } \
          *(int2*)(sE_ + 2 * lane) = make_int2(key[0], key[1]); *(float2*)(sG_ + 2 * lane) = make_float2(pay[0], pay[1]); } while (0)
        SORTTOK(mA, sEA, sGA); SORTTOK(mBs, sEB, sGB);
        asm volatile("s_waitcnt lgkmcnt(0)" ::: "memory");
#pragma unroll 1
        for (int half = 0; half < 2; ++half) {
            const int pos = half * 64 + 4 * (lane & 15) + (((lane >> 4) == 1) ? 2 : ((lane >> 4) == 2) ? 1 : (lane >> 4));
            const int evA = sEA[pos], evB = sEB[pos]; const float gvA = sGA[pos], gvB = sGB[pos];
            u32x4 bufA[4], bufB[4];
#define ROWLD(dst, T, e_) dst = ((const u32x4*)(T + (size_t)(e_) * D))[lane]
#define KIDX(g, c) ((g) + ((c) == 1 ? 32 : (c) == 2 ? 16 : (c) == 3 ? 48 : 0))
#define LOADG(buf, T, ev_, g) do { _Pragma("unroll") for (int i_ = 0; i_ < 4; ++i_) ROWLD(buf[i_], T, __builtin_amdgcn_readlane(ev_, KIDX(g, i_))); } while (0)
#define BF2(a_, b_, o) (((lane & (o)) ? (b_) : (a_)) + __shfl_xor((lane & (o)) ? (a_) : (b_), (o)))
#define DOTG(buf, hp, sP_, g) do { float d4_[4]; _Pragma("unroll") for (int i_ = 0; i_ < 4; ++i_) { f32x2_t f_[8]; dec8(buf[i_], f_); f32x2_t d2_ = f_[0] * hp[0]; \
              _Pragma("unroll") for (int j_ = 1; j_ < 8; ++j_) d2_ = __builtin_elementwise_fma(f_[j_], hp[j_], d2_); d4_[i_] = d2_.x + d2_.y; } \
              const float q0_ = BF2(d4_[0], d4_[1], 32), q1_ = BF2(d4_[2], d4_[3], 32); sP_[(g) * 64] = BF2(q0_, q1_, 16); } while (0)
            LOADG(bufA, U8, evA, 0);
#pragma unroll 1
            for (int g = 0; g < 16; ++g) { const int gn = g < 15 ? g + 1 : 15;
                LOADG(bufB, U8, evB, g); DOTG(bufA, hpA, sPA, g);
                LOADG(bufA, U8, evA, gn); DOTG(bufB, hpB, sPB, g); }
            int svbA, svbB;
#define BFLY(o, n) do { const bool up_ = (lane & (o)) != 0; _Pragma("unroll") for (int i_ = 0; i_ < (n); ++i_) { const float a_ = p[i_], b_ = p[i_ + (n)]; const float sd_ = up_ ? a_ : b_, kp_ = up_ ? b_ : a_; p[i_] = kp_ + __shfl_xor(sd_, (o)); } } while (0)
#define FINISH(sP_, gv_, svb_) do { float p[16]; _Pragma("unroll") for (int i_ = 0; i_ < 16; ++i_) p[i_] = sP_[i_ * 64]; BFLY(8, 8); BFLY(4, 4); BFLY(2, 2); BFLY(1, 1); \
              svb_ = __builtin_bit_cast(int, gv_ * gelu_t(p[0] * (1.f / 256.f)) * (1.f / 64.f)); } while (0)
            FINISH(sPA, gvA, svbA); FINISH(sPB, gvB, svbB);
#define ACCG(buf, acc, svb_, g) do { _Pragma("unroll") for (int i_ = 0; i_ < 4; ++i_) { const float sk_ = __builtin_bit_cast(float, __builtin_amdgcn_readlane(svb_, KIDX(g, i_))); const f32x2_t s2_ = {sk_, sk_}; f32x2_t f_[8]; dec8(buf[i_], f_); \
              _Pragma("unroll") for (int j_ = 0; j_ < 8; ++j_) acc[j_] = __builtin_elementwise_fma(f_[j_], s2_, acc[j_]); } } while (0)
            LOADG(bufA, V8, evA, 0);
#pragma unroll 1
            for (int g = 0; g < 16; ++g) { const int gn = g < 15 ? g + 1 : 15;
                LOADG(bufB, V8, evB, g); ACCG(bufA, accA, svbA, g);
                LOADG(bufA, V8, evA, gn); ACCG(bufB, accB, svbB, g); }
#undef ROWLD
#undef KIDX
#undef LOADG
#undef BF2
#undef DOTG
#undef BFLY
#undef FINISH
#undef ACCG
        }
#define EPILOG(m_, acc2) do { float acc[16]; _Pragma("unroll") for (int j = 0; j < 8; ++j) { acc[2 * j] = acc2[j].x; acc[2 * j + 1] = acc2[j].y; } \
        float* xr = a.out + (size_t)(m_) * D + lane * 16; float xn[16]; float ss = 0.f; \
        _Pragma("unroll") for (int j = 0; j < 4; ++j) { const f32x4 xv = *(const f32x4*)(xr + 4 * j); xn[4 * j] = xv.x + acc[4 * j]; xn[4 * j + 1] = xv.y + acc[4 * j + 1]; xn[4 * j + 2] = xv.z + acc[4 * j + 2]; xn[4 * j + 3] = xv.w + acc[4 * j + 3]; } \
        _Pragma("unroll") for (int j = 0; j < 16; ++j) ss += xn[j] * xn[j]; \
        const float r = rsqrtf(wave_sum(ss) * (1.f / D) + EPS); \
        if (l + 1 < DEPTH) { const float* gn = a.norm1 + (size_t)(l + 1) * D + lane * 16; \
            _Pragma("unroll") for (int j = 0; j < 4; ++j) *(f32x4*)(xr + 4 * j) = (f32x4){xn[4 * j], xn[4 * j + 1], xn[4 * j + 2], xn[4 * j + 3]}; \
            u32x4 w0, w1; \
            w0.x = pk2(xn[0] * r * gn[0], xn[1] * r * gn[1]); w0.y = pk2(xn[2] * r * gn[2], xn[3] * r * gn[3]); w0.z = pk2(xn[4] * r * gn[4], xn[5] * r * gn[5]); w0.w = pk2(xn[6] * r * gn[6], xn[7] * r * gn[7]); \
            w1.x = pk2(xn[8] * r * gn[8], xn[9] * r * gn[9]); w1.y = pk2(xn[10] * r * gn[10], xn[11] * r * gn[11]); w1.z = pk2(xn[12] * r * gn[12], xn[13] * r * gn[13]); w1.w = pk2(xn[14] * r * gn[14], xn[15] * r * gn[15]); \
            *(u32x4*)((bf16_t*)(ws + WS_H16) + (size_t)(m_) * D + lane * 16) = w0; *(u32x4*)((bf16_t*)(ws + WS_H16) + (size_t)(m_) * D + lane * 16 + 8) = w1; \
        } else { const float* gn = a.final_gain + lane * 16; \
            _Pragma("unroll") for (int j = 0; j < 4; ++j) *(f32x4*)(xr + 4 * j) = (f32x4){xn[4 * j] * r * gn[4 * j], xn[4 * j + 1] * r * gn[4 * j + 1], xn[4 * j + 2] * r * gn[4 * j + 2], xn[4 * j + 3] * r * gn[4 * j + 3]}; } } while (0)
        EPILOG(mA, accA);
        if (vB) EPILOG(mB, accB);
#undef EPILOG
#undef LOADH
#undef SORTTOK
    }
}

constexpr int PH_PER_LAYER = 9, N_PHASES = 1 + DEPTH * PH_PER_LAYER;
__global__ void __launch_bounds__(NTHR, 2) fwd_kernel(Args a) {
    extern __shared__ __attribute__((aligned(16))) unsigned char lds[];
    const int wv = __builtin_amdgcn_readfirstlane((int)threadIdx.x >> 6);
    const int tid = threadIdx.x;
    for (int u = tid; u < (LDS_BYTES - LDS_CTL_OFF) / 4; u += NTHR) ((unsigned*)(lds + LDS_CTL_OFF))[u] = 0u;
    __syncthreads();
    unsigned* ctl = (unsigned*)(a.ws + WS_CTL);
    XcdBarrier bar = xcd_barrier_post(ctl + 4096, (volatile LAS unsigned*)(LAS unsigned char*)(lds + LDS_CTL_OFF), wv);
    const int lo = a.ph_lo, hi = a.ph_hi;
#define IN(k) (lo <= (k) && (k) < hi)
#define SEAM(k) do { if (IN(k) && IN((k) + 1)) xcd_barrier(bar, wv); } while (0)
    unsigned char* ws = oport(a.ws);
    if (IN(0)) { ph_prologue(a, lds, wv); } SEAM(0);
    for (int l = 0; l < DEPTH; ++l) {
        const int pb = 1 + l * PH_PER_LAYER;
        unsigned char* ws = oport(a.ws);
        if (IN(pb + 0)) {
            ph_kiwi(a, l, lds, wv);
            pg8::Gemm g{(const bf16_t*)(ws + WS_H16), (const bf16_t*)(ws + WS_WIN + (size_t)l * WIN_L), M, NMAIN, D, 0, 0};
            pg8::StaticOrder S; S.init(M, NMAIN, gridDim.x, blockIdx.x, 0);
            pg8::EpiIn E{(bf16_t*)(ws + WS_P16), (float*)(ws + WS_PF)};
            pg8::gemm_phase(((LAS unsigned char*)lds), g, S, E, wv);
        } SEAM(pb + 0);
        if (IN(pb + 1)) { ph_post(a, l, lds, wv); ph_h1(a, l, lds, wv); } SEAM(pb + 1);
        if (IN(pb + 2)) { ph_h2(a, wv); ph_gmlp(a, l, lds, wv); ph_sel(a, lds, wv); } SEAM(pb + 2);
        if (IN(pb + 3)) { ph_attn(a, lds, wv); ph_h3(a, l, lds, wv); } SEAM(pb + 3);
        if (IN(pb + 4)) {
            pg8::Gemm g{(const bf16_t*)(ws + WS_YALL), (const bf16_t*)(ws + WS_WBR + (size_t)l * WBR_L), M, 3072, 512, (size_t)M * 512 * 2, 4};
            pg8::BranchOrder S; S.init(gridDim.x, blockIdx.x);
            pg8::EpiGate E{(bf16_t*)(ws + WS_GB), (const bf16_t*)(ws + WS_P16)};
            pg8::gemm_phase(((LAS unsigned char*)lds), g, S, E, wv);
        } SEAM(pb + 4);
        if (IN(pb + 5)) {
            pg8::Gemm g{(const bf16_t*)(ws + WS_GB), (const bf16_t*)(ws + WS_WOUT + (size_t)l * WOUT_L), M, D, D, 0, 0};
            pg8::StaticOrder S; S.init(M, D, gridDim.x, blockIdx.x, 0);
            pg8::EpiRes E{a.out};
            pg8::gemm_phase(((LAS unsigned char*)lds), g, S, E, wv);
        } SEAM(pb + 5);
        if (IN(pb + 6)) { ph_norm2(a, l, wv); } SEAM(pb + 6);
        if (IN(pb + 7)) {
            pg8::Gemm g{(const bf16_t*)(ws + WS_H16), (const bf16_t*)(ws + WS_WPQ + (size_t)l * WPQ_L), M, 2048, D, 0, 0};
            pg8::StaticOrder S; S.init(M, 2048, gridDim.x, blockIdx.x, 0);
            pg8::EpiB16 E{(bf16_t*)(ws + WS_GB), 2048};
            pg8::gemm_phase(((LAS unsigned char*)lds), g, S, E, wv);
            asm volatile("s_waitcnt vmcnt(0)" ::: "memory"); __syncthreads();
            for (int i0_ = 0;; i0_ += 2) { pg8::Unit u0, u1; if (!S.next(i0_, u0)) break; const bool two = S.next(i0_ + 1, u1);
                ph_peer_select(a, l, lds, wv, two ? 2 : 1, u0.pm, u0.pn, two ? u1.pm : 0, two ? u1.pn : 0); }
        } SEAM(pb + 7);
        if (IN(pb + 8)) { ph_peer_experts(a, l, lds, wv); } SEAM(pb + 8);
    }
#undef IN
#undef SEAM
}

#ifndef MK_N_LAUNCHES
#define MK_N_LAUNCHES 1
#endif
extern "C" void kernel_launch(void* const* d_in, const int* in_sizes, int n_in, void* d_out, int out_size, void* d_ws, size_t ws_size, hipStream_t stream) {
    static int grid = 0;
    if (grid == 0) {
        if (n_in != 17 || out_size != M * D || ws_size < WS_END) { fprintf(stderr, "kernel_launch: unexpected shapes (n_in %d, out %d, ws %zu)\n", n_in, out_size, ws_size); grid = -1; return; }
        int dev = 0, cus = 0, per_cu = 0;
        if (hipGetDevice(&dev) != hipSuccess || hipDeviceGetAttribute(&cus, hipDeviceAttributeMultiprocessorCount, dev) != hipSuccess) { grid = -1; return; }
        if (hipFuncSetAttribute((const void*)fwd_kernel, hipFuncAttributeMaxDynamicSharedMemorySize, LDS_BYTES) != hipSuccess) { fprintf(stderr, "kernel_launch: hipFuncSetAttribute failed\n"); grid = -1; return; }
        if (hipOccupancyMaxActiveBlocksPerMultiprocessor(&per_cu, (const void*)fwd_kernel, NTHR, LDS_BYTES) != hipSuccess || per_cu < 1) { fprintf(stderr, "kernel_launch: occupancy query says %d\n", per_cu); (void)hipGetLastError(); grid = -1; return; }
        grid = cus;
    }
    if (grid < 0) return;
    (void)hipMemsetAsync((char*)d_ws + WS_CTL, 0, CTL_BYTES, stream);
    Args a{};
    a.x = (const float*)d_in[0]; a.pos = (const int*)d_in[1]; a.norm1 = (const float*)d_in[2]; a.w_in = (const float*)d_in[3]; a.lb_logits = (const float*)d_in[4]; a.hgrn_gain = (const float*)d_in[5];
    a.gmlp_gain = (const float*)d_in[6]; a.gmlp_ws = (const float*)d_in[7]; a.gmlp_bs = (const float*)d_in[8]; a.w_branch = (const float*)d_in[9]; a.w_out = (const float*)d_in[10]; a.norm2 = (const float*)d_in[11];
    a.peer_wq = (const float*)d_in[12]; a.peer_keys = (const float*)d_in[13]; a.peer_u = (const float*)d_in[14]; a.peer_v = (const float*)d_in[15]; a.final_gain = (const float*)d_in[16];
    a.out = (float*)d_out; a.ws = (unsigned char*)d_ws;
    if (MK_N_LAUNCHES == 1) { a.ph_lo = 0; a.ph_hi = N_PHASES; hipLaunchKernelGGL(fwd_kernel, dim3(grid), dim3(NTHR), LDS_BYTES, stream, a); }
    else for (int p = 0; p < N_PHASES; ++p) { a.ph_lo = p; a.ph_hi = p + 1; hipLaunchKernelGGL(fwd_kernel, dim3(grid), dim3(NTHR), LDS_BYTES, stream, a); }
}
```

```cpp
#include <hip/hip_runtime.h>
#include <cstdio>
#include <cstdint>

#define LAS __attribute__((address_space(3)))
typedef unsigned short bf16_t;
typedef short bf16x8 __attribute__((ext_vector_type(8)));
typedef float f32x4 __attribute__((ext_vector_type(4)));
typedef unsigned u32x4 __attribute__((ext_vector_type(4)));

constexpr int D = 1024, BATCH = 2, SEQ = 8192, DEPTH = 4, M = BATCH * SEQ;
constexpr int NIN = 8264;
constexpr int NPAD = 8448;
constexpr int C_AQ = 0, C_AF = 512, C_AI = 1024, C_AG = 1536, C_BU = 2048, C_BV = 2560, C_CQ = 3072, C_CK = 3584, C_CV = 4096, C_QI = 4608, C_GL = 5120, C_KI = 8192, C_WI = 8256;
constexpr int NMAIN = 8192;
constexpr int S_GL = 5192;
constexpr int PFW = 768;
constexpr float EPS = 1e-6f;
constexpr int NEXP = 16384;

constexpr size_t MiB = 1u << 20;
constexpr size_t WS_CTL = 0, CTL_BYTES = 1 * MiB;
constexpr size_t WS_WIN = 2 * MiB;
constexpr size_t WIN_L = (size_t)NPAD * D * 2;
constexpr size_t WS_WBR = 68 * MiB;
constexpr size_t WBR_L = (size_t)3072 * 512 * 2;
constexpr size_t WS_WOUT = 80 * MiB;
constexpr size_t WOUT_L = (size_t)1024 * 3072 * 2;
constexpr size_t WS_WPQ = 104 * MiB;
constexpr size_t WPQ_L = (size_t)2048 * 1024 * 2;
constexpr size_t WS_LB = 120 * MiB;
constexpr size_t WS_CS = 121 * MiB;
constexpr size_t WS_H16 = 134 * MiB;
constexpr size_t WS_P16 = 166 * MiB;
constexpr size_t WS_PF = 430 * MiB;
constexpr size_t WS_QR = 478 * MiB, WS_KR = 494 * MiB;
constexpr size_t WS_QI = 510 * MiB;
constexpr size_t WS_KI = 542 * MiB;
constexpr size_t WS_WI = 546 * MiB;
constexpr size_t WS_FF = 548 * MiB, WS_KK = 580 * MiB, WS_QF = 612 * MiB;
constexpr size_t WS_OA = 644 * MiB;
constexpr size_t WS_VN = 676 * MiB;
constexpr size_t WS_YALL = 708 * MiB;
constexpr size_t WS_GB = 756 * MiB;
constexpr size_t WS_EID = 852 * MiB, WS_EG = 860 * MiB;
constexpr size_t WS_DD = 120 * MiB + 256 * 1024;
constexpr size_t WS_WSB = 544 * MiB;
constexpr size_t WS_VT = 644 * MiB;
constexpr size_t WS_MASK = 660 * MiB;
constexpr size_t WS_U16 = 868 * MiB, WS_V16 = 900 * MiB;
constexpr size_t WS_SKB = 932 * MiB;
constexpr size_t WS_END = 934 * MiB;

__device__ const float ROPE_INV64[64] = {
1.000000000e+00f, 8.659643531e-01f, 7.498942614e-01f, 6.493816376e-01f, 5.623413324e-01f, 4.869675338e-01f, 4.216965139e-01f, 3.651741147e-01f, 3.162277639e-01f, 2.738419771e-01f, 2.371373773e-01f, 2.053525001e-01f, 1.778279394e-01f, 1.539926529e-01f, 1.333521307e-01f, 1.154782027e-01f, 1.000000015e-01f, 8.659642935e-02f, 7.498941571e-02f, 6.493816525e-02f, 5.623413250e-02f, 4.869675264e-02f, 4.216965288e-02f, 3.651741147e-02f, 3.162277490e-02f, 2.738419734e-02f, 2.371373773e-02f, 2.053525113e-02f, 1.778279431e-02f, 1.539926510e-02f, 1.333521493e-02f, 1.154782064e-02f, 9.999999776e-03f, 8.659643121e-03f, 7.498941850e-03f, 6.493816152e-03f, 5.623413250e-03f, 4.869675264e-03f, 4.216964822e-03f, 3.651741194e-03f, 3.162277630e-03f, 2.738419687e-03f, 2.371373586e-03f, 2.053524833e-03f, 1.778279431e-03f, 1.539926510e-03f, 1.333521446e-03f, 1.154781901e-03f, 1.000000047e-03f, 8.659643354e-04f, 7.498942432e-04f, 6.493816618e-04f, 5.623413017e-04f, 4.869675322e-04f, 4.216965172e-04f, 3.651741426e-04f, 3.162277571e-04f, 2.738419571e-04f, 2.371373703e-04f, 2.053525095e-04f, 1.778279402e-04f, 1.539926452e-04f, 1.333521504e-04f, 1.154782003e-04f};
__device__ const float ROPE_INV32[32] = {
1.000000000e+00f, 7.498942614e-01f, 5.623413324e-01f, 4.216965139e-01f, 3.162277639e-01f, 2.371373773e-01f, 1.778279394e-01f, 1.333521307e-01f, 1.000000015e-01f, 7.498941571e-02f, 5.623413250e-02f, 4.216965288e-02f, 3.162277490e-02f, 2.371373773e-02f, 1.778279431e-02f, 1.333521493e-02f, 9.999999776e-03f, 7.498941850e-03f, 5.623413250e-03f, 4.216964822e-03f, 3.162277630e-03f, 2.371373586e-03f, 1.778279431e-03f, 1.333521446e-03f, 1.000000047e-03f, 7.498942432e-04f, 5.623413017e-04f, 4.216965172e-04f, 3.162277571e-04f, 2.371373703e-04f, 1.778279402e-04f, 1.333521504e-04f};

__device__ __forceinline__ float bf2f(bf16_t b) { return __uint_as_float(((unsigned)b) << 16); }
__device__ __forceinline__ unsigned f2bf(float f) { unsigned u = __float_as_uint(f); return (u + 0x7fffu + ((u >> 16) & 1u)) >> 16; }
__device__ __forceinline__ unsigned pk2(float lo, float hi) { return f2bf(lo) | (f2bf(hi) << 16); }
__device__ __forceinline__ float lo_bf(unsigned w) { return __uint_as_float(w << 16); }
__device__ __forceinline__ float hi_bf(unsigned w) { return __uint_as_float(w & 0xffff0000u); }
__device__ __forceinline__ float sigm(float x) { return 1.f / (1.f + __expf(-x)); }
__device__ __forceinline__ float silu(float x) { return x * sigm(x); }
__device__ __forceinline__ float gelu_t(float x) { const float u = 0.7978845608028654f * (x + 0.044715f * x * x * x); const float th = 1.f - 2.f / (1.f + __expf(2.f * u)); return 0.5f * x * (1.f + th); }
__device__ __forceinline__ float wave_sum(float v) {
#pragma unroll
    for (int o = 1; o < 64; o <<= 1) v += __shfl_xor(v, o);
    return v;
}
__device__ __forceinline__ float wave_max(float v) {
#pragma unroll
    for (int o = 1; o < 64; o <<= 1) v = fmaxf(v, __shfl_xor(v, o));
    return v;
}
typedef __bf16 bf2_t __attribute__((ext_vector_type(2)));
__device__ __forceinline__ float dot2(unsigned a, unsigned b, float c) { return __builtin_amdgcn_fdot2_f32_bf16(__builtin_bit_cast(bf2_t, a), __builtin_bit_cast(bf2_t, b), c, false); }
__device__ __forceinline__ int otid(int wv) { int t; asm volatile("v_mbcnt_lo_u32_b32 %0, -1, 0\n\tv_mbcnt_hi_u32_b32 %0, -1, %0" : "=v"(t)); return wv * 64 + t; }
__device__ __forceinline__ unsigned char* oport(unsigned char* p) { unsigned long long z; asm volatile("s_mov_b64 %0, 0" : "=s"(z)); return p + z; }
__device__ __forceinline__ unsigned fkey(float f) { const unsigned u = __float_as_uint(f); return u ^ ((u >> 31) ? 0xFFFFFFFFu : 0x80000000u); }

#define XB_TMO      128
#define XB_XCNT(j)  (256  + 64 * (j))
#define XB_XSUB(j)  (1280 + 64 * (j))
#define XB_XGEN(j)  (2304 + 64 * (j))
#define XB_TOP      3328
#define XB_TOPGEN   3392
#define XCD_BAR_WORDS 3456
#define XB_SPIN_CAP (1u << 23)
__device__ __forceinline__ unsigned xb_ld(unsigned* p)              { return __hip_atomic_load(p, __ATOMIC_RELAXED, __HIP_MEMORY_SCOPE_AGENT); }
__device__ __forceinline__ unsigned xb_add(unsigned* p, unsigned v) { return __hip_atomic_fetch_add(p, v, __ATOMIC_RELAXED, __HIP_MEMORY_SCOPE_AGENT); }
__device__ __forceinline__ unsigned xb_xcc_id() { return (unsigned)__builtin_amdgcn_s_getreg((3 << 11) | 20) & 0xFu; }
#define XB_SPIN(cond, bar) do { unsigned _sp = 0; while (cond) { __builtin_amdgcn_s_sleep(1); \
    if ((++_sp & 255u) == 0u) { if (xb_ld(&(bar)[XB_TMO])) break; if (_sp > XB_SPIN_CAP) { atomicAdd(&(bar)[XB_TMO], 1u); break; } } } } while (0)
struct XcdBarrier { unsigned* bar; unsigned x; volatile LAS unsigned* st; };
__device__ __forceinline__ XcdBarrier xcd_barrier_post(unsigned* bar, volatile LAS unsigned* st, int wv) {
    XcdBarrier b; b.bar = bar; b.x = xb_xcc_id(); b.st = st;
    if (wv == 0) if ((otid(0) & 63) == 0) (void)xb_add(&bar[XB_XCNT(b.x)], 1u);
    return b;
}
__device__ __forceinline__ void xcd_barrier_complete(unsigned* bar, unsigned x, unsigned& nloc, unsigned& nx) {
    const unsigned G = gridDim.x * gridDim.y * gridDim.z;
    unsigned sum, cnt, mine, sp = 0u;
    for (;;) {
        sum = 0u; cnt = 0u; mine = 0u;
#pragma unroll
        for (unsigned j = 0; j < 16; ++j) { const unsigned c = xb_ld(&bar[XB_XCNT(j)]); sum += c; cnt += (c > 0u) ? 1u : 0u; mine = (j == x) ? c : mine; }
        if (sum == G) break;
        __builtin_amdgcn_s_sleep(1);
        if ((++sp & 255u) == 0u) { if (xb_ld(&bar[XB_TMO])) break; if (sp > XB_SPIN_CAP) { atomicAdd(&bar[XB_TMO], 1u); break; } }
    }
    nloc = mine > 0u ? mine : 1u; nx = cnt > 0u ? cnt : 1u;
}
__device__ __forceinline__ void xcd_barrier(const XcdBarrier& b, int wv) {
    asm volatile("s_waitcnt vmcnt(0)" ::: "memory");
    __syncthreads();
    if (wv == 0) if ((otid(0) & 63) == 0) {
        unsigned* bar = b.bar;
        __builtin_amdgcn_s_waitcnt(0);
        unsigned nloc = b.st[0], nx = b.st[1];
        if (nloc == 0u) { xcd_barrier_complete(bar, b.x, nloc, nx); b.st[0] = nloc; b.st[1] = nx; }
        const unsigned old = xb_add(&bar[XB_XSUB(b.x)], 1u);
        const unsigned gen = old / nloc;
        if (old + 1u == (gen + 1u) * nloc) {
            __builtin_amdgcn_fence(__ATOMIC_RELEASE, "agent");
            asm volatile("s_waitcnt vmcnt(0)" ::: "memory");
            const unsigned og = xb_add(&bar[XB_TOP], 1u);
            const unsigned tg = og / nx;
            if (og + 1u == (tg + 1u) * nx) xb_add(&bar[XB_TOPGEN], 1u);
            else XB_SPIN(xb_ld(&bar[XB_TOPGEN]) == tg, bar);
            __builtin_amdgcn_fence(__ATOMIC_ACQUIRE, "agent");
            xb_add(&bar[XB_XGEN(b.x)], 1u);
            asm volatile("s_waitcnt vmcnt(0)" ::: "memory");
        } else {
            XB_SPIN(xb_ld(&bar[XB_XGEN(b.x)]) == gen, bar);
            __builtin_amdgcn_fence(__ATOMIC_ACQUIRE, "agent");
            asm volatile("s_waitcnt vmcnt(0)" ::: "memory");
        }
    }
    __syncthreads();
}

namespace pg8 {
constexpr int BM = 256, BK = 64, HALF = 128, HTB = HALF * BK * 2, STAGE_BYTES = 8 * HTB, NXCD = 8, WGM = 8;
__host__ __device__ __forceinline__ int lds_byte(int r, int c) { const int st = (r >> 4) * 2 + (c >> 5), rr = r & 15, cc = c & 31, ob = rr * 64 + cc * 2; return st * 1024 + (ob ^ (((ob >> 9) & 1) << 5)); }
__host__ __device__ __forceinline__ void stage_rc(int b, int& R, int& C) { const int st = b / 1024, sb = b % 1024, swz = sb ^ (((sb >> 9) & 1) << 5); R = (st >> 1) * 16 + swz / 64; C = (st & 1) * 32 + (swz % 64) / 2; }
__host__ __device__ __forceinline__ int perm32(int rho) { const int n = rho >> 4, i = rho & 15; return 8 * (i >> 2) + 4 * n + (i & 3); }
struct Unit { int pm, pn, ka; };
struct Gemm { const bf16_t* A; const bf16_t* Bt; int M, N, K; size_t strideA; int nsplit; };
struct StaticOrder {
    int nM, nN, nwg, G, c, nsplit;
    __device__ __forceinline__ void init(int M_, int N_, int G_, int c_, int nsplit_) { nM = M_ / BM; nN = N_ / BM; nwg = nM * nN; G = G_; c = c_; nsplit = nsplit_; }
    __device__ __forceinline__ bool next(int i, Unit& u) const {
        const long L = (long)i * G + c; if (L >= nwg) return false;
        int wgid = (int)L; { const int q = nwg / NXCD, r = nwg % NXCD, xcd = wgid % NXCD, off = wgid / NXCD; wgid = (xcd < r ? xcd * (q + 1) : r * (q + 1) + (xcd - r) * q) + off; }
        const int nig = WGM * nN, gid = wgid / nig, fm = gid * WGM, gsz = (nM - fm) < WGM ? (nM - fm) : WGM;
        u.pm = fm + ((wgid % nig) % gsz); u.pn = (wgid % nig) / gsz; u.ka = nsplit ? u.pn / nsplit : 0; return true;
    }
};
__device__ __forceinline__ unsigned cvt_pk_bf16(float lo, float hi) { unsigned r; asm volatile("v_cvt_pk_bf16_f32 %0, %1, %2" : "=v"(r) : "v"(lo), "v"(hi)); return r; }

template <class Epi, class Sched>
__device__ __forceinline__ void gemm_phase(LAS unsigned char* lds, const Gemm g, const Sched& S, const Epi& E, int wv) {
    const int tid = otid(wv), wid = __builtin_amdgcn_readfirstlane(tid >> 6), lane = tid & 63, wr = wid >> 2, wc = wid & 3, fr = lane & 15, fq = lane >> 4;
    const int K = g.K, nt = K / BK;
    unsigned voffA[2], voffB[2];
#pragma unroll
    for (int i = 0; i < 2; ++i) { int R, C; stage_rc(tid * 16 + i * 8192, R, C); const int Rb = Epi::PERM ? ((R & ~31) + perm32(R & 31)) : R;
        voffA[i] = (unsigned)(R * K + C) * 2u; voffB[i] = (unsigned)(Rb * K + C) * 2u; }
    const size_t kstep = (size_t)(BK * 2);
    const size_t hstep = (size_t)HALF * K * 2;
    const size_t tstep = 2 * hstep;
    const unsigned ldsw = (unsigned)wid * 1024u;
    const int aoff = lds_byte(wr * 64 + fr, fq * 8), boff = lds_byte(wc * 32 + fr, fq * 8);
#define PG8_SA(b, h) (((b) * 2 + (h)) * HTB)
#define PG8_SB(b, h) ((4 + (b) * 2 + (h)) * HTB)
#define PG8_STAGE(bufoff, gbase, voff) do { _Pragma("unroll") for (int _i = 0; _i < 2; ++_i) \
        __builtin_amdgcn_global_load_lds((const unsigned*)((const char*)(gbase) + (voff)[_i]), (LAS unsigned*)(lds + (bufoff) + ldsw + _i * 8192), 16, 0, 0); } while (0)
#define PG8_LDA(dst, b, h) do { _Pragma("unroll") for (int m = 0; m < 4; ++m) _Pragma("unroll") for (int k = 0; k < 2; ++k) dst[m][k] = *(const LAS bf16x8*)(lds + PG8_SA(b, h) + aoff + m * 2048 + k * 1024); } while (0)
#define PG8_LDB(dst, b, h) do { _Pragma("unroll") for (int n = 0; n < 2; ++n) _Pragma("unroll") for (int k = 0; k < 2; ++k) dst[n][k] = *(const LAS bf16x8*)(lds + PG8_SB(b, h) + boff + n * 2048 + k * 1024); } while (0)
#define PG8_MMA(ai, bj, At, Bt) do { __builtin_amdgcn_s_setprio(1); _Pragma("unroll") for (int m = 0; m < 4; ++m) _Pragma("unroll") for (int n = 0; n < 2; ++n) _Pragma("unroll") for (int k = 0; k < 2; ++k) \
        acc[ai][bj][m][n] = __builtin_amdgcn_mfma_f32_16x16x32_bf16(Bt[n][k], At[m][k], acc[ai][bj][m][n], 0, 0, 0); __builtin_amdgcn_s_setprio(0); } while (0)
#define PG8_WAIT_V(n) asm volatile("s_waitcnt vmcnt(" #n ")" ::: "memory")
#define PG8_WAIT_L(n) asm volatile("s_waitcnt lgkmcnt(" #n ")" ::: "memory")
#define PG8_BAR __builtin_amdgcn_s_barrier()
#define PG8_SCHED __builtin_amdgcn_sched_barrier(0)
    Unit cur, nxt; int ui = 0;
    if (!S.next(0, cur)) return;
    f32x4 acc[2][2][4][2];
#pragma unroll
    for (int a = 0; a < 2; ++a)
#pragma unroll
        for (int b = 0; b < 2; ++b)
#pragma unroll
            for (int m = 0; m < 4; ++m)
#pragma unroll
                for (int n = 0; n < 2; ++n) acc[a][b][m][n] = (f32x4){0.f, 0.f, 0.f, 0.f};
    bf16x8 At[4][2], B0[2][2], B1[2][2];
    const char* cA = (const char*)g.A + (size_t)cur.ka * g.strideA + (size_t)cur.pm * tstep; const char* cB = (const char*)g.Bt + (size_t)cur.pn * tstep;
    PG8_STAGE(PG8_SB(0, 0), cB, voffB); PG8_STAGE(PG8_SA(0, 0), cA, voffA); PG8_STAGE(PG8_SB(0, 1), cB + hstep, voffB); PG8_STAGE(PG8_SA(0, 1), cA + hstep, voffA);
    if (wr == 1) PG8_BAR;
    PG8_WAIT_V(4); PG8_BAR;
    PG8_STAGE(PG8_SB(1, 0), cB + kstep, voffB); PG8_STAGE(PG8_SA(1, 0), cA + kstep, voffA); PG8_STAGE(PG8_SB(1, 1), cB + hstep + kstep, voffB);
    PG8_WAIT_V(6); PG8_BAR;
    for (;;) {
        const bool has_next = S.next(ui + 1, nxt);
        const char* nA = has_next ? (const char*)g.A + (size_t)nxt.ka * g.strideA + (size_t)nxt.pm * tstep : cA; const char* nB = has_next ? (const char*)g.Bt + (size_t)nxt.pn * tstep : cB;
        for (int t = 0; t < nt; t += 2) {
            const bool last = (t == nt - 2);
            const char* a1 = cA + (size_t)(t + 1) * kstep;
            const char* a2 = last ? nA : cA + (size_t)(t + 2) * kstep; const char* b2 = last ? nB : cB + (size_t)(t + 2) * kstep;
            const char* a3 = a2 + kstep; const char* b3 = b2 + kstep;
            PG8_LDB(B0, 0, 0); PG8_SCHED; PG8_LDA(At, 0, 0); PG8_STAGE(PG8_SA(1, 1), a1 + hstep, voffA);
            PG8_WAIT_L(8); PG8_BAR; PG8_WAIT_L(0); PG8_MMA(0, 0, At, B0); PG8_BAR; PG8_SCHED;
            PG8_LDB(B1, 0, 1); PG8_STAGE(PG8_SB(0, 0), b2, voffB);
            PG8_BAR; PG8_WAIT_L(0); PG8_MMA(0, 1, At, B1); PG8_BAR;
            PG8_LDA(At, 0, 1); PG8_STAGE(PG8_SA(0, 0), a2, voffA);
            PG8_BAR; PG8_WAIT_L(0); PG8_MMA(1, 0, At, B0); PG8_BAR; PG8_SCHED;
            PG8_STAGE(PG8_SB(0, 1), b2 + hstep, voffB);
            PG8_WAIT_V(6); PG8_BAR; PG8_MMA(1, 1, At, B1); PG8_BAR;
            PG8_LDB(B0, 1, 0); PG8_SCHED; PG8_LDA(At, 1, 0); PG8_STAGE(PG8_SA(0, 1), a2 + hstep, voffA);
            PG8_WAIT_L(8); PG8_BAR; PG8_WAIT_L(0); PG8_MMA(0, 0, At, B0); PG8_BAR; PG8_SCHED;
            PG8_LDB(B1, 1, 1); PG8_STAGE(PG8_SB(1, 0), b3, voffB);
            PG8_BAR; PG8_WAIT_L(0); PG8_MMA(0, 1, At, B1); PG8_BAR;
            PG8_LDA(At, 1, 1); PG8_STAGE(PG8_SA(1, 0), a3, voffA);
            PG8_BAR; PG8_WAIT_L(0); PG8_MMA(1, 0, At, B0); PG8_BAR; PG8_SCHED;
            PG8_STAGE(PG8_SB(1, 1), b3 + hstep, voffB);
            PG8_WAIT_V(6); PG8_BAR; PG8_MMA(1, 1, At, B1); PG8_BAR;
        }
        E(acc, cur, wr, wc, fr, fq);
        if (!has_next) break;
        if (!E.keep(cur))
#pragma unroll
        for (int a = 0; a < 2; ++a)
#pragma unroll
            for (int b = 0; b < 2; ++b)
#pragma unroll
                for (int m = 0; m < 4; ++m)
#pragma unroll
                    for (int n = 0; n < 2; ++n) acc[a][b][m][n] = (f32x4){0.f, 0.f, 0.f, 0.f};
        cur = nxt; cA = nA; cB = nB; ++ui;
    }
    PG8_WAIT_V(0);
    if (wr == 0) PG8_BAR;
    PG8_BAR;
#undef PG8_SA
#undef PG8_SB
#undef PG8_STAGE
#undef PG8_LDA
#undef PG8_LDB
#undef PG8_MMA
#undef PG8_WAIT_V
#undef PG8_WAIT_L
#undef PG8_BAR
#undef PG8_SCHED
}

struct EpiIn {
    __device__ __forceinline__ bool keep(const Unit&) const { return false; }
    static constexpr bool PERM = true;
    bf16_t* P16; float* PF;
    __device__ __forceinline__ void operator()(f32x4 (&acc)[2][2][4][2], const Unit& u, int wr, int wc, int fr, int fq) const {
        const int row0 = u.pm * BM + wr * 64 + fr, col0 = u.pn * BM + wc * 32 + 8 * fq;
        const bool f32t = (u.pn == 2) || (u.pn == 3), gate = u.pn >= C_GL / 256;
        const int pfc0 = (u.pn - 2) * 256 + wc * 32 + 8 * fq;
#pragma unroll
        for (int ai = 0; ai < 2; ++ai)
#pragma unroll
            for (int m = 0; m < 4; ++m) { const size_t row = (size_t)(row0 + ai * HALF + m * 16);
#pragma unroll
                for (int bj = 0; bj < 2; ++bj) { f32x4 v0 = acc[ai][bj][m][0], v1 = acc[ai][bj][m][1];
                    if (gate) {
#pragma unroll
                        for (int j = 0; j < 4; ++j) { v0[j] = sigm(v0[j]); v1[j] = sigm(v1[j]); } }
                    u32x4 w; w.x = cvt_pk_bf16(v0[0], v0[1]); w.y = cvt_pk_bf16(v0[2], v0[3]); w.z = cvt_pk_bf16(v1[0], v1[1]); w.w = cvt_pk_bf16(v1[2], v1[3]);
                    *(u32x4*)(P16 + row * NPAD + col0 + bj * HALF) = w;
                    if (f32t) { float* pf = PF + row * PFW + pfc0 + bj * HALF; *(f32x4*)pf = v0; *(f32x4*)(pf + 4) = v1; } } }
    }
};
struct EpiGate {
    static constexpr bool PERM = true;
    bf16_t* GS; const bf16_t* P16;
    __device__ __forceinline__ bool keep(const Unit& u) const { return (u.pn >> 2) < 2; }
    __device__ __forceinline__ void operator()(f32x4 (&acc)[2][2][4][2], const Unit& u, int wr, int wc, int fr, int fq) const {
        const int n = u.pn >> 2, row0 = u.pm * BM + wr * 64 + fr, col0 = (u.pn & 3) * BM + wc * 32 + 8 * fq;
#pragma unroll
        for (int ai = 0; ai < 2; ++ai) {
            u32x4 gwv[4][2], hwv[4][2];
#pragma unroll
            for (int m = 0; m < 4; ++m)
#pragma unroll
                for (int bj = 0; bj < 2; ++bj) { const size_t row = (size_t)(row0 + ai * HALF + m * 16);
                    gwv[m][bj] = *(const u32x4*)(P16 + row * NPAD + C_GL + n * 1024 + col0 + bj * HALF);
                    if (n < 2) hwv[m][bj] = *(const u32x4*)(P16 + row * NPAD + C_GL + (n + 1) * 1024 + col0 + bj * HALF); else hwv[m][bj] = gwv[m][bj]; }
#pragma unroll
            for (int m = 0; m < 4; ++m)
#pragma unroll
                for (int bj = 0; bj < 2; ++bj) { const size_t row = (size_t)(row0 + ai * HALF + m * 16); f32x4& v0 = acc[ai][bj][m][0]; f32x4& v1 = acc[ai][bj][m][1];
                    const u32x4 gw = gwv[m][bj], hw = hwv[m][bj];
                    const float g[8] = {lo_bf(gw.x), hi_bf(gw.x), lo_bf(gw.y), hi_bf(gw.y), lo_bf(gw.z), hi_bf(gw.z), lo_bf(gw.w), hi_bf(gw.w)};
                    if (n < 2) { const float h[8] = {lo_bf(hw.x), hi_bf(hw.x), lo_bf(hw.y), hi_bf(hw.y), lo_bf(hw.z), hi_bf(hw.z), lo_bf(hw.w), hi_bf(hw.w)};
#pragma unroll
                        for (int j = 0; j < 4; ++j) { v0[j] *= g[j] * __builtin_amdgcn_rcpf(h[j]); v1[j] *= g[4 + j] * __builtin_amdgcn_rcpf(h[4 + j]); }
                    } else { u32x4 w;
                        w.x = cvt_pk_bf16(v0[0] * g[0], v0[1] * g[1]); w.y = cvt_pk_bf16(v0[2] * g[2], v0[3] * g[3]);
                        w.z = cvt_pk_bf16(v1[0] * g[4], v1[1] * g[5]); w.w = cvt_pk_bf16(v1[2] * g[6], v1[3] * g[7]);
                        *(u32x4*)(GS + row * D + col0 + bj * HALF) = w; } }
        }
    }
};
struct BranchOrder {
    StaticOrder so; int G;
    __device__ __forceinline__ void init(int G_, int c_) { so.init(M, 1024, G_, c_, 0); G = G_; }
    __device__ __forceinline__ bool next(int i, Unit& u) const { Unit t; if (!so.next(i / 3, t)) return false; const int n = i % 3; u.pm = t.pm; u.pn = n * 4 + t.pn; u.ka = n; return true; }
};
struct EpiRes {
    __device__ __forceinline__ bool keep(const Unit&) const { return false; }
    static constexpr bool PERM = false;
    float* X;
    __device__ __forceinline__ void operator()(f32x4 (&acc)[2][2][4][2], const Unit& u, int wr, int wc, int fr, int fq) const {
        const int row0 = u.pm * BM + wr * 64 + fr, col0 = u.pn * BM + wc * 32 + 4 * fq;
#pragma unroll
        for (int ai = 0; ai < 2; ++ai)
#pragma unroll
            for (int m = 0; m < 4; ++m) { float* rowp = X + (size_t)(row0 + ai * HALF + m * 16) * D + col0;
#pragma unroll
                for (int bj = 0; bj < 2; ++bj)
#pragma unroll
                    for (int n = 0; n < 2; ++n) { f32x4* p = (f32x4*)(rowp + bj * HALF + n * 16); *p = *p + acc[ai][bj][m][n]; } }
    }
};
struct EpiB16 {
    __device__ __forceinline__ bool keep(const Unit&) const { return false; }
    static constexpr bool PERM = true;
    bf16_t* O; int ldc;
    __device__ __forceinline__ void operator()(f32x4 (&acc)[2][2][4][2], const Unit& u, int wr, int wc, int fr, int fq) const {
        const int row0 = u.pm * BM + wr * 64 + fr, col0 = u.pn * BM + wc * 32 + 8 * fq;
#pragma unroll
        for (int ai = 0; ai < 2; ++ai)
#pragma unroll
            for (int m = 0; m < 4; ++m) { bf16_t* rowp = O + (size_t)(row0 + ai * HALF + m * 16) * ldc + col0;
#pragma unroll
                for (int bj = 0; bj < 2; ++bj) { const f32x4 v0 = acc[ai][bj][m][0], v1 = acc[ai][bj][m][1];
                    u32x4 w; w.x = cvt_pk_bf16(v0[0], v0[1]); w.y = cvt_pk_bf16(v0[2], v0[3]); w.z = cvt_pk_bf16(v1[0], v1[1]); w.w = cvt_pk_bf16(v1[2], v1[3]);
                    *(u32x4*)(rowp + bj * HALF) = w; } }
    }
};
}

struct Args {
    const float* x; const int* pos; const float* norm1; const float* w_in; const float* lb_logits; const float* hgrn_gain; const float* gmlp_gain; const float* gmlp_ws; const float* gmlp_bs;
    const float* w_branch; const float* w_out; const float* norm2; const float* peer_wq; const float* peer_keys; const float* peer_u; const float* peer_v; const float* final_gain;
    float* out; unsigned char* ws; int ph_lo, ph_hi;
};
constexpr int NTHR = 512, NWAVE = 8;
constexpr int LDS_BYTES = 147456;
constexpr int LDS_CTL_OFF = 143360;

__device__ __forceinline__ void tr_item(const float* src, int ldsrc, int c0, int nvalid, bf16_t* dst, int ldd, int r0, int koff, float* scr, int item, int nblk, int lane) {
    const int kb = item / nblk, nb = item % nblk, k0 = 64 * kb, n0 = 32 * nb;
    const int nn = n0 + (lane & 31);
    float tv[32];
#pragma unroll
    for (int i = 0; i < 32; ++i) { const int kk = 2 * i + (lane >> 5); tv[i] = (nn < nvalid) ? src[(size_t)(k0 + kk) * ldsrc + c0 + nn] : 0.f; }
#pragma unroll
    for (int i = 0; i < 32; ++i) { const int kk = 2 * i + (lane >> 5); scr[kk * 33 + (lane & 31)] = tv[i]; }
    asm volatile("s_waitcnt lgkmcnt(0)" ::: "memory");
    const int c = lane & 7;
#pragma unroll
    for (int j = 0; j < 4; ++j) { const int n = (lane >> 3) + 8 * j; const float* s = scr + (8 * c) * 33 + n;
        u32x4 o; o.x = pk2(s[0 * 33], s[1 * 33]); o.y = pk2(s[2 * 33], s[3 * 33]); o.z = pk2(s[4 * 33], s[5 * 33]); o.w = pk2(s[6 * 33], s[7 * 33]);
        *(u32x4*)(dst + (size_t)(r0 + n0 + n) * ldd + koff + k0 + 8 * c) = o; }
    asm volatile("s_waitcnt lgkmcnt(0)" ::: "memory");
}
__device__ __forceinline__ void rms_row_to_bf16(const float* xrow, const float* gain, bf16_t* orow, int lane) {
    const f32x4* xr = (const f32x4*)xrow + lane; const f32x4* gr = (const f32x4*)gain + lane;
    f32x4 v[4]; float s = 0.f;
#pragma unroll
    for (int j = 0; j < 4; ++j) { v[j] = xr[64 * j]; s += (v[j].x * v[j].x + v[j].y * v[j].y) + (v[j].z * v[j].z + v[j].w * v[j].w); }
    const float r = rsqrtf(wave_sum(s) * (1.f / D) + EPS);
    unsigned long long* o8 = (unsigned long long*)orow + lane;
#pragma unroll
    for (int j = 0; j < 4; ++j) { const f32x4 g = gr[64 * j]; o8[64 * j] = (unsigned long long)pk2(v[j].x * r * g.x, v[j].y * r * g.y) | ((unsigned long long)pk2(v[j].z * r * g.z, v[j].w * r * g.w) << 32); }
}

__device__ __forceinline__ void ph_prologue(const Args& a, unsigned char* lds, int wv) {
    const int tid = otid(wv), lane = tid & 63, wave = tid >> 6;
    const int gw = blockIdx.x * NWAVE + wave, ngw = gridDim.x * NWAVE;
    const size_t gtid = (size_t)blockIdx.x * NTHR + tid, gsz = (size_t)gridDim.x * NTHR;
    unsigned char* ws = oport(a.ws);
    { const f32x4* s = (const f32x4*)a.x; f32x4* d = (f32x4*)a.out; for (size_t i = gtid; i < (size_t)M * D / 4; i += gsz) d[i] = s[i]; }
    float* scr = (float*)(lds + wave * 16384);
    constexpr int I_IN1 = 16 * 160, I_IN2 = 16 * 8, I_IN3 = 16 * 96, I_IN = I_IN1 + I_IN2 + I_IN3;
    constexpr int I_BR = 3 * 8 * 32, I_OUT = 16 * 32, I_PQ = 16 * 64, I_L = I_IN + I_BR + I_OUT + I_PQ;
    for (int it = gw; it < DEPTH * I_L; it += ngw) {
        const int l = it / I_L; int r = it % I_L;
        bf16_t* win = (bf16_t*)(ws + WS_WIN + (size_t)l * WIN_L); const float* src_in = a.w_in + (size_t)l * D * NIN;
        if (r < I_IN1) { tr_item(src_in, NIN, 0, 5120, win, D, 0, 0, scr, r, 160, lane); continue; } r -= I_IN1;
        if (r < I_IN2) { tr_item(src_in, NIN, 5120, 72, win, D, C_KI, 0, scr, r, 8, lane); continue; } r -= I_IN2;
        if (r < I_IN3) { tr_item(src_in, NIN, S_GL, 3072, win, D, C_GL, 0, scr, r, 96, lane); continue; } r -= I_IN3;
        if (r < I_BR) { const int n = r / 256; tr_item(a.w_branch + ((size_t)l * 3 + n) * 512 * D, D, 0, 1024, (bf16_t*)(ws + WS_WBR + (size_t)l * WBR_L), 512, n * 1024, 0, scr, r % 256, 32, lane); continue; } r -= I_BR;
        if (r < I_OUT) { tr_item(a.w_out + (size_t)l * D * D, D, 0, 1024, (bf16_t*)(ws + WS_WOUT + (size_t)l * WOUT_L), D, 0, 0, scr, r, 32, lane); continue; } r -= I_OUT;
        tr_item(a.peer_wq + (size_t)l * D * 2048, 2048, 0, 2048, (bf16_t*)(ws + WS_WPQ + (size_t)l * WPQ_L), D, 0, 0, scr, r, 64, lane);
    }
    if (gtid < 512) { float v[DEPTH], mx = -1e30f; for (int l = 0; l < DEPTH; ++l) { v[l] = a.lb_logits[l * 512 + gtid]; mx = fmaxf(mx, v[l]); }
        float s = 0.f; for (int l = 0; l < DEPTH; ++l) { v[l] = __expf(v[l] - mx); s += v[l]; }
        float c = 0.f; float* lb = (float*)(ws + WS_LB); for (int l = 0; l < DEPTH; ++l) { if (l > 0) c += v[l] / s; lb[l * 512 + gtid] = c; } }
    { u32x4* SKB = (u32x4*)(ws + WS_SKB); const f32x4* sk = (const f32x4*)a.peer_keys; for (size_t i = gtid; i < (size_t)DEPTH * 16 * 128 * 128 / 8; i += gsz) { const f32x4 k0 = sk[2 * i], k1 = sk[2 * i + 1]; SKB[i] = (u32x4){pk2(k0.x, k0.y), pk2(k0.z, k0.w), pk2(k1.x, k1.y), pk2(k1.z, k1.w)}; } }
    { bf16_t* WSB = (bf16_t*)(ws + WS_WSB); for (size_t i = gtid; i < (size_t)DEPTH * 4 * 128 * 128; i += gsz) { const int t = (int)((i >> 7) & 127), sx = (int)(i & 127); WSB[i] = (bf16_t)f2bf(sx <= t ? a.gmlp_ws[i] : 0.f); } }
    { float2* cs = (float2*)(ws + WS_CS);
      for (size_t i = gtid; i < (size_t)M * 96; i += gsz) { const int m = (int)(i / 96), j = (int)(i % 96);
          const float inv = j < 64 ? ROPE_INV64[j] : ROPE_INV32[j - 64]; const float angf = (float)a.pos[m] * inv;
          const double ang = (double)angf; const double k = rint(ang * 0.15915494309189535); const float r = (float)(ang - k * 6.283185307179586);
          cs[i] = make_float2(__cosf(r), __sinf(r)); } }
    for (int m = gw; m < M; m += ngw) rms_row_to_bf16(a.x + (size_t)m * D, a.norm1, (bf16_t*)(ws + WS_H16) + (size_t)m * D, lane);
}

__device__ __forceinline__ void ph_kiwi(const Args& a, int l, unsigned char* lds, int wv) {
    unsigned char* ws = oport(a.ws); const int tid = otid(wv), lane = tid & 63, wave = __builtin_amdgcn_readfirstlane(tid >> 6), g4 = wave & 3, kh = wave >> 2, fr = lane & 15, fq = lane >> 4;
    const bf16_t* H16 = (const bf16_t*)(ws + WS_H16); const bf16_t* W = (const bf16_t*)(ws + WS_WIN + (size_t)l * WIN_L) + (size_t)C_KI * D; float* PF = (float*)(ws + WS_PF);
    f32x4* sK = (f32x4*)lds + (g4 * 5) * 64 + lane;
    for (int base = blockIdx.x; base * 4 < M / 16; base += gridDim.x) { const int tg = base * 4 + g4; f32x4 acc[5];
#pragma unroll
        for (int nt = 0; nt < 5; ++nt) acc[nt] = (f32x4){0.f, 0.f, 0.f, 0.f};
#pragma unroll 8
        for (int ks = 16 * kh; ks < 16 * kh + 16; ++ks) { const bf16x8 y = ((const bf16x8*)(H16 + (size_t)tg * 16 * D + 32 * ks))[fr * (D / 8) + fq];
#pragma unroll
            for (int nt = 0; nt < 5; ++nt) { const bf16x8 x = ((const bf16x8*)(W + (size_t)nt * 16 * D + 32 * ks))[fr * (D / 8) + fq]; acc[nt] = __builtin_amdgcn_mfma_f32_16x16x32_bf16(x, y, acc[nt], 0, 0, 0); } }
        __syncthreads();
        if (kh == 1) {
#pragma unroll
            for (int nt = 0; nt < 5; ++nt) sK[nt * 64] = acc[nt]; }
        __syncthreads();
        if (kh == 0) {
#pragma unroll
            for (int nt = 0; nt < 5; ++nt) *(f32x4*)(PF + ((size_t)tg * 16 + fr) * PFW + 512 + 16 * nt + 4 * fq) = acc[nt] + sK[nt * 64]; }
    }
    __syncthreads();
}

__device__ __forceinline__ void ph_post(const Args& a, int l, unsigned char* lds, int wv) {
    const int tid = otid(wv), lane = tid & 63, wave = tid >> 6;
    const int gw = blockIdx.x * NWAVE + wave, ngw = gridDim.x * NWAVE;
    const size_t gtid = (size_t)blockIdx.x * NTHR + tid, gsz = (size_t)gridDim.x * NTHR;
    unsigned char* ws = oport(a.ws);
    const bf16_t* P16 = (const bf16_t*)(ws + WS_P16); const float* PF = (const float*)(ws + WS_PF); const float2* cs = (const float2*)(ws + WS_CS);
    { bf16_t* QR = (bf16_t*)(ws + WS_QR); bf16_t* KR = (bf16_t*)(ws + WS_KR);
#pragma unroll 4
      for (size_t i = gtid; i < (size_t)M * 256; i += gsz) { const int m = (int)(i >> 8), h = (int)((i >> 6) & 3), j = (int)(i & 63);
          const float2 c = cs[(size_t)m * 96 + j]; const size_t pb = (size_t)m * NPAD + h * 128 + j, ob = (size_t)m * 512 + h * 128 + j;
          const float q1 = bf2f(P16[pb + C_CQ]), q2 = bf2f(P16[pb + C_CQ + 64]), k1 = bf2f(P16[pb + C_CK]), k2 = bf2f(P16[pb + C_CK + 64]);
          const float sc = 0.08838834764831845f * 1.4426950408889634f;
          QR[ob] = (bf16_t)f2bf((q1 * c.x - q2 * c.y) * sc); QR[ob + 64] = (bf16_t)f2bf((q2 * c.x + q1 * c.y) * sc);
          KR[ob] = (bf16_t)f2bf(k1 * c.x - k2 * c.y); KR[ob + 64] = (bf16_t)f2bf(k2 * c.x + k1 * c.y); } }
    { bf16_t* QS = (bf16_t*)(ws + WS_QI); bf16_t* KIb = (bf16_t*)(ws + WS_KI); float* WP = (float*)(ws + WS_WI);
#pragma unroll 2
      for (int m = gw; m < M; m += ngw) { const int h = lane >> 3, jj = lane & 7;
          const unsigned long long w1 = *(const unsigned long long*)(P16 + (size_t)m * NPAD + C_QI + h * 64 + 4 * jj), w2 = *(const unsigned long long*)(P16 + (size_t)m * NPAD + C_QI + h * 64 + 32 + 4 * jj);
          const float q1[4] = {lo_bf((unsigned)w1), hi_bf((unsigned)w1), lo_bf((unsigned)(w1 >> 32)), hi_bf((unsigned)(w1 >> 32))}, q2[4] = {lo_bf((unsigned)w2), hi_bf((unsigned)w2), lo_bf((unsigned)(w2 >> 32)), hi_bf((unsigned)(w2 >> 32))};
          const float2* c = cs + (size_t)m * 96 + 64 + 4 * jj; const float w = PF[(size_t)m * PFW + 576 + h] * 0.02209708691207961f;
          float r1[4], r2[4], l1[4], l2[4];
#pragma unroll
          for (int i = 0; i < 4; ++i) { const float2 cc = c[i]; r1[i] = q1[i] * cc.x - q2[i] * cc.y; r2[i] = q2[i] * cc.x + q1[i] * cc.y; l1[i] = w * r1[i]; l2[i] = w * r2[i]; }
          *(unsigned long long*)(QS + (size_t)m * 576 + h * 64 + 4 * jj) = (unsigned long long)pk2(r1[0], r1[1]) | ((unsigned long long)pk2(r1[2], r1[3]) << 32);
          *(unsigned long long*)(QS + (size_t)m * 576 + h * 64 + 32 + 4 * jj) = (unsigned long long)pk2(r2[0], r2[1]) | ((unsigned long long)pk2(r2[2], r2[3]) << 32);
#pragma unroll
          for (int i = 0; i < 4; ++i) { l1[i] += __shfl_xor(l1[i], 8); l1[i] += __shfl_xor(l1[i], 16); l1[i] += __shfl_xor(l1[i], 32); l2[i] += __shfl_xor(l2[i], 8); l2[i] += __shfl_xor(l2[i], 16); l2[i] += __shfl_xor(l2[i], 32); }
          if (h == 0) { *(unsigned long long*)(QS + (size_t)m * 576 + 512 + 4 * jj) = (unsigned long long)pk2(l1[0], l1[1]) | ((unsigned long long)pk2(l1[2], l1[3]) << 32);
                        *(unsigned long long*)(QS + (size_t)m * 576 + 512 + 32 + 4 * jj) = (unsigned long long)pk2(l2[0], l2[1]) | ((unsigned long long)pk2(l2[2], l2[3]) << 32);
                        const f32x4 k1 = *(const f32x4*)(PF + (size_t)m * PFW + 512 + 4 * jj), k2 = *(const f32x4*)(PF + (size_t)m * PFW + 512 + 32 + 4 * jj);
                        const float kk1[4] = {k1.x, k1.y, k1.z, k1.w}, kk2[4] = {k2.x, k2.y, k2.z, k2.w}; float o1[4], o2[4];
#pragma unroll
                        for (int i = 0; i < 4; ++i) { const float2 cc = c[i]; o1[i] = kk1[i] * cc.x - kk2[i] * cc.y; o2[i] = kk2[i] * cc.x + kk1[i] * cc.y; }
                        *(unsigned long long*)(KIb + (size_t)m * 64 + 4 * jj) = (unsigned long long)pk2(o1[0], o1[1]) | ((unsigned long long)pk2(o1[2], o1[3]) << 32);
                        *(unsigned long long*)(KIb + (size_t)m * 64 + 32 + 4 * jj) = (unsigned long long)pk2(o2[0], o2[1]) | ((unsigned long long)pk2(o2[2], o2[3]) << 32); }
          if (jj == 0) WP[(size_t)m * 8 + h] = w; } }
    { bf16_t* VT = (bf16_t*)(ws + WS_VT); bf16_t* sT = (bf16_t*)lds;
      for (int t0 = blockIdx.x * 8; t0 < (M / 64) * 8; t0 += gridDim.x * 8) {
          u32x4 w[8]; const int row = tid >> 3, seg = tid & 7;
#pragma unroll
          for (int q = 0; q < 8; ++q) { const int tile = t0 + q, tb = tile >> 3, cb = tile & 7; w[q] = *(const u32x4*)(P16 + (size_t)(tb * 64 + row) * NPAD + C_CV + cb * 64 + seg * 8); }
          __syncthreads();
#pragma unroll
          for (int q = 0; q < 8; ++q) { unsigned* d = (unsigned*)(sT + q * 64 * 66 + row * 66 + seg * 8); d[0] = w[q].x; d[1] = w[q].y; d[2] = w[q].z; d[3] = w[q].w; }
          __syncthreads();
          const int ch = tid >> 3, tg = tid & 7;
#pragma unroll
          for (int q = 0; q < 8; ++q) { const int tile = t0 + q, tb = tile >> 3, cb = tile & 7; unsigned short v[8];
#pragma unroll
              for (int i = 0; i < 8; ++i) v[i] = sT[q * 64 * 66 + (tg * 8 + i) * 66 + ch];
              const u32x4 o = {(unsigned)v[0] | ((unsigned)v[1] << 16), (unsigned)v[2] | ((unsigned)v[3] << 16), (unsigned)v[4] | ((unsigned)v[5] << 16), (unsigned)v[6] | ((unsigned)v[7] << 16)};
              *(u32x4*)(VT + ((size_t)((tb >> 7) * 512 + cb * 64 + ch)) * SEQ + (tb & 127) * 64 + tg * 8) = o; } }
      __syncthreads(); }
    { bf16_t* VN = (bf16_t*)(ws + WS_VN); const float* gain = a.gmlp_gain + l * 512;
#pragma unroll 4
      for (int m = gw; m < M; m += ngw) { const u32x4 w = *(const u32x4*)(P16 + (size_t)m * NPAD + C_BV + lane * 8);
          float v[8] = {gelu_t(lo_bf(w.x)), gelu_t(hi_bf(w.x)), gelu_t(lo_bf(w.y)), gelu_t(hi_bf(w.y)), gelu_t(lo_bf(w.z)), gelu_t(hi_bf(w.z)), gelu_t(lo_bf(w.w)), gelu_t(hi_bf(w.w))};
          float sm = 0.f;
#pragma unroll
          for (int j = 0; j < 8; ++j) sm += v[j] * v[j];
          const float r = rsqrtf(wave_sum(sm) * (1.f / 512.f) + EPS);
          const f32x4 g0 = *(const f32x4*)(gain + lane * 8), g1 = *(const f32x4*)(gain + lane * 8 + 4);
          *(u32x4*)(VN + (size_t)m * 512 + lane * 8) = (u32x4){pk2(v[0] * r * g0.x, v[1] * r * g0.y), pk2(v[2] * r * g0.z, v[3] * r * g0.w), pk2(v[4] * r * g1.x, v[5] * r * g1.y), pk2(v[6] * r * g1.z, v[7] * r * g1.w)}; } }
}

constexpr int NHU = BATCH * 128 * 4;
__device__ __forceinline__ void ph_h1(const Args& a, int l, unsigned char* lds, int wv) {
    unsigned char* ws = oport(a.ws);
    const int tid = otid(wv), lane = tid & 63, wave = __builtin_amdgcn_readfirstlane(tid >> 6), j = wave >> 1, d = tid & 127, fr = lane & 15, fq = lane >> 4;
    bf16_t* KT = (bf16_t*)lds;
    bf16_t* VT = KT + 128 * 72;
    float* sT = (float*)(VT + 128 * 72);
    const float* PF = (const float*)(ws + WS_PF); const bf16_t* P16 = (const bf16_t*)(ws + WS_P16); const float* LB = (const float*)(ws + WS_LB) + l * 512;
    float* LL = (float*)(ws + WS_FF); float* DD = (float*)(ws + WS_DD);
    for (int u = blockIdx.x; u < NHU; u += gridDim.x) {
        const int h = u & 3, c = (u >> 2) & 127, b = u >> 9; const size_t m0 = (size_t)b * SEQ + c * 64 + j * 16;
        const float lbv = LB[h * 128 + d];
        float cs[16], ky[16]; unsigned vv[16]; float run = 0.f;
#pragma unroll
        for (int i = 0; i < 16; ++i) { const float z = PF[(m0 + i) * PFW + h * 128 + d]; const float sg = sigm(z); run += __logf(lbv + (1.f - lbv) * sg); cs[i] = run; ky[i] = (1.f - lbv) * (1.f - sg);
            vv[i] = P16[(m0 + i) * NPAD + C_AI + h * 128 + d]; }
        sT[j * 128 + d] = run;
        __syncthreads();
        float tail = 0.f;
#pragma unroll
        for (int jj = 1; jj < 4; ++jj) if (jj > j) tail += sT[jj * 128 + d];
        { unsigned w[8], x[8];
#pragma unroll
          for (int i = 0; i < 8; ++i) { w[i] = pk2(ky[2 * i] * __expf(tail + (run - cs[2 * i])), ky[2 * i + 1] * __expf(tail + (run - cs[2 * i + 1]))); x[i] = vv[2 * i] | (vv[2 * i + 1] << 16); }
          u32x4* kp = (u32x4*)(KT + d * 72 + j * 16); kp[0] = (u32x4){w[0], w[1], w[2], w[3]}; kp[1] = (u32x4){w[4], w[5], w[6], w[7]};
          u32x4* vp = (u32x4*)(VT + d * 72 + j * 16); vp[0] = (u32x4){x[0], x[1], x[2], x[3]}; vp[1] = (u32x4){x[4], x[5], x[6], x[7]}; }
        if (j == 0) DD[(size_t)u * 128 + d] = __expf(run + tail);
        __syncthreads();
        { bf16x8 xk[2];
#pragma unroll
          for (int ks = 0; ks < 2; ++ks) xk[ks] = *(const bf16x8*)(KT + (16 * wave + fr) * 72 + ks * 32 + fq * 8);
#pragma unroll
          for (int nt = 0; nt < 8; ++nt) { f32x4 acc = {0.f, 0.f, 0.f, 0.f};
#pragma unroll
              for (int ks = 0; ks < 2; ++ks) { const bf16x8 y = *(const bf16x8*)(VT + (16 * nt + fr) * 72 + ks * 32 + fq * 8); acc = __builtin_amdgcn_mfma_f32_16x16x32_bf16(xk[ks], y, acc, 0, 0, 0); }
              *(f32x4*)(LL + ((size_t)u * 128 + 16 * nt + fr) * 128 + 16 * wave + 4 * fq) = acc; } }
        __syncthreads();
    }
}
__device__ __forceinline__ void ph_h2(const Args& a, int wv) {
    unsigned char* ws = oport(a.ws);
    const float* LL = (const float*)(ws + WS_FF); const float* DD = (const float*)(ws + WS_DD); bf16_t* SB = (bf16_t*)(ws + WS_QF);
    for (int e = blockIdx.x * NTHR + otid(wv); e < 8 * 16384; e += gridDim.x * NTHR) { const int bh = e >> 14, b = bh >> 2, h = bh & 3, dvdk = e & 16383, dk = e & 127; float S = 0.f;
#pragma unroll 16
        for (int c = 0; c < 128; ++c) { const size_t u = (size_t)(((b * 128 + c) << 2) + h); SB[u * 16384 + dvdk] = (bf16_t)f2bf(S); S = DD[u * 128 + dk] * S + LL[u * 16384 + dvdk]; } }
}
__device__ __forceinline__ void ph_h3(const Args& a, int l, unsigned char* lds, int wv) {
    unsigned char* ws = oport(a.ws);
    const int tid = otid(wv), lane = tid & 63, wave = __builtin_amdgcn_readfirstlane(tid >> 6), j = wave >> 1, d = tid & 127, fr = lane & 15, fq = lane >> 4;
    bf16_t* QT = (bf16_t*)lds;
    bf16_t* QH = QT + 64 * 136;
    bf16_t* KI = QH + 64 * 136;
    bf16_t* VT = KI + 160 * 136;
    bf16_t* AT = VT + 128 * 72;
    float* sT = (float*)(AT + 64 * 72);
    float* sSS = sT + 512;
    const float* PF = (const float*)(ws + WS_PF); const bf16_t* P16 = (const bf16_t*)(ws + WS_P16); const float* LB = (const float*)(ws + WS_LB) + l * 512;
    const bf16_t* SB = (const bf16_t*)(ws + WS_QF); bf16_t* YA = (bf16_t*)(ws + WS_YALL); const float* gain = a.hgrn_gain + l * 128;
    for (int u = blockIdx.x; u < NHU; u += gridDim.x) {
        const int h = u & 3, c = (u >> 2) & 127, b = u >> 9; const size_t mc = (size_t)b * SEQ + c * 64, m0 = mc + j * 16;
        for (int i = tid; i < 64 * 72 * 2 / 16; i += NTHR) ((u32x4*)AT)[i] = (u32x4){0u, 0u, 0u, 0u};
        bf16x8 sbf[4][4];
#pragma unroll
        for (int q4 = 0; q4 < 4; ++q4)
#pragma unroll
            for (int ks = 0; ks < 4; ++ks) sbf[q4][ks] = ((const bf16x8*)(SB + ((size_t)u * 128 + 16 * (4 * (wave >> 2) + q4)) * 128 + 32 * ks))[fr * 16 + fq];
        const float lbv = LB[h * 128 + d];
        float cs[16], ky[16], qf[16]; unsigned vv[16]; float run = 0.f;
#pragma unroll
        for (int i = 0; i < 16; ++i) { const size_t pr = (m0 + i) * NPAD + h * 128 + d; const float z = PF[(m0 + i) * PFW + h * 128 + d]; const float sg = sigm(z); run += __logf(lbv + (1.f - lbv) * sg); cs[i] = run; ky[i] = (1.f - lbv) * (1.f - sg);
            qf[i] = silu(bf2f(P16[pr + C_AQ])) * 0.08838834764831845f; vv[i] = P16[pr + C_AI]; }
        sT[j * 128 + d] = run;
        __syncthreads();
        const float T0 = sT[d], T1 = sT[128 + d], T2 = sT[256 + d];
        const float Bj = (j > 0 ? T0 : 0.f) + (j > 1 ? T1 : 0.f) + (j > 2 ? T2 : 0.f); const float eBj = __expf(Bj);
        float pre[4]; pre[0] = 0.f; pre[1] = (j < 1 ? T0 : 0.f); pre[2] = (j < 1 ? T0 : 0.f) + (j < 2 ? T1 : 0.f); pre[3] = (j < 1 ? T0 : 0.f) + (j < 2 ? T1 : 0.f) + (j < 3 ? T2 : 0.f);
        float epre[4];
#pragma unroll
        for (int I = 0; I < 4; ++I) epre[I] = __expf(pre[I]);
#pragma unroll
        for (int i = 0; i < 16; ++i) { const int t = 16 * j + i; const float ec = __expf(cs[i]), kn = ky[i] * __expf(fminf(-cs[i], 60.f));
            QT[t * 136 + d] = (bf16_t)f2bf(qf[i] * ec); QH[t * 136 + d] = (bf16_t)f2bf(qf[i] * ec * eBj);
#pragma unroll
            for (int I = 0; I < 4; ++I) if (I >= j) KI[(8 * I * (I + 1) + t) * 136 + d] = (bf16_t)f2bf(kn * epre[I]); }
        { unsigned x[8];
#pragma unroll
          for (int i = 0; i < 8; ++i) x[i] = vv[2 * i] | (vv[2 * i + 1] << 16);
          u32x4* vp = (u32x4*)(VT + d * 72 + j * 16); vp[0] = (u32x4){x[0], x[1], x[2], x[3]}; vp[1] = (u32x4){x[4], x[5], x[6], x[7]}; }
        __syncthreads();
        for (int tl = wave; tl < 10; tl += 8) { const int I = tl < 1 ? 0 : tl < 3 ? 1 : tl < 6 ? 2 : 3, J = tl - (I * (I + 1)) / 2; f32x4 acc = {0.f, 0.f, 0.f, 0.f};
#pragma unroll
            for (int ks = 0; ks < 4; ++ks) { const bf16x8 x = *(const bf16x8*)(QT + (16 * I + fr) * 136 + ks * 32 + fq * 8); const bf16x8 y = *(const bf16x8*)(KI + (8 * I * (I + 1) + 16 * J + fr) * 136 + ks * 32 + fq * 8);
                acc = __builtin_amdgcn_mfma_f32_16x16x32_bf16(x, y, acc, 0, 0, 0); }
#pragma unroll
            for (int r = 0; r < 4; ++r) { float v = acc[r]; if (J == I && fr > 4 * fq + r) v = 0.f; AT[(16 * I + 4 * fq + r) * 72 + 16 * J + fr] = (bf16_t)f2bf(v); } }
        __syncthreads();
        const int I = wave & 3, nt0 = 4 * (wave >> 2); f32x4 o[4];
#pragma unroll
        for (int q4 = 0; q4 < 4; ++q4) { const int nt = nt0 + q4; f32x4 acc = {0.f, 0.f, 0.f, 0.f};
            for (int ks = 0; ks <= (I >> 1); ++ks) { const bf16x8 x = *(const bf16x8*)(AT + (16 * I + fr) * 72 + ks * 32 + fq * 8); const bf16x8 y = *(const bf16x8*)(VT + (16 * nt + fr) * 72 + ks * 32 + fq * 8);
                acc = __builtin_amdgcn_mfma_f32_16x16x32_bf16(x, y, acc, 0, 0, 0); }
#pragma unroll
            for (int ks = 0; ks < 4; ++ks) { const bf16x8 x = *(const bf16x8*)(QH + (16 * I + fr) * 136 + ks * 32 + fq * 8); acc = __builtin_amdgcn_mfma_f32_16x16x32_bf16(x, sbf[q4][ks], acc, 0, 0, 0); }
            o[q4] = acc; }
        { float ssq[4];
#pragma unroll
          for (int r = 0; r < 4; ++r) { float s = o[0][r] * o[0][r] + o[1][r] * o[1][r] + o[2][r] * o[2][r] + o[3][r] * o[3][r]; s += __shfl_xor(s, 1); s += __shfl_xor(s, 2); s += __shfl_xor(s, 4); s += __shfl_xor(s, 8); ssq[r] = s; }
          if (fr == 0) {
#pragma unroll
              for (int r = 0; r < 4; ++r) sSS[(16 * I + 4 * fq + r) * 2 + (wave >> 2)] = ssq[r]; } }
        __syncthreads();
#pragma unroll
        for (int r = 0; r < 4; ++r) { const int tt = 16 * I + 4 * fq + r; const float rinv = rsqrtf((sSS[tt * 2] + sSS[tt * 2 + 1]) * (1.f / 128.f) + EPS); const size_t m = mc + tt;
#pragma unroll
            for (int q4 = 0; q4 < 4; ++q4) { const int dv = 16 * (nt0 + q4) + fr; const float g = bf2f(P16[m * NPAD + C_AG + h * 128 + dv]);
                YA[m * 512 + h * 128 + dv] = (bf16_t)f2bf(o[q4][r] * rinv * gain[dv] * silu(g)); } }
        __syncthreads();
    }
}
__device__ __forceinline__ void ph_gmlp(const Args& a, int l, unsigned char* lds, int wv) {
    unsigned char* ws = oport(a.ws);
    const int tid = otid(wv), lane = tid & 63, wave = __builtin_amdgcn_readfirstlane(tid >> 6), fr = lane & 15, fq = lane >> 4;
    const bf16_t* P16 = (const bf16_t*)(ws + WS_P16); const bf16_t* VN = (const bf16_t*)(ws + WS_VN); bf16_t* YB = (bf16_t*)(ws + WS_YALL) + (size_t)M * 512;
    const bf16_t* WSB = (const bf16_t*)(ws + WS_WSB) + (size_t)l * 4 * 128 * 128; const float* bs = a.gmlp_bs + (size_t)l * 4 * 128;
    bf16_t* VNt = (bf16_t*)lds;
    for (int u = blockIdx.x; u < (M / 128) * 4; u += gridDim.x) { const int g = u & 3, nb = u >> 2; const size_t mb = (size_t)nb * 128;
        __syncthreads();
#pragma unroll
        for (int n = 0; n < 4; ++n) { const int idx = tid + NTHR * n, row = idx >> 4, seg = idx & 15; const u32x4 w = *(const u32x4*)(VN + (mb + row) * 512 + g * 128 + seg * 8);
            bf16_t* d = VNt + (seg * 8) * 136 + row;
            d[0 * 136] = (bf16_t)(w.x & 0xffffu); d[1 * 136] = (bf16_t)(w.x >> 16); d[2 * 136] = (bf16_t)(w.y & 0xffffu); d[3 * 136] = (bf16_t)(w.y >> 16);
            d[4 * 136] = (bf16_t)(w.z & 0xffffu); d[5 * 136] = (bf16_t)(w.z >> 16); d[6 * 136] = (bf16_t)(w.w & 0xffffu); d[7 * 136] = (bf16_t)(w.w >> 16); }
        bf16x8 wf[4];
#pragma unroll
        for (int ks = 0; ks < 4; ++ks) wf[ks] = *(const bf16x8*)(WSB + ((size_t)g * 128 + 16 * wave + fr) * 128 + 32 * ks + 8 * fq);
        __syncthreads();
        const int t = 16 * wave + fr; const float bias = bs[g * 128 + t]; const int nks = (wave >> 1) + 1;
        unsigned long long uwv[8];
#pragma unroll
        for (int ct = 0; ct < 8; ++ct) uwv[ct] = *(const unsigned long long*)(P16 + (mb + t) * NPAD + C_BU + g * 128 + 16 * ct + 4 * fq);
#pragma unroll
        for (int ct = 0; ct < 8; ++ct) { f32x4 acc = {0.f, 0.f, 0.f, 0.f};
#pragma unroll
            for (int ks = 0; ks < 4; ++ks) if (ks < nks) { const bf16x8 x = *(const bf16x8*)(VNt + (16 * ct + fr) * 136 + 32 * ks + 8 * fq); acc = __builtin_amdgcn_mfma_f32_16x16x32_bf16(x, wf[ks], acc, 0, 0, 0); }
            const size_t m = mb + t; const int c = g * 128 + 16 * ct + 4 * fq; const unsigned long long uw = uwv[ct];
            const float o0 = gelu_t(lo_bf((unsigned)uw)) * (acc[0] + bias), o1 = gelu_t(hi_bf((unsigned)uw)) * (acc[1] + bias), o2 = gelu_t(lo_bf((unsigned)(uw >> 32))) * (acc[2] + bias), o3 = gelu_t(hi_bf((unsigned)(uw >> 32))) * (acc[3] + bias);
            *(unsigned long long*)(YB + m * 512 + c) = (unsigned long long)pk2(o0, o1) | ((unsigned long long)pk2(o2, o3) << 32); }
    }
}
constexpr int SEL_CAP = 256;
__device__ __forceinline__ int sel_bin(float s, float lo, float sc) { return (int)__builtin_amdgcn_fmed3f((s - lo) * sc, 0.f, 1023.f); }
struct SelQ { float lo1, sc1, lo2, sc2, tau; int b1, b2, ref, tidx; };
__device__ __forceinline__ void sel_pass(const int mode, const bf16x8 (&qf)[9][2], const float (&wp)[8], const SelQ& sq, const bf16_t* kib, int c, int kp, int qloc, int fr, int fq,
                                         unsigned* sHist, unsigned* sCand, unsigned* sCnt, unsigned* maskrow) {
    bf16x8 af[4][2];
    { const int T0 = kp <= c ? kp : c;
#pragma unroll
      for (int rg = 0; rg < 4; ++rg)
#pragma unroll
          for (int ks = 0; ks < 2; ++ks) af[rg][ks] = ((const bf16x8*)(kib + (size_t)(64 * T0 + 16 * rg) * 64 + 32 * ks))[fr * 8 + fq]; }
#pragma unroll 1
    for (int T = kp; T <= c; T += 4) {
        const int Tn = (T + 4 <= c) ? T + 4 : T;
        unsigned mlo = 0u, mhi = 0u;
#pragma unroll
        for (int rg = 0; rg < 4; ++rg) {
            f32x4 sc = __builtin_amdgcn_mfma_f32_16x16x32_bf16(af[rg][0], qf[8][0], (f32x4){0.f, 0.f, 0.f, 0.f}, 0, 0, 0);
            sc = __builtin_amdgcn_mfma_f32_16x16x32_bf16(af[rg][1], qf[8][1], sc, 0, 0, 0);
#pragma unroll
            for (int h = 0; h < 8; ++h) { f32x4 ah = __builtin_amdgcn_mfma_f32_16x16x32_bf16(af[rg][0], qf[h][0], (f32x4){0.f, 0.f, 0.f, 0.f}, 0, 0, 0);
                ah = __builtin_amdgcn_mfma_f32_16x16x32_bf16(af[rg][1], qf[h][1], ah, 0, 0, 0);
#pragma unroll
                for (int r = 0; r < 4; ++r) sc[r] += wp[h] * __builtin_fabsf(ah[r]); }
#pragma unroll
            for (int ks = 0; ks < 2; ++ks) af[rg][ks] = ((const bf16x8*)(kib + (size_t)(64 * Tn + 16 * rg) * 64 + 32 * ks))[fr * 8 + fq];
            if (mode == 0) {
#pragma unroll
                for (int r = 0; r < 4; ++r) { const int b = sel_bin(sc[r], sq.lo1, sq.sc1); __hip_atomic_fetch_add(sHist + qloc * 512 + (b >> 1), 1u << ((b & 1) * 16), __ATOMIC_RELAXED, __HIP_MEMORY_SCOPE_WORKGROUP); }
            } else if (mode == 1) {
                if (sq.ref) {
#pragma unroll
                    for (int r = 0; r < 4; ++r) if (sel_bin(sc[r], sq.lo1, sq.sc1) == sq.b1) { const int b = sel_bin(sc[r], sq.lo2, sq.sc2); __hip_atomic_fetch_add(sHist + qloc * 512 + (b >> 1), 1u << ((b & 1) * 16), __ATOMIC_RELAXED, __HIP_MEMORY_SCOPE_WORKGROUP); } }
            } else {
                int b[4]; unsigned bits = 0u; bool anyc = false;
#pragma unroll
                for (int r = 0; r < 4; ++r) { b[r] = sel_bin(sc[r], sq.lo1, sq.sc1); bits |= (b[r] > sq.b1) ? (1u << r) : 0u; anyc |= (b[r] == sq.b1); }
                if (anyc) {
#pragma unroll
                    for (int r = 0; r < 4; ++r) if (b[r] == sq.b1) { bool cand = true;
                        if (sq.ref) { const int b2 = sel_bin(sc[r], sq.lo2, sq.sc2); if (b2 > sq.b2) bits |= 1u << r; cand = b2 == sq.b2; }
                        if (cand) { const unsigned slot = __hip_atomic_fetch_add(sCnt + qloc, 1u, __ATOMIC_RELAXED, __HIP_MEMORY_SCOPE_WORKGROUP);
                            if (slot < (unsigned)SEL_CAP) { sCand[(qloc * SEL_CAP + slot) * 2] = __float_as_uint(sc[r]); sCand[(qloc * SEL_CAP + slot) * 2 + 1] = (unsigned)(64 * T + 16 * rg + 4 * fq + r); } } } }
                bits <<= (16 * (rg & 1)) + 4 * fq; if (rg < 2) mlo |= bits; else mhi |= bits;
            }
            __builtin_amdgcn_sched_barrier(0);
        }
        if (mode == 2) { mlo |= __shfl_xor(mlo, 16); mlo |= __shfl_xor(mlo, 32); mhi |= __shfl_xor(mhi, 16); mhi |= __shfl_xor(mhi, 32);
            if (fq == 0) *(uint2*)(maskrow + 2 * T) = make_uint2(mlo, mhi); }
    }
}
__device__ __forceinline__ void sel_scan(const unsigned* hist, unsigned need, int lane, int& bsel, unsigned& nneed, unsigned& cnt) {
    unsigned c16[16]; unsigned tot = 0u;
#pragma unroll
    for (int i = 0; i < 8; ++i) { const unsigned w = hist[512 - 8 * (lane + 1) + i]; c16[2 * i] = w & 0xffffu; c16[2 * i + 1] = w >> 16; tot += (w & 0xffffu) + (w >> 16); }
    unsigned inc = tot;
#pragma unroll
    for (int o = 1; o < 64; o <<= 1) { const unsigned t2 = __shfl_up(inc, o); if (lane >= o) inc += t2; }
    const unsigned long long bal = __ballot(inc >= need);
    const int L = bal ? (__ffsll((long long)bal) - 1) : 63;
    unsigned above = __shfl(inc - tot, L); int bs = 0; unsigned nn = 1u, cc = 0u; bool found = false;
#pragma unroll
    for (int j = 0; j < 16; ++j) { const unsigned hcnt = __shfl(c16[15 - j], L); if (!found) { if (above + hcnt >= need) { found = true; bs = 1024 - 16 * L - 1 - j; nn = need - above; cc = hcnt; } else above += hcnt; } }
    bsel = bs; nneed = nn; cnt = cc;
}
__device__ __forceinline__ void ph_sel(const Args& a, unsigned char* lds, int wv) {
    unsigned char* ws = oport(a.ws);
    const int tid = otid(wv), lane = tid & 63, wave = __builtin_amdgcn_readfirstlane(tid >> 6), gq = wave & 1, kp = wave >> 1, fr = lane & 15, fq = lane >> 4, qloc = 16 * gq + fr;
    unsigned* sHist = (unsigned*)lds;
    unsigned* sCand = (unsigned*)(lds + 65536);
    float* sLo1 = (float*)(lds + 131072); float* sSc1 = sLo1 + 32; float* sLo2 = sSc1 + 32; float* sSc2 = sLo2 + 32; float* sTau = sSc2 + 32;
    int* sB1 = (int*)(sTau + 32); int* sB2 = sB1 + 32; int* sRef = sB2 + 32; int* sTidx = sRef + 32; unsigned* sNeed = (unsigned*)(sTidx + 32); unsigned* sCnt = sNeed + 32; int* sAny = (int*)(sCnt + 32);
    const bf16_t* QS = (const bf16_t*)(ws + WS_QI); const bf16_t* KIb = (const bf16_t*)(ws + WS_KI); const float* WP = (const float*)(ws + WS_WI); unsigned* MASKB = (unsigned*)(ws + WS_MASK);
    for (int pi = blockIdx.x; pi < 256; pi += gridDim.x) {
#pragma unroll 1
      for (int which = 0; which < 2; ++which) {
        const int b = pi & 1, half = (pi >> 1) & 1, cc = pi >> 2, c = which ? cc : 127 - cc;
        const size_t mq = (size_t)b * SEQ + 64 * c + 32 * half;
        const bf16_t* kib = KIb + (size_t)b * SEQ * 64;
        __syncthreads();
        if (tid < 32) { const float* w = WP + (mq + tid) * 8; float s1 = 0.f, s2 = 0.f;
#pragma unroll
            for (int h = 0; h < 8; ++h) { s1 += w[h]; s2 += w[h] * w[h]; }
            const float sd = 9.34f * sqrtf(fmaxf(s2, 1e-30f)); sLo1[tid] = 6.38f * s1 - 8.f * sd; sSc1[tid] = 1024.f / (16.f * sd);
            sLo2[tid] = 0.f; sSc2[tid] = 1.f; sB1[tid] = 0; sB2[tid] = 0; sRef[tid] = 0; sNeed[tid] = 256u; sCnt[tid] = 0u; sTau[tid] = -INFINITY; sTidx[tid] = 0x7fffffff; }
        if (tid == 0) sAny[0] = 0;
        for (int i = tid; i < 32 * 512 / 4; i += NTHR) ((u32x4*)sHist)[i] = (u32x4){0u, 0u, 0u, 0u};
        bf16x8 qf[9][2]; float wp[8];
        { const bf16_t* qrow = QS + (mq + qloc) * 576;
#pragma unroll
          for (int h = 0; h < 9; ++h)
#pragma unroll
              for (int ks = 0; ks < 2; ++ks) qf[h][ks] = *(const bf16x8*)(qrow + h * 64 + 32 * ks + 8 * fq);
#pragma unroll
          for (int h = 0; h < 8; ++h) wp[h] = WP[(mq + qloc) * 8 + h]; }
        __syncthreads();
        unsigned* maskrow = MASKB + (mq + qloc) * 256;
        if (c < 4) {
            if (tid < 32) for (int T = 0; T <= c; ++T) *(uint2*)(MASKB + (mq + tid) * 256 + 2 * T) = make_uint2(0xFFFFFFFFu, 0xFFFFFFFFu);
        } else {
#pragma unroll 1
            for (int pass = 0; pass < 3; ++pass) {
                if (pass == 1) { if (!sAny[0]) continue; __syncthreads(); for (int i = tid; i < 32 * 512 / 4; i += NTHR) ((u32x4*)sHist)[i] = (u32x4){0u, 0u, 0u, 0u}; __syncthreads(); }
                SelQ sq; sq.lo1 = sLo1[qloc]; sq.sc1 = sSc1[qloc]; sq.lo2 = sLo2[qloc]; sq.sc2 = sSc2[qloc]; sq.b1 = sB1[qloc]; sq.b2 = sB2[qloc]; sq.ref = sRef[qloc]; sq.tau = 0.f; sq.tidx = 0;
                sel_pass(pass, qf, wp, sq, kib, c, kp, qloc, fr, fq, sHist, sCand, sCnt, maskrow);
                asm volatile("s_waitcnt vmcnt(0)" ::: "memory");
                __syncthreads();
                if (pass < 2) {
                    for (int qq = wave * 4; qq < wave * 4 + 4; ++qq) if (pass == 0 || sRef[qq]) { int bs; unsigned nn, cn; sel_scan(sHist + qq * 512, sNeed[qq], lane, bs, nn, cn);
                        if (lane == 0) { sNeed[qq] = nn; if (pass == 0) { sB1[qq] = bs; if (cn > (unsigned)SEL_CAP) { sRef[qq] = 1; sLo2[qq] = sLo1[qq] + (float)bs / sSc1[qq]; sSc2[qq] = sSc1[qq] * 1024.f; sAny[0] = 1; } } else sB2[qq] = bs; } }
                    __syncthreads(); }
            }
            unsigned* sOff = (unsigned*)sAny + 4;
            if (tid < 64) { unsigned n = 0u; if (tid < 32) n = sCnt[tid] < (unsigned)SEL_CAP ? sCnt[tid] : (unsigned)SEL_CAP; unsigned inc = n;
#pragma unroll
                for (int o = 1; o < 32; o <<= 1) { const unsigned t2 = __shfl_up(inc, o); if (lane >= o) inc += t2; }
                if (tid < 32) { sOff[tid] = inc - n; if (tid == 31) sOff[32] = inc; } }
            __syncthreads();
            { const unsigned total = sOff[32];
              for (unsigned p = tid; p < total; p += NTHR) { int qq = 0;
#pragma unroll
                  for (int st = 16; st >= 1; st >>= 1) if (sOff[qq + st] <= p) qq += st;
                  const unsigned i = p - sOff[qq], n = sOff[qq + 1] - sOff[qq], want = sNeed[qq] - 1u;
                  const float si = __uint_as_float(sCand[(qq * SEL_CAP + i) * 2]); const unsigned ki = sCand[(qq * SEL_CAP + i) * 2 + 1]; unsigned rank = 0u;
                  for (unsigned j = 0; j < n; ++j) { const float sj = __uint_as_float(sCand[(qq * SEL_CAP + j) * 2]); const unsigned kj = sCand[(qq * SEL_CAP + j) * 2 + 1]; rank += (sj > si || (sj == si && kj < ki)) ? 1u : 0u; }
                  if (rank <= want) atomicOr(MASKB + (mq + qq) * 256 + (ki >> 5), 1u << (ki & 31u)); } }
        }
      }
    }
}

__device__ __forceinline__ void ph_attn(const Args& a, unsigned char* lds, int wv) {
    unsigned char* ws = oport(a.ws);
    const int tid = otid(wv), lane = tid & 63, wave = __builtin_amdgcn_readfirstlane(tid >> 6), g4 = wave & 3, par = wave >> 2, fr = lane & 15, fq = lane >> 4;
    const bf16_t* QR = (const bf16_t*)(ws + WS_QR); const bf16_t* KR = (const bf16_t*)(ws + WS_KR); const bf16_t* VT = (const bf16_t*)(ws + WS_VT); const unsigned* MASKB = (const unsigned*)(ws + WS_MASK);
    bf16_t* YC = (bf16_t*)(ws + WS_YALL) + (size_t)2 * M * 512;
    bf16_t* Kt = (bf16_t*)lds;
    bf16_t* Vt = Kt + 2 * 64 * 136;
    float* sMrg = (float*)lds;
    for (int pi = blockIdx.x; pi < 256; pi += gridDim.x) {
#pragma unroll 1
      for (int which = 0; which < 2; ++which) {
        const int bh = pi & 7, b = bh >> 2, h = bh & 3, cc = pi >> 3, qb = which ? cc : 63 - cc;
        const size_t m0 = (size_t)b * SEQ + 128 * qb + 32 * g4;
        const int mych = 2 * qb + (g4 >> 1);
        bf16x8 qf[2][4];
#pragma unroll
        for (int cg = 0; cg < 2; ++cg)
#pragma unroll
            for (int ks = 0; ks < 4; ++ks) qf[cg][ks] = *(const bf16x8*)(QR + (m0 + 16 * cg + fr) * 512 + h * 128 + 32 * ks + 8 * fq);
        f32x4 O[2][8], Lacc[2]; float mrun[2];
        const bf16x8 xones = (fr == 0) ? (bf16x8){0x3f80, 0x3f80, 0x3f80, 0x3f80, 0x3f80, 0x3f80, 0x3f80, 0x3f80} : (bf16x8){0, 0, 0, 0, 0, 0, 0, 0};
#pragma unroll
        for (int cg = 0; cg < 2; ++cg) { mrun[cg] = 0.f; Lacc[cg] = (f32x4){0.f, 0.f, 0.f, 0.f};
#pragma unroll
            for (int vt = 0; vt < 8; ++vt) O[cg][vt] = (f32x4){0.f, 0.f, 0.f, 0.f}; }
        const bf16_t* kbase = KR + (size_t)b * SEQ * 512 + h * 128; const bf16_t* vbase = VT + (size_t)(b * 512 + h * 128) * SEQ;
        unsigned doff[9];
#pragma unroll
        for (int k = 0; k < 9; ++k) { const int i_ = wave + NWAVE * k, slot = 64 * i_ + lane;
            if (slot < 2176) { const int tl = slot >= 1088 ? 1 : 0, rs = slot - 1088 * tl, row = rs / 17, seg = rs - 17 * row; doff[k] = (unsigned)((64 * tl + row) * 512 + ((seg < 16) ? (seg ^ ((row & 16) >> 2)) : 0) * 8); }
            else { const int s2 = slot - 2176, tl = s2 >= 1152 ? 1 : 0, rs = s2 - 1152 * tl, row = rs / 9, seg = rs - 9 * row; doff[k] = (unsigned)(row * SEQ + 64 * tl + (seg & 7) * 8); } }
#define ATT_DMA(jj, buf) do { const bf16_t* kb_ = kbase + (size_t)(jj) * 128 * 512; const bf16_t* vb_ = vbase + (size_t)(jj) * 128; \
            _Pragma("unroll") for (int k = 0; k < 9; ++k) { const int i_ = wave + NWAVE * k; if (i_ < 70) { const bf16_t* src = (i_ < 34 ? kb_ : vb_) + doff[k]; \
                __builtin_amdgcn_global_load_lds((const unsigned*)src, (LAS unsigned*)(LAS unsigned char*)(lds + (buf) * 71680 + i_ * 1024), 16, 0, 0); } } } while (0)
        __syncthreads();
        ATT_DMA(0, 0);
        asm volatile("s_waitcnt vmcnt(0)" ::: "memory");
        __syncthreads();
        for (int j = 0; j <= qb; ++j) {
            if (j < qb) ATT_DMA(j + 1, (j + 1) & 1);
            const bf16_t* Ktb = Kt + (j & 1) * 35840; const bf16_t* Vtb = Vt + (j & 1) * 35840;
            const int T = 2 * j + par;
            if (T <= mych) {
                const bf16_t* kt = Ktb + par * 64 * 136; const bf16_t* vtl = Vtb + par * 128 * 72;
                uint2 mw[2];
#pragma unroll
                for (int cg = 0; cg < 2; ++cg) mw[cg] = *(const uint2*)(MASKB + (m0 + 16 * cg + fr) * 256 + 2 * T);
                f32x4 S[2][4];
#pragma unroll
                for (int rg = 0; rg < 4; ++rg) { S[0][rg] = (f32x4){-mrun[0], -mrun[0], -mrun[0], -mrun[0]}; S[1][rg] = (f32x4){-mrun[1], -mrun[1], -mrun[1], -mrun[1]};
                    const int krow = 32 * (rg >> 1) + 8 * (fr >> 2) + 4 * (rg & 1) + (fr & 3);
#pragma unroll
                    for (int ks = 0; ks < 4; ++ks) { const bf16x8 kf = *(const bf16x8*)(kt + krow * 136 + ((4 * ks + fq) ^ ((krow & 16) >> 2)) * 8);
                        S[0][rg] = __builtin_amdgcn_mfma_f32_16x16x32_bf16(kf, qf[0][ks], S[0][rg], 0, 0, 0); S[1][rg] = __builtin_amdgcn_mfma_f32_16x16x32_bf16(kf, qf[1][ks], S[1][rg], 0, 0, 0); } }
                bf16x8 pf[2][2];
#pragma unroll
                for (int cg = 0; cg < 2; ++cg) {
                    float mx = fmaxf(fmaxf(fmaxf(S[cg][0][0], S[cg][0][1]), fmaxf(S[cg][0][2], S[cg][0][3])), fmaxf(fmaxf(S[cg][1][0], S[cg][1][1]), fmaxf(S[cg][1][2], S[cg][1][3])));
                    mx = fmaxf(mx, fmaxf(fmaxf(fmaxf(S[cg][2][0], S[cg][2][1]), fmaxf(S[cg][2][2], S[cg][2][3])), fmaxf(fmaxf(S[cg][3][0], S[cg][3][1]), fmaxf(S[cg][3][2], S[cg][3][3]))));
                    mx = fmaxf(mx, __shfl_xor(mx, 16)); mx = fmaxf(mx, __shfl_xor(mx, 32));
                    const float dlt = fmaxf(mx, 0.f);
                    const int m16 = (int)(((mw[cg].x >> (8 * fq)) & 0xFFu) | (((mw[cg].y >> (8 * fq)) & 0xFFu) << 8));
                    if (__builtin_amdgcn_ballot_w64(dlt != 0.f) != 0ull) {
                        mrun[cg] += dlt; const float alpha = __builtin_amdgcn_exp2f(-dlt);
#pragma unroll
                        for (int rg = 0; rg < 4; ++rg)
#pragma unroll
                            for (int r = 0; r < 4; ++r) S[cg][rg][r] -= dlt;
#pragma unroll
                        for (int vt = 0; vt < 8; ++vt) O[cg][vt] = O[cg][vt] * alpha;
                        Lacc[cg] = Lacc[cg] * alpha; }
#pragma unroll
                    for (int rg = 0; rg < 4; ++rg)
#pragma unroll
                        for (int r = 0; r < 4; ++r) S[cg][rg][r] = __int_as_float(__float_as_int(__builtin_amdgcn_exp2f(S[cg][rg][r])) & __builtin_amdgcn_sbfe(m16, 4 * rg + r, 1));
#pragma unroll
                    for (int k2 = 0; k2 < 2; ++k2) { const u32x4 w = {pg8::cvt_pk_bf16(S[cg][2 * k2][0], S[cg][2 * k2][1]), pg8::cvt_pk_bf16(S[cg][2 * k2][2], S[cg][2 * k2][3]), pg8::cvt_pk_bf16(S[cg][2 * k2 + 1][0], S[cg][2 * k2 + 1][1]), pg8::cvt_pk_bf16(S[cg][2 * k2 + 1][2], S[cg][2 * k2 + 1][3])};
                        pf[cg][k2] = __builtin_bit_cast(bf16x8, w); }
                    Lacc[cg] = __builtin_amdgcn_mfma_f32_16x16x32_bf16(xones, pf[cg][0], Lacc[cg], 0, 0, 0); Lacc[cg] = __builtin_amdgcn_mfma_f32_16x16x32_bf16(xones, pf[cg][1], Lacc[cg], 0, 0, 0);
                }
#pragma unroll
                for (int vt = 0; vt < 8; ++vt)
#pragma unroll
                    for (int k2 = 0; k2 < 2; ++k2) { const bf16x8 vf = *(const bf16x8*)(vtl + (16 * vt + fr) * 72 + 32 * k2 + 8 * fq);
                        O[0][vt] = __builtin_amdgcn_mfma_f32_16x16x32_bf16(vf, pf[0][k2], O[0][vt], 0, 0, 0); O[1][vt] = __builtin_amdgcn_mfma_f32_16x16x32_bf16(vf, pf[1][k2], O[1][vt], 0, 0, 0); }
            }
            asm volatile("s_waitcnt vmcnt(0)" ::: "memory");
            __syncthreads();
        }
#undef ATT_DMA
        const float lrun[2] = {Lacc[0][0], Lacc[1][0]};
        float* mb = sMrg + (size_t)g4 * 68 * 64 + lane;
        if (par == 1) {
#pragma unroll
            for (int cg = 0; cg < 2; ++cg) { mb[(cg * 2 + 0) * 64] = mrun[cg]; mb[(cg * 2 + 1) * 64] = lrun[cg];
#pragma unroll
                for (int vt = 0; vt < 8; ++vt)
#pragma unroll
                    for (int r = 0; r < 4; ++r) mb[(4 + (cg * 8 + vt) * 4 + r) * 64] = O[cg][vt][r]; } }
        __syncthreads();
        if (par == 0) {
#pragma unroll
            for (int cg = 0; cg < 2; ++cg) { const float m1 = mb[(cg * 2 + 0) * 64], l1 = mb[(cg * 2 + 1) * 64]; const float mm = fmaxf(mrun[cg], m1), a0 = __builtin_amdgcn_exp2f(mrun[cg] - mm), a1 = __builtin_amdgcn_exp2f(m1 - mm);
                float lt = lrun[cg] * a0 + l1 * a1; lt += __shfl_xor(lt, 16); lt += __shfl_xor(lt, 32); const float inv = 1.f / lt;
#pragma unroll
                for (int vt = 0; vt < 8; ++vt) { float o[4];
#pragma unroll
                    for (int r = 0; r < 4; ++r) o[r] = (O[cg][vt][r] * a0 + mb[(4 + (cg * 8 + vt) * 4 + r) * 64] * a1) * inv;
                    *(unsigned long long*)(YC + (m0 + 16 * cg + fr) * 512 + h * 128 + 16 * vt + 4 * fq) = (unsigned long long)pk2(o[0], o[1]) | ((unsigned long long)pk2(o[2], o[3]) << 32); } } }
      }
    }
}
__device__ __forceinline__ void ph_norm2(const Args& a, int l, int wv) {
    const int tid = otid(wv), lane = tid & 63, gw = blockIdx.x * NWAVE + (tid >> 6), ngw = gridDim.x * NWAVE;
    unsigned char* ws = oport(a.ws);
#pragma unroll 2
    for (int m = gw; m < M; m += ngw) rms_row_to_bf16(a.out + (size_t)m * D, a.norm2 + l * D, (bf16_t*)(ws + WS_H16) + (size_t)m * D, lane);
    { const f32x4* U = (const f32x4*)(a.peer_u + (size_t)l * NEXP * D); const f32x4* V = (const f32x4*)(a.peer_v + (size_t)l * NEXP * D); u32x4* U8 = (u32x4*)(ws + WS_U16); u32x4* V8 = (u32x4*)(ws + WS_V16);
#pragma unroll 2
      for (size_t i = (size_t)blockIdx.x * NTHR + tid; i < (size_t)NEXP * D / 16; i += (size_t)gridDim.x * NTHR) { u32x4 ou, ov; unsigned* pu = (unsigned*)&ou; unsigned* pv = (unsigned*)&ov;
#pragma unroll
          for (int q = 0; q < 4; ++q) { const f32x4 u = U[4 * i + q] * 256.f, v = V[4 * i + q] * 64.f; int wu = 0, wvv = 0;
              wu = __builtin_amdgcn_cvt_pk_fp8_f32(u.x, u.y, wu, false); wu = __builtin_amdgcn_cvt_pk_fp8_f32(u.z, u.w, wu, true); wvv = __builtin_amdgcn_cvt_pk_fp8_f32(v.x, v.y, wvv, false); wvv = __builtin_amdgcn_cvt_pk_fp8_f32(v.z, v.w, wvv, true);
              pu[q] = (unsigned)wu; pv[q] = (unsigned)wvv; }
          U8[i] = ou; V8[i] = ov; } }
}
#define CE_(a_, b_) do { const float hi_ = fmaxf(a_, b_), lo_ = fminf(a_, b_); a_ = hi_; b_ = lo_; } while (0)
#define SORT16D(x) do { CE_(x[0], x[1]); CE_(x[3], x[2]); CE_(x[4], x[5]); CE_(x[7], x[6]); CE_(x[8], x[9]); CE_(x[11], x[10]); CE_(x[12], x[13]); CE_(x[15], x[14]); CE_(x[0], x[2]); CE_(x[1], x[3]); CE_(x[6], x[4]); CE_(x[7], x[5]); CE_(x[8], x[10]); CE_(x[9], x[11]); CE_(x[14], x[12]); CE_(x[15], x[13]); CE_(x[0], x[1]); CE_(x[2], x[3]); CE_(x[5], x[4]); CE_(x[7], x[6]); CE_(x[8], x[9]); CE_(x[10], x[11]); CE_(x[13], x[12]); CE_(x[15], x[14]); CE_(x[0], x[4]); CE_(x[1], x[5]); CE_(x[2], x[6]); CE_(x[3], x[7]); CE_(x[12], x[8]); CE_(x[13], x[9]); CE_(x[14], x[10]); CE_(x[15], x[11]); CE_(x[0], x[2]); CE_(x[1], x[3]); CE_(x[4], x[6]); CE_(x[5], x[7]); CE_(x[10], x[8]); CE_(x[11], x[9]); CE_(x[14], x[12]); CE_(x[15], x[13]); CE_(x[0], x[1]); CE_(x[2], x[3]); CE_(x[4], x[5]); CE_(x[6], x[7]); CE_(x[9], x[8]); CE_(x[11], x[10]); CE_(x[13], x[12]); CE_(x[15], x[14]); CE_(x[0], x[8]); CE_(x[1], x[9]); CE_(x[2], x[10]); CE_(x[3], x[11]); CE_(x[4], x[12]); CE_(x[5], x[13]); CE_(x[6], x[14]); CE_(x[7], x[15]); CE_(x[0], x[4]); CE_(x[1], x[5]); CE_(x[2], x[6]); CE_(x[3], x[7]); CE_(x[8], x[12]); CE_(x[9], x[13]); CE_(x[10], x[14]); CE_(x[11], x[15]); CE_(x[0], x[2]); CE_(x[1], x[3]); CE_(x[4], x[6]); CE_(x[5], x[7]); CE_(x[8], x[10]); CE_(x[9], x[11]); CE_(x[12], x[14]); CE_(x[13], x[15]); CE_(x[0], x[1]); CE_(x[2], x[3]); CE_(x[4], x[5]); CE_(x[6], x[7]); CE_(x[8], x[9]); CE_(x[10], x[11]); CE_(x[12], x[13]); CE_(x[14], x[15]); } while (0)
#define MERGE16D(x) do { CE_(x[0], x[8]); CE_(x[1], x[9]); CE_(x[2], x[10]); CE_(x[3], x[11]); CE_(x[4], x[12]); CE_(x[5], x[13]); CE_(x[6], x[14]); CE_(x[7], x[15]); CE_(x[0], x[4]); CE_(x[1], x[5]); CE_(x[2], x[6]); CE_(x[3], x[7]); CE_(x[8], x[12]); CE_(x[9], x[13]); CE_(x[10], x[14]); CE_(x[11], x[15]); CE_(x[0], x[2]); CE_(x[1], x[3]); CE_(x[4], x[6]); CE_(x[5], x[7]); CE_(x[8], x[10]); CE_(x[9], x[11]); CE_(x[12], x[14]); CE_(x[13], x[15]); CE_(x[0], x[1]); CE_(x[2], x[3]); CE_(x[4], x[5]); CE_(x[6], x[7]); CE_(x[8], x[9]); CE_(x[10], x[11]); CE_(x[12], x[13]); CE_(x[14], x[15]); } while (0)
__device__ __forceinline__ float pkf(float v, unsigned tag) { return __uint_as_float((__float_as_uint(v) & 0xFFFFFF00u) | tag); }
__device__ __forceinline__ void ph_peer_select(const Args& a, int l, unsigned char* lds, int wv, int nunits, int pm0, int pn0, int pm1, int pn1) {
    unsigned char* ws = oport(a.ws); const int tid = otid(wv), lane = tid & 63, wave = __builtin_amdgcn_readfirstlane(tid >> 6), fr = lane & 15, fq = lane >> 4;
    bf16_t* sK = (bf16_t*)lds;
    int* sI = (int*)(lds + 69632 + wave * 2048);
    const bf16_t* QRY = (const bf16_t*)(ws + WS_GB); const bf16_t* SKB = (const bf16_t*)(ws + WS_SKB) + (size_t)l * 16 * 128 * 128; int* EID = (int*)(ws + WS_EID); float* EG = (float*)(ws + WS_EG);
  for (int uu = 0; uu < nunits; ++uu) { const int h = uu == 0 ? pn0 : pn1, pmu = uu == 0 ? pm0 : pm1;
    __syncthreads();
    { const u32x4* src = (const u32x4*)(SKB + (size_t)h * 2 * 128 * 128);
#pragma unroll
      for (int n = 0; n < 8; ++n) { const int idx = tid + NTHR * n, row = idx >> 4, seg = idx & 15; *(u32x4*)(sK + row * 136 + seg * 8) = src[idx]; } }
    __syncthreads();
    for (int it = wave; it < 16; it += NWAVE) { const int tg = pmu * 16 + it; const size_t m = (size_t)tg * 16 + fr;
        float va[16], vb[16];
#pragma unroll
        for (int p = 0; p < 2; ++p) {
            bf16x8 qf[4];
#pragma unroll
            for (int ks = 0; ks < 4; ++ks) qf[ks] = *(const bf16x8*)(QRY + m * 2048 + h * 256 + p * 128 + 32 * ks + 8 * fq);
            const bf16_t* kb = sK + (size_t)p * 128 * 136; float s0[16], s1[16];
#pragma unroll
            for (int nt = 0; nt < 8; ++nt) { f32x4 acc = {0.f, 0.f, 0.f, 0.f};
#pragma unroll
                for (int ks = 0; ks < 4; ++ks) { const bf16x8 x = *(const bf16x8*)(kb + (16 * nt + fr) * 136 + 32 * ks + 8 * fq); acc = __builtin_amdgcn_mfma_f32_16x16x32_bf16(x, qf[ks], acc, 0, 0, 0); }
#pragma unroll
                for (int r = 0; r < 4; ++r) { const float tv = __uint_as_float((__float_as_uint(acc[r]) & 0xFFFFFF80u) | (unsigned)(127 - (16 * nt + 4 * fq + r))); if (nt < 4) s0[nt * 4 + r] = tv; else s1[(nt - 4) * 4 + r] = tv; } }
            SORT16D(s0); SORT16D(s1);
            float t[16];
#pragma unroll
            for (int i = 0; i < 16; ++i) t[i] = fmaxf(s0[i], s1[15 - i]);
            MERGE16D(t);
#pragma unroll
            for (int off = 16; off <= 32; off <<= 1) { float o[16];
#pragma unroll
                for (int i = 0; i < 16; ++i) o[i] = __shfl_xor(t[15 - i], off);
#pragma unroll
                for (int i = 0; i < 16; ++i) t[i] = fmaxf(t[i], o[i]);
                MERGE16D(t); }
#pragma unroll
            for (int i = 0; i < 16; ++i) { if (p == 0) va[i] = t[i]; else vb[i] = t[i]; }
            __builtin_amdgcn_sched_barrier(0);
        }
        if (fq == 0) {
#pragma unroll
            for (int r = 0; r < 16; ++r) { sI[fr * 32 + r] = 127 - (int)(__float_as_uint(va[r]) & 127u); sI[fr * 32 + 16 + r] = 127 - (int)(__float_as_uint(vb[r]) & 127u); } }
#pragma unroll
        for (int r = 0; r < 16; ++r) { va[r] = __uint_as_float(__float_as_uint(va[r]) & 0xFFFFFF80u); vb[r] = __uint_as_float(__float_as_uint(vb[r]) & 0xFFFFFF80u); }
        float cs[16];
        {
            cs[0] = fq == 0 ? pkf(va[0] + vb[0], 255u) : fq == 1 ? pkf(va[0] + vb[1], 254u) : fq == 2 ? pkf(va[0] + vb[2], 253u) : pkf(va[0] + vb[3], 252u);
            cs[1] = fq == 0 ? pkf(va[0] + vb[4], 251u) : fq == 1 ? pkf(va[0] + vb[5], 250u) : fq == 2 ? pkf(va[0] + vb[6], 249u) : pkf(va[0] + vb[7], 248u);
            cs[2] = fq == 0 ? pkf(va[0] + vb[8], 247u) : fq == 1 ? pkf(va[0] + vb[9], 246u) : fq == 2 ? pkf(va[0] + vb[10], 245u) : pkf(va[0] + vb[11], 244u);
            cs[3] = fq == 0 ? pkf(va[0] + vb[12], 243u) : fq == 1 ? pkf(va[0] + vb[13], 242u) : fq == 2 ? pkf(va[0] + vb[14], 241u) : pkf(va[0] + vb[15], 240u);
            cs[4] = fq == 0 ? pkf(va[1] + vb[0], 239u) : fq == 1 ? pkf(va[1] + vb[1], 238u) : fq == 2 ? pkf(va[1] + vb[2], 237u) : pkf(va[1] + vb[3], 236u);
            cs[5] = fq == 0 ? pkf(va[1] + vb[4], 235u) : fq == 1 ? pkf(va[1] + vb[5], 234u) : fq == 2 ? pkf(va[1] + vb[6], 233u) : pkf(va[1] + vb[7], 232u);
            cs[6] = fq == 0 ? pkf(va[2] + vb[0], 223u) : fq == 1 ? pkf(va[2] + vb[1], 222u) : fq == 2 ? pkf(va[2] + vb[2], 221u) : pkf(va[2] + vb[3], 220u);
            cs[7] = fq == 0 ? pkf(va[2] + vb[4], 219u) : fq == 1 ? pkf(va[3] + vb[0], 207u) : fq == 2 ? pkf(va[3] + vb[1], 206u) : pkf(va[3] + vb[2], 205u);
            cs[8] = fq == 0 ? pkf(va[3] + vb[3], 204u) : fq == 1 ? pkf(va[4] + vb[0], 191u) : fq == 2 ? pkf(va[4] + vb[1], 190u) : pkf(va[4] + vb[2], 189u);
            cs[9] = fq == 0 ? pkf(va[5] + vb[0], 175u) : fq == 1 ? pkf(va[5] + vb[1], 174u) : fq == 2 ? pkf(va[6] + vb[0], 159u) : pkf(va[6] + vb[1], 158u);
            cs[10] = fq == 0 ? pkf(va[7] + vb[0], 143u) : fq == 1 ? pkf(va[7] + vb[1], 142u) : fq == 2 ? pkf(va[8] + vb[0], 127u) : pkf(va[9] + vb[0], 111u);
            cs[11] = fq == 0 ? pkf(va[10] + vb[0], 95u) : fq == 1 ? pkf(va[11] + vb[0], 79u) : fq == 2 ? pkf(va[12] + vb[0], 63u) : pkf(va[13] + vb[0], 47u);
            cs[12] = fq == 0 ? pkf(va[14] + vb[0], 31u) : fq == 1 ? pkf(va[15] + vb[0], 15u) : fq == 2 ? -INFINITY : -INFINITY;
            cs[13] = -INFINITY; cs[14] = -INFINITY; cs[15] = -INFINITY;
        }
        __builtin_amdgcn_sched_barrier(0);
        SORT16D(cs);
#pragma unroll
        for (int off = 16; off <= 32; off <<= 1) { float o[16];
#pragma unroll
            for (int i = 0; i < 16; ++i) o[i] = __shfl_xor(cs[15 - i], off);
#pragma unroll
            for (int i = 0; i < 16; ++i) cs[i] = fmaxf(cs[i], o[i]);
            MERGE16D(cs); }
        float bv[16];
#pragma unroll
        for (int i = 0; i < 16; ++i) bv[i] = cs[i];
        asm volatile("s_waitcnt lgkmcnt(0)" ::: "memory"); __builtin_amdgcn_sched_barrier(0);
        if (fq == 0) { int eid[16]; float ex[16]; float sm = 0.f; const float b0 = __uint_as_float(__float_as_uint(bv[0]) & 0xFFFFFF00u);
#pragma unroll
            for (int r = 0; r < 16; ++r) { const unsigned bits = __float_as_uint(bv[r]); const int f = 255 - (int)(bits & 255u); eid[r] = sI[fr * 32 + (f >> 4)] * 128 + sI[fr * 32 + 16 + (f & 15)];
                ex[r] = __expf(__uint_as_float(bits & 0xFFFFFF00u) - b0); sm += ex[r]; }
            const float inv = 1.f / sm; int* ep = EID + m * 128 + h * 16; float* gp = EG + m * 128 + h * 16;
#pragma unroll
            for (int r = 0; r < 16; r += 4) { *(int4*)(ep + r) = make_int4(eid[r], eid[r + 1], eid[r + 2], eid[r + 3]); *(f32x4*)(gp + r) = (f32x4){ex[r] * inv, ex[r + 1] * inv, ex[r + 2] * inv, ex[r + 3] * inv}; } }
        asm volatile("s_waitcnt lgkmcnt(0)" ::: "memory");
    }
  }
}
typedef float f32x2_t __attribute__((ext_vector_type(2)));
__device__ __forceinline__ void dec8(const u32x4 w, f32x2_t (&f)[8]) {
    const unsigned ww[4] = {w.x, w.y, w.z, w.w};
#pragma unroll
    for (int q = 0; q < 4; ++q) { f[2 * q] = __builtin_amdgcn_cvt_pk_f32_fp8((int)ww[q], false); f[2 * q + 1] = __builtin_amdgcn_cvt_pk_f32_fp8((int)ww[q], true); }
}
__device__ __forceinline__ void ph_peer_experts(const Args& a, int l, unsigned char* lds, int wv) {
    unsigned char* ws = oport(a.ws); const int tid = otid(wv), lane = tid & 63, wave = __builtin_amdgcn_readfirstlane(tid >> 6), gw = blockIdx.x * NWAVE + wave, ngw = gridDim.x * NWAVE;
    const bf16_t* H16 = (const bf16_t*)(ws + WS_H16); const int* EID = (const int*)(ws + WS_EID); const float* EG = (const float*)(ws + WS_EG);
    const unsigned char* U8 = (const unsigned char*)(ws + WS_U16); const unsigned char* V8 = (const unsigned char*)(ws + WS_V16);
    float* sPA = (float*)(lds + wave * 8192) + lane; float* sPB = sPA + 1024;
    int* sEA = (int*)(lds + 65536 + wave * 2048); float* sGA = (float*)(sEA + 128); int* sEB = sEA + 256; float* sGB = (float*)(sEB + 128);
    for (int it = 0, nit = ((M + ngw - 1) / ngw + 1) / 2; it < nit; ++it) { const int mA = gw + (2 * it) * ngw, mB = mA + ngw; const bool vA = mA < M, vB = mB < M;
        __syncthreads();
        if (!vA) continue;
        const int mBs = vB ? mB : mA;
        f32x2_t hpA[8], hpB[8], accA[8], accB[8];
#define LOADH(hp, m_) do { float hv_[16]; const u32x4 h0_ = *(const u32x4*)(H16 + (size_t)(m_) * D + lane * 16), h1_ = *(const u32x4*)(H16 + (size_t)(m_) * D + lane * 16 + 8); \
          hv_[0] = lo_bf(h0_.x); hv_[1] = hi_bf(h0_.x); hv_[2] = lo_bf(h0_.y); hv_[3] = hi_bf(h0_.y); hv_[4] = lo_bf(h0_.z); hv_[5] = hi_bf(h0_.z); hv_[6] = lo_bf(h0_.w); hv_[7] = hi_bf(h0_.w); \
          hv_[8] = lo_bf(h1_.x); hv_[9] = hi_bf(h1_.x); hv_[10] = lo_bf(h1_.y); hv_[11] = hi_bf(h1_.y); hv_[12] = lo_bf(h1_.z); hv_[13] = hi_bf(h1_.z); hv_[14] = lo_bf(h1_.w); hv_[15] = hi_bf(h1_.w); \
          _Pragma("unroll") for (int j_ = 0; j_ < 8; ++j_) hp[j_] = (f32x2_t){hv_[2 * j_], hv_[2 * j_ + 1]}; } while (0)
        LOADH(hpA, mA); LOADH(hpB, mBs);
#pragma unroll
        for (int j = 0; j < 8; ++j) { accA[j] = (f32x2_t){0.f, 0.f}; accB[j] = (f32x2_t){0.f, 0.f}; }
#define SORTTOK(m_, sE_, sG_) do { int key[2] = {EID[(size_t)(m_) * 128 + 2 * lane], EID[(size_t)(m_) * 128 + 2 * lane + 1]}; float pay[2] = {EG[(size_t)(m_) * 128 + 2 * lane], EG[(size_t)(m_) * 128 + 2 * lane + 1]}; \
          _Pragma("unroll") for (int k = 2; k <= 128; k <<= 1) _Pragma("unroll") for (int j = k >> 1; j >= 1; j >>= 1) { \
              if (j == 1) { const bool asc = ((2 * lane) & k) == 0; if ((key[0] > key[1]) == asc) { const int tk = key[0]; key[0] = key[1]; key[1] = tk; const float tp = pay[0]; pay[0] = pay[1]; pay[1] = tp; } } \
              else { const int lj = j >> 1; const bool keep_min = (((2 * lane) & k) == 0) == ((lane & lj) == 0); \
                  _Pragma("unroll") for (int r = 0; r < 2; ++r) { const int pk = __shfl_xor(key[r], lj); const float pp = __shfl_xor(pay[r], lj); const bool take = keep_min ? (pk < key[r]) : (pk > key[r]); if (take) { key[r] = pk; pay[r] = pp; } } } } \
          *(int2*)(sE_ + 2 * lane) = make_int2(key[0], key[1]); *(float2*)(sG_ + 2 * lane) = make_float2(pay[0], pay[1]); } while (0)
        SORTTOK(mA, sEA, sGA); SORTTOK(mBs, sEB, sGB);
        asm volatile("s_waitcnt lgkmcnt(0)" ::: "memory");
#pragma unroll 1
        for (int half = 0; half < 2; ++half) {
            const int pos = half * 64 + 4 * (lane & 15) + (((lane >> 4) == 1) ? 2 : ((lane >> 4) == 2) ? 1 : (lane >> 4));
            const int evA = sEA[pos], evB = sEB[pos]; const float gvA = sGA[pos], gvB = sGB[pos];
            u32x4 bufA[4], bufB[4];
#define ROWLD(dst, T, e_) dst = ((const u32x4*)(T + (size_t)(e_) * D))[lane]
#define KIDX(g, c) ((g) + ((c) == 1 ? 32 : (c) == 2 ? 16 : (c) == 3 ? 48 : 0))
#define LOADG(buf, T, ev_, g) do { _Pragma("unroll") for (int i_ = 0; i_ < 4; ++i_) ROWLD(buf[i_], T, __builtin_amdgcn_readlane(ev_, KIDX(g, i_))); } while (0)
#define BF2(a_, b_, o) (((lane & (o)) ? (b_) : (a_)) + __shfl_xor((lane & (o)) ? (a_) : (b_), (o)))
#define DOTG(buf, hp, sP_, g) do { float d4_[4]; _Pragma("unroll") for (int i_ = 0; i_ < 4; ++i_) { f32x2_t f_[8]; dec8(buf[i_], f_); f32x2_t d2_ = f_[0] * hp[0]; \
              _Pragma("unroll") for (int j_ = 1; j_ < 8; ++j_) d2_ = __builtin_elementwise_fma(f_[j_], hp[j_], d2_); d4_[i_] = d2_.x + d2_.y; } \
              const float q0_ = BF2(d4_[0], d4_[1], 32), q1_ = BF2(d4_[2], d4_[3], 32); sP_[(g) * 64] = BF2(q0_, q1_, 16); } while (0)
            LOADG(bufA, U8, evA, 0);
#pragma unroll 1
            for (int g = 0; g < 16; ++g) { const int gn = g < 15 ? g + 1 : 15;
                LOADG(bufB, U8, evB, g); DOTG(bufA, hpA, sPA, g);
                LOADG(bufA, U8, evA, gn); DOTG(bufB, hpB, sPB, g); }
            int svbA, svbB;
#define BFLY(o, n) do { const bool up_ = (lane & (o)) != 0; _Pragma("unroll") for (int i_ = 0; i_ < (n); ++i_) { const float a_ = p[i_], b_ = p[i_ + (n)]; const float sd_ = up_ ? a_ : b_, kp_ = up_ ? b_ : a_; p[i_] = kp_ + __shfl_xor(sd_, (o)); } } while (0)
#define FINISH(sP_, gv_, svb_) do { float p[16]; _Pragma("unroll") for (int i_ = 0; i_ < 16; ++i_) p[i_] = sP_[i_ * 64]; BFLY(8, 8); BFLY(4, 4); BFLY(2, 2); BFLY(1, 1); \
              svb_ = __builtin_bit_cast(int, gv_ * gelu_t(p[0] * (1.f / 256.f)) * (1.f / 64.f)); } while (0)
            FINISH(sPA, gvA, svbA); FINISH(sPB, gvB, svbB);
#define ACCG(buf, acc, svb_, g) do { _Pragma("unroll") for (int i_ = 0; i_ < 4; ++i_) { const float sk_ = __builtin_bit_cast(float, __builtin_amdgcn_readlane(svb_, KIDX(g, i_))); const f32x2_t s2_ = {sk_, sk_}; f32x2_t f_[8]; dec8(buf[i_], f_); \
              _Pragma("unroll") for (int j_ = 0; j_ < 8; ++j_) acc[j_] = __builtin_elementwise_fma(f_[j_], s2_, acc[j_]); } } while (0)
            LOADG(bufA, V8, evA, 0);
#pragma unroll 1
            for (int g = 0; g < 16; ++g) { const int gn = g < 15 ? g + 1 : 15;
                LOADG(bufB, V8, evB, g); ACCG(bufA, accA, svbA, g);
                LOADG(bufA, V8, evA, gn); ACCG(bufB, accB, svbB, g); }
#undef ROWLD
#undef KIDX
#undef LOADG
#undef BF2
#undef DOTG
#undef BFLY
#undef FINISH
#undef ACCG
        }
#define EPILOG(m_, acc2) do { float acc[16]; _Pragma("unroll") for (int j = 0; j < 8; ++j) { acc[2 * j] = acc2[j].x; acc[2 * j + 1] = acc2[j].y; } \
        float* xr = a.out + (size_t)(m_) * D + lane * 16; float xn[16]; float ss = 0.f; \
        _Pragma("unroll") for (int j = 0; j < 4; ++j) { const f32x4 xv = *(const f32x4*)(xr + 4 * j); xn[4 * j] = xv.x + acc[4 * j]; xn[4 * j + 1] = xv.y + acc[4 * j + 1]; xn[4 * j + 2] = xv.z + acc[4 * j + 2]; xn[4 * j + 3] = xv.w + acc[4 * j + 3]; } \
        _Pragma("unroll") for (int j = 0; j < 16; ++j) ss += xn[j] * xn[j]; \
        const float r = rsqrtf(wave_sum(ss) * (1.f / D) + EPS); \
        if (l + 1 < DEPTH) { const float* gn = a.norm1 + (size_t)(l + 1) * D + lane * 16; \
            _Pragma("unroll") for (int j = 0; j < 4; ++j) *(f32x4*)(xr + 4 * j) = (f32x4){xn[4 * j], xn[4 * j + 1], xn[4 * j + 2], xn[4 * j + 3]}; \
            u32x4 w0, w1; \
            w0.x = pk2(xn[0] * r * gn[0], xn[1] * r * gn[1]); w0.y = pk2(xn[2] * r * gn[2], xn[3] * r * gn[3]); w0.z = pk2(xn[4] * r * gn[4], xn[5] * r * gn[5]); w0.w = pk2(xn[6] * r * gn[6], xn[7] * r * gn[7]); \
            w1.x = pk2(xn[8] * r * gn[8], xn[9] * r * gn[9]); w1.y = pk2(xn[10] * r * gn[10], xn[11] * r * gn[11]); w1.z = pk2(xn[12] * r * gn[12], xn[13] * r * gn[13]); w1.w = pk2(xn[14] * r * gn[14], xn[15] * r * gn[15]); \
            *(u32x4*)((bf16_t*)(ws + WS_H16) + (size_t)(m_) * D + lane * 16) = w0; *(u32x4*)((bf16_t*)(ws + WS_H16) + (size_t)(m_) * D + lane * 16 + 8) = w1; \
        } else { const float* gn = a.final_gain + lane * 16; \
            _Pragma("unroll") for (int j = 0; j < 4; ++j) *(f32x4*)(xr + 4 * j) = (f32x4){xn[4 * j] * r * gn[4 * j], xn[4 * j + 1] * r * gn[4 * j + 1], xn[4 * j + 2] * r * gn[4 * j + 2], xn[4 * j + 3] * r * gn[4 * j + 3]}; } } while (0)
        EPILOG(mA, accA);
        if (vB) EPILOG(mB, accB);
#undef EPILOG
#undef LOADH
#undef SORTTOK
    }
}

constexpr int PH_PER_LAYER = 9, N_PHASES = 1 + DEPTH * PH_PER_LAYER;
__global__ void __launch_bounds__(NTHR, 2) fwd_kernel(Args a) {
    extern __shared__ __attribute__((aligned(16))) unsigned char lds[];
    const int wv = __builtin_amdgcn_readfirstlane((int)threadIdx.x >> 6);
    const int tid = threadIdx.x;
    for (int u = tid; u < (LDS_BYTES - LDS_CTL_OFF) / 4; u += NTHR) ((unsigned*)(lds + LDS_CTL_OFF))[u] = 0u;
    __syncthreads();
    unsigned* ctl = (unsigned*)(a.ws + WS_CTL);
    XcdBarrier bar = xcd_barrier_post(ctl + 4096, (volatile LAS unsigned*)(LAS unsigned char*)(lds + LDS_CTL_OFF), wv);
    const int lo = a.ph_lo, hi = a.ph_hi;
#define IN(k) (lo <= (k) && (k) < hi)
#define SEAM(k) do { if (IN(k) && IN((k) + 1)) xcd_barrier(bar, wv); } while (0)
    unsigned char* ws = oport(a.ws);
    if (IN(0)) { ph_prologue(a, lds, wv); } SEAM(0);
    for (int l = 0; l < DEPTH; ++l) {
        const int pb = 1 + l * PH_PER_LAYER;
        unsigned char* ws = oport(a.ws);
        if (IN(pb + 0)) {
            ph_kiwi(a, l, lds, wv);
            pg8::Gemm g{(const bf16_t*)(ws + WS_H16), (const bf16_t*)(ws + WS_WIN + (size_t)l * WIN_L), M, NMAIN, D, 0, 0};
            pg8::StaticOrder S; S.init(M, NMAIN, gridDim.x, blockIdx.x, 0);
            pg8::EpiIn E{(bf16_t*)(ws + WS_P16), (float*)(ws + WS_PF)};
            pg8::gemm_phase(((LAS unsigned char*)lds), g, S, E, wv);
        } SEAM(pb + 0);
        if (IN(pb + 1)) { ph_post(a, l, lds, wv); ph_h1(a, l, lds, wv); } SEAM(pb + 1);
        if (IN(pb + 2)) { ph_h2(a, wv); ph_gmlp(a, l, lds, wv); ph_sel(a, lds, wv); } SEAM(pb + 2);
        if (IN(pb + 3)) { ph_attn(a, lds, wv); ph_h3(a, l, lds, wv); } SEAM(pb + 3);
        if (IN(pb + 4)) {
            pg8::Gemm g{(const bf16_t*)(ws + WS_YALL), (const bf16_t*)(ws + WS_WBR + (size_t)l * WBR_L), M, 3072, 512, (size_t)M * 512 * 2, 4};
            pg8::BranchOrder S; S.init(gridDim.x, blockIdx.x);
            pg8::EpiGate E{(bf16_t*)(ws + WS_GB), (const bf16_t*)(ws + WS_P16)};
            pg8::gemm_phase(((LAS unsigned char*)lds), g, S, E, wv);
        } SEAM(pb + 4);
        if (IN(pb + 5)) {
            pg8::Gemm g{(const bf16_t*)(ws + WS_GB), (const bf16_t*)(ws + WS_WOUT + (size_t)l * WOUT_L), M, D, D, 0, 0};
            pg8::StaticOrder S; S.init(M, D, gridDim.x, blockIdx.x, 0);
            pg8::EpiRes E{a.out};
            pg8::gemm_phase(((LAS unsigned char*)lds), g, S, E, wv);
        } SEAM(pb + 5);
        if (IN(pb + 6)) { ph_norm2(a, l, wv); } SEAM(pb + 6);
        if (IN(pb + 7)) {
            pg8::Gemm g{(const bf16_t*)(ws + WS_H16), (const bf16_t*)(ws + WS_WPQ + (size_t)l * WPQ_L), M, 2048, D, 0, 0};
            pg8::StaticOrder S; S.init(M, 2048, gridDim.x, blockIdx.x, 0);
            pg8::EpiB16 E{(bf16_t*)(ws + WS_GB), 2048};
            pg8::gemm_phase(((LAS unsigned char*)lds), g, S, E, wv);
            asm volatile("s_waitcnt vmcnt(0)" ::: "memory"); __syncthreads();
            for (int i0_ = 0;; i0_ += 2) { pg8::Unit u0, u1; if (!S.next(i0_, u0)) break; const bool two = S.next(i0_ + 1, u1);
                ph_peer_select(a, l, lds, wv, two ? 2 : 1, u0.pm, u0.pn, two ? u1.pm : 0, two ? u1.pn : 0); }
        } SEAM(pb + 7);
        if (IN(pb + 8)) { ph_peer_experts(a, l, lds, wv); } SEAM(pb + 8);
    }
#undef IN
#undef SEAM
}

#ifndef MK_N_LAUNCHES
#define MK_N_LAUNCHES 1
#endif
extern "C" void kernel_launch(void* const* d_in, const int* in_sizes, int n_in, void* d_out, int out_size, void* d_ws, size_t ws_size, hipStream_t stream) {
    static int grid = 0;
    if (grid == 0) {
        if (n_in != 17 || out_size != M * D || ws_size < WS_END) { fprintf(stderr, "kernel_launch: unexpected shapes (n_in %d, out %d, ws %zu)\n", n_in, out_size, ws_size); grid = -1; return; }
        int dev = 0, cus = 0, per_cu = 0;
        if (hipGetDevice(&dev) != hipSuccess || hipDeviceGetAttribute(&cus, hipDeviceAttributeMultiprocessorCount, dev) != hipSuccess) { grid = -1; return; }
        if (hipFuncSetAttribute((const void*)fwd_kernel, hipFuncAttributeMaxDynamicSharedMemorySize, LDS_BYTES) != hipSuccess) { fprintf(stderr, "kernel_launch: hipFuncSetAttribute failed\n"); grid = -1; return; }
        if (hipOccupancyMaxActiveBlocksPerMultiprocessor(&per_cu, (const void*)fwd_kernel, NTHR, LDS_BYTES) != hipSuccess || per_cu < 1) { fprintf(stderr, "kernel_launch: occupancy query says %d\n", per_cu); (void)hipGetLastError(); grid = -1; return; }
        grid = cus;
    }
    if (grid < 0) return;
    (void)hipMemsetAsync((char*)d_ws + WS_CTL, 0, CTL_BYTES, stream);
    Args a{};
    a.x = (const float*)d_in[0]; a.pos = (const int*)d_in[1]; a.norm1 = (const float*)d_in[2]; a.w_in = (const float*)d_in[3]; a.lb_logits = (const float*)d_in[4]; a.hgrn_gain = (const float*)d_in[5];
    a.gmlp_gain = (const float*)d_in[6]; a.gmlp_ws = (const float*)d_in[7]; a.gmlp_bs = (const float*)d_in[8]; a.w_branch = (const float*)d_in[9]; a.w_out = (const float*)d_in[10]; a.norm2 = (const float*)d_in[11];
    a.peer_wq = (const float*)d_in[12]; a.peer_keys = (const float*)d_in[13]; a.peer_u = (const float*)d_in[14]; a.peer_v = (const float*)d_in[15]; a.final_gain = (const float*)d_in[16];
    a.out = (float*)d_out; a.ws = (unsigned char*)d_ws;
    if (MK_N_LAUNCHES == 1) { a.ph_lo = 0; a.ph_hi = N_PHASES; hipLaunchKernelGGL(fwd_kernel, dim3(grid), dim3(NTHR), LDS_BYTES, stream, a); }
    else for (int p = 0; p < N_PHASES; ++p) { a.ph_lo = p; a.ph_hi = p + 1; hipLaunchKernelGGL(fwd_kernel, dim3(grid), dim3(NTHR), LDS_BYTES, stream, a); }
}
```

```cpp
#include <hip/hip_runtime.h>
#include <cstdio>
#include <cstdint>

#define LAS __attribute__((address_space(3)))
typedef unsigned short bf16_t;
typedef short bf16x8 __attribute__((ext_vector_type(8)));
typedef float f32x4 __attribute__((ext_vector_type(4)));
typedef unsigned u32x4 __attribute__((ext_vector_type(4)));

constexpr int D = 1024, BATCH = 2, SEQ = 8192, DEPTH = 4, M = BATCH * SEQ;
constexpr int NIN = 8264;
constexpr int NPAD = 8448;
constexpr int C_AQ = 0, C_AF = 512, C_AI = 1024, C_AG = 1536, C_BU = 2048, C_BV = 2560, C_CQ = 3072, C_CK = 3584, C_CV = 4096, C_QI = 4608, C_GL = 5120, C_KI = 8192, C_WI = 8256;
constexpr int NMAIN = 8192;
constexpr int S_GL = 5192;
constexpr int PFW = 768;
constexpr float EPS = 1e-6f;
constexpr int NEXP = 16384;

constexpr size_t MiB = 1u << 20;
constexpr size_t WS_CTL = 0, CTL_BYTES = 1 * MiB;
constexpr size_t WS_WIN = 2 * MiB;
constexpr size_t WIN_L = (size_t)NPAD * D * 2;
constexpr size_t WS_WBR = 68 * MiB;
constexpr size_t WBR_L = (size_t)3072 * 512 * 2;
constexpr size_t WS_WOUT = 80 * MiB;
constexpr size_t WOUT_L = (size_t)1024 * 3072 * 2;
constexpr size_t WS_WPQ = 104 * MiB;
constexpr size_t WPQ_L = (size_t)2048 * 1024 * 2;
constexpr size_t WS_LB = 120 * MiB;
constexpr size_t WS_CS = 121 * MiB;
constexpr size_t WS_H16 = 134 * MiB;
constexpr size_t WS_P16 = 166 * MiB;
constexpr size_t WS_PF = 430 * MiB;
constexpr size_t WS_QR = 478 * MiB, WS_KR = 494 * MiB;
constexpr size_t WS_QI = 510 * MiB;
constexpr size_t WS_KI = 542 * MiB;
constexpr size_t WS_WI = 546 * MiB;
constexpr size_t WS_FF = 548 * MiB, WS_KK = 580 * MiB, WS_QF = 612 * MiB;
constexpr size_t WS_OA = 644 * MiB;
constexpr size_t WS_VN = 676 * MiB;
constexpr size_t WS_YALL = 708 * MiB;
constexpr size_t WS_GB = 756 * MiB;
constexpr size_t WS_EID = 852 * MiB, WS_EG = 860 * MiB;
constexpr size_t WS_DD = 120 * MiB + 256 * 1024;
constexpr size_t WS_WSB = 544 * MiB;
constexpr size_t WS_VT = 644 * MiB;
constexpr size_t WS_MASK = 660 * MiB;
constexpr size_t WS_U16 = 868 * MiB, WS_V16 = 900 * MiB;
constexpr size_t WS_SKB = 932 * MiB;
constexpr size_t WS_END = 934 * MiB;

__device__ const float ROPE_INV64[64] = {
1.000000000e+00f, 8.659643531e-01f, 7.498942614e-01f, 6.493816376e-01f, 5.623413324e-01f, 4.869675338e-01f, 4.216965139e-01f, 3.651741147e-01f, 3.162277639e-01f, 2.738419771e-01f, 2.371373773e-01f, 2.053525001e-01f, 1.778279394e-01f, 1.539926529e-01f, 1.333521307e-01f, 1.154782027e-01f, 1.000000015e-01f, 8.659642935e-02f, 7.498941571e-02f, 6.493816525e-02f, 5.623413250e-02f, 4.869675264e-02f, 4.216965288e-02f, 3.651741147e-02f, 3.162277490e-02f, 2.738419734e-02f, 2.371373773e-02f, 2.053525113e-02f, 1.778279431e-02f, 1.539926510e-02f, 1.333521493e-02f, 1.154782064e-02f, 9.999999776e-03f, 8.659643121e-03f, 7.498941850e-03f, 6.493816152e-03f, 5.623413250e-03f, 4.869675264e-03f, 4.216964822e-03f, 3.651741194e-03f, 3.162277630e-03f, 2.738419687e-03f, 2.371373586e-03f, 2.053524833e-03f, 1.778279431e-03f, 1.539926510e-03f, 1.333521446e-03f, 1.154781901e-03f, 1.000000047e-03f, 8.659643354e-04f, 7.498942432e-04f, 6.493816618e-04f, 5.623413017e-04f, 4.869675322e-04f, 4.216965172e-04f, 3.651741426e-04f, 3.162277571e-04f, 2.738419571e-04f, 2.371373703e-04f, 2.053525095e-04f, 1.778279402e-04f, 1.539926452e-04f, 1.333521504e-04f, 1.154782003e-04f};
__device__ const float ROPE_INV32[32] = {
1.000000000e+00f, 7.498942614e-01f, 5.623413324e-01f, 4.216965139e-01f, 3.162277639e-01f, 2.371373773e-01f, 1.778279394e-01f, 1.333521307e-01f, 1.000000015e-01f, 7.498941571e-02f, 5.623413250e-02f, 4.216965288e-02f, 3.162277490e-02f, 2.371373773e-02f, 1.778279431e-02f, 1.333521493e-02f, 9.999999776e-03f, 7.498941850e-03f, 5.623413250e-03f, 4.216964822e-03f, 3.162277630e-03f, 2.371373586e-03f, 1.778279431e-03f, 1.333521446e-03f, 1.000000047e-03f, 7.498942432e-04f, 5.623413017e-04f, 4.216965172e-04f, 3.162277571e-04f, 2.371373703e-04f, 1.778279402e-04f, 1.333521504e-04f};

__device__ __forceinline__ float bf2f(bf16_t b) { return __uint_as_float(((unsigned)b) << 16); }
__device__ __forceinline__ unsigned f2bf(float f) { unsigned u = __float_as_uint(f); return (u + 0x7fffu + ((u >> 16) & 1u)) >> 16; }
__device__ __forceinline__ unsigned pk2(float lo, float hi) { return f2bf(lo) | (f2bf(hi) << 16); }
__device__ __forceinline__ float lo_bf(unsigned w) { return __uint_as_float(w << 16); }
__device__ __forceinline__ float hi_bf(unsigned w) { return __uint_as_float(w & 0xffff0000u); }
__device__ __forceinline__ float sigm(float x) { return 1.f / (1.f + __expf(-x)); }
__device__ __forceinline__ float silu(float x) { return x * sigm(x); }
__device__ __forceinline__ float gelu_t(float x) { const float u = 0.7978845608028654f * (x + 0.044715f * x * x * x); const float th = 1.f - 2.f / (1.f + __expf(2.f * u)); return 0.5f * x * (1.f + th); }
__device__ __forceinline__ float wave_sum(float v) {
#pragma unroll
    for (int o = 1; o < 64; o <<= 1) v += __shfl_xor(v, o);
    return v;
}
__device__ __forceinline__ float wave_max(float v) {
#pragma unroll
    for (int o = 1; o < 64; o <<= 1) v = fmaxf(v, __shfl_xor(v, o));
    return v;
}
typedef __bf16 bf2_t __attribute__((ext_vector_type(2)));
__device__ __forceinline__ float dot2(unsigned a, unsigned b, float c) { return __builtin_amdgcn_fdot2_f32_bf16(__builtin_bit_cast(bf2_t, a), __builtin_bit_cast(bf2_t, b), c, false); }
__device__ __forceinline__ int otid(int wv) { int t; asm volatile("v_mbcnt_lo_u32_b32 %0, -1, 0\n\tv_mbcnt_hi_u32_b32 %0, -1, %0" : "=v"(t)); return wv * 64 + t; }
__device__ __forceinline__ unsigned char* oport(unsigned char* p) { unsigned long long z; asm volatile("s_mov_b64 %0, 0" : "=s"(z)); return p + z; }
__device__ __forceinline__ unsigned fkey(float f) { const unsigned u = __float_as_uint(f); return u ^ ((u >> 31) ? 0xFFFFFFFFu : 0x80000000u); }

#define XB_TMO      128
#define XB_XCNT(j)  (256  + 64 * (j))
#define XB_XSUB(j)  (1280 + 64 * (j))
#define XB_XGEN(j)  (2304 + 64 * (j))
#define XB_TOP      3328
#define XB_TOPGEN   3392
#define XCD_BAR_WORDS 3456
#define XB_SPIN_CAP (1u << 23)
__device__ __forceinline__ unsigned xb_ld(unsigned* p)              { return __hip_atomic_load(p, __ATOMIC_RELAXED, __HIP_MEMORY_SCOPE_AGENT); }
__device__ __forceinline__ unsigned xb_add(unsigned* p, unsigned v) { return __hip_atomic_fetch_add(p, v, __ATOMIC_RELAXED, __HIP_MEMORY_SCOPE_AGENT); }
__device__ __forceinline__ unsigned xb_xcc_id() { return (unsigned)__builtin_amdgcn_s_getreg((3 << 11) | 20) & 0xFu; }
#define XB_SPIN(cond, bar) do { unsigned _sp = 0; while (cond) { __builtin_amdgcn_s_sleep(1); \
    if ((++_sp & 255u) == 0u) { if (xb_ld(&(bar)[XB_TMO])) break; if (_sp > XB_SPIN_CAP) { atomicAdd(&(bar)[XB_TMO], 1u); break; } } } } while (0)
struct XcdBarrier { unsigned* bar; unsigned x; volatile LAS unsigned* st; };
__device__ __forceinline__ XcdBarrier xcd_barrier_post(unsigned* bar, volatile LAS unsigned* st, int wv) {
    XcdBarrier b; b.bar = bar; b.x = xb_xcc_id(); b.st = st;
    if (wv == 0) if ((otid(0) & 63) == 0) (void)xb_add(&bar[XB_XCNT(b.x)], 1u);
    return b;
}
__device__ __forceinline__ void xcd_barrier_complete(unsigned* bar, unsigned x, unsigned& nloc, unsigned& nx) {
    const unsigned G = gridDim.x * gridDim.y * gridDim.z;
    unsigned sum, cnt, mine, sp = 0u;
    for (;;) {
        sum = 0u; cnt = 0u; mine = 0u;
#pragma unroll
        for (unsigned j = 0; j < 16; ++j) { const unsigned c = xb_ld(&bar[XB_XCNT(j)]); sum += c; cnt += (c > 0u) ? 1u : 0u; mine = (j == x) ? c : mine; }
        if (sum == G) break;
        __builtin_amdgcn_s_sleep(1);
        if ((++sp & 255u) == 0u) { if (xb_ld(&bar[XB_TMO])) break; if (sp > XB_SPIN_CAP) { atomicAdd(&bar[XB_TMO], 1u); break; } }
    }
    nloc = mine > 0u ? mine : 1u; nx = cnt > 0u ? cnt : 1u;
}
__device__ __forceinline__ void xcd_barrier(const XcdBarrier& b, int wv) {
    asm volatile("s_waitcnt vmcnt(0)" ::: "memory");
    __syncthreads();
    if (wv == 0) if ((otid(0) & 63) == 0) {
        unsigned* bar = b.bar;
        __builtin_amdgcn_s_waitcnt(0);
        unsigned nloc = b.st[0], nx = b.st[1];
        if (nloc == 0u) { xcd_barrier_complete(bar, b.x, nloc, nx); b.st[0] = nloc; b.st[1] = nx; }
        const unsigned old = xb_add(&bar[XB_XSUB(b.x)], 1u);
        const unsigned gen = old / nloc;
        if (old + 1u == (gen + 1u) * nloc) {
            __builtin_amdgcn_fence(__ATOMIC_RELEASE, "agent");
            asm volatile("s_waitcnt vmcnt(0)" ::: "memory");
            const unsigned og = xb_add(&bar[XB_TOP], 1u);
            const unsigned tg = og / nx;
            if (og + 1u == (tg + 1u) * nx) xb_add(&bar[XB_TOPGEN], 1u);
            else XB_SPIN(xb_ld(&bar[XB_TOPGEN]) == tg, bar);
            __builtin_amdgcn_fence(__ATOMIC_ACQUIRE, "agent");
            xb_add(&bar[XB_XGEN(b.x)], 1u);
            asm volatile("s_waitcnt vmcnt(0)" ::: "memory");
        } else {
            XB_SPIN(xb_ld(&bar[XB_XGEN(b.x)]) == gen, bar);
            __builtin_amdgcn_fence(__ATOMIC_ACQUIRE, "agent");
            asm volatile("s_waitcnt vmcnt(0)" ::: "memory");
        }
    }
    __syncthreads();
}

namespace pg8 {
constexpr int BM = 256, BK = 64, HALF = 128, HTB = HALF * BK * 2, STAGE_BYTES = 8 * HTB, NXCD = 8, WGM = 8;
__host__ __device__ __forceinline__ int lds_byte(int r, int c) { const int st = (r >> 4) * 2 + (c >> 5), rr = r & 15, cc = c & 31, ob = rr * 64 + cc * 2; return st * 1024 + (ob ^ (((ob >> 9) & 1) << 5)); }
__host__ __device__ __forceinline__ void stage_rc(int b, int& R, int& C) { const int st = b / 1024, sb = b % 1024, swz = sb ^ (((sb >> 9) & 1) << 5); R = (st >> 1) * 16 + swz / 64; C = (st & 1) * 32 + (swz % 64) / 2; }
__host__ __device__ __forceinline__ int perm32(int rho) { const int n = rho >> 4, i = rho & 15; return 8 * (i >> 2) + 4 * n + (i & 3); }
struct Unit { int pm, pn, ka; };
struct Gemm { const bf16_t* A; const bf16_t* Bt; int M, N, K; size_t strideA; int nsplit; };
struct StaticOrder {
    int nM, nN, nwg, G, c, nsplit;
    __device__ __forceinline__ void init(int M_, int N_, int G_, int c_, int nsplit_) { nM = M_ / BM; nN = N_ / BM; nwg = nM * nN; G = G_; c = c_; nsplit = nsplit_; }
    __device__ __forceinline__ bool next(int i, Unit& u) const {
        const long L = (long)i * G + c; if (L >= nwg) return false;
        int wgid = (int)L; { const int q = nwg / NXCD, r = nwg % NXCD, xcd = wgid % NXCD, off = wgid / NXCD; wgid = (xcd < r ? xcd * (q + 1) : r * (q + 1) + (xcd - r) * q) + off; }
        const int nig = WGM * nN, gid = wgid / nig, fm = gid * WGM, gsz = (nM - fm) < WGM ? (nM - fm) : WGM;
        u.pm = fm + ((wgid % nig) % gsz); u.pn = (wgid % nig) / gsz; u.ka = nsplit ? u.pn / nsplit : 0; return true;
    }
};
__device__ __forceinline__ unsigned cvt_pk_bf16(float lo, float hi) { unsigned r; asm volatile("v_cvt_pk_bf16_f32 %0, %1, %2" : "=v"(r) : "v"(lo), "v"(hi)); return r; }

template <class Epi, class Sched>
__device__ __forceinline__ void gemm_phase(LAS unsigned char* lds, const Gemm g, const Sched& S, const Epi& E, int wv) {
    const int tid = otid(wv), wid = __builtin_amdgcn_readfirstlane(tid >> 6), lane = tid & 63, wr = wid >> 2, wc = wid & 3, fr = lane & 15, fq = lane >> 4;
    const int K = g.K, nt = K / BK;
    unsigned voffA[2], voffB[2];
#pragma unroll
    for (int i = 0; i < 2; ++i) { int R, C; stage_rc(tid * 16 + i * 8192, R, C); const int Rb = Epi::PERM ? ((R & ~31) + perm32(R & 31)) : R;
        voffA[i] = (unsigned)(R * K + C) * 2u; voffB[i] = (unsigned)(Rb * K + C) * 2u; }
    const size_t kstep = (size_t)(BK * 2);
    const size_t hstep = (size_t)HALF * K * 2;
    const size_t tstep = 2 * hstep;
    const unsigned ldsw = (unsigned)wid * 1024u;
    const int aoff = lds_byte(wr * 64 + fr, fq * 8), boff = lds_byte(wc * 32 + fr, fq * 8);
#define PG8_SA(b, h) (((b) * 2 + (h)) * HTB)
#define PG8_SB(b, h) ((4 + (b) * 2 + (h)) * HTB)
#define PG8_STAGE(bufoff, gbase, voff) do { _Pragma("unroll") for (int _i = 0; _i < 2; ++_i) \
        __builtin_amdgcn_global_load_lds((const unsigned*)((const char*)(gbase) + (voff)[_i]), (LAS unsigned*)(lds + (bufoff) + ldsw + _i * 8192), 16, 0, 0); } while (0)
#define PG8_LDA(dst, b, h) do { _Pragma("unroll") for (int m = 0; m < 4; ++m) _Pragma("unroll") for (int k = 0; k < 2; ++k) dst[m][k] = *(const LAS bf16x8*)(lds + PG8_SA(b, h) + aoff + m * 2048 + k * 1024); } while (0)
#define PG8_LDB(dst, b, h) do { _Pragma("unroll") for (int n = 0; n < 2; ++n) _Pragma("unroll") for (int k = 0; k < 2; ++k) dst[n][k] = *(const LAS bf16x8*)(lds + PG8_SB(b, h) + boff + n * 2048 + k * 1024); } while (0)
#define PG8_MMA(ai, bj, At, Bt) do { __builtin_amdgcn_s_setprio(1); _Pragma("unroll") for (int m = 0; m < 4; ++m) _Pragma("unroll") for (int n = 0; n < 2; ++n) _Pragma("unroll") for (int k = 0; k < 2; ++k) \
        acc[ai][bj][m][n] = __builtin_amdgcn_mfma_f32_16x16x32_bf16(Bt[n][k], At[m][k], acc[ai][bj][m][n], 0, 0, 0); __builtin_amdgcn_s_setprio(0); } while (0)
#define PG8_WAIT_V(n) asm volatile("s_waitcnt vmcnt(" #n ")" ::: "memory")
#define PG8_WAIT_L(n) asm volatile("s_waitcnt lgkmcnt(" #n ")" ::: "memory")
#define PG8_BAR __builtin_amdgcn_s_barrier()
#define PG8_SCHED __builtin_amdgcn_sched_barrier(0)
    Unit cur, nxt; int ui = 0;
    if (!S.next(0, cur)) return;
    f32x4 acc[2][2][4][2];
#pragma unroll
    for (int a = 0; a < 2; ++a)
#pragma unroll
        for (int b = 0; b < 2; ++b)
#pragma unroll
            for (int m = 0; m < 4; ++m)
#pragma unroll
                for (int n = 0; n < 2; ++n) acc[a][b][m][n] = (f32x4){0.f, 0.f, 0.f, 0.f};
    bf16x8 At[4][2], B0[2][2], B1[2][2];
    const char* cA = (const char*)g.A + (size_t)cur.ka * g.strideA + (size_t)cur.pm * tstep; const char* cB = (const char*)g.Bt + (size_t)cur.pn * tstep;
    PG8_STAGE(PG8_SB(0, 0), cB, voffB); PG8_STAGE(PG8_SA(0, 0), cA, voffA); PG8_STAGE(PG8_SB(0, 1), cB + hstep, voffB); PG8_STAGE(PG8_SA(0, 1), cA + hstep, voffA);
    if (wr == 1) PG8_BAR;
    PG8_WAIT_V(4); PG8_BAR;
    PG8_STAGE(PG8_SB(1, 0), cB + kstep, voffB); PG8_STAGE(PG8_SA(1, 0), cA + kstep, voffA); PG8_STAGE(PG8_SB(1, 1), cB + hstep + kstep, voffB);
    PG8_WAIT_V(6); PG8_BAR;
    for (;;) {
        const bool has_next = S.next(ui + 1, nxt);
        const char* nA = has_next ? (const char*)g.A + (size_t)nxt.ka * g.strideA + (size_t)nxt.pm * tstep : cA; const char* nB = has_next ? (const char*)g.Bt + (size_t)nxt.pn * tstep : cB;
        for (int t = 0; t < nt; t += 2) {
            const bool last = (t == nt - 2);
            const char* a1 = cA + (size_t)(t + 1) * kstep;
            const char* a2 = last ? nA : cA + (size_t)(t + 2) * kstep; const char* b2 = last ? nB : cB + (size_t)(t + 2) * kstep;
            const char* a3 = a2 + kstep; const char* b3 = b2 + kstep;
            PG8_LDB(B0, 0, 0); PG8_SCHED; PG8_LDA(At, 0, 0); PG8_STAGE(PG8_SA(1, 1), a1 + hstep, voffA);
            PG8_WAIT_L(8); PG8_BAR; PG8_WAIT_L(0); PG8_MMA(0, 0, At, B0); PG8_BAR; PG8_SCHED;
            PG8_LDB(B1, 0, 1); PG8_STAGE(PG8_SB(0, 0), b2, voffB);
            PG8_BAR; PG8_WAIT_L(0); PG8_MMA(0, 1, At, B1); PG8_BAR;
            PG8_LDA(At, 0, 1); PG8_STAGE(PG8_SA(0, 0), a2, voffA);
            PG8_BAR; PG8_WAIT_L(0); PG8_MMA(1, 0, At, B0); PG8_BAR; PG8_SCHED;
            PG8_STAGE(PG8_SB(0, 1), b2 + hstep, voffB);
            PG8_WAIT_V(6); PG8_BAR; PG8_MMA(1, 1, At, B1); PG8_BAR;
            PG8_LDB(B0, 1, 0); PG8_SCHED; PG8_LDA(At, 1, 0); PG8_STAGE(PG8_SA(0, 1), a2 + hstep, voffA);
            PG8_WAIT_L(8); PG8_BAR; PG8_WAIT_L(0); PG8_MMA(0, 0, At, B0); PG8_BAR; PG8_SCHED;
            PG8_LDB(B1, 1, 1); PG8_STAGE(PG8_SB(1, 0), b3, voffB);
            PG8_BAR; PG8_WAIT_L(0); PG8_MMA(0, 1, At, B1); PG8_BAR;
            PG8_LDA(At, 1, 1); PG8_STAGE(PG8_SA(1, 0), a3, voffA);
            PG8_BAR; PG8_WAIT_L(0); PG8_MMA(1, 0, At, B0); PG8_BAR; PG8_SCHED;
            PG8_STAGE(PG8_SB(1, 1), b3 + hstep, voffB);
            PG8_WAIT_V(6); PG8_BAR; PG8_MMA(1, 1, At, B1); PG8_BAR;
        }
        E(acc, cur, wr, wc, fr, fq);
        if (!has_next) break;
        if (!E.keep(cur))
#pragma unroll
        for (int a = 0; a < 2; ++a)
#pragma unroll
            for (int b = 0; b < 2; ++b)
#pragma unroll
                for (int m = 0; m < 4; ++m)
#pragma unroll
                    for (int n = 0; n < 2; ++n) acc[a][b][m][n] = (f32x4){0.f, 0.f, 0.f, 0.f};
        cur = nxt; cA = nA; cB = nB; ++ui;
    }
    PG8_WAIT_V(0);
    if (wr == 0) PG8_BAR;
    PG8_BAR;
#undef PG8_SA
#undef PG8_SB
#undef PG8_STAGE
#undef PG8_LDA
#undef PG8_LDB
#undef PG8_MMA
#undef PG8_WAIT_V
#undef PG8_WAIT_L
#undef PG8_BAR
#undef PG8_SCHED
}

struct EpiIn {
    __device__ __forceinline__ bool keep(const Unit&) const { return false; }
    static constexpr bool PERM = true;
    bf16_t* P16; float* PF;
    __device__ __forceinline__ void operator()(f32x4 (&acc)[2][2][4][2], const Unit& u, int wr, int wc, int fr, int fq) const {
        const int row0 = u.pm * BM + wr * 64 + fr, col0 = u.pn * BM + wc * 32 + 8 * fq;
        const bool f32t = (u.pn == 2) || (u.pn == 3), gate = u.pn >= C_GL / 256;
        const int pfc0 = (u.pn - 2) * 256 + wc * 32 + 8 * fq;
#pragma unroll
        for (int ai = 0; ai < 2; ++ai)
#pragma unroll
            for (int m = 0; m < 4; ++m) { const size_t row = (size_t)(row0 + ai * HALF + m * 16);
#pragma unroll
                for (int bj = 0; bj < 2; ++bj) { f32x4 v0 = acc[ai][bj][m][0], v1 = acc[ai][bj][m][1];
                    if (gate) {
#pragma unroll
                        for (int j = 0; j < 4; ++j) { v0[j] = sigm(v0[j]); v1[j] = sigm(v1[j]); } }
                    u32x4 w; w.x = cvt_pk_bf16(v0[0], v0[1]); w.y = cvt_pk_bf16(v0[2], v0[3]); w.z = cvt_pk_bf16(v1[0], v1[1]); w.w = cvt_pk_bf16(v1[2], v1[3]);
                    *(u32x4*)(P16 + row * NPAD + col0 + bj * HALF) = w;
                    if (f32t) { float* pf = PF + row * PFW + pfc0 + bj * HALF; *(f32x4*)pf = v0; *(f32x4*)(pf + 4) = v1; } } }
    }
};
struct EpiGate {
    static constexpr bool PERM = true;
    bf16_t* GS; const bf16_t* P16;
    __device__ __forceinline__ bool keep(const Unit& u) const { return (u.pn >> 2) < 2; }
    __device__ __forceinline__ void operator()(f32x4 (&acc)[2][2][4][2], const Unit& u, int wr, int wc, int fr, int fq) const {
        const int n = u.pn >> 2, row0 = u.pm * BM + wr * 64 + fr, col0 = (u.pn & 3) * BM + wc * 32 + 8 * fq;
#pragma unroll
        for (int ai = 0; ai < 2; ++ai) {
            u32x4 gwv[4][2], hwv[4][2];
#pragma unroll
            for (int m = 0; m < 4; ++m)
#pragma unroll
                for (int bj = 0; bj < 2; ++bj) { const size_t row = (size_t)(row0 + ai * HALF + m * 16);
                    gwv[m][bj] = *(const u32x4*)(P16 + row * NPAD + C_GL + n * 1024 + col0 + bj * HALF);
                    if (n < 2) hwv[m][bj] = *(const u32x4*)(P16 + row * NPAD + C_GL + (n + 1) * 1024 + col0 + bj * HALF); else hwv[m][bj] = gwv[m][bj]; }
#pragma unroll
            for (int m = 0; m < 4; ++m)
#pragma unroll
                for (int bj = 0; bj < 2; ++bj) { const size_t row = (size_t)(row0 + ai * HALF + m * 16); f32x4& v0 = acc[ai][bj][m][0]; f32x4& v1 = acc[ai][bj][m][1];
                    const u32x4 gw = gwv[m][bj], hw = hwv[m][bj];
                    const float g[8] = {lo_bf(gw.x), hi_bf(gw.x), lo_bf(gw.y), hi_bf(gw.y), lo_bf(gw.z), hi_bf(gw.z), lo_bf(gw.w), hi_bf(gw.w)};
                    if (n < 2) { const float h[8] = {lo_bf(hw.x), hi_bf(hw.x), lo_bf(hw.y), hi_bf(hw.y), lo_bf(hw.z), hi_bf(hw.z), lo_bf(hw.w), hi_bf(hw.w)};
#pragma unroll
                        for (int j = 0; j < 4; ++j) { v0[j] *= g[j] * __builtin_amdgcn_rcpf(h[j]); v1[j] *= g[4 + j] * __builtin_amdgcn_rcpf(h[4 + j]); }
                    } else { u32x4 w;
                        w.x = cvt_pk_bf16(v0[0] * g[0], v0[1] * g[1]); w.y = cvt_pk_bf16(v0[2] * g[2], v0[3] * g[3]);
                        w.z = cvt_pk_bf16(v1[0] * g[4], v1[1] * g[5]); w.w = cvt_pk_bf16(v1[2] * g[6], v1[3] * g[7]);
                        *(u32x4*)(GS + row * D + col0 + bj * HALF) = w; } }
        }
    }
};
struct BranchOrder {
    StaticOrder so; int G;
    __device__ __forceinline__ void init(int G_, int c_) { so.init(M, 1024, G_, c_, 0); G = G_; }
    __device__ __forceinline__ bool next(int i, Unit& u) const { Unit t; if (!so.next(i / 3, t)) return false; const int n = i % 3; u.pm = t.pm; u.pn = n * 4 + t.pn; u.ka = n; return true; }
};
struct EpiRes {
    __device__ __forceinline__ bool keep(const Unit&) const { return false; }
    static constexpr bool PERM = false;
    float* X;
    __device__ __forceinline__ void operator()(f32x4 (&acc)[2][2][4][2], const Unit& u, int wr, int wc, int fr, int fq) const {
        const int row0 = u.pm * BM + wr * 64 + fr, col0 = u.pn * BM + wc * 32 + 4 * fq;
#pragma unroll
        for (int ai = 0; ai < 2; ++ai)
#pragma unroll
            for (int m = 0; m < 4; ++m) { float* rowp = X + (size_t)(row0 + ai * HALF + m * 16) * D + col0;
#pragma unroll
                for (int bj = 0; bj < 2; ++bj)
#pragma unroll
                    for (int n = 0; n < 2; ++n) { f32x4* p = (f32x4*)(rowp + bj * HALF + n * 16); *p = *p + acc[ai][bj][m][n]; } }
    }
};
struct EpiB16 {
    __device__ __forceinline__ bool keep(const Unit&) const { return false; }
    static constexpr bool PERM = true;
    bf16_t* O; int ldc;
    __device__ __forceinline__ void operator()(f32x4 (&acc)[2][2][4][2], const Unit& u, int wr, int wc, int fr, int fq) const {
        const int row0 = u.pm * BM + wr * 64 + fr, col0 = u.pn * BM + wc * 32 + 8 * fq;
#pragma unroll
        for (int ai = 0; ai < 2; ++ai)
#pragma unroll
            for (int m = 0; m < 4; ++m) { bf16_t* rowp = O + (size_t)(row0 + ai * HALF + m * 16) * ldc + col0;
#pragma unroll
                for (int bj = 0; bj < 2; ++bj) { const f32x4 v0 = acc[ai][bj][m][0], v1 = acc[ai][bj][m][1];
                    u32x4 w; w.x = cvt_pk_bf16(v0[0], v0[1]); w.y = cvt_pk_bf16(v0[2], v0[3]); w.z = cvt_pk_bf16(v1[0], v1[1]); w.w = cvt_pk_bf16(v1[2], v1[3]);
                    *(u32x4*)(rowp + bj * HALF) = w; } }
    }
};
}

struct Args {
    const float* x; const int* pos; const float* norm1; const float* w_in; const float* lb_logits; const float* hgrn_gain; const float* gmlp_gain; const float* gmlp_ws; const float* gmlp_bs;
    const float* w_branch; const float* w_out; const float* norm2; const float* peer_wq; const float* peer_keys; const float* peer_u; const float* peer_v; const float* final_gain;
    float* out; unsigned char* ws; int ph_lo, ph_hi;
};
constexpr int NTHR = 512, NWAVE = 8;
constexpr int LDS_BYTES = 147456;
constexpr int LDS_CTL_OFF = 143360;

__device__ __forceinline__ void tr_item(const float* src, int ldsrc, int c0, int nvalid, bf16_t* dst, int ldd, int r0, int koff, float* scr, int item, int nblk, int lane) {
    const int kb = item / nblk, nb = item % nblk, k0 = 64 * kb, n0 = 32 * nb;
    const int nn = n0 + (lane & 31);
    float tv[32];
#pragma unroll
    for (int i = 0; i < 32; ++i) { const int kk = 2 * i + (lane >> 5); tv[i] = (nn < nvalid) ? src[(size_t)(k0 + kk) * ldsrc + c0 + nn] : 0.f; }
#pragma unroll
    for (int i = 0; i < 32; ++i) { const int kk = 2 * i + (lane >> 5); scr[kk * 33 + (lane & 31)] = tv[i]; }
    asm volatile("s_waitcnt lgkmcnt(0)" ::: "memory");
    const int c = lane & 7;
#pragma unroll
    for (int j = 0; j < 4; ++j) { const int n = (lane >> 3) + 8 * j; const float* s = scr + (8 * c) * 33 + n;
        u32x4 o; o.x = pk2(s[0 * 33], s[1 * 33]); o.y = pk2(s[2 * 33], s[3 * 33]); o.z = pk2(s[4 * 33], s[5 * 33]); o.w = pk2(s[6 * 33], s[7 * 33]);
        *(u32x4*)(dst + (size_t)(r0 + n0 + n) * ldd + koff + k0 + 8 * c) = o; }
    asm volatile("s_waitcnt lgkmcnt(0)" ::: "memory");
}
__device__ __forceinline__ void rms_row_to_bf16(const float* xrow, const float* gain, bf16_t* orow, int lane) {
    const f32x4* xr = (const f32x4*)xrow + lane; const f32x4* gr = (const f32x4*)gain + lane;
    f32x4 v[4]; float s = 0.f;
#pragma unroll
    for (int j = 0; j < 4; ++j) { v[j] = xr[64 * j]; s += (v[j].x * v[j].x + v[j].y * v[j].y) + (v[j].z * v[j].z + v[j].w * v[j].w); }
    const float r = rsqrtf(wave_sum(s) * (1.f / D) + EPS);
    unsigned long long* o8 = (unsigned long long*)orow + lane;
#pragma unroll
    for (int j = 0; j < 4; ++j) { const f32x4 g = gr[64 * j]; o8[64 * j] = (unsigned long long)pk2(v[j].x * r * g.x, v[j].y * r * g.y) | ((unsigned long long)pk2(v[j].z * r * g.z, v[j].w * r * g.w) << 32); }
}

__device__ __forceinline__ void ph_prologue(const Args& a, unsigned char* lds, int wv) {
    const int tid = otid(wv), lane = tid & 63, wave = tid >> 6;
    const int gw = blockIdx.x * NWAVE + wave, ngw = gridDim.x * NWAVE;
    const size_t gtid = (size_t)blockIdx.x * NTHR + tid, gsz = (size_t)gridDim.x * NTHR;
    unsigned char* ws = oport(a.ws);
    { const f32x4* s = (const f32x4*)a.x; f32x4* d = (f32x4*)a.out; for (size_t i = gtid; i < (size_t)M * D / 4; i += gsz) d[i] = s[i]; }
    float* scr = (float*)(lds + wave * 16384);
    constexpr int I_IN1 = 16 * 160, I_IN2 = 16 * 8, I_IN3 = 16 * 96, I_IN = I_IN1 + I_IN2 + I_IN3;
    constexpr int I_BR = 3 * 8 * 32, I_OUT = 16 * 32, I_PQ = 16 * 64, I_L = I_IN + I_BR + I_OUT + I_PQ;
    for (int it = gw; it < DEPTH * I_L; it += ngw) {
        const int l = it / I_L; int r = it % I_L;
        bf16_t* win = (bf16_t*)(ws + WS_WIN + (size_t)l * WIN_L); const float* src_in = a.w_in + (size_t)l * D * NIN;
        if (r < I_IN1) { tr_item(src_in, NIN, 0, 5120, win, D, 0, 0, scr, r, 160, lane); continue; } r -= I_IN1;
        if (r < I_IN2) { tr_item(src_in, NIN, 5120, 72, win, D, C_KI, 0, scr, r, 8, lane); continue; } r -= I_IN2;
        if (r < I_IN3) { tr_item(src_in, NIN, S_GL, 3072, win, D, C_GL, 0, scr, r, 96, lane); continue; } r -= I_IN3;
        if (r < I_BR) { const int n = r / 256; tr_item(a.w_branch + ((size_t)l * 3 + n) * 512 * D, D, 0, 1024, (bf16_t*)(ws + WS_WBR + (size_t)l * WBR_L), 512, n * 1024, 0, scr, r % 256, 32, lane); continue; } r -= I_BR;
        if (r < I_OUT) { tr_item(a.w_out + (size_t)l * D * D, D, 0, 1024, (bf16_t*)(ws + WS_WOUT + (size_t)l * WOUT_L), D, 0, 0, scr, r, 32, lane); continue; } r -= I_OUT;
        tr_item(a.peer_wq + (size_t)l * D * 2048, 2048, 0, 2048, (bf16_t*)(ws + WS_WPQ + (size_t)l * WPQ_L), D, 0, 0, scr, r, 64, lane);
    }
    if (gtid < 512) { float v[DEPTH], mx = -1e30f; for (int l = 0; l < DEPTH; ++l) { v[l] = a.lb_logits[l * 512 + gtid]; mx = fmaxf(mx, v[l]); }
        float s = 0.f; for (int l = 0; l < DEPTH; ++l) { v[l] = __expf(v[l] - mx); s += v[l]; }
        float c = 0.f; float* lb = (float*)(ws + WS_LB); for (int l = 0; l < DEPTH; ++l) { if (l > 0) c += v[l] / s; lb[l * 512 + gtid] = c; } }
    { u32x4* SKB = (u32x4*)(ws + WS_SKB); const f32x4* sk = (const f32x4*)a.peer_keys; for (size_t i = gtid; i < (size_t)DEPTH * 16 * 128 * 128 / 8; i += gsz) { const f32x4 k0 = sk[2 * i], k1 = sk[2 * i + 1]; SKB[i] = (u32x4){pk2(k0.x, k0.y), pk2(k0.z, k0.w), pk2(k1.x, k1.y), pk2(k1.z, k1.w)}; } }
    { bf16_t* WSB = (bf16_t*)(ws + WS_WSB); for (size_t i = gtid; i < (size_t)DEPTH * 4 * 128 * 128; i += gsz) { const int t = (int)((i >> 7) & 127), sx = (int)(i & 127); WSB[i] = (bf16_t)f2bf(sx <= t ? a.gmlp_ws[i] : 0.f); } }
    { float2* cs = (float2*)(ws + WS_CS);
      for (size_t i = gtid; i < (size_t)M * 96; i += gsz) { const int m = (int)(i / 96), j = (int)(i % 96);
          const float inv = j < 64 ? ROPE_INV64[j] : ROPE_INV32[j - 64]; const float angf = (float)a.pos[m] * inv;
          const double ang = (double)angf; const double k = rint(ang * 0.15915494309189535); const float r = (float)(ang - k * 6.283185307179586);
          cs[i] = make_float2(__cosf(r), __sinf(r)); } }
    for (int m = gw; m < M; m += ngw) rms_row_to_bf16(a.x + (size_t)m * D, a.norm1, (bf16_t*)(ws + WS_H16) + (size_t)m * D, lane);
}

__device__ __forceinline__ void ph_kiwi(const Args& a, int l, unsigned char* lds, int wv) {
    unsigned char* ws = oport(a.ws); const int tid = otid(wv), lane = tid & 63, wave = __builtin_amdgcn_readfirstlane(tid >> 6), g4 = wave & 3, kh = wave >> 2, fr = lane & 15, fq = lane >> 4;
    const bf16_t* H16 = (const bf16_t*)(ws + WS_H16); const bf16_t* W = (const bf16_t*)(ws + WS_WIN + (size_t)l * WIN_L) + (size_t)C_KI * D; float* PF = (float*)(ws + WS_PF);
    f32x4* sK = (f32x4*)lds + (g4 * 5) * 64 + lane;
    for (int base = blockIdx.x; base * 4 < M / 16; base += gridDim.x) { const int tg = base * 4 + g4; f32x4 acc[5];
#pragma unroll
        for (int nt = 0; nt < 5; ++nt) acc[nt] = (f32x4){0.f, 0.f, 0.f, 0.f};
#pragma unroll 8
        for (int ks = 16 * kh; ks < 16 * kh + 16; ++ks) { const bf16x8 y = ((const bf16x8*)(H16 + (size_t)tg * 16 * D + 32 * ks))[fr * (D / 8) + fq];
#pragma unroll
            for (int nt = 0; nt < 5; ++nt) { const bf16x8 x = ((const bf16x8*)(W + (size_t)nt * 16 * D + 32 * ks))[fr * (D / 8) + fq]; acc[nt] = __builtin_amdgcn_mfma_f32_16x16x32_bf16(x, y, acc[nt], 0, 0, 0); } }
        __syncthreads();
        if (kh == 1) {
#pragma unroll
            for (int nt = 0; nt < 5; ++nt) sK[nt * 64] = acc[nt]; }
        __syncthreads();
        if (kh == 0) {
#pragma unroll
            for (int nt = 0; nt < 5; ++nt) *(f32x4*)(PF + ((size_t)tg * 16 + fr) * PFW + 512 + 16 * nt + 4 * fq) = acc[nt] + sK[nt * 64]; }
    }
    __syncthreads();
}

__device__ __forceinline__ void ph_post(const Args& a, int l, unsigned char* lds, int wv) {
    const int tid = otid(wv), lane = tid & 63, wave = tid >> 6;
    const int gw = blockIdx.x * NWAVE + wave, ngw = gridDim.x * NWAVE;
    const size_t gtid = (size_t)blockIdx.x * NTHR + tid, gsz = (size_t)gridDim.x * NTHR;
    unsigned char* ws = oport(a.ws);
    const bf16_t* P16 = (const bf16_t*)(ws + WS_P16); const float* PF = (const float*)(ws + WS_PF); const float2* cs = (const float2*)(ws + WS_CS);
    { bf16_t* QR = (bf16_t*)(ws + WS_QR); bf16_t* KR = (bf16_t*)(ws + WS_KR);
#pragma unroll 4
      for (size_t i = gtid; i < (size_t)M * 256; i += gsz) { const int m = (int)(i >> 8), h = (int)((i >> 6) & 3), j = (int)(i & 63);
          const float2 c = cs[(size_t)m * 96 + j]; const size_t pb = (size_t)m * NPAD + h * 128 + j, ob = (size_t)m * 512 + h * 128 + j;
          const float q1 = bf2f(P16[pb + C_CQ]), q2 = bf2f(P16[pb + C_CQ + 64]), k1 = bf2f(P16[pb + C_CK]), k2 = bf2f(P16[pb + C_CK + 64]);
          const float sc = 0.08838834764831845f * 1.4426950408889634f;
          QR[ob] = (bf16_t)f2bf((q1 * c.x - q2 * c.y) * sc); QR[ob + 64] = (bf16_t)f2bf((q2 * c.x + q1 * c.y) * sc);
          KR[ob] = (bf16_t)f2bf(k1 * c.x - k2 * c.y); KR[ob + 64] = (bf16_t)f2bf(k2 * c.x + k1 * c.y); } }
    { bf16_t* QS = (bf16_t*)(ws + WS_QI); bf16_t* KIb = (bf16_t*)(ws + WS_KI); float* WP = (float*)(ws + WS_WI);
#pragma unroll 2
      for (int m = gw; m < M; m += ngw) { const int h = lane >> 3, jj = lane & 7;
          const unsigned long long w1 = *(const unsigned long long*)(P16 + (size_t)m * NPAD + C_QI + h * 64 + 4 * jj), w2 = *(const unsigned long long*)(P16 + (size_t)m * NPAD + C_QI + h * 64 + 32 + 4 * jj);
          const float q1[4] = {lo_bf((unsigned)w1), hi_bf((unsigned)w1), lo_bf((unsigned)(w1 >> 32)), hi_bf((unsigned)(w1 >> 32))}, q2[4] = {lo_bf((unsigned)w2), hi_bf((unsigned)w2), lo_bf((unsigned)(w2 >> 32)), hi_bf((unsigned)(w2 >> 32))};
          const float2* c = cs + (size_t)m * 96 + 64 + 4 * jj; const float w = PF[(size_t)m * PFW + 576 + h] * 0.02209708691207961f;
          float r1[4], r2[4], l1[4], l2[4];
#pragma unroll
          for (int i = 0; i < 4; ++i) { const float2 cc = c[i]; r1[i] = q1[i] * cc.x - q2[i] * cc.y; r2[i] = q2[i] * cc.x + q1[i] * cc.y; l1[i] = w * r1[i]; l2[i] = w * r2[i]; }
          *(unsigned long long*)(QS + (size_t)m * 576 + h * 64 + 4 * jj) = (unsigned long long)pk2(r1[0], r1[1]) | ((unsigned long long)pk2(r1[2], r1[3]) << 32);
          *(unsigned long long*)(QS + (size_t)m * 576 + h * 64 + 32 + 4 * jj) = (unsigned long long)pk2(r2[0], r2[1]) | ((unsigned long long)pk2(r2[2], r2[3]) << 32);
#pragma unroll
          for (int i = 0; i < 4; ++i) { l1[i] += __shfl_xor(l1[i], 8); l1[i] += __shfl_xor(l1[i], 16); l1[i] += __shfl_xor(l1[i], 32); l2[i] += __shfl_xor(l2[i], 8); l2[i] += __shfl_xor(l2[i], 16); l2[i] += __shfl_xor(l2[i], 32); }
          if (h == 0) { *(unsigned long long*)(QS + (size_t)m * 576 + 512 + 4 * jj) = (unsigned long long)pk2(l1[0], l1[1]) | ((unsigned long long)pk2(l1[2], l1[3]) << 32);
                        *(unsigned long long*)(QS + (size_t)m * 576 + 512 + 32 + 4 * jj) = (unsigned long long)pk2(l2[0], l2[1]) | ((unsigned long long)pk2(l2[2], l2[3]) << 32);
                        const f32x4 k1 = *(const f32x4*)(PF + (size_t)m * PFW + 512 + 4 * jj), k2 = *(const f32x4*)(PF + (size_t)m * PFW + 512 + 32 + 4 * jj);
                        const float kk1[4] = {k1.x, k1.y, k1.z, k1.w}, kk2[4] = {k2.x, k2.y, k2.z, k2.w}; float o1[4], o2[4];
#pragma unroll
                        for (int i = 0; i < 4; ++i) { const float2 cc = c[i]; o1[i] = kk1[i] * cc.x - kk2[i] * cc.y; o2[i] = kk2[i] * cc.x + kk1[i] * cc.y; }
                        *(unsigned long long*)(KIb + (size_t)m * 64 + 4 * jj) = (unsigned long long)pk2(o1[0], o1[1]) | ((unsigned long long)pk2(o1[2], o1[3]) << 32);
                        *(unsigned long long*)(KIb + (size_t)m * 64 + 32 + 4 * jj) = (unsigned long long)pk2(o2[0], o2[1]) | ((unsigned long long)pk2(o2[2], o2[3]) << 32); }
          if (jj == 0) WP[(size_t)m * 8 + h] = w; } }
    { bf16_t* VT = (bf16_t*)(ws + WS_VT); bf16_t* sT = (bf16_t*)lds;
      for (int t0 = blockIdx.x * 8; t0 < (M / 64) * 8; t0 += gridDim.x * 8) {
          u32x4 w[8]; const int row = tid >> 3, seg = tid & 7;
#pragma unroll
          for (int q = 0; q < 8; ++q) { const int tile = t0 + q, tb = tile >> 3, cb = tile & 7; w[q] = *(const u32x4*)(P16 + (size_t)(tb * 64 + row) * NPAD + C_CV + cb * 64 + seg * 8); }
          __syncthreads();
#pragma unroll
          for (int q = 0; q < 8; ++q) { unsigned* d = (unsigned*)(sT + q * 64 * 66 + row * 66 + seg * 8); d[0] = w[q].x; d[1] = w[q].y; d[2] = w[q].z; d[3] = w[q].w; }
          __syncthreads();
          const int ch = tid >> 3, tg = tid & 7;
#pragma unroll
          for (int q = 0; q < 8; ++q) { const int tile = t0 + q, tb = tile >> 3, cb = tile & 7; unsigned short v[8];
#pragma unroll
              for (int i = 0; i < 8; ++i) v[i] = sT[q * 64 * 66 + (tg * 8 + i) * 66 + ch];
              const u32x4 o = {(unsigned)v[0] | ((unsigned)v[1] << 16), (unsigned)v[2] | ((unsigned)v[3] << 16), (unsigned)v[4] | ((unsigned)v[5] << 16), (unsigned)v[6] | ((unsigned)v[7] << 16)};
              *(u32x4*)(VT + ((size_t)((tb >> 7) * 512 + cb * 64 + ch)) * SEQ + (tb & 127) * 64 + tg * 8) = o; } }
      __syncthreads(); }
    { bf16_t* VN = (bf16_t*)(ws + WS_VN); const float* gain = a.gmlp_gain + l * 512;
#pragma unroll 4
      for (int m = gw; m < M; m += ngw) { const u32x4 w = *(const u32x4*)(P16 + (size_t)m * NPAD + C_BV + lane * 8);
          float v[8] = {gelu_t(lo_bf(w.x)), gelu_t(hi_bf(w.x)), gelu_t(lo_bf(w.y)), gelu_t(hi_bf(w.y)), gelu_t(lo_bf(w.z)), gelu_t(hi_bf(w.z)), gelu_t(lo_bf(w.w)), gelu_t(hi_bf(w.w))};
          float sm = 0.f;
#pragma unroll
          for (int j = 0; j < 8; ++j) sm += v[j] * v[j];
          const float r = rsqrtf(wave_sum(sm) * (1.f / 512.f) + EPS);
          const f32x4 g0 = *(const f32x4*)(gain + lane * 8), g1 = *(const f32x4*)(gain + lane * 8 + 4);
          *(u32x4*)(VN + (size_t)m * 512 + lane * 8) = (u32x4){pk2(v[0] * r * g0.x, v[1] * r * g0.y), pk2(v[2] * r * g0.z, v[3] * r * g0.w), pk2(v[4] * r * g1.x, v[5] * r * g1.y), pk2(v[6] * r * g1.z, v[7] * r * g1.w)}; } }
}

constexpr int NHU = BATCH * 128 * 4;
__device__ __forceinline__ void ph_h1(const Args& a, int l, unsigned char* lds, int wv) {
    unsigned char* ws = oport(a.ws);
    const int tid = otid(wv), lane = tid & 63, wave = __builtin_amdgcn_readfirstlane(tid >> 6), j = wave >> 1, d = tid & 127, fr = lane & 15, fq = lane >> 4;
    bf16_t* KT = (bf16_t*)lds;
    bf16_t* VT = KT + 128 * 72;
    float* sT = (float*)(VT + 128 * 72);
    const float* PF = (const float*)(ws + WS_PF); const bf16_t* P16 = (const bf16_t*)(ws + WS_P16); const float* LB = (const float*)(ws + WS_LB) + l * 512;
    float* LL = (float*)(ws + WS_FF); float* DD = (float*)(ws + WS_DD);
    for (int u = blockIdx.x; u < NHU; u += gridDim.x) {
        const int h = u & 3, c = (u >> 2) & 127, b = u >> 9; const size_t m0 = (size_t)b * SEQ + c * 64 + j * 16;
        const float lbv = LB[h * 128 + d];
        float cs[16], ky[16]; unsigned vv[16]; float run = 0.f;
#pragma unroll
        for (int i = 0; i < 16; ++i) { const float z = PF[(m0 + i) * PFW + h * 128 + d]; const float sg = sigm(z); run += __logf(lbv + (1.f - lbv) * sg); cs[i] = run; ky[i] = (1.f - lbv) * (1.f - sg);
            vv[i] = P16[(m0 + i) * NPAD + C_AI + h * 128 + d]; }
        sT[j * 128 + d] = run;
        __syncthreads();
        float tail = 0.f;
#pragma unroll
        for (int jj = 1; jj < 4; ++jj) if (jj > j) tail += sT[jj * 128 + d];
        { unsigned w[8], x[8];
#pragma unroll
          for (int i = 0; i < 8; ++i) { w[i] = pk2(ky[2 * i] * __expf(tail + (run - cs[2 * i])), ky[2 * i + 1] * __expf(tail + (run - cs[2 * i + 1]))); x[i] = vv[2 * i] | (vv[2 * i + 1] << 16); }
          u32x4* kp = (u32x4*)(KT + d * 72 + j * 16); kp[0] = (u32x4){w[0], w[1], w[2], w[3]}; kp[1] = (u32x4){w[4], w[5], w[6], w[7]};
          u32x4* vp = (u32x4*)(VT + d * 72 + j * 16); vp[0] = (u32x4){x[0], x[1], x[2], x[3]}; vp[1] = (u32x4){x[4], x[5], x[6], x[7]}; }
        if (j == 0) DD[(size_t)u * 128 + d] = __expf(run + tail);
        __syncthreads();
        { bf16x8 xk[2];
#pragma unroll
          for (int ks = 0; ks < 2; ++ks) xk[ks] = *(const bf16x8*)(KT + (16 * wave + fr) * 72 + ks * 32 + fq * 8);
#pragma unroll
          for (int nt = 0; nt < 8; ++nt) { f32x4 acc = {0.f, 0.f, 0.f, 0.f};
#pragma unroll
              for (int ks = 0; ks < 2; ++ks) { const bf16x8 y = *(const bf16x8*)(VT + (16 * nt + fr) * 72 + ks * 32 + fq * 8); acc = __builtin_amdgcn_mfma_f32_16x16x32_bf16(xk[ks], y, acc, 0, 0, 0); }
              *(f32x4*)(LL + ((size_t)u * 128 + 16 * nt + fr) * 128 + 16 * wave + 4 * fq) = acc; } }
        __syncthreads();
    }
}
__device__ __forceinline__ void ph_h2(const Args& a, int wv) {
    unsigned char* ws = oport(a.ws);
    const float* LL = (const float*)(ws + WS_FF); const float* DD = (const float*)(ws + WS_DD); bf16_t* SB = (bf16_t*)(ws + WS_QF);
    for (int e = blockIdx.x * NTHR + otid(wv); e < 8 * 16384; e += gridDim.x * NTHR) { const int bh = e >> 14, b = bh >> 2, h = bh & 3, dvdk = e & 16383, dk = e & 127; float S = 0.f;
#pragma unroll 16
        for (int c = 0; c < 128; ++c) { const size_t u = (size_t)(((b * 128 + c) << 2) + h); SB[u * 16384 + dvdk] = (bf16_t)f2bf(S); S = DD[u * 128 + dk] * S + LL[u * 16384 + dvdk]; } }
}
__device__ __forceinline__ void ph_h3(const Args& a, int l, unsigned char* lds, int wv) {
    unsigned char* ws = oport(a.ws);
    const int tid = otid(wv), lane = tid & 63, wave = __builtin_amdgcn_readfirstlane(tid >> 6), j = wave >> 1, d = tid & 127, fr = lane & 15, fq = lane >> 4;
    bf16_t* QT = (bf16_t*)lds;
    bf16_t* QH = QT + 64 * 136;
    bf16_t* KI = QH + 64 * 136;
    bf16_t* VT = KI + 160 * 136;
    bf16_t* AT = VT + 128 * 72;
    float* sT = (float*)(AT + 64 * 72);
    float* sSS = sT + 512;
    const float* PF = (const float*)(ws + WS_PF); const bf16_t* P16 = (const bf16_t*)(ws + WS_P16); const float* LB = (const float*)(ws + WS_LB) + l * 512;
    const bf16_t* SB = (const bf16_t*)(ws + WS_QF); bf16_t* YA = (bf16_t*)(ws + WS_YALL); const float* gain = a.hgrn_gain + l * 128;
    for (int u = blockIdx.x; u < NHU; u += gridDim.x) {
        const int h = u & 3, c = (u >> 2) & 127, b = u >> 9; const size_t mc = (size_t)b * SEQ + c * 64, m0 = mc + j * 16;
        for (int i = tid; i < 64 * 72 * 2 / 16; i += NTHR) ((u32x4*)AT)[i] = (u32x4){0u, 0u, 0u, 0u};
        bf16x8 sbf[4][4];
#pragma unroll
        for (int q4 = 0; q4 < 4; ++q4)
#pragma unroll
            for (int ks = 0; ks < 4; ++ks) sbf[q4][ks] = ((const bf16x8*)(SB + ((size_t)u * 128 + 16 * (4 * (wave >> 2) + q4)) * 128 + 32 * ks))[fr * 16 + fq];
        const float lbv = LB[h * 128 + d];
        float cs[16], ky[16], qf[16]; unsigned vv[16]; float run = 0.f;
#pragma unroll
        for (int i = 0; i < 16; ++i) { const size_t pr = (m0 + i) * NPAD + h * 128 + d; const float z = PF[(m0 + i) * PFW + h * 128 + d]; const float sg = sigm(z); run += __logf(lbv + (1.f - lbv) * sg); cs[i] = run; ky[i] = (1.f - lbv) * (1.f - sg);
            qf[i] = silu(bf2f(P16[pr + C_AQ])) * 0.08838834764831845f; vv[i] = P16[pr + C_AI]; }
        sT[j * 128 + d] = run;
        __syncthreads();
        const float T0 = sT[d], T1 = sT[128 + d], T2 = sT[256 + d];
        const float Bj = (j > 0 ? T0 : 0.f) + (j > 1 ? T1 : 0.f) + (j > 2 ? T2 : 0.f); const float eBj = __expf(Bj);
        float pre[4]; pre[0] = 0.f; pre[1] = (j < 1 ? T0 : 0.f); pre[2] = (j < 1 ? T0 : 0.f) + (j < 2 ? T1 : 0.f); pre[3] = (j < 1 ? T0 : 0.f) + (j < 2 ? T1 : 0.f) + (j < 3 ? T2 : 0.f);
        float epre[4];
#pragma unroll
        for (int I = 0; I < 4; ++I) epre[I] = __expf(pre[I]);
#pragma unroll
        for (int i = 0; i < 16; ++i) { const int t = 16 * j + i; const float ec = __expf(cs[i]), kn = ky[i] * __expf(fminf(-cs[i], 60.f));
            QT[t * 136 + d] = (bf16_t)f2bf(qf[i] * ec); QH[t * 136 + d] = (bf16_t)f2bf(qf[i] * ec * eBj);
#pragma unroll
            for (int I = 0; I < 4; ++I) if (I >= j) KI[(8 * I * (I + 1) + t) * 136 + d] = (bf16_t)f2bf(kn * epre[I]); }
        { unsigned x[8];
#pragma unroll
          for (int i = 0; i < 8; ++i) x[i] = vv[2 * i] | (vv[2 * i + 1] << 16);
          u32x4* vp = (u32x4*)(VT + d * 72 + j * 16); vp[0] = (u32x4){x[0], x[1], x[2], x[3]}; vp[1] = (u32x4){x[4], x[5], x[6], x[7]}; }
        __syncthreads();
        for (int tl = wave; tl < 10; tl += 8) { const int I = tl < 1 ? 0 : tl < 3 ? 1 : tl < 6 ? 2 : 3, J = tl - (I * (I + 1)) / 2; f32x4 acc = {0.f, 0.f, 0.f, 0.f};
#pragma unroll
            for (int ks = 0; ks < 4; ++ks) { const bf16x8 x = *(const bf16x8*)(QT + (16 * I + fr) * 136 + ks * 32 + fq * 8); const bf16x8 y = *(const bf16x8*)(KI + (8 * I * (I + 1) + 16 * J + fr) * 136 + ks * 32 + fq * 8);
                acc = __builtin_amdgcn_mfma_f32_16x16x32_bf16(x, y, acc, 0, 0, 0); }
#pragma unroll
            for (int r = 0; r < 4; ++r) { float v = acc[r]; if (J == I && fr > 4 * fq + r) v = 0.f; AT[(16 * I + 4 * fq + r) * 72 + 16 * J + fr] = (bf16_t)f2bf(v); } }
        __syncthreads();
        const int I = wave & 3, nt0 = 4 * (wave >> 2); f32x4 o[4];
#pragma unroll
        for (int q4 = 0; q4 < 4; ++q4) { const int nt = nt0 + q4; f32x4 acc = {0.f, 0.f, 0.f, 0.f};
            for (int ks = 0; ks <= (I >> 1); ++ks) { const bf16x8 x = *(const bf16x8*)(AT + (16 * I + fr) * 72 + ks * 32 + fq * 8); const bf16x8 y = *(const bf16x8*)(VT + (16 * nt + fr) * 72 + ks * 32 + fq * 8);
                acc = __builtin_amdgcn_mfma_f32_16x16x32_bf16(x, y, acc, 0, 0, 0); }
#pragma unroll
            for (int ks = 0; ks < 4; ++ks) { const bf16x8 x = *(const bf16x8*)(QH + (16 * I + fr) * 136 + ks * 32 + fq * 8); acc = __builtin_amdgcn_mfma_f32_16x16x32_bf16(x, sbf[q4][ks], acc, 0, 0, 0); }
            o[q4] = acc; }
        { float ssq[4];
#pragma unroll
          for (int r = 0; r < 4; ++r) { float s = o[0][r] * o[0][r] + o[1][r] * o[1][r] + o[2][r] * o[2][r] + o[3][r] * o[3][r]; s += __shfl_xor(s, 1); s += __shfl_xor(s, 2); s += __shfl_xor(s, 4); s += __shfl_xor(s, 8); ssq[r] = s; }
          if (fr == 0) {
#pragma unroll
              for (int r = 0; r < 4; ++r) sSS[(16 * I + 4 * fq + r) * 2 + (wave >> 2)] = ssq[r]; } }
        __syncthreads();
#pragma unroll
        for (int r = 0; r < 4; ++r) { const int tt = 16 * I + 4 * fq + r; const float rinv = rsqrtf((sSS[tt * 2] + sSS[tt * 2 + 1]) * (1.f / 128.f) + EPS); const size_t m = mc + tt;
#pragma unroll
            for (int q4 = 0; q4 < 4; ++q4) { const int dv = 16 * (nt0 + q4) + fr; const float g = bf2f(P16[m * NPAD + C_AG + h * 128 + dv]);
                YA[m * 512 + h * 128 + dv] = (bf16_t)f2bf(o[q4][r] * rinv * gain[dv] * silu(g)); } }
        __syncthreads();
    }
}
__device__ __forceinline__ void ph_gmlp(const Args& a, int l, unsigned char* lds, int wv) {
    unsigned char* ws = oport(a.ws);
    const int tid = otid(wv), lane = tid & 63, wave = __builtin_amdgcn_readfirstlane(tid >> 6), fr = lane & 15, fq = lane >> 4;
    const bf16_t* P16 = (const bf16_t*)(ws + WS_P16); const bf16_t* VN = (const bf16_t*)(ws + WS_VN); bf16_t* YB = (bf16_t*)(ws + WS_YALL) + (size_t)M * 512;
    const bf16_t* WSB = (const bf16_t*)(ws + WS_WSB) + (size_t)l * 4 * 128 * 128; const float* bs = a.gmlp_bs + (size_t)l * 4 * 128;
    bf16_t* VNt = (bf16_t*)lds;
    for (int u = blockIdx.x; u < (M / 128) * 4; u += gridDim.x) { const int g = u & 3, nb = u >> 2; const size_t mb = (size_t)nb * 128;
        __syncthreads();
#pragma unroll
        for (int n = 0; n < 4; ++n) { const int idx = tid + NTHR * n, row = idx >> 4, seg = idx & 15; const u32x4 w = *(const u32x4*)(VN + (mb + row) * 512 + g * 128 + seg * 8);
            bf16_t* d = VNt + (seg * 8) * 136 + row;
            d[0 * 136] = (bf16_t)(w.x & 0xffffu); d[1 * 136] = (bf16_t)(w.x >> 16); d[2 * 136] = (bf16_t)(w.y & 0xffffu); d[3 * 136] = (bf16_t)(w.y >> 16);
            d[4 * 136] = (bf16_t)(w.z & 0xffffu); d[5 * 136] = (bf16_t)(w.z >> 16); d[6 * 136] = (bf16_t)(w.w & 0xffffu); d[7 * 136] = (bf16_t)(w.w >> 16); }
        bf16x8 wf[4];
#pragma unroll
        for (int ks = 0; ks < 4; ++ks) wf[ks] = *(const bf16x8*)(WSB + ((size_t)g * 128 + 16 * wave + fr) * 128 + 32 * ks + 8 * fq);
        __syncthreads();
        const int t = 16 * wave + fr; const float bias = bs[g * 128 + t]; const int nks = (wave >> 1) + 1;
        unsigned long long uwv[8];
#pragma unroll
        for (int ct = 0; ct < 8; ++ct) uwv[ct] = *(const unsigned long long*)(P16 + (mb + t) * NPAD + C_BU + g * 128 + 16 * ct + 4 * fq);
#pragma unroll
        for (int ct = 0; ct < 8; ++ct) { f32x4 acc = {0.f, 0.f, 0.f, 0.f};
#pragma unroll
            for (int ks = 0; ks < 4; ++ks) if (ks < nks) { const bf16x8 x = *(const bf16x8*)(VNt + (16 * ct + fr) * 136 + 32 * ks + 8 * fq); acc = __builtin_amdgcn_mfma_f32_16x16x32_bf16(x, wf[ks], acc, 0, 0, 0); }
            const size_t m = mb + t; const int c = g * 128 + 16 * ct + 4 * fq; const unsigned long long uw = uwv[ct];
            const float o0 = gelu_t(lo_bf((unsigned)uw)) * (acc[0] + bias), o1 = gelu_t(hi_bf((unsigned)uw)) * (acc[1] + bias), o2 = gelu_t(lo_bf((unsigned)(uw >> 32))) * (acc[2] + bias), o3 = gelu_t(hi_bf((unsigned)(uw >> 32))) * (acc[3] + bias);
            *(unsigned long long*)(YB + m * 512 + c) = (unsigned long long)pk2(o0, o1) | ((unsigned long long)pk2(o2, o3) << 32); }
    }
}
constexpr int SEL_CAP = 256;
__device__ __forceinline__ int sel_bin(float s, float lo, float sc) { return (int)__builtin_amdgcn_fmed3f((s - lo) * sc, 0.f, 1023.f); }
struct SelQ { float lo1, sc1, lo2, sc2, tau; int b1, b2, ref, tidx; };
__device__ __forceinline__ void sel_pass(const int mode, const bf16x8 (&qf)[9][2], const float (&wp)[8], const SelQ& sq, const bf16_t* kib, int c, int kp, int qloc, int fr, int fq,
                                         unsigned* sHist, unsigned* sCand, unsigned* sCnt, unsigned* maskrow) {
    bf16x8 af[4][2];
    { const int T0 = kp <= c ? kp : c;
#pragma unroll
      for (int rg = 0; rg < 4; ++rg)
#pragma unroll
          for (int ks = 0; ks < 2; ++ks) af[rg][ks] = ((const bf16x8*)(kib + (size_t)(64 * T0 + 16 * rg) * 64 + 32 * ks))[fr * 8 + fq]; }
#pragma unroll 1
    for (int T = kp; T <= c; T += 4) {
        const int Tn = (T + 4 <= c) ? T + 4 : T;
        unsigned mlo = 0u, mhi = 0u;
#pragma unroll
        for (int rg = 0; rg < 4; ++rg) {
            f32x4 sc = __builtin_amdgcn_mfma_f32_16x16x32_bf16(af[rg][0], qf[8][0], (f32x4){0.f, 0.f, 0.f, 0.f}, 0, 0, 0);
            sc = __builtin_amdgcn_mfma_f32_16x16x32_bf16(af[rg][1], qf[8][1], sc, 0, 0, 0);
#pragma unroll
            for (int h = 0; h < 8; ++h) { f32x4 ah = __builtin_amdgcn_mfma_f32_16x16x32_bf16(af[rg][0], qf[h][0], (f32x4){0.f, 0.f, 0.f, 0.f}, 0, 0, 0);
                ah = __builtin_amdgcn_mfma_f32_16x16x32_bf16(af[rg][1], qf[h][1], ah, 0, 0, 0);
#pragma unroll
                for (int r = 0; r < 4; ++r) sc[r] += wp[h] * __builtin_fabsf(ah[r]); }
#pragma unroll
            for (int ks = 0; ks < 2; ++ks) af[rg][ks] = ((const bf16x8*)(kib + (size_t)(64 * Tn + 16 * rg) * 64 + 32 * ks))[fr * 8 + fq];
            if (mode == 0) {
#pragma unroll
                for (int r = 0; r < 4; ++r) { const int b = sel_bin(sc[r], sq.lo1, sq.sc1); __hip_atomic_fetch_add(sHist + qloc * 512 + (b >> 1), 1u << ((b & 1) * 16), __ATOMIC_RELAXED, __HIP_MEMORY_SCOPE_WORKGROUP); }
            } else if (mode == 1) {
                if (sq.ref) {
#pragma unroll
                    for (int r = 0; r < 4; ++r) if (sel_bin(sc[r], sq.lo1, sq.sc1) == sq.b1) { const int b = sel_bin(sc[r], sq.lo2, sq.sc2); __hip_atomic_fetch_add(sHist + qloc * 512 + (b >> 1), 1u << ((b & 1) * 16), __ATOMIC_RELAXED, __HIP_MEMORY_SCOPE_WORKGROUP); } }
            } else {
                int b[4]; unsigned bits = 0u; bool anyc = false;
#pragma unroll
                for (int r = 0; r < 4; ++r) { b[r] = sel_bin(sc[r], sq.lo1, sq.sc1); bits |= (b[r] > sq.b1) ? (1u << r) : 0u; anyc |= (b[r] == sq.b1); }
                if (anyc) {
#pragma unroll
                    for (int r = 0; r < 4; ++r) if (b[r] == sq.b1) { bool cand = true;
                        if (sq.ref) { const int b2 = sel_bin(sc[r], sq.lo2, sq.sc2); if (b2 > sq.b2) bits |= 1u << r; cand = b2 == sq.b2; }
                        if (cand) { const unsigned slot = __hip_atomic_fetch_add(sCnt + qloc, 1u, __ATOMIC_RELAXED, __HIP_MEMORY_SCOPE_WORKGROUP);
                            if (slot < (unsigned)SEL_CAP) { sCand[(qloc * SEL_CAP + slot) * 2] = __float_as_uint(sc[r]); sCand[(qloc * SEL_CAP + slot) * 2 + 1] = (unsigned)(64 * T + 16 * rg + 4 * fq + r); } } } }
                bits <<= (16 * (rg & 1)) + 4 * fq; if (rg < 2) mlo |= bits; else mhi |= bits;
            }
            __builtin_amdgcn_sched_barrier(0);
        }
        if (mode == 2) { mlo |= __shfl_xor(mlo, 16); mlo |= __shfl_xor(mlo, 32); mhi |= __shfl_xor(mhi, 16); mhi |= __shfl_xor(mhi, 32);
            if (fq == 0) *(uint2*)(maskrow + 2 * T) = make_uint2(mlo, mhi); }
    }
}
__device__ __forceinline__ void sel_scan(const unsigned* hist, unsigned need, int lane, int& bsel, unsigned& nneed, unsigned& cnt) {
    unsigned c16[16]; unsigned tot = 0u;
#pragma unroll
    for (int i = 0; i < 8; ++i) { const unsigned w = hist[512 - 8 * (lane + 1) + i]; c16[2 * i] = w & 0xffffu; c16[2 * i + 1] = w >> 16; tot += (w & 0xffffu) + (w >> 16); }
    unsigned inc = tot;
#pragma unroll
    for (int o = 1; o < 64; o <<= 1) { const unsigned t2 = __shfl_up(inc, o); if (lane >= o) inc += t2; }
    const unsigned long long bal = __ballot(inc >= need);
    const int L = bal ? (__ffsll((long long)bal) - 1) : 63;
    unsigned above = __shfl(inc - tot, L); int bs = 0; unsigned nn = 1u, cc = 0u; bool found = false;
#pragma unroll
    for (int j = 0; j < 16; ++j) { const unsigned hcnt = __shfl(c16[15 - j], L); if (!found) { if (above + hcnt >= need) { found = true; bs = 1024 - 16 * L - 1 - j; nn = need - above; cc = hcnt; } else above += hcnt; } }
    bsel = bs; nneed = nn; cnt = cc;
}
__device__ __forceinline__ void ph_sel(const Args& a, unsigned char* lds, int wv) {
    unsigned char* ws = oport(a.ws);
    const int tid = otid(wv), lane = tid & 63, wave = __builtin_amdgcn_readfirstlane(tid >> 6), gq = wave & 1, kp = wave >> 1, fr = lane & 15, fq = lane >> 4, qloc = 16 * gq + fr;
    unsigned* sHist = (unsigned*)lds;
    unsigned* sCand = (unsigned*)(lds + 65536);
    float* sLo1 = (float*)(lds + 131072); float* sSc1 = sLo1 + 32; float* sLo2 = sSc1 + 32; float* sSc2 = sLo2 + 32; float* sTau = sSc2 + 32;
    int* sB1 = (int*)(sTau + 32); int* sB2 = sB1 + 32; int* sRef = sB2 + 32; int* sTidx = sRef + 32; unsigned* sNeed = (unsigned*)(sTidx + 32); unsigned* sCnt = sNeed + 32; int* sAny = (int*)(sCnt + 32);
    const bf16_t* QS = (const bf16_t*)(ws + WS_QI); const bf16_t* KIb = (const bf16_t*)(ws + WS_KI); const float* WP = (const float*)(ws + WS_WI); unsigned* MASKB = (unsigned*)(ws + WS_MASK);
    for (int pi = blockIdx.x; pi < 256; pi += gridDim.x) {
#pragma unroll 1
      for (int which = 0; which < 2; ++which) {
        const int b = pi & 1, half = (pi >> 1) & 1, cc = pi >> 2, c = which ? cc : 127 - cc;
        const size_t mq = (size_t)b * SEQ + 64 * c + 32 * half;
        const bf16_t* kib = KIb + (size_t)b * SEQ * 64;
        __syncthreads();
        if (tid < 32) { const float* w = WP + (mq + tid) * 8; float s1 = 0.f, s2 = 0.f;
#pragma unroll
            for (int h = 0; h < 8; ++h) { s1 += w[h]; s2 += w[h] * w[h]; }
            const float sd = 9.34f * sqrtf(fmaxf(s2, 1e-30f)); sLo1[tid] = 6.38f * s1 - 8.f * sd; sSc1[tid] = 1024.f / (16.f * sd);
            sLo2[tid] = 0.f; sSc2[tid] = 1.f; sB1[tid] = 0; sB2[tid] = 0; sRef[tid] = 0; sNeed[tid] = 256u; sCnt[tid] = 0u; sTau[tid] = -INFINITY; sTidx[tid] = 0x7fffffff; }
        if (tid == 0) sAny[0] = 0;
        for (int i = tid; i < 32 * 512 / 4; i += NTHR) ((u32x4*)sHist)[i] = (u32x4){0u, 0u, 0u, 0u};
        bf16x8 qf[9][2]; float wp[8];
        { const bf16_t* qrow = QS + (mq + qloc) * 576;
#pragma unroll
          for (int h = 0; h < 9; ++h)
#pragma unroll
              for (int ks = 0; ks < 2; ++ks) qf[h][ks] = *(const bf16x8*)(qrow + h * 64 + 32 * ks + 8 * fq);
#pragma unroll
          for (int h = 0; h < 8; ++h) wp[h] = WP[(mq + qloc) * 8 + h]; }
        __syncthreads();
        unsigned* maskrow = MASKB + (mq + qloc) * 256;
        if (c < 4) {
            if (tid < 32) for (int T = 0; T <= c; ++T) *(uint2*)(MASKB + (mq + tid) * 256 + 2 * T) = make_uint2(0xFFFFFFFFu, 0xFFFFFFFFu);
        } else {
#pragma unroll 1
            for (int pass = 0; pass < 3; ++pass) {
                if (pass == 1) { if (!sAny[0]) continue; __syncthreads(); for (int i = tid; i < 32 * 512 / 4; i += NTHR) ((u32x4*)sHist)[i] = (u32x4){0u, 0u, 0u, 0u}; __syncthreads(); }
                SelQ sq; sq.lo1 = sLo1[qloc]; sq.sc1 = sSc1[qloc]; sq.lo2 = sLo2[qloc]; sq.sc2 = sSc2[qloc]; sq.b1 = sB1[qloc]; sq.b2 = sB2[qloc]; sq.ref = sRef[qloc]; sq.tau = 0.f; sq.tidx = 0;
                sel_pass(pass, qf, wp, sq, kib, c, kp, qloc, fr, fq, sHist, sCand, sCnt, maskrow);
                asm volatile("s_waitcnt vmcnt(0)" ::: "memory");
                __syncthreads();
                if (pass < 2) {
                    for (int qq = wave * 4; qq < wave * 4 + 4; ++qq) if (pass == 0 || sRef[qq]) { int bs; unsigned nn, cn; sel_scan(sHist + qq * 512, sNeed[qq], lane, bs, nn, cn);
                        if (lane == 0) { sNeed[qq] = nn; if (pass == 0) { sB1[qq] = bs; if (cn > (unsigned)SEL_CAP) { sRef[qq] = 1; sLo2[qq] = sLo1[qq] + (float)bs / sSc1[qq]; sSc2[qq] = sSc1[qq] * 1024.f; sAny[0] = 1; } } else sB2[qq] = bs; } }
                    __syncthreads(); }
            }
            unsigned* sOff = (unsigned*)sAny + 4;
            if (tid < 64) { unsigned n = 0u; if (tid < 32) n = sCnt[tid] < (unsigned)SEL_CAP ? sCnt[tid] : (unsigned)SEL_CAP; unsigned inc = n;
#pragma unroll
                for (int o = 1; o < 32; o <<= 1) { const unsigned t2 = __shfl_up(inc, o); if (lane >= o) inc += t2; }
                if (tid < 32) { sOff[tid] = inc - n; if (tid == 31) sOff[32] = inc; } }
            __syncthreads();
            { const unsigned total = sOff[32];
              for (unsigned p = tid; p < total; p += NTHR) { int qq = 0;
#pragma unroll
                  for (int st = 16; st >= 1; st >>= 1) if (sOff[qq + st] <= p) qq += st;
                  const unsigned i = p - sOff[qq], n = sOff[qq + 1] - sOff[qq], want = sNeed[qq] - 1u;
                  const float si = __uint_as_float(sCand[(qq * SEL_CAP + i) * 2]); const unsigned ki = sCand[(qq * SEL_CAP + i) * 2 + 1]; unsigned rank = 0u;
                  for (unsigned j = 0; j < n; ++j) { const float sj = __uint_as_float(sCand[(qq * SEL_CAP + j) * 2]); const unsigned kj = sCand[(qq * SEL_CAP + j) * 2 + 1]; rank += (sj > si || (sj == si && kj < ki)) ? 1u : 0u; }
                  if (rank <= want) atomicOr(MASKB + (mq + qq) * 256 + (ki >> 5), 1u << (ki & 31u)); } }
        }
      }
    }
}

__device__ __forceinline__ void ph_attn(const Args& a, unsigned char* lds, int wv) {
    unsigned char* ws = oport(a.ws);
    const int tid = otid(wv), lane = tid & 63, wave = __builtin_amdgcn_readfirstlane(tid >> 6), g4 = wave & 3, par = wave >> 2, fr = lane & 15, fq = lane >> 4;
    const bf16_t* QR = (const bf16_t*)(ws + WS_QR); const bf16_t* KR = (const bf16_t*)(ws + WS_KR); const bf16_t* VT = (const bf16_t*)(ws + WS_VT); const unsigned* MASKB = (const unsigned*)(ws + WS_MASK);
    bf16_t* Kt = (bf16_t*)lds;
    bf16_t* Vt = Kt + 2 * 64 * 136;
    float* sMrg = (float*)lds;
    for (int pi = blockIdx.x; pi < 256; pi += gridDim.x) {
#pragma unroll 1
      for (int which = 0; which < 2; ++which) {
        const int bh = pi & 7, b = bh >> 2, h = bh & 3, cc = pi >> 3, qb = which ? cc : 63 - cc;
        const size_t m0 = (size_t)b * SEQ + 128 * qb + 32 * g4;
        const int mych = 2 * qb + (g4 >> 1);
        bf16x8 qf[2][4];
#pragma unroll
        for (int cg = 0; cg < 2; ++cg)
#pragma unroll
            for (int ks = 0; ks < 4; ++ks) qf[cg][ks] = *(const bf16x8*)(QR + (m0 + 16 * cg + fr) * 512 + h * 128 + 32 * ks + 8 * fq);
        f32x4 O[2][8], Lacc[2]; float mrun[2];
        const bf16x8 xones = (fr == 0) ? (bf16x8){0x3f80, 0x3f80, 0x3f80, 0x3f80, 0x3f80, 0x3f80, 0x3f80, 0x3f80} : (bf16x8){0, 0, 0, 0, 0, 0, 0, 0};
#pragma unroll
        for (int cg = 0; cg < 2; ++cg) { mrun[cg] = 0.f; Lacc[cg] = (f32x4){0.f, 0.f, 0.f, 0.f};
#pragma unroll
            for (int vt = 0; vt < 8; ++vt) O[cg][vt] = (f32x4){0.f, 0.f, 0.f, 0.f}; }
        const bf16_t* kbase = KR + (size_t)b * SEQ * 512 + h * 128; const bf16_t* vbase = VT + (size_t)(b * 512 + h * 128) * SEQ;
        unsigned doff[9];
#pragma unroll
        for (int k = 0; k < 9; ++k) { const int i_ = (wave + NWAVE * k < 70) ? wave + NWAVE * k : 69, slot = 64 * i_ + lane;
            if (slot < 2176) { const int tl = slot >= 1088 ? 1 : 0, rs = slot - 1088 * tl, row = rs / 17, seg = rs - 17 * row; doff[k] = (unsigned)((64 * tl + row) * 512 + ((seg < 16) ? (seg ^ ((row & 16) >> 2)) : 0) * 8); }
            else { const int s2 = slot - 2176, tl = s2 >= 1152 ? 1 : 0, rs = s2 - 1152 * tl, row = rs / 9, seg = rs - 9 * row; doff[k] = (unsigned)(row * SEQ + 64 * tl + (seg & 7) * 8); } }
#define ATT_DMA(jj, buf) do { const bf16_t* kb_ = kbase + (size_t)(jj) * 128 * 512; const bf16_t* vb_ = vbase + (size_t)(jj) * 128; \
            _Pragma("unroll") for (int k = 0; k < 9; ++k) { const int i_ = (wave + NWAVE * k < 70) ? wave + NWAVE * k : 69; const bf16_t* src = (i_ < 34 ? kb_ : vb_) + doff[k]; \
                __builtin_amdgcn_global_load_lds((const unsigned*)src, (LAS unsigned*)(LAS unsigned char*)(lds + (buf) * 71680 + i_ * 1024), 16, 0, 0); } } while (0)
        __syncthreads();
        ATT_DMA(0, 0);
        asm volatile("s_waitcnt vmcnt(0)" ::: "memory");
        __syncthreads();
        for (int j = 0; j <= qb; ++j) {
            const int T = 2 * j + par;
            unsigned long long mw64[2];
#pragma unroll
            for (int cg = 0; cg < 2; ++cg) asm volatile("global_load_dwordx2 %0, %1, off" : "=v"(mw64[cg]) : "v"(MASKB + (m0 + 16 * cg + fr) * 256 + 2 * T) : "memory");
            ATT_DMA(j + 1, (j + 1) & 1);
            const bf16_t* Ktb = Kt + (j & 1) * 35840; const bf16_t* Vtb = Vt + (j & 1) * 35840;
            if (T <= mych) {
                const bf16_t* kt = Ktb + par * 64 * 136; const bf16_t* vtl = Vtb + par * 128 * 72;
                bf16x8 kf[2][4];
#define ATT_LDK(bf_, rg_) do { const int krow = 32 * ((rg_) >> 1) + 8 * (fr >> 2) + 4 * ((rg_) & 1) + (fr & 3); \
                    _Pragma("unroll") for (int ks = 0; ks < 4; ++ks) kf[bf_][ks] = *(const bf16x8*)(kt + krow * 136 + ((4 * ks + fq) ^ ((krow & 16) >> 2)) * 8); } while (0)
                ATT_LDK(0, 0);
                f32x4 S[2][4];
#pragma unroll
                for (int rg = 0; rg < 4; ++rg) { S[0][rg] = (f32x4){-mrun[0], -mrun[0], -mrun[0], -mrun[0]}; S[1][rg] = (f32x4){-mrun[1], -mrun[1], -mrun[1], -mrun[1]};
                    if (rg < 3) ATT_LDK((rg + 1) & 1, rg + 1);
                    __builtin_amdgcn_sched_barrier(0);
#pragma unroll
                    for (int ks = 0; ks < 4; ++ks) { S[0][rg] = __builtin_amdgcn_mfma_f32_16x16x32_bf16(kf[rg & 1][ks], qf[0][ks], S[0][rg], 0, 0, 0); S[1][rg] = __builtin_amdgcn_mfma_f32_16x16x32_bf16(kf[rg & 1][ks], qf[1][ks], S[1][rg], 0, 0, 0); }
                    __builtin_amdgcn_sched_barrier(0); }
#undef ATT_LDK
                bf16x8 vf[2][4];
#define ATT_LDV(bf_, g_) do { _Pragma("unroll") for (int i_ = 0; i_ < 2; ++i_) _Pragma("unroll") for (int k2 = 0; k2 < 2; ++k2) vf[bf_][2 * i_ + k2] = *(const bf16x8*)(vtl + (16 * (2 * (g_) + i_) + fr) * 72 + 32 * k2 + 8 * fq); } while (0)
                ATT_LDV(0, 0);
                __builtin_amdgcn_sched_barrier(0);
                asm volatile("s_waitcnt vmcnt(9)" : "+v"(mw64[0]), "+v"(mw64[1]) :: "memory");
                const uint2 mw[2] = {make_uint2((unsigned)mw64[0], (unsigned)(mw64[0] >> 32)), make_uint2((unsigned)mw64[1], (unsigned)(mw64[1] >> 32))};
                bf16x8 pf[2][2];
#pragma unroll
                for (int cg = 0; cg < 2; ++cg) {
                    float mx = fmaxf(fmaxf(fmaxf(S[cg][0][0], S[cg][0][1]), fmaxf(S[cg][0][2], S[cg][0][3])), fmaxf(fmaxf(S[cg][1][0], S[cg][1][1]), fmaxf(S[cg][1][2], S[cg][1][3])));
                    mx = fmaxf(mx, fmaxf(fmaxf(fmaxf(S[cg][2][0], S[cg][2][1]), fmaxf(S[cg][2][2], S[cg][2][3])), fmaxf(fmaxf(S[cg][3][0], S[cg][3][1]), fmaxf(S[cg][3][2], S[cg][3][3]))));
                    mx = fmaxf(mx, __shfl_xor(mx, 16)); mx = fmaxf(mx, __shfl_xor(mx, 32));
                    const float dlt = fmaxf(mx, 0.f);
                    const int m16 = (int)(((mw[cg].x >> (8 * fq)) & 0xFFu) | (((mw[cg].y >> (8 * fq)) & 0xFFu) << 8));
                    if (__builtin_amdgcn_ballot_w64(dlt != 0.f) != 0ull) {
                        mrun[cg] += dlt; const float alpha = __builtin_amdgcn_exp2f(-dlt);
#pragma unroll
                        for (int rg = 0; rg < 4; ++rg)
#pragma unroll
                            for (int r = 0; r < 4; ++r) S[cg][rg][r] -= dlt;
#pragma unroll
                        for (int vt = 0; vt < 8; ++vt) O[cg][vt] = O[cg][vt] * alpha;
                        Lacc[cg] = Lacc[cg] * alpha; }
#pragma unroll
                    for (int rg = 0; rg < 4; ++rg)
#pragma unroll
                        for (int r = 0; r < 4; ++r) S[cg][rg][r] = __int_as_float(__float_as_int(__builtin_amdgcn_exp2f(S[cg][rg][r])) & __builtin_amdgcn_sbfe(m16, 4 * rg + r, 1));
#pragma unroll
                    for (int k2 = 0; k2 < 2; ++k2) { const u32x4 w = {pg8::cvt_pk_bf16(S[cg][2 * k2][0], S[cg][2 * k2][1]), pg8::cvt_pk_bf16(S[cg][2 * k2][2], S[cg][2 * k2][3]), pg8::cvt_pk_bf16(S[cg][2 * k2 + 1][0], S[cg][2 * k2 + 1][1]), pg8::cvt_pk_bf16(S[cg][2 * k2 + 1][2], S[cg][2 * k2 + 1][3])};
                        pf[cg][k2] = __builtin_bit_cast(bf16x8, w); }
                    Lacc[cg] = __builtin_amdgcn_mfma_f32_16x16x32_bf16(xones, pf[cg][0], Lacc[cg], 0, 0, 0); Lacc[cg] = __builtin_amdgcn_mfma_f32_16x16x32_bf16(xones, pf[cg][1], Lacc[cg], 0, 0, 0);
                }
#pragma unroll
                for (int g = 0; g < 4; ++g) {
                    if (g < 3) ATT_LDV((g + 1) & 1, g + 1);
                    __builtin_amdgcn_sched_barrier(0);
#pragma unroll
                    for (int i_ = 0; i_ < 2; ++i_)
#pragma unroll
                        for (int k2 = 0; k2 < 2; ++k2) { const int vt = 2 * g + i_;
                            O[0][vt] = __builtin_amdgcn_mfma_f32_16x16x32_bf16(vf[g & 1][2 * i_ + k2], pf[0][k2], O[0][vt], 0, 0, 0); O[1][vt] = __builtin_amdgcn_mfma_f32_16x16x32_bf16(vf[g & 1][2 * i_ + k2], pf[1][k2], O[1][vt], 0, 0, 0); }
                    __builtin_amdgcn_sched_barrier(0); }
#undef ATT_LDV
            }
            asm volatile("s_waitcnt vmcnt(0)" ::: "memory");
            __syncthreads();
        }
#undef ATT_DMA
        const float lrun[2] = {Lacc[0][0], Lacc[1][0]};
        float* mb = sMrg + (size_t)g4 * 68 * 64 + lane;
        if (par == 1) {
#pragma unroll
            for (int cg = 0; cg < 2; ++cg) { mb[(cg * 2 + 0) * 64] = mrun[cg]; mb[(cg * 2 + 1) * 64] = lrun[cg];
#pragma unroll
                for (int vt = 0; vt < 8; ++vt)
#pragma unroll
                    for (int r = 0; r < 4; ++r) mb[(4 + (cg * 8 + vt) * 4 + r) * 64] = O[cg][vt][r]; } }
        __syncthreads();
        if (par == 0) {
            bf16_t* YC = (bf16_t*)(oport(ws) + WS_YALL) + (size_t)2 * M * 512;
#pragma unroll
            for (int cg = 0; cg < 2; ++cg) { const float m1 = mb[(cg * 2 + 0) * 64], l1 = mb[(cg * 2 + 1) * 64]; const float mm = fmaxf(mrun[cg], m1), a0 = __builtin_amdgcn_exp2f(mrun[cg] - mm), a1 = __builtin_amdgcn_exp2f(m1 - mm);
                float lt = lrun[cg] * a0 + l1 * a1; lt += __shfl_xor(lt, 16); lt += __shfl_xor(lt, 32); const float inv = 1.f / lt;
#pragma unroll
                for (int vt = 0; vt < 8; ++vt) { float o[4];
#pragma unroll
                    for (int r = 0; r < 4; ++r) o[r] = (O[cg][vt][r] * a0 + mb[(4 + (cg * 8 + vt) * 4 + r) * 64] * a1) * inv;
                    *(unsigned long long*)(YC + (m0 + 16 * cg + fr) * 512 + h * 128 + 16 * vt + 4 * fq) = (unsigned long long)pk2(o[0], o[1]) | ((unsigned long long)pk2(o[2], o[3]) << 32); } } }
      }
    }
}
__device__ __forceinline__ void ph_norm2(const Args& a, int l, int wv) {
    const int tid = otid(wv), lane = tid & 63, gw = blockIdx.x * NWAVE + (tid >> 6), ngw = gridDim.x * NWAVE;
    unsigned char* ws = oport(a.ws);
#pragma unroll 2
    for (int m = gw; m < M; m += ngw) rms_row_to_bf16(a.out + (size_t)m * D, a.norm2 + l * D, (bf16_t*)(ws + WS_H16) + (size_t)m * D, lane);
    { const f32x4* U = (const f32x4*)(a.peer_u + (size_t)l * NEXP * D); const f32x4* V = (const f32x4*)(a.peer_v + (size_t)l * NEXP * D); u32x4* U8 = (u32x4*)(ws + WS_U16); u32x4* V8 = (u32x4*)(ws + WS_V16);
#pragma unroll 2
      for (size_t i = (size_t)blockIdx.x * NTHR + tid; i < (size_t)NEXP * D / 16; i += (size_t)gridDim.x * NTHR) { u32x4 ou, ov; unsigned* pu = (unsigned*)&ou; unsigned* pv = (unsigned*)&ov;
#pragma unroll
          for (int q = 0; q < 4; ++q) { const f32x4 u = U[4 * i + q] * 256.f, v = V[4 * i + q] * 64.f; int wu = 0, wvv = 0;
              wu = __builtin_amdgcn_cvt_pk_fp8_f32(u.x, u.y, wu, false); wu = __builtin_amdgcn_cvt_pk_fp8_f32(u.z, u.w, wu, true); wvv = __builtin_amdgcn_cvt_pk_fp8_f32(v.x, v.y, wvv, false); wvv = __builtin_amdgcn_cvt_pk_fp8_f32(v.z, v.w, wvv, true);
              pu[q] = (unsigned)wu; pv[q] = (unsigned)wvv; }
          U8[i] = ou; V8[i] = ov; } }
}
#define CE_(a_, b_) do { const float hi_ = fmaxf(a_, b_), lo_ = fminf(a_, b_); a_ = hi_; b_ = lo_; } while (0)
#define SORT16D(x) do { CE_(x[0], x[1]); CE_(x[3], x[2]); CE_(x[4], x[5]); CE_(x[7], x[6]); CE_(x[8], x[9]); CE_(x[11], x[10]); CE_(x[12], x[13]); CE_(x[15], x[14]); CE_(x[0], x[2]); CE_(x[1], x[3]); CE_(x[6], x[4]); CE_(x[7], x[5]); CE_(x[8], x[10]); CE_(x[9], x[11]); CE_(x[14], x[12]); CE_(x[15], x[13]); CE_(x[0], x[1]); CE_(x[2], x[3]); CE_(x[5], x[4]); CE_(x[7], x[6]); CE_(x[8], x[9]); CE_(x[10], x[11]); CE_(x[13], x[12]); CE_(x[15], x[14]); CE_(x[0], x[4]); CE_(x[1], x[5]); CE_(x[2], x[6]); CE_(x[3], x[7]); CE_(x[12], x[8]); CE_(x[13], x[9]); CE_(x[14], x[10]); CE_(x[15], x[11]); CE_(x[0], x[2]); CE_(x[1], x[3]); CE_(x[4], x[6]); CE_(x[5], x[7]); CE_(x[10], x[8]); CE_(x[11], x[9]); CE_(x[14], x[12]); CE_(x[15], x[13]); CE_(x[0], x[1]); CE_(x[2], x[3]); CE_(x[4], x[5]); CE_(x[6], x[7]); CE_(x[9], x[8]); CE_(x[11], x[10]); CE_(x[13], x[12]); CE_(x[15], x[14]); CE_(x[0], x[8]); CE_(x[1], x[9]); CE_(x[2], x[10]); CE_(x[3], x[11]); CE_(x[4], x[12]); CE_(x[5], x[13]); CE_(x[6], x[14]); CE_(x[7], x[15]); CE_(x[0], x[4]); CE_(x[1], x[5]); CE_(x[2], x[6]); CE_(x[3], x[7]); CE_(x[8], x[12]); CE_(x[9], x[13]); CE_(x[10], x[14]); CE_(x[11], x[15]); CE_(x[0], x[2]); CE_(x[1], x[3]); CE_(x[4], x[6]); CE_(x[5], x[7]); CE_(x[8], x[10]); CE_(x[9], x[11]); CE_(x[12], x[14]); CE_(x[13], x[15]); CE_(x[0], x[1]); CE_(x[2], x[3]); CE_(x[4], x[5]); CE_(x[6], x[7]); CE_(x[8], x[9]); CE_(x[10], x[11]); CE_(x[12], x[13]); CE_(x[14], x[15]); } while (0)
#define MERGE16D(x) do { CE_(x[0], x[8]); CE_(x[1], x[9]); CE_(x[2], x[10]); CE_(x[3], x[11]); CE_(x[4], x[12]); CE_(x[5], x[13]); CE_(x[6], x[14]); CE_(x[7], x[15]); CE_(x[0], x[4]); CE_(x[1], x[5]); CE_(x[2], x[6]); CE_(x[3], x[7]); CE_(x[8], x[12]); CE_(x[9], x[13]); CE_(x[10], x[14]); CE_(x[11], x[15]); CE_(x[0], x[2]); CE_(x[1], x[3]); CE_(x[4], x[6]); CE_(x[5], x[7]); CE_(x[8], x[10]); CE_(x[9], x[11]); CE_(x[12], x[14]); CE_(x[13], x[15]); CE_(x[0], x[1]); CE_(x[2], x[3]); CE_(x[4], x[5]); CE_(x[6], x[7]); CE_(x[8], x[9]); CE_(x[10], x[11]); CE_(x[12], x[13]); CE_(x[14], x[15]); } while (0)
__device__ __forceinline__ float pkf(float v, unsigned tag) { return __uint_as_float((__float_as_uint(v) & 0xFFFFFF00u) | tag); }
__device__ __forceinline__ void ph_peer_select(const Args& a, int l, unsigned char* lds, int wv, int nunits, int pm0, int pn0, int pm1, int pn1) {
    unsigned char* ws = oport(a.ws); const int tid = otid(wv), lane = tid & 63, wave = __builtin_amdgcn_readfirstlane(tid >> 6), fr = lane & 15, fq = lane >> 4;
    bf16_t* sK = (bf16_t*)lds;
    int* sI = (int*)(lds + 69632 + wave * 2048);
    const bf16_t* QRY = (const bf16_t*)(ws + WS_GB); const bf16_t* SKB = (const bf16_t*)(ws + WS_SKB) + (size_t)l * 16 * 128 * 128; int* EID = (int*)(ws + WS_EID); float* EG = (float*)(ws + WS_EG);
  for (int uu = 0; uu < nunits; ++uu) { const int h = uu == 0 ? pn0 : pn1, pmu = uu == 0 ? pm0 : pm1;
    __syncthreads();
    { const u32x4* src = (const u32x4*)(SKB + (size_t)h * 2 * 128 * 128);
#pragma unroll
      for (int n = 0; n < 8; ++n) { const int idx = tid + NTHR * n, row = idx >> 4, seg = idx & 15; *(u32x4*)(sK + row * 136 + seg * 8) = src[idx]; } }
    __syncthreads();
    for (int it = wave; it < 16; it += NWAVE) { const int tg = pmu * 16 + it; const size_t m = (size_t)tg * 16 + fr;
        float va[16], vb[16];
#pragma unroll
        for (int p = 0; p < 2; ++p) {
            bf16x8 qf[4];
#pragma unroll
            for (int ks = 0; ks < 4; ++ks) qf[ks] = *(const bf16x8*)(QRY + m * 2048 + h * 256 + p * 128 + 32 * ks + 8 * fq);
            const bf16_t* kb = sK + (size_t)p * 128 * 136; float s0[16], s1[16];
#pragma unroll
            for (int nt = 0; nt < 8; ++nt) { f32x4 acc = {0.f, 0.f, 0.f, 0.f};
#pragma unroll
                for (int ks = 0; ks < 4; ++ks) { const bf16x8 x = *(const bf16x8*)(kb + (16 * nt + fr) * 136 + 32 * ks + 8 * fq); acc = __builtin_amdgcn_mfma_f32_16x16x32_bf16(x, qf[ks], acc, 0, 0, 0); }
#pragma unroll
                for (int r = 0; r < 4; ++r) { const float tv = __uint_as_float((__float_as_uint(acc[r]) & 0xFFFFFF80u) | (unsigned)(127 - (16 * nt + 4 * fq + r))); if (nt < 4) s0[nt * 4 + r] = tv; else s1[(nt - 4) * 4 + r] = tv; } }
            SORT16D(s0); SORT16D(s1);
            float t[16];
#pragma unroll
            for (int i = 0; i < 16; ++i) t[i] = fmaxf(s0[i], s1[15 - i]);
            MERGE16D(t);
#pragma unroll
            for (int off = 16; off <= 32; off <<= 1) { float o[16];
#pragma unroll
                for (int i = 0; i < 16; ++i) o[i] = __shfl_xor(t[15 - i], off);
#pragma unroll
                for (int i = 0; i < 16; ++i) t[i] = fmaxf(t[i], o[i]);
                MERGE16D(t); }
#pragma unroll
            for (int i = 0; i < 16; ++i) { if (p == 0) va[i] = t[i]; else vb[i] = t[i]; }
            __builtin_amdgcn_sched_barrier(0);
        }
        if (fq == 0) {
#pragma unroll
            for (int r = 0; r < 16; ++r) { sI[fr * 32 + r] = 127 - (int)(__float_as_uint(va[r]) & 127u); sI[fr * 32 + 16 + r] = 127 - (int)(__float_as_uint(vb[r]) & 127u); } }
#pragma unroll
        for (int r = 0; r < 16; ++r) { va[r] = __uint_as_float(__float_as_uint(va[r]) & 0xFFFFFF80u); vb[r] = __uint_as_float(__float_as_uint(vb[r]) & 0xFFFFFF80u); }
        float cs[16];
        {
            cs[0] = fq == 0 ? pkf(va[0] + vb[0], 255u) : fq == 1 ? pkf(va[0] + vb[1], 254u) : fq == 2 ? pkf(va[0] + vb[2], 253u) : pkf(va[0] + vb[3], 252u);
            cs[1] = fq == 0 ? pkf(va[0] + vb[4], 251u) : fq == 1 ? pkf(va[0] + vb[5], 250u) : fq == 2 ? pkf(va[0] + vb[6], 249u) : pkf(va[0] + vb[7], 248u);
            cs[2] = fq == 0 ? pkf(va[0] + vb[8], 247u) : fq == 1 ? pkf(va[0] + vb[9], 246u) : fq == 2 ? pkf(va[0] + vb[10], 245u) : pkf(va[0] + vb[11], 244u);
            cs[3] = fq == 0 ? pkf(va[0] + vb[12], 243u) : fq == 1 ? pkf(va[0] + vb[13], 242u) : fq == 2 ? pkf(va[0] + vb[14], 241u) : pkf(va[0] + vb[15], 240u);
            cs[4] = fq == 0 ? pkf(va[1] + vb[0], 239u) : fq == 1 ? pkf(va[1] + vb[1], 238u) : fq == 2 ? pkf(va[1] + vb[2], 237u) : pkf(va[1] + vb[3], 236u);
            cs[5] = fq == 0 ? pkf(va[1] + vb[4], 235u) : fq == 1 ? pkf(va[1] + vb[5], 234u) : fq == 2 ? pkf(va[1] + vb[6], 233u) : pkf(va[1] + vb[7], 232u);
            cs[6] = fq == 0 ? pkf(va[2] + vb[0], 223u) : fq == 1 ? pkf(va[2] + vb[1], 222u) : fq == 2 ? pkf(va[2] + vb[2], 221u) : pkf(va[2] + vb[3], 220u);
            cs[7] = fq == 0 ? pkf(va[2] + vb[4], 219u) : fq == 1 ? pkf(va[3] + vb[0], 207u) : fq == 2 ? pkf(va[3] + vb[1], 206u) : pkf(va[3] + vb[2], 205u);
            cs[8] = fq == 0 ? pkf(va[3] + vb[3], 204u) : fq == 1 ? pkf(va[4] + vb[0], 191u) : fq == 2 ? pkf(va[4] + vb[1], 190u) : pkf(va[4] + vb[2], 189u);
            cs[9] = fq == 0 ? pkf(va[5] + vb[0], 175u) : fq == 1 ? pkf(va[5] + vb[1], 174u) : fq == 2 ? pkf(va[6] + vb[0], 159u) : pkf(va[6] + vb[1], 158u);
            cs[10] = fq == 0 ? pkf(va[7] + vb[0], 143u) : fq == 1 ? pkf(va[7] + vb[1], 142u) : fq == 2 ? pkf(va[8] + vb[0], 127u) : pkf(va[9] + vb[0], 111u);
            cs[11] = fq == 0 ? pkf(va[10] + vb[0], 95u) : fq == 1 ? pkf(va[11] + vb[0], 79u) : fq == 2 ? pkf(va[12] + vb[0], 63u) : pkf(va[13] + vb[0], 47u);
            cs[12] = fq == 0 ? pkf(va[14] + vb[0], 31u) : fq == 1 ? pkf(va[15] + vb[0], 15u) : fq == 2 ? -INFINITY : -INFINITY;
            cs[13] = -INFINITY; cs[14] = -INFINITY; cs[15] = -INFINITY;
        }
        __builtin_amdgcn_sched_barrier(0);
        SORT16D(cs);
#pragma unroll
        for (int off = 16; off <= 32; off <<= 1) { float o[16];
#pragma unroll
            for (int i = 0; i < 16; ++i) o[i] = __shfl_xor(cs[15 - i], off);
#pragma unroll
            for (int i = 0; i < 16; ++i) cs[i] = fmaxf(cs[i], o[i]);
            MERGE16D(cs); }
        float bv[16];
#pragma unroll
        for (int i = 0; i < 16; ++i) bv[i] = cs[i];
        asm volatile("s_waitcnt lgkmcnt(0)" ::: "memory"); __builtin_amdgcn_sched_barrier(0);
        if (fq == 0) { int eid[16]; float ex[16]; float sm = 0.f; const float b0 = __uint_as_float(__float_as_uint(bv[0]) & 0xFFFFFF00u);
#pragma unroll
            for (int r = 0; r < 16; ++r) { const unsigned bits = __float_as_uint(bv[r]); const int f = 255 - (int)(bits & 255u); eid[r] = sI[fr * 32 + (f >> 4)] * 128 + sI[fr * 32 + 16 + (f & 15)];
                ex[r] = __expf(__uint_as_float(bits & 0xFFFFFF00u) - b0); sm += ex[r]; }
            const float inv = 1.f / sm; int* ep = EID + m * 128 + h * 16; float* gp = EG + m * 128 + h * 16;
#pragma unroll
            for (int r = 0; r < 16; r += 4) { *(int4*)(ep + r) = make_int4(eid[r], eid[r + 1], eid[r + 2], eid[r + 3]); *(f32x4*)(gp + r) = (f32x4){ex[r] * inv, ex[r + 1] * inv, ex[r + 2] * inv, ex[r + 3] * inv}; } }
        asm volatile("s_waitcnt lgkmcnt(0)" ::: "memory");
    }
  }
}
typedef float f32x2_t __attribute__((ext_vector_type(2)));
__device__ __forceinline__ void dec8(const u32x4 w, f32x2_t (&f)[8]) {
    const unsigned ww[4] = {w.x, w.y, w.z, w.w};
#pragma unroll
    for (int q = 0; q < 4; ++q) { f[2 * q] = __builtin_amdgcn_cvt_pk_f32_fp8((int)ww[q], false); f[2 * q + 1] = __builtin_amdgcn_cvt_pk_f32_fp8((int)ww[q], true); }
}
__device__ __forceinline__ void ph_peer_experts(const Args& a, int l, unsigned char* lds, int wv) {
    unsigned char* ws = oport(a.ws); const int tid = otid(wv), lane = tid & 63, wave = __builtin_amdgcn_readfirstlane(tid >> 6), gw = blockIdx.x * NWAVE + wave, ngw = gridDim.x * NWAVE;
    const bf16_t* H16 = (const bf16_t*)(ws + WS_H16); const int* EID = (const int*)(ws + WS_EID); const float* EG = (const float*)(ws + WS_EG);
    const unsigned char* U8 = (const unsigned char*)(ws + WS_U16); const unsigned char* V8 = (const unsigned char*)(ws + WS_V16);
    float* sPA = (float*)(lds + wave * 8192) + lane; float* sPB = sPA + 1024;
    int* sEA = (int*)(lds + 65536 + wave * 2048); float* sGA = (float*)(sEA + 128); int* sEB = sEA + 256; float* sGB = (float*)(sEB + 128);
    for (int it = 0, nit = ((M + ngw - 1) / ngw + 1) / 2; it < nit; ++it) { const int mA = gw + (2 * it) * ngw, mB = mA + ngw; const bool vA = mA < M, vB = mB < M;
        __syncthreads();
        if (!vA) continue;
        const int mBs = vB ? mB : mA;
        f32x2_t hpA[8], hpB[8], accA[8], accB[8];
#define LOADH(hp, m_) do { float hv_[16]; const u32x4 h0_ = *(const u32x4*)(H16 + (size_t)(m_) * D + lane * 16), h1_ = *(const u32x4*)(H16 + (size_t)(m_) * D + lane * 16 + 8); \
          hv_[0] = lo_bf(h0_.x); hv_[1] = hi_bf(h0_.x); hv_[2] = lo_bf(h0_.y); hv_[3] = hi_bf(h0_.y); hv_[4] = lo_bf(h0_.z); hv_[5] = hi_bf(h0_.z); hv_[6] = lo_bf(h0_.w); hv_[7] = hi_bf(h0_.w); \
          hv_[8] = lo_bf(h1_.x); hv_[9] = hi_bf(h1_.x); hv_[10] = lo_bf(h1_.y); hv_[11] = hi_bf(h1_.y); hv_[12] = lo_bf(h1_.z); hv_[13] = hi_bf(h1_.z); hv_[14] = lo_bf(h1_.w); hv_[15] = hi_bf(h1_.w); \
          _Pragma("unroll") for (int j_ = 0; j_ < 8; ++j_) hp[j_] = (f32x2_t){hv_[2 * j_], hv_[2 * j_ + 1]}; } while (0)
        LOADH(hpA, mA); LOADH(hpB, mBs);
#pragma unroll
        for (int j = 0; j < 8; ++j) { accA[j] = (f32x2_t){0.f, 0.f}; accB[j] = (f32x2_t){0.f, 0.f}; }
#define SORTTOK(m_, sE_, sG_) do { int key[2] = {EID[(size_t)(m_) * 128 + 2 * lane], EID[(size_t)(m_) * 128 + 2 * lane + 1]}; float pay[2] = {EG[(size_t)(m_) * 128 + 2 * lane], EG[(size_t)(m_) * 128 + 2 * lane + 1]}; \
          _Pragma("unroll") for (int k = 2; k <= 128; k <<= 1) _Pragma("unroll") for (int j = k >> 1; j >= 1; j >>= 1) { \
              if (j == 1) { const bool asc = ((2 * lane) & k) == 0; if ((key[0] > key[1]) == asc) { const int tk = key[0]; key[0] = key[1]; key[1] = tk; const float tp = pay[0]; pay[0] = pay[1]; pay[1] = tp; } } \
              else { const int lj = j >> 1; const bool keep_min = (((2 * lane) & k) == 0) == ((lane & lj) == 0); \
                  _Pragma("unroll") for (int r = 0; r < 2; ++r) { const int pk = __shfl_xor(key[r], lj); const float pp = __shfl_xor(pay[r], lj); const bool take = keep_min ? (pk < key[r]) : (pk > key[r]); if (take) { key[r] = pk; pay[r] = pp; } } } } \
          *(int2*)(sE_ + 2 * lane) = make_int2(key[0], key[1]); *(float2*)(sG_ + 2 * lane) = make_float2(pay[0], pay[1]); } while (0)
        SORTTOK(mA, sEA, sGA); SORTTOK(mBs, sEB, sGB);
        asm volatile("s_waitcnt lgkmcnt(0)" ::: "memory");
#pragma unroll 1
        for (int half = 0; half < 2; ++half) {
            const int pos = half * 64 + 4 * (lane & 15) + (((lane >> 4) == 1) ? 2 : ((lane >> 4) == 2) ? 1 : (lane >> 4));
            const int evA = sEA[pos], evB = sEB[pos]; const float gvA = sGA[pos], gvB = sGB[pos];
            u32x4 bufA[4], bufB[4];
#define ROWLD(dst, T, e_) dst = ((const u32x4*)(T + (size_t)(e_) * D))[lane]
#define KIDX(g, c) ((g) + ((c) == 1 ? 32 : (c) == 2 ? 16 : (c) == 3 ? 48 : 0))
#define LOADG(buf, T, ev_, g) do { _Pragma("unroll") for (int i_ = 0; i_ < 4; ++i_) ROWLD(buf[i_], T, __builtin_amdgcn_readlane(ev_, KIDX(g, i_))); } while (0)
#define BF2(a_, b_, o) (((lane & (o)) ? (b_) : (a_)) + __shfl_xor((lane & (o)) ? (a_) : (b_), (o)))
#define DOTG(buf, hp, sP_, g) do { float d4_[4]; _Pragma("unroll") for (int i_ = 0; i_ < 4; ++i_) { f32x2_t f_[8]; dec8(buf[i_], f_); f32x2_t d2_ = f_[0] * hp[0]; \
              _Pragma("unroll") for (int j_ = 1; j_ < 8; ++j_) d2_ = __builtin_elementwise_fma(f_[j_], hp[j_], d2_); d4_[i_] = d2_.x + d2_.y; } \
              const float q0_ = BF2(d4_[0], d4_[1], 32), q1_ = BF2(d4_[2], d4_[3], 32); sP_[(g) * 64] = BF2(q0_, q1_, 16); } while (0)
            LOADG(bufA, U8, evA, 0);
#pragma unroll 1
            for (int g = 0; g < 16; ++g) { const int gn = g < 15 ? g + 1 : 15;
                LOADG(bufB, U8, evB, g); DOTG(bufA, hpA, sPA, g);
                LOADG(bufA, U8, evA, gn); DOTG(bufB, hpB, sPB, g); }
            int svbA, svbB;
#define BFLY(o, n) do { const bool up_ = (lane & (o)) != 0; _Pragma("unroll") for (int i_ = 0; i_ < (n); ++i_) { const float a_ = p[i_], b_ = p[i_ + (n)]; const float sd_ = up_ ? a_ : b_, kp_ = up_ ? b_ : a_; p[i_] = kp_ + __shfl_xor(sd_, (o)); } } while (0)
#define FINISH(sP_, gv_, svb_) do { float p[16]; _Pragma("unroll") for (int i_ = 0; i_ < 16; ++i_) p[i_] = sP_[i_ * 64]; BFLY(8, 8); BFLY(4, 4); BFLY(2, 2); BFLY(1, 1); \
              svb_ = __builtin_bit_cast(int, gv_ * gelu_t(p[0] * (1.f / 256.f)) * (1.f / 64.f)); } while (0)
            FINISH(sPA, gvA, svbA); FINISH(sPB, gvB, svbB);
#define ACCG(buf, acc, svb_, g) do { _Pragma("unroll") for (int i_ = 0; i_ < 4; ++i_) { const float sk_ = __builtin_bit_cast(float, __builtin_amdgcn_readlane(svb_, KIDX(g, i_))); const f32x2_t s2_ = {sk_, sk_}; f32x2_t f_[8]; dec8(buf[i_], f_); \
              _Pragma("unroll") for (int j_ = 0; j_ < 8; ++j_) acc[j_] = __builtin_elementwise_fma(f_[j_], s2_, acc[j_]); } } while (0)
            LOADG(bufA, V8, evA, 0);
#pragma unroll 1
            for (int g = 0; g < 16; ++g) { const int gn = g < 15 ? g + 1 : 15;
                LOADG(bufB, V8, evB, g); ACCG(bufA, accA, svbA, g);
                LOADG(bufA, V8, evA, gn); ACCG(bufB, accB, svbB, g); }
#undef ROWLD
#undef KIDX
#undef LOADG
#undef BF2
#undef DOTG
#undef BFLY
#undef FINISH
#undef ACCG
        }
#define EPILOG(m_, acc2) do { float acc[16]; _Pragma("unroll") for (int j = 0; j < 8; ++j) { acc[2 * j] = acc2[j].x; acc[2 * j + 1] = acc2[j].y; } \
        float* xr = a.out + (size_t)(m_) * D + lane * 16; float xn[16]; float ss = 0.f; \
        _Pragma("unroll") for (int j = 0; j < 4; ++j) { const f32x4 xv = *(const f32x4*)(xr + 4 * j); xn[4 * j] = xv.x + acc[4 * j]; xn[4 * j + 1] = xv.y + acc[4 * j + 1]; xn[4 * j + 2] = xv.z + acc[4 * j + 2]; xn[4 * j + 3] = xv.w + acc[4 * j + 3]; } \
        _Pragma("unroll") for (int j = 0; j < 16; ++j) ss += xn[j] * xn[j]; \
        const float r = rsqrtf(wave_sum(ss) * (1.f / D) + EPS); \
        if (l + 1 < DEPTH) { const float* gn = a.norm1 + (size_t)(l + 1) * D + lane * 16; \
            _Pragma("unroll") for (int j = 0; j < 4; ++j) *(f32x4*)(xr + 4 * j) = (f32x4){xn[4 * j], xn[4 * j + 1], xn[4 * j + 2], xn[4 * j + 3]}; \
            u32x4 w0, w1; \
            w0.x = pk2(xn[0] * r * gn[0], xn[1] * r * gn[1]); w0.y = pk2(xn[2] * r * gn[2], xn[3] * r * gn[3]); w0.z = pk2(xn[4] * r * gn[4], xn[5] * r * gn[5]); w0.w = pk2(xn[6] * r * gn[6], xn[7] * r * gn[7]); \
            w1.x = pk2(xn[8] * r * gn[8], xn[9] * r * gn[9]); w1.y = pk2(xn[10] * r * gn[10], xn[11] * r * gn[11]); w1.z = pk2(xn[12] * r * gn[12], xn[13] * r * gn[13]); w1.w = pk2(xn[14] * r * gn[14], xn[15] * r * gn[15]); \
            *(u32x4*)((bf16_t*)(ws + WS_H16) + (size_t)(m_) * D + lane * 16) = w0; *(u32x4*)((bf16_t*)(ws + WS_H16) + (size_t)(m_) * D + lane * 16 + 8) = w1; \
        } else { const float* gn = a.final_gain + lane * 16; \
            _Pragma("unroll") for (int j = 0; j < 4; ++j) *(f32x4*)(xr + 4 * j) = (f32x4){xn[4 * j] * r * gn[4 * j], xn[4 * j + 1] * r * gn[4 * j + 1], xn[4 * j + 2] * r * gn[4 * j + 2], xn[4 * j + 3] * r * gn[4 * j + 3]}; } } while (0)
        EPILOG(mA, accA);
        if (vB) EPILOG(mB, accB);
#undef EPILOG
#undef LOADH
#undef SORTTOK
    }
}

constexpr int PH_PER_LAYER = 9, N_PHASES = 1 + DEPTH * PH_PER_LAYER;
__global__ void __launch_bounds__(NTHR, 2) fwd_kernel(Args a) {
    extern __shared__ __attribute__((aligned(16))) unsigned char lds[];
    const int wv = __builtin_amdgcn_readfirstlane((int)threadIdx.x >> 6);
    const int tid = threadIdx.x;
    for (int u = tid; u < (LDS_BYTES - LDS_CTL_OFF) / 4; u += NTHR) ((unsigned*)(lds + LDS_CTL_OFF))[u] = 0u;
    __syncthreads();
    unsigned* ctl = (unsigned*)(a.ws + WS_CTL);
    XcdBarrier bar = xcd_barrier_post(ctl + 4096, (volatile LAS unsigned*)(LAS unsigned char*)(lds + LDS_CTL_OFF), wv);
    const int lo = a.ph_lo, hi = a.ph_hi;
#define IN(k) (lo <= (k) && (k) < hi)
#define SEAM(k) do { if (IN(k) && IN((k) + 1)) xcd_barrier(bar, wv); } while (0)
    unsigned char* ws = oport(a.ws);
    if (IN(0)) { ph_prologue(a, lds, wv); } SEAM(0);
    for (int l = 0; l < DEPTH; ++l) {
        const int pb = 1 + l * PH_PER_LAYER;
        unsigned char* ws = oport(a.ws);
        if (IN(pb + 0)) {
            ph_kiwi(a, l, lds, wv);
            pg8::Gemm g{(const bf16_t*)(ws + WS_H16), (const bf16_t*)(ws + WS_WIN + (size_t)l * WIN_L), M, NMAIN, D, 0, 0};
            pg8::StaticOrder S; S.init(M, NMAIN, gridDim.x, blockIdx.x, 0);
            pg8::EpiIn E{(bf16_t*)(ws + WS_P16), (float*)(ws + WS_PF)};
            pg8::gemm_phase(((LAS unsigned char*)lds), g, S, E, wv);
        } SEAM(pb + 0);
        if (IN(pb + 1)) { ph_post(a, l, lds, wv); ph_h1(a, l, lds, wv); } SEAM(pb + 1);
        if (IN(pb + 2)) { ph_h2(a, wv); ph_gmlp(a, l, lds, wv); ph_sel(a, lds, wv); } SEAM(pb + 2);
        if (IN(pb + 3)) { ph_attn(a, lds, wv); ph_h3(a, l, lds, wv); } SEAM(pb + 3);
        if (IN(pb + 4)) {
            pg8::Gemm g{(const bf16_t*)(ws + WS_YALL), (const bf16_t*)(ws + WS_WBR + (size_t)l * WBR_L), M, 3072, 512, (size_t)M * 512 * 2, 4};
            pg8::BranchOrder S; S.init(gridDim.x, blockIdx.x);
            pg8::EpiGate E{(bf16_t*)(ws + WS_GB), (const bf16_t*)(ws + WS_P16)};
            pg8::gemm_phase(((LAS unsigned char*)lds), g, S, E, wv);
        } SEAM(pb + 4);
        if (IN(pb + 5)) {
            pg8::Gemm g{(const bf16_t*)(ws + WS_GB), (const bf16_t*)(ws + WS_WOUT + (size_t)l * WOUT_L), M, D, D, 0, 0};
            pg8::StaticOrder S; S.init(M, D, gridDim.x, blockIdx.x, 0);
            pg8::EpiRes E{a.out};
            pg8::gemm_phase(((LAS unsigned char*)lds), g, S, E, wv);
        } SEAM(pb + 5);
        if (IN(pb + 6)) { ph_norm2(a, l, wv); } SEAM(pb + 6);
        if (IN(pb + 7)) {
            pg8::Gemm g{(const bf16_t*)(ws + WS_H16), (const bf16_t*)(ws + WS_WPQ + (size_t)l * WPQ_L), M, 2048, D, 0, 0};
            pg8::StaticOrder S; S.init(M, 2048, gridDim.x, blockIdx.x, 0);
            pg8::EpiB16 E{(bf16_t*)(ws + WS_GB), 2048};
            pg8::gemm_phase(((LAS unsigned char*)lds), g, S, E, wv);
            asm volatile("s_waitcnt vmcnt(0)" ::: "memory"); __syncthreads();
            for (int i0_ = 0;; i0_ += 2) { pg8::Unit u0, u1; if (!S.next(i0_, u0)) break; const bool two = S.next(i0_ + 1, u1);
                ph_peer_select(a, l, lds, wv, two ? 2 : 1, u0.pm, u0.pn, two ? u1.pm : 0, two ? u1.pn : 0); }
        } SEAM(pb + 7);
        if (IN(pb + 8)) { ph_peer_experts(a, l, lds, wv); } SEAM(pb + 8);
    }
#undef IN
#undef SEAM
}

#ifndef MK_N_LAUNCHES
#define MK_N_LAUNCHES 1
#endif
extern "C" void kernel_launch(void* const* d_in, const int* in_sizes, int n_in, void* d_out, int out_size, void* d_ws, size_t ws_size, hipStream_t stream) {
    static int grid = 0;
    if (grid == 0) {
        if (n_in != 17 || out_size != M * D || ws_size < WS_END) { fprintf(stderr, "kernel_launch: unexpected shapes (n_in %d, out %d, ws %zu)\n", n_in, out_size, ws_size); grid = -1; return; }
        int dev = 0, cus = 0, per_cu = 0;
        if (hipGetDevice(&dev) != hipSuccess || hipDeviceGetAttribute(&cus, hipDeviceAttributeMultiprocessorCount, dev) != hipSuccess) { grid = -1; return; }
        if (hipFuncSetAttribute((const void*)fwd_kernel, hipFuncAttributeMaxDynamicSharedMemorySize, LDS_BYTES) != hipSuccess) { fprintf(stderr, "kernel_launch: hipFuncSetAttribute failed\n"); grid = -1; return; }
        if (hipOccupancyMaxActiveBlocksPerMultiprocessor(&per_cu, (const void*)fwd_kernel, NTHR, LDS_BYTES) != hipSuccess || per_cu < 1) { fprintf(stderr, "kernel_launch: occupancy query says %d\n", per_cu); (void)hipGetLastError(); grid = -1; return; }
        grid = cus;
    }
    if (grid < 0) return;
    (void)hipMemsetAsync((char*)d_ws + WS_CTL, 0, CTL_BYTES, stream);
    Args a{};
    a.x = (const float*)d_in[0]; a.pos = (const int*)d_in[1]; a.norm1 = (const float*)d_in[2]; a.w_in = (const float*)d_in[3]; a.lb_logits = (const float*)d_in[4]; a.hgrn_gain = (const float*)d_in[5];
    a.gmlp_gain = (const float*)d_in[6]; a.gmlp_ws = (const float*)d_in[7]; a.gmlp_bs = (const float*)d_in[8]; a.w_branch = (const float*)d_in[9]; a.w_out = (const float*)d_in[10]; a.norm2 = (const float*)d_in[11];
    a.peer_wq = (const float*)d_in[12]; a.peer_keys = (const float*)d_in[13]; a.peer_u = (const float*)d_in[14]; a.peer_v = (const float*)d_in[15]; a.final_gain = (const float*)d_in[16];
    a.out = (float*)d_out; a.ws = (unsigned char*)d_ws;
    if (MK_N_LAUNCHES == 1) { a.ph_lo = 0; a.ph_hi = N_PHASES; hipLaunchKernelGGL(fwd_kernel, dim3(grid), dim3(NTHR), LDS_BYTES, stream, a); }
    else for (int p = 0; p < N_PHASES; ++p) { a.ph_lo = p; a.ph_hi = p + 1; hipLaunchKernelGGL(fwd_kernel, dim3(grid), dim3(NTHR), LDS_BYTES, stream, a); }
}
```

```cpp
#include <hip/hip_runtime.h>
#include <cstdio>
#include <cstdint>

#define LAS __attribute__((address_space(3)))
typedef unsigned short bf16_t;
typedef short bf16x8 __attribute__((ext_vector_type(8)));
typedef float f32x4 __attribute__((ext_vector_type(4)));
typedef unsigned u32x4 __attribute__((ext_vector_type(4)));

constexpr int D = 1024, BATCH = 2, SEQ = 8192, DEPTH = 4, M = BATCH * SEQ;
constexpr int NIN = 8264;
constexpr int NPAD = 8448;
constexpr int C_AQ = 0, C_AF = 512, C_AI = 1024, C_AG = 1536, C_BU = 2048, C_BV = 2560, C_CQ = 3072, C_CK = 3584, C_CV = 4096, C_QI = 4608, C_GL = 5120, C_KI = 8192, C_WI = 8256;
constexpr int NMAIN = 8192;
constexpr int S_GL = 5192;
constexpr int PFW = 768;
constexpr float EPS = 1e-6f;
constexpr int NEXP = 16384;

constexpr size_t MiB = 1u << 20;
constexpr size_t WS_CTL = 0, CTL_BYTES = 1 * MiB;
constexpr size_t WS_WIN = 2 * MiB;
constexpr size_t WIN_L = (size_t)NPAD * D * 2;
constexpr size_t WS_WBR = 68 * MiB;
constexpr size_t WBR_L = (size_t)3072 * 512 * 2;
constexpr size_t WS_WOUT = 80 * MiB;
constexpr size_t WOUT_L = (size_t)1024 * 3072 * 2;
constexpr size_t WS_WPQ = 104 * MiB;
constexpr size_t WPQ_L = (size_t)2048 * 1024 * 2;
constexpr size_t WS_LB = 120 * MiB;
constexpr size_t WS_CS = 121 * MiB;
constexpr size_t WS_H16 = 134 * MiB;
constexpr size_t WS_P16 = 166 * MiB;
constexpr size_t WS_PF = 430 * MiB;
constexpr size_t WS_QR = 478 * MiB, WS_KR = 494 * MiB;
constexpr size_t WS_QI = 510 * MiB;
constexpr size_t WS_KI = 542 * MiB;
constexpr size_t WS_WI = 546 * MiB;
constexpr size_t WS_FF = 548 * MiB, WS_KK = 580 * MiB, WS_QF = 612 * MiB;
constexpr size_t WS_OA = 644 * MiB;
constexpr size_t WS_VN = 676 * MiB;
constexpr size_t WS_YALL = 708 * MiB;
constexpr size_t WS_GB = 756 * MiB;
constexpr size_t WS_EID = 852 * MiB, WS_EG = 860 * MiB;
constexpr size_t WS_DD = 120 * MiB + 256 * 1024;
constexpr size_t WS_WSB = 544 * MiB;
constexpr size_t WS_VT = 644 * MiB;
constexpr size_t WS_MASK = 660 * MiB;
constexpr size_t WS_U16 = 868 * MiB, WS_V16 = 900 * MiB;
constexpr size_t WS_RS = 884 * MiB;
constexpr size_t WS_SKB = 932 * MiB;
constexpr size_t WS_END = 934 * MiB;

__device__ const float ROPE_INV64[64] = {
1.000000000e+00f, 8.659643531e-01f, 7.498942614e-01f, 6.493816376e-01f, 5.623413324e-01f, 4.869675338e-01f, 4.216965139e-01f, 3.651741147e-01f, 3.162277639e-01f, 2.738419771e-01f, 2.371373773e-01f, 2.053525001e-01f, 1.778279394e-01f, 1.539926529e-01f, 1.333521307e-01f, 1.154782027e-01f, 1.000000015e-01f, 8.659642935e-02f, 7.498941571e-02f, 6.493816525e-02f, 5.623413250e-02f, 4.869675264e-02f, 4.216965288e-02f, 3.651741147e-02f, 3.162277490e-02f, 2.738419734e-02f, 2.371373773e-02f, 2.053525113e-02f, 1.778279431e-02f, 1.539926510e-02f, 1.333521493e-02f, 1.154782064e-02f, 9.999999776e-03f, 8.659643121e-03f, 7.498941850e-03f, 6.493816152e-03f, 5.623413250e-03f, 4.869675264e-03f, 4.216964822e-03f, 3.651741194e-03f, 3.162277630e-03f, 2.738419687e-03f, 2.371373586e-03f, 2.053524833e-03f, 1.778279431e-03f, 1.539926510e-03f, 1.333521446e-03f, 1.154781901e-03f, 1.000000047e-03f, 8.659643354e-04f, 7.498942432e-04f, 6.493816618e-04f, 5.623413017e-04f, 4.869675322e-04f, 4.216965172e-04f, 3.651741426e-04f, 3.162277571e-04f, 2.738419571e-04f, 2.371373703e-04f, 2.053525095e-04f, 1.778279402e-04f, 1.539926452e-04f, 1.333521504e-04f, 1.154782003e-04f};
__device__ const float ROPE_INV32[32] = {
1.000000000e+00f, 7.498942614e-01f, 5.623413324e-01f, 4.216965139e-01f, 3.162277639e-01f, 2.371373773e-01f, 1.778279394e-01f, 1.333521307e-01f, 1.000000015e-01f, 7.498941571e-02f, 5.623413250e-02f, 4.216965288e-02f, 3.162277490e-02f, 2.371373773e-02f, 1.778279431e-02f, 1.333521493e-02f, 9.999999776e-03f, 7.498941850e-03f, 5.623413250e-03f, 4.216964822e-03f, 3.162277630e-03f, 2.371373586e-03f, 1.778279431e-03f, 1.333521446e-03f, 1.000000047e-03f, 7.498942432e-04f, 5.623413017e-04f, 4.216965172e-04f, 3.162277571e-04f, 2.371373703e-04f, 1.778279402e-04f, 1.333521504e-04f};

__device__ __forceinline__ float bf2f(bf16_t b) { return __uint_as_float(((unsigned)b) << 16); }
__device__ __forceinline__ unsigned f2bf(float f) { unsigned u = __float_as_uint(f); return (u + 0x7fffu + ((u >> 16) & 1u)) >> 16; }
__device__ __forceinline__ unsigned pk2(float lo, float hi) { return f2bf(lo) | (f2bf(hi) << 16); }
__device__ __forceinline__ float lo_bf(unsigned w) { return __uint_as_float(w << 16); }
__device__ __forceinline__ float hi_bf(unsigned w) { return __uint_as_float(w & 0xffff0000u); }
__device__ __forceinline__ float sigm(float x) { return 1.f / (1.f + __expf(-x)); }
__device__ __forceinline__ float silu(float x) { return x * sigm(x); }
__device__ __forceinline__ float gelu_t(float x) { const float u = 0.7978845608028654f * (x + 0.044715f * x * x * x); const float th = 1.f - 2.f / (1.f + __expf(2.f * u)); return 0.5f * x * (1.f + th); }
__device__ __forceinline__ float wave_sum(float v) {
#pragma unroll
    for (int o = 1; o < 64; o <<= 1) v += __shfl_xor(v, o);
    return v;
}
__device__ __forceinline__ float wave_max(float v) {
#pragma unroll
    for (int o = 1; o < 64; o <<= 1) v = fmaxf(v, __shfl_xor(v, o));
    return v;
}
typedef __bf16 bf2_t __attribute__((ext_vector_type(2)));
__device__ __forceinline__ float dot2(unsigned a, unsigned b, float c) { return __builtin_amdgcn_fdot2_f32_bf16(__builtin_bit_cast(bf2_t, a), __builtin_bit_cast(bf2_t, b), c, false); }
__device__ __forceinline__ int otid(int wv) { int t; asm volatile("v_mbcnt_lo_u32_b32 %0, -1, 0\n\tv_mbcnt_hi_u32_b32 %0, -1, %0" : "=v"(t)); return wv * 64 + t; }
__device__ __forceinline__ unsigned char* oport(unsigned char* p) { unsigned long long z; asm volatile("s_mov_b64 %0, 0" : "=s"(z)); return p + z; }
__device__ __forceinline__ int obid() { int b; asm volatile("s_mov_b32 %0, %1" : "=s"(b) : "s"((int)blockIdx.x)); return b; }
__device__ __forceinline__ unsigned fkey(float f) { const unsigned u = __float_as_uint(f); return u ^ ((u >> 31) ? 0xFFFFFFFFu : 0x80000000u); }

#define XB_TMO      128
#define XB_XCNT(j)  (256  + 64 * (j))
#define XB_XSUB(j)  (1280 + 64 * (j))
#define XB_XGEN(j)  (2304 + 64 * (j))
#define XB_TOP      3328
#define XB_TOPGEN   3392
#define XCD_BAR_WORDS 3456
#define XB_SPIN_CAP (1u << 23)
__device__ __forceinline__ unsigned xb_ld(unsigned* p)              { return __hip_atomic_load(p, __ATOMIC_RELAXED, __HIP_MEMORY_SCOPE_AGENT); }
__device__ __forceinline__ unsigned xb_add(unsigned* p, unsigned v) { return __hip_atomic_fetch_add(p, v, __ATOMIC_RELAXED, __HIP_MEMORY_SCOPE_AGENT); }
__device__ __forceinline__ unsigned xb_xcc_id() { return (unsigned)__builtin_amdgcn_s_getreg((3 << 11) | 20) & 0xFu; }
#define XB_SPIN(cond, bar) do { unsigned _sp = 0; while (cond) { __builtin_amdgcn_s_sleep(1); \
    if ((++_sp & 255u) == 0u) { if (xb_ld(&(bar)[XB_TMO])) break; if (_sp > XB_SPIN_CAP) { atomicAdd(&(bar)[XB_TMO], 1u); break; } } } } while (0)
struct XcdBarrier { unsigned* bar; unsigned x; volatile LAS unsigned* st; };
__device__ __forceinline__ XcdBarrier xcd_barrier_post(unsigned* bar, volatile LAS unsigned* st, int wv) {
    XcdBarrier b; b.bar = bar; b.x = xb_xcc_id(); b.st = st;
    if (wv == 0) if ((otid(0) & 63) == 0) (void)xb_add(&bar[XB_XCNT(b.x)], 1u);
    return b;
}
__device__ __forceinline__ void xcd_barrier_complete(unsigned* bar, unsigned x, unsigned& nloc, unsigned& nx) {
    const unsigned G = gridDim.x * gridDim.y * gridDim.z;
    unsigned sum, cnt, mine, sp = 0u;
    for (;;) {
        sum = 0u; cnt = 0u; mine = 0u;
#pragma unroll
        for (unsigned j = 0; j < 16; ++j) { const unsigned c = xb_ld(&bar[XB_XCNT(j)]); sum += c; cnt += (c > 0u) ? 1u : 0u; mine = (j == x) ? c : mine; }
        if (sum == G) break;
        __builtin_amdgcn_s_sleep(1);
        if ((++sp & 255u) == 0u) { if (xb_ld(&bar[XB_TMO])) break; if (sp > XB_SPIN_CAP) { atomicAdd(&bar[XB_TMO], 1u); break; } }
    }
    nloc = mine > 0u ? mine : 1u; nx = cnt > 0u ? cnt : 1u;
}
__device__ __forceinline__ void xcd_barrier(const XcdBarrier& b, int wv) {
    asm volatile("s_waitcnt vmcnt(0)" ::: "memory");
    __syncthreads();
    if (wv == 0) if ((otid(0) & 63) == 0) {
        unsigned* bar = b.bar;
        __builtin_amdgcn_s_waitcnt(0);
        unsigned nloc = b.st[0], nx = b.st[1];
        if (nloc == 0u) { xcd_barrier_complete(bar, b.x, nloc, nx); b.st[0] = nloc; b.st[1] = nx; }
        const unsigned old = xb_add(&bar[XB_XSUB(b.x)], 1u);
        const unsigned gen = old / nloc;
        if (old + 1u == (gen + 1u) * nloc) {
            __builtin_amdgcn_fence(__ATOMIC_RELEASE, "agent");
            asm volatile("s_waitcnt vmcnt(0)" ::: "memory");
            const unsigned og = xb_add(&bar[XB_TOP], 1u);
            const unsigned tg = og / nx;
            if (og + 1u == (tg + 1u) * nx) xb_add(&bar[XB_TOPGEN], 1u);
            else XB_SPIN(xb_ld(&bar[XB_TOPGEN]) == tg, bar);
            __builtin_amdgcn_fence(__ATOMIC_ACQUIRE, "agent");
            xb_add(&bar[XB_XGEN(b.x)], 1u);
            asm volatile("s_waitcnt vmcnt(0)" ::: "memory");
        } else {
            XB_SPIN(xb_ld(&bar[XB_XGEN(b.x)]) == gen, bar);
            __builtin_amdgcn_fence(__ATOMIC_ACQUIRE, "agent");
            asm volatile("s_waitcnt vmcnt(0)" ::: "memory");
        }
    }
    __syncthreads();
}

namespace pg8 {
constexpr int BM = 256, BK = 64, HALF = 128, HTB = HALF * BK * 2, STAGE_BYTES = 8 * HTB, NXCD = 8, WGM = 8;
__host__ __device__ __forceinline__ int lds_byte(int r, int c) { const int st = (r >> 4) * 2 + (c >> 5), rr = r & 15, cc = c & 31, ob = rr * 64 + cc * 2; return st * 1024 + (ob ^ (((ob >> 9) & 1) << 5)); }
__host__ __device__ __forceinline__ void stage_rc(int b, int& R, int& C) { const int st = b / 1024, sb = b % 1024, swz = sb ^ (((sb >> 9) & 1) << 5); R = (st >> 1) * 16 + swz / 64; C = (st & 1) * 32 + (swz % 64) / 2; }
__host__ __device__ __forceinline__ int perm32(int rho) { const int n = rho >> 4, i = rho & 15; return 8 * (i >> 2) + 4 * n + (i & 3); }
struct Unit { int pm, pn, ka; };
struct Gemm { const bf16_t* A; const bf16_t* Bt; int M, N, K; size_t strideA; int nsplit; };
struct StaticOrder {
    int nM, nN, nwg, G, c, nsplit;
    __device__ __forceinline__ void init(int M_, int N_, int G_, int c_, int nsplit_) { nM = M_ / BM; nN = N_ / BM; nwg = nM * nN; G = G_; c = c_; nsplit = nsplit_; }
    __device__ __forceinline__ bool next(int i, Unit& u) const {
        const long L = (long)i * G + c; if (L >= nwg) return false;
        int wgid = (int)L; { const int q = nwg / NXCD, r = nwg % NXCD, xcd = wgid % NXCD, off = wgid / NXCD; wgid = (xcd < r ? xcd * (q + 1) : r * (q + 1) + (xcd - r) * q) + off; }
        const int nig = WGM * nN, gid = wgid / nig, fm = gid * WGM, gsz = (nM - fm) < WGM ? (nM - fm) : WGM;
        u.pm = fm + ((wgid % nig) % gsz); u.pn = (wgid % nig) / gsz; u.ka = nsplit ? u.pn / nsplit : 0; return true;
    }
};
__device__ __forceinline__ unsigned cvt_pk_bf16(float lo, float hi) { unsigned r; asm volatile("v_cvt_pk_bf16_f32 %0, %1, %2" : "=v"(r) : "v"(lo), "v"(hi)); return r; }

template <class Epi, class Sched>
__device__ __forceinline__ void gemm_phase(LAS unsigned char* lds, const Gemm g, const Sched& S, const Epi& E, int wv) {
    const int tid = otid(wv), wid = __builtin_amdgcn_readfirstlane(tid >> 6), lane = tid & 63, wr = wid >> 2, wc = wid & 3, fr = lane & 15, fq = lane >> 4;
    const int K = g.K, nt = K / BK;
    unsigned voffA[2], voffB[2];
#pragma unroll
    for (int i = 0; i < 2; ++i) { int R, C; stage_rc(tid * 16 + i * 8192, R, C); const int Rb = Epi::PERM ? ((R & ~31) + perm32(R & 31)) : R;
        voffA[i] = (unsigned)(R * K + C) * 2u; voffB[i] = (unsigned)(Rb * K + C) * 2u; }
    const size_t kstep = (size_t)(BK * 2);
    const size_t hstep = (size_t)HALF * K * 2;
    const size_t tstep = 2 * hstep;
    const unsigned ldsw = (unsigned)wid * 1024u;
    const int aoff = lds_byte(wr * 64 + fr, fq * 8), boff = lds_byte(wc * 32 + fr, fq * 8);
#define PG8_SA(b, h) (((b) * 2 + (h)) * HTB)
#define PG8_SB(b, h) ((4 + (b) * 2 + (h)) * HTB)
#define PG8_STAGE(bufoff, gbase, voff) do { _Pragma("unroll") for (int _i = 0; _i < 2; ++_i) \
        __builtin_amdgcn_global_load_lds((const unsigned*)((const char*)(gbase) + (voff)[_i]), (LAS unsigned*)(lds + (bufoff) + ldsw + _i * 8192), 16, 0, 0); } while (0)
#define PG8_LDA(dst, b, h) do { _Pragma("unroll") for (int m = 0; m < 4; ++m) _Pragma("unroll") for (int k = 0; k < 2; ++k) dst[m][k] = *(const LAS bf16x8*)(lds + PG8_SA(b, h) + aoff + m * 2048 + k * 1024); } while (0)
#define PG8_LDB(dst, b, h) do { _Pragma("unroll") for (int n = 0; n < 2; ++n) _Pragma("unroll") for (int k = 0; k < 2; ++k) dst[n][k] = *(const LAS bf16x8*)(lds + PG8_SB(b, h) + boff + n * 2048 + k * 1024); } while (0)
#define PG8_MMA(ai, bj, At, Bt) do { __builtin_amdgcn_s_setprio(1); _Pragma("unroll") for (int m = 0; m < 4; ++m) _Pragma("unroll") for (int n = 0; n < 2; ++n) _Pragma("unroll") for (int k = 0; k < 2; ++k) \
        acc[ai][bj][m][n] = __builtin_amdgcn_mfma_f32_16x16x32_bf16(Bt[n][k], At[m][k], acc[ai][bj][m][n], 0, 0, 0); __builtin_amdgcn_s_setprio(0); } while (0)
#define PG8_WAIT_V(n) asm volatile("s_waitcnt vmcnt(" #n ")" ::: "memory")
#define PG8_WAIT_L(n) asm volatile("s_waitcnt lgkmcnt(" #n ")" ::: "memory")
#define PG8_BAR __builtin_amdgcn_s_barrier()
#define PG8_SCHED __builtin_amdgcn_sched_barrier(0)
    Unit cur, nxt; int ui = 0;
    if (!S.next(0, cur)) return;
    f32x4 acc[2][2][4][2];
#pragma unroll
    for (int a = 0; a < 2; ++a)
#pragma unroll
        for (int b = 0; b < 2; ++b)
#pragma unroll
            for (int m = 0; m < 4; ++m)
#pragma unroll
                for (int n = 0; n < 2; ++n) acc[a][b][m][n] = (f32x4){0.f, 0.f, 0.f, 0.f};
    bf16x8 At[4][2], B0[2][2], B1[2][2];
    const char* cA = (const char*)g.A + (size_t)cur.ka * g.strideA + (size_t)cur.pm * tstep; const char* cB = (const char*)g.Bt + (size_t)cur.pn * tstep;
    PG8_STAGE(PG8_SB(0, 0), cB, voffB); PG8_STAGE(PG8_SA(0, 0), cA, voffA); PG8_STAGE(PG8_SB(0, 1), cB + hstep, voffB); PG8_STAGE(PG8_SA(0, 1), cA + hstep, voffA);
    if (wr == 1) PG8_BAR;
    PG8_WAIT_V(4); PG8_BAR;
    PG8_STAGE(PG8_SB(1, 0), cB + kstep, voffB); PG8_STAGE(PG8_SA(1, 0), cA + kstep, voffA); PG8_STAGE(PG8_SB(1, 1), cB + hstep + kstep, voffB);
    PG8_WAIT_V(6); PG8_BAR;
    for (;;) {
        const bool has_next = S.next(ui + 1, nxt);
        const char* nA = has_next ? (const char*)g.A + (size_t)nxt.ka * g.strideA + (size_t)nxt.pm * tstep : cA; const char* nB = has_next ? (const char*)g.Bt + (size_t)nxt.pn * tstep : cB;
        for (int t = 0; t < nt; t += 2) {
            const bool last = (t == nt - 2);
            const char* a1 = cA + (size_t)(t + 1) * kstep;
            const char* a2 = last ? nA : cA + (size_t)(t + 2) * kstep; const char* b2 = last ? nB : cB + (size_t)(t + 2) * kstep;
            const char* a3 = a2 + kstep; const char* b3 = b2 + kstep;
            PG8_LDB(B0, 0, 0); PG8_SCHED; PG8_LDA(At, 0, 0); PG8_STAGE(PG8_SA(1, 1), a1 + hstep, voffA);
            PG8_WAIT_L(8); PG8_BAR; PG8_WAIT_L(0); PG8_MMA(0, 0, At, B0); PG8_BAR; PG8_SCHED;
            PG8_LDB(B1, 0, 1); PG8_STAGE(PG8_SB(0, 0), b2, voffB);
            PG8_BAR; PG8_WAIT_L(0); PG8_MMA(0, 1, At, B1); PG8_BAR;
            PG8_LDA(At, 0, 1); PG8_STAGE(PG8_SA(0, 0), a2, voffA);
            PG8_BAR; PG8_WAIT_L(0); PG8_MMA(1, 0, At, B0); PG8_BAR; PG8_SCHED;
            PG8_STAGE(PG8_SB(0, 1), b2 + hstep, voffB);
            PG8_WAIT_V(6); PG8_BAR; PG8_MMA(1, 1, At, B1); PG8_BAR;
            PG8_LDB(B0, 1, 0); PG8_SCHED; PG8_LDA(At, 1, 0); PG8_STAGE(PG8_SA(0, 1), a2 + hstep, voffA);
            PG8_WAIT_L(8); PG8_BAR; PG8_WAIT_L(0); PG8_MMA(0, 0, At, B0); PG8_BAR; PG8_SCHED;
            PG8_LDB(B1, 1, 1); PG8_STAGE(PG8_SB(1, 0), b3, voffB);
            PG8_BAR; PG8_WAIT_L(0); PG8_MMA(0, 1, At, B1); PG8_BAR;
            PG8_LDA(At, 1, 1); PG8_STAGE(PG8_SA(1, 0), a3, voffA);
            PG8_BAR; PG8_WAIT_L(0); PG8_MMA(1, 0, At, B0); PG8_BAR; PG8_SCHED;
            PG8_STAGE(PG8_SB(1, 1), b3 + hstep, voffB);
            PG8_WAIT_V(6); PG8_BAR; PG8_MMA(1, 1, At, B1); PG8_BAR;
        }
        E(acc, cur, wr, wc, fr, fq);
        if (!has_next) break;
        if (!E.keep(cur))
#pragma unroll
        for (int a = 0; a < 2; ++a)
#pragma unroll
            for (int b = 0; b < 2; ++b)
#pragma unroll
                for (int m = 0; m < 4; ++m)
#pragma unroll
                    for (int n = 0; n < 2; ++n) acc[a][b][m][n] = (f32x4){0.f, 0.f, 0.f, 0.f};
        cur = nxt; cA = nA; cB = nB; ++ui;
    }
    PG8_WAIT_V(0);
    if (wr == 0) PG8_BAR;
    PG8_BAR;
#undef PG8_SA
#undef PG8_SB
#undef PG8_STAGE
#undef PG8_LDA
#undef PG8_LDB
#undef PG8_MMA
#undef PG8_WAIT_V
#undef PG8_WAIT_L
#undef PG8_BAR
#undef PG8_SCHED
}

struct EpiIn {
    __device__ __forceinline__ bool keep(const Unit&) const { return false; }
    static constexpr bool PERM = true;
    bf16_t* P16; float* PF;
    __device__ __forceinline__ void operator()(f32x4 (&acc)[2][2][4][2], const Unit& u, int wr, int wc, int fr, int fq) const {
        const int row0 = u.pm * BM + wr * 64 + fr, col0 = u.pn * BM + wc * 32 + 8 * fq;
        const bool f32t = (u.pn == 2) || (u.pn == 3), gate = u.pn >= C_GL / 256;
        const int pfc0 = (u.pn - 2) * 256 + wc * 32 + 8 * fq;
#pragma unroll
        for (int ai = 0; ai < 2; ++ai)
#pragma unroll
            for (int m = 0; m < 4; ++m) { const size_t row = (size_t)(row0 + ai * HALF + m * 16);
#pragma unroll
                for (int bj = 0; bj < 2; ++bj) { f32x4 v0 = acc[ai][bj][m][0], v1 = acc[ai][bj][m][1];
                    if (gate) {
#pragma unroll
                        for (int j = 0; j < 4; ++j) { v0[j] = sigm(v0[j]); v1[j] = sigm(v1[j]); } }
                    u32x4 w; w.x = cvt_pk_bf16(v0[0], v0[1]); w.y = cvt_pk_bf16(v0[2], v0[3]); w.z = cvt_pk_bf16(v1[0], v1[1]); w.w = cvt_pk_bf16(v1[2], v1[3]);
                    *(u32x4*)(P16 + row * NPAD + col0 + bj * HALF) = w;
                    if (f32t) { float* pf = PF + row * PFW + pfc0 + bj * HALF; *(f32x4*)pf = v0; *(f32x4*)(pf + 4) = v1; } } }
    }
};
struct EpiGate {
    static constexpr bool PERM = true;
    bf16_t* GS; const bf16_t* P16;
    __device__ __forceinline__ bool keep(const Unit& u) const { return (u.pn >> 2) < 2; }
    __device__ __forceinline__ void operator()(f32x4 (&acc)[2][2][4][2], const Unit& u, int wr, int wc, int fr, int fq) const {
        const int n = u.pn >> 2, row0 = u.pm * BM + wr * 64 + fr, col0 = (u.pn & 3) * BM + wc * 32 + 8 * fq;
#pragma unroll
        for (int ai = 0; ai < 2; ++ai) {
            u32x4 gwv[4][2], hwv[4][2];
#pragma unroll
            for (int m = 0; m < 4; ++m)
#pragma unroll
                for (int bj = 0; bj < 2; ++bj) { const size_t row = (size_t)(row0 + ai * HALF + m * 16);
                    gwv[m][bj] = *(const u32x4*)(P16 + row * NPAD + C_GL + n * 1024 + col0 + bj * HALF);
                    if (n < 2) hwv[m][bj] = *(const u32x4*)(P16 + row * NPAD + C_GL + (n + 1) * 1024 + col0 + bj * HALF); else hwv[m][bj] = gwv[m][bj]; }
#pragma unroll
            for (int m = 0; m < 4; ++m)
#pragma unroll
                for (int bj = 0; bj < 2; ++bj) { const size_t row = (size_t)(row0 + ai * HALF + m * 16); f32x4& v0 = acc[ai][bj][m][0]; f32x4& v1 = acc[ai][bj][m][1];
                    const u32x4 gw = gwv[m][bj], hw = hwv[m][bj];
                    const float g[8] = {lo_bf(gw.x), hi_bf(gw.x), lo_bf(gw.y), hi_bf(gw.y), lo_bf(gw.z), hi_bf(gw.z), lo_bf(gw.w), hi_bf(gw.w)};
                    if (n < 2) { const float h[8] = {lo_bf(hw.x), hi_bf(hw.x), lo_bf(hw.y), hi_bf(hw.y), lo_bf(hw.z), hi_bf(hw.z), lo_bf(hw.w), hi_bf(hw.w)};
#pragma unroll
                        for (int j = 0; j < 4; ++j) { v0[j] *= g[j] * __builtin_amdgcn_rcpf(h[j]); v1[j] *= g[4 + j] * __builtin_amdgcn_rcpf(h[4 + j]); }
                    } else { u32x4 w;
                        w.x = cvt_pk_bf16(v0[0] * g[0], v0[1] * g[1]); w.y = cvt_pk_bf16(v0[2] * g[2], v0[3] * g[3]);
                        w.z = cvt_pk_bf16(v1[0] * g[4], v1[1] * g[5]); w.w = cvt_pk_bf16(v1[2] * g[6], v1[3] * g[7]);
                        *(u32x4*)(GS + row * D + col0 + bj * HALF) = w; } }
        }
    }
};
struct BranchOrder {
    StaticOrder so; int G;
    __device__ __forceinline__ void init(int G_, int c_) { so.init(M, 1024, G_, c_, 0); G = G_; }
    __device__ __forceinline__ bool next(int i, Unit& u) const { Unit t; if (!so.next(i / 3, t)) return false; const int n = i % 3; u.pm = t.pm; u.pn = n * 4 + t.pn; u.ka = n; return true; }
};
struct EpiRes {
    __device__ __forceinline__ bool keep(const Unit&) const { return false; }
    static constexpr bool PERM = false;
    float* X;
    __device__ __forceinline__ void operator()(f32x4 (&acc)[2][2][4][2], const Unit& u, int wr, int wc, int fr, int fq) const {
        const int row0 = u.pm * BM + wr * 64 + fr, col0 = u.pn * BM + wc * 32 + 4 * fq;
#pragma unroll
        for (int ai = 0; ai < 2; ++ai)
#pragma unroll
            for (int m = 0; m < 4; ++m) { float* rowp = X + (size_t)(row0 + ai * HALF + m * 16) * D + col0;
#pragma unroll
                for (int bj = 0; bj < 2; ++bj)
#pragma unroll
                    for (int n = 0; n < 2; ++n) { f32x4* p = (f32x4*)(rowp + bj * HALF + n * 16); *p = *p + acc[ai][bj][m][n]; } }
    }
};
struct EpiB16 {
    __device__ __forceinline__ bool keep(const Unit&) const { return false; }
    static constexpr bool PERM = true;
    bf16_t* O; int ldc;
    __device__ __forceinline__ void operator()(f32x4 (&acc)[2][2][4][2], const Unit& u, int wr, int wc, int fr, int fq) const {
        const int row0 = u.pm * BM + wr * 64 + fr, col0 = u.pn * BM + wc * 32 + 8 * fq;
#pragma unroll
        for (int ai = 0; ai < 2; ++ai)
#pragma unroll
            for (int m = 0; m < 4; ++m) { bf16_t* rowp = O + (size_t)(row0 + ai * HALF + m * 16) * ldc + col0;
#pragma unroll
                for (int bj = 0; bj < 2; ++bj) { const f32x4 v0 = acc[ai][bj][m][0], v1 = acc[ai][bj][m][1];
                    u32x4 w; w.x = cvt_pk_bf16(v0[0], v0[1]); w.y = cvt_pk_bf16(v0[2], v0[3]); w.z = cvt_pk_bf16(v1[0], v1[1]); w.w = cvt_pk_bf16(v1[2], v1[3]);
                    *(u32x4*)(rowp + bj * HALF) = w; } }
    }
};
}

struct Args {
    const float* x; const int* pos; const float* norm1; const float* w_in; const float* lb_logits; const float* hgrn_gain; const float* gmlp_gain; const float* gmlp_ws; const float* gmlp_bs;
    const float* w_branch; const float* w_out; const float* norm2; const float* peer_wq; const float* peer_keys; const float* peer_u; const float* peer_v; const float* final_gain;
    float* out; unsigned char* ws; int ph_lo, ph_hi;
};
constexpr int NTHR = 512, NWAVE = 8;
constexpr int LDS_BYTES = 147456;
constexpr int LDS_CTL_OFF = 143360;

__device__ __forceinline__ void tr_item(const float* src, int ldsrc, int c0, int nvalid, bf16_t* dst, int ldd, int r0, int koff, float* scr, int item, int nblk, int lane) {
    const int kb = item / nblk, nb = item % nblk, k0 = 64 * kb, n0 = 32 * nb;
    const int nn = n0 + (lane & 31);
    float tv[32];
#pragma unroll
    for (int i = 0; i < 32; ++i) { const int kk = 2 * i + (lane >> 5); tv[i] = (nn < nvalid) ? src[(size_t)(k0 + kk) * ldsrc + c0 + nn] : 0.f; }
#pragma unroll
    for (int i = 0; i < 32; ++i) { const int kk = 2 * i + (lane >> 5); scr[kk * 33 + (lane & 31)] = tv[i]; }
    asm volatile("s_waitcnt lgkmcnt(0)" ::: "memory");
    const int c = lane & 7;
#pragma unroll
    for (int j = 0; j < 4; ++j) { const int n = (lane >> 3) + 8 * j; const float* s = scr + (8 * c) * 33 + n;
        u32x4 o; o.x = pk2(s[0 * 33], s[1 * 33]); o.y = pk2(s[2 * 33], s[3 * 33]); o.z = pk2(s[4 * 33], s[5 * 33]); o.w = pk2(s[6 * 33], s[7 * 33]);
        *(u32x4*)(dst + (size_t)(r0 + n0 + n) * ldd + koff + k0 + 8 * c) = o; }
    asm volatile("s_waitcnt lgkmcnt(0)" ::: "memory");
}
__device__ __forceinline__ void rms_row_to_bf16(const float* xrow, const float* gain, bf16_t* orow, int lane) {
    const f32x4* xr = (const f32x4*)xrow + lane; const f32x4* gr = (const f32x4*)gain + lane;
    f32x4 v[4]; float s = 0.f;
#pragma unroll
    for (int j = 0; j < 4; ++j) { v[j] = xr[64 * j]; s += (v[j].x * v[j].x + v[j].y * v[j].y) + (v[j].z * v[j].z + v[j].w * v[j].w); }
    const float r = rsqrtf(wave_sum(s) * (1.f / D) + EPS);
    unsigned long long* o8 = (unsigned long long*)orow + lane;
#pragma unroll
    for (int j = 0; j < 4; ++j) { const f32x4 g = gr[64 * j]; o8[64 * j] = (unsigned long long)pk2(v[j].x * r * g.x, v[j].y * r * g.y) | ((unsigned long long)pk2(v[j].z * r * g.z, v[j].w * r * g.w) << 32); }
}

__device__ __forceinline__ void ph_prologue(const Args& a, unsigned char* lds, int wv) {
    const int tid = otid(wv), lane = tid & 63, wave = tid >> 6;
    const int gw = blockIdx.x * NWAVE + wave, ngw = gridDim.x * NWAVE;
    const size_t gtid = (size_t)blockIdx.x * NTHR + tid, gsz = (size_t)gridDim.x * NTHR;
    unsigned char* ws = oport(a.ws);
    { const f32x4* s = (const f32x4*)a.x; f32x4* d = (f32x4*)a.out; for (size_t i = gtid; i < (size_t)M * D / 4; i += gsz) d[i] = s[i]; }
    float* scr = (float*)(lds + wave * 16384);
    constexpr int I_IN1 = 16 * 160, I_IN2 = 16 * 8, I_IN3 = 16 * 96, I_IN = I_IN1 + I_IN2 + I_IN3;
    constexpr int I_BR = 3 * 8 * 32, I_OUT = 16 * 32, I_PQ = 16 * 64, I_L = I_IN + I_BR + I_OUT + I_PQ;
    for (int it = gw; it < DEPTH * I_L; it += ngw) {
        const int l = it / I_L; int r = it % I_L;
        bf16_t* win = (bf16_t*)(ws + WS_WIN + (size_t)l * WIN_L); const float* src_in = a.w_in + (size_t)l * D * NIN;
        if (r < I_IN1) { tr_item(src_in, NIN, 0, 5120, win, D, 0, 0, scr, r, 160, lane); continue; } r -= I_IN1;
        if (r < I_IN2) { tr_item(src_in, NIN, 5120, 72, win, D, C_KI, 0, scr, r, 8, lane); continue; } r -= I_IN2;
        if (r < I_IN3) { tr_item(src_in, NIN, S_GL, 3072, win, D, C_GL, 0, scr, r, 96, lane); continue; } r -= I_IN3;
        if (r < I_BR) { const int n = r / 256; tr_item(a.w_branch + ((size_t)l * 3 + n) * 512 * D, D, 0, 1024, (bf16_t*)(ws + WS_WBR + (size_t)l * WBR_L), 512, n * 1024, 0, scr, r % 256, 32, lane); continue; } r -= I_BR;
        if (r < I_OUT) { tr_item(a.w_out + (size_t)l * D * D, D, 0, 1024, (bf16_t*)(ws + WS_WOUT + (size_t)l * WOUT_L), D, 0, 0, scr, r, 32, lane); continue; } r -= I_OUT;
        tr_item(a.peer_wq + (size_t)l * D * 2048, 2048, 0, 2048, (bf16_t*)(ws + WS_WPQ + (size_t)l * WPQ_L), D, 0, 0, scr, r, 64, lane);
    }
    if (gtid < 512) { float v[DEPTH], mx = -1e30f; for (int l = 0; l < DEPTH; ++l) { v[l] = a.lb_logits[l * 512 + gtid]; mx = fmaxf(mx, v[l]); }
        float s = 0.f; for (int l = 0; l < DEPTH; ++l) { v[l] = __expf(v[l] - mx); s += v[l]; }
        float c = 0.f; float* lb = (float*)(ws + WS_LB); for (int l = 0; l < DEPTH; ++l) { if (l > 0) c += v[l] / s; lb[l * 512 + gtid] = c; } }
    { u32x4* SKB = (u32x4*)(ws + WS_SKB); const f32x4* sk = (const f32x4*)a.peer_keys; for (size_t i = gtid; i < (size_t)DEPTH * 16 * 128 * 128 / 8; i += gsz) { const f32x4 k0 = sk[2 * i], k1 = sk[2 * i + 1]; SKB[i] = (u32x4){pk2(k0.x, k0.y), pk2(k0.z, k0.w), pk2(k1.x, k1.y), pk2(k1.z, k1.w)}; } }
    { bf16_t* WSB = (bf16_t*)(ws + WS_WSB); for (size_t i = gtid; i < (size_t)DEPTH * 4 * 128 * 128; i += gsz) { const int t = (int)((i >> 7) & 127), sx = (int)(i & 127); WSB[i] = (bf16_t)f2bf(sx <= t ? a.gmlp_ws[i] : 0.f); } }
    { float2* cs = (float2*)(ws + WS_CS);
      for (size_t i = gtid; i < (size_t)M * 96; i += gsz) { const int m = (int)(i / 96), j = (int)(i % 96);
          const float inv = j < 64 ? ROPE_INV64[j] : ROPE_INV32[j - 64]; const float angf = (float)a.pos[m] * inv;
          const double ang = (double)angf; const double k = rint(ang * 0.15915494309189535); const float r = (float)(ang - k * 6.283185307179586);
          cs[i] = make_float2(__cosf(r), __sinf(r)); } }
    for (int m = gw; m < M; m += ngw) rms_row_to_bf16(a.x + (size_t)m * D, a.norm1, (bf16_t*)(ws + WS_H16) + (size_t)m * D, lane);
}

__device__ __forceinline__ void ph_kiwi(const Args& a, int l, unsigned char* lds, int wv) {
    unsigned char* ws = oport(a.ws); const int tid = otid(wv), lane = tid & 63, wave = __builtin_amdgcn_readfirstlane(tid >> 6), g4 = wave & 3, kh = wave >> 2, fr = lane & 15, fq = lane >> 4;
    const bf16_t* H16 = (const bf16_t*)(ws + WS_H16); const bf16_t* W = (const bf16_t*)(ws + WS_WIN + (size_t)l * WIN_L) + (size_t)C_KI * D; float* PF = (float*)(ws + WS_PF);
    f32x4* sK = (f32x4*)lds + (g4 * 5) * 64 + lane;
    for (int base = obid(); base * 4 < M / 16; base += gridDim.x) { const int tg = base * 4 + g4; f32x4 acc[5];
#pragma unroll
        for (int nt = 0; nt < 5; ++nt) acc[nt] = (f32x4){0.f, 0.f, 0.f, 0.f};
#pragma unroll 8
        for (int ks = 16 * kh; ks < 16 * kh + 16; ++ks) { const bf16x8 y = ((const bf16x8*)(H16 + (size_t)tg * 16 * D + 32 * ks))[fr * (D / 8) + fq];
#pragma unroll
            for (int nt = 0; nt < 5; ++nt) { const bf16x8 x = ((const bf16x8*)(W + (size_t)nt * 16 * D + 32 * ks))[fr * (D / 8) + fq]; acc[nt] = __builtin_amdgcn_mfma_f32_16x16x32_bf16(x, y, acc[nt], 0, 0, 0); } }
        __syncthreads();
        if (kh == 1) {
#pragma unroll
            for (int nt = 0; nt < 5; ++nt) sK[nt * 64] = acc[nt]; }
        __syncthreads();
        if (kh == 0) {
#pragma unroll
            for (int nt = 0; nt < 5; ++nt) *(f32x4*)(PF + ((size_t)tg * 16 + fr) * PFW + 512 + 16 * nt + 4 * fq) = acc[nt] + sK[nt * 64]; }
    }
    __syncthreads();
}

__device__ __forceinline__ void ph_post(const Args& a, int l, unsigned char* lds, int wv) {
    const int tid = otid(wv), lane = tid & 63, wave = tid >> 6;
    const int gw = obid() * NWAVE + wave, ngw = gridDim.x * NWAVE;
    const size_t gtid = (size_t)obid() * NTHR + tid, gsz = (size_t)gridDim.x * NTHR;
    unsigned char* ws = oport(a.ws);
    const bf16_t* P16 = (const bf16_t*)(ws + WS_P16); const float* PF = (const float*)(ws + WS_PF); const float2* cs = (const float2*)(ws + WS_CS);
    { bf16_t* QR = (bf16_t*)(ws + WS_QR); bf16_t* KR = (bf16_t*)(ws + WS_KR);
#pragma unroll 4
      for (size_t i = gtid; i < (size_t)M * 256; i += gsz) { const int m = (int)(i >> 8), h = (int)((i >> 6) & 3), j = (int)(i & 63);
          const float2 c = cs[(size_t)m * 96 + j]; const size_t pb = (size_t)m * NPAD + h * 128 + j, ob = (size_t)m * 512 + h * 128 + j;
          const float q1 = bf2f(P16[pb + C_CQ]), q2 = bf2f(P16[pb + C_CQ + 64]), k1 = bf2f(P16[pb + C_CK]), k2 = bf2f(P16[pb + C_CK + 64]);
          const float sc = 0.08838834764831845f * 1.4426950408889634f;
          QR[ob] = (bf16_t)f2bf((q1 * c.x - q2 * c.y) * sc); QR[ob + 64] = (bf16_t)f2bf((q2 * c.x + q1 * c.y) * sc);
          KR[ob] = (bf16_t)f2bf(k1 * c.x - k2 * c.y); KR[ob + 64] = (bf16_t)f2bf(k2 * c.x + k1 * c.y); } }
    { bf16_t* QS = (bf16_t*)(ws + WS_QI); bf16_t* KIb = (bf16_t*)(ws + WS_KI); float* WP = (float*)(ws + WS_WI);
#pragma unroll 2
      for (int m = gw; m < M; m += ngw) { const int h = lane >> 3, jj = lane & 7;
          const unsigned long long w1 = *(const unsigned long long*)(P16 + (size_t)m * NPAD + C_QI + h * 64 + 4 * jj), w2 = *(const unsigned long long*)(P16 + (size_t)m * NPAD + C_QI + h * 64 + 32 + 4 * jj);
          const float q1[4] = {lo_bf((unsigned)w1), hi_bf((unsigned)w1), lo_bf((unsigned)(w1 >> 32)), hi_bf((unsigned)(w1 >> 32))}, q2[4] = {lo_bf((unsigned)w2), hi_bf((unsigned)w2), lo_bf((unsigned)(w2 >> 32)), hi_bf((unsigned)(w2 >> 32))};
          const float2* c = cs + (size_t)m * 96 + 64 + 4 * jj; const float w = PF[(size_t)m * PFW + 576 + h] * 0.02209708691207961f;
          float r1[4], r2[4], l1[4], l2[4];
#pragma unroll
          for (int i = 0; i < 4; ++i) { const float2 cc = c[i]; r1[i] = q1[i] * cc.x - q2[i] * cc.y; r2[i] = q2[i] * cc.x + q1[i] * cc.y; l1[i] = w * r1[i]; l2[i] = w * r2[i]; }
          *(unsigned long long*)(QS + (size_t)m * 576 + h * 64 + 4 * jj) = (unsigned long long)pk2(r1[0], r1[1]) | ((unsigned long long)pk2(r1[2], r1[3]) << 32);
          *(unsigned long long*)(QS + (size_t)m * 576 + h * 64 + 32 + 4 * jj) = (unsigned long long)pk2(r2[0], r2[1]) | ((unsigned long long)pk2(r2[2], r2[3]) << 32);
#pragma unroll
          for (int i = 0; i < 4; ++i) { l1[i] += __shfl_xor(l1[i], 8); l1[i] += __shfl_xor(l1[i], 16); l1[i] += __shfl_xor(l1[i], 32); l2[i] += __shfl_xor(l2[i], 8); l2[i] += __shfl_xor(l2[i], 16); l2[i] += __shfl_xor(l2[i], 32); }
          if (h == 0) { *(unsigned long long*)(QS + (size_t)m * 576 + 512 + 4 * jj) = (unsigned long long)pk2(l1[0], l1[1]) | ((unsigned long long)pk2(l1[2], l1[3]) << 32);
                        *(unsigned long long*)(QS + (size_t)m * 576 + 512 + 32 + 4 * jj) = (unsigned long long)pk2(l2[0], l2[1]) | ((unsigned long long)pk2(l2[2], l2[3]) << 32);
                        const f32x4 k1 = *(const f32x4*)(PF + (size_t)m * PFW + 512 + 4 * jj), k2 = *(const f32x4*)(PF + (size_t)m * PFW + 512 + 32 + 4 * jj);
                        const float kk1[4] = {k1.x, k1.y, k1.z, k1.w}, kk2[4] = {k2.x, k2.y, k2.z, k2.w}; float o1[4], o2[4];
#pragma unroll
                        for (int i = 0; i < 4; ++i) { const float2 cc = c[i]; o1[i] = kk1[i] * cc.x - kk2[i] * cc.y; o2[i] = kk2[i] * cc.x + kk1[i] * cc.y; }
                        *(unsigned long long*)(KIb + (size_t)m * 64 + 4 * jj) = (unsigned long long)pk2(o1[0], o1[1]) | ((unsigned long long)pk2(o1[2], o1[3]) << 32);
                        *(unsigned long long*)(KIb + (size_t)m * 64 + 32 + 4 * jj) = (unsigned long long)pk2(o2[0], o2[1]) | ((unsigned long long)pk2(o2[2], o2[3]) << 32); }
          if (jj == 0) WP[(size_t)m * 8 + h] = w; } }
    { bf16_t* VT = (bf16_t*)(ws + WS_VT); bf16_t* sT = (bf16_t*)lds;
      for (int t0 = obid() * 8; t0 < (M / 64) * 8; t0 += gridDim.x * 8) {
          u32x4 w[8]; const int row = tid >> 3, seg = tid & 7;
#pragma unroll
          for (int q = 0; q < 8; ++q) { const int tile = t0 + q, tb = tile >> 3, cb = tile & 7; w[q] = *(const u32x4*)(P16 + (size_t)(tb * 64 + row) * NPAD + C_CV + cb * 64 + seg * 8); }
          __syncthreads();
#pragma unroll
          for (int q = 0; q < 8; ++q) { unsigned* d = (unsigned*)(sT + q * 64 * 66 + row * 66 + seg * 8); d[0] = w[q].x; d[1] = w[q].y; d[2] = w[q].z; d[3] = w[q].w; }
          __syncthreads();
          const int ch = tid >> 3, tg = tid & 7;
#pragma unroll
          for (int q = 0; q < 8; ++q) { const int tile = t0 + q, tb = tile >> 3, cb = tile & 7; unsigned short v[8];
#pragma unroll
              for (int i = 0; i < 8; ++i) v[i] = sT[q * 64 * 66 + (tg * 8 + i) * 66 + ch];
              const u32x4 o = {(unsigned)v[0] | ((unsigned)v[1] << 16), (unsigned)v[2] | ((unsigned)v[3] << 16), (unsigned)v[4] | ((unsigned)v[5] << 16), (unsigned)v[6] | ((unsigned)v[7] << 16)};
              *(u32x4*)(VT + ((size_t)((tb >> 7) * 512 + cb * 64 + ch)) * SEQ + (tb & 127) * 64 + tg * 8) = o; } }
      __syncthreads(); }
    { bf16_t* VN = (bf16_t*)(ws + WS_VN); const float* gain = a.gmlp_gain + l * 512;
#pragma unroll 4
      for (int m = gw; m < M; m += ngw) { const u32x4 w = *(const u32x4*)(P16 + (size_t)m * NPAD + C_BV + lane * 8);
          float v[8] = {gelu_t(lo_bf(w.x)), gelu_t(hi_bf(w.x)), gelu_t(lo_bf(w.y)), gelu_t(hi_bf(w.y)), gelu_t(lo_bf(w.z)), gelu_t(hi_bf(w.z)), gelu_t(lo_bf(w.w)), gelu_t(hi_bf(w.w))};
          float sm = 0.f;
#pragma unroll
          for (int j = 0; j < 8; ++j) sm += v[j] * v[j];
          const float r = rsqrtf(wave_sum(sm) * (1.f / 512.f) + EPS);
          const f32x4 g0 = *(const f32x4*)(gain + lane * 8), g1 = *(const f32x4*)(gain + lane * 8 + 4);
          *(u32x4*)(VN + (size_t)m * 512 + lane * 8) = (u32x4){pk2(v[0] * r * g0.x, v[1] * r * g0.y), pk2(v[2] * r * g0.z, v[3] * r * g0.w), pk2(v[4] * r * g1.x, v[5] * r * g1.y), pk2(v[6] * r * g1.z, v[7] * r * g1.w)}; } }
}

constexpr int NHU = BATCH * 128 * 4;
__device__ __forceinline__ void ph_h1(const Args& a, int l, unsigned char* lds, int wv) {
    unsigned char* ws = oport(a.ws);
    const int tid = otid(wv), lane = tid & 63, wave = __builtin_amdgcn_readfirstlane(tid >> 6), j = wave >> 1, d = tid & 127, fr = lane & 15, fq = lane >> 4;
    bf16_t* KT = (bf16_t*)lds;
    bf16_t* VT = KT + 128 * 72;
    float* sT = (float*)(VT + 128 * 72);
    const float* PF = (const float*)(ws + WS_PF); const bf16_t* P16 = (const bf16_t*)(ws + WS_P16); const float* LB = (const float*)(ws + WS_LB) + l * 512;
    float* LL = (float*)(ws + WS_FF); float* DD = (float*)(ws + WS_DD);
    for (int u = obid(); u < NHU; u += gridDim.x) {
        const int h = u & 3, c = (u >> 2) & 127, b = u >> 9; const size_t m0 = (size_t)b * SEQ + c * 64 + j * 16;
        const float lbv = LB[h * 128 + d];
        float cs[16], ky[16]; unsigned vv[16]; float run = 0.f;
#pragma unroll
        for (int i = 0; i < 16; ++i) { const float z = PF[(m0 + i) * PFW + h * 128 + d]; const float sg = sigm(z); run += __logf(lbv + (1.f - lbv) * sg); cs[i] = run; ky[i] = (1.f - lbv) * (1.f - sg);
            vv[i] = P16[(m0 + i) * NPAD + C_AI + h * 128 + d]; }
        sT[j * 128 + d] = run;
        __syncthreads();
        float tail = 0.f;
#pragma unroll
        for (int jj = 1; jj < 4; ++jj) if (jj > j) tail += sT[jj * 128 + d];
        { unsigned w[8], x[8];
#pragma unroll
          for (int i = 0; i < 8; ++i) { w[i] = pk2(ky[2 * i] * __expf(tail + (run - cs[2 * i])), ky[2 * i + 1] * __expf(tail + (run - cs[2 * i + 1]))); x[i] = vv[2 * i] | (vv[2 * i + 1] << 16); }
          u32x4* kp = (u32x4*)(KT + d * 72 + j * 16); kp[0] = (u32x4){w[0], w[1], w[2], w[3]}; kp[1] = (u32x4){w[4], w[5], w[6], w[7]};
          u32x4* vp = (u32x4*)(VT + d * 72 + j * 16); vp[0] = (u32x4){x[0], x[1], x[2], x[3]}; vp[1] = (u32x4){x[4], x[5], x[6], x[7]}; }
        if (j == 0) DD[(size_t)u * 128 + d] = __expf(run + tail);
        __syncthreads();
        { bf16x8 xk[2];
#pragma unroll
          for (int ks = 0; ks < 2; ++ks) xk[ks] = *(const bf16x8*)(KT + (16 * wave + fr) * 72 + ks * 32 + fq * 8);
#pragma unroll
          for (int nt = 0; nt < 8; ++nt) { f32x4 acc = {0.f, 0.f, 0.f, 0.f};
#pragma unroll
              for (int ks = 0; ks < 2; ++ks) { const bf16x8 y = *(const bf16x8*)(VT + (16 * nt + fr) * 72 + ks * 32 + fq * 8); acc = __builtin_amdgcn_mfma_f32_16x16x32_bf16(xk[ks], y, acc, 0, 0, 0); }
              *(f32x4*)(LL + ((size_t)u * 128 + 16 * nt + fr) * 128 + 16 * wave + 4 * fq) = acc; } }
        __syncthreads();
    }
}
__device__ __forceinline__ void ph_h2(const Args& a, int wv) {
    unsigned char* ws = oport(a.ws);
    const float* LL = (const float*)(ws + WS_FF); const float* DD = (const float*)(ws + WS_DD); bf16_t* SB = (bf16_t*)(ws + WS_QF);
    for (int e = obid() * NTHR + otid(wv); e < 8 * 16384; e += gridDim.x * NTHR) { const int bh = e >> 14, b = bh >> 2, h = bh & 3, dvdk = e & 16383, dk = e & 127; float S = 0.f;
#pragma unroll 16
        for (int c = 0; c < 128; ++c) { const size_t u = (size_t)(((b * 128 + c) << 2) + h); SB[u * 16384 + dvdk] = (bf16_t)f2bf(S); S = DD[u * 128 + dk] * S + LL[u * 16384 + dvdk]; } }
}
__device__ __forceinline__ void ph_h3(const Args& a, int l, unsigned char* lds, int wv) {
    unsigned char* ws = oport(a.ws);
    const int tid = otid(wv), lane = tid & 63, wave = __builtin_amdgcn_readfirstlane(tid >> 6), j = wave >> 1, d = tid & 127, fr = lane & 15, fq = lane >> 4;
    bf16_t* QT = (bf16_t*)lds;
    bf16_t* QH = QT + 64 * 136;
    bf16_t* KI = QH + 64 * 136;
    bf16_t* VT = KI + 160 * 136;
    bf16_t* AT = VT + 128 * 72;
    float* sT = (float*)(AT + 64 * 72);
    float* sSS = sT + 512;
    const float* PF = (const float*)(ws + WS_PF); const bf16_t* P16 = (const bf16_t*)(ws + WS_P16); const float* LB = (const float*)(ws + WS_LB) + l * 512;
    const bf16_t* SB = (const bf16_t*)(ws + WS_QF); bf16_t* YA = (bf16_t*)(ws + WS_YALL); const float* gain = a.hgrn_gain + l * 128;
    for (int u = obid(); u < NHU; u += gridDim.x) {
        const int h = u & 3, c = (u >> 2) & 127, b = u >> 9; const size_t mc = (size_t)b * SEQ + c * 64, m0 = mc + j * 16;
        for (int i = tid; i < 64 * 72 * 2 / 16; i += NTHR) ((u32x4*)AT)[i] = (u32x4){0u, 0u, 0u, 0u};
        bf16x8 sbf[4][4];
#pragma unroll
        for (int q4 = 0; q4 < 4; ++q4)
#pragma unroll
            for (int ks = 0; ks < 4; ++ks) sbf[q4][ks] = ((const bf16x8*)(SB + ((size_t)u * 128 + 16 * (4 * (wave >> 2) + q4)) * 128 + 32 * ks))[fr * 16 + fq];
        const float lbv = LB[h * 128 + d];
        float cs[16], ky[16], qf[16]; unsigned vv[16]; float run = 0.f;
#pragma unroll
        for (int i = 0; i < 16; ++i) { const size_t pr = (m0 + i) * NPAD + h * 128 + d; const float z = PF[(m0 + i) * PFW + h * 128 + d]; const float sg = sigm(z); run += __logf(lbv + (1.f - lbv) * sg); cs[i] = run; ky[i] = (1.f - lbv) * (1.f - sg);
            qf[i] = silu(bf2f(P16[pr + C_AQ])) * 0.08838834764831845f; vv[i] = P16[pr + C_AI]; }
        sT[j * 128 + d] = run;
        __syncthreads();
        const float T0 = sT[d], T1 = sT[128 + d], T2 = sT[256 + d];
        const float Bj = (j > 0 ? T0 : 0.f) + (j > 1 ? T1 : 0.f) + (j > 2 ? T2 : 0.f); const float eBj = __expf(Bj);
        float pre[4]; pre[0] = 0.f; pre[1] = (j < 1 ? T0 : 0.f); pre[2] = (j < 1 ? T0 : 0.f) + (j < 2 ? T1 : 0.f); pre[3] = (j < 1 ? T0 : 0.f) + (j < 2 ? T1 : 0.f) + (j < 3 ? T2 : 0.f);
        float epre[4];
#pragma unroll
        for (int I = 0; I < 4; ++I) epre[I] = __expf(pre[I]);
#pragma unroll
        for (int i = 0; i < 16; ++i) { const int t = 16 * j + i; const float ec = __expf(cs[i]), kn = ky[i] * __expf(fminf(-cs[i], 60.f));
            QT[t * 136 + d] = (bf16_t)f2bf(qf[i] * ec); QH[t * 136 + d] = (bf16_t)f2bf(qf[i] * ec * eBj);
#pragma unroll
            for (int I = 0; I < 4; ++I) if (I >= j) KI[(8 * I * (I + 1) + t) * 136 + d] = (bf16_t)f2bf(kn * epre[I]); }
        { unsigned x[8];
#pragma unroll
          for (int i = 0; i < 8; ++i) x[i] = vv[2 * i] | (vv[2 * i + 1] << 16);
          u32x4* vp = (u32x4*)(VT + d * 72 + j * 16); vp[0] = (u32x4){x[0], x[1], x[2], x[3]}; vp[1] = (u32x4){x[4], x[5], x[6], x[7]}; }
        __syncthreads();
        for (int tl = wave; tl < 10; tl += 8) { const int I = tl < 1 ? 0 : tl < 3 ? 1 : tl < 6 ? 2 : 3, J = tl - (I * (I + 1)) / 2; f32x4 acc = {0.f, 0.f, 0.f, 0.f};
#pragma unroll
            for (int ks = 0; ks < 4; ++ks) { const bf16x8 x = *(const bf16x8*)(QT + (16 * I + fr) * 136 + ks * 32 + fq * 8); const bf16x8 y = *(const bf16x8*)(KI + (8 * I * (I + 1) + 16 * J + fr) * 136 + ks * 32 + fq * 8);
                acc = __builtin_amdgcn_mfma_f32_16x16x32_bf16(x, y, acc, 0, 0, 0); }
#pragma unroll
            for (int r = 0; r < 4; ++r) { float v = acc[r]; if (J == I && fr > 4 * fq + r) v = 0.f; AT[(16 * I + 4 * fq + r) * 72 + 16 * J + fr] = (bf16_t)f2bf(v); } }
        __syncthreads();
        const int I = wave & 3, nt0 = 4 * (wave >> 2); f32x4 o[4];
#pragma unroll
        for (int q4 = 0; q4 < 4; ++q4) { const int nt = nt0 + q4; f32x4 acc = {0.f, 0.f, 0.f, 0.f};
            for (int ks = 0; ks <= (I >> 1); ++ks) { const bf16x8 x = *(const bf16x8*)(AT + (16 * I + fr) * 72 + ks * 32 + fq * 8); const bf16x8 y = *(const bf16x8*)(VT + (16 * nt + fr) * 72 + ks * 32 + fq * 8);
                acc = __builtin_amdgcn_mfma_f32_16x16x32_bf16(x, y, acc, 0, 0, 0); }
#pragma unroll
            for (int ks = 0; ks < 4; ++ks) { const bf16x8 x = *(const bf16x8*)(QH + (16 * I + fr) * 136 + ks * 32 + fq * 8); acc = __builtin_amdgcn_mfma_f32_16x16x32_bf16(x, sbf[q4][ks], acc, 0, 0, 0); }
            o[q4] = acc; }
        { float ssq[4];
#pragma unroll
          for (int r = 0; r < 4; ++r) { float s = o[0][r] * o[0][r] + o[1][r] * o[1][r] + o[2][r] * o[2][r] + o[3][r] * o[3][r]; s += __shfl_xor(s, 1); s += __shfl_xor(s, 2); s += __shfl_xor(s, 4); s += __shfl_xor(s, 8); ssq[r] = s; }
          if (fr == 0) {
#pragma unroll
              for (int r = 0; r < 4; ++r) sSS[(16 * I + 4 * fq + r) * 2 + (wave >> 2)] = ssq[r]; } }
        __syncthreads();
#pragma unroll
        for (int r = 0; r < 4; ++r) { const int tt = 16 * I + 4 * fq + r; const float rinv = rsqrtf((sSS[tt * 2] + sSS[tt * 2 + 1]) * (1.f / 128.f) + EPS); const size_t m = mc + tt;
#pragma unroll
            for (int q4 = 0; q4 < 4; ++q4) { const int dv = 16 * (nt0 + q4) + fr; const float g = bf2f(P16[m * NPAD + C_AG + h * 128 + dv]);
                YA[m * 512 + h * 128 + dv] = (bf16_t)f2bf(o[q4][r] * rinv * gain[dv] * silu(g)); } }
        __syncthreads();
    }
}
__device__ __forceinline__ void ph_gmlp(const Args& a, int l, unsigned char* lds, int wv) {
    unsigned char* ws = oport(a.ws);
    const int tid = otid(wv), lane = tid & 63, wave = __builtin_amdgcn_readfirstlane(tid >> 6), fr = lane & 15, fq = lane >> 4;
    const bf16_t* P16 = (const bf16_t*)(ws + WS_P16); const bf16_t* VN = (const bf16_t*)(ws + WS_VN); bf16_t* YB = (bf16_t*)(ws + WS_YALL) + (size_t)M * 512;
    const bf16_t* WSB = (const bf16_t*)(ws + WS_WSB) + (size_t)l * 4 * 128 * 128; const float* bs = a.gmlp_bs + (size_t)l * 4 * 128;
    bf16_t* VNt = (bf16_t*)lds;
    for (int u = obid(); u < (M / 128) * 4; u += gridDim.x) { const int g = u & 3, nb = u >> 2; const size_t mb = (size_t)nb * 128;
        __syncthreads();
#pragma unroll
        for (int n = 0; n < 4; ++n) { const int idx = tid + NTHR * n, row = idx >> 4, seg = idx & 15; const u32x4 w = *(const u32x4*)(VN + (mb + row) * 512 + g * 128 + seg * 8);
            bf16_t* d = VNt + (seg * 8) * 136 + row;
            d[0 * 136] = (bf16_t)(w.x & 0xffffu); d[1 * 136] = (bf16_t)(w.x >> 16); d[2 * 136] = (bf16_t)(w.y & 0xffffu); d[3 * 136] = (bf16_t)(w.y >> 16);
            d[4 * 136] = (bf16_t)(w.z & 0xffffu); d[5 * 136] = (bf16_t)(w.z >> 16); d[6 * 136] = (bf16_t)(w.w & 0xffffu); d[7 * 136] = (bf16_t)(w.w >> 16); }
        bf16x8 wf[4];
#pragma unroll
        for (int ks = 0; ks < 4; ++ks) wf[ks] = *(const bf16x8*)(WSB + ((size_t)g * 128 + 16 * wave + fr) * 128 + 32 * ks + 8 * fq);
        __syncthreads();
        const int t = 16 * wave + fr; const float bias = bs[g * 128 + t]; const int nks = (wave >> 1) + 1;
        unsigned long long uwv[8];
#pragma unroll
        for (int ct = 0; ct < 8; ++ct) uwv[ct] = *(const unsigned long long*)(P16 + (mb + t) * NPAD + C_BU + g * 128 + 16 * ct + 4 * fq);
#pragma unroll
        for (int ct = 0; ct < 8; ++ct) { f32x4 acc = {0.f, 0.f, 0.f, 0.f};
#pragma unroll
            for (int ks = 0; ks < 4; ++ks) if (ks < nks) { const bf16x8 x = *(const bf16x8*)(VNt + (16 * ct + fr) * 136 + 32 * ks + 8 * fq); acc = __builtin_amdgcn_mfma_f32_16x16x32_bf16(x, wf[ks], acc, 0, 0, 0); }
            const size_t m = mb + t; const int c = g * 128 + 16 * ct + 4 * fq; const unsigned long long uw = uwv[ct];
            const float o0 = gelu_t(lo_bf((unsigned)uw)) * (acc[0] + bias), o1 = gelu_t(hi_bf((unsigned)uw)) * (acc[1] + bias), o2 = gelu_t(lo_bf((unsigned)(uw >> 32))) * (acc[2] + bias), o3 = gelu_t(hi_bf((unsigned)(uw >> 32))) * (acc[3] + bias);
            *(unsigned long long*)(YB + m * 512 + c) = (unsigned long long)pk2(o0, o1) | ((unsigned long long)pk2(o2, o3) << 32); }
    }
}
constexpr int SEL_CAP = 256;
__device__ __forceinline__ int sel_bin(float s, float lo, float sc) { return (int)__builtin_amdgcn_fmed3f((s - lo) * sc, 0.f, 1023.f); }
struct SelQ { float lo1, sc1, lo2, sc2, tau; int b1, b2, ref, tidx; };
__device__ __forceinline__ void sel_pass(const int mode, const bf16x8 (&qf)[9][2], const float (&wp)[8], const SelQ& sq, const bf16_t* kib, int c, int kp, int qloc, int fr, int fq,
                                         unsigned* sHist, unsigned* sCand, unsigned* sCnt, unsigned* maskrow) {
    bf16x8 af[4][2];
    { const int T0 = kp <= c ? kp : c;
#pragma unroll
      for (int rg = 0; rg < 4; ++rg)
#pragma unroll
          for (int ks = 0; ks < 2; ++ks) af[rg][ks] = ((const bf16x8*)(kib + (size_t)(64 * T0 + 16 * rg) * 64 + 32 * ks))[fr * 8 + fq]; }
#pragma unroll 1
    for (int T = kp; T <= c; T += 4) {
        const int Tn = (T + 4 <= c) ? T + 4 : T;
        unsigned mlo = 0u, mhi = 0u;
#pragma unroll
        for (int rg = 0; rg < 4; ++rg) {
            f32x4 sc = __builtin_amdgcn_mfma_f32_16x16x32_bf16(af[rg][0], qf[8][0], (f32x4){0.f, 0.f, 0.f, 0.f}, 0, 0, 0);
            sc = __builtin_amdgcn_mfma_f32_16x16x32_bf16(af[rg][1], qf[8][1], sc, 0, 0, 0);
#pragma unroll
            for (int h = 0; h < 8; ++h) { f32x4 ah = __builtin_amdgcn_mfma_f32_16x16x32_bf16(af[rg][0], qf[h][0], (f32x4){0.f, 0.f, 0.f, 0.f}, 0, 0, 0);
                ah = __builtin_amdgcn_mfma_f32_16x16x32_bf16(af[rg][1], qf[h][1], ah, 0, 0, 0);
#pragma unroll
                for (int r = 0; r < 4; ++r) sc[r] += wp[h] * __builtin_fabsf(ah[r]); }
#pragma unroll
            for (int ks = 0; ks < 2; ++ks) af[rg][ks] = ((const bf16x8*)(kib + (size_t)(64 * Tn + 16 * rg) * 64 + 32 * ks))[fr * 8 + fq];
            if (mode == 0) {
#pragma unroll
                for (int r = 0; r < 4; ++r) { const int b = sel_bin(sc[r], sq.lo1, sq.sc1); __hip_atomic_fetch_add(sHist + qloc * 512 + (b >> 1), 1u << ((b & 1) * 16), __ATOMIC_RELAXED, __HIP_MEMORY_SCOPE_WORKGROUP); }
            } else if (mode == 1) {
                if (sq.ref) {
#pragma unroll
                    for (int r = 0; r < 4; ++r) if (sel_bin(sc[r], sq.lo1, sq.sc1) == sq.b1) { const int b = sel_bin(sc[r], sq.lo2, sq.sc2); __hip_atomic_fetch_add(sHist + qloc * 512 + (b >> 1), 1u << ((b & 1) * 16), __ATOMIC_RELAXED, __HIP_MEMORY_SCOPE_WORKGROUP); } }
            } else {
                int b[4]; unsigned bits = 0u; bool anyc = false;
#pragma unroll
                for (int r = 0; r < 4; ++r) { b[r] = sel_bin(sc[r], sq.lo1, sq.sc1); bits |= (b[r] > sq.b1) ? (1u << r) : 0u; anyc |= (b[r] == sq.b1); }
                if (anyc) {
#pragma unroll
                    for (int r = 0; r < 4; ++r) if (b[r] == sq.b1) { bool cand = true;
                        if (sq.ref) { const int b2 = sel_bin(sc[r], sq.lo2, sq.sc2); if (b2 > sq.b2) bits |= 1u << r; cand = b2 == sq.b2; }
                        if (cand) { const unsigned slot = __hip_atomic_fetch_add(sCnt + qloc, 1u, __ATOMIC_RELAXED, __HIP_MEMORY_SCOPE_WORKGROUP);
                            if (slot < (unsigned)SEL_CAP) { sCand[(qloc * SEL_CAP + slot) * 2] = __float_as_uint(sc[r]); sCand[(qloc * SEL_CAP + slot) * 2 + 1] = (unsigned)(64 * T + 16 * rg + 4 * fq + r); } } } }
                bits <<= (16 * (rg & 1)) + 4 * fq; if (rg < 2) mlo |= bits; else mhi |= bits;
            }
            __builtin_amdgcn_sched_barrier(0);
        }
        if (mode == 2) { mlo |= __shfl_xor(mlo, 16); mlo |= __shfl_xor(mlo, 32); mhi |= __shfl_xor(mhi, 16); mhi |= __shfl_xor(mhi, 32);
            if (fq == 0) *(uint2*)(maskrow + 2 * T) = make_uint2(mlo, mhi); }
    }
}
__device__ __forceinline__ void sel_scan(const unsigned* hist, unsigned need, int lane, int& bsel, unsigned& nneed, unsigned& cnt) {
    unsigned c16[16]; unsigned tot = 0u;
#pragma unroll
    for (int i = 0; i < 8; ++i) { const unsigned w = hist[512 - 8 * (lane + 1) + i]; c16[2 * i] = w & 0xffffu; c16[2 * i + 1] = w >> 16; tot += (w & 0xffffu) + (w >> 16); }
    unsigned inc = tot;
#pragma unroll
    for (int o = 1; o < 64; o <<= 1) { const unsigned t2 = __shfl_up(inc, o); if (lane >= o) inc += t2; }
    const unsigned long long bal = __ballot(inc >= need);
    const int L = bal ? (__ffsll((long long)bal) - 1) : 63;
    unsigned above = __shfl(inc - tot, L); int bs = 0; unsigned nn = 1u, cc = 0u; bool found = false;
#pragma unroll
    for (int j = 0; j < 16; ++j) { const unsigned hcnt = __shfl(c16[15 - j], L); if (!found) { if (above + hcnt >= need) { found = true; bs = 1024 - 16 * L - 1 - j; nn = need - above; cc = hcnt; } else above += hcnt; } }
    bsel = bs; nneed = nn; cnt = cc;
}
__device__ __forceinline__ void ph_sel(const Args& a, unsigned char* lds, int wv) {
    unsigned char* ws = oport(a.ws);
    const int tid = otid(wv), lane = tid & 63, wave = __builtin_amdgcn_readfirstlane(tid >> 6), gq = wave & 1, kp = wave >> 1, fr = lane & 15, fq = lane >> 4, qloc = 16 * gq + fr;
    unsigned* sHist = (unsigned*)lds;
    unsigned* sCand = (unsigned*)(lds + 65536);
    float* sLo1 = (float*)(lds + 131072); float* sSc1 = sLo1 + 32; float* sLo2 = sSc1 + 32; float* sSc2 = sLo2 + 32; float* sTau = sSc2 + 32;
    int* sB1 = (int*)(sTau + 32); int* sB2 = sB1 + 32; int* sRef = sB2 + 32; int* sTidx = sRef + 32; unsigned* sNeed = (unsigned*)(sTidx + 32); unsigned* sCnt = sNeed + 32; int* sAny = (int*)(sCnt + 32);
    const bf16_t* QS = (const bf16_t*)(ws + WS_QI); const bf16_t* KIb = (const bf16_t*)(ws + WS_KI); const float* WP = (const float*)(ws + WS_WI); unsigned* MASKB = (unsigned*)(ws + WS_MASK);
    for (int pi = obid(); pi < 256; pi += gridDim.x) {
#pragma unroll 1
      for (int which = 0; which < 2; ++which) {
        const int b = pi & 1, half = (pi >> 1) & 1, cc = pi >> 2, c = which ? cc : 127 - cc;
        const size_t mq = (size_t)b * SEQ + 64 * c + 32 * half;
        const bf16_t* kib = KIb + (size_t)b * SEQ * 64;
        __syncthreads();
        if (tid < 32) { const float* w = WP + (mq + tid) * 8; float s1 = 0.f, s2 = 0.f;
#pragma unroll
            for (int h = 0; h < 8; ++h) { s1 += w[h]; s2 += w[h] * w[h]; }
            const float sd = 9.34f * sqrtf(fmaxf(s2, 1e-30f)); sLo1[tid] = 6.38f * s1 - 8.f * sd; sSc1[tid] = 1024.f / (16.f * sd);
            sLo2[tid] = 0.f; sSc2[tid] = 1.f; sB1[tid] = 0; sB2[tid] = 0; sRef[tid] = 0; sNeed[tid] = 256u; sCnt[tid] = 0u; sTau[tid] = -INFINITY; sTidx[tid] = 0x7fffffff; }
        if (tid == 0) sAny[0] = 0;
        for (int i = tid; i < 32 * 512 / 4; i += NTHR) ((u32x4*)sHist)[i] = (u32x4){0u, 0u, 0u, 0u};
        bf16x8 qf[9][2]; float wp[8];
        { const bf16_t* qrow = QS + (mq + qloc) * 576;
#pragma unroll
          for (int h = 0; h < 9; ++h)
#pragma unroll
              for (int ks = 0; ks < 2; ++ks) qf[h][ks] = *(const bf16x8*)(qrow + h * 64 + 32 * ks + 8 * fq);
#pragma unroll
          for (int h = 0; h < 8; ++h) wp[h] = WP[(mq + qloc) * 8 + h]; }
        __syncthreads();
        unsigned* maskrow = MASKB + (mq + qloc) * 256;
        if (c < 4) {
            if (tid < 32) for (int T = 0; T <= c; ++T) *(uint2*)(MASKB + (mq + tid) * 256 + 2 * T) = make_uint2(0xFFFFFFFFu, 0xFFFFFFFFu);
        } else {
#pragma unroll 1
            for (int pass = 0; pass < 3; ++pass) {
                if (pass == 1) { if (!sAny[0]) continue; __syncthreads(); for (int i = tid; i < 32 * 512 / 4; i += NTHR) ((u32x4*)sHist)[i] = (u32x4){0u, 0u, 0u, 0u}; __syncthreads(); }
                SelQ sq; sq.lo1 = sLo1[qloc]; sq.sc1 = sSc1[qloc]; sq.lo2 = sLo2[qloc]; sq.sc2 = sSc2[qloc]; sq.b1 = sB1[qloc]; sq.b2 = sB2[qloc]; sq.ref = sRef[qloc]; sq.tau = 0.f; sq.tidx = 0;
                sel_pass(pass, qf, wp, sq, kib, c, kp, qloc, fr, fq, sHist, sCand, sCnt, maskrow);
                asm volatile("s_waitcnt vmcnt(0)" ::: "memory");
                __syncthreads();
                if (pass < 2) {
                    for (int qq = wave * 4; qq < wave * 4 + 4; ++qq) if (pass == 0 || sRef[qq]) { int bs; unsigned nn, cn; sel_scan(sHist + qq * 512, sNeed[qq], lane, bs, nn, cn);
                        if (lane == 0) { sNeed[qq] = nn; if (pass == 0) { sB1[qq] = bs; if (cn > (unsigned)SEL_CAP) { sRef[qq] = 1; sLo2[qq] = sLo1[qq] + (float)bs / sSc1[qq]; sSc2[qq] = sSc1[qq] * 1024.f; sAny[0] = 1; } } else sB2[qq] = bs; } }
                    __syncthreads(); }
            }
            unsigned* sOff = (unsigned*)sAny + 4;
            if (tid < 64) { unsigned n = 0u; if (tid < 32) n = sCnt[tid] < (unsigned)SEL_CAP ? sCnt[tid] : (unsigned)SEL_CAP; unsigned inc = n;
#pragma unroll
                for (int o = 1; o < 32; o <<= 1) { const unsigned t2 = __shfl_up(inc, o); if (lane >= o) inc += t2; }
                if (tid < 32) { sOff[tid] = inc - n; if (tid == 31) sOff[32] = inc; } }
            __syncthreads();
            { const unsigned total = sOff[32];
              for (unsigned p = tid; p < total; p += NTHR) { int qq = 0;
#pragma unroll
                  for (int st = 16; st >= 1; st >>= 1) if (sOff[qq + st] <= p) qq += st;
                  const unsigned i = p - sOff[qq], n = sOff[qq + 1] - sOff[qq], want = sNeed[qq] - 1u;
                  const float si = __uint_as_float(sCand[(qq * SEL_CAP + i) * 2]); const unsigned ki = sCand[(qq * SEL_CAP + i) * 2 + 1]; unsigned rank = 0u;
                  for (unsigned j = 0; j < n; ++j) { const float sj = __uint_as_float(sCand[(qq * SEL_CAP + j) * 2]); const unsigned kj = sCand[(qq * SEL_CAP + j) * 2 + 1]; rank += (sj > si || (sj == si && kj < ki)) ? 1u : 0u; }
                  if (rank <= want) atomicOr(MASKB + (mq + qq) * 256 + (ki >> 5), 1u << (ki & 31u)); } }
        }
      }
    }
}

__device__ __forceinline__ void ph_attn(const Args& a, unsigned char* lds, int wv) {
    unsigned char* ws = oport(a.ws);
    const int tid = otid(wv), lane = tid & 63, wave = __builtin_amdgcn_readfirstlane(tid >> 6), g4 = wave & 3, par = wave >> 2, fr = lane & 15, fq = lane >> 4;
    const bf16_t* QR = (const bf16_t*)(ws + WS_QR); const bf16_t* KR = (const bf16_t*)(ws + WS_KR); const bf16_t* VT = (const bf16_t*)(ws + WS_VT); const unsigned* MASKB = (const unsigned*)(ws + WS_MASK);
    bf16_t* Kt = (bf16_t*)lds;
    bf16_t* Vt = Kt + 2 * 64 * 136;
    float* sMrg = (float*)lds;
    for (int pi = obid(); pi < 256; pi += gridDim.x) {
#pragma unroll 1
      for (int which = 0; which < 2; ++which) {
        const int bh = pi & 7, b = bh >> 2, h = bh & 3, cc = pi >> 3, qb = which ? cc : 63 - cc;
        const size_t m0 = (size_t)b * SEQ + 128 * qb + 32 * g4;
        const int mych = 2 * qb + (g4 >> 1);
        bf16x8 qf[2][4];
#pragma unroll
        for (int cg = 0; cg < 2; ++cg)
#pragma unroll
            for (int ks = 0; ks < 4; ++ks) qf[cg][ks] = *(const bf16x8*)(QR + (m0 + 16 * cg + fr) * 512 + h * 128 + 32 * ks + 8 * fq);
        f32x4 O[2][8], Lacc[2]; float mrun[2];
        const bf16x8 xones = (fr == 0) ? (bf16x8){0x3f80, 0x3f80, 0x3f80, 0x3f80, 0x3f80, 0x3f80, 0x3f80, 0x3f80} : (bf16x8){0, 0, 0, 0, 0, 0, 0, 0};
#pragma unroll
        for (int cg = 0; cg < 2; ++cg) { mrun[cg] = 0.f; Lacc[cg] = (f32x4){0.f, 0.f, 0.f, 0.f};
#pragma unroll
            for (int vt = 0; vt < 8; ++vt) O[cg][vt] = (f32x4){0.f, 0.f, 0.f, 0.f}; }
        const bf16_t* kbase = KR + (size_t)b * SEQ * 512 + h * 128; const bf16_t* vbase = VT + (size_t)(b * 512 + h * 128) * SEQ;
        unsigned doff[9];
#pragma unroll
        for (int k = 0; k < 9; ++k) { const int i_ = (wave + NWAVE * k < 70) ? wave + NWAVE * k : 69, slot = 64 * i_ + lane;
            if (slot < 2176) { const int tl = slot >= 1088 ? 1 : 0, rs = slot - 1088 * tl, row = rs / 17, seg = rs - 17 * row; doff[k] = 2u * (unsigned)((64 * tl + row) * 512 + ((seg < 16) ? (seg ^ ((row & 16) >> 2)) : 0) * 8); }
            else { const int s2 = slot - 2176, tl = s2 >= 1152 ? 1 : 0, rs = s2 - 1152 * tl, row = rs / 9, seg = rs - 9 * row; doff[k] = 2u * (unsigned)(row * SEQ + 64 * tl + (seg & 7) * 8); } }
#define ATT_DMA(jj, buf) do { const bf16_t* kb_ = kbase + (size_t)(jj) * 128 * 512; const bf16_t* vb_ = vbase + (size_t)(jj) * 128; \
            _Pragma("unroll") for (int k = 0; k < 9; ++k) { const int i_ = (wave + NWAVE * k < 70) ? wave + NWAVE * k : 69; unsigned d_ = doff[k]; asm volatile("" : "+v"(d_)); const unsigned char* src = (const unsigned char*)(k < 4 ? kb_ : k > 4 ? vb_ : wave < 2 ? kb_ : vb_) + d_; \
                __builtin_amdgcn_global_load_lds((const unsigned*)src, (LAS unsigned*)(LAS unsigned char*)(lds + (buf) * 71680 + i_ * 1024), 16, 0, 0); } } while (0)
        __syncthreads();
        ATT_DMA(0, 0);
        asm volatile("s_waitcnt vmcnt(0)" ::: "memory");
        __syncthreads();
        for (int j = 0; j <= qb; ++j) {
            const int T = 2 * j + par;
            unsigned long long mw64[2];
#pragma unroll
            for (int cg = 0; cg < 2; ++cg) asm volatile("global_load_dwordx2 %0, %1, off" : "=v"(mw64[cg]) : "v"(MASKB + (m0 + 16 * cg + fr) * 256 + 2 * T) : "memory");
            const bf16_t* Ktb = Kt + (j & 1) * 35840; const bf16_t* Vtb = Vt + (j & 1) * 35840;
            const bool act = T <= mych;
            f32x4 S[2][4]; bf16x8 vf[2][4];
            if (act) {
                const bf16_t* kt = Ktb + par * 64 * 136; const bf16_t* vtl = Vtb + par * 128 * 72;
                bf16x8 kf[2][4];
#define ATT_LDK(bf_, rg_) do { const int krow = 32 * ((rg_) >> 1) + 8 * (fr >> 2) + 4 * ((rg_) & 1) + (fr & 3); \
                    _Pragma("unroll") for (int ks = 0; ks < 4; ++ks) kf[bf_][ks] = *(const bf16x8*)(kt + krow * 136 + ((4 * ks + fq) ^ ((krow & 16) >> 2)) * 8); } while (0)
                ATT_LDK(0, 0);
#pragma unroll
                for (int rg = 0; rg < 4; ++rg) { S[0][rg] = (f32x4){-mrun[0], -mrun[0], -mrun[0], -mrun[0]}; S[1][rg] = (f32x4){-mrun[1], -mrun[1], -mrun[1], -mrun[1]};
                    if (rg < 3) ATT_LDK((rg + 1) & 1, rg + 1);
                    __builtin_amdgcn_sched_barrier(0);
#pragma unroll
                    for (int ks = 0; ks < 4; ++ks) { S[0][rg] = __builtin_amdgcn_mfma_f32_16x16x32_bf16(kf[rg & 1][ks], qf[0][ks], S[0][rg], 0, 0, 0); S[1][rg] = __builtin_amdgcn_mfma_f32_16x16x32_bf16(kf[rg & 1][ks], qf[1][ks], S[1][rg], 0, 0, 0); }
                    __builtin_amdgcn_sched_barrier(0); }
#undef ATT_LDK
#define ATT_LDV(bf_, g_) do { _Pragma("unroll") for (int i_ = 0; i_ < 2; ++i_) _Pragma("unroll") for (int k2 = 0; k2 < 2; ++k2) vf[bf_][2 * i_ + k2] = *(const bf16x8*)(vtl + (16 * (2 * (g_) + i_) + fr) * 72 + 32 * k2 + 8 * fq); } while (0)
                ATT_LDV(0, 0);
                __builtin_amdgcn_sched_barrier(0);
                asm volatile("s_waitcnt vmcnt(0)" : "+v"(mw64[0]), "+v"(mw64[1]) :: "memory");
            }
            ATT_DMA(j + 1, (j + 1) & 1);
            __builtin_amdgcn_sched_barrier(0);
            if (act) {
                const bf16_t* vtl = Vtb + par * 128 * 72;
                const uint2 mw[2] = {make_uint2((unsigned)mw64[0], (unsigned)(mw64[0] >> 32)), make_uint2((unsigned)mw64[1], (unsigned)(mw64[1] >> 32))};
                bf16x8 pf[2][2];
#pragma unroll
                for (int cg = 0; cg < 2; ++cg) {
                    float mx = fmaxf(fmaxf(fmaxf(S[cg][0][0], S[cg][0][1]), fmaxf(S[cg][0][2], S[cg][0][3])), fmaxf(fmaxf(S[cg][1][0], S[cg][1][1]), fmaxf(S[cg][1][2], S[cg][1][3])));
                    mx = fmaxf(mx, fmaxf(fmaxf(fmaxf(S[cg][2][0], S[cg][2][1]), fmaxf(S[cg][2][2], S[cg][2][3])), fmaxf(fmaxf(S[cg][3][0], S[cg][3][1]), fmaxf(S[cg][3][2], S[cg][3][3]))));
                    mx = fmaxf(mx, __shfl_xor(mx, 16)); mx = fmaxf(mx, __shfl_xor(mx, 32));
                    const float dlt = fmaxf(mx, 0.f);
                    const int m16 = (int)(((mw[cg].x >> (8 * fq)) & 0xFFu) | (((mw[cg].y >> (8 * fq)) & 0xFFu) << 8));
                    if (__builtin_amdgcn_ballot_w64(dlt != 0.f) != 0ull) {
                        mrun[cg] += dlt; const float alpha = __builtin_amdgcn_exp2f(-dlt);
#pragma unroll
                        for (int rg = 0; rg < 4; ++rg)
#pragma unroll
                            for (int r = 0; r < 4; ++r) S[cg][rg][r] -= dlt;
#pragma unroll
                        for (int vt = 0; vt < 8; ++vt) O[cg][vt] = O[cg][vt] * alpha;
                        Lacc[cg] = Lacc[cg] * alpha; }
#pragma unroll
                    for (int rg = 0; rg < 4; ++rg)
#pragma unroll
                        for (int r = 0; r < 4; ++r) S[cg][rg][r] = __int_as_float(__float_as_int(__builtin_amdgcn_exp2f(S[cg][rg][r])) & __builtin_amdgcn_sbfe(m16, 4 * rg + r, 1));
#pragma unroll
                    for (int k2 = 0; k2 < 2; ++k2) { const u32x4 w = {pg8::cvt_pk_bf16(S[cg][2 * k2][0], S[cg][2 * k2][1]), pg8::cvt_pk_bf16(S[cg][2 * k2][2], S[cg][2 * k2][3]), pg8::cvt_pk_bf16(S[cg][2 * k2 + 1][0], S[cg][2 * k2 + 1][1]), pg8::cvt_pk_bf16(S[cg][2 * k2 + 1][2], S[cg][2 * k2 + 1][3])};
                        pf[cg][k2] = __builtin_bit_cast(bf16x8, w); }
                    Lacc[cg] = __builtin_amdgcn_mfma_f32_16x16x32_bf16(xones, pf[cg][0], Lacc[cg], 0, 0, 0); Lacc[cg] = __builtin_amdgcn_mfma_f32_16x16x32_bf16(xones, pf[cg][1], Lacc[cg], 0, 0, 0);
                }
#pragma unroll
                for (int g = 0; g < 4; ++g) {
                    if (g < 3) ATT_LDV((g + 1) & 1, g + 1);
                    __builtin_amdgcn_sched_barrier(0);
#pragma unroll
                    for (int i_ = 0; i_ < 2; ++i_)
#pragma unroll
                        for (int k2 = 0; k2 < 2; ++k2) { const int vt = 2 * g + i_;
                            O[0][vt] = __builtin_amdgcn_mfma_f32_16x16x32_bf16(vf[g & 1][2 * i_ + k2], pf[0][k2], O[0][vt], 0, 0, 0); O[1][vt] = __builtin_amdgcn_mfma_f32_16x16x32_bf16(vf[g & 1][2 * i_ + k2], pf[1][k2], O[1][vt], 0, 0, 0); }
                    __builtin_amdgcn_sched_barrier(0); }
#undef ATT_LDV
            }
            asm volatile("s_waitcnt vmcnt(0)" ::: "memory");
            __syncthreads();
        }
#undef ATT_DMA
        const float lrun[2] = {Lacc[0][0], Lacc[1][0]};
        float* mb = sMrg + (size_t)g4 * 68 * 64 + lane;
        if (par == 1) {
#pragma unroll
            for (int cg = 0; cg < 2; ++cg) { mb[(cg * 2 + 0) * 64] = mrun[cg]; mb[(cg * 2 + 1) * 64] = lrun[cg];
#pragma unroll
                for (int vt = 0; vt < 8; ++vt)
#pragma unroll
                    for (int r = 0; r < 4; ++r) mb[(4 + (cg * 8 + vt) * 4 + r) * 64] = O[cg][vt][r]; } }
        __syncthreads();
        if (par == 0) {
            bf16_t* YC = (bf16_t*)(oport(ws) + WS_YALL) + (size_t)2 * M * 512;
#pragma unroll
            for (int cg = 0; cg < 2; ++cg) { const float m1 = mb[(cg * 2 + 0) * 64], l1 = mb[(cg * 2 + 1) * 64]; const float mm = fmaxf(mrun[cg], m1), a0 = __builtin_amdgcn_exp2f(mrun[cg] - mm), a1 = __builtin_amdgcn_exp2f(m1 - mm);
                float lt = lrun[cg] * a0 + l1 * a1; lt += __shfl_xor(lt, 16); lt += __shfl_xor(lt, 32); const float inv = 1.f / lt;
#pragma unroll
                for (int vt = 0; vt < 8; ++vt) { float o[4];
#pragma unroll
                    for (int r = 0; r < 4; ++r) o[r] = (O[cg][vt][r] * a0 + mb[(4 + (cg * 8 + vt) * 4 + r) * 64] * a1) * inv;
                    *(unsigned long long*)(YC + (m0 + 16 * cg + fr) * 512 + h * 128 + 16 * vt + 4 * fq) = (unsigned long long)pk2(o[0], o[1]) | ((unsigned long long)pk2(o[2], o[3]) << 32); } } }
      }
    }
}
__device__ __forceinline__ void ph_norm2(const Args& a, int l, int wv) {
    const int tid = otid(wv), lane = tid & 63, gw = obid() * NWAVE + (tid >> 6), ngw = gridDim.x * NWAVE;
    unsigned char* ws = oport(a.ws);
#pragma unroll 2
    for (int m = gw; m < M; m += ngw) rms_row_to_bf16(a.out + (size_t)m * D, a.norm2 + l * D, (bf16_t*)(ws + WS_H16) + (size_t)m * D, lane);
    { const f32x4* U = (const f32x4*)(a.peer_u + (size_t)l * NEXP * D); const f32x4* V = (const f32x4*)(a.peer_v + (size_t)l * NEXP * D); uint2* U4 = (uint2*)(ws + WS_U16); uint2* V4 = (uint2*)(ws + WS_V16);
      float* RSU = (float*)(ws + WS_RS); float* RSV = RSU + NEXP;
#pragma unroll 2
      for (size_t i = (size_t)obid() * NTHR + tid; i < (size_t)NEXP * D / 16; i += (size_t)gridDim.x * NTHR) { f32x4 u[4], v[4]; float su = 0.f, sv = 0.f;
#pragma unroll
          for (int q = 0; q < 4; ++q) { u[q] = U[4 * i + q]; v[q] = V[4 * i + q]; su += (u[q].x * u[q].x + u[q].y * u[q].y) + (u[q].z * u[q].z + u[q].w * u[q].w); sv += (v[q].x * v[q].x + v[q].y * v[q].y) + (v[q].z * v[q].z + v[q].w * v[q].w); }
          const float ru = fmaxf(sqrtf(wave_sum(su) * (1.f / D)), 1e-30f), rv = fmaxf(sqrtf(wave_sum(sv) * (1.f / D)), 1e-30f), ku = 2.f / ru, kv = 2.f / rv;
          unsigned wu[2] = {0u, 0u}, wq[2] = {0u, 0u};
#pragma unroll
          for (int q = 0; q < 4; ++q) {
              if (q & 1) { wu[q >> 1] = __builtin_amdgcn_cvt_scalef32_pk_fp4_f32(wu[q >> 1], u[q].x * ku, u[q].y * ku, 1.f, 2); wu[q >> 1] = __builtin_amdgcn_cvt_scalef32_pk_fp4_f32(wu[q >> 1], u[q].z * ku, u[q].w * ku, 1.f, 3);
                           wq[q >> 1] = __builtin_amdgcn_cvt_scalef32_pk_fp4_f32(wq[q >> 1], v[q].x * kv, v[q].y * kv, 1.f, 2); wq[q >> 1] = __builtin_amdgcn_cvt_scalef32_pk_fp4_f32(wq[q >> 1], v[q].z * kv, v[q].w * kv, 1.f, 3); }
              else       { wu[q >> 1] = __builtin_amdgcn_cvt_scalef32_pk_fp4_f32(wu[q >> 1], u[q].x * ku, u[q].y * ku, 1.f, 0); wu[q >> 1] = __builtin_amdgcn_cvt_scalef32_pk_fp4_f32(wu[q >> 1], u[q].z * ku, u[q].w * ku, 1.f, 1);
                           wq[q >> 1] = __builtin_amdgcn_cvt_scalef32_pk_fp4_f32(wq[q >> 1], v[q].x * kv, v[q].y * kv, 1.f, 0); wq[q >> 1] = __builtin_amdgcn_cvt_scalef32_pk_fp4_f32(wq[q >> 1], v[q].z * kv, v[q].w * kv, 1.f, 1); } }
          U4[i] = make_uint2(wu[0], wu[1]); V4[i] = make_uint2(wq[0], wq[1]);
          if (lane == 0) { RSU[i >> 6] = 0.5f * ru; RSV[i >> 6] = 0.5f * rv; } } }
}
#define CE_(a_, b_) do { const float hi_ = fmaxf(a_, b_), lo_ = fminf(a_, b_); a_ = hi_; b_ = lo_; } while (0)
#define SORT16D(x) do { CE_(x[0], x[1]); CE_(x[3], x[2]); CE_(x[4], x[5]); CE_(x[7], x[6]); CE_(x[8], x[9]); CE_(x[11], x[10]); CE_(x[12], x[13]); CE_(x[15], x[14]); CE_(x[0], x[2]); CE_(x[1], x[3]); CE_(x[6], x[4]); CE_(x[7], x[5]); CE_(x[8], x[10]); CE_(x[9], x[11]); CE_(x[14], x[12]); CE_(x[15], x[13]); CE_(x[0], x[1]); CE_(x[2], x[3]); CE_(x[5], x[4]); CE_(x[7], x[6]); CE_(x[8], x[9]); CE_(x[10], x[11]); CE_(x[13], x[12]); CE_(x[15], x[14]); CE_(x[0], x[4]); CE_(x[1], x[5]); CE_(x[2], x[6]); CE_(x[3], x[7]); CE_(x[12], x[8]); CE_(x[13], x[9]); CE_(x[14], x[10]); CE_(x[15], x[11]); CE_(x[0], x[2]); CE_(x[1], x[3]); CE_(x[4], x[6]); CE_(x[5], x[7]); CE_(x[10], x[8]); CE_(x[11], x[9]); CE_(x[14], x[12]); CE_(x[15], x[13]); CE_(x[0], x[1]); CE_(x[2], x[3]); CE_(x[4], x[5]); CE_(x[6], x[7]); CE_(x[9], x[8]); CE_(x[11], x[10]); CE_(x[13], x[12]); CE_(x[15], x[14]); CE_(x[0], x[8]); CE_(x[1], x[9]); CE_(x[2], x[10]); CE_(x[3], x[11]); CE_(x[4], x[12]); CE_(x[5], x[13]); CE_(x[6], x[14]); CE_(x[7], x[15]); CE_(x[0], x[4]); CE_(x[1], x[5]); CE_(x[2], x[6]); CE_(x[3], x[7]); CE_(x[8], x[12]); CE_(x[9], x[13]); CE_(x[10], x[14]); CE_(x[11], x[15]); CE_(x[0], x[2]); CE_(x[1], x[3]); CE_(x[4], x[6]); CE_(x[5], x[7]); CE_(x[8], x[10]); CE_(x[9], x[11]); CE_(x[12], x[14]); CE_(x[13], x[15]); CE_(x[0], x[1]); CE_(x[2], x[3]); CE_(x[4], x[5]); CE_(x[6], x[7]); CE_(x[8], x[9]); CE_(x[10], x[11]); CE_(x[12], x[13]); CE_(x[14], x[15]); } while (0)
#define MERGE16D(x) do { CE_(x[0], x[8]); CE_(x[1], x[9]); CE_(x[2], x[10]); CE_(x[3], x[11]); CE_(x[4], x[12]); CE_(x[5], x[13]); CE_(x[6], x[14]); CE_(x[7], x[15]); CE_(x[0], x[4]); CE_(x[1], x[5]); CE_(x[2], x[6]); CE_(x[3], x[7]); CE_(x[8], x[12]); CE_(x[9], x[13]); CE_(x[10], x[14]); CE_(x[11], x[15]); CE_(x[0], x[2]); CE_(x[1], x[3]); CE_(x[4], x[6]); CE_(x[5], x[7]); CE_(x[8], x[10]); CE_(x[9], x[11]); CE_(x[12], x[14]); CE_(x[13], x[15]); CE_(x[0], x[1]); CE_(x[2], x[3]); CE_(x[4], x[5]); CE_(x[6], x[7]); CE_(x[8], x[9]); CE_(x[10], x[11]); CE_(x[12], x[13]); CE_(x[14], x[15]); } while (0)
__device__ __forceinline__ float pkf(float v, unsigned tag) { return __uint_as_float((__float_as_uint(v) & 0xFFFFFF00u) | tag); }
__device__ __forceinline__ void ph_peer_select(const Args& a, int l, unsigned char* lds, int wv, int nunits, int pm0, int pn0, int pm1, int pn1) {
    unsigned char* ws = oport(a.ws); const int tid = otid(wv), lane = tid & 63, wave = __builtin_amdgcn_readfirstlane(tid >> 6), fr = lane & 15, fq = lane >> 4;
    bf16_t* sK = (bf16_t*)lds;
    int* sI = (int*)(lds + 69632 + wave * 2048);
    const bf16_t* QRY = (const bf16_t*)(ws + WS_GB); const bf16_t* SKB = (const bf16_t*)(ws + WS_SKB) + (size_t)l * 16 * 128 * 128; int* EID = (int*)(ws + WS_EID); float* EG = (float*)(ws + WS_EG);
  for (int uu = 0; uu < nunits; ++uu) { const int h = uu == 0 ? pn0 : pn1, pmu = uu == 0 ? pm0 : pm1;
    __syncthreads();
    { const u32x4* src = (const u32x4*)(SKB + (size_t)h * 2 * 128 * 128);
#pragma unroll
      for (int n = 0; n < 8; ++n) { const int idx = tid + NTHR * n, row = idx >> 4, seg = idx & 15; *(u32x4*)(sK + row * 136 + seg * 8) = src[idx]; } }
    __syncthreads();
    for (int it = wave; it < 16; it += NWAVE) { const int tg = pmu * 16 + it; const size_t m = (size_t)tg * 16 + fr;
        float va[16], vb[16];
#pragma unroll
        for (int p = 0; p < 2; ++p) {
            bf16x8 qf[4];
#pragma unroll
            for (int ks = 0; ks < 4; ++ks) qf[ks] = *(const bf16x8*)(QRY + m * 2048 + h * 256 + p * 128 + 32 * ks + 8 * fq);
            const bf16_t* kb = sK + (size_t)p * 128 * 136; float s0[16], s1[16];
#pragma unroll
            for (int nt = 0; nt < 8; ++nt) { f32x4 acc = {0.f, 0.f, 0.f, 0.f};
#pragma unroll
                for (int ks = 0; ks < 4; ++ks) { const bf16x8 x = *(const bf16x8*)(kb + (16 * nt + fr) * 136 + 32 * ks + 8 * fq); acc = __builtin_amdgcn_mfma_f32_16x16x32_bf16(x, qf[ks], acc, 0, 0, 0); }
#pragma unroll
                for (int r = 0; r < 4; ++r) { const float tv = __uint_as_float((__float_as_uint(acc[r]) & 0xFFFFFF80u) | (unsigned)(127 - (16 * nt + 4 * fq + r))); if (nt < 4) s0[nt * 4 + r] = tv; else s1[(nt - 4) * 4 + r] = tv; } }
            SORT16D(s0); SORT16D(s1);
            float t[16];
#pragma unroll
            for (int i = 0; i < 16; ++i) t[i] = fmaxf(s0[i], s1[15 - i]);
            MERGE16D(t);
#pragma unroll
            for (int off = 16; off <= 32; off <<= 1) { float o[16];
#pragma unroll
                for (int i = 0; i < 16; ++i) o[i] = __shfl_xor(t[15 - i], off);
#pragma unroll
                for (int i = 0; i < 16; ++i) t[i] = fmaxf(t[i], o[i]);
                MERGE16D(t); }
#pragma unroll
            for (int i = 0; i < 16; ++i) { if (p == 0) va[i] = t[i]; else vb[i] = t[i]; }
            __builtin_amdgcn_sched_barrier(0);
        }
        if (fq == 0) {
#pragma unroll
            for (int r = 0; r < 16; ++r) { sI[fr * 32 + r] = 127 - (int)(__float_as_uint(va[r]) & 127u); sI[fr * 32 + 16 + r] = 127 - (int)(__float_as_uint(vb[r]) & 127u); } }
#pragma unroll
        for (int r = 0; r < 16; ++r) { va[r] = __uint_as_float(__float_as_uint(va[r]) & 0xFFFFFF80u); vb[r] = __uint_as_float(__float_as_uint(vb[r]) & 0xFFFFFF80u); }
        float cs[16];
        {
            cs[0] = fq == 0 ? pkf(va[0] + vb[0], 255u) : fq == 1 ? pkf(va[0] + vb[1], 254u) : fq == 2 ? pkf(va[0] + vb[2], 253u) : pkf(va[0] + vb[3], 252u);
            cs[1] = fq == 0 ? pkf(va[0] + vb[4], 251u) : fq == 1 ? pkf(va[0] + vb[5], 250u) : fq == 2 ? pkf(va[0] + vb[6], 249u) : pkf(va[0] + vb[7], 248u);
            cs[2] = fq == 0 ? pkf(va[0] + vb[8], 247u) : fq == 1 ? pkf(va[0] + vb[9], 246u) : fq == 2 ? pkf(va[0] + vb[10], 245u) : pkf(va[0] + vb[11], 244u);
            cs[3] = fq == 0 ? pkf(va[0] + vb[12], 243u) : fq == 1 ? pkf(va[0] + vb[13], 242u) : fq == 2 ? pkf(va[0] + vb[14], 241u) : pkf(va[0] + vb[15], 240u);
            cs[4] = fq == 0 ? pkf(va[1] + vb[0], 239u) : fq == 1 ? pkf(va[1] + vb[1], 238u) : fq == 2 ? pkf(va[1] + vb[2], 237u) : pkf(va[1] + vb[3], 236u);
            cs[5] = fq == 0 ? pkf(va[1] + vb[4], 235u) : fq == 1 ? pkf(va[1] + vb[5], 234u) : fq == 2 ? pkf(va[1] + vb[6], 233u) : pkf(va[1] + vb[7], 232u);
            cs[6] = fq == 0 ? pkf(va[2] + vb[0], 223u) : fq == 1 ? pkf(va[2] + vb[1], 222u) : fq == 2 ? pkf(va[2] + vb[2], 221u) : pkf(va[2] + vb[3], 220u);
            cs[7] = fq == 0 ? pkf(va[2] + vb[4], 219u) : fq == 1 ? pkf(va[3] + vb[0], 207u) : fq == 2 ? pkf(va[3] + vb[1], 206u) : pkf(va[3] + vb[2], 205u);
            cs[8] = fq == 0 ? pkf(va[3] + vb[3], 204u) : fq == 1 ? pkf(va[4] + vb[0], 191u) : fq == 2 ? pkf(va[4] + vb[1], 190u) : pkf(va[4] + vb[2], 189u);
            cs[9] = fq == 0 ? pkf(va[5] + vb[0], 175u) : fq == 1 ? pkf(va[5] + vb[1], 174u) : fq == 2 ? pkf(va[6] + vb[0], 159u) : pkf(va[6] + vb[1], 158u);
            cs[10] = fq == 0 ? pkf(va[7] + vb[0], 143u) : fq == 1 ? pkf(va[7] + vb[1], 142u) : fq == 2 ? pkf(va[8] + vb[0], 127u) : pkf(va[9] + vb[0], 111u);
            cs[11] = fq == 0 ? pkf(va[10] + vb[0], 95u) : fq == 1 ? pkf(va[11] + vb[0], 79u) : fq == 2 ? pkf(va[12] + vb[0], 63u) : pkf(va[13] + vb[0], 47u);
            cs[12] = fq == 0 ? pkf(va[14] + vb[0], 31u) : fq == 1 ? pkf(va[15] + vb[0], 15u) : fq == 2 ? -INFINITY : -INFINITY;
            cs[13] = -INFINITY; cs[14] = -INFINITY; cs[15] = -INFINITY;
        }
        __builtin_amdgcn_sched_barrier(0);
        SORT16D(cs);
#pragma unroll
        for (int off = 16; off <= 32; off <<= 1) { float o[16];
#pragma unroll
            for (int i = 0; i < 16; ++i) o[i] = __shfl_xor(cs[15 - i], off);
#pragma unroll
            for (int i = 0; i < 16; ++i) cs[i] = fmaxf(cs[i], o[i]);
            MERGE16D(cs); }
        float bv[16];
#pragma unroll
        for (int i = 0; i < 16; ++i) bv[i] = cs[i];
        asm volatile("s_waitcnt lgkmcnt(0)" ::: "memory"); __builtin_amdgcn_sched_barrier(0);
        if (fq == 0) { int eid[16]; float ex[16]; float sm = 0.f; const float b0 = __uint_as_float(__float_as_uint(bv[0]) & 0xFFFFFF00u);
#pragma unroll
            for (int r = 0; r < 16; ++r) { const unsigned bits = __float_as_uint(bv[r]); const int f = 255 - (int)(bits & 255u); eid[r] = sI[fr * 32 + (f >> 4)] * 128 + sI[fr * 32 + 16 + (f & 15)];
                ex[r] = __expf(__uint_as_float(bits & 0xFFFFFF00u) - b0); sm += ex[r]; }
            const float inv = 1.f / sm; int* ep = EID + m * 128 + h * 16; float* gp = EG + m * 128 + h * 16;
#pragma unroll
            for (int r = 0; r < 16; r += 4) { *(int4*)(ep + r) = make_int4(eid[r], eid[r + 1], eid[r + 2], eid[r + 3]); *(f32x4*)(gp + r) = (f32x4){ex[r] * inv, ex[r + 1] * inv, ex[r + 2] * inv, ex[r + 3] * inv}; } }
        asm volatile("s_waitcnt lgkmcnt(0)" ::: "memory");
    }
  }
}
typedef float f32x2_t __attribute__((ext_vector_type(2)));
__device__ __forceinline__ void dec8(const uint2 w, f32x2_t (&f)[8]) {
    f[0] = __builtin_amdgcn_cvt_scalef32_pk_f32_fp4(w.x, 1.f, 0); f[1] = __builtin_amdgcn_cvt_scalef32_pk_f32_fp4(w.x, 1.f, 1); f[2] = __builtin_amdgcn_cvt_scalef32_pk_f32_fp4(w.x, 1.f, 2); f[3] = __builtin_amdgcn_cvt_scalef32_pk_f32_fp4(w.x, 1.f, 3);
    f[4] = __builtin_amdgcn_cvt_scalef32_pk_f32_fp4(w.y, 1.f, 0); f[5] = __builtin_amdgcn_cvt_scalef32_pk_f32_fp4(w.y, 1.f, 1); f[6] = __builtin_amdgcn_cvt_scalef32_pk_f32_fp4(w.y, 1.f, 2); f[7] = __builtin_amdgcn_cvt_scalef32_pk_f32_fp4(w.y, 1.f, 3);
}
__device__ __forceinline__ void ph_peer_experts(const Args& a, int l, unsigned char* lds, int wv) {
    unsigned char* ws = oport(a.ws); const int tid = otid(wv), lane = tid & 63, wave = __builtin_amdgcn_readfirstlane(tid >> 6), gw = obid() * NWAVE + wave, ngw = gridDim.x * NWAVE;
    const bf16_t* H16 = (const bf16_t*)(ws + WS_H16); const int* EID = (const int*)(ws + WS_EID); const float* EG = (const float*)(ws + WS_EG);
    const unsigned char* U8 = (const unsigned char*)(ws + WS_U16); const unsigned char* V8 = (const unsigned char*)(ws + WS_V16);
    const float* RSU = (const float*)(ws + WS_RS); const float* RSV = RSU + NEXP;
    float* sPA = (float*)(lds + wave * 8192) + lane; float* sPB = sPA + 1024;
    int* sEA = (int*)(lds + 65536 + wave * 2048); float* sGA = (float*)(sEA + 128); int* sEB = sEA + 256; float* sGB = (float*)(sEB + 128);
    for (int it = 0, nit = ((M + ngw - 1) / ngw + 1) / 2; it < nit; ++it) { const int mA = gw + (2 * it) * ngw, mB = mA + ngw; const bool vA = mA < M, vB = mB < M;
        __syncthreads();
        if (!vA) continue;
        const int mBs = vB ? mB : mA;
        f32x2_t hpA[8], hpB[8], accA[8], accB[8];
#define LOADH(hp, m_) do { float hv_[16]; const u32x4 h0_ = *(const u32x4*)(H16 + (size_t)(m_) * D + lane * 16), h1_ = *(const u32x4*)(H16 + (size_t)(m_) * D + lane * 16 + 8); \
          hv_[0] = lo_bf(h0_.x); hv_[1] = hi_bf(h0_.x); hv_[2] = lo_bf(h0_.y); hv_[3] = hi_bf(h0_.y); hv_[4] = lo_bf(h0_.z); hv_[5] = hi_bf(h0_.z); hv_[6] = lo_bf(h0_.w); hv_[7] = hi_bf(h0_.w); \
          hv_[8] = lo_bf(h1_.x); hv_[9] = hi_bf(h1_.x); hv_[10] = lo_bf(h1_.y); hv_[11] = hi_bf(h1_.y); hv_[12] = lo_bf(h1_.z); hv_[13] = hi_bf(h1_.z); hv_[14] = lo_bf(h1_.w); hv_[15] = hi_bf(h1_.w); \
          _Pragma("unroll") for (int j_ = 0; j_ < 8; ++j_) hp[j_] = (f32x2_t){hv_[2 * j_], hv_[2 * j_ + 1]}; } while (0)
        LOADH(hpA, mA); LOADH(hpB, mBs);
#pragma unroll
        for (int j = 0; j < 8; ++j) { accA[j] = (f32x2_t){0.f, 0.f}; accB[j] = (f32x2_t){0.f, 0.f}; }
#define SORTTOK(m_, sE_, sG_) do { int key[2] = {EID[(size_t)(m_) * 128 + 2 * lane], EID[(size_t)(m_) * 128 + 2 * lane + 1]}; float pay[2] = {EG[(size_t)(m_) * 128 + 2 * lane], EG[(size_t)(m_) * 128 + 2 * lane + 1]}; \
          _Pragma("unroll") for (int k = 2; k <= 128; k <<= 1) _Pragma("unroll") for (int j = k >> 1; j >= 1; j >>= 1) { \
              if (j == 1) { const bool asc = ((2 * lane) & k) == 0; if ((key[0] > key[1]) == asc) { const int tk = key[0]; key[0] = key[1]; key[1] = tk; const float tp = pay[0]; pay[0] = pay[1]; pay[1] = tp; } } \
              else { const int lj = j >> 1; const bool keep_min = (((2 * lane) & k) == 0) == ((lane & lj) == 0); \
                  _Pragma("unroll") for (int r = 0; r < 2; ++r) { const int pk = __shfl_xor(key[r], lj); const float pp = __shfl_xor(pay[r], lj); const bool take = keep_min ? (pk < key[r]) : (pk > key[r]); if (take) { key[r] = pk; pay[r] = pp; } } } } \
          *(int2*)(sE_ + 2 * lane) = make_int2(key[0], key[1]); *(float2*)(sG_ + 2 * lane) = make_float2(pay[0], pay[1]); } while (0)
        SORTTOK(mA, sEA, sGA); SORTTOK(mBs, sEB, sGB);
        asm volatile("s_waitcnt lgkmcnt(0)" ::: "memory");
#pragma unroll 1
        for (int half = 0; half < 2; ++half) {
            const int pos = half * 64 + 4 * (lane & 15) + (((lane >> 4) == 1) ? 2 : ((lane >> 4) == 2) ? 1 : (lane >> 4));
            const int evA = sEA[pos], evB = sEB[pos]; const float gvA = sGA[pos], gvB = sGB[pos];
            const float suA = RSU[evA], sdA = RSV[evA], suB = RSU[evB], sdB = RSV[evB];
            uint2 bufA[4], bufB[4];
#define ROWLD(dst, T, e_) dst = ((const uint2*)(T + (size_t)(e_) * (D / 2)))[lane]
#define KIDX(g, c) ((g) + ((c) == 1 ? 32 : (c) == 2 ? 16 : (c) == 3 ? 48 : 0))
#define LOADG(buf, T, ev_, g) do { _Pragma("unroll") for (int i_ = 0; i_ < 4; ++i_) ROWLD(buf[i_], T, __builtin_amdgcn_readlane(ev_, KIDX(g, i_))); } while (0)
#define BF2(a_, b_, o) (((lane & (o)) ? (b_) : (a_)) + __shfl_xor((lane & (o)) ? (a_) : (b_), (o)))
#define DOTG(buf, hp, sP_, g) do { float d4_[4]; _Pragma("unroll") for (int i_ = 0; i_ < 4; ++i_) { f32x2_t f_[8]; dec8(buf[i_], f_); f32x2_t d2_ = f_[0] * hp[0]; \
              _Pragma("unroll") for (int j_ = 1; j_ < 8; ++j_) d2_ = __builtin_elementwise_fma(f_[j_], hp[j_], d2_); d4_[i_] = d2_.x + d2_.y; } \
              const float q0_ = BF2(d4_[0], d4_[1], 32), q1_ = BF2(d4_[2], d4_[3], 32); sP_[(g) * 64] = BF2(q0_, q1_, 16); } while (0)
            LOADG(bufA, U8, evA, 0);
#pragma unroll 1
            for (int g = 0; g < 16; ++g) { const int gn = g < 15 ? g + 1 : 15;
                LOADG(bufB, U8, evB, g); DOTG(bufA, hpA, sPA, g);
                LOADG(bufA, U8, evA, gn); DOTG(bufB, hpB, sPB, g); }
            int svbA, svbB;
#define BFLY(o, n) do { const bool up_ = (lane & (o)) != 0; _Pragma("unroll") for (int i_ = 0; i_ < (n); ++i_) { const float a_ = p[i_], b_ = p[i_ + (n)]; const float sd_ = up_ ? a_ : b_, kp_ = up_ ? b_ : a_; p[i_] = kp_ + __shfl_xor(sd_, (o)); } } while (0)
#define FINISH(sP_, gv_, svb_, su_, sd_) do { float p[16]; _Pragma("unroll") for (int i_ = 0; i_ < 16; ++i_) p[i_] = sP_[i_ * 64]; BFLY(8, 8); BFLY(4, 4); BFLY(2, 2); BFLY(1, 1); \
              svb_ = __builtin_bit_cast(int, gv_ * gelu_t(p[0] * su_) * sd_); } while (0)
            FINISH(sPA, gvA, svbA, suA, sdA); FINISH(sPB, gvB, svbB, suB, sdB);
#define ACCG(buf, acc, svb_, g) do { _Pragma("unroll") for (int i_ = 0; i_ < 4; ++i_) { const float sk_ = __builtin_bit_cast(float, __builtin_amdgcn_readlane(svb_, KIDX(g, i_))); const f32x2_t s2_ = {sk_, sk_}; f32x2_t f_[8]; dec8(buf[i_], f_); \
              _Pragma("unroll") for (int j_ = 0; j_ < 8; ++j_) acc[j_] = __builtin_elementwise_fma(f_[j_], s2_, acc[j_]); } } while (0)
            LOADG(bufA, V8, evA, 0);
#pragma unroll 1
            for (int g = 0; g < 16; ++g) { const int gn = g < 15 ? g + 1 : 15;
                LOADG(bufB, V8, evB, g); ACCG(bufA, accA, svbA, g);
                LOADG(bufA, V8, evA, gn); ACCG(bufB, accB, svbB, g); }
#undef ROWLD
#undef KIDX
#undef LOADG
#undef BF2
#undef DOTG
#undef BFLY
#undef FINISH
#undef ACCG
        }
#define EPILOG(m_, acc2) do { float acc[16]; _Pragma("unroll") for (int j = 0; j < 8; ++j) { acc[2 * j] = acc2[j].x; acc[2 * j + 1] = acc2[j].y; } \
        float* xr = a.out + (size_t)(m_) * D + lane * 16; float xn[16]; float ss = 0.f; \
        _Pragma("unroll") for (int j = 0; j < 4; ++j) { const f32x4 xv = *(const f32x4*)(xr + 4 * j); xn[4 * j] = xv.x + acc[4 * j]; xn[4 * j + 1] = xv.y + acc[4 * j + 1]; xn[4 * j + 2] = xv.z + acc[4 * j + 2]; xn[4 * j + 3] = xv.w + acc[4 * j + 3]; } \
        _Pragma("unroll") for (int j = 0; j < 16; ++j) ss += xn[j] * xn[j]; \
        const float r = rsqrtf(wave_sum(ss) * (1.f / D) + EPS); \
        if (l + 1 < DEPTH) { const float* gn = a.norm1 + (size_t)(l + 1) * D + lane * 16; \
            _Pragma("unroll") for (int j = 0; j < 4; ++j) *(f32x4*)(xr + 4 * j) = (f32x4){xn[4 * j], xn[4 * j + 1], xn[4 * j + 2], xn[4 * j + 3]}; \
            u32x4 w0, w1; \
            w0.x = pk2(xn[0] * r * gn[0], xn[1] * r * gn[1]); w0.y = pk2(xn[2] * r * gn[2], xn[3] * r * gn[3]); w0.z = pk2(xn[4] * r * gn[4], xn[5] * r * gn[5]); w0.w = pk2(xn[6] * r * gn[6], xn[7] * r * gn[7]); \
            w1.x = pk2(xn[8] * r * gn[8], xn[9] * r * gn[9]); w1.y = pk2(xn[10] * r * gn[10], xn[11] * r * gn[11]); w1.z = pk2(xn[12] * r * gn[12], xn[13] * r * gn[13]); w1.w = pk2(xn[14] * r * gn[14], xn[15] * r * gn[15]); \
            *(u32x4*)((bf16_t*)(ws + WS_H16) + (size_t)(m_) * D + lane * 16) = w0; *(u32x4*)((bf16_t*)(ws + WS_H16) + (size_t)(m_) * D + lane * 16 + 8) = w1; \
        } else { const float* gn = a.final_gain + lane * 16; \
            _Pragma("unroll") for (int j = 0; j < 4; ++j) *(f32x4*)(xr + 4 * j) = (f32x4){xn[4 * j] * r * gn[4 * j], xn[4 * j + 1] * r * gn[4 * j + 1], xn[4 * j + 2] * r * gn[4 * j + 2], xn[4 * j + 3] * r * gn[4 * j + 3]}; } } while (0)
        EPILOG(mA, accA);
        if (vB) EPILOG(mB, accB);
#undef EPILOG
#undef LOADH
#undef SORTTOK
    }
}

constexpr int PH_PER_LAYER = 9, N_PHASES = 1 + DEPTH * PH_PER_LAYER;
__global__ void __launch_bounds__(NTHR, 2) fwd_kernel(Args a) {
    extern __shared__ __attribute__((aligned(16))) unsigned char lds[];
    const int wv = __builtin_amdgcn_readfirstlane((int)threadIdx.x >> 6);
    const int tid = threadIdx.x;
    for (int u = tid; u < (LDS_BYTES - LDS_CTL_OFF) / 4; u += NTHR) ((unsigned*)(lds + LDS_CTL_OFF))[u] = 0u;
    __syncthreads();
    unsigned* ctl = (unsigned*)(a.ws + WS_CTL);
    XcdBarrier bar = xcd_barrier_post(ctl + 4096, (volatile LAS unsigned*)(LAS unsigned char*)(lds + LDS_CTL_OFF), wv);
    const int lo = a.ph_lo, hi = a.ph_hi;
#define IN(k) (lo <= (k) && (k) < hi)
#define SEAM(k) do { if (IN(k) && IN((k) + 1)) xcd_barrier(bar, wv); } while (0)
    unsigned char* ws = oport(a.ws);
    if (IN(0)) { ph_prologue(a, lds, wv); } SEAM(0);
    for (int l = 0; l < DEPTH; ++l) {
        const int pb = 1 + l * PH_PER_LAYER;
        unsigned char* ws = oport(a.ws);
        if (IN(pb + 0)) {
            ph_kiwi(a, l, lds, wv);
            pg8::Gemm g{(const bf16_t*)(ws + WS_H16), (const bf16_t*)(ws + WS_WIN + (size_t)l * WIN_L), M, NMAIN, D, 0, 0};
            pg8::StaticOrder S; S.init(M, NMAIN, gridDim.x, obid(), 0);
            pg8::EpiIn E{(bf16_t*)(ws + WS_P16), (float*)(ws + WS_PF)};
            pg8::gemm_phase(((LAS unsigned char*)lds), g, S, E, wv);
        } SEAM(pb + 0);
        if (IN(pb + 1)) { ph_post(a, l, lds, wv); ph_h1(a, l, lds, wv); } SEAM(pb + 1);
        if (IN(pb + 2)) { ph_h2(a, wv); ph_gmlp(a, l, lds, wv); ph_sel(a, lds, wv); } SEAM(pb + 2);
        if (IN(pb + 3)) { ph_attn(a, lds, wv); ph_h3(a, l, lds, wv); } SEAM(pb + 3);
        if (IN(pb + 4)) {
            pg8::Gemm g{(const bf16_t*)(ws + WS_YALL), (const bf16_t*)(ws + WS_WBR + (size_t)l * WBR_L), M, 3072, 512, (size_t)M * 512 * 2, 4};
            pg8::BranchOrder S; S.init(gridDim.x, obid());
            pg8::EpiGate E{(bf16_t*)(ws + WS_GB), (const bf16_t*)(ws + WS_P16)};
            pg8::gemm_phase(((LAS unsigned char*)lds), g, S, E, wv);
        } SEAM(pb + 4);
        if (IN(pb + 5)) {
            pg8::Gemm g{(const bf16_t*)(ws + WS_GB), (const bf16_t*)(ws + WS_WOUT + (size_t)l * WOUT_L), M, D, D, 0, 0};
            pg8::StaticOrder S; S.init(M, D, gridDim.x, obid(), 0);
            pg8::EpiRes E{a.out};
            pg8::gemm_phase(((LAS unsigned char*)lds), g, S, E, wv);
        } SEAM(pb + 5);
        if (IN(pb + 6)) { ph_norm2(a, l, wv); } SEAM(pb + 6);
        if (IN(pb + 7)) {
            pg8::Gemm g{(const bf16_t*)(ws + WS_H16), (const bf16_t*)(ws + WS_WPQ + (size_t)l * WPQ_L), M, 2048, D, 0, 0};
            pg8::StaticOrder S; S.init(M, 2048, gridDim.x, obid(), 0);
            pg8::EpiB16 E{(bf16_t*)(ws + WS_GB), 2048};
            pg8::gemm_phase(((LAS unsigned char*)lds), g, S, E, wv);
            asm volatile("s_waitcnt vmcnt(0)" ::: "memory"); __syncthreads();
            for (int i0_ = 0;; i0_ += 2) { pg8::Unit u0, u1; if (!S.next(i0_, u0)) break; const bool two = S.next(i0_ + 1, u1);
                ph_peer_select(a, l, lds, wv, two ? 2 : 1, u0.pm, u0.pn, two ? u1.pm : 0, two ? u1.pn : 0); }
        } SEAM(pb + 7);
        if (IN(pb + 8)) { ph_peer_experts(a, l, lds, wv); } SEAM(pb + 8);
    }
#undef IN
#undef SEAM
}

#ifndef MK_N_LAUNCHES
#define MK_N_LAUNCHES 1
#endif
extern "C" void kernel_launch(void* const* d_in, const int* in_sizes, int n_in, void* d_out, int out_size, void* d_ws, size_t ws_size, hipStream_t stream) {
    static int grid = 0;
    if (grid == 0) {
        if (n_in != 17 || out_size != M * D || ws_size < WS_END) { fprintf(stderr, "kernel_launch: unexpected shapes (n_in %d, out %d, ws %zu)\n", n_in, out_size, ws_size); grid = -1; return; }
        int dev = 0, cus = 0, per_cu = 0;
        if (hipGetDevice(&dev) != hipSuccess || hipDeviceGetAttribute(&cus, hipDeviceAttributeMultiprocessorCount, dev) != hipSuccess) { grid = -1; return; }
        if (hipFuncSetAttribute((const void*)fwd_kernel, hipFuncAttributeMaxDynamicSharedMemorySize, LDS_BYTES) != hipSuccess) { fprintf(stderr, "kernel_launch: hipFuncSetAttribute failed\n"); grid = -1; return; }
        if (hipOccupancyMaxActiveBlocksPerMultiprocessor(&per_cu, (const void*)fwd_kernel, NTHR, LDS_BYTES) != hipSuccess || per_cu < 1) { fprintf(stderr, "kernel_launch: occupancy query says %d\n", per_cu); (void)hipGetLastError(); grid = -1; return; }
        grid = cus;
    }
    if (grid < 0) return;
    (void)hipMemsetAsync((char*)d_ws + WS_CTL, 0, CTL_BYTES, stream);
    Args a{};
    a.x = (const float*)d_in[0]; a.pos = (const int*)d_in[1]; a.norm1 = (const float*)d_in[2]; a.w_in = (const float*)d_in[3]; a.lb_logits = (const float*)d_in[4]; a.hgrn_gain = (const float*)d_in[5];
    a.gmlp_gain = (const float*)d_in[6]; a.gmlp_ws = (const float*)d_in[7]; a.gmlp_bs = (const float*)d_in[8]; a.w_branch = (const float*)d_in[9]; a.w_out = (const float*)d_in[10]; a.norm2 = (const float*)d_in[11];
    a.peer_wq = (const float*)d_in[12]; a.peer_keys = (const float*)d_in[13]; a.peer_u = (const float*)d_in[14]; a.peer_v = (const float*)d_in[15]; a.final_gain = (const float*)d_in[16];
    a.out = (float*)d_out; a.ws = (unsigned char*)d_ws;
    if (MK_N_LAUNCHES == 1) { a.ph_lo = 0; a.ph_hi = N_PHASES; hipLaunchKernelGGL(fwd_kernel, dim3(grid), dim3(NTHR), LDS_BYTES, stream, a); }
    else for (int p = 0; p < N_PHASES; ++p) { a.ph_lo = p; a.ph_hi = p + 1; hipLaunchKernelGGL(fwd_kernel, dim3(grid), dim3(NTHR), LDS_BYTES, stream, a); }
}
```

```cpp
#include <hip/hip_runtime.h>
#include <cstdio>
#include <cstdint>

#define LAS __attribute__((address_space(3)))
typedef unsigned short bf16_t;
typedef short bf16x8 __attribute__((ext_vector_type(8)));
typedef float f32x4 __attribute__((ext_vector_type(4)));
typedef unsigned u32x4 __attribute__((ext_vector_type(4)));

constexpr int D = 1024, BATCH = 2, SEQ = 8192, DEPTH = 4, M = BATCH * SEQ;
constexpr int NIN = 8264;
constexpr int NPAD = 8448;
constexpr int C_AQ = 0, C_AF = 512, C_AI = 1024, C_AG = 1536, C_BU = 2048, C_BV = 2560, C_CQ = 3072, C_CK = 3584, C_CV = 4096, C_QI = 4608, C_GL = 5120, C_KI = 8192, C_WI = 8256;
constexpr int NMAIN = 8192;
constexpr int S_GL = 5192;
constexpr int PFW = 768;
constexpr float EPS = 1e-6f;
constexpr int NEXP = 16384;

constexpr size_t MiB = 1u << 20;
constexpr size_t WS_CTL = 0, CTL_BYTES = 1 * MiB;
constexpr size_t WS_WIN = 2 * MiB;
constexpr size_t WIN_L = (size_t)NPAD * D * 2;
constexpr size_t WS_WBR = 68 * MiB;
constexpr size_t WBR_L = (size_t)3072 * 512 * 2;
constexpr size_t WS_WOUT = 80 * MiB;
constexpr size_t WOUT_L = (size_t)1024 * 3072 * 2;
constexpr size_t WS_WPQ = 104 * MiB;
constexpr size_t WPQ_L = (size_t)2048 * 1024 * 2;
constexpr size_t WS_LB = 120 * MiB;
constexpr size_t WS_CS = 121 * MiB;
constexpr size_t WS_H16 = 134 * MiB;
constexpr size_t WS_P16 = 166 * MiB;
constexpr size_t WS_PF = 430 * MiB;
constexpr size_t WS_QR = 478 * MiB, WS_KR = 494 * MiB;
constexpr size_t WS_QI = 510 * MiB;
constexpr size_t WS_KI = 542 * MiB;
constexpr size_t WS_WI = 546 * MiB;
constexpr size_t WS_FF = 548 * MiB, WS_KK = 580 * MiB, WS_QF = 612 * MiB;
constexpr size_t WS_OA = 644 * MiB;
constexpr size_t WS_VN = 676 * MiB;
constexpr size_t WS_YALL = 708 * MiB;
constexpr size_t WS_GB = 756 * MiB;
constexpr size_t WS_EID = 852 * MiB, WS_EG = 860 * MiB;
constexpr size_t WS_DD = 120 * MiB + 256 * 1024;
constexpr size_t WS_WSB = 544 * MiB;
constexpr size_t WS_VT = 644 * MiB;
constexpr size_t WS_MASK = 660 * MiB;
constexpr size_t WS_U16 = 868 * MiB, WS_V16 = 900 * MiB;
constexpr size_t WS_RS = 884 * MiB;
constexpr size_t WS_SKB = 932 * MiB;
constexpr size_t WS_END = 934 * MiB;

__device__ const float ROPE_INV64[64] = {
1.000000000e+00f, 8.659643531e-01f, 7.498942614e-01f, 6.493816376e-01f, 5.623413324e-01f, 4.869675338e-01f, 4.216965139e-01f, 3.651741147e-01f, 3.162277639e-01f, 2.738419771e-01f, 2.371373773e-01f, 2.053525001e-01f, 1.778279394e-01f, 1.539926529e-01f, 1.333521307e-01f, 1.154782027e-01f, 1.000000015e-01f, 8.659642935e-02f, 7.498941571e-02f, 6.493816525e-02f, 5.623413250e-02f, 4.869675264e-02f, 4.216965288e-02f, 3.651741147e-02f, 3.162277490e-02f, 2.738419734e-02f, 2.371373773e-02f, 2.053525113e-02f, 1.778279431e-02f, 1.539926510e-02f, 1.333521493e-02f, 1.154782064e-02f, 9.999999776e-03f, 8.659643121e-03f, 7.498941850e-03f, 6.493816152e-03f, 5.623413250e-03f, 4.869675264e-03f, 4.216964822e-03f, 3.651741194e-03f, 3.162277630e-03f, 2.738419687e-03f, 2.371373586e-03f, 2.053524833e-03f, 1.778279431e-03f, 1.539926510e-03f, 1.333521446e-03f, 1.154781901e-03f, 1.000000047e-03f, 8.659643354e-04f, 7.498942432e-04f, 6.493816618e-04f, 5.623413017e-04f, 4.869675322e-04f, 4.216965172e-04f, 3.651741426e-04f, 3.162277571e-04f, 2.738419571e-04f, 2.371373703e-04f, 2.053525095e-04f, 1.778279402e-04f, 1.539926452e-04f, 1.333521504e-04f, 1.154782003e-04f};
__device__ const float ROPE_INV32[32] = {
1.000000000e+00f, 7.498942614e-01f, 5.623413324e-01f, 4.216965139e-01f, 3.162277639e-01f, 2.371373773e-01f, 1.778279394e-01f, 1.333521307e-01f, 1.000000015e-01f, 7.498941571e-02f, 5.623413250e-02f, 4.216965288e-02f, 3.162277490e-02f, 2.371373773e-02f, 1.778279431e-02f, 1.333521493e-02f, 9.999999776e-03f, 7.498941850e-03f, 5.623413250e-03f, 4.216964822e-03f, 3.162277630e-03f, 2.371373586e-03f, 1.778279431e-03f, 1.333521446e-03f, 1.000000047e-03f, 7.498942432e-04f, 5.623413017e-04f, 4.216965172e-04f, 3.162277571e-04f, 2.371373703e-04f, 1.778279402e-04f, 1.333521504e-04f};

__device__ __forceinline__ float bf2f(bf16_t b) { return __uint_as_float(((unsigned)b) << 16); }
__device__ __forceinline__ unsigned f2bf(float f) { unsigned u = __float_as_uint(f); return (u + 0x7fffu + ((u >> 16) & 1u)) >> 16; }
__device__ __forceinline__ unsigned pk2(float lo, float hi) { return f2bf(lo) | (f2bf(hi) << 16); }
__device__ __forceinline__ float lo_bf(unsigned w) { return __uint_as_float(w << 16); }
__device__ __forceinline__ float hi_bf(unsigned w) { return __uint_as_float(w & 0xffff0000u); }
__device__ __forceinline__ float sigm(float x) { return 1.f / (1.f + __expf(-x)); }
__device__ __forceinline__ float silu(float x) { return x * sigm(x); }
__device__ __forceinline__ float gelu_t(float x) { const float u = 0.7978845608028654f * (x + 0.044715f * x * x * x); const float th = 1.f - 2.f / (1.f + __expf(2.f * u)); return 0.5f * x * (1.f + th); }
__device__ __forceinline__ float wave_sum(float v) {
#pragma unroll
    for (int o = 1; o < 64; o <<= 1) v += __shfl_xor(v, o);
    return v;
}
__device__ __forceinline__ float wave_max(float v) {
#pragma unroll
    for (int o = 1; o < 64; o <<= 1) v = fmaxf(v, __shfl_xor(v, o));
    return v;
}
typedef __bf16 bf2_t __attribute__((ext_vector_type(2)));
__device__ __forceinline__ float dot2(unsigned a, unsigned b, float c) { return __builtin_amdgcn_fdot2_f32_bf16(__builtin_bit_cast(bf2_t, a), __builtin_bit_cast(bf2_t, b), c, false); }
__device__ __forceinline__ int otid(int wv) { int t; asm volatile("v_mbcnt_lo_u32_b32 %0, -1, 0\n\tv_mbcnt_hi_u32_b32 %0, -1, %0" : "=v"(t)); return wv * 64 + t; }
__device__ __forceinline__ unsigned char* oport(unsigned char* p) { unsigned long long z; asm volatile("s_mov_b64 %0, 0" : "=s"(z)); return p + z; }
__device__ __forceinline__ int obid() { int b; asm volatile("s_mov_b32 %0, %1" : "=s"(b) : "s"((int)blockIdx.x)); return b; }
__device__ __forceinline__ unsigned fkey(float f) { const unsigned u = __float_as_uint(f); return u ^ ((u >> 31) ? 0xFFFFFFFFu : 0x80000000u); }

#define XB_TMO      128
#define XB_XCNT(j)  (256  + 64 * (j))
#define XB_XSUB(j)  (1280 + 64 * (j))
#define XB_XGEN(j)  (2304 + 64 * (j))
#define XB_TOP      3328
#define XB_TOPGEN   3392
#define XCD_BAR_WORDS 3456
#define XB_SPIN_CAP (1u << 23)
__device__ __forceinline__ unsigned xb_ld(unsigned* p)              { return __hip_atomic_load(p, __ATOMIC_RELAXED, __HIP_MEMORY_SCOPE_AGENT); }
__device__ __forceinline__ unsigned xb_add(unsigned* p, unsigned v) { return __hip_atomic_fetch_add(p, v, __ATOMIC_RELAXED, __HIP_MEMORY_SCOPE_AGENT); }
__device__ __forceinline__ unsigned xb_xcc_id() { return (unsigned)__builtin_amdgcn_s_getreg((3 << 11) | 20) & 0xFu; }
#define XB_SPIN(cond, bar) do { unsigned _sp = 0; while (cond) { __builtin_amdgcn_s_sleep(1); \
    if ((++_sp & 255u) == 0u) { if (xb_ld(&(bar)[XB_TMO])) break; if (_sp > XB_SPIN_CAP) { atomicAdd(&(bar)[XB_TMO], 1u); break; } } } } while (0)
struct XcdBarrier { unsigned* bar; unsigned x; volatile LAS unsigned* st; };
__device__ __forceinline__ XcdBarrier xcd_barrier_post(unsigned* bar, volatile LAS unsigned* st, int wv) {
    XcdBarrier b; b.bar = bar; b.x = xb_xcc_id(); b.st = st;
    if (wv == 0) if ((otid(0) & 63) == 0) (void)xb_add(&bar[XB_XCNT(b.x)], 1u);
    return b;
}
__device__ __forceinline__ void xcd_barrier_complete(unsigned* bar, unsigned x, unsigned& nloc, unsigned& nx) {
    const unsigned G = gridDim.x * gridDim.y * gridDim.z;
    unsigned sum, cnt, mine, sp = 0u;
    for (;;) {
        sum = 0u; cnt = 0u; mine = 0u;
#pragma unroll
        for (unsigned j = 0; j < 16; ++j) { const unsigned c = xb_ld(&bar[XB_XCNT(j)]); sum += c; cnt += (c > 0u) ? 1u : 0u; mine = (j == x) ? c : mine; }
        if (sum == G) break;
        __builtin_amdgcn_s_sleep(1);
        if ((++sp & 255u) == 0u) { if (xb_ld(&bar[XB_TMO])) break; if (sp > XB_SPIN_CAP) { atomicAdd(&bar[XB_TMO], 1u); break; } }
    }
    nloc = mine > 0u ? mine : 1u; nx = cnt > 0u ? cnt : 1u;
}
__device__ __forceinline__ void xcd_barrier(const XcdBarrier& b, int wv) {
    asm volatile("s_waitcnt vmcnt(0)" ::: "memory");
    __syncthreads();
    if (wv == 0) if ((otid(0) & 63) == 0) {
        unsigned* bar = b.bar;
        __builtin_amdgcn_s_waitcnt(0);
        unsigned nloc = b.st[0], nx = b.st[1];
        if (nloc == 0u) { xcd_barrier_complete(bar, b.x, nloc, nx); b.st[0] = nloc; b.st[1] = nx; }
        const unsigned old = xb_add(&bar[XB_XSUB(b.x)], 1u);
        const unsigned gen = old / nloc;
        if (old + 1u == (gen + 1u) * nloc) {
            __builtin_amdgcn_fence(__ATOMIC_RELEASE, "agent");
            asm volatile("s_waitcnt vmcnt(0)" ::: "memory");
            const unsigned og = xb_add(&bar[XB_TOP], 1u);
            const unsigned tg = og / nx;
            if (og + 1u == (tg + 1u) * nx) xb_add(&bar[XB_TOPGEN], 1u);
            else XB_SPIN(xb_ld(&bar[XB_TOPGEN]) == tg, bar);
            __builtin_amdgcn_fence(__ATOMIC_ACQUIRE, "agent");
            xb_add(&bar[XB_XGEN(b.x)], 1u);
            asm volatile("s_waitcnt vmcnt(0)" ::: "memory");
        } else {
            XB_SPIN(xb_ld(&bar[XB_XGEN(b.x)]) == gen, bar);
            __builtin_amdgcn_fence(__ATOMIC_ACQUIRE, "agent");
            asm volatile("s_waitcnt vmcnt(0)" ::: "memory");
        }
    }
    __syncthreads();
}

namespace pg8 {
constexpr int BM = 256, BK = 64, HALF = 128, HTB = HALF * BK * 2, STAGE_BYTES = 8 * HTB, NXCD = 8, WGM = 8;
__host__ __device__ __forceinline__ int lds_byte(int r, int c) { const int st = (r >> 4) * 2 + (c >> 5), rr = r & 15, cc = c & 31, ob = rr * 64 + cc * 2; return st * 1024 + (ob ^ (((ob >> 9) & 1) << 5)); }
__host__ __device__ __forceinline__ void stage_rc(int b, int& R, int& C) { const int st = b / 1024, sb = b % 1024, swz = sb ^ (((sb >> 9) & 1) << 5); R = (st >> 1) * 16 + swz / 64; C = (st & 1) * 32 + (swz % 64) / 2; }
__host__ __device__ __forceinline__ int perm32(int rho) { const int n = rho >> 4, i = rho & 15; return 8 * (i >> 2) + 4 * n + (i & 3); }
struct Unit { int pm, pn, ka; };
struct Gemm { const bf16_t* A; const bf16_t* Bt; int M, N, K; size_t strideA; int nsplit; };
struct StaticOrder {
    int nM, nN, nwg, G, c, nsplit;
    __device__ __forceinline__ void init(int M_, int N_, int G_, int c_, int nsplit_) { nM = M_ / BM; nN = N_ / BM; nwg = nM * nN; G = G_; c = c_; nsplit = nsplit_; }
    __device__ __forceinline__ bool next(int i, Unit& u) const {
        const long L = (long)i * G + c; if (L >= nwg) return false;
        int wgid = (int)L; { const int q = nwg / NXCD, r = nwg % NXCD, xcd = wgid % NXCD, off = wgid / NXCD; wgid = (xcd < r ? xcd * (q + 1) : r * (q + 1) + (xcd - r) * q) + off; }
        const int nig = WGM * nN, gid = wgid / nig, fm = gid * WGM, gsz = (nM - fm) < WGM ? (nM - fm) : WGM;
        u.pm = fm + ((wgid % nig) % gsz); u.pn = (wgid % nig) / gsz; u.ka = nsplit ? u.pn / nsplit : 0; return true;
    }
};
__device__ __forceinline__ unsigned cvt_pk_bf16(float lo, float hi) { unsigned r; asm volatile("v_cvt_pk_bf16_f32 %0, %1, %2" : "=v"(r) : "v"(lo), "v"(hi)); return r; }

template <class Epi, class Sched>
__device__ __forceinline__ void gemm_phase(LAS unsigned char* lds, const Gemm g, const Sched& S, const Epi& E, int wv) {
    const int tid = otid(wv), wid = __builtin_amdgcn_readfirstlane(tid >> 6), lane = tid & 63, wr = wid >> 2, wc = wid & 3, fr = lane & 15, fq = lane >> 4;
    const int K = g.K, nt = K / BK;
    unsigned voffA[2], voffB[2];
#pragma unroll
    for (int i = 0; i < 2; ++i) { int R, C; stage_rc(tid * 16 + i * 8192, R, C); const int Rb = Epi::PERM ? ((R & ~31) + perm32(R & 31)) : R;
        voffA[i] = (unsigned)(R * K + C) * 2u; voffB[i] = (unsigned)(Rb * K + C) * 2u; }
    const size_t kstep = (size_t)(BK * 2);
    const size_t hstep = (size_t)HALF * K * 2;
    const size_t tstep = 2 * hstep;
    const unsigned ldsw = (unsigned)wid * 1024u;
    const int aoff = lds_byte(wr * 64 + fr, fq * 8), boff = lds_byte(wc * 32 + fr, fq * 8);
#define PG8_SA(b, h) (((b) * 2 + (h)) * HTB)
#define PG8_SB(b, h) ((4 + (b) * 2 + (h)) * HTB)
#define PG8_STAGE(bufoff, gbase, voff) do { _Pragma("unroll") for (int _i = 0; _i < 2; ++_i) \
        __builtin_amdgcn_global_load_lds((const unsigned*)((const char*)(gbase) + (voff)[_i]), (LAS unsigned*)(lds + (bufoff) + ldsw + _i * 8192), 16, 0, 0); } while (0)
#define PG8_LDA(dst, b, h) do { _Pragma("unroll") for (int m = 0; m < 4; ++m) _Pragma("unroll") for (int k = 0; k < 2; ++k) dst[m][k] = *(const LAS bf16x8*)(lds + PG8_SA(b, h) + aoff + m * 2048 + k * 1024); } while (0)
#define PG8_LDB(dst, b, h) do { _Pragma("unroll") for (int n = 0; n < 2; ++n) _Pragma("unroll") for (int k = 0; k < 2; ++k) dst[n][k] = *(const LAS bf16x8*)(lds + PG8_SB(b, h) + boff + n * 2048 + k * 1024); } while (0)
#define PG8_MMA(ai, bj, At, Bt) do { __builtin_amdgcn_s_setprio(1); _Pragma("unroll") for (int m = 0; m < 4; ++m) _Pragma("unroll") for (int n = 0; n < 2; ++n) _Pragma("unroll") for (int k = 0; k < 2; ++k) \
        acc[ai][bj][m][n] = __builtin_amdgcn_mfma_f32_16x16x32_bf16(Bt[n][k], At[m][k], acc[ai][bj][m][n], 0, 0, 0); __builtin_amdgcn_s_setprio(0); } while (0)
#define PG8_WAIT_V(n) asm volatile("s_waitcnt vmcnt(" #n ")" ::: "memory")
#define PG8_WAIT_L(n) asm volatile("s_waitcnt lgkmcnt(" #n ")" ::: "memory")
#define PG8_BAR __builtin_amdgcn_s_barrier()
#define PG8_SCHED __builtin_amdgcn_sched_barrier(0)
    Unit cur, nxt; int ui = 0;
    if (!S.next(0, cur)) return;
    f32x4 acc[2][2][4][2];
#pragma unroll
    for (int a = 0; a < 2; ++a)
#pragma unroll
        for (int b = 0; b < 2; ++b)
#pragma unroll
            for (int m = 0; m < 4; ++m)
#pragma unroll
                for (int n = 0; n < 2; ++n) acc[a][b][m][n] = (f32x4){0.f, 0.f, 0.f, 0.f};
    bf16x8 At[4][2], B0[2][2], B1[2][2];
    const char* cA = (const char*)g.A + (size_t)cur.ka * g.strideA + (size_t)cur.pm * tstep; const char* cB = (const char*)g.Bt + (size_t)cur.pn * tstep;
    PG8_STAGE(PG8_SB(0, 0), cB, voffB); PG8_STAGE(PG8_SA(0, 0), cA, voffA); PG8_STAGE(PG8_SB(0, 1), cB + hstep, voffB); PG8_STAGE(PG8_SA(0, 1), cA + hstep, voffA);
    if (wr == 1) PG8_BAR;
    PG8_WAIT_V(4); PG8_BAR;
    PG8_STAGE(PG8_SB(1, 0), cB + kstep, voffB); PG8_STAGE(PG8_SA(1, 0), cA + kstep, voffA); PG8_STAGE(PG8_SB(1, 1), cB + hstep + kstep, voffB);
    PG8_WAIT_V(6); PG8_BAR;
    for (;;) {
        const bool has_next = S.next(ui + 1, nxt);
        const char* nA = has_next ? (const char*)g.A + (size_t)nxt.ka * g.strideA + (size_t)nxt.pm * tstep : cA; const char* nB = has_next ? (const char*)g.Bt + (size_t)nxt.pn * tstep : cB;
        for (int t = 0; t < nt; t += 2) {
            const bool last = (t == nt - 2);
            const char* a1 = cA + (size_t)(t + 1) * kstep;
            const char* a2 = last ? nA : cA + (size_t)(t + 2) * kstep; const char* b2 = last ? nB : cB + (size_t)(t + 2) * kstep;
            const char* a3 = a2 + kstep; const char* b3 = b2 + kstep;
            PG8_LDB(B0, 0, 0); PG8_SCHED; PG8_LDA(At, 0, 0); PG8_STAGE(PG8_SA(1, 1), a1 + hstep, voffA);
            PG8_WAIT_L(8); PG8_BAR; PG8_WAIT_L(0); PG8_MMA(0, 0, At, B0); PG8_BAR; PG8_SCHED;
            PG8_LDB(B1, 0, 1); PG8_STAGE(PG8_SB(0, 0), b2, voffB);
            PG8_BAR; PG8_WAIT_L(0); PG8_MMA(0, 1, At, B1); PG8_BAR;
            PG8_LDA(At, 0, 1); PG8_STAGE(PG8_SA(0, 0), a2, voffA);
            PG8_BAR; PG8_WAIT_L(0); PG8_MMA(1, 0, At, B0); PG8_BAR; PG8_SCHED;
            PG8_STAGE(PG8_SB(0, 1), b2 + hstep, voffB);
            PG8_WAIT_V(6); PG8_BAR; PG8_MMA(1, 1, At, B1); PG8_BAR;
            PG8_LDB(B0, 1, 0); PG8_SCHED; PG8_LDA(At, 1, 0); PG8_STAGE(PG8_SA(0, 1), a2 + hstep, voffA);
            PG8_WAIT_L(8); PG8_BAR; PG8_WAIT_L(0); PG8_MMA(0, 0, At, B0); PG8_BAR; PG8_SCHED;
            PG8_LDB(B1, 1, 1); PG8_STAGE(PG8_SB(1, 0), b3, voffB);
            PG8_BAR; PG8_WAIT_L(0); PG8_MMA(0, 1, At, B1); PG8_BAR;
            PG8_LDA(At, 1, 1); PG8_STAGE(PG8_SA(1, 0), a3, voffA);
            PG8_BAR; PG8_WAIT_L(0); PG8_MMA(1, 0, At, B0); PG8_BAR; PG8_SCHED;
            PG8_STAGE(PG8_SB(1, 1), b3 + hstep, voffB);
            PG8_WAIT_V(6); PG8_BAR; PG8_MMA(1, 1, At, B1); PG8_BAR;
        }
        E(acc, cur, wr, wc, fr, fq);
        if (!has_next) break;
        if (!E.keep(cur))
#pragma unroll
        for (int a = 0; a < 2; ++a)
#pragma unroll
            for (int b = 0; b < 2; ++b)
#pragma unroll
                for (int m = 0; m < 4; ++m)
#pragma unroll
                    for (int n = 0; n < 2; ++n) acc[a][b][m][n] = (f32x4){0.f, 0.f, 0.f, 0.f};
        cur = nxt; cA = nA; cB = nB; ++ui;
    }
    PG8_WAIT_V(0);
    if (wr == 0) PG8_BAR;
    PG8_BAR;
#undef PG8_SA
#undef PG8_SB
#undef PG8_STAGE
#undef PG8_LDA
#undef PG8_LDB
#undef PG8_MMA
#undef PG8_WAIT_V
#undef PG8_WAIT_L
#undef PG8_BAR
#undef PG8_SCHED
}

struct EpiIn {
    __device__ __forceinline__ bool keep(const Unit&) const { return false; }
    static constexpr bool PERM = true;
    bf16_t* P16; float* PF;
    __device__ __forceinline__ void operator()(f32x4 (&acc)[2][2][4][2], const Unit& u, int wr, int wc, int fr, int fq) const {
        const int row0 = u.pm * BM + wr * 64 + fr, col0 = u.pn * BM + wc * 32 + 8 * fq;
        const bool f32t = (u.pn == 2) || (u.pn == 3), gate = u.pn >= C_GL / 256;
        const int pfc0 = (u.pn - 2) * 256 + wc * 32 + 8 * fq;
#pragma unroll
        for (int ai = 0; ai < 2; ++ai)
#pragma unroll
            for (int m = 0; m < 4; ++m) { const size_t row = (size_t)(row0 + ai * HALF + m * 16);
#pragma unroll
                for (int bj = 0; bj < 2; ++bj) { f32x4 v0 = acc[ai][bj][m][0], v1 = acc[ai][bj][m][1];
                    if (gate) {
#pragma unroll
                        for (int j = 0; j < 4; ++j) { v0[j] = sigm(v0[j]); v1[j] = sigm(v1[j]); } }
                    u32x4 w; w.x = cvt_pk_bf16(v0[0], v0[1]); w.y = cvt_pk_bf16(v0[2], v0[3]); w.z = cvt_pk_bf16(v1[0], v1[1]); w.w = cvt_pk_bf16(v1[2], v1[3]);
                    *(u32x4*)(P16 + row * NPAD + col0 + bj * HALF) = w;
                    if (f32t) { float* pf = PF + row * PFW + pfc0 + bj * HALF; *(f32x4*)pf = v0; *(f32x4*)(pf + 4) = v1; } } }
    }
};
struct EpiGate {
    static constexpr bool PERM = true;
    bf16_t* GS; const bf16_t* P16;
    __device__ __forceinline__ bool keep(const Unit& u) const { return (u.pn >> 2) < 2; }
    __device__ __forceinline__ void operator()(f32x4 (&acc)[2][2][4][2], const Unit& u, int wr, int wc, int fr, int fq) const {
        const int n = u.pn >> 2, row0 = u.pm * BM + wr * 64 + fr, col0 = (u.pn & 3) * BM + wc * 32 + 8 * fq;
#pragma unroll
        for (int ai = 0; ai < 2; ++ai) {
            u32x4 gwv[4][2], hwv[4][2];
#pragma unroll
            for (int m = 0; m < 4; ++m)
#pragma unroll
                for (int bj = 0; bj < 2; ++bj) { const size_t row = (size_t)(row0 + ai * HALF + m * 16);
                    gwv[m][bj] = *(const u32x4*)(P16 + row * NPAD + C_GL + n * 1024 + col0 + bj * HALF);
                    if (n < 2) hwv[m][bj] = *(const u32x4*)(P16 + row * NPAD + C_GL + (n + 1) * 1024 + col0 + bj * HALF); else hwv[m][bj] = gwv[m][bj]; }
#pragma unroll
            for (int m = 0; m < 4; ++m)
#pragma unroll
                for (int bj = 0; bj < 2; ++bj) { const size_t row = (size_t)(row0 + ai * HALF + m * 16); f32x4& v0 = acc[ai][bj][m][0]; f32x4& v1 = acc[ai][bj][m][1];
                    const u32x4 gw = gwv[m][bj], hw = hwv[m][bj];
                    const float g[8] = {lo_bf(gw.x), hi_bf(gw.x), lo_bf(gw.y), hi_bf(gw.y), lo_bf(gw.z), hi_bf(gw.z), lo_bf(gw.w), hi_bf(gw.w)};
                    if (n < 2) { const float h[8] = {lo_bf(hw.x), hi_bf(hw.x), lo_bf(hw.y), hi_bf(hw.y), lo_bf(hw.z), hi_bf(hw.z), lo_bf(hw.w), hi_bf(hw.w)};
#pragma unroll
                        for (int j = 0; j < 4; ++j) { v0[j] *= g[j] * __builtin_amdgcn_rcpf(h[j]); v1[j] *= g[4 + j] * __builtin_amdgcn_rcpf(h[4 + j]); }
                    } else { u32x4 w;
                        w.x = cvt_pk_bf16(v0[0] * g[0], v0[1] * g[1]); w.y = cvt_pk_bf16(v0[2] * g[2], v0[3] * g[3]);
                        w.z = cvt_pk_bf16(v1[0] * g[4], v1[1] * g[5]); w.w = cvt_pk_bf16(v1[2] * g[6], v1[3] * g[7]);
                        *(u32x4*)(GS + row * D + col0 + bj * HALF) = w; } }
        }
    }
};
struct BranchOrder {
    StaticOrder so; int G;
    __device__ __forceinline__ void init(int G_, int c_) { so.init(M, 1024, G_, c_, 0); G = G_; }
    __device__ __forceinline__ bool next(int i, Unit& u) const { Unit t; if (!so.next(i / 3, t)) return false; const int n = i % 3; u.pm = t.pm; u.pn = n * 4 + t.pn; u.ka = n; return true; }
};
struct EpiRes {
    __device__ __forceinline__ bool keep(const Unit&) const { return false; }
    static constexpr bool PERM = false;
    float* X;
    __device__ __forceinline__ void operator()(f32x4 (&acc)[2][2][4][2], const Unit& u, int wr, int wc, int fr, int fq) const {
        const int row0 = u.pm * BM + wr * 64 + fr, col0 = u.pn * BM + wc * 32 + 4 * fq;
#pragma unroll
        for (int ai = 0; ai < 2; ++ai)
#pragma unroll
            for (int m = 0; m < 4; ++m) { float* rowp = X + (size_t)(row0 + ai * HALF + m * 16) * D + col0;
#pragma unroll
                for (int bj = 0; bj < 2; ++bj)
#pragma unroll
                    for (int n = 0; n < 2; ++n) { f32x4* p = (f32x4*)(rowp + bj * HALF + n * 16); *p = *p + acc[ai][bj][m][n]; } }
    }
};
struct EpiB16 {
    __device__ __forceinline__ bool keep(const Unit&) const { return false; }
    static constexpr bool PERM = true;
    bf16_t* O; int ldc;
    __device__ __forceinline__ void operator()(f32x4 (&acc)[2][2][4][2], const Unit& u, int wr, int wc, int fr, int fq) const {
        const int row0 = u.pm * BM + wr * 64 + fr, col0 = u.pn * BM + wc * 32 + 8 * fq;
#pragma unroll
        for (int ai = 0; ai < 2; ++ai)
#pragma unroll
            for (int m = 0; m < 4; ++m) { bf16_t* rowp = O + (size_t)(row0 + ai * HALF + m * 16) * ldc + col0;
#pragma unroll
                for (int bj = 0; bj < 2; ++bj) { const f32x4 v0 = acc[ai][bj][m][0], v1 = acc[ai][bj][m][1];
                    u32x4 w; w.x = cvt_pk_bf16(v0[0], v0[1]); w.y = cvt_pk_bf16(v0[2], v0[3]); w.z = cvt_pk_bf16(v1[0], v1[1]); w.w = cvt_pk_bf16(v1[2], v1[3]);
                    *(u32x4*)(rowp + bj * HALF) = w; } }
    }
};
}

struct Args {
    const float* x; const int* pos; const float* norm1; const float* w_in; const float* lb_logits; const float* hgrn_gain; const float* gmlp_gain; const float* gmlp_ws; const float* gmlp_bs;
    const float* w_branch; const float* w_out; const float* norm2; const float* peer_wq; const float* peer_keys; const float* peer_u; const float* peer_v; const float* final_gain;
    float* out; unsigned char* ws; int ph_lo, ph_hi;
};
constexpr int NTHR = 512, NWAVE = 8;
constexpr int LDS_BYTES = 147456;
constexpr int LDS_CTL_OFF = 143360;

__device__ __forceinline__ void tr_item(const float* src, int ldsrc, int c0, int nvalid, bf16_t* dst, int ldd, int r0, int koff, float* scr, int item, int nblk, int lane) {
    const int kb = item / nblk, nb = item % nblk, k0 = 64 * kb, n0 = 32 * nb;
    const int nn = n0 + (lane & 31);
    float tv[32];
#pragma unroll
    for (int i = 0; i < 32; ++i) { const int kk = 2 * i + (lane >> 5); tv[i] = (nn < nvalid) ? src[(size_t)(k0 + kk) * ldsrc + c0 + nn] : 0.f; }
#pragma unroll
    for (int i = 0; i < 32; ++i) { const int kk = 2 * i + (lane >> 5); scr[kk * 33 + (lane & 31)] = tv[i]; }
    asm volatile("s_waitcnt lgkmcnt(0)" ::: "memory");
    const int c = lane & 7;
#pragma unroll
    for (int j = 0; j < 4; ++j) { const int n = (lane >> 3) + 8 * j; const float* s = scr + (8 * c) * 33 + n;
        u32x4 o; o.x = pk2(s[0 * 33], s[1 * 33]); o.y = pk2(s[2 * 33], s[3 * 33]); o.z = pk2(s[4 * 33], s[5 * 33]); o.w = pk2(s[6 * 33], s[7 * 33]);
        *(u32x4*)(dst + (size_t)(r0 + n0 + n) * ldd + koff + k0 + 8 * c) = o; }
    asm volatile("s_waitcnt lgkmcnt(0)" ::: "memory");
}
__device__ __forceinline__ void rms_row_to_bf16(const float* xrow, const float* gain, bf16_t* orow, int lane) {
    const f32x4* xr = (const f32x4*)xrow + lane; const f32x4* gr = (const f32x4*)gain + lane;
    f32x4 v[4]; float s = 0.f;
#pragma unroll
    for (int j = 0; j < 4; ++j) { v[j] = xr[64 * j]; s += (v[j].x * v[j].x + v[j].y * v[j].y) + (v[j].z * v[j].z + v[j].w * v[j].w); }
    const float r = rsqrtf(wave_sum(s) * (1.f / D) + EPS);
    unsigned long long* o8 = (unsigned long long*)orow + lane;
#pragma unroll
    for (int j = 0; j < 4; ++j) { const f32x4 g = gr[64 * j]; o8[64 * j] = (unsigned long long)pk2(v[j].x * r * g.x, v[j].y * r * g.y) | ((unsigned long long)pk2(v[j].z * r * g.z, v[j].w * r * g.w) << 32); }
}

__device__ __forceinline__ void ph_prologue(const Args& a, unsigned char* lds, int wv) {
    const int tid = otid(wv), lane = tid & 63, wave = tid >> 6;
    const int gw = blockIdx.x * NWAVE + wave, ngw = gridDim.x * NWAVE;
    const size_t gtid = (size_t)blockIdx.x * NTHR + tid, gsz = (size_t)gridDim.x * NTHR;
    unsigned char* ws = oport(a.ws);
    { const f32x4* s = (const f32x4*)a.x; f32x4* d = (f32x4*)a.out; for (size_t i = gtid; i < (size_t)M * D / 4; i += gsz) d[i] = s[i]; }
    float* scr = (float*)(lds + wave * 16384);
    constexpr int I_IN1 = 16 * 160, I_IN2 = 16 * 8, I_IN3 = 16 * 96, I_IN = I_IN1 + I_IN2 + I_IN3;
    constexpr int I_BR = 3 * 8 * 32, I_OUT = 16 * 32, I_PQ = 16 * 64, I_L = I_IN + I_BR + I_OUT + I_PQ;
    for (int it = gw; it < DEPTH * I_L; it += ngw) {
        const int l = it / I_L; int r = it % I_L;
        bf16_t* win = (bf16_t*)(ws + WS_WIN + (size_t)l * WIN_L); const float* src_in = a.w_in + (size_t)l * D * NIN;
        if (r < I_IN1) { tr_item(src_in, NIN, 0, 5120, win, D, 0, 0, scr, r, 160, lane); continue; } r -= I_IN1;
        if (r < I_IN2) { tr_item(src_in, NIN, 5120, 72, win, D, C_KI, 0, scr, r, 8, lane); continue; } r -= I_IN2;
        if (r < I_IN3) { tr_item(src_in, NIN, S_GL, 3072, win, D, C_GL, 0, scr, r, 96, lane); continue; } r -= I_IN3;
        if (r < I_BR) { const int n = r / 256; tr_item(a.w_branch + ((size_t)l * 3 + n) * 512 * D, D, 0, 1024, (bf16_t*)(ws + WS_WBR + (size_t)l * WBR_L), 512, n * 1024, 0, scr, r % 256, 32, lane); continue; } r -= I_BR;
        if (r < I_OUT) { tr_item(a.w_out + (size_t)l * D * D, D, 0, 1024, (bf16_t*)(ws + WS_WOUT + (size_t)l * WOUT_L), D, 0, 0, scr, r, 32, lane); continue; } r -= I_OUT;
        tr_item(a.peer_wq + (size_t)l * D * 2048, 2048, 0, 2048, (bf16_t*)(ws + WS_WPQ + (size_t)l * WPQ_L), D, 0, 0, scr, r, 64, lane);
    }
    if (gtid < 512) { float v[DEPTH], mx = -1e30f; for (int l = 0; l < DEPTH; ++l) { v[l] = a.lb_logits[l * 512 + gtid]; mx = fmaxf(mx, v[l]); }
        float s = 0.f; for (int l = 0; l < DEPTH; ++l) { v[l] = __expf(v[l] - mx); s += v[l]; }
        float c = 0.f; float* lb = (float*)(ws + WS_LB); for (int l = 0; l < DEPTH; ++l) { if (l > 0) c += v[l] / s; lb[l * 512 + gtid] = c; } }
    { u32x4* SKB = (u32x4*)(ws + WS_SKB); const f32x4* sk = (const f32x4*)a.peer_keys; for (size_t i = gtid; i < (size_t)DEPTH * 16 * 128 * 128 / 8; i += gsz) { const f32x4 k0 = sk[2 * i], k1 = sk[2 * i + 1]; SKB[i] = (u32x4){pk2(k0.x, k0.y), pk2(k0.z, k0.w), pk2(k1.x, k1.y), pk2(k1.z, k1.w)}; } }
    { bf16_t* WSB = (bf16_t*)(ws + WS_WSB); for (size_t i = gtid; i < (size_t)DEPTH * 4 * 128 * 128; i += gsz) { const int t = (int)((i >> 7) & 127), sx = (int)(i & 127); WSB[i] = (bf16_t)f2bf(sx <= t ? a.gmlp_ws[i] : 0.f); } }
    { float2* cs = (float2*)(ws + WS_CS);
      for (size_t i = gtid; i < (size_t)M * 96; i += gsz) { const int m = (int)(i / 96), j = (int)(i % 96);
          const float inv = j < 64 ? ROPE_INV64[j] : ROPE_INV32[j - 64]; const float angf = (float)a.pos[m] * inv;
          const double ang = (double)angf; const double k = rint(ang * 0.15915494309189535); const float r = (float)(ang - k * 6.283185307179586);
          cs[i] = make_float2(__cosf(r), __sinf(r)); } }
    for (int m = gw; m < M; m += ngw) rms_row_to_bf16(a.x + (size_t)m * D, a.norm1, (bf16_t*)(ws + WS_H16) + (size_t)m * D, lane);
}

__device__ __forceinline__ void ph_kiwi(const Args& a, int l, unsigned char* lds, int wv) {
    unsigned char* ws = oport(a.ws); const int tid = otid(wv), lane = tid & 63, wave = __builtin_amdgcn_readfirstlane(tid >> 6), g4 = wave & 3, kh = wave >> 2, fr = lane & 15, fq = lane >> 4;
    const bf16_t* H16 = (const bf16_t*)(ws + WS_H16); const bf16_t* W = (const bf16_t*)(ws + WS_WIN + (size_t)l * WIN_L) + (size_t)C_KI * D; float* PF = (float*)(ws + WS_PF);
    f32x4* sK = (f32x4*)lds + (g4 * 5) * 64 + lane;
    for (int base = obid(); base * 4 < M / 16; base += gridDim.x) { const int tg = base * 4 + g4; f32x4 acc[5];
#pragma unroll
        for (int nt = 0; nt < 5; ++nt) acc[nt] = (f32x4){0.f, 0.f, 0.f, 0.f};
#pragma unroll 8
        for (int ks = 16 * kh; ks < 16 * kh + 16; ++ks) { const bf16x8 y = ((const bf16x8*)(H16 + (size_t)tg * 16 * D + 32 * ks))[fr * (D / 8) + fq];
#pragma unroll
            for (int nt = 0; nt < 5; ++nt) { const bf16x8 x = ((const bf16x8*)(W + (size_t)nt * 16 * D + 32 * ks))[fr * (D / 8) + fq]; acc[nt] = __builtin_amdgcn_mfma_f32_16x16x32_bf16(x, y, acc[nt], 0, 0, 0); } }
        __syncthreads();
        if (kh == 1) {
#pragma unroll
            for (int nt = 0; nt < 5; ++nt) sK[nt * 64] = acc[nt]; }
        __syncthreads();
        if (kh == 0) {
#pragma unroll
            for (int nt = 0; nt < 5; ++nt) *(f32x4*)(PF + ((size_t)tg * 16 + fr) * PFW + 512 + 16 * nt + 4 * fq) = acc[nt] + sK[nt * 64]; }
    }
    __syncthreads();
}

__device__ __forceinline__ void ph_post(const Args& a, int l, unsigned char* lds, int wv) {
    const int tid = otid(wv), lane = tid & 63, wave = tid >> 6;
    const int gw = obid() * NWAVE + wave, ngw = gridDim.x * NWAVE;
    const size_t gtid = (size_t)obid() * NTHR + tid, gsz = (size_t)gridDim.x * NTHR;
    unsigned char* ws = oport(a.ws);
    const bf16_t* P16 = (const bf16_t*)(ws + WS_P16); const float* PF = (const float*)(ws + WS_PF); const float2* cs = (const float2*)(ws + WS_CS);
    { bf16_t* QR = (bf16_t*)(ws + WS_QR); bf16_t* KR = (bf16_t*)(ws + WS_KR);
#pragma unroll 4
      for (size_t i = gtid; i < (size_t)M * 256; i += gsz) { const int m = (int)(i >> 8), h = (int)((i >> 6) & 3), j = (int)(i & 63);
          const float2 c = cs[(size_t)m * 96 + j]; const size_t pb = (size_t)m * NPAD + h * 128 + j, ob = (size_t)m * 512 + h * 128 + j;
          const float q1 = bf2f(P16[pb + C_CQ]), q2 = bf2f(P16[pb + C_CQ + 64]), k1 = bf2f(P16[pb + C_CK]), k2 = bf2f(P16[pb + C_CK + 64]);
          const float sc = 0.08838834764831845f * 1.4426950408889634f;
          QR[ob] = (bf16_t)f2bf((q1 * c.x - q2 * c.y) * sc); QR[ob + 64] = (bf16_t)f2bf((q2 * c.x + q1 * c.y) * sc);
          KR[ob] = (bf16_t)f2bf(k1 * c.x - k2 * c.y); KR[ob + 64] = (bf16_t)f2bf(k2 * c.x + k1 * c.y); } }
    { bf16_t* QS = (bf16_t*)(ws + WS_QI); bf16_t* KIb = (bf16_t*)(ws + WS_KI); float* WP = (float*)(ws + WS_WI);
#pragma unroll 2
      for (int m = gw; m < M; m += ngw) { const int h = lane >> 3, jj = lane & 7;
          const unsigned long long w1 = *(const unsigned long long*)(P16 + (size_t)m * NPAD + C_QI + h * 64 + 4 * jj), w2 = *(const unsigned long long*)(P16 + (size_t)m * NPAD + C_QI + h * 64 + 32 + 4 * jj);
          const float q1[4] = {lo_bf((unsigned)w1), hi_bf((unsigned)w1), lo_bf((unsigned)(w1 >> 32)), hi_bf((unsigned)(w1 >> 32))}, q2[4] = {lo_bf((unsigned)w2), hi_bf((unsigned)w2), lo_bf((unsigned)(w2 >> 32)), hi_bf((unsigned)(w2 >> 32))};
          const float2* c = cs + (size_t)m * 96 + 64 + 4 * jj; const float w = PF[(size_t)m * PFW + 576 + h] * 0.02209708691207961f;
          float r1[4], r2[4], l1[4], l2[4];
#pragma unroll
          for (int i = 0; i < 4; ++i) { const float2 cc = c[i]; r1[i] = q1[i] * cc.x - q2[i] * cc.y; r2[i] = q2[i] * cc.x + q1[i] * cc.y; l1[i] = w * r1[i]; l2[i] = w * r2[i]; }
          *(unsigned long long*)(QS + (size_t)m * 576 + h * 64 + 4 * jj) = (unsigned long long)pk2(r1[0], r1[1]) | ((unsigned long long)pk2(r1[2], r1[3]) << 32);
          *(unsigned long long*)(QS + (size_t)m * 576 + h * 64 + 32 + 4 * jj) = (unsigned long long)pk2(r2[0], r2[1]) | ((unsigned long long)pk2(r2[2], r2[3]) << 32);
#pragma unroll
          for (int i = 0; i < 4; ++i) { l1[i] += __shfl_xor(l1[i], 8); l1[i] += __shfl_xor(l1[i], 16); l1[i] += __shfl_xor(l1[i], 32); l2[i] += __shfl_xor(l2[i], 8); l2[i] += __shfl_xor(l2[i], 16); l2[i] += __shfl_xor(l2[i], 32); }
          if (h == 0) { *(unsigned long long*)(QS + (size_t)m * 576 + 512 + 4 * jj) = (unsigned long long)pk2(l1[0], l1[1]) | ((unsigned long long)pk2(l1[2], l1[3]) << 32);
                        *(unsigned long long*)(QS + (size_t)m * 576 + 512 + 32 + 4 * jj) = (unsigned long long)pk2(l2[0], l2[1]) | ((unsigned long long)pk2(l2[2], l2[3]) << 32);
                        const f32x4 k1 = *(const f32x4*)(PF + (size_t)m * PFW + 512 + 4 * jj), k2 = *(const f32x4*)(PF + (size_t)m * PFW + 512 + 32 + 4 * jj);
                        const float kk1[4] = {k1.x, k1.y, k1.z, k1.w}, kk2[4] = {k2.x, k2.y, k2.z, k2.w}; float o1[4], o2[4];
#pragma unroll
                        for (int i = 0; i < 4; ++i) { const float2 cc = c[i]; o1[i] = kk1[i] * cc.x - kk2[i] * cc.y; o2[i] = kk2[i] * cc.x + kk1[i] * cc.y; }
                        *(unsigned long long*)(KIb + (size_t)m * 64 + 4 * jj) = (unsigned long long)pk2(o1[0], o1[1]) | ((unsigned long long)pk2(o1[2], o1[3]) << 32);
                        *(unsigned long long*)(KIb + (size_t)m * 64 + 32 + 4 * jj) = (unsigned long long)pk2(o2[0], o2[1]) | ((unsigned long long)pk2(o2[2], o2[3]) << 32); }
          if (jj == 0) WP[(size_t)m * 8 + h] = w; } }
    { bf16_t* VT = (bf16_t*)(ws + WS_VT); bf16_t* sT = (bf16_t*)lds;
      for (int t0 = obid() * 8; t0 < (M / 64) * 8; t0 += gridDim.x * 8) {
          u32x4 w[8]; const int row = tid >> 3, seg = tid & 7;
#pragma unroll
          for (int q = 0; q < 8; ++q) { const int tile = t0 + q, tb = tile >> 3, cb = tile & 7; w[q] = *(const u32x4*)(P16 + (size_t)(tb * 64 + row) * NPAD + C_CV + cb * 64 + seg * 8); }
          __syncthreads();
#pragma unroll
          for (int q = 0; q < 8; ++q) { unsigned* d = (unsigned*)(sT + q * 64 * 66 + row * 66 + seg * 8); d[0] = w[q].x; d[1] = w[q].y; d[2] = w[q].z; d[3] = w[q].w; }
          __syncthreads();
          const int ch = tid >> 3, tg = tid & 7;
#pragma unroll
          for (int q = 0; q < 8; ++q) { const int tile = t0 + q, tb = tile >> 3, cb = tile & 7; unsigned short v[8];
#pragma unroll
              for (int i = 0; i < 8; ++i) v[i] = sT[q * 64 * 66 + (tg * 8 + i) * 66 + ch];
              const u32x4 o = {(unsigned)v[0] | ((unsigned)v[1] << 16), (unsigned)v[2] | ((unsigned)v[3] << 16), (unsigned)v[4] | ((unsigned)v[5] << 16), (unsigned)v[6] | ((unsigned)v[7] << 16)};
              *(u32x4*)(VT + ((size_t)((tb >> 7) * 512 + cb * 64 + ch)) * SEQ + (tb & 127) * 64 + tg * 8) = o; } }
      __syncthreads(); }
    { bf16_t* VN = (bf16_t*)(ws + WS_VN); const float* gain = a.gmlp_gain + l * 512;
#pragma unroll 4
      for (int m = gw; m < M; m += ngw) { const u32x4 w = *(const u32x4*)(P16 + (size_t)m * NPAD + C_BV + lane * 8);
          float v[8] = {gelu_t(lo_bf(w.x)), gelu_t(hi_bf(w.x)), gelu_t(lo_bf(w.y)), gelu_t(hi_bf(w.y)), gelu_t(lo_bf(w.z)), gelu_t(hi_bf(w.z)), gelu_t(lo_bf(w.w)), gelu_t(hi_bf(w.w))};
          float sm = 0.f;
#pragma unroll
          for (int j = 0; j < 8; ++j) sm += v[j] * v[j];
          const float r = rsqrtf(wave_sum(sm) * (1.f / 512.f) + EPS);
          const f32x4 g0 = *(const f32x4*)(gain + lane * 8), g1 = *(const f32x4*)(gain + lane * 8 + 4);
          *(u32x4*)(VN + (size_t)m * 512 + lane * 8) = (u32x4){pk2(v[0] * r * g0.x, v[1] * r * g0.y), pk2(v[2] * r * g0.z, v[3] * r * g0.w), pk2(v[4] * r * g1.x, v[5] * r * g1.y), pk2(v[6] * r * g1.z, v[7] * r * g1.w)}; } }
}

constexpr int NHU = BATCH * 128 * 4;
__device__ __forceinline__ void ph_h1(const Args& a, int l, unsigned char* lds, int wv) {
    unsigned char* ws = oport(a.ws);
    const int tid = otid(wv), lane = tid & 63, wave = __builtin_amdgcn_readfirstlane(tid >> 6), j = wave >> 1, d = tid & 127, fr = lane & 15, fq = lane >> 4;
    bf16_t* KT = (bf16_t*)lds;
    bf16_t* VT = KT + 128 * 72;
    float* sT = (float*)(VT + 128 * 72);
    const float* PF = (const float*)(ws + WS_PF); const bf16_t* P16 = (const bf16_t*)(ws + WS_P16); const float* LB = (const float*)(ws + WS_LB) + l * 512;
    float* LL = (float*)(ws + WS_FF); float* DD = (float*)(ws + WS_DD);
    for (int u = obid(); u < NHU; u += gridDim.x) {
        const int h = u & 3, c = (u >> 2) & 127, b = u >> 9; const size_t m0 = (size_t)b * SEQ + c * 64 + j * 16;
        const float lbv = LB[h * 128 + d];
        float cs[16], ky[16]; unsigned vv[16]; float run = 0.f;
#pragma unroll
        for (int i = 0; i < 16; ++i) { const float z = PF[(m0 + i) * PFW + h * 128 + d]; const float sg = sigm(z); run += __logf(lbv + (1.f - lbv) * sg); cs[i] = run; ky[i] = (1.f - lbv) * (1.f - sg);
            vv[i] = P16[(m0 + i) * NPAD + C_AI + h * 128 + d]; }
        sT[j * 128 + d] = run;
        __syncthreads();
        float tail = 0.f;
#pragma unroll
        for (int jj = 1; jj < 4; ++jj) if (jj > j) tail += sT[jj * 128 + d];
        { unsigned w[8], x[8];
#pragma unroll
          for (int i = 0; i < 8; ++i) { w[i] = pk2(ky[2 * i] * __expf(tail + (run - cs[2 * i])), ky[2 * i + 1] * __expf(tail + (run - cs[2 * i + 1]))); x[i] = vv[2 * i] | (vv[2 * i + 1] << 16); }
          u32x4* kp = (u32x4*)(KT + d * 72 + j * 16); kp[0] = (u32x4){w[0], w[1], w[2], w[3]}; kp[1] = (u32x4){w[4], w[5], w[6], w[7]};
          u32x4* vp = (u32x4*)(VT + d * 72 + j * 16); vp[0] = (u32x4){x[0], x[1], x[2], x[3]}; vp[1] = (u32x4){x[4], x[5], x[6], x[7]}; }
        if (j == 0) DD[(size_t)u * 128 + d] = __expf(run + tail);
        __syncthreads();
        { bf16x8 xk[2];
#pragma unroll
          for (int ks = 0; ks < 2; ++ks) xk[ks] = *(const bf16x8*)(KT + (16 * wave + fr) * 72 + ks * 32 + fq * 8);
#pragma unroll
          for (int nt = 0; nt < 8; ++nt) { f32x4 acc = {0.f, 0.f, 0.f, 0.f};
#pragma unroll
              for (int ks = 0; ks < 2; ++ks) { const bf16x8 y = *(const bf16x8*)(VT + (16 * nt + fr) * 72 + ks * 32 + fq * 8); acc = __builtin_amdgcn_mfma_f32_16x16x32_bf16(xk[ks], y, acc, 0, 0, 0); }
              *(f32x4*)(LL + ((size_t)u * 128 + 16 * nt + fr) * 128 + 16 * wave + 4 * fq) = acc; } }
        __syncthreads();
    }
}
__device__ __forceinline__ void ph_h2(const Args& a, int wv) {
    unsigned char* ws = oport(a.ws);
    const float* LL = (const float*)(ws + WS_FF); const float* DD = (const float*)(ws + WS_DD); bf16_t* SB = (bf16_t*)(ws + WS_QF);
    for (int e = obid() * NTHR + otid(wv); e < 8 * 16384; e += gridDim.x * NTHR) { const int bh = e >> 14, b = bh >> 2, h = bh & 3, dvdk = e & 16383, dk = e & 127; float S = 0.f;
#pragma unroll 16
        for (int c = 0; c < 128; ++c) { const size_t u = (size_t)(((b * 128 + c) << 2) + h); SB[u * 16384 + dvdk] = (bf16_t)f2bf(S); S = DD[u * 128 + dk] * S + LL[u * 16384 + dvdk]; } }
}
__device__ __forceinline__ void ph_h3(const Args& a, int l, unsigned char* lds, int wv) {
    unsigned char* ws = oport(a.ws);
    const int tid = otid(wv), lane = tid & 63, wave = __builtin_amdgcn_readfirstlane(tid >> 6), j = wave >> 1, d = tid & 127, fr = lane & 15, fq = lane >> 4;
    bf16_t* QT = (bf16_t*)lds;
    bf16_t* QH = QT + 64 * 136;
    bf16_t* KI = QH + 64 * 136;
    bf16_t* VT = KI + 160 * 136;
    bf16_t* AT = VT + 128 * 72;
    float* sT = (float*)(AT + 64 * 72);
    float* sSS = sT + 512;
    const float* PF = (const float*)(ws + WS_PF); const bf16_t* P16 = (const bf16_t*)(ws + WS_P16); const float* LB = (const float*)(ws + WS_LB) + l * 512;
    const bf16_t* SB = (const bf16_t*)(ws + WS_QF); bf16_t* YA = (bf16_t*)(ws + WS_YALL); const float* gain = a.hgrn_gain + l * 128;
    for (int u = obid(); u < NHU; u += gridDim.x) {
        const int h = u & 3, c = (u >> 2) & 127, b = u >> 9; const size_t mc = (size_t)b * SEQ + c * 64, m0 = mc + j * 16;
        for (int i = tid; i < 64 * 72 * 2 / 16; i += NTHR) ((u32x4*)AT)[i] = (u32x4){0u, 0u, 0u, 0u};
        bf16x8 sbf[4][4];
#pragma unroll
        for (int q4 = 0; q4 < 4; ++q4)
#pragma unroll
            for (int ks = 0; ks < 4; ++ks) sbf[q4][ks] = ((const bf16x8*)(SB + ((size_t)u * 128 + 16 * (4 * (wave >> 2) + q4)) * 128 + 32 * ks))[fr * 16 + fq];
        const float lbv = LB[h * 128 + d];
        float cs[16], ky[16], qf[16]; unsigned vv[16]; float run = 0.f;
#pragma unroll
        for (int i = 0; i < 16; ++i) { const size_t pr = (m0 + i) * NPAD + h * 128 + d; const float z = PF[(m0 + i) * PFW + h * 128 + d]; const float sg = sigm(z); run += __logf(lbv + (1.f - lbv) * sg); cs[i] = run; ky[i] = (1.f - lbv) * (1.f - sg);
            qf[i] = silu(bf2f(P16[pr + C_AQ])) * 0.08838834764831845f; vv[i] = P16[pr + C_AI]; }
        sT[j * 128 + d] = run;
        __syncthreads();
        const float T0 = sT[d], T1 = sT[128 + d], T2 = sT[256 + d];
        const float Bj = (j > 0 ? T0 : 0.f) + (j > 1 ? T1 : 0.f) + (j > 2 ? T2 : 0.f); const float eBj = __expf(Bj);
        float pre[4]; pre[0] = 0.f; pre[1] = (j < 1 ? T0 : 0.f); pre[2] = (j < 1 ? T0 : 0.f) + (j < 2 ? T1 : 0.f); pre[3] = (j < 1 ? T0 : 0.f) + (j < 2 ? T1 : 0.f) + (j < 3 ? T2 : 0.f);
        float epre[4];
#pragma unroll
        for (int I = 0; I < 4; ++I) epre[I] = __expf(pre[I]);
#pragma unroll
        for (int i = 0; i < 16; ++i) { const int t = 16 * j + i; const float ec = __expf(cs[i]), kn = ky[i] * __expf(fminf(-cs[i], 60.f));
            QT[t * 136 + d] = (bf16_t)f2bf(qf[i] * ec); QH[t * 136 + d] = (bf16_t)f2bf(qf[i] * ec * eBj);
#pragma unroll
            for (int I = 0; I < 4; ++I) if (I >= j) KI[(8 * I * (I + 1) + t) * 136 + d] = (bf16_t)f2bf(kn * epre[I]); }
        { unsigned x[8];
#pragma unroll
          for (int i = 0; i < 8; ++i) x[i] = vv[2 * i] | (vv[2 * i + 1] << 16);
          u32x4* vp = (u32x4*)(VT + d * 72 + j * 16); vp[0] = (u32x4){x[0], x[1], x[2], x[3]}; vp[1] = (u32x4){x[4], x[5], x[6], x[7]}; }
        __syncthreads();
        for (int tl = wave; tl < 10; tl += 8) { const int I = tl < 1 ? 0 : tl < 3 ? 1 : tl < 6 ? 2 : 3, J = tl - (I * (I + 1)) / 2; f32x4 acc = {0.f, 0.f, 0.f, 0.f};
#pragma unroll
            for (int ks = 0; ks < 4; ++ks) { const bf16x8 x = *(const bf16x8*)(QT + (16 * I + fr) * 136 + ks * 32 + fq * 8); const bf16x8 y = *(const bf16x8*)(KI + (8 * I * (I + 1) + 16 * J + fr) * 136 + ks * 32 + fq * 8);
                acc = __builtin_amdgcn_mfma_f32_16x16x32_bf16(x, y, acc, 0, 0, 0); }
#pragma unroll
            for (int r = 0; r < 4; ++r) { float v = acc[r]; if (J == I && fr > 4 * fq + r) v = 0.f; AT[(16 * I + 4 * fq + r) * 72 + 16 * J + fr] = (bf16_t)f2bf(v); } }
        __syncthreads();
        const int I = wave & 3, nt0 = 4 * (wave >> 2); f32x4 o[4];
#pragma unroll
        for (int q4 = 0; q4 < 4; ++q4) { const int nt = nt0 + q4; f32x4 acc = {0.f, 0.f, 0.f, 0.f};
            for (int ks = 0; ks <= (I >> 1); ++ks) { const bf16x8 x = *(const bf16x8*)(AT + (16 * I + fr) * 72 + ks * 32 + fq * 8); const bf16x8 y = *(const bf16x8*)(VT + (16 * nt + fr) * 72 + ks * 32 + fq * 8);
                acc = __builtin_amdgcn_mfma_f32_16x16x32_bf16(x, y, acc, 0, 0, 0); }
#pragma unroll
            for (int ks = 0; ks < 4; ++ks) { const bf16x8 x = *(const bf16x8*)(QH + (16 * I + fr) * 136 + ks * 32 + fq * 8); acc = __builtin_amdgcn_mfma_f32_16x16x32_bf16(x, sbf[q4][ks], acc, 0, 0, 0); }
            o[q4] = acc; }
        { float ssq[4];
#pragma unroll
          for (int r = 0; r < 4; ++r) { float s = o[0][r] * o[0][r] + o[1][r] * o[1][r] + o[2][r] * o[2][r] + o[3][r] * o[3][r]; s += __shfl_xor(s, 1); s += __shfl_xor(s, 2); s += __shfl_xor(s, 4); s += __shfl_xor(s, 8); ssq[r] = s; }
          if (fr == 0) {
#pragma unroll
              for (int r = 0; r < 4; ++r) sSS[(16 * I + 4 * fq + r) * 2 + (wave >> 2)] = ssq[r]; } }
        __syncthreads();
#pragma unroll
        for (int r = 0; r < 4; ++r) { const int tt = 16 * I + 4 * fq + r; const float rinv = rsqrtf((sSS[tt * 2] + sSS[tt * 2 + 1]) * (1.f / 128.f) + EPS); const size_t m = mc + tt;
#pragma unroll
            for (int q4 = 0; q4 < 4; ++q4) { const int dv = 16 * (nt0 + q4) + fr; const float g = bf2f(P16[m * NPAD + C_AG + h * 128 + dv]);
                YA[m * 512 + h * 128 + dv] = (bf16_t)f2bf(o[q4][r] * rinv * gain[dv] * silu(g)); } }
        __syncthreads();
    }
}
__device__ __forceinline__ void ph_gmlp(const Args& a, int l, unsigned char* lds, int wv) {
    unsigned char* ws = oport(a.ws);
    const int tid = otid(wv), lane = tid & 63, wave = __builtin_amdgcn_readfirstlane(tid >> 6), fr = lane & 15, fq = lane >> 4;
    const bf16_t* P16 = (const bf16_t*)(ws + WS_P16); const bf16_t* VN = (const bf16_t*)(ws + WS_VN); bf16_t* YB = (bf16_t*)(ws + WS_YALL) + (size_t)M * 512;
    const bf16_t* WSB = (const bf16_t*)(ws + WS_WSB) + (size_t)l * 4 * 128 * 128; const float* bs = a.gmlp_bs + (size_t)l * 4 * 128;
    bf16_t* VNt = (bf16_t*)lds;
    for (int u = obid(); u < (M / 128) * 4; u += gridDim.x) { const int g = u & 3, nb = u >> 2; const size_t mb = (size_t)nb * 128;
        __syncthreads();
#pragma unroll
        for (int n = 0; n < 4; ++n) { const int idx = tid + NTHR * n, row = idx >> 4, seg = idx & 15; const u32x4 w = *(const u32x4*)(VN + (mb + row) * 512 + g * 128 + seg * 8);
            bf16_t* d = VNt + (seg * 8) * 136 + row;
            d[0 * 136] = (bf16_t)(w.x & 0xffffu); d[1 * 136] = (bf16_t)(w.x >> 16); d[2 * 136] = (bf16_t)(w.y & 0xffffu); d[3 * 136] = (bf16_t)(w.y >> 16);
            d[4 * 136] = (bf16_t)(w.z & 0xffffu); d[5 * 136] = (bf16_t)(w.z >> 16); d[6 * 136] = (bf16_t)(w.w & 0xffffu); d[7 * 136] = (bf16_t)(w.w >> 16); }
        bf16x8 wf[4];
#pragma unroll
        for (int ks = 0; ks < 4; ++ks) wf[ks] = *(const bf16x8*)(WSB + ((size_t)g * 128 + 16 * wave + fr) * 128 + 32 * ks + 8 * fq);
        __syncthreads();
        const int t = 16 * wave + fr; const float bias = bs[g * 128 + t]; const int nks = (wave >> 1) + 1;
        unsigned long long uwv[8];
#pragma unroll
        for (int ct = 0; ct < 8; ++ct) uwv[ct] = *(const unsigned long long*)(P16 + (mb + t) * NPAD + C_BU + g * 128 + 16 * ct + 4 * fq);
#pragma unroll
        for (int ct = 0; ct < 8; ++ct) { f32x4 acc = {0.f, 0.f, 0.f, 0.f};
#pragma unroll
            for (int ks = 0; ks < 4; ++ks) if (ks < nks) { const bf16x8 x = *(const bf16x8*)(VNt + (16 * ct + fr) * 136 + 32 * ks + 8 * fq); acc = __builtin_amdgcn_mfma_f32_16x16x32_bf16(x, wf[ks], acc, 0, 0, 0); }
            const size_t m = mb + t; const int c = g * 128 + 16 * ct + 4 * fq; const unsigned long long uw = uwv[ct];
            const float o0 = gelu_t(lo_bf((unsigned)uw)) * (acc[0] + bias), o1 = gelu_t(hi_bf((unsigned)uw)) * (acc[1] + bias), o2 = gelu_t(lo_bf((unsigned)(uw >> 32))) * (acc[2] + bias), o3 = gelu_t(hi_bf((unsigned)(uw >> 32))) * (acc[3] + bias);
            *(unsigned long long*)(YB + m * 512 + c) = (unsigned long long)pk2(o0, o1) | ((unsigned long long)pk2(o2, o3) << 32); }
    }
}
constexpr int SEL_CAP = 256;
__device__ __forceinline__ int sel_bin(float s, float lo, float sc) { return (int)__builtin_amdgcn_fmed3f((s - lo) * sc, 0.f, 1023.f); }
struct SelQ { float lo1, sc1, lo2, sc2, tau; int b1, b2, ref, tidx; };
__device__ __forceinline__ void sel_pass(const int mode, const bf16x8 (&qf)[9][2], const float (&wp)[8], const SelQ& sq, const bf16_t* kib, int c, int kp, int qloc, int fr, int fq,
                                         unsigned* sHist, unsigned* sCand, unsigned* sCnt, unsigned* maskrow) {
    bf16x8 af[4][2];
    { const int T0 = kp <= c ? kp : c;
#pragma unroll
      for (int rg = 0; rg < 4; ++rg)
#pragma unroll
          for (int ks = 0; ks < 2; ++ks) af[rg][ks] = ((const bf16x8*)(kib + (size_t)(64 * T0 + 16 * rg) * 64 + 32 * ks))[fr * 8 + fq]; }
#pragma unroll 1
    for (int T = kp; T <= c; T += 4) {
        const int Tn = (T + 4 <= c) ? T + 4 : T;
        unsigned mlo = 0u, mhi = 0u;
#pragma unroll
        for (int rg = 0; rg < 4; ++rg) {
            f32x4 sc = __builtin_amdgcn_mfma_f32_16x16x32_bf16(af[rg][0], qf[8][0], (f32x4){0.f, 0.f, 0.f, 0.f}, 0, 0, 0);
            sc = __builtin_amdgcn_mfma_f32_16x16x32_bf16(af[rg][1], qf[8][1], sc, 0, 0, 0);
#pragma unroll
            for (int h = 0; h < 8; ++h) { f32x4 ah = __builtin_amdgcn_mfma_f32_16x16x32_bf16(af[rg][0], qf[h][0], (f32x4){0.f, 0.f, 0.f, 0.f}, 0, 0, 0);
                ah = __builtin_amdgcn_mfma_f32_16x16x32_bf16(af[rg][1], qf[h][1], ah, 0, 0, 0);
#pragma unroll
                for (int r = 0; r < 4; ++r) sc[r] += wp[h] * __builtin_fabsf(ah[r]); }
#pragma unroll
            for (int ks = 0; ks < 2; ++ks) af[rg][ks] = ((const bf16x8*)(kib + (size_t)(64 * Tn + 16 * rg) * 64 + 32 * ks))[fr * 8 + fq];
            if (mode == 0) {
#pragma unroll
                for (int r = 0; r < 4; ++r) { const int b = sel_bin(sc[r], sq.lo1, sq.sc1); __hip_atomic_fetch_add(sHist + qloc * 512 + (b >> 1), 1u << ((b & 1) * 16), __ATOMIC_RELAXED, __HIP_MEMORY_SCOPE_WORKGROUP); }
            } else if (mode == 1) {
                if (sq.ref) {
#pragma unroll
                    for (int r = 0; r < 4; ++r) if (sel_bin(sc[r], sq.lo1, sq.sc1) == sq.b1) { const int b = sel_bin(sc[r], sq.lo2, sq.sc2); __hip_atomic_fetch_add(sHist + qloc * 512 + (b >> 1), 1u << ((b & 1) * 16), __ATOMIC_RELAXED, __HIP_MEMORY_SCOPE_WORKGROUP); } }
            } else {
                int b[4]; unsigned bits = 0u; bool anyc = false;
#pragma unroll
                for (int r = 0; r < 4; ++r) { b[r] = sel_bin(sc[r], sq.lo1, sq.sc1); bits |= (b[r] > sq.b1) ? (1u << r) : 0u; anyc |= (b[r] == sq.b1); }
                if (anyc) {
#pragma unroll
                    for (int r = 0; r < 4; ++r) if (b[r] == sq.b1) { bool cand = true;
                        if (sq.ref) { const int b2 = sel_bin(sc[r], sq.lo2, sq.sc2); if (b2 > sq.b2) bits |= 1u << r; cand = b2 == sq.b2; }
                        if (cand) { const unsigned slot = __hip_atomic_fetch_add(sCnt + qloc, 1u, __ATOMIC_RELAXED, __HIP_MEMORY_SCOPE_WORKGROUP);
                            if (slot < (unsigned)SEL_CAP) { sCand[(qloc * SEL_CAP + slot) * 2] = __float_as_uint(sc[r]); sCand[(qloc * SEL_CAP + slot) * 2 + 1] = (unsigned)(64 * T + 16 * rg + 4 * fq + r); } } } }
                bits <<= (16 * (rg & 1)) + 4 * fq; if (rg < 2) mlo |= bits; else mhi |= bits;
            }
            __builtin_amdgcn_sched_barrier(0);
        }
        if (mode == 2) { mlo |= __shfl_xor(mlo, 16); mlo |= __shfl_xor(mlo, 32); mhi |= __shfl_xor(mhi, 16); mhi |= __shfl_xor(mhi, 32);
            if (fq == 0) *(uint2*)(maskrow + 2 * T) = make_uint2(mlo, mhi); }
    }
}
__device__ __forceinline__ void sel_scan(const unsigned* hist, unsigned need, int lane, int& bsel, unsigned& nneed, unsigned& cnt) {
    unsigned c16[16]; unsigned tot = 0u;
#pragma unroll
    for (int i = 0; i < 8; ++i) { const unsigned w = hist[512 - 8 * (lane + 1) + i]; c16[2 * i] = w & 0xffffu; c16[2 * i + 1] = w >> 16; tot += (w & 0xffffu) + (w >> 16); }
    unsigned inc = tot;
#pragma unroll
    for (int o = 1; o < 64; o <<= 1) { const unsigned t2 = __shfl_up(inc, o); if (lane >= o) inc += t2; }
    const unsigned long long bal = __ballot(inc >= need);
    const int L = bal ? (__ffsll((long long)bal) - 1) : 63;
    unsigned above = __shfl(inc - tot, L); int bs = 0; unsigned nn = 1u, cc = 0u; bool found = false;
#pragma unroll
    for (int j = 0; j < 16; ++j) { const unsigned hcnt = __shfl(c16[15 - j], L); if (!found) { if (above + hcnt >= need) { found = true; bs = 1024 - 16 * L - 1 - j; nn = need - above; cc = hcnt; } else above += hcnt; } }
    bsel = bs; nneed = nn; cnt = cc;
}
__device__ __forceinline__ void ph_sel(const Args& a, unsigned char* lds, int wv) {
    unsigned char* ws = oport(a.ws);
    const int tid = otid(wv), lane = tid & 63, wave = __builtin_amdgcn_readfirstlane(tid >> 6), gq = wave & 1, kp = wave >> 1, fr = lane & 15, fq = lane >> 4, qloc = 16 * gq + fr;
    unsigned* sHist = (unsigned*)lds;
    unsigned* sCand = (unsigned*)(lds + 65536);
    float* sLo1 = (float*)(lds + 131072); float* sSc1 = sLo1 + 32; float* sLo2 = sSc1 + 32; float* sSc2 = sLo2 + 32; float* sTau = sSc2 + 32;
    int* sB1 = (int*)(sTau + 32); int* sB2 = sB1 + 32; int* sRef = sB2 + 32; int* sTidx = sRef + 32; unsigned* sNeed = (unsigned*)(sTidx + 32); unsigned* sCnt = sNeed + 32; int* sAny = (int*)(sCnt + 32);
    const bf16_t* QS = (const bf16_t*)(ws + WS_QI); const bf16_t* KIb = (const bf16_t*)(ws + WS_KI); const float* WP = (const float*)(ws + WS_WI); unsigned* MASKB = (unsigned*)(ws + WS_MASK);
    for (int pi = obid(); pi < 256; pi += gridDim.x) {
#pragma unroll 1
      for (int which = 0; which < 2; ++which) {
        const int b = pi & 1, half = (pi >> 1) & 1, cc = pi >> 2, c = which ? cc : 127 - cc;
        const size_t mq = (size_t)b * SEQ + 64 * c + 32 * half;
        const bf16_t* kib = KIb + (size_t)b * SEQ * 64;
        __syncthreads();
        if (tid < 32) { const float* w = WP + (mq + tid) * 8; float s1 = 0.f, s2 = 0.f;
#pragma unroll
            for (int h = 0; h < 8; ++h) { s1 += w[h]; s2 += w[h] * w[h]; }
            const float sd = 9.34f * sqrtf(fmaxf(s2, 1e-30f)); sLo1[tid] = 6.38f * s1 - 8.f * sd; sSc1[tid] = 1024.f / (16.f * sd);
            sLo2[tid] = 0.f; sSc2[tid] = 1.f; sB1[tid] = 0; sB2[tid] = 0; sRef[tid] = 0; sNeed[tid] = 256u; sCnt[tid] = 0u; sTau[tid] = -INFINITY; sTidx[tid] = 0x7fffffff; }
        if (tid == 0) sAny[0] = 0;
        for (int i = tid; i < 32 * 512 / 4; i += NTHR) ((u32x4*)sHist)[i] = (u32x4){0u, 0u, 0u, 0u};
        bf16x8 qf[9][2]; float wp[8];
        { const bf16_t* qrow = QS + (mq + qloc) * 576;
#pragma unroll
          for (int h = 0; h < 9; ++h)
#pragma unroll
              for (int ks = 0; ks < 2; ++ks) qf[h][ks] = *(const bf16x8*)(qrow + h * 64 + 32 * ks + 8 * fq);
#pragma unroll
          for (int h = 0; h < 8; ++h) wp[h] = WP[(mq + qloc) * 8 + h]; }
        __syncthreads();
        unsigned* maskrow = MASKB + (mq + qloc) * 256;
        if (c < 4) {
            if (tid < 32) for (int T = 0; T <= c; ++T) *(uint2*)(MASKB + (mq + tid) * 256 + 2 * T) = make_uint2(0xFFFFFFFFu, 0xFFFFFFFFu);
        } else {
#pragma unroll 1
            for (int pass = 0; pass < 3; ++pass) {
                if (pass == 1) { if (!sAny[0]) continue; __syncthreads(); for (int i = tid; i < 32 * 512 / 4; i += NTHR) ((u32x4*)sHist)[i] = (u32x4){0u, 0u, 0u, 0u}; __syncthreads(); }
                SelQ sq; sq.lo1 = sLo1[qloc]; sq.sc1 = sSc1[qloc]; sq.lo2 = sLo2[qloc]; sq.sc2 = sSc2[qloc]; sq.b1 = sB1[qloc]; sq.b2 = sB2[qloc]; sq.ref = sRef[qloc]; sq.tau = 0.f; sq.tidx = 0;
                sel_pass(pass, qf, wp, sq, kib, c, kp, qloc, fr, fq, sHist, sCand, sCnt, maskrow);
                asm volatile("s_waitcnt vmcnt(0)" ::: "memory");
                __syncthreads();
                if (pass < 2) {
                    for (int qq = wave * 4; qq < wave * 4 + 4; ++qq) if (pass == 0 || sRef[qq]) { int bs; unsigned nn, cn; sel_scan(sHist + qq * 512, sNeed[qq], lane, bs, nn, cn);
                        if (lane == 0) { sNeed[qq] = nn; if (pass == 0) { sB1[qq] = bs; if (cn > (unsigned)SEL_CAP) { sRef[qq] = 1; sLo2[qq] = sLo1[qq] + (float)bs / sSc1[qq]; sSc2[qq] = sSc1[qq] * 1024.f; sAny[0] = 1; } } else sB2[qq] = bs; } }
                    __syncthreads(); }
            }
            unsigned* sOff = (unsigned*)sAny + 4;
            if (tid < 64) { unsigned n = 0u; if (tid < 32) n = sCnt[tid] < (unsigned)SEL_CAP ? sCnt[tid] : (unsigned)SEL_CAP; unsigned inc = n;
#pragma unroll
                for (int o = 1; o < 32; o <<= 1) { const unsigned t2 = __shfl_up(inc, o); if (lane >= o) inc += t2; }
                if (tid < 32) { sOff[tid] = inc - n; if (tid == 31) sOff[32] = inc; } }
            __syncthreads();
            { const unsigned total = sOff[32];
              for (unsigned p = tid; p < total; p += NTHR) { int qq = 0;
#pragma unroll
                  for (int st = 16; st >= 1; st >>= 1) if (sOff[qq + st] <= p) qq += st;
                  const unsigned i = p - sOff[qq], n = sOff[qq + 1] - sOff[qq], want = sNeed[qq] - 1u;
                  const float si = __uint_as_float(sCand[(qq * SEL_CAP + i) * 2]); const unsigned ki = sCand[(qq * SEL_CAP + i) * 2 + 1]; unsigned rank = 0u;
                  for (unsigned j = 0; j < n; ++j) { const float sj = __uint_as_float(sCand[(qq * SEL_CAP + j) * 2]); const unsigned kj = sCand[(qq * SEL_CAP + j) * 2 + 1]; rank += (sj > si || (sj == si && kj < ki)) ? 1u : 0u; }
                  if (rank <= want) atomicOr(MASKB + (mq + qq) * 256 + (ki >> 5), 1u << (ki & 31u)); } }
        }
      }
    }
}

__device__ __forceinline__ void ph_attn(const Args& a, unsigned char* lds, int wv) {
    unsigned char* ws = oport(a.ws);
    const int tid = otid(wv), lane = tid & 63, wave = __builtin_amdgcn_readfirstlane(tid >> 6), g4 = wave & 3, par = wave >> 2, fr = lane & 15, fq = lane >> 4;
    const bf16_t* QR = (const bf16_t*)(ws + WS_QR); const bf16_t* KR = (const bf16_t*)(ws + WS_KR); const bf16_t* VT = (const bf16_t*)(ws + WS_VT); const unsigned* MASKB = (const unsigned*)(ws + WS_MASK);
    bf16_t* Kt = (bf16_t*)lds;
    bf16_t* Vt = Kt + 2 * 64 * 136;
    float* sMrg = (float*)lds;
    for (int pi = obid(); pi < 256; pi += gridDim.x) {
#pragma unroll 1
      for (int which = 0; which < 2; ++which) {
        const int bh = pi & 7, b = bh >> 2, h = bh & 3, cc = pi >> 3, qb = which ? cc : 63 - cc;
        const size_t m0 = (size_t)b * SEQ + 128 * qb + 32 * g4;
        const int mych = 2 * qb + (g4 >> 1);
        bf16x8 qf[2][4];
#pragma unroll
        for (int cg = 0; cg < 2; ++cg)
#pragma unroll
            for (int ks = 0; ks < 4; ++ks) qf[cg][ks] = *(const bf16x8*)(QR + (m0 + 16 * cg + fr) * 512 + h * 128 + 32 * ks + 8 * fq);
        f32x4 O[2][8], Lacc[2]; float mrun[2];
        const bf16x8 xones = (fr == 0) ? (bf16x8){0x3f80, 0x3f80, 0x3f80, 0x3f80, 0x3f80, 0x3f80, 0x3f80, 0x3f80} : (bf16x8){0, 0, 0, 0, 0, 0, 0, 0};
#pragma unroll
        for (int cg = 0; cg < 2; ++cg) { mrun[cg] = 0.f; Lacc[cg] = (f32x4){0.f, 0.f, 0.f, 0.f};
#pragma unroll
            for (int vt = 0; vt < 8; ++vt) O[cg][vt] = (f32x4){0.f, 0.f, 0.f, 0.f}; }
        const bf16_t* kbase = KR + (size_t)b * SEQ * 512 + h * 128; const bf16_t* vbase = VT + (size_t)(b * 512 + h * 128) * SEQ;
        unsigned doff[9];
#pragma unroll
        for (int k = 0; k < 9; ++k) { const int i_ = (wave + NWAVE * k < 70) ? wave + NWAVE * k : 69, slot = 64 * i_ + lane;
            if (slot < 2176) { const int tl = slot >= 1088 ? 1 : 0, rs = slot - 1088 * tl, row = rs / 17, seg = rs - 17 * row; doff[k] = 2u * (unsigned)((64 * tl + row) * 512 + ((seg < 16) ? (seg ^ ((row & 16) >> 2)) : 0) * 8); }
            else { const int s2 = slot - 2176, tl = s2 >= 1152 ? 1 : 0, rs = s2 - 1152 * tl, row = rs / 9, seg = rs - 9 * row; doff[k] = 2u * (unsigned)(row * SEQ + 64 * tl + (seg & 7) * 8); } }
#define ATT_DMA(jj, buf) do { const bf16_t* kb_ = kbase + (size_t)(jj) * 128 * 512; const bf16_t* vb_ = vbase + (size_t)(jj) * 128; \
            _Pragma("unroll") for (int k = 0; k < 9; ++k) { const int i_ = (wave + NWAVE * k < 70) ? wave + NWAVE * k : 69; unsigned d_ = doff[k]; asm volatile("" : "+v"(d_)); const unsigned char* src = (const unsigned char*)(k < 4 ? kb_ : k > 4 ? vb_ : wave < 2 ? kb_ : vb_) + d_; \
                __builtin_amdgcn_global_load_lds((const unsigned*)src, (LAS unsigned*)(LAS unsigned char*)(lds + (buf) * 71680 + i_ * 1024), 16, 0, 0); } } while (0)
        __syncthreads();
        ATT_DMA(0, 0);
        asm volatile("s_waitcnt vmcnt(0)" ::: "memory");
        __syncthreads();
        for (int j = 0; j <= qb; ++j) {
            const int T = 2 * j + par;
            unsigned long long mw64[2];
#pragma unroll
            for (int cg = 0; cg < 2; ++cg) asm volatile("global_load_dwordx2 %0, %1, off" : "=v"(mw64[cg]) : "v"(MASKB + (m0 + 16 * cg + fr) * 256 + 2 * T) : "memory");
            const bf16_t* Ktb = Kt + (j & 1) * 35840; const bf16_t* Vtb = Vt + (j & 1) * 35840;
            const bool act = T <= mych;
            f32x4 S[2][4]; bf16x8 vf[2][4];
            if (act) {
                const bf16_t* kt = Ktb + par * 64 * 136; const bf16_t* vtl = Vtb + par * 128 * 72;
                bf16x8 kf[2][4];
#define ATT_LDK(bf_, rg_) do { const int krow = 32 * ((rg_) >> 1) + 8 * (fr >> 2) + 4 * ((rg_) & 1) + (fr & 3); \
                    _Pragma("unroll") for (int ks = 0; ks < 4; ++ks) kf[bf_][ks] = *(const bf16x8*)(kt + krow * 136 + ((4 * ks + fq) ^ ((krow & 16) >> 2)) * 8); } while (0)
                ATT_LDK(0, 0);
#pragma unroll
                for (int rg = 0; rg < 4; ++rg) { S[0][rg] = (f32x4){-mrun[0], -mrun[0], -mrun[0], -mrun[0]}; S[1][rg] = (f32x4){-mrun[1], -mrun[1], -mrun[1], -mrun[1]};
                    if (rg < 3) ATT_LDK((rg + 1) & 1, rg + 1);
                    __builtin_amdgcn_sched_barrier(0);
#pragma unroll
                    for (int ks = 0; ks < 4; ++ks) { S[0][rg] = __builtin_amdgcn_mfma_f32_16x16x32_bf16(kf[rg & 1][ks], qf[0][ks], S[0][rg], 0, 0, 0); S[1][rg] = __builtin_amdgcn_mfma_f32_16x16x32_bf16(kf[rg & 1][ks], qf[1][ks], S[1][rg], 0, 0, 0); }
                    __builtin_amdgcn_sched_barrier(0); }
#undef ATT_LDK
#define ATT_LDV(bf_, g_) do { _Pragma("unroll") for (int i_ = 0; i_ < 2; ++i_) _Pragma("unroll") for (int k2 = 0; k2 < 2; ++k2) vf[bf_][2 * i_ + k2] = *(const bf16x8*)(vtl + (16 * (2 * (g_) + i_) + fr) * 72 + 32 * k2 + 8 * fq); } while (0)
                ATT_LDV(0, 0);
                __builtin_amdgcn_sched_barrier(0);
                asm volatile("s_waitcnt vmcnt(0)" : "+v"(mw64[0]), "+v"(mw64[1]) :: "memory");
            }
            ATT_DMA(j + 1, (j + 1) & 1);
            __builtin_amdgcn_sched_barrier(0);
            if (act) {
                const bf16_t* vtl = Vtb + par * 128 * 72;
                const uint2 mw[2] = {make_uint2((unsigned)mw64[0], (unsigned)(mw64[0] >> 32)), make_uint2((unsigned)mw64[1], (unsigned)(mw64[1] >> 32))};
                bf16x8 pf[2][2];
#pragma unroll
                for (int cg = 0; cg < 2; ++cg) {
                    float mx = fmaxf(fmaxf(fmaxf(S[cg][0][0], S[cg][0][1]), fmaxf(S[cg][0][2], S[cg][0][3])), fmaxf(fmaxf(S[cg][1][0], S[cg][1][1]), fmaxf(S[cg][1][2], S[cg][1][3])));
                    mx = fmaxf(mx, fmaxf(fmaxf(fmaxf(S[cg][2][0], S[cg][2][1]), fmaxf(S[cg][2][2], S[cg][2][3])), fmaxf(fmaxf(S[cg][3][0], S[cg][3][1]), fmaxf(S[cg][3][2], S[cg][3][3]))));
                    mx = fmaxf(mx, __shfl_xor(mx, 16)); mx = fmaxf(mx, __shfl_xor(mx, 32));
                    const float dlt = fmaxf(mx, 0.f);
                    const int m16 = (int)(((mw[cg].x >> (8 * fq)) & 0xFFu) | (((mw[cg].y >> (8 * fq)) & 0xFFu) << 8));
                    if (__builtin_amdgcn_ballot_w64(dlt != 0.f) != 0ull) {
                        mrun[cg] += dlt; const float alpha = __builtin_amdgcn_exp2f(-dlt);
#pragma unroll
                        for (int rg = 0; rg < 4; ++rg)
#pragma unroll
                            for (int r = 0; r < 4; ++r) S[cg][rg][r] -= dlt;
#pragma unroll
                        for (int vt = 0; vt < 8; ++vt) O[cg][vt] = O[cg][vt] * alpha;
                        Lacc[cg] = Lacc[cg] * alpha; }
#pragma unroll
                    for (int rg = 0; rg < 4; ++rg)
#pragma unroll
                        for (int r = 0; r < 4; ++r) S[cg][rg][r] = __int_as_float(__float_as_int(__builtin_amdgcn_exp2f(S[cg][rg][r])) & __builtin_amdgcn_sbfe(m16, 4 * rg + r, 1));
#pragma unroll
                    for (int k2 = 0; k2 < 2; ++k2) { const u32x4 w = {pg8::cvt_pk_bf16(S[cg][2 * k2][0], S[cg][2 * k2][1]), pg8::cvt_pk_bf16(S[cg][2 * k2][2], S[cg][2 * k2][3]), pg8::cvt_pk_bf16(S[cg][2 * k2 + 1][0], S[cg][2 * k2 + 1][1]), pg8::cvt_pk_bf16(S[cg][2 * k2 + 1][2], S[cg][2 * k2 + 1][3])};
                        pf[cg][k2] = __builtin_bit_cast(bf16x8, w); }
                    Lacc[cg] = __builtin_amdgcn_mfma_f32_16x16x32_bf16(xones, pf[cg][0], Lacc[cg], 0, 0, 0); Lacc[cg] = __builtin_amdgcn_mfma_f32_16x16x32_bf16(xones, pf[cg][1], Lacc[cg], 0, 0, 0);
                }
#pragma unroll
                for (int g = 0; g < 4; ++g) {
                    if (g < 3) ATT_LDV((g + 1) & 1, g + 1);
                    __builtin_amdgcn_sched_barrier(0);
#pragma unroll
                    for (int i_ = 0; i_ < 2; ++i_)
#pragma unroll
                        for (int k2 = 0; k2 < 2; ++k2) { const int vt = 2 * g + i_;
                            O[0][vt] = __builtin_amdgcn_mfma_f32_16x16x32_bf16(vf[g & 1][2 * i_ + k2], pf[0][k2], O[0][vt], 0, 0, 0); O[1][vt] = __builtin_amdgcn_mfma_f32_16x16x32_bf16(vf[g & 1][2 * i_ + k2], pf[1][k2], O[1][vt], 0, 0, 0); }
                    __builtin_amdgcn_sched_barrier(0); }
#undef ATT_LDV
            }
            asm volatile("s_waitcnt vmcnt(0)" ::: "memory");
            __syncthreads();
        }
#undef ATT_DMA
        const float lrun[2] = {Lacc[0][0], Lacc[1][0]};
        float* mb = sMrg + (size_t)g4 * 68 * 64 + lane;
        if (par == 1) {
#pragma unroll
            for (int cg = 0; cg < 2; ++cg) { mb[(cg * 2 + 0) * 64] = mrun[cg]; mb[(cg * 2 + 1) * 64] = lrun[cg];
#pragma unroll
                for (int vt = 0; vt < 8; ++vt)
#pragma unroll
                    for (int r = 0; r < 4; ++r) mb[(4 + (cg * 8 + vt) * 4 + r) * 64] = O[cg][vt][r]; } }
        __syncthreads();
        if (par == 0) {
            bf16_t* YC = (bf16_t*)(oport(ws) + WS_YALL) + (size_t)2 * M * 512;
#pragma unroll
            for (int cg = 0; cg < 2; ++cg) { const float m1 = mb[(cg * 2 + 0) * 64], l1 = mb[(cg * 2 + 1) * 64]; const float mm = fmaxf(mrun[cg], m1), a0 = __builtin_amdgcn_exp2f(mrun[cg] - mm), a1 = __builtin_amdgcn_exp2f(m1 - mm);
                float lt = lrun[cg] * a0 + l1 * a1; lt += __shfl_xor(lt, 16); lt += __shfl_xor(lt, 32); const float inv = 1.f / lt;
#pragma unroll
                for (int vt = 0; vt < 8; ++vt) { float o[4];
#pragma unroll
                    for (int r = 0; r < 4; ++r) o[r] = (O[cg][vt][r] * a0 + mb[(4 + (cg * 8 + vt) * 4 + r) * 64] * a1) * inv;
                    *(unsigned long long*)(YC + (m0 + 16 * cg + fr) * 512 + h * 128 + 16 * vt + 4 * fq) = (unsigned long long)pk2(o[0], o[1]) | ((unsigned long long)pk2(o[2], o[3]) << 32); } } }
      }
    }
}
__device__ __forceinline__ void ph_norm2(const Args& a, int l, int wv) {
    const int tid = otid(wv), lane = tid & 63, gw = obid() * NWAVE + (tid >> 6), ngw = gridDim.x * NWAVE;
    unsigned char* ws = oport(a.ws);
#pragma unroll 2
    for (int m = gw; m < M; m += ngw) rms_row_to_bf16(a.out + (size_t)m * D, a.norm2 + l * D, (bf16_t*)(ws + WS_H16) + (size_t)m * D, lane);
    { const f32x4* U = (const f32x4*)(a.peer_u + (size_t)l * NEXP * D); const f32x4* V = (const f32x4*)(a.peer_v + (size_t)l * NEXP * D); uint2* U4 = (uint2*)(ws + WS_U16); uint2* V4 = (uint2*)(ws + WS_V16);
      float* RSU = (float*)(ws + WS_RS); float* RSV = RSU + NEXP;
#pragma unroll 2
      for (size_t i = (size_t)obid() * NTHR + tid; i < (size_t)NEXP * D / 16; i += (size_t)gridDim.x * NTHR) { f32x4 u[4], v[4]; float su = 0.f, sv = 0.f;
#pragma unroll
          for (int q = 0; q < 4; ++q) { u[q] = U[4 * i + q]; v[q] = V[4 * i + q]; su += (u[q].x * u[q].x + u[q].y * u[q].y) + (u[q].z * u[q].z + u[q].w * u[q].w); sv += (v[q].x * v[q].x + v[q].y * v[q].y) + (v[q].z * v[q].z + v[q].w * v[q].w); }
          const float ru = fmaxf(sqrtf(wave_sum(su) * (1.f / D)), 1e-30f), rv = fmaxf(sqrtf(wave_sum(sv) * (1.f / D)), 1e-30f), ku = 1.f / (0.3352f * ru), kv = 2.f / rv;
          unsigned wu[2] = {0u, 0u}, wq[2] = {0u, 0u};
#pragma unroll
          for (int q = 3; q >= 0; --q) { const float ue[4] = {u[q].x, u[q].y, u[q].z, u[q].w};
#pragma unroll
              for (int e = 3; e >= 0; --e) { const int qi = (int)__builtin_amdgcn_fmed3f(__builtin_rintf(ue[e] * ku), -8.f, 7.f); wu[q >> 1] = (wu[q >> 1] << 4) | ((unsigned)qi & 15u); } }
#pragma unroll
          for (int q = 0; q < 4; ++q) {
              if (q & 1) { wq[q >> 1] = __builtin_amdgcn_cvt_scalef32_pk_fp4_f32(wq[q >> 1], v[q].x * kv, v[q].y * kv, 1.f, 2); wq[q >> 1] = __builtin_amdgcn_cvt_scalef32_pk_fp4_f32(wq[q >> 1], v[q].z * kv, v[q].w * kv, 1.f, 3); }
              else       { wq[q >> 1] = __builtin_amdgcn_cvt_scalef32_pk_fp4_f32(wq[q >> 1], v[q].x * kv, v[q].y * kv, 1.f, 0); wq[q >> 1] = __builtin_amdgcn_cvt_scalef32_pk_fp4_f32(wq[q >> 1], v[q].z * kv, v[q].w * kv, 1.f, 1); } }
          U4[i] = make_uint2(wu[0], wu[1]); V4[i] = make_uint2(wq[0], wq[1]);
          if (lane == 0) { RSU[i >> 6] = 0.3352f * ru; RSV[i >> 6] = 0.5f * rv; } } }
}
#define CE_(a_, b_) do { const float hi_ = fmaxf(a_, b_), lo_ = fminf(a_, b_); a_ = hi_; b_ = lo_; } while (0)
#define SORT16D(x) do { CE_(x[0], x[1]); CE_(x[3], x[2]); CE_(x[4], x[5]); CE_(x[7], x[6]); CE_(x[8], x[9]); CE_(x[11], x[10]); CE_(x[12], x[13]); CE_(x[15], x[14]); CE_(x[0], x[2]); CE_(x[1], x[3]); CE_(x[6], x[4]); CE_(x[7], x[5]); CE_(x[8], x[10]); CE_(x[9], x[11]); CE_(x[14], x[12]); CE_(x[15], x[13]); CE_(x[0], x[1]); CE_(x[2], x[3]); CE_(x[5], x[4]); CE_(x[7], x[6]); CE_(x[8], x[9]); CE_(x[10], x[11]); CE_(x[13], x[12]); CE_(x[15], x[14]); CE_(x[0], x[4]); CE_(x[1], x[5]); CE_(x[2], x[6]); CE_(x[3], x[7]); CE_(x[12], x[8]); CE_(x[13], x[9]); CE_(x[14], x[10]); CE_(x[15], x[11]); CE_(x[0], x[2]); CE_(x[1], x[3]); CE_(x[4], x[6]); CE_(x[5], x[7]); CE_(x[10], x[8]); CE_(x[11], x[9]); CE_(x[14], x[12]); CE_(x[15], x[13]); CE_(x[0], x[1]); CE_(x[2], x[3]); CE_(x[4], x[5]); CE_(x[6], x[7]); CE_(x[9], x[8]); CE_(x[11], x[10]); CE_(x[13], x[12]); CE_(x[15], x[14]); CE_(x[0], x[8]); CE_(x[1], x[9]); CE_(x[2], x[10]); CE_(x[3], x[11]); CE_(x[4], x[12]); CE_(x[5], x[13]); CE_(x[6], x[14]); CE_(x[7], x[15]); CE_(x[0], x[4]); CE_(x[1], x[5]); CE_(x[2], x[6]); CE_(x[3], x[7]); CE_(x[8], x[12]); CE_(x[9], x[13]); CE_(x[10], x[14]); CE_(x[11], x[15]); CE_(x[0], x[2]); CE_(x[1], x[3]); CE_(x[4], x[6]); CE_(x[5], x[7]); CE_(x[8], x[10]); CE_(x[9], x[11]); CE_(x[12], x[14]); CE_(x[13], x[15]); CE_(x[0], x[1]); CE_(x[2], x[3]); CE_(x[4], x[5]); CE_(x[6], x[7]); CE_(x[8], x[9]); CE_(x[10], x[11]); CE_(x[12], x[13]); CE_(x[14], x[15]); } while (0)
#define MERGE16D(x) do { CE_(x[0], x[8]); CE_(x[1], x[9]); CE_(x[2], x[10]); CE_(x[3], x[11]); CE_(x[4], x[12]); CE_(x[5], x[13]); CE_(x[6], x[14]); CE_(x[7], x[15]); CE_(x[0], x[4]); CE_(x[1], x[5]); CE_(x[2], x[6]); CE_(x[3], x[7]); CE_(x[8], x[12]); CE_(x[9], x[13]); CE_(x[10], x[14]); CE_(x[11], x[15]); CE_(x[0], x[2]); CE_(x[1], x[3]); CE_(x[4], x[6]); CE_(x[5], x[7]); CE_(x[8], x[10]); CE_(x[9], x[11]); CE_(x[12], x[14]); CE_(x[13], x[15]); CE_(x[0], x[1]); CE_(x[2], x[3]); CE_(x[4], x[5]); CE_(x[6], x[7]); CE_(x[8], x[9]); CE_(x[10], x[11]); CE_(x[12], x[13]); CE_(x[14], x[15]); } while (0)
__device__ __forceinline__ float pkf(float v, unsigned tag) { return __uint_as_float((__float_as_uint(v) & 0xFFFFFF00u) | tag); }
__device__ __forceinline__ void ph_peer_select(const Args& a, int l, unsigned char* lds, int wv, int nunits, int pm0, int pn0, int pm1, int pn1) {
    unsigned char* ws = oport(a.ws); const int tid = otid(wv), lane = tid & 63, wave = __builtin_amdgcn_readfirstlane(tid >> 6), fr = lane & 15, fq = lane >> 4;
    bf16_t* sK = (bf16_t*)lds;
    int* sI = (int*)(lds + 69632 + wave * 2048);
    const bf16_t* QRY = (const bf16_t*)(ws + WS_GB); const bf16_t* SKB = (const bf16_t*)(ws + WS_SKB) + (size_t)l * 16 * 128 * 128; int* EID = (int*)(ws + WS_EID); float* EG = (float*)(ws + WS_EG);
  for (int uu = 0; uu < nunits; ++uu) { const int h = uu == 0 ? pn0 : pn1, pmu = uu == 0 ? pm0 : pm1;
    __syncthreads();
    { const u32x4* src = (const u32x4*)(SKB + (size_t)h * 2 * 128 * 128);
#pragma unroll
      for (int n = 0; n < 8; ++n) { const int idx = tid + NTHR * n, row = idx >> 4, seg = idx & 15; *(u32x4*)(sK + row * 136 + seg * 8) = src[idx]; } }
    __syncthreads();
    for (int it = wave; it < 16; it += NWAVE) { const int tg = pmu * 16 + it; const size_t m = (size_t)tg * 16 + fr;
        float va[16], vb[16];
#pragma unroll
        for (int p = 0; p < 2; ++p) {
            bf16x8 qf[4];
#pragma unroll
            for (int ks = 0; ks < 4; ++ks) qf[ks] = *(const bf16x8*)(QRY + m * 2048 + h * 256 + p * 128 + 32 * ks + 8 * fq);
            const bf16_t* kb = sK + (size_t)p * 128 * 136; float s0[16], s1[16];
#pragma unroll
            for (int nt = 0; nt < 8; ++nt) { f32x4 acc = {0.f, 0.f, 0.f, 0.f};
#pragma unroll
                for (int ks = 0; ks < 4; ++ks) { const bf16x8 x = *(const bf16x8*)(kb + (16 * nt + fr) * 136 + 32 * ks + 8 * fq); acc = __builtin_amdgcn_mfma_f32_16x16x32_bf16(x, qf[ks], acc, 0, 0, 0); }
#pragma unroll
                for (int r = 0; r < 4; ++r) { const float tv = __uint_as_float((__float_as_uint(acc[r]) & 0xFFFFFF80u) | (unsigned)(127 - (16 * nt + 4 * fq + r))); if (nt < 4) s0[nt * 4 + r] = tv; else s1[(nt - 4) * 4 + r] = tv; } }
            SORT16D(s0); SORT16D(s1);
            float t[16];
#pragma unroll
            for (int i = 0; i < 16; ++i) t[i] = fmaxf(s0[i], s1[15 - i]);
            MERGE16D(t);
#pragma unroll
            for (int off = 16; off <= 32; off <<= 1) { float o[16];
#pragma unroll
                for (int i = 0; i < 16; ++i) o[i] = __shfl_xor(t[15 - i], off);
#pragma unroll
                for (int i = 0; i < 16; ++i) t[i] = fmaxf(t[i], o[i]);
                MERGE16D(t); }
#pragma unroll
            for (int i = 0; i < 16; ++i) { if (p == 0) va[i] = t[i]; else vb[i] = t[i]; }
            __builtin_amdgcn_sched_barrier(0);
        }
        if (fq == 0) {
#pragma unroll
            for (int r = 0; r < 16; ++r) { sI[fr * 32 + r] = 127 - (int)(__float_as_uint(va[r]) & 127u); sI[fr * 32 + 16 + r] = 127 - (int)(__float_as_uint(vb[r]) & 127u); } }
#pragma unroll
        for (int r = 0; r < 16; ++r) { va[r] = __uint_as_float(__float_as_uint(va[r]) & 0xFFFFFF80u); vb[r] = __uint_as_float(__float_as_uint(vb[r]) & 0xFFFFFF80u); }
        float cs[16];
        {
            cs[0] = fq == 0 ? pkf(va[0] + vb[0], 255u) : fq == 1 ? pkf(va[0] + vb[1], 254u) : fq == 2 ? pkf(va[0] + vb[2], 253u) : pkf(va[0] + vb[3], 252u);
            cs[1] = fq == 0 ? pkf(va[0] + vb[4], 251u) : fq == 1 ? pkf(va[0] + vb[5], 250u) : fq == 2 ? pkf(va[0] + vb[6], 249u) : pkf(va[0] + vb[7], 248u);
            cs[2] = fq == 0 ? pkf(va[0] + vb[8], 247u) : fq == 1 ? pkf(va[0] + vb[9], 246u) : fq == 2 ? pkf(va[0] + vb[10], 245u) : pkf(va[0] + vb[11], 244u);
            cs[3] = fq == 0 ? pkf(va[0] + vb[12], 243u) : fq == 1 ? pkf(va[0] + vb[13], 242u) : fq == 2 ? pkf(va[0] + vb[14], 241u) : pkf(va[0] + vb[15], 240u);
            cs[4] = fq == 0 ? pkf(va[1] + vb[0], 239u) : fq == 1 ? pkf(va[1] + vb[1], 238u) : fq == 2 ? pkf(va[1] + vb[2], 237u) : pkf(va[1] + vb[3], 236u);
            cs[5] = fq == 0 ? pkf(va[1] + vb[4], 235u) : fq == 1 ? pkf(va[1] + vb[5], 234u) : fq == 2 ? pkf(va[1] + vb[6], 233u) : pkf(va[1] + vb[7], 232u);
            cs[6] = fq == 0 ? pkf(va[2] + vb[0], 223u) : fq == 1 ? pkf(va[2] + vb[1], 222u) : fq == 2 ? pkf(va[2] + vb[2], 221u) : pkf(va[2] + vb[3], 220u);
            cs[7] = fq == 0 ? pkf(va[2] + vb[4], 219u) : fq == 1 ? pkf(va[3] + vb[0], 207u) : fq == 2 ? pkf(va[3] + vb[1], 206u) : pkf(va[3] + vb[2], 205u);
            cs[8] = fq == 0 ? pkf(va[3] + vb[3], 204u) : fq == 1 ? pkf(va[4] + vb[0], 191u) : fq == 2 ? pkf(va[4] + vb[1], 190u) : pkf(va[4] + vb[2], 189u);
            cs[9] = fq == 0 ? pkf(va[5] + vb[0], 175u) : fq == 1 ? pkf(va[5] + vb[1], 174u) : fq == 2 ? pkf(va[6] + vb[0], 159u) : pkf(va[6] + vb[1], 158u);
            cs[10] = fq == 0 ? pkf(va[7] + vb[0], 143u) : fq == 1 ? pkf(va[7] + vb[1], 142u) : fq == 2 ? pkf(va[8] + vb[0], 127u) : pkf(va[9] + vb[0], 111u);
            cs[11] = fq == 0 ? pkf(va[10] + vb[0], 95u) : fq == 1 ? pkf(va[11] + vb[0], 79u) : fq == 2 ? pkf(va[12] + vb[0], 63u) : pkf(va[13] + vb[0], 47u);
            cs[12] = fq == 0 ? pkf(va[14] + vb[0], 31u) : fq == 1 ? pkf(va[15] + vb[0], 15u) : fq == 2 ? -INFINITY : -INFINITY;
            cs[13] = -INFINITY; cs[14] = -INFINITY; cs[15] = -INFINITY;
        }
        __builtin_amdgcn_sched_barrier(0);
        SORT16D(cs);
#pragma unroll
        for (int off = 16; off <= 32; off <<= 1) { float o[16];
#pragma unroll
            for (int i = 0; i < 16; ++i) o[i] = __shfl_xor(cs[15 - i], off);
#pragma unroll
            for (int i = 0; i < 16; ++i) cs[i] = fmaxf(cs[i], o[i]);
            MERGE16D(cs); }
        float bv[16];
#pragma unroll
        for (int i = 0; i < 16; ++i) bv[i] = cs[i];
        asm volatile("s_waitcnt lgkmcnt(0)" ::: "memory"); __builtin_amdgcn_sched_barrier(0);
        if (fq == 0) { int eid[16]; float ex[16]; float sm = 0.f; const float b0 = __uint_as_float(__float_as_uint(bv[0]) & 0xFFFFFF00u);
#pragma unroll
            for (int r = 0; r < 16; ++r) { const unsigned bits = __float_as_uint(bv[r]); const int f = 255 - (int)(bits & 255u); eid[r] = sI[fr * 32 + (f >> 4)] * 128 + sI[fr * 32 + 16 + (f & 15)];
                ex[r] = __expf(__uint_as_float(bits & 0xFFFFFF00u) - b0); sm += ex[r]; }
            const float inv = 1.f / sm; int* ep = EID + m * 128 + h * 16; float* gp = EG + m * 128 + h * 16;
#pragma unroll
            for (int r = 0; r < 16; r += 4) { *(int4*)(ep + r) = make_int4(eid[r], eid[r + 1], eid[r + 2], eid[r + 3]); *(f32x4*)(gp + r) = (f32x4){ex[r] * inv, ex[r + 1] * inv, ex[r + 2] * inv, ex[r + 3] * inv}; } }
        asm volatile("s_waitcnt lgkmcnt(0)" ::: "memory");
    }
  }
}
typedef float f32x2_t __attribute__((ext_vector_type(2)));
__device__ __forceinline__ void dec8(const uint2 w, f32x2_t (&f)[8]) {
    f[0] = __builtin_amdgcn_cvt_scalef32_pk_f32_fp4(w.x, 1.f, 0); f[1] = __builtin_amdgcn_cvt_scalef32_pk_f32_fp4(w.x, 1.f, 1); f[2] = __builtin_amdgcn_cvt_scalef32_pk_f32_fp4(w.x, 1.f, 2); f[3] = __builtin_amdgcn_cvt_scalef32_pk_f32_fp4(w.x, 1.f, 3);
    f[4] = __builtin_amdgcn_cvt_scalef32_pk_f32_fp4(w.y, 1.f, 0); f[5] = __builtin_amdgcn_cvt_scalef32_pk_f32_fp4(w.y, 1.f, 1); f[6] = __builtin_amdgcn_cvt_scalef32_pk_f32_fp4(w.y, 1.f, 2); f[7] = __builtin_amdgcn_cvt_scalef32_pk_f32_fp4(w.y, 1.f, 3);
}
__device__ __forceinline__ void ph_peer_experts(const Args& a, int l, unsigned char* lds, int wv) {
    unsigned char* ws = oport(a.ws); const int tid = otid(wv), lane = tid & 63, wave = __builtin_amdgcn_readfirstlane(tid >> 6), gw = obid() * NWAVE + wave, ngw = gridDim.x * NWAVE;
    const bf16_t* H16 = (const bf16_t*)(ws + WS_H16); const int* EID = (const int*)(ws + WS_EID); const float* EG = (const float*)(ws + WS_EG);
    const unsigned char* U8 = (const unsigned char*)(ws + WS_U16); const unsigned char* V8 = (const unsigned char*)(ws + WS_V16);
    const float* RSU = (const float*)(ws + WS_RS); const float* RSV = RSU + NEXP;
    float* sPA = (float*)(lds + wave * 8192) + lane; float* sPB = sPA + 1024;
    int* sEA = (int*)(lds + 65536 + wave * 2048); float* sGA = (float*)(sEA + 128); int* sEB = sEA + 256; float* sGB = (float*)(sEB + 128);
    for (int it = 0, nit = ((M + ngw - 1) / ngw + 1) / 2; it < nit; ++it) { const int mA = gw + (2 * it) * ngw, mB = mA + ngw; const bool vA = mA < M, vB = mB < M;
        __syncthreads();
        if (!vA) continue;
        const int mBs = vB ? mB : mA;
        f32x2_t accA[8], accB[8]; int hhA[2], hlA[2], hhB[2], hlB[2]; float shA, shB;
#define LOADH(hh, hl, sh, m_) do { float hv_[16]; const u32x4 h0_ = *(const u32x4*)(H16 + (size_t)(m_) * D + lane * 16), h1_ = *(const u32x4*)(H16 + (size_t)(m_) * D + lane * 16 + 8); \
          hv_[0] = lo_bf(h0_.x); hv_[1] = hi_bf(h0_.x); hv_[2] = lo_bf(h0_.y); hv_[3] = hi_bf(h0_.y); hv_[4] = lo_bf(h0_.z); hv_[5] = hi_bf(h0_.z); hv_[6] = lo_bf(h0_.w); hv_[7] = hi_bf(h0_.w); \
          hv_[8] = lo_bf(h1_.x); hv_[9] = hi_bf(h1_.x); hv_[10] = lo_bf(h1_.y); hv_[11] = hi_bf(h1_.y); hv_[12] = lo_bf(h1_.z); hv_[13] = hi_bf(h1_.z); hv_[14] = lo_bf(h1_.w); hv_[15] = hi_bf(h1_.w); \
          float am_ = 0.f; _Pragma("unroll") for (int j_ = 0; j_ < 16; ++j_) am_ = fmaxf(am_, __builtin_fabsf(hv_[j_])); am_ = fmaxf(wave_max(am_), 1e-30f); sh = am_ * (1.f / 119.f); const float ih_ = 119.f / am_; \
          unsigned wh_[2] = {0u, 0u}, wl_[2] = {0u, 0u}; \
          _Pragma("unroll") for (int j_ = 15; j_ >= 0; --j_) { const int h8_ = (int)__builtin_rintf(hv_[j_] * ih_); const int l4_ = (h8_ + 8) & 15; const int hi_ = (h8_ - l4_ + 8) >> 4; \
              wl_[j_ >> 3] = (wl_[j_ >> 3] << 4) | (unsigned)(l4_ ^ 8); wh_[j_ >> 3] = (wh_[j_ >> 3] << 4) | ((unsigned)hi_ & 15u); } \
          hh[0] = (int)wh_[0]; hh[1] = (int)wh_[1]; hl[0] = (int)wl_[0]; hl[1] = (int)wl_[1]; } while (0)
        LOADH(hhA, hlA, shA, mA); LOADH(hhB, hlB, shB, mBs);
#pragma unroll
        for (int j = 0; j < 8; ++j) { accA[j] = (f32x2_t){0.f, 0.f}; accB[j] = (f32x2_t){0.f, 0.f}; }
#define SORTTOK(m_, sE_, sG_) do { int key[2] = {EID[(size_t)(m_) * 128 + 2 * lane], EID[(size_t)(m_) * 128 + 2 * lane + 1]}; float pay[2] = {EG[(size_t)(m_) * 128 + 2 * lane], EG[(size_t)(m_) * 128 + 2 * lane + 1]}; \
          _Pragma("unroll") for (int k = 2; k <= 128; k <<= 1) _Pragma("unroll") for (int j = k >> 1; j >= 1; j >>= 1) { \
              if (j == 1) { const bool asc = ((2 * lane) & k) == 0; if ((key[0] > key[1]) == asc) { const int tk = key[0]; key[0] = key[1]; key[1] = tk; const float tp = pay[0]; pay[0] = pay[1]; pay[1] = tp; } } \
              else { const int lj = j >> 1; const bool keep_min = (((2 * lane) & k) == 0) == ((lane & lj) == 0); \
                  _Pragma("unroll") for (int r = 0; r < 2; ++r) { const int pk = __shfl_xor(key[r], lj); const float pp = __shfl_xor(pay[r], lj); const bool take = keep_min ? (pk < key[r]) : (pk > key[r]); if (take) { key[r] = pk; pay[r] = pp; } } } } \
          *(int2*)(sE_ + 2 * lane) = make_int2(key[0], key[1]); *(float2*)(sG_ + 2 * lane) = make_float2(pay[0], pay[1]); } while (0)
        SORTTOK(mA, sEA, sGA); SORTTOK(mBs, sEB, sGB);
        asm volatile("s_waitcnt lgkmcnt(0)" ::: "memory");
#pragma unroll 1
        for (int half = 0; half < 2; ++half) {
            const int pos = half * 64 + 8 * (lane & 7) + ((lane >> 5) & 1) + 2 * ((lane >> 4) & 1) + 4 * ((lane >> 3) & 1);
            const int evA = sEA[pos], evB = sEB[pos]; const float gvA = sGA[pos], gvB = sGB[pos];
            const float suA = RSU[evA], sdA = RSV[evA], suB = RSU[evB], sdB = RSV[evB];
            uint2 bufA[8], bufB[8];
#define ROWLD(dst, T, e_) dst = ((const uint2*)(T + (size_t)(e_) * (D / 2)))[lane]
#define KIDX(g, c) ((g) + 32 * ((c) & 1) + 16 * (((c) >> 1) & 1) + 8 * (((c) >> 2) & 1))
#define LOADG(buf, T, ev_, g) do { _Pragma("unroll") for (int i_ = 0; i_ < 8; ++i_) ROWLD(buf[i_], T, __builtin_amdgcn_readlane(ev_, KIDX(g, i_))); } while (0)
#define BF2(a_, b_, o) (((lane & (o)) ? (b_) : (a_)) + __shfl_xor((lane & (o)) ? (a_) : (b_), (o)))
#define DOTG(buf, hh, hl, sP_, g) do { float d4_[8]; _Pragma("unroll") for (int i_ = 0; i_ < 8; ++i_) { \
              const int ah_ = __builtin_amdgcn_sdot8((int)buf[i_].y, hh[1], __builtin_amdgcn_sdot8((int)buf[i_].x, hh[0], 0, false), false), al_ = __builtin_amdgcn_sdot8((int)buf[i_].y, hl[1], __builtin_amdgcn_sdot8((int)buf[i_].x, hl[0], 0, false), false); \
              d4_[i_] = (float)(16 * ah_ + al_); } \
              const float q0_ = BF2(d4_[0], d4_[1], 32), q1_ = BF2(d4_[2], d4_[3], 32), q2_ = BF2(d4_[4], d4_[5], 32), q3_ = BF2(d4_[6], d4_[7], 32); const float r0_ = BF2(q0_, q1_, 16), r1_ = BF2(q2_, q3_, 16); sP_[(g) * 64] = BF2(r0_, r1_, 8); } while (0)
            LOADG(bufA, U8, evA, 0);
#pragma unroll 1
            for (int g = 0; g < 8; ++g) { const int gn = g < 7 ? g + 1 : 7;
                LOADG(bufB, U8, evB, g); DOTG(bufA, hhA, hlA, sPA, g);
                LOADG(bufA, U8, evA, gn); DOTG(bufB, hhB, hlB, sPB, g); }
            int svbA, svbB;
#define BFLY(o, n) do { const bool up_ = (lane & (o)) != 0; _Pragma("unroll") for (int i_ = 0; i_ < (n); ++i_) { const float a_ = p[i_], b_ = p[i_ + (n)]; const float sd_ = up_ ? a_ : b_, kp_ = up_ ? b_ : a_; p[i_] = kp_ + __shfl_xor(sd_, (o)); } } while (0)
#define FINISH(sP_, gv_, svb_, su_, sd_) do { float p[8]; _Pragma("unroll") for (int i_ = 0; i_ < 8; ++i_) p[i_] = sP_[i_ * 64]; BFLY(4, 4); BFLY(2, 2); BFLY(1, 1); \
              svb_ = __builtin_bit_cast(int, gv_ * gelu_t(p[0] * su_) * sd_); } while (0)
            FINISH(sPA, gvA, svbA, suA * shA, sdA); FINISH(sPB, gvB, svbB, suB * shB, sdB);
#define ACCG(buf, acc, svb_, g) do { _Pragma("unroll") for (int i_ = 0; i_ < 8; ++i_) { const float sk_ = __builtin_bit_cast(float, __builtin_amdgcn_readlane(svb_, KIDX(g, i_))); const f32x2_t s2_ = {sk_, sk_}; f32x2_t f_[8]; dec8(buf[i_], f_); \
              _Pragma("unroll") for (int j_ = 0; j_ < 8; ++j_) acc[j_] = __builtin_elementwise_fma(f_[j_], s2_, acc[j_]); } } while (0)
            LOADG(bufA, V8, evA, 0);
#pragma unroll 1
            for (int g = 0; g < 8; ++g) { const int gn = g < 7 ? g + 1 : 7;
                LOADG(bufB, V8, evB, g); ACCG(bufA, accA, svbA, g);
                LOADG(bufA, V8, evA, gn); ACCG(bufB, accB, svbB, g); }
#undef ROWLD
#undef KIDX
#undef LOADG
#undef BF2
#undef DOTG
#undef BFLY
#undef FINISH
#undef ACCG
        }
#define EPILOG(m_, acc2) do { float acc[16]; _Pragma("unroll") for (int j = 0; j < 8; ++j) { acc[2 * j] = acc2[j].x; acc[2 * j + 1] = acc2[j].y; } \
        float* xr = a.out + (size_t)(m_) * D + lane * 16; float xn[16]; float ss = 0.f; \
        _Pragma("unroll") for (int j = 0; j < 4; ++j) { const f32x4 xv = *(const f32x4*)(xr + 4 * j); xn[4 * j] = xv.x + acc[4 * j]; xn[4 * j + 1] = xv.y + acc[4 * j + 1]; xn[4 * j + 2] = xv.z + acc[4 * j + 2]; xn[4 * j + 3] = xv.w + acc[4 * j + 3]; } \
        _Pragma("unroll") for (int j = 0; j < 16; ++j) ss += xn[j] * xn[j]; \
        const float r = rsqrtf(wave_sum(ss) * (1.f / D) + EPS); \
        if (l + 1 < DEPTH) { const float* gn = a.norm1 + (size_t)(l + 1) * D + lane * 16; \
            _Pragma("unroll") for (int j = 0; j < 4; ++j) *(f32x4*)(xr + 4 * j) = (f32x4){xn[4 * j], xn[4 * j + 1], xn[4 * j + 2], xn[4 * j + 3]}; \
            u32x4 w0, w1; \
            w0.x = pk2(xn[0] * r * gn[0], xn[1] * r * gn[1]); w0.y = pk2(xn[2] * r * gn[2], xn[3] * r * gn[3]); w0.z = pk2(xn[4] * r * gn[4], xn[5] * r * gn[5]); w0.w = pk2(xn[6] * r * gn[6], xn[7] * r * gn[7]); \
            w1.x = pk2(xn[8] * r * gn[8], xn[9] * r * gn[9]); w1.y = pk2(xn[10] * r * gn[10], xn[11] * r * gn[11]); w1.z = pk2(xn[12] * r * gn[12], xn[13] * r * gn[13]); w1.w = pk2(xn[14] * r * gn[14], xn[15] * r * gn[15]); \
            *(u32x4*)((bf16_t*)(ws + WS_H16) + (size_t)(m_) * D + lane * 16) = w0; *(u32x4*)((bf16_t*)(ws + WS_H16) + (size_t)(m_) * D + lane * 16 + 8) = w1; \
        } else { const float* gn = a.final_gain + lane * 16; \
            _Pragma("unroll") for (int j = 0; j < 4; ++j) *(f32x4*)(xr + 4 * j) = (f32x4){xn[4 * j] * r * gn[4 * j], xn[4 * j + 1] * r * gn[4 * j + 1], xn[4 * j + 2] * r * gn[4 * j + 2], xn[4 * j + 3] * r * gn[4 * j + 3]}; } } while (0)
        EPILOG(mA, accA);
        if (vB) EPILOG(mB, accB);
#undef EPILOG
#undef LOADH
#undef SORTTOK
    }
}

constexpr int PH_PER_LAYER = 9, N_PHASES = 1 + DEPTH * PH_PER_LAYER;
__global__ void __launch_bounds__(NTHR, 2) fwd_kernel(Args a) {
    extern __shared__ __attribute__((aligned(16))) unsigned char lds[];
    const int wv = __builtin_amdgcn_readfirstlane((int)threadIdx.x >> 6);
    const int tid = threadIdx.x;
    for (int u = tid; u < (LDS_BYTES - LDS_CTL_OFF) / 4; u += NTHR) ((unsigned*)(lds + LDS_CTL_OFF))[u] = 0u;
    __syncthreads();
    unsigned* ctl = (unsigned*)(a.ws + WS_CTL);
    XcdBarrier bar = xcd_barrier_post(ctl + 4096, (volatile LAS unsigned*)(LAS unsigned char*)(lds + LDS_CTL_OFF), wv);
    const int lo = a.ph_lo, hi = a.ph_hi;
#define IN(k) (lo <= (k) && (k) < hi)
#define SEAM(k) do { if (IN(k) && IN((k) + 1)) xcd_barrier(bar, wv); } while (0)
    unsigned char* ws = oport(a.ws);
    if (IN(0)) { ph_prologue(a, lds, wv); } SEAM(0);
    for (int l = 0; l < DEPTH; ++l) {
        const int pb = 1 + l * PH_PER_LAYER;
        unsigned char* ws = oport(a.ws);
        if (IN(pb + 0)) {
            ph_kiwi(a, l, lds, wv);
            pg8::Gemm g{(const bf16_t*)(ws + WS_H16), (const bf16_t*)(ws + WS_WIN + (size_t)l * WIN_L), M, NMAIN, D, 0, 0};
            pg8::StaticOrder S; S.init(M, NMAIN, gridDim.x, obid(), 0);
            pg8::EpiIn E{(bf16_t*)(ws + WS_P16), (float*)(ws + WS_PF)};
            pg8::gemm_phase(((LAS unsigned char*)lds), g, S, E, wv);
        } SEAM(pb + 0);
        if (IN(pb + 1)) { ph_post(a, l, lds, wv); ph_h1(a, l, lds, wv); } SEAM(pb + 1);
        if (IN(pb + 2)) { ph_h2(a, wv); ph_gmlp(a, l, lds, wv); ph_sel(a, lds, wv); } SEAM(pb + 2);
        if (IN(pb + 3)) { ph_attn(a, lds, wv); ph_h3(a, l, lds, wv); } SEAM(pb + 3);
        if (IN(pb + 4)) {
            pg8::Gemm g{(const bf16_t*)(ws + WS_YALL), (const bf16_t*)(ws + WS_WBR + (size_t)l * WBR_L), M, 3072, 512, (size_t)M * 512 * 2, 4};
            pg8::BranchOrder S; S.init(gridDim.x, obid());
            pg8::EpiGate E{(bf16_t*)(ws + WS_GB), (const bf16_t*)(ws + WS_P16)};
            pg8::gemm_phase(((LAS unsigned char*)lds), g, S, E, wv);
        } SEAM(pb + 4);
        if (IN(pb + 5)) {
            pg8::Gemm g{(const bf16_t*)(ws + WS_GB), (const bf16_t*)(ws + WS_WOUT + (size_t)l * WOUT_L), M, D, D, 0, 0};
            pg8::StaticOrder S; S.init(M, D, gridDim.x, obid(), 0);
            pg8::EpiRes E{a.out};
            pg8::gemm_phase(((LAS unsigned char*)lds), g, S, E, wv);
        } SEAM(pb + 5);
        if (IN(pb + 6)) { ph_norm2(a, l, wv); } SEAM(pb + 6);
        if (IN(pb + 7)) {
            pg8::Gemm g{(const bf16_t*)(ws + WS_H16), (const bf16_t*)(ws + WS_WPQ + (size_t)l * WPQ_L), M, 2048, D, 0, 0};
            pg8::StaticOrder S; S.init(M, 2048, gridDim.x, obid(), 0);
            pg8::EpiB16 E{(bf16_t*)(ws + WS_GB), 2048};
            pg8::gemm_phase(((LAS unsigned char*)lds), g, S, E, wv);
            asm volatile("s_waitcnt vmcnt(0)" ::: "memory"); __syncthreads();
            for (int i0_ = 0;; i0_ += 2) { pg8::Unit u0, u1; if (!S.next(i0_, u0)) break; const bool two = S.next(i0_ + 1, u1);
                ph_peer_select(a, l, lds, wv, two ? 2 : 1, u0.pm, u0.pn, two ? u1.pm : 0, two ? u1.pn : 0); }
        } SEAM(pb + 7);
        if (IN(pb + 8)) { ph_peer_experts(a, l, lds, wv); } SEAM(pb + 8);
    }
#undef IN
#undef SEAM
}

#ifndef MK_N_LAUNCHES
#define MK_N_LAUNCHES 1
#endif
extern "C" void kernel_launch(void* const* d_in, const int* in_sizes, int n_in, void* d_out, int out_size, void* d_ws, size_t ws_size, hipStream_t stream) {
    static int grid = 0;
    if (grid == 0) {
        if (n_in != 17 || out_size != M * D || ws_size < WS_END) { fprintf(stderr, "kernel_launch: unexpected shapes (n_in %d, out %d, ws %zu)\n", n_in, out_size, ws_size); grid = -1; return; }
        int dev = 0, cus = 0, per_cu = 0;
        if (hipGetDevice(&dev) != hipSuccess || hipDeviceGetAttribute(&cus, hipDeviceAttributeMultiprocessorCount, dev) != hipSuccess) { grid = -1; return; }
        if (hipFuncSetAttribute((const void*)fwd_kernel, hipFuncAttributeMaxDynamicSharedMemorySize, LDS_BYTES) != hipSuccess) { fprintf(stderr, "kernel_launch: hipFuncSetAttribute failed\n"); grid = -1; return; }
        if (hipOccupancyMaxActiveBlocksPerMultiprocessor(&per_cu, (const void*)fwd_kernel, NTHR, LDS_BYTES) != hipSuccess || per_cu < 1) { fprintf(stderr, "kernel_launch: occupancy query says %d\n", per_cu); (void)hipGetLastError(); grid = -1; return; }
        grid = cus;
    }
    if (grid < 0) return;
    (void)hipMemsetAsync((char*)d_ws + WS_CTL, 0, CTL_BYTES, stream);
    Args a{};
    a.x = (const float*)d_in[0]; a.pos = (const int*)d_in[1]; a.norm1 = (const float*)d_in[2]; a.w_in = (const float*)d_in[3]; a.lb_logits = (const float*)d_in[4]; a.hgrn_gain = (const float*)d_in[5];
    a.gmlp_gain = (const float*)d_in[6]; a.gmlp_ws = (const float*)d_in[7]; a.gmlp_bs = (const float*)d_in[8]; a.w_branch = (const float*)d_in[9]; a.w_out = (const float*)d_in[10]; a.norm2 = (const float*)d_in[11];
    a.peer_wq = (const float*)d_in[12]; a.peer_keys = (const float*)d_in[13]; a.peer_u = (const float*)d_in[14]; a.peer_v = (const float*)d_in[15]; a.final_gain = (const float*)d_in[16];
    a.out = (float*)d_out; a.ws = (unsigned char*)d_ws;
    if (MK_N_LAUNCHES == 1) { a.ph_lo = 0; a.ph_hi = N_PHASES; hipLaunchKernelGGL(fwd_kernel, dim3(grid), dim3(NTHR), LDS_BYTES, stream, a); }
    else for (int p = 0; p < N_PHASES; ++p) { a.ph_lo = p; a.ph_hi = p + 1; hipLaunchKernelGGL(fwd_kernel, dim3(grid), dim3(NTHR), LDS_BYTES, stream, a); }
}
```

```cpp
#include <hip/hip_runtime.h>
#include <cstdio>
#include <cstdint>

#define LAS __attribute__((address_space(3)))
typedef unsigned short bf16_t;
typedef short bf16x8 __attribute__((ext_vector_type(8)));
typedef float f32x4 __attribute__((ext_vector_type(4)));
typedef unsigned u32x4 __attribute__((ext_vector_type(4)));

constexpr int D = 1024, BATCH = 2, SEQ = 8192, DEPTH = 4, M = BATCH * SEQ;
constexpr int NIN = 8264;
constexpr int NPAD = 8448;
constexpr int C_AQ = 0, C_AF = 512, C_AI = 1024, C_AG = 1536, C_BU = 2048, C_BV = 2560, C_CQ = 3072, C_CK = 3584, C_CV = 4096, C_QI = 4608, C_GL = 5120, C_KI = 8192, C_WI = 8256;
constexpr int NMAIN = 8192;
constexpr int S_GL = 5192;
constexpr int PFW = 768;
constexpr float EPS = 1e-6f;
constexpr int NEXP = 16384;

constexpr size_t MiB = 1u << 20;
constexpr size_t WS_CTL = 0, CTL_BYTES = 32 * 1024;
constexpr size_t WS_WIN = 2 * MiB;
constexpr size_t WIN_L = (size_t)NPAD * D * 2;
constexpr size_t WS_WBR = 68 * MiB;
constexpr size_t WBR_L = (size_t)3072 * 512 * 2;
constexpr size_t WS_WOUT = 80 * MiB;
constexpr size_t WOUT_L = (size_t)1024 * 3072 * 2;
constexpr size_t WS_WPQ = 104 * MiB;
constexpr size_t WPQ_L = (size_t)2048 * 1024 * 2;
constexpr size_t WS_LB = 120 * MiB;
constexpr size_t WS_CS = 121 * MiB;
constexpr size_t WS_H16 = 134 * MiB;
constexpr size_t WS_P16 = 166 * MiB;
constexpr size_t WS_PF = 430 * MiB;
constexpr size_t WS_QR = 478 * MiB, WS_KR = 494 * MiB;
constexpr size_t WS_QI = 510 * MiB;
constexpr size_t WS_KI = 542 * MiB;
constexpr size_t WS_WI = 546 * MiB;
constexpr size_t WS_FF = 548 * MiB, WS_KK = 580 * MiB, WS_QF = 612 * MiB;
constexpr size_t WS_OA = 644 * MiB;
constexpr size_t WS_VN = 676 * MiB;
constexpr size_t WS_YALL = 708 * MiB;
constexpr size_t WS_GB = 756 * MiB;
constexpr size_t WS_EID = 852 * MiB, WS_EG = 860 * MiB;
constexpr size_t WS_DD = 120 * MiB + 256 * 1024;
constexpr size_t WS_WSB = 544 * MiB;
constexpr size_t WS_VT = 644 * MiB;
constexpr size_t WS_MASK = 660 * MiB;
constexpr size_t WS_U16 = 868 * MiB, WS_V16 = 900 * MiB;
constexpr size_t WS_XR = 580 * MiB;
constexpr size_t WS_RS = 884 * MiB;
constexpr size_t WS_SKB = 932 * MiB;
constexpr size_t WS_END = 934 * MiB;

__device__ const float ROPE_INV64[64] = {
1.000000000e+00f, 8.659643531e-01f, 7.498942614e-01f, 6.493816376e-01f, 5.623413324e-01f, 4.869675338e-01f, 4.216965139e-01f, 3.651741147e-01f, 3.162277639e-01f, 2.738419771e-01f, 2.371373773e-01f, 2.053525001e-01f, 1.778279394e-01f, 1.539926529e-01f, 1.333521307e-01f, 1.154782027e-01f, 1.000000015e-01f, 8.659642935e-02f, 7.498941571e-02f, 6.493816525e-02f, 5.623413250e-02f, 4.869675264e-02f, 4.216965288e-02f, 3.651741147e-02f, 3.162277490e-02f, 2.738419734e-02f, 2.371373773e-02f, 2.053525113e-02f, 1.778279431e-02f, 1.539926510e-02f, 1.333521493e-02f, 1.154782064e-02f, 9.999999776e-03f, 8.659643121e-03f, 7.498941850e-03f, 6.493816152e-03f, 5.623413250e-03f, 4.869675264e-03f, 4.216964822e-03f, 3.651741194e-03f, 3.162277630e-03f, 2.738419687e-03f, 2.371373586e-03f, 2.053524833e-03f, 1.778279431e-03f, 1.539926510e-03f, 1.333521446e-03f, 1.154781901e-03f, 1.000000047e-03f, 8.659643354e-04f, 7.498942432e-04f, 6.493816618e-04f, 5.623413017e-04f, 4.869675322e-04f, 4.216965172e-04f, 3.651741426e-04f, 3.162277571e-04f, 2.738419571e-04f, 2.371373703e-04f, 2.053525095e-04f, 1.778279402e-04f, 1.539926452e-04f, 1.333521504e-04f, 1.154782003e-04f};
__device__ const float ROPE_INV32[32] = {
1.000000000e+00f, 7.498942614e-01f, 5.623413324e-01f, 4.216965139e-01f, 3.162277639e-01f, 2.371373773e-01f, 1.778279394e-01f, 1.333521307e-01f, 1.000000015e-01f, 7.498941571e-02f, 5.623413250e-02f, 4.216965288e-02f, 3.162277490e-02f, 2.371373773e-02f, 1.778279431e-02f, 1.333521493e-02f, 9.999999776e-03f, 7.498941850e-03f, 5.623413250e-03f, 4.216964822e-03f, 3.162277630e-03f, 2.371373586e-03f, 1.778279431e-03f, 1.333521446e-03f, 1.000000047e-03f, 7.498942432e-04f, 5.623413017e-04f, 4.216965172e-04f, 3.162277571e-04f, 2.371373703e-04f, 1.778279402e-04f, 1.333521504e-04f};

__device__ __forceinline__ float bf2f(bf16_t b) { return __uint_as_float(((unsigned)b) << 16); }
__device__ __forceinline__ unsigned f2bf(float f) { unsigned u = __float_as_uint(f); return (u + 0x7fffu + ((u >> 16) & 1u)) >> 16; }
__device__ __forceinline__ unsigned pk2(float lo, float hi) { return f2bf(lo) | (f2bf(hi) << 16); }
__device__ __forceinline__ float lo_bf(unsigned w) { return __uint_as_float(w << 16); }
__device__ __forceinline__ float hi_bf(unsigned w) { return __uint_as_float(w & 0xffff0000u); }
__device__ __forceinline__ float sigm(float x) { return 1.f / (1.f + __expf(-x)); }
__device__ __forceinline__ float silu(float x) { return x * sigm(x); }
__device__ __forceinline__ float gelu_t(float x) { const float u = 0.7978845608028654f * (x + 0.044715f * x * x * x); const float th = 1.f - 2.f / (1.f + __expf(2.f * u)); return 0.5f * x * (1.f + th); }
__device__ __forceinline__ int shx_i(int v, int o) {
    return o == 1 ? __builtin_amdgcn_update_dpp(v, v, 0xB1, 0xF, 0xF, false) : o == 2 ? __builtin_amdgcn_update_dpp(v, v, 0x4E, 0xF, 0xF, false) : o == 8 ? __builtin_amdgcn_update_dpp(v, v, 0x128, 0xF, 0xF, false) : __shfl_xor(v, o);
}
__device__ __forceinline__ float shx_f(float v, int o) { return __builtin_bit_cast(float, shx_i(__builtin_bit_cast(int, v), o)); }
__device__ __forceinline__ int shx_il(int v, int o, int lane) {
    if (o == 4) { const int a = __builtin_amdgcn_update_dpp(v, v, 0x114, 0xF, 0xF, false), b = __builtin_amdgcn_update_dpp(v, v, 0x104, 0xF, 0xF, false); return (lane & 4) ? a : b; }
    if (o == 16) { const auto r = __builtin_amdgcn_permlane16_swap((unsigned)v, (unsigned)v, false, false); return (lane & 16) ? (int)r[0] : (int)r[1]; }
    if (o == 32) { const auto r = __builtin_amdgcn_permlane32_swap((unsigned)v, (unsigned)v, false, false); return (lane & 32) ? (int)r[0] : (int)r[1]; }
    return shx_i(v, o);
}
__device__ __forceinline__ float shx_fl(float v, int o, int lane) { return __builtin_bit_cast(float, shx_il(__builtin_bit_cast(int, v), o, lane)); }
__device__ __forceinline__ float dpp_ror_f(float v, int n) { return __builtin_bit_cast(float, n == 4 ? __builtin_amdgcn_update_dpp(__builtin_bit_cast(int, v), __builtin_bit_cast(int, v), 0x124, 0xF, 0xF, false) : __builtin_amdgcn_update_dpp(__builtin_bit_cast(int, v), __builtin_bit_cast(int, v), 0x128, 0xF, 0xF, false)); }
__device__ __forceinline__ float bf2_swap32(float a, float b) { const auto r = __builtin_amdgcn_permlane32_swap(__builtin_bit_cast(unsigned, a), __builtin_bit_cast(unsigned, b), false, false); return __builtin_bit_cast(float, (unsigned)r[0]) + __builtin_bit_cast(float, (unsigned)r[1]); }
__device__ __forceinline__ float bf2_swap16(float a, float b) { const auto r = __builtin_amdgcn_permlane16_swap(__builtin_bit_cast(unsigned, a), __builtin_bit_cast(unsigned, b), false, false); return __builtin_bit_cast(float, (unsigned)r[0]) + __builtin_bit_cast(float, (unsigned)r[1]); }
__device__ __forceinline__ float xsum16(float v) { const auto r = __builtin_amdgcn_permlane16_swap(__builtin_bit_cast(unsigned, v), __builtin_bit_cast(unsigned, v), false, false); return __builtin_bit_cast(float, (unsigned)r[0]) + __builtin_bit_cast(float, (unsigned)r[1]); }
__device__ __forceinline__ float xsum32(float v) { const auto r = __builtin_amdgcn_permlane32_swap(__builtin_bit_cast(unsigned, v), __builtin_bit_cast(unsigned, v), false, false); return __builtin_bit_cast(float, (unsigned)r[0]) + __builtin_bit_cast(float, (unsigned)r[1]); }
__device__ __forceinline__ float xmax16(float v) { const auto r = __builtin_amdgcn_permlane16_swap(__builtin_bit_cast(unsigned, v), __builtin_bit_cast(unsigned, v), false, false); return fmaxf(__builtin_bit_cast(float, (unsigned)r[0]), __builtin_bit_cast(float, (unsigned)r[1])); }
__device__ __forceinline__ float xmax32(float v) { const auto r = __builtin_amdgcn_permlane32_swap(__builtin_bit_cast(unsigned, v), __builtin_bit_cast(unsigned, v), false, false); return fmaxf(__builtin_bit_cast(float, (unsigned)r[0]), __builtin_bit_cast(float, (unsigned)r[1])); }
__device__ __forceinline__ unsigned xor16(unsigned v) { const auto r = __builtin_amdgcn_permlane16_swap(v, v, false, false); return (unsigned)r[0] | (unsigned)r[1]; }
__device__ __forceinline__ unsigned xor32(unsigned v) { const auto r = __builtin_amdgcn_permlane32_swap(v, v, false, false); return (unsigned)r[0] | (unsigned)r[1]; }
__device__ __forceinline__ float wave_sum(float v) {
    v += shx_f(v, 1); v += shx_f(v, 2); v += dpp_ror_f(v, 4); v += dpp_ror_f(v, 8); v = xsum16(v); v = xsum32(v);
    return v;
}
__device__ __forceinline__ float wave_max(float v) {
    v = fmaxf(v, shx_f(v, 1)); v = fmaxf(v, shx_f(v, 2)); v = fmaxf(v, dpp_ror_f(v, 4)); v = fmaxf(v, dpp_ror_f(v, 8)); v = xmax16(v); v = xmax32(v);
    return v;
}
typedef __bf16 bf2_t __attribute__((ext_vector_type(2)));
__device__ __forceinline__ float dot2(unsigned a, unsigned b, float c) { return __builtin_amdgcn_fdot2_f32_bf16(__builtin_bit_cast(bf2_t, a), __builtin_bit_cast(bf2_t, b), c, false); }
__device__ __forceinline__ int otid(int wv) { int t; asm volatile("v_mbcnt_lo_u32_b32 %0, -1, 0\n\tv_mbcnt_hi_u32_b32 %0, -1, %0" : "=v"(t)); return wv * 64 + t; }
__device__ __forceinline__ unsigned char* oport(unsigned char* p) { unsigned long long z; asm volatile("s_mov_b64 %0, 0" : "=s"(z)); return p + z; }
__device__ __forceinline__ int obid() { int b; asm volatile("s_mov_b32 %0, %1" : "=s"(b) : "s"((int)blockIdx.x)); return b; }
__device__ __forceinline__ unsigned fkey(float f) { const unsigned u = __float_as_uint(f); return u ^ ((u >> 31) ? 0xFFFFFFFFu : 0x80000000u); }

#define XB_TMO      128
#define XB_XCNT(j)  (256  + 64 * (j))
#define XB_XSUB(j)  (1280 + 64 * (j))
#define XB_XGEN(j)  (2304 + 64 * (j))
#define XB_TOP      3328
#define XB_TOPGEN   3392
#define XCD_BAR_WORDS 3456
#define XB_SPIN_CAP (1u << 23)
__device__ __forceinline__ unsigned xb_ld(unsigned* p)              { return __hip_atomic_load(p, __ATOMIC_RELAXED, __HIP_MEMORY_SCOPE_AGENT); }
__device__ __forceinline__ unsigned xb_add(unsigned* p, unsigned v) { return __hip_atomic_fetch_add(p, v, __ATOMIC_RELAXED, __HIP_MEMORY_SCOPE_AGENT); }
__device__ __forceinline__ unsigned xb_xcc_id() { return (unsigned)__builtin_amdgcn_s_getreg((3 << 11) | 20) & 0xFu; }
#define XB_SPIN(cond, bar) do { unsigned _sp = 0; while (cond) { __builtin_amdgcn_s_sleep(1); \
    if ((++_sp & 255u) == 0u) { if (xb_ld(&(bar)[XB_TMO])) break; if (_sp > XB_SPIN_CAP) { atomicAdd(&(bar)[XB_TMO], 1u); break; } } } } while (0)
struct XcdBarrier { unsigned* bar; unsigned x; volatile LAS unsigned* st; };
__device__ __forceinline__ XcdBarrier xcd_barrier_post(unsigned* bar, volatile LAS unsigned* st, int wv) {
    XcdBarrier b; b.bar = bar; b.x = xb_xcc_id(); b.st = st;
    if (wv == 0) if ((otid(0) & 63) == 0) (void)xb_add(&bar[XB_XCNT(b.x)], 1u);
    return b;
}
__device__ __forceinline__ void xcd_barrier_complete(unsigned* bar, unsigned x, unsigned& nloc, unsigned& nx) {
    const unsigned G = gridDim.x * gridDim.y * gridDim.z;
    unsigned sum, cnt, mine, sp = 0u;
    for (;;) {
        sum = 0u; cnt = 0u; mine = 0u;
#pragma unroll
        for (unsigned j = 0; j < 16; ++j) { const unsigned c = xb_ld(&bar[XB_XCNT(j)]); sum += c; cnt += (c > 0u) ? 1u : 0u; mine = (j == x) ? c : mine; }
        if (sum == G) break;
        __builtin_amdgcn_s_sleep(1);
        if ((++sp & 255u) == 0u) { if (xb_ld(&bar[XB_TMO])) break; if (sp > XB_SPIN_CAP) { atomicAdd(&bar[XB_TMO], 1u); break; } }
    }
    nloc = mine > 0u ? mine : 1u; nx = cnt > 0u ? cnt : 1u;
}
__device__ __forceinline__ void xcd_barrier(const XcdBarrier& b, int wv) {
    asm volatile("s_waitcnt vmcnt(0)" ::: "memory");
    __syncthreads();
    if (wv == 0) if ((otid(0) & 63) == 0) {
        unsigned* bar = b.bar;
        __builtin_amdgcn_s_waitcnt(0);
        unsigned nloc = b.st[0], nx = b.st[1];
        if (nloc == 0u) { xcd_barrier_complete(bar, b.x, nloc, nx); b.st[0] = nloc; b.st[1] = nx; }
        const unsigned old = xb_add(&bar[XB_XSUB(b.x)], 1u);
        const unsigned gen = old / nloc;
        if (old + 1u == (gen + 1u) * nloc) {
            __builtin_amdgcn_fence(__ATOMIC_RELEASE, "agent");
            asm volatile("s_waitcnt vmcnt(0)" ::: "memory");
            const unsigned og = xb_add(&bar[XB_TOP], 1u);
            const unsigned tg = og / nx;
            if (og + 1u == (tg + 1u) * nx) xb_add(&bar[XB_TOPGEN], 1u);
            else XB_SPIN(xb_ld(&bar[XB_TOPGEN]) == tg, bar);
            __builtin_amdgcn_fence(__ATOMIC_ACQUIRE, "agent");
            xb_add(&bar[XB_XGEN(b.x)], 1u);
            asm volatile("s_waitcnt vmcnt(0)" ::: "memory");
        } else {
            XB_SPIN(xb_ld(&bar[XB_XGEN(b.x)]) == gen, bar);
            __builtin_amdgcn_fence(__ATOMIC_ACQUIRE, "agent");
            asm volatile("s_waitcnt vmcnt(0)" ::: "memory");
        }
    }
    __syncthreads();
}

namespace pg8 {
constexpr int BM = 256, BK = 64, HALF = 128, HTB = HALF * BK * 2, STAGE_BYTES = 8 * HTB, NXCD = 8, WGM = 8;
__host__ __device__ __forceinline__ int lds_byte(int r, int c) { const int st = (r >> 4) * 2 + (c >> 5), rr = r & 15, cc = c & 31, ob = rr * 64 + cc * 2; return st * 1024 + (ob ^ (((ob >> 9) & 1) << 5)); }
__host__ __device__ __forceinline__ void stage_rc(int b, int& R, int& C) { const int st = b / 1024, sb = b % 1024, swz = sb ^ (((sb >> 9) & 1) << 5); R = (st >> 1) * 16 + swz / 64; C = (st & 1) * 32 + (swz % 64) / 2; }
__host__ __device__ __forceinline__ int perm32(int rho) { const int n = rho >> 4, i = rho & 15; return 8 * (i >> 2) + 4 * n + (i & 3); }
struct Unit { int pm, pn, ka; };
struct Gemm { const bf16_t* A; const bf16_t* Bt; int M, N, K; size_t strideA; int nsplit; };
struct StaticOrder {
    int nM, nN, nwg, G, c, nsplit;
    __device__ __forceinline__ void init(int M_, int N_, int G_, int c_, int nsplit_) { nM = M_ / BM; nN = N_ / BM; nwg = nM * nN; G = G_; c = c_; nsplit = nsplit_; }
    __device__ __forceinline__ bool next(int i, Unit& u) const {
        const long L = (long)i * G + c; if (L >= nwg) return false;
        int wgid = (int)L; { const int q = nwg / NXCD, r = nwg % NXCD, xcd = wgid % NXCD, off = wgid / NXCD; wgid = (xcd < r ? xcd * (q + 1) : r * (q + 1) + (xcd - r) * q) + off; }
        const int nig = WGM * nN, gid = wgid / nig, fm = gid * WGM, gsz = (nM - fm) < WGM ? (nM - fm) : WGM;
        u.pm = fm + ((wgid % nig) % gsz); u.pn = (wgid % nig) / gsz; u.ka = nsplit ? u.pn / nsplit : 0; return true;
    }
};
__device__ __forceinline__ unsigned cvt_pk_bf16(float lo, float hi) { unsigned r; asm volatile("v_cvt_pk_bf16_f32 %0, %1, %2" : "=v"(r) : "v"(lo), "v"(hi)); return r; }

template <class Epi, class Sched>
__device__ __forceinline__ void gemm_phase(LAS unsigned char* lds, const Gemm g, const Sched& S, const Epi& E, int wv) {
    const int tid = otid(wv), wid = __builtin_amdgcn_readfirstlane(tid >> 6), lane = tid & 63, wr = wid >> 2, wc = wid & 3, fr = lane & 15, fq = lane >> 4;
    const int K = g.K, nt = K / BK;
    unsigned voffA[2], voffB[2];
#pragma unroll
    for (int i = 0; i < 2; ++i) { int R, C; stage_rc(tid * 16 + i * 8192, R, C); const int Rb = Epi::PERM ? ((R & ~31) + perm32(R & 31)) : R;
        voffA[i] = (unsigned)(R * K + C) * 2u; voffB[i] = (unsigned)(Rb * K + C) * 2u; }
    const size_t kstep = (size_t)(BK * 2);
    const size_t hstep = (size_t)HALF * K * 2;
    const size_t tstep = 2 * hstep;
    const unsigned ldsw = (unsigned)wid * 1024u;
    const int aoff = lds_byte(wr * 64 + fr, fq * 8), boff = lds_byte(wc * 32 + fr, fq * 8);
#define PG8_SA(b, h) (((b) * 2 + (h)) * HTB)
#define PG8_SB(b, h) ((4 + (b) * 2 + (h)) * HTB)
#define PG8_STAGE(bufoff, gbase, voff) do { _Pragma("unroll") for (int _i = 0; _i < 2; ++_i) \
        __builtin_amdgcn_global_load_lds((const unsigned*)((const char*)(gbase) + (voff)[_i]), (LAS unsigned*)(lds + (bufoff) + ldsw + _i * 8192), 16, 0, 0); } while (0)
#define PG8_LDA(dst, b, h) do { _Pragma("unroll") for (int m = 0; m < 4; ++m) _Pragma("unroll") for (int k = 0; k < 2; ++k) dst[m][k] = *(const LAS bf16x8*)(lds + PG8_SA(b, h) + aoff + m * 2048 + k * 1024); } while (0)
#define PG8_LDB(dst, b, h) do { _Pragma("unroll") for (int n = 0; n < 2; ++n) _Pragma("unroll") for (int k = 0; k < 2; ++k) dst[n][k] = *(const LAS bf16x8*)(lds + PG8_SB(b, h) + boff + n * 2048 + k * 1024); } while (0)
#define PG8_MMA(ai, bj, At, Bt) do { __builtin_amdgcn_s_setprio(1); _Pragma("unroll") for (int m = 0; m < 4; ++m) _Pragma("unroll") for (int n = 0; n < 2; ++n) _Pragma("unroll") for (int k = 0; k < 2; ++k) \
        acc[ai][bj][m][n] = __builtin_amdgcn_mfma_f32_16x16x32_bf16(Bt[n][k], At[m][k], acc[ai][bj][m][n], 0, 0, 0); __builtin_amdgcn_s_setprio(0); } while (0)
#define PG8_WAIT_V(n) asm volatile("s_waitcnt vmcnt(" #n ")" ::: "memory")
#define PG8_WAIT_L(n) asm volatile("s_waitcnt lgkmcnt(" #n ")" ::: "memory")
#define PG8_BAR __builtin_amdgcn_s_barrier()
#define PG8_SCHED __builtin_amdgcn_sched_barrier(0)
    Unit cur, nxt; int ui = 0;
    if (!S.next(0, cur)) return;
    f32x4 acc[2][2][4][2];
#pragma unroll
    for (int a = 0; a < 2; ++a)
#pragma unroll
        for (int b = 0; b < 2; ++b)
#pragma unroll
            for (int m = 0; m < 4; ++m)
#pragma unroll
                for (int n = 0; n < 2; ++n) acc[a][b][m][n] = (f32x4){0.f, 0.f, 0.f, 0.f};
    bf16x8 At[4][2], B0[2][2], B1[2][2];
    const char* cA = (const char*)g.A + (size_t)cur.ka * g.strideA + (size_t)cur.pm * tstep; const char* cB = (const char*)g.Bt + (size_t)cur.pn * tstep;
    PG8_STAGE(PG8_SB(0, 0), cB, voffB); PG8_STAGE(PG8_SA(0, 0), cA, voffA); PG8_STAGE(PG8_SB(0, 1), cB + hstep, voffB); PG8_STAGE(PG8_SA(0, 1), cA + hstep, voffA);
    if (wr == 1) PG8_BAR;
    PG8_WAIT_V(4); PG8_BAR;
    PG8_STAGE(PG8_SB(1, 0), cB + kstep, voffB); PG8_STAGE(PG8_SA(1, 0), cA + kstep, voffA); PG8_STAGE(PG8_SB(1, 1), cB + hstep + kstep, voffB);
    PG8_WAIT_V(6); PG8_BAR;
    for (;;) {
        const bool has_next = S.next(ui + 1, nxt);
        const char* nA = has_next ? (const char*)g.A + (size_t)nxt.ka * g.strideA + (size_t)nxt.pm * tstep : cA; const char* nB = has_next ? (const char*)g.Bt + (size_t)nxt.pn * tstep : cB;
        for (int t = 0; t < nt; t += 2) {
            const bool last = (t == nt - 2);
            const char* a1 = cA + (size_t)(t + 1) * kstep;
            const char* a2 = last ? nA : cA + (size_t)(t + 2) * kstep; const char* b2 = last ? nB : cB + (size_t)(t + 2) * kstep;
            const char* a3 = a2 + kstep; const char* b3 = b2 + kstep;
            PG8_LDB(B0, 0, 0); PG8_SCHED; PG8_LDA(At, 0, 0); PG8_STAGE(PG8_SA(1, 1), a1 + hstep, voffA);
            PG8_WAIT_L(8); PG8_BAR; PG8_WAIT_L(0); PG8_MMA(0, 0, At, B0); PG8_BAR; PG8_SCHED;
            PG8_LDB(B1, 0, 1); PG8_STAGE(PG8_SB(0, 0), b2, voffB);
            PG8_BAR; PG8_WAIT_L(0); PG8_MMA(0, 1, At, B1); PG8_BAR;
            PG8_LDA(At, 0, 1); PG8_STAGE(PG8_SA(0, 0), a2, voffA);
            PG8_BAR; PG8_WAIT_L(0); PG8_MMA(1, 0, At, B0); PG8_BAR; PG8_SCHED;
            PG8_STAGE(PG8_SB(0, 1), b2 + hstep, voffB);
            PG8_WAIT_V(6); PG8_BAR; PG8_MMA(1, 1, At, B1); PG8_BAR;
            PG8_LDB(B0, 1, 0); PG8_SCHED; PG8_LDA(At, 1, 0); PG8_STAGE(PG8_SA(0, 1), a2 + hstep, voffA);
            PG8_WAIT_L(8); PG8_BAR; PG8_WAIT_L(0); PG8_MMA(0, 0, At, B0); PG8_BAR; PG8_SCHED;
            PG8_LDB(B1, 1, 1); PG8_STAGE(PG8_SB(1, 0), b3, voffB);
            PG8_BAR; PG8_WAIT_L(0); PG8_MMA(0, 1, At, B1); PG8_BAR;
            PG8_LDA(At, 1, 1); PG8_STAGE(PG8_SA(1, 0), a3, voffA);
            PG8_BAR; PG8_WAIT_L(0); PG8_MMA(1, 0, At, B0); PG8_BAR; PG8_SCHED;
            PG8_STAGE(PG8_SB(1, 1), b3 + hstep, voffB);
            PG8_WAIT_V(6); PG8_BAR; PG8_MMA(1, 1, At, B1); PG8_BAR;
        }
        E(acc, cur, wr, wc, fr, fq);
        if (!has_next) break;
        if (!E.keep(cur))
#pragma unroll
        for (int a = 0; a < 2; ++a)
#pragma unroll
            for (int b = 0; b < 2; ++b)
#pragma unroll
                for (int m = 0; m < 4; ++m)
#pragma unroll
                    for (int n = 0; n < 2; ++n) acc[a][b][m][n] = (f32x4){0.f, 0.f, 0.f, 0.f};
        cur = nxt; cA = nA; cB = nB; ++ui;
    }
    PG8_WAIT_V(0);
    if (wr == 0) PG8_BAR;
    PG8_BAR;
#undef PG8_SA
#undef PG8_SB
#undef PG8_STAGE
#undef PG8_LDA
#undef PG8_LDB
#undef PG8_MMA
#undef PG8_WAIT_V
#undef PG8_WAIT_L
#undef PG8_BAR
#undef PG8_SCHED
}

struct EpiIn {
    __device__ __forceinline__ bool keep(const Unit&) const { return false; }
    static constexpr bool PERM = true;
    bf16_t* P16; float* PF;
    __device__ __forceinline__ void operator()(f32x4 (&acc)[2][2][4][2], const Unit& u, int wr, int wc, int fr, int fq) const {
        const int row0 = u.pm * BM + wr * 64 + fr, col0 = u.pn * BM + wc * 32 + 8 * fq;
        const bool gate = u.pn >= C_GL / 256;
#pragma unroll
        for (int ai = 0; ai < 2; ++ai)
#pragma unroll
            for (int m = 0; m < 4; ++m) { const size_t row = (size_t)(row0 + ai * HALF + m * 16);
#pragma unroll
                for (int bj = 0; bj < 2; ++bj) { f32x4 v0 = acc[ai][bj][m][0], v1 = acc[ai][bj][m][1];
                    if (gate) {
#pragma unroll
                        for (int j = 0; j < 4; ++j) { v0[j] = sigm(v0[j]); v1[j] = sigm(v1[j]); } }
                    u32x4 w; w.x = cvt_pk_bf16(v0[0], v0[1]); w.y = cvt_pk_bf16(v0[2], v0[3]); w.z = cvt_pk_bf16(v1[0], v1[1]); w.w = cvt_pk_bf16(v1[2], v1[3]);
                    *(u32x4*)(P16 + row * NPAD + col0 + bj * HALF) = w;
 } }
    }
};
struct EpiGate {
    static constexpr bool PERM = true;
    bf16_t* GS; const bf16_t* P16;
    __device__ __forceinline__ bool keep(const Unit& u) const { return (u.pn >> 2) < 2; }
    __device__ __forceinline__ void operator()(f32x4 (&acc)[2][2][4][2], const Unit& u, int wr, int wc, int fr, int fq) const {
        const int n = u.pn >> 2, row0 = u.pm * BM + wr * 64 + fr, col0 = (u.pn & 3) * BM + wc * 32 + 8 * fq;
#pragma unroll
        for (int ai = 0; ai < 2; ++ai) {
            u32x4 gwv[4][2], hwv[4][2];
#pragma unroll
            for (int m = 0; m < 4; ++m)
#pragma unroll
                for (int bj = 0; bj < 2; ++bj) { const size_t row = (size_t)(row0 + ai * HALF + m * 16);
                    gwv[m][bj] = *(const u32x4*)(P16 + row * NPAD + C_GL + n * 1024 + col0 + bj * HALF);
                    if (n < 2) hwv[m][bj] = *(const u32x4*)(P16 + row * NPAD + C_GL + (n + 1) * 1024 + col0 + bj * HALF); else hwv[m][bj] = gwv[m][bj]; }
#pragma unroll
            for (int m = 0; m < 4; ++m)
#pragma unroll
                for (int bj = 0; bj < 2; ++bj) { const size_t row = (size_t)(row0 + ai * HALF + m * 16); f32x4& v0 = acc[ai][bj][m][0]; f32x4& v1 = acc[ai][bj][m][1];
                    const u32x4 gw = gwv[m][bj], hw = hwv[m][bj];
                    const float g[8] = {lo_bf(gw.x), hi_bf(gw.x), lo_bf(gw.y), hi_bf(gw.y), lo_bf(gw.z), hi_bf(gw.z), lo_bf(gw.w), hi_bf(gw.w)};
                    if (n < 2) { const float h[8] = {lo_bf(hw.x), hi_bf(hw.x), lo_bf(hw.y), hi_bf(hw.y), lo_bf(hw.z), hi_bf(hw.z), lo_bf(hw.w), hi_bf(hw.w)};
#pragma unroll
                        for (int j = 0; j < 4; ++j) { v0[j] *= g[j] * __builtin_amdgcn_rcpf(h[j]); v1[j] *= g[4 + j] * __builtin_amdgcn_rcpf(h[4 + j]); }
                    } else { u32x4 w;
                        w.x = cvt_pk_bf16(v0[0] * g[0], v0[1] * g[1]); w.y = cvt_pk_bf16(v0[2] * g[2], v0[3] * g[3]);
                        w.z = cvt_pk_bf16(v1[0] * g[4], v1[1] * g[5]); w.w = cvt_pk_bf16(v1[2] * g[6], v1[3] * g[7]);
                        *(u32x4*)(GS + row * D + col0 + bj * HALF) = w; } }
        }
    }
};
struct BranchOrder {
    StaticOrder so; int G;
    __device__ __forceinline__ void init(int G_, int c_) { so.init(M, 1024, G_, c_, 0); G = G_; }
    __device__ __forceinline__ bool next(int i, Unit& u) const { Unit t; if (!so.next(i / 3, t)) return false; const int n = i % 3; u.pm = t.pm; u.pn = n * 4 + t.pn; u.ka = n; return true; }
};
struct EpiRes {
    __device__ __forceinline__ bool keep(const Unit&) const { return false; }
    static constexpr bool PERM = true;
    bf16_t* X; const float* S32;
    __device__ __forceinline__ void operator()(f32x4 (&acc)[2][2][4][2], const Unit& u, int wr, int wc, int fr, int fq) const {
        const int row0 = u.pm * BM + wr * 64 + fr, col0 = u.pn * BM + wc * 32 + 8 * fq;
#pragma unroll
        for (int ai = 0; ai < 2; ++ai)
#pragma unroll
            for (int m = 0; m < 4; ++m) { const size_t ro = (size_t)(row0 + ai * HALF + m * 16) * D + col0;
#pragma unroll
                for (int bj = 0; bj < 2; ++bj) { f32x4 v0 = acc[ai][bj][m][0], v1 = acc[ai][bj][m][1];
                    if (S32) { v0 = v0 + *(const f32x4*)(S32 + ro + bj * HALF); v1 = v1 + *(const f32x4*)(S32 + ro + bj * HALF + 4); }
                    else { const u32x4 sw = *(const u32x4*)(X + ro + bj * HALF); v0[0] += lo_bf(sw.x); v0[1] += hi_bf(sw.x); v0[2] += lo_bf(sw.y); v0[3] += hi_bf(sw.y); v1[0] += lo_bf(sw.z); v1[1] += hi_bf(sw.z); v1[2] += lo_bf(sw.w); v1[3] += hi_bf(sw.w); }
                    u32x4 w; w.x = cvt_pk_bf16(v0[0], v0[1]); w.y = cvt_pk_bf16(v0[2], v0[3]); w.z = cvt_pk_bf16(v1[0], v1[1]); w.w = cvt_pk_bf16(v1[2], v1[3]);
                    *(u32x4*)(X + ro + bj * HALF) = w; } }
    }
};
struct EpiB16 {
    __device__ __forceinline__ bool keep(const Unit&) const { return false; }
    static constexpr bool PERM = true;
    bf16_t* O; int ldc;
    __device__ __forceinline__ void operator()(f32x4 (&acc)[2][2][4][2], const Unit& u, int wr, int wc, int fr, int fq) const {
        const int row0 = u.pm * BM + wr * 64 + fr, col0 = u.pn * BM + wc * 32 + 8 * fq;
#pragma unroll
        for (int ai = 0; ai < 2; ++ai)
#pragma unroll
            for (int m = 0; m < 4; ++m) { bf16_t* rowp = O + (size_t)(row0 + ai * HALF + m * 16) * ldc + col0;
#pragma unroll
                for (int bj = 0; bj < 2; ++bj) { const f32x4 v0 = acc[ai][bj][m][0], v1 = acc[ai][bj][m][1];
                    u32x4 w; w.x = cvt_pk_bf16(v0[0], v0[1]); w.y = cvt_pk_bf16(v0[2], v0[3]); w.z = cvt_pk_bf16(v1[0], v1[1]); w.w = cvt_pk_bf16(v1[2], v1[3]);
                    *(u32x4*)(rowp + bj * HALF) = w; } }
    }
};
}

struct Args {
    const float* x; const int* pos; const float* norm1; const float* w_in; const float* lb_logits; const float* hgrn_gain; const float* gmlp_gain; const float* gmlp_ws; const float* gmlp_bs;
    const float* w_branch; const float* w_out; const float* norm2; const float* peer_wq; const float* peer_keys; const float* peer_u; const float* peer_v; const float* final_gain;
    float* out; unsigned char* ws; int ph_lo, ph_hi;
};
constexpr int NTHR = 512, NWAVE = 8;
constexpr int LDS_BYTES = 147456;
constexpr int LDS_CTL_OFF = 143360;

__device__ __forceinline__ void tr_item(const float* src, int ldsrc, int c0, int nvalid, bf16_t* dst, int ldd, int r0, int koff, float* scr, int item, int nblk, int lane) {
    const int kb = item / nblk, nb = item % nblk, k0 = 64 * kb, n0 = 32 * nb;
    const int nn = n0 + (lane & 31);
    float tv[32];
#pragma unroll
    for (int i = 0; i < 32; ++i) { const int kk = 2 * i + (lane >> 5); tv[i] = (nn < nvalid) ? src[(size_t)(k0 + kk) * ldsrc + c0 + nn] : 0.f; }
#pragma unroll
    for (int i = 0; i < 32; ++i) { const int kk = 2 * i + (lane >> 5); scr[kk * 33 + (lane & 31)] = tv[i]; }
    asm volatile("s_waitcnt lgkmcnt(0)" ::: "memory");
    const int c = lane & 7;
#pragma unroll
    for (int j = 0; j < 4; ++j) { const int n = (lane >> 3) + 8 * j; const float* s = scr + (8 * c) * 33 + n;
        u32x4 o; o.x = pk2(s[0 * 33], s[1 * 33]); o.y = pk2(s[2 * 33], s[3 * 33]); o.z = pk2(s[4 * 33], s[5 * 33]); o.w = pk2(s[6 * 33], s[7 * 33]);
        *(u32x4*)(dst + (size_t)(r0 + n0 + n) * ldd + koff + k0 + 8 * c) = o; }
    asm volatile("s_waitcnt lgkmcnt(0)" ::: "memory");
}
__device__ __forceinline__ void rms_rowb_to_bf16(const bf16_t* xrow, const float* gain, bf16_t* orow, int lane) {
    const u32x4 a0 = *(const u32x4*)(xrow + lane * 16), a1 = *(const u32x4*)(xrow + lane * 16 + 8); const unsigned w[8] = {a0.x, a0.y, a0.z, a0.w, a1.x, a1.y, a1.z, a1.w};
    float v[16], s = 0.f;
#pragma unroll
    for (int j = 0; j < 8; ++j) { v[2 * j] = lo_bf(w[j]); v[2 * j + 1] = hi_bf(w[j]); s += v[2 * j] * v[2 * j] + v[2 * j + 1] * v[2 * j + 1]; }
    const float r = rsqrtf(wave_sum(s) * (1.f / D) + EPS);
    const f32x4* gp = (const f32x4*)(gain + lane * 16); const f32x4 g0 = gp[0], g1 = gp[1], g2 = gp[2], g3 = gp[3];
    const float g[16] = {g0.x, g0.y, g0.z, g0.w, g1.x, g1.y, g1.z, g1.w, g2.x, g2.y, g2.z, g2.w, g3.x, g3.y, g3.z, g3.w};
    u32x4 o0, o1; unsigned ow[8];
#pragma unroll
    for (int j = 0; j < 8; ++j) ow[j] = pk2(v[2 * j] * r * g[2 * j], v[2 * j + 1] * r * g[2 * j + 1]);
    o0 = (u32x4){ow[0], ow[1], ow[2], ow[3]}; o1 = (u32x4){ow[4], ow[5], ow[6], ow[7]};
    *(u32x4*)(orow + lane * 16) = o0; *(u32x4*)(orow + lane * 16 + 8) = o1;
}
__device__ __forceinline__ void rms_row_to_bf16(const float* xrow, const float* gain, bf16_t* orow, int lane) {
    const f32x4* xr = (const f32x4*)xrow + lane; const f32x4* gr = (const f32x4*)gain + lane;
    f32x4 v[4]; float s = 0.f;
#pragma unroll
    for (int j = 0; j < 4; ++j) { v[j] = xr[64 * j]; s += (v[j].x * v[j].x + v[j].y * v[j].y) + (v[j].z * v[j].z + v[j].w * v[j].w); }
    const float r = rsqrtf(wave_sum(s) * (1.f / D) + EPS);
    unsigned long long* o8 = (unsigned long long*)orow + lane;
#pragma unroll
    for (int j = 0; j < 4; ++j) { const f32x4 g = gr[64 * j]; o8[64 * j] = (unsigned long long)pk2(v[j].x * r * g.x, v[j].y * r * g.y) | ((unsigned long long)pk2(v[j].z * r * g.z, v[j].w * r * g.w) << 32); }
}

__device__ __forceinline__ void ph_prologue(const Args& a, unsigned char* lds, int wv) {
    const int tid = otid(wv), lane = tid & 63, wave = tid >> 6;
    const int gw = blockIdx.x * NWAVE + wave, ngw = gridDim.x * NWAVE;
    const size_t gtid = (size_t)blockIdx.x * NTHR + tid, gsz = (size_t)gridDim.x * NTHR;
    unsigned char* ws = oport(a.ws);
    float* scr = (float*)(lds + wave * 16384);
    constexpr int I_IN1 = 16 * 160, I_IN2 = 16 * 8, I_IN3 = 16 * 96, I_IN = I_IN1 + I_IN2 + I_IN3;
    constexpr int I_BR = 3 * 8 * 32, I_OUT = 16 * 32, I_PQ = 16 * 64, I_L = I_IN + I_BR + I_OUT + I_PQ;
    for (int it = gw; it < DEPTH * I_L; it += ngw) {
        const int l = it / I_L; int r = it % I_L;
        bf16_t* win = (bf16_t*)(ws + WS_WIN + (size_t)l * WIN_L); const float* src_in = a.w_in + (size_t)l * D * NIN;
        if (r < I_IN1) { tr_item(src_in, NIN, 0, 5120, win, D, 0, 0, scr, r, 160, lane); continue; } r -= I_IN1;
        if (r < I_IN2) { tr_item(src_in, NIN, 5120, 72, win, D, C_KI, 0, scr, r, 8, lane); continue; } r -= I_IN2;
        if (r < I_IN3) { tr_item(src_in, NIN, S_GL, 3072, win, D, C_GL, 0, scr, r, 96, lane); continue; } r -= I_IN3;
        if (r < I_BR) { const int n = r / 256; tr_item(a.w_branch + ((size_t)l * 3 + n) * 512 * D, D, 0, 1024, (bf16_t*)(ws + WS_WBR + (size_t)l * WBR_L), 512, n * 1024, 0, scr, r % 256, 32, lane); continue; } r -= I_BR;
        if (r < I_OUT) { tr_item(a.w_out + (size_t)l * D * D, D, 0, 1024, (bf16_t*)(ws + WS_WOUT + (size_t)l * WOUT_L), D, 0, 0, scr, r, 32, lane); continue; } r -= I_OUT;
        tr_item(a.peer_wq + (size_t)l * D * 2048, 2048, 0, 2048, (bf16_t*)(ws + WS_WPQ + (size_t)l * WPQ_L), D, 0, 0, scr, r, 64, lane);
    }
    if (gtid < 512) { float v[DEPTH], mx = -1e30f; for (int l = 0; l < DEPTH; ++l) { v[l] = a.lb_logits[l * 512 + gtid]; mx = fmaxf(mx, v[l]); }
        float s = 0.f; for (int l = 0; l < DEPTH; ++l) { v[l] = __expf(v[l] - mx); s += v[l]; }
        float c = 0.f; float* lb = (float*)(ws + WS_LB); for (int l = 0; l < DEPTH; ++l) { if (l > 0) c += v[l] / s; lb[l * 512 + gtid] = c; } }
    { u32x4* SKB = (u32x4*)(ws + WS_SKB); const f32x4* sk = (const f32x4*)a.peer_keys; for (size_t i = gtid; i < (size_t)DEPTH * 16 * 128 * 128 / 8; i += gsz) { const f32x4 k0 = sk[2 * i], k1 = sk[2 * i + 1]; SKB[i] = (u32x4){pk2(k0.x, k0.y), pk2(k0.z, k0.w), pk2(k1.x, k1.y), pk2(k1.z, k1.w)}; } }
    { bf16_t* WSB = (bf16_t*)(ws + WS_WSB); for (size_t i = gtid; i < (size_t)DEPTH * 4 * 128 * 128; i += gsz) { const int t = (int)((i >> 7) & 127), sx = (int)(i & 127); WSB[i] = (bf16_t)f2bf(sx <= t ? a.gmlp_ws[i] : 0.f); } }
    { float2* cs = (float2*)(ws + WS_CS);
      for (size_t i = gtid; i < (size_t)M * 96; i += gsz) { const int m = (int)(i / 96), j = (int)(i % 96);
          const float inv = j < 64 ? ROPE_INV64[j] : ROPE_INV32[j - 64]; const float angf = (float)a.pos[m] * inv;
          const double ang = (double)angf; const double k = rint(ang * 0.15915494309189535); const float r = (float)(ang - k * 6.283185307179586);
          cs[i] = make_float2(__cosf(r), __sinf(r)); } }
    for (int m = gw; m < M; m += ngw) rms_row_to_bf16(a.x + (size_t)m * D, a.norm1, (bf16_t*)(ws + WS_H16) + (size_t)m * D, lane);
}

__device__ __forceinline__ void ph_kiwi(const Args& a, int l, unsigned char* lds, int wv) {
    unsigned char* ws = oport(a.ws); const int tid = otid(wv), lane = tid & 63, wave = __builtin_amdgcn_readfirstlane(tid >> 6), fr = lane & 15, fq = lane >> 4;
    const bf16_t* H16 = (const bf16_t*)(ws + WS_H16); const bf16_t* W = (const bf16_t*)(ws + WS_WIN + (size_t)l * WIN_L) + (size_t)C_KI * D; float* PF = (float*)(ws + WS_PF);
    f32x4* sK = (f32x4*)lds;
    bf16x8 xw[5][4];
#pragma unroll
    for (int nt = 0; nt < 5; ++nt)
#pragma unroll
        for (int s = 0; s < 4; ++s) xw[nt][s] = ((const bf16x8*)(W + (size_t)nt * 16 * D + 128 * wave + 32 * s))[fr * (D / 8) + fq];
    for (int base = obid(); base * 4 < M / 16; base += gridDim.x) {
        bf16x8 y[4][4];
#pragma unroll
        for (int g = 0; g < 4; ++g)
#pragma unroll
            for (int s = 0; s < 4; ++s) y[g][s] = ((const bf16x8*)(H16 + (size_t)(base * 4 + g) * 16 * D + 128 * wave + 32 * s))[fr * (D / 8) + fq];
#pragma unroll
        for (int g = 0; g < 4; ++g) { f32x4 acc[5];
#pragma unroll
            for (int nt = 0; nt < 5; ++nt) acc[nt] = (f32x4){0.f, 0.f, 0.f, 0.f};
#pragma unroll
            for (int s = 0; s < 4; ++s)
#pragma unroll
                for (int nt = 0; nt < 5; ++nt) acc[nt] = __builtin_amdgcn_mfma_f32_16x16x32_bf16(xw[nt][s], y[g][s], acc[nt], 0, 0, 0);
            f32x4* buf = sK + (g & 1) * 8 * 320;
#pragma unroll
            for (int nt = 0; nt < 5; ++nt) buf[wave * 320 + nt * 64 + lane] = acc[nt];
            __syncthreads();
            if (wave < 5) { f32x4 t = buf[wave * 64 + lane];
#pragma unroll
                for (int w2 = 1; w2 < 8; ++w2) t += buf[w2 * 320 + wave * 64 + lane];
                *(f32x4*)(PF + ((size_t)(base * 4 + g) * 16 + fr) * PFW + 512 + 16 * wave + 4 * fq) = t; } }
    }
    __syncthreads();
}

__device__ __forceinline__ void ph_post(const Args& a, int l, unsigned char* lds, int wv) {
    const int tid = otid(wv), lane = tid & 63, wave = tid >> 6;
    const int gw = obid() * NWAVE + wave, ngw = gridDim.x * NWAVE;
    const size_t gtid = (size_t)obid() * NTHR + tid, gsz = (size_t)gridDim.x * NTHR;
    unsigned char* ws = oport(a.ws);
    const bf16_t* P16 = (const bf16_t*)(ws + WS_P16); const float* PF = (const float*)(ws + WS_PF); const float2* cs = (const float2*)(ws + WS_CS);
    { bf16_t* QR = (bf16_t*)(ws + WS_QR); bf16_t* KR = (bf16_t*)(ws + WS_KR);
      const float sc = 0.08838834764831845f * 1.4426950408889634f;
#pragma unroll 2
      for (size_t i = gtid; i < (size_t)M * 32; i += gsz) { const int m = (int)(i >> 5), h = (int)((i >> 3) & 3), j = 8 * (int)(i & 7);
          const size_t pb = (size_t)m * NPAD + h * 128 + j, ob = (size_t)m * 512 + h * 128 + j;
          const u32x4 q1w = *(const u32x4*)(P16 + pb + C_CQ), q2w = *(const u32x4*)(P16 + pb + C_CQ + 64), k1w = *(const u32x4*)(P16 + pb + C_CK), k2w = *(const u32x4*)(P16 + pb + C_CK + 64);
          const f32x4* cp = (const f32x4*)(cs + (size_t)m * 96 + j); const f32x4 c0 = cp[0], c1 = cp[1], c2 = cp[2], c3 = cp[3];
          const float cx[8] = {c0.x, c0.z, c1.x, c1.z, c2.x, c2.z, c3.x, c3.z}, cy[8] = {c0.y, c0.w, c1.y, c1.w, c2.y, c2.w, c3.y, c3.w};
          const unsigned q1u[4] = {q1w.x, q1w.y, q1w.z, q1w.w}, q2u[4] = {q2w.x, q2w.y, q2w.z, q2w.w}, k1u[4] = {k1w.x, k1w.y, k1w.z, k1w.w}, k2u[4] = {k2w.x, k2w.y, k2w.z, k2w.w};
          unsigned oq1[4], oq2[4], ok1[4], ok2[4];
#pragma unroll
          for (int e = 0; e < 4; ++e) { const float qa0 = lo_bf(q1u[e]), qa1 = hi_bf(q1u[e]), qb0 = lo_bf(q2u[e]), qb1 = hi_bf(q2u[e]), ka0 = lo_bf(k1u[e]), ka1 = hi_bf(k1u[e]), kb0 = lo_bf(k2u[e]), kb1 = hi_bf(k2u[e]);
              const float x0 = cx[2 * e], y0 = cy[2 * e], x1 = cx[2 * e + 1], y1 = cy[2 * e + 1];
              oq1[e] = pk2((qa0 * x0 - qb0 * y0) * sc, (qa1 * x1 - qb1 * y1) * sc); oq2[e] = pk2((qb0 * x0 + qa0 * y0) * sc, (qb1 * x1 + qa1 * y1) * sc);
              ok1[e] = pk2(ka0 * x0 - kb0 * y0, ka1 * x1 - kb1 * y1); ok2[e] = pk2(kb0 * x0 + ka0 * y0, kb1 * x1 + ka1 * y1); }
          *(u32x4*)(QR + ob) = (u32x4){oq1[0], oq1[1], oq1[2], oq1[3]}; *(u32x4*)(QR + ob + 64) = (u32x4){oq2[0], oq2[1], oq2[2], oq2[3]};
          *(u32x4*)(KR + ob) = (u32x4){ok1[0], ok1[1], ok1[2], ok1[3]}; *(u32x4*)(KR + ob + 64) = (u32x4){ok2[0], ok2[1], ok2[2], ok2[3]}; } }
    { bf16_t* QS = (bf16_t*)(ws + WS_QI); bf16_t* KIb = (bf16_t*)(ws + WS_KI); float* WP = (float*)(ws + WS_WI);
#pragma unroll 2
      for (int m = gw; m < M; m += ngw) { const int h = lane >> 3, jj = lane & 7;
          const unsigned long long w1 = *(const unsigned long long*)(P16 + (size_t)m * NPAD + C_QI + h * 64 + 4 * jj), w2 = *(const unsigned long long*)(P16 + (size_t)m * NPAD + C_QI + h * 64 + 32 + 4 * jj);
          const float q1[4] = {lo_bf((unsigned)w1), hi_bf((unsigned)w1), lo_bf((unsigned)(w1 >> 32)), hi_bf((unsigned)(w1 >> 32))}, q2[4] = {lo_bf((unsigned)w2), hi_bf((unsigned)w2), lo_bf((unsigned)(w2 >> 32)), hi_bf((unsigned)(w2 >> 32))};
          const float2* c = cs + (size_t)m * 96 + 64 + 4 * jj; const float w = PF[(size_t)m * PFW + 576 + h] * 0.02209708691207961f;
          float r1[4], r2[4], l1[4], l2[4];
#pragma unroll
          for (int i = 0; i < 4; ++i) { const float2 cc = c[i]; r1[i] = q1[i] * cc.x - q2[i] * cc.y; r2[i] = q2[i] * cc.x + q1[i] * cc.y; l1[i] = w * r1[i]; l2[i] = w * r2[i]; }
          *(unsigned long long*)(QS + (size_t)m * 576 + h * 64 + 4 * jj) = (unsigned long long)pk2(r1[0], r1[1]) | ((unsigned long long)pk2(r1[2], r1[3]) << 32);
          *(unsigned long long*)(QS + (size_t)m * 576 + h * 64 + 32 + 4 * jj) = (unsigned long long)pk2(r2[0], r2[1]) | ((unsigned long long)pk2(r2[2], r2[3]) << 32);
#pragma unroll
          for (int i = 0; i < 4; ++i) { l1[i] += shx_f(l1[i], 8); l1[i] = xsum16(l1[i]); l1[i] = xsum32(l1[i]); l2[i] += shx_f(l2[i], 8); l2[i] = xsum16(l2[i]); l2[i] = xsum32(l2[i]); }
          if (h == 0) { *(unsigned long long*)(QS + (size_t)m * 576 + 512 + 4 * jj) = (unsigned long long)pk2(l1[0], l1[1]) | ((unsigned long long)pk2(l1[2], l1[3]) << 32);
                        *(unsigned long long*)(QS + (size_t)m * 576 + 512 + 32 + 4 * jj) = (unsigned long long)pk2(l2[0], l2[1]) | ((unsigned long long)pk2(l2[2], l2[3]) << 32);
                        const f32x4 k1 = *(const f32x4*)(PF + (size_t)m * PFW + 512 + 4 * jj), k2 = *(const f32x4*)(PF + (size_t)m * PFW + 512 + 32 + 4 * jj);
                        const float kk1[4] = {k1.x, k1.y, k1.z, k1.w}, kk2[4] = {k2.x, k2.y, k2.z, k2.w}; float o1[4], o2[4];
#pragma unroll
                        for (int i = 0; i < 4; ++i) { const float2 cc = c[i]; o1[i] = kk1[i] * cc.x - kk2[i] * cc.y; o2[i] = kk2[i] * cc.x + kk1[i] * cc.y; }
                        *(unsigned long long*)(KIb + (size_t)m * 64 + 4 * jj) = (unsigned long long)pk2(o1[0], o1[1]) | ((unsigned long long)pk2(o1[2], o1[3]) << 32);
                        *(unsigned long long*)(KIb + (size_t)m * 64 + 32 + 4 * jj) = (unsigned long long)pk2(o2[0], o2[1]) | ((unsigned long long)pk2(o2[2], o2[3]) << 32); }
          if (jj == 0) WP[(size_t)m * 8 + h] = w; } }
    { bf16_t* VT = (bf16_t*)(ws + WS_VT); bf16_t* sT = (bf16_t*)lds;
      for (int t0 = obid() * 8; t0 < (M / 64) * 8; t0 += gridDim.x * 8) {
          u32x4 w[8]; const int row = tid >> 3, seg = tid & 7;
#pragma unroll
          for (int q = 0; q < 8; ++q) { const int tile = t0 + q, tb = tile >> 3, cb = tile & 7; w[q] = *(const u32x4*)(P16 + (size_t)(tb * 64 + row) * NPAD + C_CV + cb * 64 + seg * 8); }
          __syncthreads();
#pragma unroll
          for (int q = 0; q < 8; ++q) { unsigned* d = (unsigned*)(sT + q * 64 * 66 + row * 66 + seg * 8); d[0] = w[q].x; d[1] = w[q].y; d[2] = w[q].z; d[3] = w[q].w; }
          __syncthreads();
          const int ch = tid >> 3, tg = tid & 7;
#pragma unroll
          for (int q = 0; q < 8; ++q) { const int tile = t0 + q, tb = tile >> 3, cb = tile & 7; unsigned short v[8];
#pragma unroll
              for (int i = 0; i < 8; ++i) v[i] = sT[q * 64 * 66 + (tg * 8 + i) * 66 + ch];
              const u32x4 o = {(unsigned)v[0] | ((unsigned)v[1] << 16), (unsigned)v[2] | ((unsigned)v[3] << 16), (unsigned)v[4] | ((unsigned)v[5] << 16), (unsigned)v[6] | ((unsigned)v[7] << 16)};
              *(u32x4*)(VT + ((size_t)((tb >> 7) * 512 + cb * 64 + ch)) * SEQ + (tb & 127) * 64 + tg * 8) = o; } }
      __syncthreads(); }
    { bf16_t* VN = (bf16_t*)(ws + WS_VN); const float* gain = a.gmlp_gain + l * 512;
#pragma unroll 4
      for (int m = gw; m < M; m += ngw) { const u32x4 w = *(const u32x4*)(P16 + (size_t)m * NPAD + C_BV + lane * 8);
          float v[8] = {gelu_t(lo_bf(w.x)), gelu_t(hi_bf(w.x)), gelu_t(lo_bf(w.y)), gelu_t(hi_bf(w.y)), gelu_t(lo_bf(w.z)), gelu_t(hi_bf(w.z)), gelu_t(lo_bf(w.w)), gelu_t(hi_bf(w.w))};
          float sm = 0.f;
#pragma unroll
          for (int j = 0; j < 8; ++j) sm += v[j] * v[j];
          const float r = rsqrtf(wave_sum(sm) * (1.f / 512.f) + EPS);
          const f32x4 g0 = *(const f32x4*)(gain + lane * 8), g1 = *(const f32x4*)(gain + lane * 8 + 4);
          *(u32x4*)(VN + (size_t)m * 512 + lane * 8) = (u32x4){pk2(v[0] * r * g0.x, v[1] * r * g0.y), pk2(v[2] * r * g0.z, v[3] * r * g0.w), pk2(v[4] * r * g1.x, v[5] * r * g1.y), pk2(v[6] * r * g1.z, v[7] * r * g1.w)}; } }
}

constexpr int NHU = BATCH * 128 * 4;
__device__ __forceinline__ void ph_h1(const Args& a, int l, unsigned char* lds, int wv) {
    unsigned char* ws = oport(a.ws);
    const int tid = otid(wv), lane = tid & 63, wave = __builtin_amdgcn_readfirstlane(tid >> 6), j = wave >> 1, d = tid & 127, fr = lane & 15, fq = lane >> 4;
    bf16_t* KT = (bf16_t*)lds;
    bf16_t* VT = KT + 128 * 72;
    float* sT = (float*)(VT + 128 * 72);
    const float* PF = (const float*)(ws + WS_PF); const bf16_t* P16 = (const bf16_t*)(ws + WS_P16); const float* LB = (const float*)(ws + WS_LB) + l * 512;
    bf16_t* LL = (bf16_t*)(ws + WS_FF); float* DD = (float*)(ws + WS_DD);
    unsigned short zr[16], vr[16]; float lbn = 0.f;
#define H1_LOAD(u_) do { const int h_ = (u_) & 3, c_ = ((u_) >> 2) & 127, b_ = (u_) >> 9; const size_t m_ = (size_t)b_ * SEQ + c_ * 64 + j * 16; lbn = LB[h_ * 128 + d]; \
        _Pragma("unroll") for (int i = 0; i < 16; ++i) { zr[i] = P16[(m_ + i) * NPAD + C_AF + h_ * 128 + d]; vr[i] = P16[(m_ + i) * NPAD + C_AI + h_ * 128 + d]; } } while (0)
    { const int u0 = obid(); if (u0 < NHU) H1_LOAD(u0); }
    for (int u = obid(); u < NHU; u += gridDim.x) {
        const int h = u & 3, c = (u >> 2) & 127, b = u >> 9; const size_t m0 = (size_t)b * SEQ + c * 64 + j * 16;
        const float lbv = lbn;
        float cs[16], ky[16]; unsigned vv[16]; float run = 0.f;
#pragma unroll
        for (int i = 0; i < 16; ++i) { const float z = bf2f(zr[i]); const float sg = sigm(z); run += __logf(lbv + (1.f - lbv) * sg); cs[i] = run; ky[i] = (1.f - lbv) * (1.f - sg);
            vv[i] = vr[i]; }
        { const int un = u + gridDim.x; if (un < NHU) H1_LOAD(un); }
        sT[j * 128 + d] = run;
        __syncthreads();
        float tail = 0.f;
#pragma unroll
        for (int jj = 1; jj < 4; ++jj) if (jj > j) tail += sT[jj * 128 + d];
        { unsigned w[8], x[8];
#pragma unroll
          for (int i = 0; i < 8; ++i) { w[i] = pk2(ky[2 * i] * __expf(tail + (run - cs[2 * i])), ky[2 * i + 1] * __expf(tail + (run - cs[2 * i + 1]))); x[i] = vv[2 * i] | (vv[2 * i + 1] << 16); }
          u32x4* kp = (u32x4*)(KT + d * 72 + j * 16); kp[0] = (u32x4){w[0], w[1], w[2], w[3]}; kp[1] = (u32x4){w[4], w[5], w[6], w[7]};
          u32x4* vp = (u32x4*)(VT + d * 72 + j * 16); vp[0] = (u32x4){x[0], x[1], x[2], x[3]}; vp[1] = (u32x4){x[4], x[5], x[6], x[7]}; }
        if (j == 0) DD[(size_t)u * 128 + d] = __expf(run + tail);
        __syncthreads();
        { bf16x8 xk[2];
#pragma unroll
          for (int ks = 0; ks < 2; ++ks) xk[ks] = *(const bf16x8*)(KT + (16 * wave + fr) * 72 + ks * 32 + fq * 8);
#pragma unroll
          for (int nt = 0; nt < 8; ++nt) { f32x4 acc = {0.f, 0.f, 0.f, 0.f};
#pragma unroll
              for (int ks = 0; ks < 2; ++ks) { const bf16x8 y = *(const bf16x8*)(VT + (16 * nt + fr) * 72 + ks * 32 + fq * 8); acc = __builtin_amdgcn_mfma_f32_16x16x32_bf16(xk[ks], y, acc, 0, 0, 0); }
              *(unsigned long long*)(LL + ((size_t)u * 128 + 16 * nt + fr) * 128 + 16 * wave + 4 * fq) = (unsigned long long)pk2(acc[0], acc[1]) | ((unsigned long long)pk2(acc[2], acc[3]) << 32); } }
        __syncthreads();
    }
}
#undef H1_LOAD
__device__ __forceinline__ void ph_h2(const Args& a, int wv) {
    unsigned char* ws = oport(a.ws);
    const bf16_t* LL = (const bf16_t*)(ws + WS_FF); const float* DD = (const float*)(ws + WS_DD); bf16_t* SB = (bf16_t*)(ws + WS_QF);
    for (int e = obid() * NTHR + otid(wv); e < 8 * 16384; e += gridDim.x * NTHR) { const int bh = e >> 14, b = bh >> 2, h = bh & 3, dvdk = e & 16383, dk = e & 127; float S = 0.f;
        const size_t u0 = (size_t)((b * 128) << 2) + h;
        unsigned short ll[2][16]; float dd[2][16];
#pragma unroll
        for (int i = 0; i < 16; ++i) { const size_t u = u0 + 4 * i; ll[0][i] = LL[u * 16384 + dvdk]; dd[0][i] = DD[u * 128 + dk]; }
#pragma unroll 1
        for (int r = 0; r < 8; r += 2) {
#pragma unroll
            for (int i = 0; i < 16; ++i) { const size_t u = u0 + 4 * (16 * (r + 1) + i); ll[1][i] = LL[u * 16384 + dvdk]; dd[1][i] = DD[u * 128 + dk]; }
#pragma unroll
            for (int i = 0; i < 16; ++i) { const size_t u = u0 + 4 * (16 * r + i); SB[u * 16384 + dvdk] = (bf16_t)f2bf(S); S = dd[0][i] * S + bf2f(ll[0][i]); }
            const int rn = r + 2 < 8 ? r + 2 : r;
#pragma unroll
            for (int i = 0; i < 16; ++i) { const size_t u = u0 + 4 * (16 * rn + i); ll[0][i] = LL[u * 16384 + dvdk]; dd[0][i] = DD[u * 128 + dk]; }
#pragma unroll
            for (int i = 0; i < 16; ++i) { const size_t u = u0 + 4 * (16 * (r + 1) + i); SB[u * 16384 + dvdk] = (bf16_t)f2bf(S); S = dd[1][i] * S + bf2f(ll[1][i]); } } }
}
__device__ __forceinline__ void ph_h3(const Args& a, int l, unsigned char* lds, int wv) {
    unsigned char* ws = oport(a.ws);
    const int tid = otid(wv), lane = tid & 63, wave = __builtin_amdgcn_readfirstlane(tid >> 6), j = wave >> 1, d = tid & 127, fr = lane & 15, fq = lane >> 4;
    bf16_t* QT = (bf16_t*)lds;
    bf16_t* QH = QT + 64 * 136;
    bf16_t* KI = QH + 64 * 136;
    bf16_t* VT = KI + 160 * 136;
    bf16_t* AT = VT + 128 * 72;
    float* sT = (float*)(AT + 64 * 72);
    float* sSS = sT + 512;
    const float* PF = (const float*)(ws + WS_PF); const bf16_t* P16 = (const bf16_t*)(ws + WS_P16); const float* LB = (const float*)(ws + WS_LB) + l * 512;
    const bf16_t* SB = (const bf16_t*)(ws + WS_QF); bf16_t* YA = (bf16_t*)(ws + WS_YALL); const float* gain = a.hgrn_gain + l * 128;
    float gn4[4];
#pragma unroll
    for (int q4 = 0; q4 < 4; ++q4) gn4[q4] = gain[16 * (4 * (wave >> 2) + q4) + fr];
    unsigned short zr[16], qr[16]; float lbn = 0.f;
#define H3_LOAD(u_) do { const int h_ = (u_) & 3, c_ = ((u_) >> 2) & 127, b_ = (u_) >> 9; const size_t m_ = (size_t)b_ * SEQ + c_ * 64 + j * 16; lbn = LB[h_ * 128 + d]; \
        _Pragma("unroll") for (int i = 0; i < 16; ++i) { const size_t pr_ = (m_ + i) * NPAD + h_ * 128 + d; zr[i] = P16[pr_ + C_AF]; qr[i] = P16[pr_ + C_AQ]; } } while (0)
    { const int u0 = obid(); if (u0 < NHU) H3_LOAD(u0); }
    for (int u = obid(); u < NHU; u += gridDim.x) {
        const int h = u & 3, c = (u >> 2) & 127, b = u >> 9; const size_t mc = (size_t)b * SEQ + c * 64, m0 = mc + j * 16;
        for (int i = tid; i < 64 * 72 * 2 / 16; i += NTHR) ((u32x4*)AT)[i] = (u32x4){0u, 0u, 0u, 0u};
        bf16x8 sbf[4][4];
#pragma unroll
        for (int q4 = 0; q4 < 4; ++q4)
#pragma unroll
            for (int ks = 0; ks < 4; ++ks) sbf[q4][ks] = ((const bf16x8*)(SB + ((size_t)u * 128 + 16 * (4 * (wave >> 2) + q4)) * 128 + 32 * ks))[fr * 16 + fq];
        const float lbv = lbn;
        float cs[16], ky[16], qf[16]; unsigned vv[16]; float run = 0.f;
#pragma unroll
        for (int i = 0; i < 16; ++i) { const float z = bf2f(zr[i]); const float sg = sigm(z); run += __logf(lbv + (1.f - lbv) * sg); cs[i] = run; ky[i] = (1.f - lbv) * (1.f - sg);
            qf[i] = silu(bf2f(qr[i])) * 0.08838834764831845f; vv[i] = P16[(m0 + i) * NPAD + h * 128 + d + C_AI]; }
        { const int un = u + gridDim.x; if (un < NHU) H3_LOAD(un); }
        sT[j * 128 + d] = run;
        __syncthreads();
        const float T0 = sT[d], T1 = sT[128 + d], T2 = sT[256 + d];
        const float Bj = (j > 0 ? T0 : 0.f) + (j > 1 ? T1 : 0.f) + (j > 2 ? T2 : 0.f); const float eBj = __expf(Bj);
        float pre[4]; pre[0] = 0.f; pre[1] = (j < 1 ? T0 : 0.f); pre[2] = (j < 1 ? T0 : 0.f) + (j < 2 ? T1 : 0.f); pre[3] = (j < 1 ? T0 : 0.f) + (j < 2 ? T1 : 0.f) + (j < 3 ? T2 : 0.f);
        float epre[4];
#pragma unroll
        for (int I = 0; I < 4; ++I) epre[I] = __expf(pre[I]);
#pragma unroll
        for (int i = 0; i < 16; ++i) { const int t = 16 * j + i; const float ec = __expf(cs[i]), kn = ky[i] * __expf(fminf(-cs[i], 60.f));
            QT[t * 136 + d] = (bf16_t)f2bf(qf[i] * ec); QH[t * 136 + d] = (bf16_t)f2bf(qf[i] * ec * eBj);
#pragma unroll
            for (int I = 0; I < 4; ++I) if (I >= j) KI[(8 * I * (I + 1) + t) * 136 + d] = (bf16_t)f2bf(kn * epre[I]); }
        { unsigned x[8];
#pragma unroll
          for (int i = 0; i < 8; ++i) x[i] = vv[2 * i] | (vv[2 * i + 1] << 16);
          u32x4* vp = (u32x4*)(VT + d * 72 + j * 16); vp[0] = (u32x4){x[0], x[1], x[2], x[3]}; vp[1] = (u32x4){x[4], x[5], x[6], x[7]}; }
        __syncthreads();
        for (int tl = wave; tl < 10; tl += 8) { const int I = tl < 1 ? 0 : tl < 3 ? 1 : tl < 6 ? 2 : 3, J = tl - (I * (I + 1)) / 2; f32x4 acc = {0.f, 0.f, 0.f, 0.f};
#pragma unroll
            for (int ks = 0; ks < 4; ++ks) { const bf16x8 x = *(const bf16x8*)(QT + (16 * I + fr) * 136 + ks * 32 + fq * 8); const bf16x8 y = *(const bf16x8*)(KI + (8 * I * (I + 1) + 16 * J + fr) * 136 + ks * 32 + fq * 8);
                acc = __builtin_amdgcn_mfma_f32_16x16x32_bf16(x, y, acc, 0, 0, 0); }
#pragma unroll
            for (int r = 0; r < 4; ++r) { float v = acc[r]; if (J == I && fr > 4 * fq + r) v = 0.f; AT[(16 * I + 4 * fq + r) * 72 + 16 * J + fr] = (bf16_t)f2bf(v); } }
        __syncthreads();
        const int I = wave & 3, nt0 = 4 * (wave >> 2); f32x4 o[4];
#pragma unroll
        for (int q4 = 0; q4 < 4; ++q4) { const int nt = nt0 + q4; f32x4 acc = {0.f, 0.f, 0.f, 0.f};
            for (int ks = 0; ks <= (I >> 1); ++ks) { const bf16x8 x = *(const bf16x8*)(AT + (16 * I + fr) * 72 + ks * 32 + fq * 8); const bf16x8 y = *(const bf16x8*)(VT + (16 * nt + fr) * 72 + ks * 32 + fq * 8);
                acc = __builtin_amdgcn_mfma_f32_16x16x32_bf16(x, y, acc, 0, 0, 0); }
#pragma unroll
            for (int ks = 0; ks < 4; ++ks) { const bf16x8 x = *(const bf16x8*)(QH + (16 * I + fr) * 136 + ks * 32 + fq * 8); acc = __builtin_amdgcn_mfma_f32_16x16x32_bf16(x, sbf[q4][ks], acc, 0, 0, 0); }
            o[q4] = acc; }
        unsigned short gg[4][4];
#pragma unroll
        for (int r = 0; r < 4; ++r)
#pragma unroll
            for (int q4 = 0; q4 < 4; ++q4) gg[r][q4] = P16[(mc + 16 * I + 4 * fq + r) * NPAD + C_AG + h * 128 + 16 * (nt0 + q4) + fr];
        { float ssq[4];
#pragma unroll
          for (int r = 0; r < 4; ++r) { float s = o[0][r] * o[0][r] + o[1][r] * o[1][r] + o[2][r] * o[2][r] + o[3][r] * o[3][r]; s += shx_f(s, 1); s += shx_f(s, 2); s += dpp_ror_f(s, 4); s += dpp_ror_f(s, 8); ssq[r] = s; }
          if (fr == 0) {
#pragma unroll
              for (int r = 0; r < 4; ++r) sSS[(16 * I + 4 * fq + r) * 2 + (wave >> 2)] = ssq[r]; } }
        __syncthreads();
#pragma unroll
        for (int r = 0; r < 4; ++r) { const int tt = 16 * I + 4 * fq + r; const float rinv = rsqrtf((sSS[tt * 2] + sSS[tt * 2 + 1]) * (1.f / 128.f) + EPS); const size_t m = mc + tt;
#pragma unroll
            for (int q4 = 0; q4 < 4; ++q4) { const int dv = 16 * (nt0 + q4) + fr; const float g = bf2f(gg[r][q4]);
                YA[m * 512 + h * 128 + dv] = (bf16_t)f2bf(o[q4][r] * rinv * gn4[q4] * silu(g)); } }
        __syncthreads();
    }
}
#undef H3_LOAD
__device__ __forceinline__ void ph_gmlp(const Args& a, int l, unsigned char* lds, int wv) {
    unsigned char* ws = oport(a.ws);
    const int tid = otid(wv), lane = tid & 63, wave = __builtin_amdgcn_readfirstlane(tid >> 6), fr = lane & 15, fq = lane >> 4;
    const bf16_t* P16 = (const bf16_t*)(ws + WS_P16); const bf16_t* VN = (const bf16_t*)(ws + WS_VN); bf16_t* YB = (bf16_t*)(ws + WS_YALL) + (size_t)M * 512;
    const bf16_t* WSB = (const bf16_t*)(ws + WS_WSB) + (size_t)l * 4 * 128 * 128; const float* bs = a.gmlp_bs + (size_t)l * 4 * 128;
    bf16_t* VNt = (bf16_t*)lds;
    for (int u = obid(); u < (M / 128) * 4; u += gridDim.x) { const int g = u & 3, nb = u >> 2; const size_t mb = (size_t)nb * 128;
        __syncthreads();
#pragma unroll
        for (int n = 0; n < 4; ++n) { const int idx = tid + NTHR * n, row = idx >> 4, seg = idx & 15; const u32x4 w = *(const u32x4*)(VN + (mb + row) * 512 + g * 128 + seg * 8);
            bf16_t* d = VNt + (seg * 8) * 136 + row;
            d[0 * 136] = (bf16_t)(w.x & 0xffffu); d[1 * 136] = (bf16_t)(w.x >> 16); d[2 * 136] = (bf16_t)(w.y & 0xffffu); d[3 * 136] = (bf16_t)(w.y >> 16);
            d[4 * 136] = (bf16_t)(w.z & 0xffffu); d[5 * 136] = (bf16_t)(w.z >> 16); d[6 * 136] = (bf16_t)(w.w & 0xffffu); d[7 * 136] = (bf16_t)(w.w >> 16); }
        bf16x8 wf[4];
#pragma unroll
        for (int ks = 0; ks < 4; ++ks) wf[ks] = *(const bf16x8*)(WSB + ((size_t)g * 128 + 16 * wave + fr) * 128 + 32 * ks + 8 * fq);
        __syncthreads();
        const int t = 16 * wave + fr; const float bias = bs[g * 128 + t]; const int nks = (wave >> 1) + 1;
        unsigned long long uwv[8];
#pragma unroll
        for (int ct = 0; ct < 8; ++ct) uwv[ct] = *(const unsigned long long*)(P16 + (mb + t) * NPAD + C_BU + g * 128 + 16 * ct + 4 * fq);
#pragma unroll
        for (int ct = 0; ct < 8; ++ct) { f32x4 acc = {0.f, 0.f, 0.f, 0.f};
#pragma unroll
            for (int ks = 0; ks < 4; ++ks) if (ks < nks) { const bf16x8 x = *(const bf16x8*)(VNt + (16 * ct + fr) * 136 + 32 * ks + 8 * fq); acc = __builtin_amdgcn_mfma_f32_16x16x32_bf16(x, wf[ks], acc, 0, 0, 0); }
            const size_t m = mb + t; const int c = g * 128 + 16 * ct + 4 * fq; const unsigned long long uw = uwv[ct];
            const float o0 = gelu_t(lo_bf((unsigned)uw)) * (acc[0] + bias), o1 = gelu_t(hi_bf((unsigned)uw)) * (acc[1] + bias), o2 = gelu_t(lo_bf((unsigned)(uw >> 32))) * (acc[2] + bias), o3 = gelu_t(hi_bf((unsigned)(uw >> 32))) * (acc[3] + bias);
            *(unsigned long long*)(YB + m * 512 + c) = (unsigned long long)pk2(o0, o1) | ((unsigned long long)pk2(o2, o3) << 32); }
    }
}
constexpr int SEL_CAP = 256;
__device__ __forceinline__ int sel_bin(float s, float lo, float sc) { return (int)__builtin_amdgcn_fmed3f((s - lo) * sc, 0.f, 1023.f); }
struct SelQ { float lo1, sc1, lo2, sc2, tau; int b1, b2, ref, tidx; };
__device__ __forceinline__ void sel_pass(const int mode, const bf16x8 (&qf)[9][2], const float (&wp)[8], const SelQ& sq, const bf16_t* kib, int c, int kp, int qloc, int fr, int fq,
                                         unsigned* sHist, unsigned* sCand, unsigned* sCnt, unsigned* maskrow) {
    bf16x8 af[4][2];
    { const int T0 = kp <= c ? kp : c;
#pragma unroll
      for (int rg = 0; rg < 4; ++rg)
#pragma unroll
          for (int ks = 0; ks < 2; ++ks) af[rg][ks] = ((const bf16x8*)(kib + (size_t)(64 * T0 + 16 * rg) * 64 + 32 * ks))[fr * 8 + fq]; }
    if (kp >= 2) __builtin_amdgcn_s_sleep(4);
#pragma unroll 1
    for (int T = kp; T <= c; T += 4) {
        const int Tn = (T + 4 <= c) ? T + 4 : T;
        unsigned mlo = 0u, mhi = 0u;
#pragma unroll
        for (int rg = 0; rg < 4; ++rg) {
            __builtin_amdgcn_s_setprio(1);
            f32x4 sc, ah[8];
            sc = __builtin_amdgcn_mfma_f32_16x16x32_bf16(af[rg][0], qf[8][0], (f32x4){0.f, 0.f, 0.f, 0.f}, 0, 0, 0);
#pragma unroll
            for (int h = 0; h < 4; ++h) ah[h] = __builtin_amdgcn_mfma_f32_16x16x32_bf16(af[rg][0], qf[h][0], (f32x4){0.f, 0.f, 0.f, 0.f}, 0, 0, 0);
            sc = __builtin_amdgcn_mfma_f32_16x16x32_bf16(af[rg][1], qf[8][1], sc, 0, 0, 0);
#pragma unroll
            for (int h = 0; h < 4; ++h) ah[h] = __builtin_amdgcn_mfma_f32_16x16x32_bf16(af[rg][1], qf[h][1], ah[h], 0, 0, 0);
#pragma unroll
            for (int h = 4; h < 8; ++h) ah[h] = __builtin_amdgcn_mfma_f32_16x16x32_bf16(af[rg][0], qf[h][0], (f32x4){0.f, 0.f, 0.f, 0.f}, 0, 0, 0);
#pragma unroll
            for (int h = 4; h < 8; ++h) ah[h] = __builtin_amdgcn_mfma_f32_16x16x32_bf16(af[rg][1], qf[h][1], ah[h], 0, 0, 0);
            __builtin_amdgcn_s_setprio(0);
#pragma unroll
            for (int h = 0; h < 8; ++h)
#pragma unroll
                for (int r = 0; r < 4; ++r) sc[r] += wp[h] * __builtin_fabsf(ah[h][r]);
#pragma unroll
            for (int ks = 0; ks < 2; ++ks) af[rg][ks] = ((const bf16x8*)(kib + (size_t)(64 * Tn + 16 * rg) * 64 + 32 * ks))[fr * 8 + fq];
            if (mode == 0) {
#pragma unroll
                for (int r = 0; r < 4; ++r) { const int b = sel_bin(sc[r], sq.lo1, sq.sc1); __hip_atomic_fetch_add(sHist + qloc * 512 + (b >> 1), 1u << ((b & 1) * 16), __ATOMIC_RELAXED, __HIP_MEMORY_SCOPE_WORKGROUP); }
            } else if (mode == 1) {
                if (sq.ref) {
#pragma unroll
                    for (int r = 0; r < 4; ++r) if (sel_bin(sc[r], sq.lo1, sq.sc1) == sq.b1) { const int b = sel_bin(sc[r], sq.lo2, sq.sc2); __hip_atomic_fetch_add(sHist + qloc * 512 + (b >> 1), 1u << ((b & 1) * 16), __ATOMIC_RELAXED, __HIP_MEMORY_SCOPE_WORKGROUP); } }
            } else {
                int b[4]; unsigned bits = 0u; bool anyc = false;
#pragma unroll
                for (int r = 0; r < 4; ++r) { b[r] = sel_bin(sc[r], sq.lo1, sq.sc1); bits |= (b[r] > sq.b1) ? (1u << r) : 0u; anyc |= (b[r] == sq.b1); }
                if (anyc) {
#pragma unroll
                    for (int r = 0; r < 4; ++r) if (b[r] == sq.b1) { bool cand = true;
                        if (sq.ref) { const int b2 = sel_bin(sc[r], sq.lo2, sq.sc2); if (b2 > sq.b2) bits |= 1u << r; cand = b2 == sq.b2; }
                        if (cand) { const unsigned slot = __hip_atomic_fetch_add(sCnt + qloc, 1u, __ATOMIC_RELAXED, __HIP_MEMORY_SCOPE_WORKGROUP);
                            if (slot < (unsigned)SEL_CAP) { sCand[(qloc * SEL_CAP + slot) * 2] = __float_as_uint(sc[r]); sCand[(qloc * SEL_CAP + slot) * 2 + 1] = (unsigned)(64 * T + 16 * rg + 4 * fq + r); } } } }
                bits <<= (16 * (rg & 1)) + 4 * fq; if (rg < 2) mlo |= bits; else mhi |= bits;
            }
            __builtin_amdgcn_sched_barrier(0);
        }
        if (mode == 2) { mlo = xor16(mlo); mlo = xor32(mlo); mhi = xor16(mhi); mhi = xor32(mhi);
            if (fq == 0) *(uint2*)(maskrow + 2 * T) = make_uint2(mlo, mhi); }
    }
}
__device__ __forceinline__ void sel_scan(const unsigned* hist, unsigned need, int lane, int& bsel, unsigned& nneed, unsigned& cnt) {
    unsigned c16[16]; unsigned tot = 0u;
    { const u32x4 w0 = *(const u32x4*)(hist + 512 - 8 * (lane + 1)), w1 = *(const u32x4*)(hist + 512 - 8 * (lane + 1) + 4); const unsigned w[8] = {w0.x, w0.y, w0.z, w0.w, w1.x, w1.y, w1.z, w1.w};
#pragma unroll
      for (int i = 0; i < 8; ++i) { c16[2 * i] = w[i] & 0xffffu; c16[2 * i + 1] = w[i] >> 16; tot += (w[i] & 0xffffu) + (w[i] >> 16); } }
    unsigned inc = tot;
#pragma unroll
    for (int o = 1; o < 64; o <<= 1) { const unsigned t2 = __shfl_up(inc, o); if (lane >= o) inc += t2; }
    const unsigned long long bal = __ballot(inc >= need);
    const int L = bal ? (__ffsll((long long)bal) - 1) : 63;
    unsigned above = (unsigned)__builtin_amdgcn_readlane((int)(inc - tot), L); int bs = 0; unsigned nn = 1u, cc = 0u; bool found = false;
#pragma unroll
    for (int j = 0; j < 16; ++j) { const unsigned hcnt = (unsigned)__builtin_amdgcn_readlane((int)c16[15 - j], L); if (!found) { if (above + hcnt >= need) { found = true; bs = 1024 - 16 * L - 1 - j; nn = need - above; cc = hcnt; } else above += hcnt; } }
    bsel = bs; nneed = nn; cnt = cc;
}
__device__ __forceinline__ void ph_sel(const Args& a, unsigned char* lds, int wv) {
    unsigned char* ws = oport(a.ws);
    const int tid = otid(wv), lane = tid & 63, wave = __builtin_amdgcn_readfirstlane(tid >> 6), gq = wave & 1, kp = wave >> 1, fr = lane & 15, fq = lane >> 4, qloc = 16 * gq + fr;
    unsigned* sHist = (unsigned*)lds;
    unsigned* sCand = (unsigned*)(lds + 65536);
    float* sLo1 = (float*)(lds + 131072); float* sSc1 = sLo1 + 32; float* sLo2 = sSc1 + 32; float* sSc2 = sLo2 + 32; float* sTau = sSc2 + 32;
    int* sB1 = (int*)(sTau + 32); int* sB2 = sB1 + 32; int* sRef = sB2 + 32; int* sTidx = sRef + 32; unsigned* sNeed = (unsigned*)(sTidx + 32); unsigned* sCnt = sNeed + 32; int* sAny = (int*)(sCnt + 32);
    const bf16_t* QS = (const bf16_t*)(ws + WS_QI); const bf16_t* KIb = (const bf16_t*)(ws + WS_KI); const float* WP = (const float*)(ws + WS_WI); unsigned* MASKB = (unsigned*)(ws + WS_MASK);
    for (int pi = obid(); pi < 256; pi += gridDim.x) {
#pragma unroll 1
      for (int which = 0; which < 2; ++which) {
        const int b = pi & 1, half = (pi >> 1) & 1, cc = pi >> 2, c = which ? cc : 127 - cc;
        const size_t mq = (size_t)b * SEQ + 64 * c + 32 * half;
        const bf16_t* kib = KIb + (size_t)b * SEQ * 64;
        __syncthreads();
        if (tid < 32) { const float* w = WP + (mq + tid) * 8; float s1 = 0.f, s2 = 0.f;
#pragma unroll
            for (int h = 0; h < 8; ++h) { s1 += w[h]; s2 += w[h] * w[h]; }
            const float sd = 9.34f * sqrtf(fmaxf(s2, 1e-30f)); sLo1[tid] = 6.38f * s1 - 8.f * sd; sSc1[tid] = 1024.f / (16.f * sd);
            sLo2[tid] = 0.f; sSc2[tid] = 1.f; sB1[tid] = 0; sB2[tid] = 0; sRef[tid] = 0; sNeed[tid] = 256u; sCnt[tid] = 0u; sTau[tid] = -INFINITY; sTidx[tid] = 0x7fffffff; }
        if (tid == 0) sAny[0] = 0;
        for (int i = tid; i < 32 * 512 / 4; i += NTHR) ((u32x4*)sHist)[i] = (u32x4){0u, 0u, 0u, 0u};
        bf16x8 qf[9][2]; float wp[8];
        { const bf16_t* qrow = QS + (mq + qloc) * 576;
#pragma unroll
          for (int h = 0; h < 9; ++h)
#pragma unroll
              for (int ks = 0; ks < 2; ++ks) qf[h][ks] = *(const bf16x8*)(qrow + h * 64 + 32 * ks + 8 * fq);
#pragma unroll
          for (int h = 0; h < 8; ++h) wp[h] = WP[(mq + qloc) * 8 + h]; }
        __syncthreads();
        unsigned* maskrow = MASKB + (mq + qloc) * 256;
        if (c < 4) {
            if (tid < 32) for (int T = 0; T <= c; ++T) *(uint2*)(MASKB + (mq + tid) * 256 + 2 * T) = make_uint2(0xFFFFFFFFu, 0xFFFFFFFFu);
        } else {
#pragma unroll 1
            for (int pass = 0; pass < 3; ++pass) {
                if (pass == 1) { if (!sAny[0]) continue; __syncthreads(); for (int i = tid; i < 32 * 512 / 4; i += NTHR) ((u32x4*)sHist)[i] = (u32x4){0u, 0u, 0u, 0u}; __syncthreads(); }
                SelQ sq; sq.lo1 = sLo1[qloc]; sq.sc1 = sSc1[qloc]; sq.lo2 = sLo2[qloc]; sq.sc2 = sSc2[qloc]; sq.b1 = sB1[qloc]; sq.b2 = sB2[qloc]; sq.ref = sRef[qloc]; sq.tau = 0.f; sq.tidx = 0;
                sel_pass(pass, qf, wp, sq, kib, c, kp, qloc, fr, fq, sHist, sCand, sCnt, maskrow);
                asm volatile("s_waitcnt vmcnt(0)" ::: "memory");
                __syncthreads();
                if (pass < 2) {
                    { int bs[4]; unsigned nn[4], cn[4], nd[4]; bool act[4];
#pragma unroll
                      for (int k = 0; k < 4; ++k) { const int qq = wave * 4 + k; act[k] = pass == 0 || sRef[qq]; nd[k] = sNeed[qq]; }
#pragma unroll
                      for (int k = 0; k < 4; ++k) sel_scan(sHist + (wave * 4 + k) * 512, nd[k], lane, bs[k], nn[k], cn[k]);
#pragma unroll
                      for (int k = 0; k < 4; ++k) { const int qq = wave * 4 + k; if (act[k])
                        if (lane == 0) { sNeed[qq] = nn[k]; if (pass == 0) { sB1[qq] = bs[k]; if (cn[k] > (unsigned)SEL_CAP) { sRef[qq] = 1; sLo2[qq] = sLo1[qq] + (float)bs[k] / sSc1[qq]; sSc2[qq] = sSc1[qq] * 1024.f; sAny[0] = 1; } } else sB2[qq] = bs[k]; } } }
                    __syncthreads(); }
            }
            unsigned* sOff = (unsigned*)sAny + 4;
            if (tid < 64) { unsigned n = 0u; if (tid < 32) n = sCnt[tid] < (unsigned)SEL_CAP ? sCnt[tid] : (unsigned)SEL_CAP; unsigned inc = n;
#pragma unroll
                for (int o = 1; o < 32; o <<= 1) { const unsigned t2 = __shfl_up(inc, o); if (lane >= o) inc += t2; }
                if (tid < 32) { sOff[tid] = inc - n; if (tid == 31) sOff[32] = inc; } }
            __syncthreads();
            { const unsigned total = sOff[32];
              for (unsigned p = tid; p < total; p += NTHR) { int qq = 0;
#pragma unroll
                  for (int st = 16; st >= 1; st >>= 1) if (sOff[qq + st] <= p) qq += st;
                  const unsigned i = p - sOff[qq], n = sOff[qq + 1] - sOff[qq], want = sNeed[qq] - 1u;
                  const float si = __uint_as_float(sCand[(qq * SEL_CAP + i) * 2]); const unsigned ki = sCand[(qq * SEL_CAP + i) * 2 + 1]; unsigned rank = 0u;
                  for (unsigned j = 0; j < n; ++j) { const float sj = __uint_as_float(sCand[(qq * SEL_CAP + j) * 2]); const unsigned kj = sCand[(qq * SEL_CAP + j) * 2 + 1]; rank += (sj > si || (sj == si && kj < ki)) ? 1u : 0u; }
                  if (rank <= want) atomicOr(MASKB + (mq + qq) * 256 + (ki >> 5), 1u << (ki & 31u)); } }
        }
      }
    }
}

__device__ __forceinline__ void ph_attn(const Args& a, unsigned char* lds, int wv) {
    unsigned char* ws = oport(a.ws);
    const int tid = otid(wv), lane = tid & 63, wave = __builtin_amdgcn_readfirstlane(tid >> 6), g4 = wave & 3, par = wave >> 2, fr = lane & 15, fq = lane >> 4;
    const bf16_t* QR = (const bf16_t*)(ws + WS_QR); const bf16_t* KR = (const bf16_t*)(ws + WS_KR); const bf16_t* VT = (const bf16_t*)(ws + WS_VT); const unsigned* MASKB = (const unsigned*)(ws + WS_MASK);
    bf16_t* Kt = (bf16_t*)lds;
    bf16_t* Vt = Kt + 2 * 64 * 136;
    float* sMrg = (float*)lds;
    for (int pi = obid(); pi < 256; pi += gridDim.x) {
#pragma unroll 1
      for (int which = 0; which < 2; ++which) {
        const int bh = pi & 7, b = bh >> 2, h = bh & 3, cc = pi >> 3, qb = which ? cc : 63 - cc;
        const size_t m0 = (size_t)b * SEQ + 128 * qb + 32 * g4;
        const int mych = 2 * qb + (g4 >> 1);
        bf16x8 qf[2][4];
#pragma unroll
        for (int cg = 0; cg < 2; ++cg)
#pragma unroll
            for (int ks = 0; ks < 4; ++ks) qf[cg][ks] = *(const bf16x8*)(QR + (m0 + 16 * cg + fr) * 512 + h * 128 + 32 * ks + 8 * fq);
        f32x4 O[2][8], Lacc[2]; float mrun[2];
        const bf16x8 xones = (fr == 0) ? (bf16x8){0x3f80, 0x3f80, 0x3f80, 0x3f80, 0x3f80, 0x3f80, 0x3f80, 0x3f80} : (bf16x8){0, 0, 0, 0, 0, 0, 0, 0};
#pragma unroll
        for (int cg = 0; cg < 2; ++cg) { mrun[cg] = 0.f; Lacc[cg] = (f32x4){0.f, 0.f, 0.f, 0.f};
#pragma unroll
            for (int vt = 0; vt < 8; ++vt) O[cg][vt] = (f32x4){0.f, 0.f, 0.f, 0.f}; }
        const bf16_t* kbase = KR + (size_t)b * SEQ * 512 + h * 128; const bf16_t* vbase = VT + (size_t)(b * 512 + h * 128) * SEQ;
        unsigned doff[9];
#pragma unroll
        for (int k = 0; k < 9; ++k) { const int i_ = (wave + NWAVE * k < 70) ? wave + NWAVE * k : 69, slot = 64 * i_ + lane;
            if (slot < 2176) { const int tl = slot >= 1088 ? 1 : 0, rs = slot - 1088 * tl, row = rs / 17, seg = rs - 17 * row; doff[k] = 2u * (unsigned)((64 * tl + row) * 512 + ((seg < 16) ? (seg ^ ((row & 16) >> 2)) : 0) * 8); }
            else { const int s2 = slot - 2176, tl = s2 >= 1152 ? 1 : 0, rs = s2 - 1152 * tl, row = rs / 9, seg = rs - 9 * row; doff[k] = 2u * (unsigned)(row * SEQ + 64 * tl + (seg & 7) * 8); } }
#define ATT_DMA(jj, buf) do { const bf16_t* kb_ = kbase + (size_t)(jj) * 128 * 512; const bf16_t* vb_ = vbase + (size_t)(jj) * 128; \
            _Pragma("unroll") for (int k = 0; k < 9; ++k) { const int i_ = (wave + NWAVE * k < 70) ? wave + NWAVE * k : 69; unsigned d_ = doff[k]; asm volatile("" : "+v"(d_)); const unsigned char* src = (const unsigned char*)(k < 4 ? kb_ : k > 4 ? vb_ : wave < 2 ? kb_ : vb_) + d_; \
                __builtin_amdgcn_global_load_lds((const unsigned*)src, (LAS unsigned*)(LAS unsigned char*)(lds + (buf) * 71680 + i_ * 1024), 16, 0, 0); } } while (0)
        __syncthreads();
        ATT_DMA(0, 0);
        asm volatile("s_waitcnt vmcnt(0)" ::: "memory");
        __syncthreads();
        for (int j = 0; j <= qb; ++j) {
            const int T = 2 * j + par;
            if (par) __builtin_amdgcn_s_sleep(8);
            unsigned long long mw64[2];
#pragma unroll
            for (int cg = 0; cg < 2; ++cg) asm volatile("global_load_dwordx2 %0, %1, off" : "=v"(mw64[cg]) : "v"(MASKB + (m0 + 16 * cg + fr) * 256 + 2 * T) : "memory");
            const bf16_t* Ktb = Kt + (j & 1) * 35840; const bf16_t* Vtb = Vt + (j & 1) * 35840;
            const bool act = T <= mych;
            f32x4 S[2][4]; bf16x8 vf[2][4];
            if (act) {
                const bf16_t* kt = Ktb + par * 64 * 136; const bf16_t* vtl = Vtb + par * 128 * 72;
                bf16x8 kf[2][4];
#define ATT_LDK(bf_, s_) do { _Pragma("unroll") for (int i_ = 0; i_ < 2; ++i_) { const int rg_ = 2 * ((s_) >> 1) + i_, krow = 32 * (rg_ >> 1) + 8 * (fr >> 2) + 4 * (rg_ & 1) + (fr & 3); \
                    _Pragma("unroll") for (int k_ = 0; k_ < 2; ++k_) { const int ks = 2 * ((s_) & 1) + k_; kf[bf_][2 * i_ + k_] = *(const bf16x8*)(kt + krow * 136 + ((4 * ks + fq) ^ ((krow & 16) >> 2)) * 8); } } } while (0)
                ATT_LDK(0, 0);
#pragma unroll
                for (int rg = 0; rg < 4; ++rg) { S[0][rg] = (f32x4){-mrun[0], -mrun[0], -mrun[0], -mrun[0]}; S[1][rg] = (f32x4){-mrun[1], -mrun[1], -mrun[1], -mrun[1]}; }
#pragma unroll
                for (int st = 0; st < 4; ++st) {
                    if (st < 3) ATT_LDK((st + 1) & 1, st + 1);
                    __builtin_amdgcn_sched_barrier(0);
#pragma unroll
                    for (int k_ = 0; k_ < 2; ++k_)
#pragma unroll
                        for (int i_ = 0; i_ < 2; ++i_) { const int rg = 2 * (st >> 1) + i_, ks = 2 * (st & 1) + k_;
                            S[0][rg] = __builtin_amdgcn_mfma_f32_16x16x32_bf16(kf[st & 1][2 * i_ + k_], qf[0][ks], S[0][rg], 0, 0, 0); S[1][rg] = __builtin_amdgcn_mfma_f32_16x16x32_bf16(kf[st & 1][2 * i_ + k_], qf[1][ks], S[1][rg], 0, 0, 0); }
                    __builtin_amdgcn_sched_barrier(0); }
#undef ATT_LDK
#define ATT_LDV(bf_, g_) do { _Pragma("unroll") for (int i_ = 0; i_ < 2; ++i_) _Pragma("unroll") for (int k2 = 0; k2 < 2; ++k2) vf[bf_][2 * i_ + k2] = *(const bf16x8*)(vtl + (16 * (2 * (g_) + i_) + fr) * 72 + 32 * k2 + 8 * fq); } while (0)
                ATT_LDV(0, 0);
                __builtin_amdgcn_sched_barrier(0);
                asm volatile("s_waitcnt vmcnt(0)" : "+v"(mw64[0]), "+v"(mw64[1]) :: "memory");
            }
            if (j < qb) ATT_DMA(j + 1, (j + 1) & 1);
            __builtin_amdgcn_sched_barrier(0);
            if (act) {
                const bf16_t* vtl = Vtb + par * 128 * 72;
                const uint2 mw[2] = {make_uint2((unsigned)mw64[0], (unsigned)(mw64[0] >> 32)), make_uint2((unsigned)mw64[1], (unsigned)(mw64[1] >> 32))};
                bf16x8 pf[2][2];
#pragma unroll
                for (int cg = 0; cg < 2; ++cg) {
                    float mx = fmaxf(fmaxf(fmaxf(S[cg][0][0], S[cg][0][1]), fmaxf(S[cg][0][2], S[cg][0][3])), fmaxf(fmaxf(S[cg][1][0], S[cg][1][1]), fmaxf(S[cg][1][2], S[cg][1][3])));
                    mx = fmaxf(mx, fmaxf(fmaxf(fmaxf(S[cg][2][0], S[cg][2][1]), fmaxf(S[cg][2][2], S[cg][2][3])), fmaxf(fmaxf(S[cg][3][0], S[cg][3][1]), fmaxf(S[cg][3][2], S[cg][3][3]))));
                    mx = xmax16(mx); mx = xmax32(mx);
                    const float dlt = fmaxf(mx, 0.f);
                    const int m16 = (int)(((mw[cg].x >> (8 * fq)) & 0xFFu) | (((mw[cg].y >> (8 * fq)) & 0xFFu) << 8));
                    if (__builtin_amdgcn_ballot_w64(dlt != 0.f) != 0ull) {
                        mrun[cg] += dlt; const float alpha = __builtin_amdgcn_exp2f(-dlt);
#pragma unroll
                        for (int rg = 0; rg < 4; ++rg)
#pragma unroll
                            for (int r = 0; r < 4; ++r) S[cg][rg][r] -= dlt;
#pragma unroll
                        for (int vt = 0; vt < 8; ++vt) O[cg][vt] = O[cg][vt] * alpha;
                        Lacc[cg] = Lacc[cg] * alpha; }
#pragma unroll
                    for (int rg = 0; rg < 4; ++rg)
#pragma unroll
                        for (int r = 0; r < 4; ++r) S[cg][rg][r] = __int_as_float(__float_as_int(__builtin_amdgcn_exp2f(S[cg][rg][r])) & __builtin_amdgcn_sbfe(m16, 4 * rg + r, 1));
#pragma unroll
                    for (int k2 = 0; k2 < 2; ++k2) { const u32x4 w = {pg8::cvt_pk_bf16(S[cg][2 * k2][0], S[cg][2 * k2][1]), pg8::cvt_pk_bf16(S[cg][2 * k2][2], S[cg][2 * k2][3]), pg8::cvt_pk_bf16(S[cg][2 * k2 + 1][0], S[cg][2 * k2 + 1][1]), pg8::cvt_pk_bf16(S[cg][2 * k2 + 1][2], S[cg][2 * k2 + 1][3])};
                        pf[cg][k2] = __builtin_bit_cast(bf16x8, w); }
                    Lacc[cg] = __builtin_amdgcn_mfma_f32_16x16x32_bf16(xones, pf[cg][0], Lacc[cg], 0, 0, 0); Lacc[cg] = __builtin_amdgcn_mfma_f32_16x16x32_bf16(xones, pf[cg][1], Lacc[cg], 0, 0, 0);
                }
#pragma unroll
                for (int g = 0; g < 4; ++g) {
                    if (g < 3) ATT_LDV((g + 1) & 1, g + 1);
                    __builtin_amdgcn_sched_barrier(0);
#pragma unroll
                    for (int k2 = 0; k2 < 2; ++k2)
#pragma unroll
                        for (int i_ = 0; i_ < 2; ++i_) { const int vt = 2 * g + i_;
                            O[0][vt] = __builtin_amdgcn_mfma_f32_16x16x32_bf16(vf[g & 1][2 * i_ + k2], pf[0][k2], O[0][vt], 0, 0, 0); O[1][vt] = __builtin_amdgcn_mfma_f32_16x16x32_bf16(vf[g & 1][2 * i_ + k2], pf[1][k2], O[1][vt], 0, 0, 0); }
                    __builtin_amdgcn_sched_barrier(0); }
#undef ATT_LDV
            }
            asm volatile("s_waitcnt vmcnt(0)" ::: "memory");
            __syncthreads();
        }
#undef ATT_DMA
        const float lrun[2] = {Lacc[0][0], Lacc[1][0]};
        float* mb = sMrg + (size_t)g4 * 68 * 64 + lane;
        if (par == 1) {
#pragma unroll
            for (int cg = 0; cg < 2; ++cg) { mb[(cg * 2 + 0) * 64] = mrun[cg]; mb[(cg * 2 + 1) * 64] = lrun[cg];
#pragma unroll
                for (int vt = 0; vt < 8; ++vt)
#pragma unroll
                    for (int r = 0; r < 4; ++r) mb[(4 + (cg * 8 + vt) * 4 + r) * 64] = O[cg][vt][r]; } }
        __syncthreads();
        if (par == 0) {
            bf16_t* YC = (bf16_t*)(oport(ws) + WS_YALL) + (size_t)2 * M * 512;
#pragma unroll
            for (int cg = 0; cg < 2; ++cg) { const float m1 = mb[(cg * 2 + 0) * 64], l1 = mb[(cg * 2 + 1) * 64]; const float mm = fmaxf(mrun[cg], m1), a0 = __builtin_amdgcn_exp2f(mrun[cg] - mm), a1 = __builtin_amdgcn_exp2f(m1 - mm);
                float lt = lrun[cg] * a0 + l1 * a1; lt = xsum16(lt); lt = xsum32(lt); const float inv = 1.f / lt;
#pragma unroll
                for (int vt = 0; vt < 8; ++vt) { float o[4];
#pragma unroll
                    for (int r = 0; r < 4; ++r) o[r] = (O[cg][vt][r] * a0 + mb[(4 + (cg * 8 + vt) * 4 + r) * 64] * a1) * inv;
                    *(unsigned long long*)(YC + (m0 + 16 * cg + fr) * 512 + h * 128 + 16 * vt + 4 * fq) = (unsigned long long)pk2(o[0], o[1]) | ((unsigned long long)pk2(o[2], o[3]) << 32); } } }
      }
    }
}
__device__ __forceinline__ void ph_norm2(const Args& a, int l, int wv) {
    const int tid = otid(wv), lane = tid & 63, gw = obid() * NWAVE + (tid >> 6), ngw = gridDim.x * NWAVE;
    unsigned char* ws = oport(a.ws);
#pragma unroll 2
    for (int m = gw; m < M; m += ngw) rms_rowb_to_bf16((const bf16_t*)(ws + WS_XR) + (size_t)m * D, a.norm2 + l * D, (bf16_t*)(ws + WS_H16) + (size_t)m * D, lane);
    { const f32x4* U = (const f32x4*)(a.peer_u + (size_t)l * NEXP * D); const f32x4* V = (const f32x4*)(a.peer_v + (size_t)l * NEXP * D); uint2* U4 = (uint2*)(ws + WS_U16); uint2* V4 = (uint2*)(ws + WS_V16);
      float* RSU = (float*)(ws + WS_RS); float* RSV = RSU + NEXP;
#pragma unroll 2
      for (size_t i = (size_t)obid() * NTHR + tid; i < (size_t)NEXP * D / 16; i += (size_t)gridDim.x * NTHR) { f32x4 u[4], v[4]; float su = 0.f, sv = 0.f;
#pragma unroll
          for (int q = 0; q < 4; ++q) { u[q] = U[4 * i + q]; v[q] = V[4 * i + q]; su += (u[q].x * u[q].x + u[q].y * u[q].y) + (u[q].z * u[q].z + u[q].w * u[q].w); sv += (v[q].x * v[q].x + v[q].y * v[q].y) + (v[q].z * v[q].z + v[q].w * v[q].w); }
          const float ru = fmaxf(sqrtf(wave_sum(su) * (1.f / D)), 1e-30f), rv = fmaxf(sqrtf(wave_sum(sv) * (1.f / D)), 1e-30f), ku = 1.f / (0.3352f * ru), kv = 2.f / rv;
          unsigned wu[2] = {0u, 0u}, wq[2] = {0u, 0u};
#pragma unroll
          for (int q = 3; q >= 0; --q) { const float ue[4] = {u[q].x, u[q].y, u[q].z, u[q].w};
#pragma unroll
              for (int e = 3; e >= 0; --e) { const int qi = (int)__builtin_amdgcn_fmed3f(__builtin_rintf(ue[e] * ku), -8.f, 7.f); wu[q >> 1] = (wu[q >> 1] << 4) | ((unsigned)qi & 15u); } }
#pragma unroll
          for (int q = 0; q < 4; ++q) {
              if (q & 1) { wq[q >> 1] = __builtin_amdgcn_cvt_scalef32_pk_fp4_f32(wq[q >> 1], v[q].x * kv, v[q].y * kv, 1.f, 2); wq[q >> 1] = __builtin_amdgcn_cvt_scalef32_pk_fp4_f32(wq[q >> 1], v[q].z * kv, v[q].w * kv, 1.f, 3); }
              else       { wq[q >> 1] = __builtin_amdgcn_cvt_scalef32_pk_fp4_f32(wq[q >> 1], v[q].x * kv, v[q].y * kv, 1.f, 0); wq[q >> 1] = __builtin_amdgcn_cvt_scalef32_pk_fp4_f32(wq[q >> 1], v[q].z * kv, v[q].w * kv, 1.f, 1); } }
          U4[i] = make_uint2(wu[0], wu[1]); V4[i] = make_uint2(wq[0], wq[1]);
          if (lane == 0) { RSU[i >> 6] = 0.3352f * ru; RSV[i >> 6] = 0.5f * rv; } } }
}
#define CE_(a_, b_) do { const float hi_ = fmaxf(a_, b_), lo_ = fminf(a_, b_); a_ = hi_; b_ = lo_; } while (0)
#define SORT16D(x) do { CE_(x[0], x[1]); CE_(x[3], x[2]); CE_(x[4], x[5]); CE_(x[7], x[6]); CE_(x[8], x[9]); CE_(x[11], x[10]); CE_(x[12], x[13]); CE_(x[15], x[14]); CE_(x[0], x[2]); CE_(x[1], x[3]); CE_(x[6], x[4]); CE_(x[7], x[5]); CE_(x[8], x[10]); CE_(x[9], x[11]); CE_(x[14], x[12]); CE_(x[15], x[13]); CE_(x[0], x[1]); CE_(x[2], x[3]); CE_(x[5], x[4]); CE_(x[7], x[6]); CE_(x[8], x[9]); CE_(x[10], x[11]); CE_(x[13], x[12]); CE_(x[15], x[14]); CE_(x[0], x[4]); CE_(x[1], x[5]); CE_(x[2], x[6]); CE_(x[3], x[7]); CE_(x[12], x[8]); CE_(x[13], x[9]); CE_(x[14], x[10]); CE_(x[15], x[11]); CE_(x[0], x[2]); CE_(x[1], x[3]); CE_(x[4], x[6]); CE_(x[5], x[7]); CE_(x[10], x[8]); CE_(x[11], x[9]); CE_(x[14], x[12]); CE_(x[15], x[13]); CE_(x[0], x[1]); CE_(x[2], x[3]); CE_(x[4], x[5]); CE_(x[6], x[7]); CE_(x[9], x[8]); CE_(x[11], x[10]); CE_(x[13], x[12]); CE_(x[15], x[14]); CE_(x[0], x[8]); CE_(x[1], x[9]); CE_(x[2], x[10]); CE_(x[3], x[11]); CE_(x[4], x[12]); CE_(x[5], x[13]); CE_(x[6], x[14]); CE_(x[7], x[15]); CE_(x[0], x[4]); CE_(x[1], x[5]); CE_(x[2], x[6]); CE_(x[3], x[7]); CE_(x[8], x[12]); CE_(x[9], x[13]); CE_(x[10], x[14]); CE_(x[11], x[15]); CE_(x[0], x[2]); CE_(x[1], x[3]); CE_(x[4], x[6]); CE_(x[5], x[7]); CE_(x[8], x[10]); CE_(x[9], x[11]); CE_(x[12], x[14]); CE_(x[13], x[15]); CE_(x[0], x[1]); CE_(x[2], x[3]); CE_(x[4], x[5]); CE_(x[6], x[7]); CE_(x[8], x[9]); CE_(x[10], x[11]); CE_(x[12], x[13]); CE_(x[14], x[15]); } while (0)
#define MERGE16D(x) do { CE_(x[0], x[8]); CE_(x[1], x[9]); CE_(x[2], x[10]); CE_(x[3], x[11]); CE_(x[4], x[12]); CE_(x[5], x[13]); CE_(x[6], x[14]); CE_(x[7], x[15]); CE_(x[0], x[4]); CE_(x[1], x[5]); CE_(x[2], x[6]); CE_(x[3], x[7]); CE_(x[8], x[12]); CE_(x[9], x[13]); CE_(x[10], x[14]); CE_(x[11], x[15]); CE_(x[0], x[2]); CE_(x[1], x[3]); CE_(x[4], x[6]); CE_(x[5], x[7]); CE_(x[8], x[10]); CE_(x[9], x[11]); CE_(x[12], x[14]); CE_(x[13], x[15]); CE_(x[0], x[1]); CE_(x[2], x[3]); CE_(x[4], x[5]); CE_(x[6], x[7]); CE_(x[8], x[9]); CE_(x[10], x[11]); CE_(x[12], x[13]); CE_(x[14], x[15]); } while (0)
__device__ __forceinline__ float pkf(float v, unsigned tag) { return __uint_as_float((__float_as_uint(v) & 0xFFFFFF00u) | tag); }
__device__ __forceinline__ void ph_peer_select(const Args& a, int l, unsigned char* lds, int wv, int nunits, int pm0, int pn0, int pm1, int pn1) {
    unsigned char* ws = oport(a.ws); const int tid = otid(wv), lane = tid & 63, wave = __builtin_amdgcn_readfirstlane(tid >> 6), fr = lane & 15, fq = lane >> 4;
    bf16_t* sK = (bf16_t*)lds;
    int* sI = (int*)(lds + 69632 + wave * 2048);
    const bf16_t* QRY = (const bf16_t*)(ws + WS_GB); const bf16_t* SKB = (const bf16_t*)(ws + WS_SKB) + (size_t)l * 16 * 128 * 128; int* EID = (int*)(ws + WS_EID); float* EG = (float*)(ws + WS_EG);
  for (int uu = 0; uu < nunits; ++uu) { const int h = uu == 0 ? pn0 : pn1, pmu = uu == 0 ? pm0 : pm1;
    __syncthreads();
    { const u32x4* src = (const u32x4*)(SKB + (size_t)h * 2 * 128 * 128);
#pragma unroll
      for (int n = 0; n < 8; ++n) { const int idx = tid + NTHR * n, row = idx >> 4, seg = idx & 15; *(u32x4*)(sK + row * 136 + seg * 8) = src[idx]; } }
    __syncthreads();
    bf16x8 qn[2][4];
#define PS_QLOAD(it_) do { const size_t mq_ = (size_t)(pmu * 16 + (it_)) * 16 + fr; _Pragma("unroll") for (int p_ = 0; p_ < 2; ++p_) _Pragma("unroll") for (int ks = 0; ks < 4; ++ks) \
        qn[p_][ks] = *(const bf16x8*)(QRY + mq_ * 2048 + h * 256 + p_ * 128 + 32 * ks + 8 * fq); } while (0)
    PS_QLOAD(wave);
    for (int it = wave; it < 16; it += NWAVE) { const int tg = pmu * 16 + it; const size_t m = (size_t)tg * 16 + fr;
        float va[16], vb[16];
        bf16x8 qc[2][4];
#pragma unroll
        for (int p = 0; p < 2; ++p)
#pragma unroll
            for (int ks = 0; ks < 4; ++ks) qc[p][ks] = qn[p][ks];
        if (it + NWAVE < 16) PS_QLOAD(it + NWAVE);
#pragma unroll
        for (int p = 0; p < 2; ++p) {
            bf16x8 qf[4];
#pragma unroll
            for (int ks = 0; ks < 4; ++ks) qf[ks] = qc[p][ks];
            const bf16_t* kb = sK + (size_t)p * 128 * 136; float s0[16], s1[16];
            f32x4 acc8[8];
#pragma unroll
            for (int nt = 0; nt < 8; ++nt) acc8[nt] = (f32x4){0.f, 0.f, 0.f, 0.f};
#pragma unroll
            for (int ks = 0; ks < 4; ++ks)
#pragma unroll
                for (int nt = 0; nt < 8; ++nt) { const bf16x8 x = *(const bf16x8*)(kb + (16 * nt + fr) * 136 + 32 * ks + 8 * fq); acc8[nt] = __builtin_amdgcn_mfma_f32_16x16x32_bf16(x, qf[ks], acc8[nt], 0, 0, 0); }
#pragma unroll
            for (int nt = 0; nt < 8; ++nt)
#pragma unroll
                for (int r = 0; r < 4; ++r) { const float tv = __uint_as_float((__float_as_uint(acc8[nt][r]) & 0xFFFFFF80u) | (unsigned)(127 - (16 * nt + 4 * fq + r))); if (nt < 4) s0[nt * 4 + r] = tv; else s1[(nt - 4) * 4 + r] = tv; }
            SORT16D(s0); SORT16D(s1);
            float t[16];
#pragma unroll
            for (int i = 0; i < 16; ++i) t[i] = fmaxf(s0[i], s1[15 - i]);
            MERGE16D(t);
#pragma unroll
            for (int off = 16; off <= 32; off <<= 1) { float o[16];
#pragma unroll
                for (int i = 0; i < 16; ++i) o[i] = __shfl_xor(t[15 - i], off);
#pragma unroll
                for (int i = 0; i < 16; ++i) t[i] = fmaxf(t[i], o[i]);
                MERGE16D(t); }
#pragma unroll
            for (int i = 0; i < 16; ++i) { if (p == 0) va[i] = t[i]; else vb[i] = t[i]; }
            __builtin_amdgcn_sched_barrier(0);
        }
        if (fq == 0) {
#pragma unroll
            for (int r = 0; r < 16; ++r) { sI[fr * 32 + r] = 127 - (int)(__float_as_uint(va[r]) & 127u); sI[fr * 32 + 16 + r] = 127 - (int)(__float_as_uint(vb[r]) & 127u); } }
#pragma unroll
        for (int r = 0; r < 16; ++r) { va[r] = __uint_as_float(__float_as_uint(va[r]) & 0xFFFFFF80u); vb[r] = __uint_as_float(__float_as_uint(vb[r]) & 0xFFFFFF80u); }
        float cs[16];
        {
            cs[0] = fq == 0 ? pkf(va[0] + vb[0], 255u) : fq == 1 ? pkf(va[0] + vb[1], 254u) : fq == 2 ? pkf(va[0] + vb[2], 253u) : pkf(va[0] + vb[3], 252u);
            cs[1] = fq == 0 ? pkf(va[0] + vb[4], 251u) : fq == 1 ? pkf(va[0] + vb[5], 250u) : fq == 2 ? pkf(va[0] + vb[6], 249u) : pkf(va[0] + vb[7], 248u);
            cs[2] = fq == 0 ? pkf(va[0] + vb[8], 247u) : fq == 1 ? pkf(va[0] + vb[9], 246u) : fq == 2 ? pkf(va[0] + vb[10], 245u) : pkf(va[0] + vb[11], 244u);
            cs[3] = fq == 0 ? pkf(va[0] + vb[12], 243u) : fq == 1 ? pkf(va[0] + vb[13], 242u) : fq == 2 ? pkf(va[0] + vb[14], 241u) : pkf(va[0] + vb[15], 240u);
            cs[4] = fq == 0 ? pkf(va[1] + vb[0], 239u) : fq == 1 ? pkf(va[1] + vb[1], 238u) : fq == 2 ? pkf(va[1] + vb[2], 237u) : pkf(va[1] + vb[3], 236u);
            cs[5] = fq == 0 ? pkf(va[1] + vb[4], 235u) : fq == 1 ? pkf(va[1] + vb[5], 234u) : fq == 2 ? pkf(va[1] + vb[6], 233u) : pkf(va[1] + vb[7], 232u);
            cs[6] = fq == 0 ? pkf(va[2] + vb[0], 223u) : fq == 1 ? pkf(va[2] + vb[1], 222u) : fq == 2 ? pkf(va[2] + vb[2], 221u) : pkf(va[2] + vb[3], 220u);
            cs[7] = fq == 0 ? pkf(va[2] + vb[4], 219u) : fq == 1 ? pkf(va[3] + vb[0], 207u) : fq == 2 ? pkf(va[3] + vb[1], 206u) : pkf(va[3] + vb[2], 205u);
            cs[8] = fq == 0 ? pkf(va[3] + vb[3], 204u) : fq == 1 ? pkf(va[4] + vb[0], 191u) : fq == 2 ? pkf(va[4] + vb[1], 190u) : pkf(va[4] + vb[2], 189u);
            cs[9] = fq == 0 ? pkf(va[5] + vb[0], 175u) : fq == 1 ? pkf(va[5] + vb[1], 174u) : fq == 2 ? pkf(va[6] + vb[0], 159u) : pkf(va[6] + vb[1], 158u);
            cs[10] = fq == 0 ? pkf(va[7] + vb[0], 143u) : fq == 1 ? pkf(va[7] + vb[1], 142u) : fq == 2 ? pkf(va[8] + vb[0], 127u) : pkf(va[9] + vb[0], 111u);
            cs[11] = fq == 0 ? pkf(va[10] + vb[0], 95u) : fq == 1 ? pkf(va[11] + vb[0], 79u) : fq == 2 ? pkf(va[12] + vb[0], 63u) : pkf(va[13] + vb[0], 47u);
            cs[12] = fq == 0 ? pkf(va[14] + vb[0], 31u) : fq == 1 ? pkf(va[15] + vb[0], 15u) : fq == 2 ? -INFINITY : -INFINITY;
            cs[13] = -INFINITY; cs[14] = -INFINITY; cs[15] = -INFINITY;
        }
        __builtin_amdgcn_sched_barrier(0);
        SORT16D(cs);
#pragma unroll
        for (int off = 16; off <= 32; off <<= 1) { float o[16];
#pragma unroll
            for (int i = 0; i < 16; ++i) o[i] = __shfl_xor(cs[15 - i], off);
#pragma unroll
            for (int i = 0; i < 16; ++i) cs[i] = fmaxf(cs[i], o[i]);
            MERGE16D(cs); }
        float bv[16];
#pragma unroll
        for (int i = 0; i < 16; ++i) bv[i] = cs[i];
        asm volatile("s_waitcnt lgkmcnt(0)" ::: "memory"); __builtin_amdgcn_sched_barrier(0);
        if (fq == 0) { int eid[16]; float ex[16]; float sm = 0.f; const float b0 = __uint_as_float(__float_as_uint(bv[0]) & 0xFFFFFF00u);
#pragma unroll
            for (int r = 0; r < 16; ++r) { const unsigned bits = __float_as_uint(bv[r]); const int f = 255 - (int)(bits & 255u); eid[r] = sI[fr * 32 + (f >> 4)] * 128 + sI[fr * 32 + 16 + (f & 15)];
                ex[r] = __expf(__uint_as_float(bits & 0xFFFFFF00u) - b0); sm += ex[r]; }
            const float inv = 1.f / sm; int* ep = EID + m * 128 + h * 16; float* gp = EG + m * 128 + h * 16;
#pragma unroll
            for (int r = 0; r < 16; r += 4) { *(int4*)(ep + r) = make_int4(eid[r], eid[r + 1], eid[r + 2], eid[r + 3]); *(f32x4*)(gp + r) = (f32x4){ex[r] * inv, ex[r + 1] * inv, ex[r + 2] * inv, ex[r + 3] * inv}; } }
        asm volatile("s_waitcnt lgkmcnt(0)" ::: "memory");
    }
  }
}
#undef PS_QLOAD
typedef float f32x2_t __attribute__((ext_vector_type(2)));
__device__ __forceinline__ void dec8(const uint2 w, f32x2_t (&f)[8]) {
    f[0] = __builtin_amdgcn_cvt_scalef32_pk_f32_fp4(w.x, 1.f, 0); f[1] = __builtin_amdgcn_cvt_scalef32_pk_f32_fp4(w.x, 1.f, 1); f[2] = __builtin_amdgcn_cvt_scalef32_pk_f32_fp4(w.x, 1.f, 2); f[3] = __builtin_amdgcn_cvt_scalef32_pk_f32_fp4(w.x, 1.f, 3);
    f[4] = __builtin_amdgcn_cvt_scalef32_pk_f32_fp4(w.y, 1.f, 0); f[5] = __builtin_amdgcn_cvt_scalef32_pk_f32_fp4(w.y, 1.f, 1); f[6] = __builtin_amdgcn_cvt_scalef32_pk_f32_fp4(w.y, 1.f, 2); f[7] = __builtin_amdgcn_cvt_scalef32_pk_f32_fp4(w.y, 1.f, 3);
}
__device__ __forceinline__ void ph_peer_experts(const Args& a, int l, unsigned char* lds, int wv) {
    unsigned char* ws = oport(a.ws); const int tid = otid(wv), lane = tid & 63, wave = __builtin_amdgcn_readfirstlane(tid >> 6), gw = obid() * NWAVE + wave, ngw = gridDim.x * NWAVE;
    const bf16_t* H16 = (const bf16_t*)(ws + WS_H16); const int* EID = (const int*)(ws + WS_EID); const float* EG = (const float*)(ws + WS_EG);
    const unsigned char* U8 = (const unsigned char*)(ws + WS_U16); const unsigned char* V8 = (const unsigned char*)(ws + WS_V16);
    const float* RSU = (const float*)(ws + WS_RS); const float* RSV = RSU + NEXP;
    float* sPA = (float*)(lds + wave * 8192) + lane; float* sPB = sPA + 1024;
    int* sEA = (int*)(lds + 65536 + wave * 2048); float* sGA = (float*)(sEA + 128); int* sEB = sEA + 256; float* sGB = (float*)(sEB + 128);
    u32x4 nhA0, nhA1, nhB0, nhB1; int2 nkA, nkB; float2 npA, npB;
#define PAIR_LOAD(it_) do { const int a0_ = gw + (2 * (it_)) * ngw, a_ = a0_ < M ? a0_ : M - 1, b0_ = a0_ + ngw, b_ = b0_ < M ? b0_ : a_; \
        nhA0 = *(const u32x4*)(H16 + (size_t)a_ * D + lane * 16); nhA1 = *(const u32x4*)(H16 + (size_t)a_ * D + lane * 16 + 8); nhB0 = *(const u32x4*)(H16 + (size_t)b_ * D + lane * 16); nhB1 = *(const u32x4*)(H16 + (size_t)b_ * D + lane * 16 + 8); \
        nkA = *(const int2*)(EID + (size_t)a_ * 128 + 2 * lane); nkB = *(const int2*)(EID + (size_t)b_ * 128 + 2 * lane); npA = *(const float2*)(EG + (size_t)a_ * 128 + 2 * lane); npB = *(const float2*)(EG + (size_t)b_ * 128 + 2 * lane); } while (0)
    PAIR_LOAD(0);
    for (int it = 0, nit = ((M + ngw - 1) / ngw + 1) / 2; it < nit; ++it) { const int mA = gw + (2 * it) * ngw, mB = mA + ngw; const bool vA = mA < M, vB = mB < M;
        __syncthreads();
        if (!vA) continue;
        const int mBs = vB ? mB : mA;
        f32x2_t accA[8], accB[8]; int hhA[2], hlA[2], hhB[2], hlB[2]; float shA, shB;
#define LOADH(hh, hl, sh, h0_, h1_) do { float hv_[16]; \
          hv_[0] = lo_bf(h0_.x); hv_[1] = hi_bf(h0_.x); hv_[2] = lo_bf(h0_.y); hv_[3] = hi_bf(h0_.y); hv_[4] = lo_bf(h0_.z); hv_[5] = hi_bf(h0_.z); hv_[6] = lo_bf(h0_.w); hv_[7] = hi_bf(h0_.w); \
          hv_[8] = lo_bf(h1_.x); hv_[9] = hi_bf(h1_.x); hv_[10] = lo_bf(h1_.y); hv_[11] = hi_bf(h1_.y); hv_[12] = lo_bf(h1_.z); hv_[13] = hi_bf(h1_.z); hv_[14] = lo_bf(h1_.w); hv_[15] = hi_bf(h1_.w); \
          float am_ = 0.f; _Pragma("unroll") for (int j_ = 0; j_ < 16; ++j_) am_ = fmaxf(am_, __builtin_fabsf(hv_[j_])); am_ = fmaxf(wave_max(am_), 1e-30f); sh = am_ * (1.f / 119.f); const float ih_ = 119.f / am_; \
          unsigned wh_[2] = {0u, 0u}, wl_[2] = {0u, 0u}; \
          _Pragma("unroll") for (int j_ = 15; j_ >= 0; --j_) { const int h8_ = (int)__builtin_rintf(hv_[j_] * ih_); const int l4_ = (h8_ + 8) & 15; const int hi_ = (h8_ - l4_ + 8) >> 4; \
              wl_[j_ >> 3] = (wl_[j_ >> 3] << 4) | (unsigned)(l4_ ^ 8); wh_[j_ >> 3] = (wh_[j_ >> 3] << 4) | ((unsigned)hi_ & 15u); } \
          hh[0] = (int)wh_[0]; hh[1] = (int)wh_[1]; hl[0] = (int)wl_[0]; hl[1] = (int)wl_[1]; } while (0)
        const u32x4 hA0 = nhA0, hA1 = nhA1, hB0 = nhB0, hB1 = nhB1; const int2 kA = nkA, kB = nkB; const float2 pA = npA, pB = npB;
        LOADH(hhA, hlA, shA, hA0, hA1); LOADH(hhB, hlB, shB, hB0, hB1);
#pragma unroll
        for (int j = 0; j < 8; ++j) { accA[j] = (f32x2_t){0.f, 0.f}; accB[j] = (f32x2_t){0.f, 0.f}; }
#define SORTTOK(k2_, p2_, sE_, sG_) do { int key[2] = {k2_.x, k2_.y}; float pay[2] = {p2_.x, p2_.y}; \
          _Pragma("unroll") for (int k = 2; k <= 128; k <<= 1) _Pragma("unroll") for (int j = k >> 1; j >= 1; j >>= 1) { \
              if (j == 1) { const bool asc = ((2 * lane) & k) == 0; if ((key[0] > key[1]) == asc) { const int tk = key[0]; key[0] = key[1]; key[1] = tk; const float tp = pay[0]; pay[0] = pay[1]; pay[1] = tp; } } \
              else { const int lj = j >> 1; const bool keep_min = (((2 * lane) & k) == 0) == ((lane & lj) == 0); \
                  _Pragma("unroll") for (int r = 0; r < 2; ++r) { const int pk = shx_il(key[r], lj, lane); const float pp = shx_fl(pay[r], lj, lane); const bool take = keep_min ? (pk < key[r]) : (pk > key[r]); if (take) { key[r] = pk; pay[r] = pp; } } } } \
          *(int2*)(sE_ + 2 * lane) = make_int2(key[0], key[1]); *(float2*)(sG_ + 2 * lane) = make_float2(pay[0], pay[1]); } while (0)
        SORTTOK(kA, pA, sEA, sGA); SORTTOK(kB, pB, sEB, sGB);
        PAIR_LOAD(it + 1);
        u32x4 xA[2], xB[2];
#pragma unroll
        for (int j = 0; j < 2; ++j) { xA[j] = *(const u32x4*)((const bf16_t*)(ws + WS_XR) + (size_t)mA * D + lane * 16 + 8 * j); xB[j] = *(const u32x4*)((const bf16_t*)(ws + WS_XR) + (size_t)mBs * D + lane * 16 + 8 * j); }
        asm volatile("s_waitcnt lgkmcnt(0)" ::: "memory");
#pragma unroll 1
        for (int half = 0; half < 2; ++half) {
            const int pos = half * 64 + 8 * (lane & 7) + ((lane >> 5) & 1) + 2 * ((lane >> 4) & 1) + 4 * ((lane >> 3) & 1);
            const int evA = sEA[pos], evB = sEB[pos]; const float gvA = sGA[pos], gvB = sGB[pos];
            const float suA = RSU[evA], sdA = RSV[evA], suB = RSU[evB], sdB = RSV[evB];
            uint2 bufA[8], bufB[8];
#define ROWLD(dst, T, e_) dst = ((const uint2*)(T + (size_t)(e_) * (D / 2)))[lane]
#define KIDX(g, c) ((g) + 32 * ((c) & 1) + 16 * (((c) >> 1) & 1) + 8 * (((c) >> 2) & 1))
#define LOADG(buf, T, ev_, g) do { _Pragma("unroll") for (int i_ = 0; i_ < 8; ++i_) ROWLD(buf[i_], T, __builtin_amdgcn_readlane(ev_, KIDX(g, i_))); } while (0)
#define BF2(a_, b_, o) (((lane & (o)) ? (b_) : (a_)) + shx_f((lane & (o)) ? (a_) : (b_), (o)))
#define DOTG(buf, hh, hl, sP_, g) do { float d4_[8]; _Pragma("unroll") for (int i_ = 0; i_ < 8; ++i_) { int ah_; asm("v_dot8_i32_i4 %0, %1, %2, 0" : "=v"(ah_) : "v"(buf[i_].x), "v"(hh[0]));        \
              ah_ = __builtin_amdgcn_sdot8((int)buf[i_].y, hh[1], ah_, false); const int al_ = __builtin_amdgcn_sdot8((int)buf[i_].y, hl[1], __builtin_amdgcn_sdot8((int)buf[i_].x, hl[0], ah_ << 4, false), false); \
              d4_[i_] = (float)al_; } \
              const float q0_ = bf2_swap32(d4_[0], d4_[1]), q1_ = bf2_swap32(d4_[2], d4_[3]), q2_ = bf2_swap32(d4_[4], d4_[5]), q3_ = bf2_swap32(d4_[6], d4_[7]); const float r0_ = bf2_swap16(q0_, q1_), r1_ = bf2_swap16(q2_, q3_); sP_[(g) * 64] = BF2(r0_, r1_, 8); } while (0)
            LOADG(bufA, U8, evA, 0);
#pragma unroll 1
            for (int g = 0; g < 8; ++g) { const int gn = g < 7 ? g + 1 : 0; const unsigned char* Tn = g < 7 ? U8 : V8;
                LOADG(bufB, U8, evB, g); DOTG(bufA, hhA, hlA, sPA, g);
                LOADG(bufA, Tn, evA, gn); DOTG(bufB, hhB, hlB, sPB, g); }
            int svbA, svbB;
#define BFLY(o, n) do { const bool up_ = (lane & (o)) != 0; _Pragma("unroll") for (int i_ = 0; i_ < (n); ++i_) { const float a_ = p[i_], b_ = p[i_ + (n)]; const float sd_ = up_ ? a_ : b_, kp_ = up_ ? b_ : a_; p[i_] = kp_ + shx_fl(sd_, (o), lane); } } while (0)
#define FINISH(sP_, gv_, svb_, su_, sd_) do { float p[8]; _Pragma("unroll") for (int i_ = 0; i_ < 8; ++i_) p[i_] = sP_[i_ * 64]; BFLY(4, 4); BFLY(2, 2); BFLY(1, 1); \
              svb_ = __builtin_bit_cast(int, gv_ * gelu_t(p[0] * su_) * sd_); } while (0)
            FINISH(sPA, gvA, svbA, suA * shA, sdA); FINISH(sPB, gvB, svbB, suB * shB, sdB);
#define ACCG(buf, acc, svb_, g) do { _Pragma("unroll") for (int i_ = 0; i_ < 8; ++i_) { const float sk_ = __builtin_bit_cast(float, __builtin_amdgcn_readlane(svb_, KIDX(g, i_))); const f32x2_t s2_ = {sk_, sk_}; f32x2_t f_[8]; dec8(buf[i_], f_); \
              _Pragma("unroll") for (int j_ = 0; j_ < 8; ++j_) acc[j_] = __builtin_elementwise_fma(f_[j_], s2_, acc[j_]); } } while (0)
#pragma unroll 1
            for (int g = 0; g < 7; ++g) {
                LOADG(bufB, V8, evB, g); ACCG(bufA, accA, svbA, g);
                LOADG(bufA, V8, evA, g + 1); ACCG(bufB, accB, svbB, g); }
            LOADG(bufB, V8, evB, 7); ACCG(bufA, accA, svbA, 7); ACCG(bufB, accB, svbB, 7);
#undef ROWLD
#undef KIDX
#undef LOADG
#undef BF2
#undef DOTG
#undef BFLY
#undef FINISH
#undef ACCG
        }
#define EPILOG(m_, acc2, xp_) do { float acc[16]; _Pragma("unroll") for (int j = 0; j < 8; ++j) { acc[2 * j] = acc2[j].x; acc[2 * j + 1] = acc2[j].y; } \
        float* xr = a.out + (size_t)(m_) * D + lane * 16; float xn[16]; float ss = 0.f; \
        { const unsigned xw_[8] = {xp_[0].x, xp_[0].y, xp_[0].z, xp_[0].w, xp_[1].x, xp_[1].y, xp_[1].z, xp_[1].w}; _Pragma("unroll") for (int j = 0; j < 8; ++j) { xn[2 * j] = lo_bf(xw_[j]) + acc[2 * j]; xn[2 * j + 1] = hi_bf(xw_[j]) + acc[2 * j + 1]; } } \
        _Pragma("unroll") for (int j = 0; j < 16; ++j) ss += xn[j] * xn[j]; \
        const float r = rsqrtf(wave_sum(ss) * (1.f / D) + EPS); \
        if (l + 1 < DEPTH) { const float* gn = a.norm1 + (size_t)(l + 1) * D + lane * 16; \
            { bf16_t* xb_ = (bf16_t*)(ws + WS_XR) + (size_t)(m_) * D + lane * 16; *(u32x4*)xb_ = (u32x4){pk2(xn[0], xn[1]), pk2(xn[2], xn[3]), pk2(xn[4], xn[5]), pk2(xn[6], xn[7])}; *(u32x4*)(xb_ + 8) = (u32x4){pk2(xn[8], xn[9]), pk2(xn[10], xn[11]), pk2(xn[12], xn[13]), pk2(xn[14], xn[15])}; } \
            u32x4 w0, w1; \
            w0.x = pk2(xn[0] * r * gn[0], xn[1] * r * gn[1]); w0.y = pk2(xn[2] * r * gn[2], xn[3] * r * gn[3]); w0.z = pk2(xn[4] * r * gn[4], xn[5] * r * gn[5]); w0.w = pk2(xn[6] * r * gn[6], xn[7] * r * gn[7]); \
            w1.x = pk2(xn[8] * r * gn[8], xn[9] * r * gn[9]); w1.y = pk2(xn[10] * r * gn[10], xn[11] * r * gn[11]); w1.z = pk2(xn[12] * r * gn[12], xn[13] * r * gn[13]); w1.w = pk2(xn[14] * r * gn[14], xn[15] * r * gn[15]); \
            *(u32x4*)((bf16_t*)(ws + WS_H16) + (size_t)(m_) * D + lane * 16) = w0; *(u32x4*)((bf16_t*)(ws + WS_H16) + (size_t)(m_) * D + lane * 16 + 8) = w1; \
        } else { const float* gn = a.final_gain + lane * 16; \
            _Pragma("unroll") for (int j = 0; j < 4; ++j) *(f32x4*)(xr + 4 * j) = (f32x4){xn[4 * j] * r * gn[4 * j], xn[4 * j + 1] * r * gn[4 * j + 1], xn[4 * j + 2] * r * gn[4 * j + 2], xn[4 * j + 3] * r * gn[4 * j + 3]}; } } while (0)
        EPILOG(mA, accA, xA);
        if (vB) EPILOG(mB, accB, xB);
#undef EPILOG
#undef PAIR_LOAD
#undef LOADH
#undef SORTTOK
    }
}

constexpr int PH_PER_LAYER = 9, N_PHASES = 1 + DEPTH * PH_PER_LAYER;
__global__ void __launch_bounds__(NTHR, 2) fwd_kernel(Args a) {
    extern __shared__ __attribute__((aligned(16))) unsigned char lds[];
    const int wv = __builtin_amdgcn_readfirstlane((int)threadIdx.x >> 6);
    const int tid = threadIdx.x;
    for (int u = tid; u < (LDS_BYTES - LDS_CTL_OFF) / 4; u += NTHR) ((unsigned*)(lds + LDS_CTL_OFF))[u] = 0u;
    __syncthreads();
    unsigned* ctl = (unsigned*)(a.ws + WS_CTL);
    XcdBarrier bar = xcd_barrier_post(ctl + 4096, (volatile LAS unsigned*)(LAS unsigned char*)(lds + LDS_CTL_OFF), wv);
    const int lo = a.ph_lo, hi = a.ph_hi;
#define IN(k) (lo <= (k) && (k) < hi)
#define SEAM(k) do { if (IN(k) && IN((k) + 1)) xcd_barrier(bar, wv); } while (0)
    unsigned char* ws = oport(a.ws);
    if (IN(0)) { ph_prologue(a, lds, wv); } SEAM(0);
    for (int l = 0; l < DEPTH; ++l) {
        const int pb = 1 + l * PH_PER_LAYER;
        unsigned char* ws = oport(a.ws);
        if (IN(pb + 0)) {
            ph_kiwi(a, l, lds, wv);
            pg8::Gemm g{(const bf16_t*)(ws + WS_H16), (const bf16_t*)(ws + WS_WIN + (size_t)l * WIN_L), M, NMAIN, D, 0, 0};
            pg8::StaticOrder S; S.init(M, NMAIN, gridDim.x, obid(), 0);
            pg8::EpiIn E{(bf16_t*)(ws + WS_P16), (float*)(ws + WS_PF)};
            pg8::gemm_phase(((LAS unsigned char*)lds), g, S, E, wv);
        } SEAM(pb + 0);
        if (IN(pb + 1)) { ph_post(a, l, lds, wv); ph_h1(a, l, lds, wv); } SEAM(pb + 1);
        if (IN(pb + 2)) { ph_h2(a, wv); ph_gmlp(a, l, lds, wv); ph_sel(a, lds, wv); } SEAM(pb + 2);
        if (IN(pb + 3)) { ph_attn(a, lds, wv); ph_h3(a, l, lds, wv); } SEAM(pb + 3);
        if (IN(pb + 4)) {
            pg8::Gemm g{(const bf16_t*)(ws + WS_YALL), (const bf16_t*)(ws + WS_WBR + (size_t)l * WBR_L), M, 3072, 512, (size_t)M * 512 * 2, 4};
            pg8::BranchOrder S; S.init(gridDim.x, obid());
            pg8::EpiGate E{(bf16_t*)(ws + WS_GB), (const bf16_t*)(ws + WS_P16)};
            pg8::gemm_phase(((LAS unsigned char*)lds), g, S, E, wv);
        } SEAM(pb + 4);
        if (IN(pb + 5)) {
            pg8::Gemm g{(const bf16_t*)(ws + WS_GB), (const bf16_t*)(ws + WS_WOUT + (size_t)l * WOUT_L), M, D, D, 0, 0};
            pg8::StaticOrder S; S.init(M, D, gridDim.x, obid(), 0);
            pg8::EpiRes E{(bf16_t*)(ws + WS_XR), l == 0 ? a.x : (const float*)nullptr};
            pg8::gemm_phase(((LAS unsigned char*)lds), g, S, E, wv);
        } SEAM(pb + 5);
        if (IN(pb + 6)) { ph_norm2(a, l, wv); } SEAM(pb + 6);
        if (IN(pb + 7)) {
            pg8::Gemm g{(const bf16_t*)(ws + WS_H16), (const bf16_t*)(ws + WS_WPQ + (size_t)l * WPQ_L), M, 2048, D, 0, 0};
            pg8::StaticOrder S; S.init(M, 2048, gridDim.x, obid(), 0);
            pg8::EpiB16 E{(bf16_t*)(ws + WS_GB), 2048};
            pg8::gemm_phase(((LAS unsigned char*)lds), g, S, E, wv);
            asm volatile("s_waitcnt vmcnt(0)" ::: "memory"); __syncthreads();
            for (int i0_ = 0;; i0_ += 2) { pg8::Unit u0, u1; if (!S.next(i0_, u0)) break; const bool two = S.next(i0_ + 1, u1);
                ph_peer_select(a, l, lds, wv, two ? 2 : 1, u0.pm, u0.pn, two ? u1.pm : 0, two ? u1.pn : 0); }
        } SEAM(pb + 7);
        if (IN(pb + 8)) { ph_peer_experts(a, l, lds, wv); } SEAM(pb + 8);
    }
#undef IN
#undef SEAM
}

#ifndef MK_N_LAUNCHES
#define MK_N_LAUNCHES 1
#endif
extern "C" void kernel_launch(void* const* d_in, const int* in_sizes, int n_in, void* d_out, int out_size, void* d_ws, size_t ws_size, hipStream_t stream) {
    static int grid = 0;
    if (grid == 0) {
        if (n_in != 17 || out_size != M * D || ws_size < WS_END) { fprintf(stderr, "kernel_launch: unexpected shapes (n_in %d, out %d, ws %zu)\n", n_in, out_size, ws_size); grid = -1; return; }
        int dev = 0, cus = 0, per_cu = 0;
        if (hipGetDevice(&dev) != hipSuccess || hipDeviceGetAttribute(&cus, hipDeviceAttributeMultiprocessorCount, dev) != hipSuccess) { grid = -1; return; }
        if (hipFuncSetAttribute((const void*)fwd_kernel, hipFuncAttributeMaxDynamicSharedMemorySize, LDS_BYTES) != hipSuccess) { fprintf(stderr, "kernel_launch: hipFuncSetAttribute failed\n"); grid = -1; return; }
        if (hipOccupancyMaxActiveBlocksPerMultiprocessor(&per_cu, (const void*)fwd_kernel, NTHR, LDS_BYTES) != hipSuccess || per_cu < 1) { fprintf(stderr, "kernel_launch: occupancy query says %d\n", per_cu); (void)hipGetLastError(); grid = -1; return; }
        grid = cus;
    }
    if (grid < 0) return;
    (void)hipMemsetAsync((char*)d_ws + WS_CTL, 0, CTL_BYTES, stream);
    Args a{};
    a.x = (const float*)d_in[0]; a.pos = (const int*)d_in[1]; a.norm1 = (const float*)d_in[2]; a.w_in = (const float*)d_in[3]; a.lb_logits = (const float*)d_in[4]; a.hgrn_gain = (const float*)d_in[5];
    a.gmlp_gain = (const float*)d_in[6]; a.gmlp_ws = (const float*)d_in[7]; a.gmlp_bs = (const float*)d_in[8]; a.w_branch = (const float*)d_in[9]; a.w_out = (const float*)d_in[10]; a.norm2 = (const float*)d_in[11];
    a.peer_wq = (const float*)d_in[12]; a.peer_keys = (const float*)d_in[13]; a.peer_u = (const float*)d_in[14]; a.peer_v = (const float*)d_in[15]; a.final_gain = (const float*)d_in[16];
    a.out = (float*)d_out; a.ws = (unsigned char*)d_ws;
    if (MK_N_LAUNCHES == 1) { a.ph_lo = 0; a.ph_hi = N_PHASES; hipLaunchKernelGGL(fwd_kernel, dim3(grid), dim3(NTHR), LDS_BYTES, stream, a); }
    else for (int p = 0; p < N_PHASES; ++p) { a.ph_lo = p; a.ph_hi = p + 1; hipLaunchKernelGGL(fwd_kernel, dim3(grid), dim3(NTHR), LDS_BYTES, stream, a); }
}
```
